# Optimizing an MI355X kernel written in HIP

```python
import jax, jax.numpy as jnp
from jax import lax
import numpy as np

D_MODEL = 1024
BATCH = 8
SEQ = 2048
DEPTH = 4

GRID_W = 64
CTX_LEN = 256
N_MOD = 6
MLA_H = 4
MLA_NOPE = 64
MLA_ROPE = 32
MLA_V = 64
MLA_Q_LORA = 256
MLA_KV_LORA = 128
Q_BLOCK = 128
ROPE_THETA = 10000.0
NA_H = 4
NA_D = 64
NA_W = NA_H * NA_D
NA_ROWS = 8
NA_COLS = 16
DN_H = 4
DN_D = 128
DN_W = DN_H * DN_D
DN_CONV = 5
DN_CHUNK = 64
DN_PROJ = 4 * DN_W + 4 * DN_H
IN_W = MLA_Q_LORA + MLA_KV_LORA + MLA_ROPE + 3 * NA_W + DN_PROJ
MIX_W = MLA_H * MLA_V + NA_W + DN_W
FFN_HIDDEN = -(-8 * D_MODEL // (3 * 256)) * 256
EPS = 1e-6

kernel_name = "hybrid_mla_natten_gdn_diffusion_block"


def rms_norm(x, g):
    xf = x.astype(jnp.float32)
    y = xf * lax.rsqrt(jnp.mean(xf * xf, axis=-1, keepdims=True) + EPS)
    return (y * g.astype(jnp.float32)).astype(x.dtype)


def l2_norm(x):
    xf = x.astype(jnp.float32)
    return xf * lax.rsqrt(jnp.sum(xf * xf, axis=-1, keepdims=True) + EPS)


def modulate(h, shift, scale):
    return h * (1 + scale) + shift


def split_in(p):
    sizes = [MLA_Q_LORA, MLA_KV_LORA, MLA_ROPE, NA_W, NA_W, NA_W, DN_PROJ]
    offs = [int(o) for o in np.cumsum(sizes)[:-1]]
    return jnp.split(p, offs, axis=-1)


def axial_rope_tables(n_tok):
    t = jnp.arange(n_tok)
    pos = jnp.stack([t // GRID_W, t % GRID_W], axis=-1).astype(jnp.float32)
    n_freq = MLA_ROPE // 4
    inv = jnp.power(ROPE_THETA, -jnp.arange(n_freq, dtype=jnp.float32) / n_freq)
    ang = pos[:, :, None] * inv
    return jnp.cos(ang), jnp.sin(ang)


def apply_axial_rope(x, cos, sin):
    B, T, H, R = x.shape
    xa = x.astype(jnp.float32).reshape(B, T, H, 2, 2, R // 4)
    x1, x2 = xa[..., 0, :], xa[..., 1, :]
    c, s = cos[None, :, None], sin[None, :, None]
    y = jnp.stack([x1 * c - x2 * s, x1 * s + x2 * c], axis=-2)
    return y.reshape(B, T, H, R).astype(x.dtype)


def softmax_attention(q, k, v, scale):
    s = jnp.einsum('bqhd,bkhd->bhqk', q, k).astype(jnp.float32) * scale
    p = jax.nn.softmax(s, axis=-1).astype(v.dtype)
    return jnp.einsum('bhqk,bkhd->bqhd', p, v)


def blocked_attention(q, k, v, scale):
    B, T, H, d = q.shape
    nb = T // Q_BLOCK
    qb = q.reshape(B, nb, Q_BLOCK, H, d).transpose(1, 0, 2, 3, 4)
    out = lax.map(lambda blk: softmax_attention(blk, k, v, scale), qb)
    return out.transpose(1, 0, 2, 3, 4).reshape(B, T, H, v.shape[-1])


def mla_mixer(q_c, kv_c, k_pe, cq_c, ckv_c, ck_pe, g_q, g_kv, w_q_up, w_kv_up, cos, sin, need_ctx):
    B, T, _ = q_c.shape
    scale = (MLA_NOPE + MLA_ROPE) ** -0.5

    def q_heads(qc):
        return (rms_norm(qc, g_q) @ w_q_up).reshape(qc.shape[0], qc.shape[1], MLA_H, MLA_NOPE + MLA_ROPE)

    def kv_heads(kvc, pe):
        kv = (rms_norm(kvc, g_kv) @ w_kv_up).reshape(kvc.shape[0], kvc.shape[1], MLA_H, MLA_NOPE + MLA_V)
        pe = jnp.broadcast_to(pe, kv.shape[:3] + (MLA_ROPE,))
        return jnp.concatenate([kv[..., :MLA_NOPE], pe], axis=-1), kv[..., MLA_NOPE:]

    q = q_heads(q_c)
    q = jnp.concatenate([q[..., :MLA_NOPE], apply_axial_rope(q[..., MLA_NOPE:], cos, sin)], axis=-1)
    k, v = kv_heads(kv_c, apply_axial_rope(k_pe[:, :, None, :], cos, sin))
    ck, cv = kv_heads(ckv_c, ck_pe[:, :, None, :])
    keys = jnp.concatenate([ck, k], axis=1)
    vals = jnp.concatenate([cv, v], axis=1)
    out = blocked_attention(q, keys, vals, scale).reshape(B, T, MLA_H * MLA_V)
    if not need_ctx:
        return out, None
    cq = q_heads(cq_c)
    c_out = softmax_attention(cq, ck, cv, scale).reshape(cq.shape[0], cq.shape[1], MLA_H * MLA_V)
    return out, c_out


def na_mixer(q, k, v, cq, ck, cv, rel_bias, need_ctx):
    B, T, _ = q.shape
    rows = T // GRID_W
    kh = min(NA_ROWS, rows)
    heads = lambda t: t.reshape(t.shape[0], t.shape[1], NA_H, NA_D)
    q, k, v, cq, ck, cv = heads(q), heads(k), heads(v), heads(cq), heads(ck), heads(cv)
    grid = lambda t: t.reshape(B, rows, GRID_W, NA_H, NA_D)
    qg, kg, vg = grid(q), grid(k), grid(v)
    r = jnp.arange(rows)
    row_idx = jnp.clip(r - kh // 2, 0, rows - kh)[:, None] + jnp.arange(kh)[None, :]
    kb, vb = kg[:, row_idx], vg[:, row_idx]
    col = jnp.arange(GRID_W)
    col_start = jnp.clip(col - NA_COLS // 2, 0, GRID_W - NA_COLS)
    col_ok = (col[None, :] >= col_start[:, None]) & (col[None, :] < col_start[:, None] + NA_COLS)
    dr_i = row_idx - r[:, None] + NA_ROWS - 1
    dc_i = jnp.clip(col[None, :] - col[:, None] + NA_COLS - 1, 0, 2 * NA_COLS - 2)
    bias = rel_bias[:, dr_i[:, None, :, None], dc_i[None, :, None, :]].astype(jnp.float32)
    scale = NA_D ** -0.5
    s_loc = jnp.einsum('brqhd,brjkhd->bhrqjk', qg, kb).astype(jnp.float32) * scale + bias
    s_loc = jnp.where(col_ok[:, None, :], s_loc, -jnp.inf).reshape(B, NA_H, rows, GRID_W, kh * GRID_W)
    s_ctx = jnp.einsum('brqhd,bchd->bhrqc', qg, ck).astype(jnp.float32) * scale
    p = jax.nn.softmax(jnp.concatenate([s_loc, s_ctx], axis=-1), axis=-1).astype(v.dtype)
    p_loc = p[..., :kh * GRID_W].reshape(B, NA_H, rows, GRID_W, kh, GRID_W)
    p_ctx = p[..., kh * GRID_W:]
    o = (jnp.einsum('bhrqjk,brjkhd->brqhd', p_loc, vb)
         + jnp.einsum('bhrqc,bchd->brqhd', p_ctx, cv)).reshape(B, T, NA_W)
    if not need_ctx:
        return o, None
    c_out = softmax_attention(cq, ck, cv, scale).reshape(cq.shape[0], cq.shape[1], NA_W)
    return o, c_out


def centred_depthwise_conv(x, w):
    K = w.shape[0]
    return lax.conv_general_dilated(x, w[:, None, :], window_strides=(1,), padding=[(K // 2, K // 2)],
                                    dimension_numbers=('NWC', 'WIO', 'NWC'), feature_group_count=x.shape[-1])


def chunk_gated_delta_rule(q, k, v, g, beta, state, with_out):
    f32 = jnp.float32
    B, T, H, dk = q.shape
    dv = v.shape[-1]
    N = T // DN_CHUNK

    def blocks(t):
        t = t.astype(f32).reshape((B, N, DN_CHUNK, H) + t.shape[3:])
        return jnp.moveaxis(t, 3, 1)

    q = blocks(q) * dk ** -0.5
    k, v, g, beta = blocks(k), blocks(v), blocks(g), blocks(beta)
    gc = jnp.cumsum(g, axis=-1)
    idx = jnp.arange(DN_CHUNK)
    lower = idx[:, None] >= idx[None, :]
    strict = idx[:, None] > idx[None, :]
    decay = jnp.exp(jnp.where(lower, gc[..., :, None] - gc[..., None, :], -jnp.inf))
    kb = k * beta[..., None]
    L = jnp.where(strict, jnp.einsum('bhnid,bhnjd->bhnij', kb, k) * decay, 0.0)
    eye = jnp.eye(DN_CHUNK, dtype=f32)
    tinv = lax.linalg.triangular_solve(L + eye, jnp.broadcast_to(eye, L.shape), left_side=True,
                                       lower=True, unit_diagonal=True)
    u = tinv @ (v * beta[..., None])
    w = tinv @ (kb * jnp.exp(gc)[..., None])
    k_tail = k * jnp.exp(gc[..., -1:] - gc)[..., None]
    g_last = jnp.exp(gc[..., -1])
    mv = lambda t: jnp.moveaxis(t, 2, 0)
    xs = (mv(u), mv(w), mv(k_tail), mv(g_last))
    if with_out:
        q_dec = q * jnp.exp(gc)[..., None]
        a_intra = jnp.einsum('bhnid,bhnjd->bhnij', q, k) * decay
        xs = xs + (mv(q_dec), mv(a_intra))

    def step(S, xn):
        v_new = xn[0] - xn[1] @ S
        S_new = S * xn[3][..., None, None] + jnp.swapaxes(xn[2], -1, -2) @ v_new
        if with_out:
            return S_new, xn[4] @ S + xn[5] @ v_new
        return S_new, None

    S, o = lax.scan(step, state.astype(f32), xs)
    if with_out:
        o = o.transpose(1, 0, 3, 2, 4).reshape(B, T, H, dv)
    return o, S


def gated_deltanet_mixer(p, pc, conv_w, a_log, dt_bias, g_out, need_ctx):
    def prep(t):
        B, T, _ = t.shape
        qkv = jax.nn.silu(centred_depthwise_conv(t[..., :3 * DN_W], conv_w))
        q, k, v = [s.reshape(B, T, DN_H, DN_D) for s in jnp.split(qkv, 3, axis=-1)]
        a = t[..., 4 * DN_W:4 * DN_W + 2 * DN_H].reshape(B, T, 2, DN_H).astype(jnp.float32)
        b = t[..., 4 * DN_W + 2 * DN_H:].reshape(B, T, 2, DN_H).astype(jnp.float32)
        g = -jnp.exp(a_log.astype(jnp.float32)) * jax.nn.softplus(a + dt_bias.astype(jnp.float32))
        return l2_norm(q), l2_norm(k), v, g, jax.nn.sigmoid(b)

    def direction(seq, d):
        q, k, v, g, beta = seq
        f = (lambda t: jnp.flip(t, axis=1)) if d == 1 else (lambda t: t)
        return f(q), f(k), f(v), f(g[:, :, d]), f(beta[:, :, d])

    lat, cseq = prep(p), prep(pc)
    B = p.shape[0]
    o_lat, o_ctx = 0.0, 0.0
    for d in range(2):
        s0 = jnp.zeros((B, DN_H, DN_D, DN_D), jnp.float32)
        oc, s_ctx = chunk_gated_delta_rule(*direction(cseq, d), s0, need_ctx)
        ol, _ = chunk_gated_delta_rule(*direction(lat, d), s_ctx, True)
        o_lat = o_lat + (jnp.flip(ol, axis=1) if d == 1 else ol)
        if need_ctx:
            o_ctx = o_ctx + (jnp.flip(oc, axis=1) if d == 1 else oc)

    def out_gate(o, t):
        z = t[..., 3 * DN_W:4 * DN_W].reshape(o.shape).astype(jnp.float32)
        return (rms_norm(o, g_out) * jax.nn.silu(z)).reshape(o.shape[0], o.shape[1], DN_W).astype(t.dtype)

    return out_gate(o_lat, p), (out_gate(o_ctx, pc) if need_ctx else None)


def swiglu(h, w_gate, w_up, w_down):
    return (jax.nn.silu(h @ w_gate) * (h @ w_up)) @ w_down


def setup_inputs(seed: int = 0) -> dict:
    key = jax.random.key(seed)
    ks = jax.random.split(key, 24)
    nrm = lambda k, shape, s: jax.random.normal(k, shape, jnp.float32) * s
    gain = lambda k, shape: 1.0 + 0.1 * jax.random.normal(k, shape, jnp.float32)
    dt = jnp.exp(jax.random.uniform(ks[15], (DEPTH, 2, DN_H), jnp.float32, np.log(1e-3), np.log(1e-1)))
    return {
        "x": nrm(ks[0], (BATCH, SEQ, D_MODEL), 1.0),
        "c": nrm(ks[1], (BATCH, D_MODEL), 1.0),
        "ctx": nrm(ks[2], (BATCH, CTX_LEN, D_MODEL), 1.0),
        "c_ctx": nrm(ks[3], (D_MODEL,), 1.0),
        "w_ada": nrm(ks[4], (DEPTH, D_MODEL, N_MOD * D_MODEL), 0.5 * D_MODEL ** -0.5),
        "b_ada": nrm(ks[5], (DEPTH, N_MOD * D_MODEL), 0.01),
        "g_mix": gain(ks[6], (DEPTH, D_MODEL)),
        "w_in": nrm(ks[7], (DEPTH, D_MODEL, IN_W), D_MODEL ** -0.5),
        "mla_g_q": gain(ks[8], (DEPTH, MLA_Q_LORA)),
        "mla_g_kv": gain(ks[9], (DEPTH, MLA_KV_LORA)),
        "mla_w_q_up": nrm(ks[10], (DEPTH, MLA_Q_LORA, MLA_H * (MLA_NOPE + MLA_ROPE)), MLA_Q_LORA ** -0.5),
        "mla_w_kv_up": nrm(ks[11], (DEPTH, MLA_KV_LORA, MLA_H * (MLA_NOPE + MLA_V)), MLA_KV_LORA ** -0.5),
        "na_rel_bias": nrm(ks[12], (DEPTH, NA_H, 2 * NA_ROWS - 1, 2 * NA_COLS - 1), 0.1),
        "dn_conv_w": nrm(ks[13], (DEPTH, DN_CONV, 3 * DN_W), DN_CONV ** -0.5),
        "dn_a_log": jnp.log(jax.random.uniform(ks[14], (DEPTH, 2, DN_H), jnp.float32, 1.0, 16.0)),
        "dn_dt_bias": jnp.log(jnp.expm1(dt)),
        "dn_g_out": gain(ks[16], (DEPTH, DN_D)),
        "w_out": nrm(ks[17], (DEPTH, MIX_W, D_MODEL), MIX_W ** -0.5),
        "g_ffn": gain(ks[18], (DEPTH, D_MODEL)),
        "w_gate": nrm(ks[19], (DEPTH, D_MODEL, FFN_HIDDEN), D_MODEL ** -0.5),
        "w_up": nrm(ks[20], (DEPTH, D_MODEL, FFN_HIDDEN), D_MODEL ** -0.5),
        "w_down": nrm(ks[21], (DEPTH, FFN_HIDDEN, D_MODEL), FFN_HIDDEN ** -0.5),
        "g_final": gain(ks[22], (D_MODEL,)),
    }


def reference(x, c, ctx, c_ctx, w_ada, b_ada, g_mix, w_in, mla_g_q, mla_g_kv, mla_w_q_up, mla_w_kv_up,
              na_rel_bias, dn_conv_w, dn_a_log, dn_dt_bias, dn_g_out, w_out, g_ffn, w_gate, w_up, w_down,
              g_final):
    T = x.shape[1]
    cos, sin = axial_rope_tables(T)
    sc = jax.nn.silu(c)
    scc = jax.nn.silu(c_ctx)[None]
    for l in range(DEPTH):
        need_ctx = l < DEPTH - 1
        mx = (sc @ w_ada[l] + b_ada[l]).reshape(-1, N_MOD, 1, D_MODEL)
        mc = (scc @ w_ada[l] + b_ada[l]).reshape(1, N_MOD, 1, D_MODEL)
        h = modulate(rms_norm(x, g_mix[l]), mx[:, 0], mx[:, 1])
        hc = modulate(rms_norm(ctx, g_mix[l]), mc[:, 0], mc[:, 1])
        mq, mkv, mpe, nq, nk, nv, dn = split_in(h @ w_in[l])
        cmq, cmkv, cmpe, cnq, cnk, cnv, cdn = split_in(hc @ w_in[l])
        mla_o, mla_c = mla_mixer(mq, mkv, mpe, cmq, cmkv, cmpe, mla_g_q[l], mla_g_kv[l], mla_w_q_up[l],
                                 mla_w_kv_up[l], cos, sin, need_ctx)
        na_o, na_c = na_mixer(nq, nk, nv, cnq, cnk, cnv, na_rel_bias[l], need_ctx)
        dn_o, dn_c = gated_deltanet_mixer(dn, cdn, dn_conv_w[l], dn_a_log[l], dn_dt_bias[l], dn_g_out[l], need_ctx)
        x = x + mx[:, 2] * (jnp.concatenate([mla_o, na_o, dn_o], axis=-1) @ w_out[l])
        h = modulate(rms_norm(x, g_ffn[l]), mx[:, 3], mx[:, 4])
        x = x + mx[:, 5] * swiglu(h, w_gate[l], w_up[l], w_down[l])
        if need_ctx:
            ctx = ctx + mc[:, 2] * (jnp.concatenate([mla_c, na_c, dn_c], axis=-1) @ w_out[l])
            hc = modulate(rms_norm(ctx, g_ffn[l]), mc[:, 3], mc[:, 4])
            ctx = ctx + mc[:, 5] * swiglu(hc, w_gate[l], w_up[l], w_down[l])
    return rms_norm(x, g_final)
```

```cpp
#include <hip/hip_runtime.h>
#include <hip/hip_bf16.h>
#include <hip/hip_cooperative_groups.h>
#include <cstdio>
namespace cg = cooperative_groups;

#define DEVI __device__ __forceinline__
typedef unsigned short bf16_t;
typedef short bf16x8 __attribute__((ext_vector_type(8)));
typedef float f32x16 __attribute__((ext_vector_type(16)));

constexpr int M_LAT = 16384, M_CTX = 2048, M_ALL = 18432;
constexpr int DM = 1024, INW = 3248, INWP = 3328, FFN = 2816;
constexpr int C_MQ = 0, C_MKV = 256, C_MPE = 384, C_NQ = 416, C_NK = 672, C_NV = 928, C_DN = 1184;
constexpr int C_DZ = C_DN + 1536, C_DA = C_DN + 2048;

constexpr size_t OFF_WIN = 0;
constexpr size_t OFF_WOUT = OFF_WIN + (size_t)INWP * 1024 * 2;
constexpr size_t OFF_WGU = OFF_WOUT + (size_t)1024 * 1024 * 2;
constexpr size_t OFF_WDN = OFF_WGU + (size_t)2 * FFN * 1024 * 2;
constexpr size_t OFF_WQUP = OFF_WDN + (size_t)1024 * FFN * 2;
constexpr size_t OFF_WKVUP = OFF_WQUP + (size_t)384 * 256 * 2;
constexpr size_t OFF_MOD = OFF_WKVUP + (size_t)512 * 128 * 2;
constexpr size_t OFF_ROPE = OFF_MOD + (size_t)4 * 9 * 6144 * 4;
constexpr size_t OFF_X = OFF_ROPE + (size_t)2048 * 16 * 2 * 4;
constexpr size_t OFF_HM = OFF_X + (size_t)M_ALL * 1024 * 4;
constexpr size_t OFF_P = OFF_HM + (size_t)M_ALL * 1024 * 2;
constexpr size_t OFF_QH = OFF_P + (size_t)M_ALL * INWP * 2;
constexpr size_t OFF_KH = OFF_QH + (size_t)M_ALL * 384 * 2;
constexpr size_t OFF_VH = OFF_KH + (size_t)M_ALL * 384 * 2;
constexpr size_t OFF_DNQKV = OFF_VH + (size_t)M_ALL * 256 * 2;
constexpr size_t OFF_OB = OFF_DNQKV + (size_t)M_ALL * 1536 * 2;
constexpr size_t OFF_AB = OFF_OB + (size_t)M_ALL * 512 * 2;
constexpr size_t WS_TOTAL = OFF_AB + (size_t)M_ALL * 16 * 4;

struct Params {
  const float *x, *c, *ctx, *c_ctx, *w_ada, *b_ada, *g_mix, *w_in, *g_q, *g_kv, *w_qup, *w_kvup, *rel_bias,
      *conv_w, *a_log, *dt_bias, *g_out, *w_out, *g_ffn, *w_gate, *w_up, *w_down, *g_final;
  float* out;
  char* ws;
  int ph_lo, ph_hi;
};

DEVI bf16_t f2bf(float f) {
  unsigned u = __float_as_uint(f);
  u += 0x7fffu + ((u >> 16) & 1u);
  return (bf16_t)(u >> 16);
}
DEVI int otid() {
  int t = threadIdx.x;
  asm volatile("" : "+v"(t));
  return t;
}
DEVI float bf2f(bf16_t h) { return __uint_as_float(((unsigned)h) << 16); }
DEVI float bflo(unsigned u) { return __uint_as_float(u << 16); }
DEVI float bfhi(unsigned u) { return __uint_as_float(u & 0xffff0000u); }
DEVI unsigned pack2(float a, float b) { return (unsigned)f2bf(a) | ((unsigned)f2bf(b) << 16); }
DEVI float silu_f(float x) { return x / (1.f + __expf(-x)); }
DEVI float wave_sum(float v) {
#pragma unroll
  for (int o = 32; o >= 1; o >>= 1) v += __shfl_xor(v, o);
  return v;
}

__device__ void phase0(const Params& p, char* smem) {
  const int tid = otid(), nb = gridDim.x, bid = blockIdx.x;
  {
    float4* X4 = (float4*)(p.ws + OFF_X);
    const float4* x4 = (const float4*)p.x;
    const float4* c4 = (const float4*)p.ctx;
    const size_t n1 = (size_t)M_LAT * 256, n2 = (size_t)M_CTX * 256;
    for (size_t i = (size_t)bid * 256 + tid; i < n1 + n2; i += (size_t)nb * 256) X4[i] = i < n1 ? x4[i] : c4[i - n1];
  }
  {
    float* rc = (float*)(p.ws + OFF_ROPE);
    float* rs = rc + 2048 * 16;
    for (int i = bid * 256 + tid; i < 2048 * 16; i += nb * 256) {
      int t = i >> 4, a = (i >> 3) & 1, j = i & 7;
      float pos = a ? (float)(t & 63) : (float)(t >> 6);
      float inv = powf(10000.f, -(float)j / 8.f);
      float ang = pos * inv;
      rc[i] = cosf(ang);
      rs[i] = sinf(ang);
    }
  }
  float* sc = (float*)smem;
  float* red = sc + 9 * 1024;
  float* MOD = (float*)(p.ws + OFF_MOD);
  bool loaded = false;
  for (int it = bid; it < 4 * 96; it += nb) {
    if (!loaded) {
      for (int i = tid; i < 9 * 1024; i += 256) {
        float v = i < 8192 ? p.c[i] : p.c_ctx[i - 8192];
        sc[i] = silu_f(v);
      }
      __syncthreads();
      loaded = true;
    }
    const int l = it / 96, n0 = (it % 96) * 64;
    const int cc = tid & 63, kg = tid >> 6;
    const float* w = p.w_ada + (size_t)l * 1024 * 6144 + n0 + cc;
    float acc[9];
#pragma unroll
    for (int b = 0; b < 9; ++b) acc[b] = 0.f;
    for (int k = kg * 256; k < kg * 256 + 256; ++k) {
      float wv = w[(size_t)k * 6144];
#pragma unroll
      for (int b = 0; b < 9; ++b) acc[b] += sc[b * 1024 + k] * wv;
    }
#pragma unroll
    for (int b = 0; b < 9; ++b) red[(kg * 9 + b) * 64 + cc] = acc[b];
    __syncthreads();
    for (int i = tid; i < 9 * 64; i += 256) {
      int b = i >> 6, c2 = i & 63;
      float s = red[(0 * 9 + b) * 64 + c2] + red[(1 * 9 + b) * 64 + c2] + red[(2 * 9 + b) * 64 + c2] +
                red[(3 * 9 + b) * 64 + c2];
      MOD[(size_t)(l * 9 + b) * 6144 + n0 + c2] = s + p.b_ada[l * 6144 + n0 + c2];
    }
    __syncthreads();
  }
}

__device__ void convT_tile(const float* __restrict__ src, int K, int N, bf16_t* __restrict__ dst, int mode,
                           const float* __restrict__ gs, int kt, int nt, float* tl) {
  const int tid = otid();
  const int k0 = kt * 64, n0 = nt * 64;
  __syncthreads();
#pragma unroll 4
  for (int i = 0; i < 16; ++i) {
    int kk = i * 4 + (tid >> 6), nn = tid & 63;
    float v = 0.f;
    if (n0 + nn < N) v = src[(size_t)(k0 + kk) * N + n0 + nn];
    if (gs) v *= gs[k0 + kk];
    tl[kk * 65 + nn] = v;
  }
  __syncthreads();
#pragma unroll 2
  for (int i = 0; i < 8; ++i) {
    int nn = i * 8 + (tid >> 5), kk = (tid & 31) * 2;
    unsigned pk = pack2(tl[kk * 65 + nn], tl[(kk + 1) * 65 + nn]);
    int n = n0 + nn;
    int drow = mode == 0 ? n : ((n >> 5) * 64 + (n & 31) + (mode == 2 ? 32 : 0));
    *(unsigned*)(dst + (size_t)drow * K + k0 + kk) = pk;
  }
}

__device__ void norm_rows(const float* __restrict__ X, bf16_t* __restrict__ H, const float* __restrict__ g,
                          const float* __restrict__ modl, int shift_i, int scale_i, int item) {
  const int w = otid() >> 6, lane = otid() & 63;
  const int row = item * 4 + w;
  const float4* xr = (const float4*)(X + (size_t)row * 1024);
  float4 v[4];
  float ss = 0.f;
#pragma unroll
  for (int i = 0; i < 4; ++i) {
    v[i] = xr[lane + 64 * i];
    ss += v[i].x * v[i].x + v[i].y * v[i].y + v[i].z * v[i].z + v[i].w * v[i].w;
  }
  ss = wave_sum(ss);
  const float r = rsqrtf(ss * (1.f / 1024.f) + 1e-6f);
  const int b = row < M_LAT ? (row >> 11) : 8;
  const float4* sh = (const float4*)(modl + b * 6144 + shift_i * 1024);
  const float4* sl = (const float4*)(modl + b * 6144 + scale_i * 1024);
  const float4* g4 = (const float4*)g;
#pragma unroll
  for (int i = 0; i < 4; ++i) {
    int c4 = lane + 64 * i;
    float4 gg = g4[c4], s4 = sh[c4], l4 = sl[c4];
    float y0 = v[i].x * r * gg.x * (1.f + l4.x) + s4.x;
    float y1 = v[i].y * r * gg.y * (1.f + l4.y) + s4.y;
    float y2 = v[i].z * r * gg.z * (1.f + l4.z) + s4.z;
    float y3 = v[i].w * r * gg.w * (1.f + l4.w) + s4.w;
    uint2 pk;
    pk.x = pack2(y0, y1);
    pk.y = pack2(y2, y3);
    *(uint2*)(H + (size_t)row * 1024 + c4 * 4) = pk;
  }
}

__device__ void phaseA(const Params& p, int l, char* smem) {
  const int nb = gridDim.x, bid = blockIdx.x;
  float* tl = (float*)smem;
  bf16_t* Win = (bf16_t*)(p.ws + OFF_WIN);
  bf16_t* Wout = (bf16_t*)(p.ws + OFF_WOUT);
  bf16_t* Wgu = (bf16_t*)(p.ws + OFF_WGU);
  bf16_t* Wdn = (bf16_t*)(p.ws + OFF_WDN);
  bf16_t* Wq = (bf16_t*)(p.ws + OFF_WQUP);
  bf16_t* Wkv = (bf16_t*)(p.ws + OFF_WKVUP);
  constexpr int T0 = 16 * 52, T1 = T0 + 256, T2 = T1 + 704, T3 = T2 + 704, T4 = T3 + 704, T5 = T4 + 24, T6 = T5 + 16;
  constexpr int NORM_ITEMS = M_ALL / 4;
  for (int it = bid; it < T6 + NORM_ITEMS; it += nb) {
    if (it < T6) {
      const float* src;
      const float* gs = nullptr;
      bf16_t* dst;
      int K, N, mode = 0, ntn, i;
      if (it < T0) {
        i = it; src = p.w_in + (size_t)l * 1024 * INW; K = 1024; N = INW; dst = Win; ntn = 52;
      } else if (it < T1) {
        i = it - T0; src = p.w_out + (size_t)l * 1024 * 1024; K = 1024; N = 1024; dst = Wout; ntn = 16;
      } else if (it < T2) {
        i = it - T1; src = p.w_gate + (size_t)l * 1024 * FFN; K = 1024; N = FFN; dst = Wgu; ntn = 44; mode = 1;
      } else if (it < T3) {
        i = it - T2; src = p.w_up + (size_t)l * 1024 * FFN; K = 1024; N = FFN; dst = Wgu; ntn = 44; mode = 2;
      } else if (it < T4) {
        i = it - T3; src = p.w_down + (size_t)l * FFN * 1024; K = FFN; N = 1024; dst = Wdn; ntn = 16;
      } else if (it < T5) {
        i = it - T4; src = p.w_qup + (size_t)l * 256 * 384; K = 256; N = 384; dst = Wq; ntn = 6; gs = p.g_q + l * 256;
      } else {
        i = it - T5; src = p.w_kvup + (size_t)l * 128 * 512; K = 128; N = 512; dst = Wkv; ntn = 8; gs = p.g_kv + l * 128;
      }
      convT_tile(src, K, N, dst, mode, gs, i / ntn, i % ntn, tl);
    } else {
      norm_rows((const float*)(p.ws + OFF_X), (bf16_t*)(p.ws + OFF_HM), p.g_mix + l * 1024,
                (const float*)(p.ws + OFF_MOD) + (size_t)l * 9 * 6144, 0, 1, it - T6);
    }
  }
}

enum { EPI_P = 0, EPI_QUP = 1, EPI_KVUP = 2, EPI_RES = 3, EPI_GU = 4 };

template <int EPI>
__device__ void gemm_tile(const Params& p, int l, const bf16_t* __restrict__ A, int lda,
                          const bf16_t* __restrict__ BT, int K, int m0, int n0, int gate_i, char* smem) {
  bf16_t* sA = (bf16_t*)smem;
  bf16_t* sB = sA + 128 * 72;
  float* rsv = (float*)(smem + 2 * 128 * 72 * 2);
  const int tid = otid(), lane = tid & 63, w = tid >> 6, wm = w >> 1, wn = w & 1;
  const int lr = tid >> 3, lc = (tid & 7) * 8;
  __syncthreads();
  if (EPI == EPI_QUP || EPI == EPI_KVUP) {
    const int row = tid >> 1, hf = tid & 1;
    const int n8 = K / 16;
    const uint4* ap = (const uint4*)(A + (size_t)(m0 + row) * lda + hf * (K / 2));
    float ss = 0.f;
    for (int i = 0; i < n8; ++i) {
      uint4 u = ap[i];
      float a0 = bflo(u.x), a1 = bfhi(u.x), a2 = bflo(u.y), a3 = bfhi(u.y), a4 = bflo(u.z), a5 = bfhi(u.z),
            a6 = bflo(u.w), a7 = bfhi(u.w);
      ss += a0 * a0 + a1 * a1 + a2 * a2 + a3 * a3 + a4 * a4 + a5 * a5 + a6 * a6 + a7 * a7;
    }
    ss += __shfl_xor(ss, 1);
    if (hf == 0) rsv[row] = rsqrtf(ss / (float)K + 1e-6f);
  }
  const bf16_t* Ap = A + (size_t)(m0 + lr) * lda + lc;
  const bf16_t* Bp = BT + (size_t)(n0 + lr) * K + lc;
  uint4 ra0, ra1, ra2, ra3, rb0, rb1, rb2, rb3;
  ra0 = *(const uint4*)(Ap);
  ra1 = *(const uint4*)(Ap + (size_t)32 * lda);
  ra2 = *(const uint4*)(Ap + (size_t)64 * lda);
  ra3 = *(const uint4*)(Ap + (size_t)96 * lda);
  rb0 = *(const uint4*)(Bp);
  rb1 = *(const uint4*)(Bp + (size_t)32 * K);
  rb2 = *(const uint4*)(Bp + (size_t)64 * K);
  rb3 = *(const uint4*)(Bp + (size_t)96 * K);
  f32x16 acc[2][2];
#pragma unroll
  for (int i = 0; i < 2; ++i)
#pragma unroll
    for (int j = 0; j < 2; ++j)
#pragma unroll
      for (int r = 0; r < 16; ++r) acc[i][j][r] = 0.f;
  const int nk = K / 64;
  for (int kt = 0; kt < nk; ++kt) {
    __syncthreads();
    *(uint4*)(sA + (lr + 0) * 72 + lc) = ra0;
    *(uint4*)(sA + (lr + 32) * 72 + lc) = ra1;
    *(uint4*)(sA + (lr + 64) * 72 + lc) = ra2;
    *(uint4*)(sA + (lr + 96) * 72 + lc) = ra3;
    *(uint4*)(sB + (lr + 0) * 72 + lc) = rb0;
    *(uint4*)(sB + (lr + 32) * 72 + lc) = rb1;
    *(uint4*)(sB + (lr + 64) * 72 + lc) = rb2;
    *(uint4*)(sB + (lr + 96) * 72 + lc) = rb3;
    __syncthreads();
    if (kt + 1 < nk) {
      Ap += 64;
      Bp += 64;
      ra0 = *(const uint4*)(Ap);
      ra1 = *(const uint4*)(Ap + (size_t)32 * lda);
      ra2 = *(const uint4*)(Ap + (size_t)64 * lda);
      ra3 = *(const uint4*)(Ap + (size_t)96 * lda);
      rb0 = *(const uint4*)(Bp);
      rb1 = *(const uint4*)(Bp + (size_t)32 * K);
      rb2 = *(const uint4*)(Bp + (size_t)64 * K);
      rb3 = *(const uint4*)(Bp + (size_t)96 * K);
    }
#pragma unroll
    for (int ks = 0; ks < 4; ++ks) {
      const int ko = ks * 16 + (lane >> 5) * 8;
      bf16x8 a0 = *(const bf16x8*)(sA + (wm * 64 + (lane & 31)) * 72 + ko);
      bf16x8 a1 = *(const bf16x8*)(sA + (wm * 64 + 32 + (lane & 31)) * 72 + ko);
      bf16x8 b0 = *(const bf16x8*)(sB + (wn * 64 + (lane & 31)) * 72 + ko);
      bf16x8 b1 = *(const bf16x8*)(sB + (wn * 64 + 32 + (lane & 31)) * 72 + ko);
      acc[0][0] = __builtin_amdgcn_mfma_f32_32x32x16_bf16(a0, b0, acc[0][0], 0, 0, 0);
      acc[0][1] = __builtin_amdgcn_mfma_f32_32x32x16_bf16(a0, b1, acc[0][1], 0, 0, 0);
      acc[1][0] = __builtin_amdgcn_mfma_f32_32x32x16_bf16(a1, b0, acc[1][0], 0, 0, 0);
      acc[1][1] = __builtin_amdgcn_mfma_f32_32x32x16_bf16(a1, b1, acc[1][1], 0, 0, 0);
    }
  }
  const int ci = lane & 31;
  const int rbase = m0 + wm * 64 + 4 * (lane >> 5);
  const int cbase = n0 + wn * 64;
  if (EPI == EPI_P) {
    bf16_t* P = (bf16_t*)(p.ws + OFF_P);
    float* AB = (float*)(p.ws + OFF_AB);
#pragma unroll
    for (int mt = 0; mt < 2; ++mt)
#pragma unroll
      for (int nt = 0; nt < 2; ++nt)
#pragma unroll
        for (int r = 0; r < 16; ++r) {
          int row = rbase + mt * 32 + (r & 3) + 8 * (r >> 2);
          int col = cbase + nt * 32 + ci;
          float v = acc[mt][nt][r];
          P[(size_t)row * INWP + col] = f2bf(v);
          if (col >= C_DA && col < C_DA + 16) AB[(size_t)row * 16 + col - C_DA] = v;
        }
  } else if (EPI == EPI_QUP) {
    bf16_t* QH = (bf16_t*)(p.ws + OFF_QH);
    const float* rc = (const float*)(p.ws + OFF_ROPE);
    const float* rsn = rc + 2048 * 16;
#pragma unroll
    for (int mt = 0; mt < 2; ++mt)
#pragma unroll
      for (int nt = 0; nt < 2; ++nt) {
        const int base = cbase + nt * 32;
        const bool rope = ((base % 96) == 64) && (m0 < M_LAT);
#pragma unroll
        for (int r = 0; r < 16; ++r) {
          int row = rbase + mt * 32 + (r & 3) + 8 * (r >> 2);
          float v = acc[mt][nt][r] * rsv[row - m0];
          float o = __shfl_xor(v, 8);
          if (rope) {
            int t = row & 2047;
            int a = ci >> 4, hf = (ci >> 3) & 1, j = ci & 7;
            float c = rc[t * 16 + a * 8 + j], s = rsn[t * 16 + a * 8 + j];
            v = hf ? (o * s + v * c) : (v * c - o * s);
          }
          QH[(size_t)row * 384 + base + ci] = f2bf(v);
        }
      }
  } else if (EPI == EPI_KVUP) {
    bf16_t* KH = (bf16_t*)(p.ws + OFF_KH);
    bf16_t* VH = (bf16_t*)(p.ws + OFF_VH);
#pragma unroll
    for (int mt = 0; mt < 2; ++mt)
#pragma unroll
      for (int nt = 0; nt < 2; ++nt) {
        const int base = cbase + nt * 32;
        const int h = base >> 7, cc = (base & 127) + ci;
#pragma unroll
        for (int r = 0; r < 16; ++r) {
          int row = rbase + mt * 32 + (r & 3) + 8 * (r >> 2);
          float v = acc[mt][nt][r] * rsv[row - m0];
          if (cc < 64)
            KH[(size_t)row * 384 + h * 96 + cc] = f2bf(v);
          else
            VH[(size_t)row * 256 + h * 64 + cc - 64] = f2bf(v);
        }
      }
  } else if (EPI == EPI_RES) {
    float* X = (float*)(p.ws + OFF_X);
    const float* modl = (const float*)(p.ws + OFF_MOD) + (size_t)l * 9 * 6144 + gate_i * 1024;
#pragma unroll
    for (int mt = 0; mt < 2; ++mt)
#pragma unroll
      for (int nt = 0; nt < 2; ++nt)
#pragma unroll
        for (int r = 0; r < 16; ++r) {
          int row = rbase + mt * 32 + (r & 3) + 8 * (r >> 2);
          int col = cbase + nt * 32 + ci;
          int b = row < M_LAT ? (row >> 11) : 8;
          float g = modl[b * 6144 + col];
          size_t idx = (size_t)row * 1024 + col;
          X[idx] = X[idx] + g * acc[mt][nt][r];
        }
  } else if (EPI == EPI_GU) {
    bf16_t* ACT = (bf16_t*)(p.ws + OFF_P);
#pragma unroll
    for (int mt = 0; mt < 2; ++mt)
#pragma unroll
      for (int r = 0; r < 16; ++r) {
        int row = rbase + mt * 32 + (r & 3) + 8 * (r >> 2);
        float gt = acc[mt][0][r], up = acc[mt][1][r];
        float a = silu_f(gt) * up;
        ACT[(size_t)row * FFN + (cbase >> 6) * 32 + ci] = f2bf(a);
      }
  }
}

__device__ void kpe_item(const Params& p, int it) {
  const int tid = otid();
  const bf16_t* P = (const bf16_t*)(p.ws + OFF_P);
  bf16_t* KH = (bf16_t*)(p.ws + OFF_KH);
  const float* rc = (const float*)(p.ws + OFF_ROPE);
  const float* rsn = rc + 2048 * 16;
  const int row = it * 8 + (tid >> 5), i = tid & 31;
  float v = bf2f(P[(size_t)row * INWP + C_MPE + i]);
  float o = __shfl_xor(v, 8);
  if (row < M_LAT) {
    int t = row & 2047;
    int a = i >> 4, hf = (i >> 3) & 1, j = i & 7;
    float c = rc[t * 16 + a * 8 + j], s = rsn[t * 16 + a * 8 + j];
    v = hf ? (o * s + v * c) : (v * c - o * s);
  }
  bf16_t bv = f2bf(v);
#pragma unroll
  for (int h = 0; h < 4; ++h) KH[(size_t)row * 384 + h * 96 + 64 + i] = bv;
}

__device__ void dn_prep(const Params& p, int l, int it, char* smem) {
  float* buf = (float*)smem;
  float* nrm = buf + 8 * 1536;
  const int tid = otid();
  const bf16_t* P = (const bf16_t*)(p.ws + OFF_P);
  bf16_t* DQ = (bf16_t*)(p.ws + OFF_DNQKV);
  const int r0 = it * 8;
  int seq_lo, seq_hi;
  if (r0 < M_LAT) {
    seq_lo = (r0 >> 11) << 11;
    seq_hi = seq_lo + 2048;
  } else {
    int rr = r0 - M_LAT;
    seq_lo = M_LAT + ((rr >> 8) << 8);
    seq_hi = seq_lo + 256;
  }
  const float* cw = p.conv_w + (size_t)l * 5 * 1536;
  __syncthreads();
  for (int c6 = 0; c6 < 6; ++c6) {
    const int ch = c6 * 256 + tid;
    float w0 = cw[ch], w1 = cw[1536 + ch], w2 = cw[2 * 1536 + ch], w3 = cw[3 * 1536 + ch], w4 = cw[4 * 1536 + ch];
    float xw[12];
#pragma unroll
    for (int j = 0; j < 12; ++j) {
      int r = r0 - 2 + j;
      xw[j] = (r >= seq_lo && r < seq_hi) ? bf2f(P[(size_t)r * INWP + C_DN + ch]) : 0.f;
    }
#pragma unroll
    for (int j = 0; j < 8; ++j) {
      float y = w0 * xw[j] + w1 * xw[j + 1] + w2 * xw[j + 2] + w3 * xw[j + 3] + w4 * xw[j + 4];
      buf[j * 1536 + ch] = silu_f(y);
    }
  }
  __syncthreads();
  {
    int vec = tid >> 2, part = tid & 3;
    int rr = vec >> 3, hv = vec & 7;
    const float* v = buf + rr * 1536 + hv * 128 + part * 32;
    float ss = 0.f;
#pragma unroll
    for (int i = 0; i < 32; ++i) ss += v[i] * v[i];
    ss += __shfl_xor(ss, 1);
    ss += __shfl_xor(ss, 2);
    if (part == 0) nrm[vec] = rsqrtf(ss + 1e-6f);
  }
  __syncthreads();
  for (int i = tid; i < 8 * 1536; i += 256) {
    int rr = i / 1536, ch = i - rr * 1536;
    float v = buf[i];
    if (ch < 1024) v *= nrm[rr * 8 + (ch >> 7)];
    DQ[(size_t)(r0 + rr) * 1536 + ch] = f2bf(v);
  }
}

__device__ void phaseC(const Params& p, int l, char* smem) {
  const int nb = gridDim.x, bid = blockIdx.x;
  const bf16_t* P = (const bf16_t*)(p.ws + OFF_P);
  constexpr int T0 = 144 * 3, T1 = T0 + 144 * 4, T2 = T1 + M_ALL / 8, T3 = T2 + M_ALL / 8;
  for (int it = bid; it < T3; it += nb) {
    if (it < T0) {
      int i = it;
      gemm_tile<EPI_QUP>(p, l, P + C_MQ, INWP, (const bf16_t*)(p.ws + OFF_WQUP), 256, (i / 3) * 128, (i % 3) * 128, 0,
                         smem);
    } else if (it < T1) {
      int i = it - T0;
      gemm_tile<EPI_KVUP>(p, l, P + C_MKV, INWP, (const bf16_t*)(p.ws + OFF_WKVUP), 128, (i / 4) * 128, (i % 4) * 128,
                          0, smem);
    } else if (it < T2) {
      kpe_item(p, it - T1);
    } else {
      dn_prep(p, l, it - T2, smem);
    }
  }
}

__device__ void mla_naive(const Params& p, int ti) {
  const int h = otid() >> 6, lane = otid() & 63;
  const int row = ti * 64 + lane;
  const bf16_t* QH = (const bf16_t*)(p.ws + OFF_QH);
  const bf16_t* KH = (const bf16_t*)(p.ws + OFF_KH);
  const bf16_t* VH = (const bf16_t*)(p.ws + OFF_VH);
  bf16_t* MIX = (bf16_t*)(p.ws + OFF_HM);
  uint4 qp[12];
  float acc[64];
  {
    const uint4* qg = (const uint4*)(QH + (size_t)row * 384 + h * 96);
#pragma unroll
    for (int c = 0; c < 12; ++c) qp[c] = qg[c];
  }
#pragma unroll
  for (int i = 0; i < 64; ++i) acc[i] = 0.f;
  const bool lat = ti < 256;
  const int b = lat ? (ti >> 5) : ((ti - 256) >> 2);
  const int total = lat ? 2304 : 256;
  float m = -INFINITY, ls = 0.f;
  const float scale = 0.10206207261596577f;
  for (int j = 0; j < total; ++j) {
    const int krow = j < 256 ? (M_LAT + b * 256 + j) : (b * 2048 + j - 256);
    const uint4* kp = (const uint4*)(KH + (size_t)krow * 384 + h * 96);
    float s = 0.f;
#pragma unroll
    for (int c = 0; c < 12; ++c) {
      uint4 u = kp[c];
      uint4 q = qp[c];
      s += bflo(q.x) * bflo(u.x) + bfhi(q.x) * bfhi(u.x) + bflo(q.y) * bflo(u.y) + bfhi(q.y) * bfhi(u.y) +
           bflo(q.z) * bflo(u.z) + bfhi(q.z) * bfhi(u.z) + bflo(q.w) * bflo(u.w) + bfhi(q.w) * bfhi(u.w);
    }
    s *= scale;
    float mn = fmaxf(m, s);
    float corr = __expf(m - mn), pe = __expf(s - mn);
    ls = ls * corr + pe;
    m = mn;
    const uint4* vp = (const uint4*)(VH + (size_t)krow * 256 + h * 64);
#pragma unroll
    for (int c = 0; c < 8; ++c) {
      uint4 u = vp[c];
      acc[c * 8 + 0] = acc[c * 8 + 0] * corr + pe * bflo(u.x);
      acc[c * 8 + 1] = acc[c * 8 + 1] * corr + pe * bfhi(u.x);
      acc[c * 8 + 2] = acc[c * 8 + 2] * corr + pe * bflo(u.y);
      acc[c * 8 + 3] = acc[c * 8 + 3] * corr + pe * bfhi(u.y);
      acc[c * 8 + 4] = acc[c * 8 + 4] * corr + pe * bflo(u.z);
      acc[c * 8 + 5] = acc[c * 8 + 5] * corr + pe * bfhi(u.z);
      acc[c * 8 + 6] = acc[c * 8 + 6] * corr + pe * bflo(u.w);
      acc[c * 8 + 7] = acc[c * 8 + 7] * corr + pe * bfhi(u.w);
    }
  }
  const float inv = 1.f / ls;
  uint4* op = (uint4*)(MIX + (size_t)row * 1024 + h * 64);
#pragma unroll
  for (int c = 0; c < 8; ++c) {
    uint4 u;
    u.x = pack2(acc[c * 8 + 0] * inv, acc[c * 8 + 1] * inv);
    u.y = pack2(acc[c * 8 + 2] * inv, acc[c * 8 + 3] * inv);
    u.z = pack2(acc[c * 8 + 4] * inv, acc[c * 8 + 5] * inv);
    u.w = pack2(acc[c * 8 + 6] * inv, acc[c * 8 + 7] * inv);
    op[c] = u;
  }
}

__device__ void na_naive(const Params& p, int l, int ti) {
  const int h = otid() >> 6, lane = otid() & 63;
  const bf16_t* P = (const bf16_t*)(p.ws + OFF_P);
  bf16_t* MIX = (bf16_t*)(p.ws + OFF_HM);
  const bool lat = ti < 256;
  const int b = lat ? (ti >> 5) : ((ti - 256) >> 2);
  const int r = ti & 31;
  const int row = lat ? (ti * 64 + lane) : (M_LAT + (ti - 256) * 64 + lane);
  float q[64], acc[64];
  {
    const uint4* qp = (const uint4*)(P + (size_t)row * INWP + C_NQ + h * 64);
#pragma unroll
    for (int c = 0; c < 8; ++c) {
      uint4 u = qp[c];
      q[c * 8 + 0] = bflo(u.x); q[c * 8 + 1] = bfhi(u.x); q[c * 8 + 2] = bflo(u.y); q[c * 8 + 3] = bfhi(u.y);
      q[c * 8 + 4] = bflo(u.z); q[c * 8 + 5] = bfhi(u.z); q[c * 8 + 6] = bflo(u.w); q[c * 8 + 7] = bfhi(u.w);
    }
  }
#pragma unroll
  for (int i = 0; i < 64; ++i) acc[i] = 0.f;
  float m = -INFINITY, ls = 0.f;
  const int qc = lane;
  const int rs0 = min(max(r - 4, 0), 24);
  const int cs0 = min(max(qc - 8, 0), 48);
  const float* rb = p.rel_bias + (size_t)l * 4 * 15 * 31 + h * 15 * 31;
  const int nloc = lat ? 128 : 0;
  for (int j = 0; j < nloc + 256; ++j) {
    int krow;
    float bias = 0.f;
    if (j < nloc) {
      int kr = rs0 + (j >> 4), kc = cs0 + (j & 15);
      krow = b * 2048 + kr * 64 + kc;
      bias = rb[(kr - r + 7) * 31 + (kc - qc + 15)];
    } else {
      krow = M_LAT + b * 256 + (j - nloc);
    }
    const uint4* kp = (const uint4*)(P + (size_t)krow * INWP + C_NK + h * 64);
    float s = 0.f;
#pragma unroll
    for (int c = 0; c < 8; ++c) {
      uint4 u = kp[c];
      s += q[c * 8 + 0] * bflo(u.x) + q[c * 8 + 1] * bfhi(u.x) + q[c * 8 + 2] * bflo(u.y) + q[c * 8 + 3] * bfhi(u.y) +
           q[c * 8 + 4] * bflo(u.z) + q[c * 8 + 5] * bfhi(u.z) + q[c * 8 + 6] * bflo(u.w) + q[c * 8 + 7] * bfhi(u.w);
    }
    s = s * 0.125f + bias;
    float mn = fmaxf(m, s);
    float corr = __expf(m - mn), pe = __expf(s - mn);
    ls = ls * corr + pe;
    m = mn;
    const uint4* vp = (const uint4*)(P + (size_t)krow * INWP + C_NV + h * 64);
#pragma unroll
    for (int c = 0; c < 8; ++c) {
      uint4 u = vp[c];
      acc[c * 8 + 0] = acc[c * 8 + 0] * corr + pe * bflo(u.x);
      acc[c * 8 + 1] = acc[c * 8 + 1] * corr + pe * bfhi(u.x);
      acc[c * 8 + 2] = acc[c * 8 + 2] * corr + pe * bflo(u.y);
      acc[c * 8 + 3] = acc[c * 8 + 3] * corr + pe * bfhi(u.y);
      acc[c * 8 + 4] = acc[c * 8 + 4] * corr + pe * bflo(u.z);
      acc[c * 8 + 5] = acc[c * 8 + 5] * corr + pe * bfhi(u.z);
      acc[c * 8 + 6] = acc[c * 8 + 6] * corr + pe * bflo(u.w);
      acc[c * 8 + 7] = acc[c * 8 + 7] * corr + pe * bfhi(u.w);
    }
  }
  const float inv = 1.f / ls;
  uint4* op = (uint4*)(MIX + (size_t)row * 1024 + 256 + h * 64);
#pragma unroll
  for (int c = 0; c < 8; ++c) {
    uint4 u;
    u.x = pack2(acc[c * 8 + 0] * inv, acc[c * 8 + 1] * inv);
    u.y = pack2(acc[c * 8 + 2] * inv, acc[c * 8 + 3] * inv);
    u.z = pack2(acc[c * 8 + 4] * inv, acc[c * 8 + 5] * inv);
    u.w = pack2(acc[c * 8 + 6] * inv, acc[c * 8 + 7] * inv);
    op[c] = u;
  }
}

DEVI int dn_rowof(int s, int b, int d) {
  if (s < 256) {
    int c = d ? (255 - s) : s;
    return M_LAT + b * 256 + c;
  }
  int t = s - 256;
  t = d ? (2047 - t) : t;
  return b * 2048 + t;
}

__device__ void dn_naive(const Params& p, int l, int it, char* smem) {
  float* ks = (float*)smem;
  float* qs = ks + 32 * 128;
  float* vs = qs + 32 * 128;
  float* gs = vs + 32 * 64;
  float* bs = gs + 32;
  const int half = it & 1, d = (it >> 1) & 1, h = (it >> 2) & 3, b = it >> 4;
  const int tid = otid(), w = tid >> 6, lane = tid & 63, c = lane & 15, kg = lane >> 4;
  const int col = half * 64 + w * 16 + c;
  const bf16_t* DQ = (const bf16_t*)(p.ws + OFF_DNQKV);
  const float* AB = (const float*)(p.ws + OFF_AB);
  bf16_t* MIX = (bf16_t*)(p.ws + OFF_HM);
  bf16_t* OB = (bf16_t*)(p.ws + OFF_OB);
  float S[32];
#pragma unroll
  for (int i = 0; i < 32; ++i) S[i] = 0.f;
  const float Aneg = -__expf(p.a_log[l * 8 + d * 4 + h]);
  const float dtb = p.dt_bias[l * 8 + d * 4 + h];
  for (int s0 = 0; s0 < 2304; s0 += 32) {
    __syncthreads();
    for (int i = tid; i < 32 * 128; i += 256) {
      int tk = i >> 7, ch = i & 127;
      int row = dn_rowof(s0 + tk, b, d);
      qs[i] = bf2f(DQ[(size_t)row * 1536 + h * 128 + ch]);
      ks[i] = bf2f(DQ[(size_t)row * 1536 + 512 + h * 128 + ch]);
    }
    for (int i = tid; i < 32 * 64; i += 256) {
      int tk = i >> 6, ch = i & 63;
      int row = dn_rowof(s0 + tk, b, d);
      vs[i] = bf2f(DQ[(size_t)row * 1536 + 1024 + h * 128 + half * 64 + ch]);
    }
    if (tid < 32) {
      int row = dn_rowof(s0 + tid, b, d);
      float a = AB[(size_t)row * 16 + d * 4 + h];
      float bb = AB[(size_t)row * 16 + 8 + d * 4 + h];
      float xx = a + dtb;
      float sp = xx > 20.f ? xx : log1pf(__expf(xx));
      gs[tid] = __expf(Aneg * sp);
      bs[tid] = 1.f / (1.f + __expf(-bb));
    }
    __syncthreads();
    for (int tk = 0; tk < 32; ++tk) {
      const float eg = gs[tk], beta = bs[tk];
      const float vv = vs[tk * 64 + w * 16 + c];
      const float4* k4 = (const float4*)(ks + tk * 128 + kg * 32);
      const float4* q4 = (const float4*)(qs + tk * 128 + kg * 32);
      float part = 0.f;
#pragma unroll
      for (int i = 0; i < 8; ++i) {
        float4 kk = k4[i];
        S[4 * i + 0] *= eg; S[4 * i + 1] *= eg; S[4 * i + 2] *= eg; S[4 * i + 3] *= eg;
        part += kk.x * S[4 * i + 0] + kk.y * S[4 * i + 1] + kk.z * S[4 * i + 2] + kk.w * S[4 * i + 3];
      }
      part += __shfl_xor(part, 16);
      part += __shfl_xor(part, 32);
      const float delta = beta * (vv - part);
      float po = 0.f;
#pragma unroll
      for (int i = 0; i < 8; ++i) {
        float4 kk = k4[i];
        float4 qq = q4[i];
        S[4 * i + 0] += kk.x * delta; S[4 * i + 1] += kk.y * delta; S[4 * i + 2] += kk.z * delta; S[4 * i + 3] += kk.w * delta;
        po += qq.x * S[4 * i + 0] + qq.y * S[4 * i + 1] + qq.z * S[4 * i + 2] + qq.w * S[4 * i + 3];
      }
      po += __shfl_xor(po, 16);
      po += __shfl_xor(po, 32);
      if (kg == 0) {
        int row = dn_rowof(s0 + tk, b, d);
        float o = po * 0.08838834764831845f;
        if (d == 0)
          MIX[(size_t)row * 1024 + 512 + h * 128 + col] = f2bf(o);
        else
          OB[(size_t)row * 512 + h * 128 + col] = f2bf(o);
      }
    }
  }
}

__device__ void phaseD(const Params& p, int l, char* smem) {
  const int nb = gridDim.x, bid = blockIdx.x;
  constexpr int T0 = 128, T1 = T0 + 288, T2 = T1 + 288;
  for (int it = bid; it < T2; it += nb) {
    if (it < T0)
      dn_naive(p, l, it, smem);
    else if (it < T1)
      mla_naive(p, it - T0);
    else
      na_naive(p, l, it - T1);
  }
}

__device__ void outgate_item(const Params& p, int l, int item) {
  const int w = otid() >> 6, lane = otid() & 63;
  const int row = item * 4 + w;
  const bf16_t* P = (const bf16_t*)(p.ws + OFF_P);
  bf16_t* MIX = (bf16_t*)(p.ws + OFF_HM);
  const bf16_t* OB = (const bf16_t*)(p.ws + OFF_OB);
  const int h = lane >> 4, cb = (lane & 15) * 8;
  uint4 uo = *(const uint4*)(MIX + (size_t)row * 1024 + 512 + h * 128 + cb);
  uint4 ub = *(const uint4*)(OB + (size_t)row * 512 + h * 128 + cb);
  uint4 uz = *(const uint4*)(P + (size_t)row * INWP + C_DZ + h * 128 + cb);
  float o[8], z[8];
  o[0] = bflo(uo.x) + bflo(ub.x); o[1] = bfhi(uo.x) + bfhi(ub.x); o[2] = bflo(uo.y) + bflo(ub.y); o[3] = bfhi(uo.y) + bfhi(ub.y);
  o[4] = bflo(uo.z) + bflo(ub.z); o[5] = bfhi(uo.z) + bfhi(ub.z); o[6] = bflo(uo.w) + bflo(ub.w); o[7] = bfhi(uo.w) + bfhi(ub.w);
  z[0] = bflo(uz.x); z[1] = bfhi(uz.x); z[2] = bflo(uz.y); z[3] = bfhi(uz.y);
  z[4] = bflo(uz.z); z[5] = bfhi(uz.z); z[6] = bflo(uz.w); z[7] = bfhi(uz.w);
  float ss = 0.f;
#pragma unroll
  for (int e = 0; e < 8; ++e) ss += o[e] * o[e];
  ss += __shfl_xor(ss, 1);
  ss += __shfl_xor(ss, 2);
  ss += __shfl_xor(ss, 4);
  ss += __shfl_xor(ss, 8);
  const float r = rsqrtf(ss * (1.f / 128.f) + 1e-6f);
  const float* go = p.g_out + l * 128 + cb;
  float y[8];
#pragma unroll
  for (int e = 0; e < 8; ++e) y[e] = o[e] * r * go[e] * silu_f(z[e]);
  uint4 u;
  u.x = pack2(y[0], y[1]); u.y = pack2(y[2], y[3]); u.z = pack2(y[4], y[5]); u.w = pack2(y[6], y[7]);
  *(uint4*)(MIX + (size_t)row * 1024 + 512 + h * 128 + cb) = u;
}

__device__ void final_item(const Params& p, int item) {
  const int w = otid() >> 6, lane = otid() & 63;
  const int row = item * 4 + w;
  const float4* xr = (const float4*)((const float*)(p.ws + OFF_X) + (size_t)row * 1024);
  float4 v[4];
  float ss = 0.f;
#pragma unroll
  for (int i = 0; i < 4; ++i) {
    v[i] = xr[lane + 64 * i];
    ss += v[i].x * v[i].x + v[i].y * v[i].y + v[i].z * v[i].z + v[i].w * v[i].w;
  }
  ss = wave_sum(ss);
  const float r = rsqrtf(ss * (1.f / 1024.f) + 1e-6f);
  const float4* g4 = (const float4*)p.g_final;
  float4* o4 = (float4*)(p.out + (size_t)row * 1024);
#pragma unroll
  for (int i = 0; i < 4; ++i) {
    float4 gg = g4[lane + 64 * i];
    float4 y;
    y.x = v[i].x * r * gg.x; y.y = v[i].y * r * gg.y; y.z = v[i].z * r * gg.z; y.w = v[i].w * r * gg.w;
    o4[lane + 64 * i] = y;
  }
}

constexpr int N_PHASES = 1 + 9 * 4 + 1;

__global__ void __launch_bounds__(256, 2) mega(Params p) {
  __shared__ __attribute__((aligned(16))) char smem[50176];
  cg::grid_group grid = cg::this_grid();
  const int nb = gridDim.x, bid = blockIdx.x;
  for (int ph = p.ph_lo; ph < p.ph_hi; ++ph) {
    if (ph == 0) {
      phase0(p, smem);
    } else if (ph == N_PHASES - 1) {
      for (int it = bid; it < M_LAT / 4; it += nb) final_item(p, it);
    } else {
      const int l = (ph - 1) / 9, s = (ph - 1) % 9;
      if (s == 0) {
        phaseA(p, l, smem);
      } else if (s == 1) {
        for (int it = bid; it < 144 * 26; it += nb)
          gemm_tile<EPI_P>(p, l, (const bf16_t*)(p.ws + OFF_HM), 1024, (const bf16_t*)(p.ws + OFF_WIN), 1024,
                           (it / 26) * 128, (it % 26) * 128, 0, smem);
      } else if (s == 2) {
        phaseC(p, l, smem);
      } else if (s == 3) {
        phaseD(p, l, smem);
      } else if (s == 4) {
        for (int it = bid; it < M_ALL / 4; it += nb) outgate_item(p, l, it);
      } else if (s == 5) {
        for (int it = bid; it < 144 * 8; it += nb)
          gemm_tile<EPI_RES>(p, l, (const bf16_t*)(p.ws + OFF_HM), 1024, (const bf16_t*)(p.ws + OFF_WOUT), 1024,
                             (it / 8) * 128, (it % 8) * 128, 2, smem);
      } else if (s == 6) {
        for (int it = bid; it < M_ALL / 4; it += nb)
          norm_rows((const float*)(p.ws + OFF_X), (bf16_t*)(p.ws + OFF_HM), p.g_ffn + l * 1024,
                    (const float*)(p.ws + OFF_MOD) + (size_t)l * 9 * 6144, 3, 4, it);
      } else if (s == 7) {
        for (int it = bid; it < 144 * 44; it += nb)
          gemm_tile<EPI_GU>(p, l, (const bf16_t*)(p.ws + OFF_HM), 1024, (const bf16_t*)(p.ws + OFF_WGU), 1024,
                            (it / 44) * 128, (it % 44) * 128, 0, smem);
      } else {
        for (int it = bid; it < 144 * 8; it += nb)
          gemm_tile<EPI_RES>(p, l, (const bf16_t*)(p.ws + OFF_P), FFN, (const bf16_t*)(p.ws + OFF_WDN), FFN,
                             (it / 8) * 128, (it % 8) * 128, 5, smem);
      }
    }
    if (ph + 1 < p.ph_hi) grid.sync();
  }
}

extern "C" void kernel_launch(void* const* d_in, const int* in_sizes, int n_in, void* d_out, int out_size, void* d_ws,
                              size_t ws_size, hipStream_t stream) {
  static int grid_blocks = 0;
  if (!grid_blocks) {
    int dev = 0, cus = 0, per_cu = 0;
    hipGetDevice(&dev);
    hipDeviceGetAttribute(&cus, hipDeviceAttributeMultiprocessorCount, dev);
    hipOccupancyMaxActiveBlocksPerMultiprocessor(&per_cu, mega, 256, 0);
    if (per_cu < 1) per_cu = 1;
    if (per_cu > 2) per_cu = 2;
    grid_blocks = cus * per_cu;
  }
  Params p{};
  const float** pp = (const float**)&p;
  for (int i = 0; i < 23; ++i) pp[i] = (const float*)d_in[i];
  p.out = (float*)d_out;
  p.ws = (char*)d_ws;
  p.ph_lo = 0;
  p.ph_hi = N_PHASES;
  void* args[] = {&p};
  hipError_t e = hipLaunchCooperativeKernel((void*)mega, dim3(grid_blocks), dim3(256), args, 0, stream);
  if (e != hipSuccess) {
    fprintf(stderr, "cooperative launch failed: %s (grid %d)\n", hipGetErrorString(e), grid_blocks);
    (void)hipGetLastError();
    for (int ph = 0; ph < N_PHASES; ++ph) {
      p.ph_lo = ph;
      p.ph_hi = ph + 1;
      hipLaunchKernelGGL(mega, dim3(grid_blocks), dim3(256), 0, stream, p);
    }
  }
}
```

```cpp
#include <hip/hip_runtime.h>
#include <hip/hip_bf16.h>
#include <hip/hip_cooperative_groups.h>
#include <cstdio>
namespace cg = cooperative_groups;

#define DEVI __device__ __forceinline__
typedef unsigned short bf16_t;
typedef short bf16x8 __attribute__((ext_vector_type(8)));
typedef float f32x16 __attribute__((ext_vector_type(16)));

constexpr int M_LAT = 16384, M_CTX = 2048, M_ALL = 18432;
constexpr int DM = 1024, INW = 3248, INWP = 3328, FFN = 2816;
constexpr int C_MQ = 0, C_MKV = 256, C_MPE = 384, C_NQ = 416, C_NK = 672, C_NV = 928, C_DN = 1184;
constexpr int C_DZ = C_DN + 1536, C_DA = C_DN + 2048;

constexpr size_t OFF_WIN = 0;
constexpr size_t OFF_WOUT = OFF_WIN + (size_t)INWP * 1024 * 2;
constexpr size_t OFF_WGU = OFF_WOUT + (size_t)1024 * 1024 * 2;
constexpr size_t OFF_WDN = OFF_WGU + (size_t)2 * FFN * 1024 * 2;
constexpr size_t OFF_WQUP = OFF_WDN + (size_t)1024 * FFN * 2;
constexpr size_t OFF_WKVUP = OFF_WQUP + (size_t)384 * 256 * 2;
constexpr size_t OFF_MOD = OFF_WKVUP + (size_t)512 * 128 * 2;
constexpr size_t OFF_ROPE = OFF_MOD + (size_t)4 * 9 * 6144 * 4;
constexpr size_t OFF_X = OFF_ROPE + (size_t)2048 * 16 * 2 * 4;
constexpr size_t OFF_HM = OFF_X + (size_t)M_ALL * 1024 * 4;
constexpr size_t OFF_P = OFF_HM + (size_t)M_ALL * 1024 * 2;
constexpr size_t OFF_QH = OFF_P + (size_t)M_ALL * INWP * 2;
constexpr size_t OFF_KH = OFF_QH + (size_t)M_ALL * 384 * 2;
constexpr size_t OFF_VH = OFF_KH + (size_t)M_ALL * 384 * 2;
constexpr size_t OFF_DNQKV = OFF_VH + (size_t)M_ALL * 256 * 2;
constexpr size_t OFF_OB = OFF_DNQKV + (size_t)M_ALL * 1536 * 2;
constexpr size_t OFF_AB = OFF_OB + (size_t)M_ALL * 512 * 2;
constexpr size_t WS_TOTAL = OFF_AB + (size_t)M_ALL * 16 * 4;

struct Params {
  const float *x, *c, *ctx, *c_ctx, *w_ada, *b_ada, *g_mix, *w_in, *g_q, *g_kv, *w_qup, *w_kvup, *rel_bias,
      *conv_w, *a_log, *dt_bias, *g_out, *w_out, *g_ffn, *w_gate, *w_up, *w_down, *g_final;
  float* out;
  char* ws;
  int ph_lo, ph_hi;
};

DEVI bf16_t f2bf(float f) {
  unsigned u = __float_as_uint(f);
  u += 0x7fffu + ((u >> 16) & 1u);
  return (bf16_t)(u >> 16);
}
DEVI int otid() {
  int t = threadIdx.x;
  asm volatile("" : "+v"(t));
  return t;
}
DEVI float bf2f(bf16_t h) { return __uint_as_float(((unsigned)h) << 16); }
DEVI float bflo(unsigned u) { return __uint_as_float(u << 16); }
DEVI float bfhi(unsigned u) { return __uint_as_float(u & 0xffff0000u); }
DEVI unsigned pack2(float a, float b) { return (unsigned)f2bf(a) | ((unsigned)f2bf(b) << 16); }
DEVI float silu_f(float x) { return x / (1.f + __expf(-x)); }
DEVI float wave_sum(float v) {
#pragma unroll
  for (int o = 32; o >= 1; o >>= 1) v += __shfl_xor(v, o);
  return v;
}

__device__ void phase0(const Params& p, char* smem) {
  const int tid = otid(), nb = gridDim.x, bid = blockIdx.x;
  {
    float4* X4 = (float4*)(p.ws + OFF_X);
    const float4* x4 = (const float4*)p.x;
    const float4* c4 = (const float4*)p.ctx;
    const size_t n1 = (size_t)M_LAT * 256, n2 = (size_t)M_CTX * 256;
    for (size_t i = (size_t)bid * 256 + tid; i < n1 + n2; i += (size_t)nb * 256) X4[i] = i < n1 ? x4[i] : c4[i - n1];
  }
  {
    float* rc = (float*)(p.ws + OFF_ROPE);
    float* rs = rc + 2048 * 16;
    for (int i = bid * 256 + tid; i < 2048 * 16; i += nb * 256) {
      int t = i >> 4, a = (i >> 3) & 1, j = i & 7;
      float pos = a ? (float)(t & 63) : (float)(t >> 6);
      float inv = powf(10000.f, -(float)j / 8.f);
      float ang = pos * inv;
      rc[i] = cosf(ang);
      rs[i] = sinf(ang);
    }
  }
  float* sc = (float*)smem;
  float* red = sc + 9 * 1024;
  float* MOD = (float*)(p.ws + OFF_MOD);
  bool loaded = false;
  for (int it = bid; it < 4 * 96; it += nb) {
    if (!loaded) {
      for (int i = tid; i < 9 * 1024; i += 256) {
        float v = i < 8192 ? p.c[i] : p.c_ctx[i - 8192];
        sc[i] = silu_f(v);
      }
      __syncthreads();
      loaded = true;
    }
    const int l = it / 96, n0 = (it % 96) * 64;
    const int cc = tid & 63, kg = tid >> 6;
    const float* w = p.w_ada + (size_t)l * 1024 * 6144 + n0 + cc;
    float acc[9];
#pragma unroll
    for (int b = 0; b < 9; ++b) acc[b] = 0.f;
    for (int k = kg * 256; k < kg * 256 + 256; ++k) {
      float wv = w[(size_t)k * 6144];
#pragma unroll
      for (int b = 0; b < 9; ++b) acc[b] += sc[b * 1024 + k] * wv;
    }
#pragma unroll
    for (int b = 0; b < 9; ++b) red[(kg * 9 + b) * 64 + cc] = acc[b];
    __syncthreads();
    for (int i = tid; i < 9 * 64; i += 256) {
      int b = i >> 6, c2 = i & 63;
      float s = red[(0 * 9 + b) * 64 + c2] + red[(1 * 9 + b) * 64 + c2] + red[(2 * 9 + b) * 64 + c2] +
                red[(3 * 9 + b) * 64 + c2];
      MOD[(size_t)(l * 9 + b) * 6144 + n0 + c2] = s + p.b_ada[l * 6144 + n0 + c2];
    }
    __syncthreads();
  }
}

__device__ void convT_tile(const float* __restrict__ src, int K, int N, bf16_t* __restrict__ dst, int mode,
                           const float* __restrict__ gs, int kt, int nt, float* tl) {
  const int tid = otid();
  const int k0 = kt * 64, n0 = nt * 64;
  __syncthreads();
#pragma unroll 4
  for (int i = 0; i < 16; ++i) {
    int kk = i * 4 + (tid >> 6), nn = tid & 63;
    float v = 0.f;
    if (n0 + nn < N) v = src[(size_t)(k0 + kk) * N + n0 + nn];
    if (gs) v *= gs[k0 + kk];
    tl[kk * 65 + nn] = v;
  }
  __syncthreads();
#pragma unroll 2
  for (int i = 0; i < 8; ++i) {
    int nn = i * 8 + (tid >> 5), kk = (tid & 31) * 2;
    unsigned pk = pack2(tl[kk * 65 + nn], tl[(kk + 1) * 65 + nn]);
    int n = n0 + nn;
    int drow = mode == 0 ? n : ((n >> 5) * 64 + (n & 31) + (mode == 2 ? 32 : 0));
    *(unsigned*)(dst + (size_t)drow * K + k0 + kk) = pk;
  }
}

__device__ void norm_rows(const float* __restrict__ X, bf16_t* __restrict__ H, const float* __restrict__ g,
                          const float* __restrict__ modl, int shift_i, int scale_i, int item) {
  const int w = otid() >> 6, lane = otid() & 63;
  const int row = item * 4 + w;
  const float4* xr = (const float4*)(X + (size_t)row * 1024);
  float4 v[4];
  float ss = 0.f;
#pragma unroll
  for (int i = 0; i < 4; ++i) {
    v[i] = xr[lane + 64 * i];
    ss += v[i].x * v[i].x + v[i].y * v[i].y + v[i].z * v[i].z + v[i].w * v[i].w;
  }
  ss = wave_sum(ss);
  const float r = rsqrtf(ss * (1.f / 1024.f) + 1e-6f);
  const int b = row < M_LAT ? (row >> 11) : 8;
  const float4* sh = (const float4*)(modl + b * 6144 + shift_i * 1024);
  const float4* sl = (const float4*)(modl + b * 6144 + scale_i * 1024);
  const float4* g4 = (const float4*)g;
#pragma unroll
  for (int i = 0; i < 4; ++i) {
    int c4 = lane + 64 * i;
    float4 gg = g4[c4], s4 = sh[c4], l4 = sl[c4];
    float y0 = v[i].x * r * gg.x * (1.f + l4.x) + s4.x;
    float y1 = v[i].y * r * gg.y * (1.f + l4.y) + s4.y;
    float y2 = v[i].z * r * gg.z * (1.f + l4.z) + s4.z;
    float y3 = v[i].w * r * gg.w * (1.f + l4.w) + s4.w;
    uint2 pk;
    pk.x = pack2(y0, y1);
    pk.y = pack2(y2, y3);
    *(uint2*)(H + (size_t)row * 1024 + c4 * 4) = pk;
  }
}

__device__ void phaseA(const Params& p, int l, char* smem) {
  const int nb = gridDim.x, bid = blockIdx.x;
  float* tl = (float*)smem;
  bf16_t* Win = (bf16_t*)(p.ws + OFF_WIN);
  bf16_t* Wout = (bf16_t*)(p.ws + OFF_WOUT);
  bf16_t* Wgu = (bf16_t*)(p.ws + OFF_WGU);
  bf16_t* Wdn = (bf16_t*)(p.ws + OFF_WDN);
  bf16_t* Wq = (bf16_t*)(p.ws + OFF_WQUP);
  bf16_t* Wkv = (bf16_t*)(p.ws + OFF_WKVUP);
  constexpr int T0 = 16 * 52, T1 = T0 + 256, T2 = T1 + 704, T3 = T2 + 704, T4 = T3 + 704, T5 = T4 + 24, T6 = T5 + 16;
  constexpr int NORM_ITEMS = M_ALL / 4;
  for (int it = bid; it < T6 + NORM_ITEMS; it += nb) {
    if (it < T6) {
      const float* src;
      const float* gs = nullptr;
      bf16_t* dst;
      int K, N, mode = 0, ntn, i;
      if (it < T0) {
        i = it; src = p.w_in + (size_t)l * 1024 * INW; K = 1024; N = INW; dst = Win; ntn = 52;
      } else if (it < T1) {
        i = it - T0; src = p.w_out + (size_t)l * 1024 * 1024; K = 1024; N = 1024; dst = Wout; ntn = 16;
      } else if (it < T2) {
        i = it - T1; src = p.w_gate + (size_t)l * 1024 * FFN; K = 1024; N = FFN; dst = Wgu; ntn = 44; mode = 1;
      } else if (it < T3) {
        i = it - T2; src = p.w_up + (size_t)l * 1024 * FFN; K = 1024; N = FFN; dst = Wgu; ntn = 44; mode = 2;
      } else if (it < T4) {
        i = it - T3; src = p.w_down + (size_t)l * FFN * 1024; K = FFN; N = 1024; dst = Wdn; ntn = 16;
      } else if (it < T5) {
        i = it - T4; src = p.w_qup + (size_t)l * 256 * 384; K = 256; N = 384; dst = Wq; ntn = 6; gs = p.g_q + l * 256;
      } else {
        i = it - T5; src = p.w_kvup + (size_t)l * 128 * 512; K = 128; N = 512; dst = Wkv; ntn = 8; gs = p.g_kv + l * 128;
      }
      convT_tile(src, K, N, dst, mode, gs, i / ntn, i % ntn, tl);
    } else {
      norm_rows((const float*)(p.ws + OFF_X), (bf16_t*)(p.ws + OFF_HM), p.g_mix + l * 1024,
                (const float*)(p.ws + OFF_MOD) + (size_t)l * 9 * 6144, 0, 1, it - T6);
    }
  }
}

enum { EPI_P = 0, EPI_QUP = 1, EPI_KVUP = 2, EPI_RES = 3, EPI_GU = 4 };

template <int EPI>
__device__ void gemm_tile(const Params& p, int l, const bf16_t* __restrict__ A, int lda,
                          const bf16_t* __restrict__ BT, int K, int m0, int n0, int gate_i, char* smem) {
  bf16_t* sA = (bf16_t*)smem;
  bf16_t* sB = sA + 128 * 72;
  float* rsv = (float*)(smem + 2 * 128 * 72 * 2);
  const int tid = otid(), lane = tid & 63, w = tid >> 6, wm = w >> 1, wn = w & 1;
  const int lr = tid >> 3, lc = (tid & 7) * 8;
  __syncthreads();
  if (EPI == EPI_QUP || EPI == EPI_KVUP) {
    const int row = tid >> 1, hf = tid & 1;
    const int n8 = K / 16;
    const uint4* ap = (const uint4*)(A + (size_t)(m0 + row) * lda + hf * (K / 2));
    float ss = 0.f;
    for (int i = 0; i < n8; ++i) {
      uint4 u = ap[i];
      float a0 = bflo(u.x), a1 = bfhi(u.x), a2 = bflo(u.y), a3 = bfhi(u.y), a4 = bflo(u.z), a5 = bfhi(u.z),
            a6 = bflo(u.w), a7 = bfhi(u.w);
      ss += a0 * a0 + a1 * a1 + a2 * a2 + a3 * a3 + a4 * a4 + a5 * a5 + a6 * a6 + a7 * a7;
    }
    ss += __shfl_xor(ss, 1);
    if (hf == 0) rsv[row] = rsqrtf(ss / (float)K + 1e-6f);
  }
  const bf16_t* Ap = A + (size_t)(m0 + lr) * lda + lc;
  const bf16_t* Bp = BT + (size_t)(n0 + lr) * K + lc;
  uint4 ra0, ra1, ra2, ra3, rb0, rb1, rb2, rb3;
  ra0 = *(const uint4*)(Ap);
  ra1 = *(const uint4*)(Ap + (size_t)32 * lda);
  ra2 = *(const uint4*)(Ap + (size_t)64 * lda);
  ra3 = *(const uint4*)(Ap + (size_t)96 * lda);
  rb0 = *(const uint4*)(Bp);
  rb1 = *(const uint4*)(Bp + (size_t)32 * K);
  rb2 = *(const uint4*)(Bp + (size_t)64 * K);
  rb3 = *(const uint4*)(Bp + (size_t)96 * K);
  f32x16 acc[2][2];
#pragma unroll
  for (int i = 0; i < 2; ++i)
#pragma unroll
    for (int j = 0; j < 2; ++j)
#pragma unroll
      for (int r = 0; r < 16; ++r) acc[i][j][r] = 0.f;
  const int nk = K / 64;
  for (int kt = 0; kt < nk; ++kt) {
    __syncthreads();
    *(uint4*)(sA + (lr + 0) * 72 + lc) = ra0;
    *(uint4*)(sA + (lr + 32) * 72 + lc) = ra1;
    *(uint4*)(sA + (lr + 64) * 72 + lc) = ra2;
    *(uint4*)(sA + (lr + 96) * 72 + lc) = ra3;
    *(uint4*)(sB + (lr + 0) * 72 + lc) = rb0;
    *(uint4*)(sB + (lr + 32) * 72 + lc) = rb1;
    *(uint4*)(sB + (lr + 64) * 72 + lc) = rb2;
    *(uint4*)(sB + (lr + 96) * 72 + lc) = rb3;
    __syncthreads();
    if (kt + 1 < nk) {
      Ap += 64;
      Bp += 64;
      ra0 = *(const uint4*)(Ap);
      ra1 = *(const uint4*)(Ap + (size_t)32 * lda);
      ra2 = *(const uint4*)(Ap + (size_t)64 * lda);
      ra3 = *(const uint4*)(Ap + (size_t)96 * lda);
      rb0 = *(const uint4*)(Bp);
      rb1 = *(const uint4*)(Bp + (size_t)32 * K);
      rb2 = *(const uint4*)(Bp + (size_t)64 * K);
      rb3 = *(const uint4*)(Bp + (size_t)96 * K);
    }
#pragma unroll
    for (int ks = 0; ks < 4; ++ks) {
      const int ko = ks * 16 + (lane >> 5) * 8;
      bf16x8 a0 = *(const bf16x8*)(sA + (wm * 64 + (lane & 31)) * 72 + ko);
      bf16x8 a1 = *(const bf16x8*)(sA + (wm * 64 + 32 + (lane & 31)) * 72 + ko);
      bf16x8 b0 = *(const bf16x8*)(sB + (wn * 64 + (lane & 31)) * 72 + ko);
      bf16x8 b1 = *(const bf16x8*)(sB + (wn * 64 + 32 + (lane & 31)) * 72 + ko);
      acc[0][0] = __builtin_amdgcn_mfma_f32_32x32x16_bf16(a0, b0, acc[0][0], 0, 0, 0);
      acc[0][1] = __builtin_amdgcn_mfma_f32_32x32x16_bf16(a0, b1, acc[0][1], 0, 0, 0);
      acc[1][0] = __builtin_amdgcn_mfma_f32_32x32x16_bf16(a1, b0, acc[1][0], 0, 0, 0);
      acc[1][1] = __builtin_amdgcn_mfma_f32_32x32x16_bf16(a1, b1, acc[1][1], 0, 0, 0);
    }
  }
  const int ci = lane & 31;
  const int rbase = m0 + wm * 64 + 4 * (lane >> 5);
  const int cbase = n0 + wn * 64;
  if (EPI == EPI_P) {
    bf16_t* P = (bf16_t*)(p.ws + OFF_P);
    float* AB = (float*)(p.ws + OFF_AB);
#pragma unroll
    for (int mt = 0; mt < 2; ++mt)
#pragma unroll
      for (int nt = 0; nt < 2; ++nt)
#pragma unroll
        for (int r = 0; r < 16; ++r) {
          int row = rbase + mt * 32 + (r & 3) + 8 * (r >> 2);
          int col = cbase + nt * 32 + ci;
          float v = acc[mt][nt][r];
          P[(size_t)row * INWP + col] = f2bf(v);
          if (col >= C_DA && col < C_DA + 16) AB[(size_t)row * 16 + col - C_DA] = v;
        }
  } else if (EPI == EPI_QUP) {
    bf16_t* QH = (bf16_t*)(p.ws + OFF_QH);
    const float* rc = (const float*)(p.ws + OFF_ROPE);
    const float* rsn = rc + 2048 * 16;
#pragma unroll
    for (int mt = 0; mt < 2; ++mt)
#pragma unroll
      for (int nt = 0; nt < 2; ++nt) {
        const int base = cbase + nt * 32;
        const bool rope = ((base % 96) == 64) && (m0 < M_LAT);
#pragma unroll
        for (int r = 0; r < 16; ++r) {
          int row = rbase + mt * 32 + (r & 3) + 8 * (r >> 2);
          float v = acc[mt][nt][r] * rsv[row - m0];
          float o = __shfl_xor(v, 8);
          if (rope) {
            int t = row & 2047;
            int a = ci >> 4, hf = (ci >> 3) & 1, j = ci & 7;
            float c = rc[t * 16 + a * 8 + j], s = rsn[t * 16 + a * 8 + j];
            v = hf ? (o * s + v * c) : (v * c - o * s);
          }
          QH[(size_t)row * 384 + base + ci] = f2bf(v);
        }
      }
  } else if (EPI == EPI_KVUP) {
    bf16_t* KA = (bf16_t*)(p.ws + OFF_KH);
    bf16_t* VT = (bf16_t*)(p.ws + OFF_VH);
#pragma unroll
    for (int mt = 0; mt < 2; ++mt)
#pragma unroll
      for (int nt = 0; nt < 2; ++nt) {
        const int base = cbase + nt * 32;
        const int h = base >> 7, cc = (base & 127) + ci;
#pragma unroll
        for (int g = 0; g < 4; ++g) {
          const int row0 = rbase + mt * 32 + 8 * g;
          int bb, key0;
          if (row0 < M_LAT) { bb = row0 >> 11; key0 = 256 + (row0 & 2047); }
          else { bb = (row0 - M_LAT) >> 8; key0 = (row0 - M_LAT) & 255; }
          float v0 = acc[mt][nt][4 * g + 0] * rsv[row0 - m0 + 0];
          float v1 = acc[mt][nt][4 * g + 1] * rsv[row0 - m0 + 1];
          float v2 = acc[mt][nt][4 * g + 2] * rsv[row0 - m0 + 2];
          float v3 = acc[mt][nt][4 * g + 3] * rsv[row0 - m0 + 3];
          if (cc < 64) {
            bf16_t* kp = KA + ((size_t)(bb * 4 + h) * 2304 + key0) * 96 + cc;
            kp[0] = f2bf(v0); kp[96] = f2bf(v1); kp[192] = f2bf(v2); kp[288] = f2bf(v3);
          } else {
            uint2 u;
            u.x = pack2(v0, v1);
            u.y = pack2(v2, v3);
            *(uint2*)(VT + ((size_t)(bb * 4 + h) * 64 + (cc - 64)) * 2304 + key0) = u;
          }
        }
      }
  } else if (EPI == EPI_RES) {
    float* X = (float*)(p.ws + OFF_X);
    const float* modl = (const float*)(p.ws + OFF_MOD) + (size_t)l * 9 * 6144 + gate_i * 1024;
#pragma unroll
    for (int mt = 0; mt < 2; ++mt)
#pragma unroll
      for (int nt = 0; nt < 2; ++nt)
#pragma unroll
        for (int r = 0; r < 16; ++r) {
          int row = rbase + mt * 32 + (r & 3) + 8 * (r >> 2);
          int col = cbase + nt * 32 + ci;
          int b = row < M_LAT ? (row >> 11) : 8;
          float g = modl[b * 6144 + col];
          size_t idx = (size_t)row * 1024 + col;
          X[idx] = X[idx] + g * acc[mt][nt][r];
        }
  } else if (EPI == EPI_GU) {
    bf16_t* ACT = (bf16_t*)(p.ws + OFF_P);
#pragma unroll
    for (int mt = 0; mt < 2; ++mt)
#pragma unroll
      for (int r = 0; r < 16; ++r) {
        int row = rbase + mt * 32 + (r & 3) + 8 * (r >> 2);
        float gt = acc[mt][0][r], up = acc[mt][1][r];
        float a = silu_f(gt) * up;
        ACT[(size_t)row * FFN + (cbase >> 6) * 32 + ci] = f2bf(a);
      }
  }
}

__device__ void kpe_item(const Params& p, int it) {
  const int tid = otid();
  const bf16_t* P = (const bf16_t*)(p.ws + OFF_P);
  bf16_t* KH = (bf16_t*)(p.ws + OFF_KH);
  const float* rc = (const float*)(p.ws + OFF_ROPE);
  const float* rsn = rc + 2048 * 16;
  const int row = it * 8 + (tid >> 5), i = tid & 31;
  float v = bf2f(P[(size_t)row * INWP + C_MPE + i]);
  float o = __shfl_xor(v, 8);
  if (row < M_LAT) {
    int t = row & 2047;
    int a = i >> 4, hf = (i >> 3) & 1, j = i & 7;
    float c = rc[t * 16 + a * 8 + j], s = rsn[t * 16 + a * 8 + j];
    v = hf ? (o * s + v * c) : (v * c - o * s);
  }
  bf16_t bv = f2bf(v);
  int bb, key;
  if (row < M_LAT) { bb = row >> 11; key = 256 + (row & 2047); }
  else { bb = (row - M_LAT) >> 8; key = (row - M_LAT) & 255; }
#pragma unroll
  for (int h = 0; h < 4; ++h) KH[((size_t)(bb * 4 + h) * 2304 + key) * 96 + 64 + i] = bv;
}

__device__ void dn_prep(const Params& p, int l, int it, char* smem) {
  float* buf = (float*)smem;
  float* nrm = buf + 8 * 1536;
  const int tid = otid();
  const bf16_t* P = (const bf16_t*)(p.ws + OFF_P);
  bf16_t* DQ = (bf16_t*)(p.ws + OFF_DNQKV);
  const int r0 = it * 8;
  int seq_lo, seq_hi;
  if (r0 < M_LAT) {
    seq_lo = (r0 >> 11) << 11;
    seq_hi = seq_lo + 2048;
  } else {
    int rr = r0 - M_LAT;
    seq_lo = M_LAT + ((rr >> 8) << 8);
    seq_hi = seq_lo + 256;
  }
  const float* cw = p.conv_w + (size_t)l * 5 * 1536;
  __syncthreads();
  for (int c6 = 0; c6 < 6; ++c6) {
    const int ch = c6 * 256 + tid;
    float w0 = cw[ch], w1 = cw[1536 + ch], w2 = cw[2 * 1536 + ch], w3 = cw[3 * 1536 + ch], w4 = cw[4 * 1536 + ch];
    float xw[12];
#pragma unroll
    for (int j = 0; j < 12; ++j) {
      int r = r0 - 2 + j;
      xw[j] = (r >= seq_lo && r < seq_hi) ? bf2f(P[(size_t)r * INWP + C_DN + ch]) : 0.f;
    }
#pragma unroll
    for (int j = 0; j < 8; ++j) {
      float y = w0 * xw[j] + w1 * xw[j + 1] + w2 * xw[j + 2] + w3 * xw[j + 3] + w4 * xw[j + 4];
      buf[j * 1536 + ch] = silu_f(y);
    }
  }
  __syncthreads();
  {
    int vec = tid >> 2, part = tid & 3;
    int rr = vec >> 3, hv = vec & 7;
    const float* v = buf + rr * 1536 + hv * 128 + part * 32;
    float ss = 0.f;
#pragma unroll
    for (int i = 0; i < 32; ++i) ss += v[i] * v[i];
    ss += __shfl_xor(ss, 1);
    ss += __shfl_xor(ss, 2);
    if (part == 0) nrm[vec] = rsqrtf(ss + 1e-6f);
  }
  __syncthreads();
  for (int i = tid; i < 8 * 1536; i += 256) {
    int rr = i / 1536, ch = i - rr * 1536;
    float v = buf[i];
    if (ch < 1024) v *= nrm[rr * 8 + (ch >> 7)];
    DQ[(size_t)(r0 + rr) * 1536 + ch] = f2bf(v);
  }
}

__device__ void phaseC(const Params& p, int l, char* smem) {
  const int nb = gridDim.x, bid = blockIdx.x;
  const bf16_t* P = (const bf16_t*)(p.ws + OFF_P);
  constexpr int T0 = 144 * 3, T1 = T0 + 144 * 4, T2 = T1 + M_ALL / 8, T3 = T2 + M_ALL / 8;
  for (int it = bid; it < T3; it += nb) {
    if (it < T0) {
      int i = it;
      gemm_tile<EPI_QUP>(p, l, P + C_MQ, INWP, (const bf16_t*)(p.ws + OFF_WQUP), 256, (i / 3) * 128, (i % 3) * 128, 0,
                         smem);
    } else if (it < T1) {
      int i = it - T0;
      gemm_tile<EPI_KVUP>(p, l, P + C_MKV, INWP, (const bf16_t*)(p.ws + OFF_WKVUP), 128, (i / 4) * 128, (i % 4) * 128,
                          0, smem);
    } else if (it < T2) {
      kpe_item(p, it - T1);
    } else {
      dn_prep(p, l, it - T2, smem);
    }
  }
}

__device__ void mla_flash(const Params& p, int item, char* smem) {
  bf16_t* sK = (bf16_t*)smem;
  bf16_t* sV = sK + 64 * 104;
  const int tid = otid(), lane = tid & 63, w = tid >> 6;
  const int li = lane & 31, hh = lane >> 5;
  int b, h, q0row, nkeys;
  if (item < 512) {
    b = item >> 6; h = (item >> 4) & 3; q0row = b * 2048 + (item & 15) * 128; nkeys = 2304;
  } else {
    int i = item - 512;
    b = i >> 3; h = (i >> 1) & 3; q0row = M_LAT + b * 256 + (i & 1) * 128; nkeys = 256;
  }
  const bf16_t* Kg = (const bf16_t*)(p.ws + OFF_KH) + (size_t)(b * 4 + h) * 2304 * 96;
  const bf16_t* Vg = (const bf16_t*)(p.ws + OFF_VH) + (size_t)(b * 4 + h) * 64 * 2304;
  const bf16_t* QH = (const bf16_t*)(p.ws + OFF_QH);
  bf16_t* MIX = (bf16_t*)(p.ws + OFF_HM);
  const int qrow = q0row + w * 32 + li;
  bf16x8 qf0, qf1, qf2, qf3, qf4, qf5;
  {
    const bf16_t* qp = QH + (size_t)qrow * 384 + h * 96 + hh * 8;
    qf0 = *(const bf16x8*)(qp); qf1 = *(const bf16x8*)(qp + 16); qf2 = *(const bf16x8*)(qp + 32);
    qf3 = *(const bf16x8*)(qp + 48); qf4 = *(const bf16x8*)(qp + 64); qf5 = *(const bf16x8*)(qp + 80);
  }
  const int k_i0 = tid, k_i1 = tid + 256, k_i2 = tid + 512;
  const int kk0 = k_i0 / 12, kc0 = k_i0 % 12, kk1 = k_i1 / 12, kc1 = k_i1 % 12, kk2 = k_i2 / 12, kc2 = k_i2 % 12;
  const int vd0 = tid >> 3, vc0 = tid & 7, vd1 = vd0 + 32;
  uint4 rk0, rk1, rk2, rv0, rv1;
  rk0 = *(const uint4*)(Kg + (size_t)kk0 * 96 + kc0 * 8);
  rk1 = *(const uint4*)(Kg + (size_t)kk1 * 96 + kc1 * 8);
  rk2 = *(const uint4*)(Kg + (size_t)kk2 * 96 + kc2 * 8);
  rv0 = *(const uint4*)(Vg + (size_t)vd0 * 2304 + vc0 * 8);
  rv1 = *(const uint4*)(Vg + (size_t)vd1 * 2304 + vc0 * 8);
  f32x16 o0, o1;
#pragma unroll
  for (int r = 0; r < 16; ++r) { o0[r] = 0.f; o1[r] = 0.f; }
  float m = -1e30f, lp = 0.f;
  const float sc = 0.10206207261596577f * 1.4426950408889634f;
  const int nt = nkeys >> 6;
  for (int t = 0; t < nt; ++t) {
    __syncthreads();
    *(uint4*)(sK + kk0 * 104 + kc0 * 8) = rk0;
    *(uint4*)(sK + kk1 * 104 + kc1 * 8) = rk1;
    *(uint4*)(sK + kk2 * 104 + kc2 * 8) = rk2;
    *(uint2*)(sV + vd0 * 68 + vc0 * 8) = make_uint2(rv0.x, rv0.y);
    *(uint2*)(sV + vd0 * 68 + vc0 * 8 + 4) = make_uint2(rv0.z, rv0.w);
    *(uint2*)(sV + vd1 * 68 + vc0 * 8) = make_uint2(rv1.x, rv1.y);
    *(uint2*)(sV + vd1 * 68 + vc0 * 8 + 4) = make_uint2(rv1.z, rv1.w);
    __syncthreads();
    if (t + 1 < nt) {
      const int k0 = (t + 1) * 64;
      rk0 = *(const uint4*)(Kg + (size_t)(k0 + kk0) * 96 + kc0 * 8);
      rk1 = *(const uint4*)(Kg + (size_t)(k0 + kk1) * 96 + kc1 * 8);
      rk2 = *(const uint4*)(Kg + (size_t)(k0 + kk2) * 96 + kc2 * 8);
      rv0 = *(const uint4*)(Vg + (size_t)vd0 * 2304 + k0 + vc0 * 8);
      rv1 = *(const uint4*)(Vg + (size_t)vd1 * 2304 + k0 + vc0 * 8);
    }
    f32x16 s0, s1;
#pragma unroll
    for (int r = 0; r < 16; ++r) { s0[r] = 0.f; s1[r] = 0.f; }
    {
      const bf16_t* ka = sK + li * 104 + hh * 8;
      const bf16_t* kb = ka + 32 * 104;
      s0 = __builtin_amdgcn_mfma_f32_32x32x16_bf16(*(const bf16x8*)(ka), qf0, s0, 0, 0, 0);
      s1 = __builtin_amdgcn_mfma_f32_32x32x16_bf16(*(const bf16x8*)(kb), qf0, s1, 0, 0, 0);
      s0 = __builtin_amdgcn_mfma_f32_32x32x16_bf16(*(const bf16x8*)(ka + 16), qf1, s0, 0, 0, 0);
      s1 = __builtin_amdgcn_mfma_f32_32x32x16_bf16(*(const bf16x8*)(kb + 16), qf1, s1, 0, 0, 0);
      s0 = __builtin_amdgcn_mfma_f32_32x32x16_bf16(*(const bf16x8*)(ka + 32), qf2, s0, 0, 0, 0);
      s1 = __builtin_amdgcn_mfma_f32_32x32x16_bf16(*(const bf16x8*)(kb + 32), qf2, s1, 0, 0, 0);
      s0 = __builtin_amdgcn_mfma_f32_32x32x16_bf16(*(const bf16x8*)(ka + 48), qf3, s0, 0, 0, 0);
      s1 = __builtin_amdgcn_mfma_f32_32x32x16_bf16(*(const bf16x8*)(kb + 48), qf3, s1, 0, 0, 0);
      s0 = __builtin_amdgcn_mfma_f32_32x32x16_bf16(*(const bf16x8*)(ka + 64), qf4, s0, 0, 0, 0);
      s1 = __builtin_amdgcn_mfma_f32_32x32x16_bf16(*(const bf16x8*)(kb + 64), qf4, s1, 0, 0, 0);
      s0 = __builtin_amdgcn_mfma_f32_32x32x16_bf16(*(const bf16x8*)(ka + 80), qf5, s0, 0, 0, 0);
      s1 = __builtin_amdgcn_mfma_f32_32x32x16_bf16(*(const bf16x8*)(kb + 80), qf5, s1, 0, 0, 0);
    }
    float mx = s0[0];
#pragma unroll
    for (int r = 1; r < 16; ++r) mx = fmaxf(mx, s0[r]);
#pragma unroll
    for (int r = 0; r < 16; ++r) mx = fmaxf(mx, s1[r]);
    mx = fmaxf(mx, __shfl_xor(mx, 32));
    const float mn = fmaxf(m, mx * sc);
    const float corr = __builtin_amdgcn_exp2f(m - mn);
    m = mn;
    lp *= corr;
#pragma unroll
    for (int r = 0; r < 16; ++r) { o0[r] *= corr; o1[r] *= corr; }
#pragma unroll
    for (int r = 0; r < 16; ++r) {
      s0[r] = __builtin_amdgcn_exp2f(s0[r] * sc - mn);
      s1[r] = __builtin_amdgcn_exp2f(s1[r] * sc - mn);
      lp += s0[r] + s1[r];
    }
#pragma unroll
    for (int u = 0; u < 2; ++u) {
#pragma unroll
      for (int s = 0; s < 2; ++s) {
        union { bf16x8 v; unsigned w[4]; } pb;
        if (u == 0) {
          pb.w[0] = pack2(s0[8 * s + 0], s0[8 * s + 1]); pb.w[1] = pack2(s0[8 * s + 2], s0[8 * s + 3]);
          pb.w[2] = pack2(s0[8 * s + 4], s0[8 * s + 5]); pb.w[3] = pack2(s0[8 * s + 6], s0[8 * s + 7]);
        } else {
          pb.w[0] = pack2(s1[8 * s + 0], s1[8 * s + 1]); pb.w[1] = pack2(s1[8 * s + 2], s1[8 * s + 3]);
          pb.w[2] = pack2(s1[8 * s + 4], s1[8 * s + 5]); pb.w[3] = pack2(s1[8 * s + 6], s1[8 * s + 7]);
        }
        const bf16_t* va = sV + li * 68 + 32 * u + 16 * s + 4 * hh;
        union { bf16x8 v; uint2 d[2]; } a0, a1;
        a0.d[0] = *(const uint2*)(va);
        a0.d[1] = *(const uint2*)(va + 8);
        a1.d[0] = *(const uint2*)(va + 32 * 68);
        a1.d[1] = *(const uint2*)(va + 32 * 68 + 8);
        o0 = __builtin_amdgcn_mfma_f32_32x32x16_bf16(a0.v, pb.v, o0, 0, 0, 0);
        o1 = __builtin_amdgcn_mfma_f32_32x32x16_bf16(a1.v, pb.v, o1, 0, 0, 0);
      }
    }
  }
  lp += __shfl_xor(lp, 32);
  const float inv = 1.f / lp;
  bf16_t* op = MIX + (size_t)qrow * 1024 + h * 64 + 4 * hh;
#pragma unroll
  for (int g = 0; g < 4; ++g) {
    uint2 u0, u1;
    u0.x = pack2(o0[4 * g + 0] * inv, o0[4 * g + 1] * inv);
    u0.y = pack2(o0[4 * g + 2] * inv, o0[4 * g + 3] * inv);
    u1.x = pack2(o1[4 * g + 0] * inv, o1[4 * g + 1] * inv);
    u1.y = pack2(o1[4 * g + 2] * inv, o1[4 * g + 3] * inv);
    *(uint2*)(op + 8 * g) = u0;
    *(uint2*)(op + 32 + 8 * g) = u1;
  }
}

__device__ void na_naive(const Params& p, int l, int ti) {
  const int h = otid() >> 6, lane = otid() & 63;
  const bf16_t* P = (const bf16_t*)(p.ws + OFF_P);
  bf16_t* MIX = (bf16_t*)(p.ws + OFF_HM);
  const bool lat = ti < 256;
  const int b = lat ? (ti >> 5) : ((ti - 256) >> 2);
  const int r = ti & 31;
  const int row = lat ? (ti * 64 + lane) : (M_LAT + (ti - 256) * 64 + lane);
  float q[64], acc[64];
  {
    const uint4* qp = (const uint4*)(P + (size_t)row * INWP + C_NQ + h * 64);
#pragma unroll
    for (int c = 0; c < 8; ++c) {
      uint4 u = qp[c];
      q[c * 8 + 0] = bflo(u.x); q[c * 8 + 1] = bfhi(u.x); q[c * 8 + 2] = bflo(u.y); q[c * 8 + 3] = bfhi(u.y);
      q[c * 8 + 4] = bflo(u.z); q[c * 8 + 5] = bfhi(u.z); q[c * 8 + 6] = bflo(u.w); q[c * 8 + 7] = bfhi(u.w);
    }
  }
#pragma unroll
  for (int i = 0; i < 64; ++i) acc[i] = 0.f;
  float m = -INFINITY, ls = 0.f;
  const int qc = lane;
  const int rs0 = min(max(r - 4, 0), 24);
  const int cs0 = min(max(qc - 8, 0), 48);
  const float* rb = p.rel_bias + (size_t)l * 4 * 15 * 31 + h * 15 * 31;
  const int nloc = lat ? 128 : 0;
  for (int j = 0; j < nloc + 256; ++j) {
    int krow;
    float bias = 0.f;
    if (j < nloc) {
      int kr = rs0 + (j >> 4), kc = cs0 + (j & 15);
      krow = b * 2048 + kr * 64 + kc;
      bias = rb[(kr - r + 7) * 31 + (kc - qc + 15)];
    } else {
      krow = M_LAT + b * 256 + (j - nloc);
    }
    const uint4* kp = (const uint4*)(P + (size_t)krow * INWP + C_NK + h * 64);
    float s = 0.f;
#pragma unroll
    for (int c = 0; c < 8; ++c) {
      uint4 u = kp[c];
      s += q[c * 8 + 0] * bflo(u.x) + q[c * 8 + 1] * bfhi(u.x) + q[c * 8 + 2] * bflo(u.y) + q[c * 8 + 3] * bfhi(u.y) +
           q[c * 8 + 4] * bflo(u.z) + q[c * 8 + 5] * bfhi(u.z) + q[c * 8 + 6] * bflo(u.w) + q[c * 8 + 7] * bfhi(u.w);
    }
    s = s * 0.125f + bias;
    float mn = fmaxf(m, s);
    float corr = __expf(m - mn), pe = __expf(s - mn);
    ls = ls * corr + pe;
    m = mn;
    const uint4* vp = (const uint4*)(P + (size_t)krow * INWP + C_NV + h * 64);
#pragma unroll
    for (int c = 0; c < 8; ++c) {
      uint4 u = vp[c];
      acc[c * 8 + 0] = acc[c * 8 + 0] * corr + pe * bflo(u.x);
      acc[c * 8 + 1] = acc[c * 8 + 1] * corr + pe * bfhi(u.x);
      acc[c * 8 + 2] = acc[c * 8 + 2] * corr + pe * bflo(u.y);
      acc[c * 8 + 3] = acc[c * 8 + 3] * corr + pe * bfhi(u.y);
      acc[c * 8 + 4] = acc[c * 8 + 4] * corr + pe * bflo(u.z);
      acc[c * 8 + 5] = acc[c * 8 + 5] * corr + pe * bfhi(u.z);
      acc[c * 8 + 6] = acc[c * 8 + 6] * corr + pe * bflo(u.w);
      acc[c * 8 + 7] = acc[c * 8 + 7] * corr + pe * bfhi(u.w);
    }
  }
  const float inv = 1.f / ls;
  uint4* op = (uint4*)(MIX + (size_t)row * 1024 + 256 + h * 64);
#pragma unroll
  for (int c = 0; c < 8; ++c) {
    uint4 u;
    u.x = pack2(acc[c * 8 + 0] * inv, acc[c * 8 + 1] * inv);
    u.y = pack2(acc[c * 8 + 2] * inv, acc[c * 8 + 3] * inv);
    u.z = pack2(acc[c * 8 + 4] * inv, acc[c * 8 + 5] * inv);
    u.w = pack2(acc[c * 8 + 6] * inv, acc[c * 8 + 7] * inv);
    op[c] = u;
  }
}

DEVI int dn_rowof(int s, int b, int d) {
  if (s < 256) {
    int c = d ? (255 - s) : s;
    return M_LAT + b * 256 + c;
  }
  int t = s - 256;
  t = d ? (2047 - t) : t;
  return b * 2048 + t;
}

__device__ void dn_naive(const Params& p, int l, int it, char* smem) {
  float* ks = (float*)smem;
  float* qs = ks + 32 * 128;
  float* vs = qs + 32 * 128;
  float* gs = vs + 32 * 64;
  float* bs = gs + 32;
  const int half = it & 1, d = (it >> 1) & 1, h = (it >> 2) & 3, b = it >> 4;
  const int tid = otid(), w = tid >> 6, lane = tid & 63, c = lane & 15, kg = lane >> 4;
  const int col = half * 64 + w * 16 + c;
  const bf16_t* DQ = (const bf16_t*)(p.ws + OFF_DNQKV);
  const float* AB = (const float*)(p.ws + OFF_AB);
  bf16_t* MIX = (bf16_t*)(p.ws + OFF_HM);
  bf16_t* OB = (bf16_t*)(p.ws + OFF_OB);
  float S[32];
#pragma unroll
  for (int i = 0; i < 32; ++i) S[i] = 0.f;
  const float Aneg = -__expf(p.a_log[l * 8 + d * 4 + h]);
  const float dtb = p.dt_bias[l * 8 + d * 4 + h];
  for (int s0 = 0; s0 < 2304; s0 += 32) {
    __syncthreads();
    for (int i = tid; i < 32 * 128; i += 256) {
      int tk = i >> 7, ch = i & 127;
      int row = dn_rowof(s0 + tk, b, d);
      qs[i] = bf2f(DQ[(size_t)row * 1536 + h * 128 + ch]);
      ks[i] = bf2f(DQ[(size_t)row * 1536 + 512 + h * 128 + ch]);
    }
    for (int i = tid; i < 32 * 64; i += 256) {
      int tk = i >> 6, ch = i & 63;
      int row = dn_rowof(s0 + tk, b, d);
      vs[i] = bf2f(DQ[(size_t)row * 1536 + 1024 + h * 128 + half * 64 + ch]);
    }
    if (tid < 32) {
      int row = dn_rowof(s0 + tid, b, d);
      float a = AB[(size_t)row * 16 + d * 4 + h];
      float bb = AB[(size_t)row * 16 + 8 + d * 4 + h];
      float xx = a + dtb;
      float sp = xx > 20.f ? xx : log1pf(__expf(xx));
      gs[tid] = __expf(Aneg * sp);
      bs[tid] = 1.f / (1.f + __expf(-bb));
    }
    __syncthreads();
    for (int tk = 0; tk < 32; ++tk) {
      const float eg = gs[tk], beta = bs[tk];
      const float vv = vs[tk * 64 + w * 16 + c];
      const float4* k4 = (const float4*)(ks + tk * 128 + kg * 32);
      const float4* q4 = (const float4*)(qs + tk * 128 + kg * 32);
      float part = 0.f;
#pragma unroll
      for (int i = 0; i < 8; ++i) {
        float4 kk = k4[i];
        S[4 * i + 0] *= eg; S[4 * i + 1] *= eg; S[4 * i + 2] *= eg; S[4 * i + 3] *= eg;
        part += kk.x * S[4 * i + 0] + kk.y * S[4 * i + 1] + kk.z * S[4 * i + 2] + kk.w * S[4 * i + 3];
      }
      part += __shfl_xor(part, 16);
      part += __shfl_xor(part, 32);
      const float delta = beta * (vv - part);
      float po = 0.f;
#pragma unroll
      for (int i = 0; i < 8; ++i) {
        float4 kk = k4[i];
        float4 qq = q4[i];
        S[4 * i + 0] += kk.x * delta; S[4 * i + 1] += kk.y * delta; S[4 * i + 2] += kk.z * delta; S[4 * i + 3] += kk.w * delta;
        po += qq.x * S[4 * i + 0] + qq.y * S[4 * i + 1] + qq.z * S[4 * i + 2] + qq.w * S[4 * i + 3];
      }
      po += __shfl_xor(po, 16);
      po += __shfl_xor(po, 32);
      if (kg == 0) {
        int row = dn_rowof(s0 + tk, b, d);
        float o = po * 0.08838834764831845f;
        if (d == 0)
          MIX[(size_t)row * 1024 + 512 + h * 128 + col] = f2bf(o);
        else
          OB[(size_t)row * 512 + h * 128 + col] = f2bf(o);
      }
    }
  }
}

__device__ void phaseD(const Params& p, int l, char* smem) {
  const int nb = gridDim.x, bid = blockIdx.x;
  constexpr int T0 = 128, T1 = T0 + 576, T2 = T1 + 288;
  for (int it = bid; it < T2; it += nb) {
    if (it < T0)
      dn_naive(p, l, it, smem);
    else if (it < T1)
      mla_flash(p, it - T0, smem);
    else
      na_naive(p, l, it - T1);
  }
}

__device__ void outgate_item(const Params& p, int l, int item) {
  const int w = otid() >> 6, lane = otid() & 63;
  const int row = item * 4 + w;
  const bf16_t* P = (const bf16_t*)(p.ws + OFF_P);
  bf16_t* MIX = (bf16_t*)(p.ws + OFF_HM);
  const bf16_t* OB = (const bf16_t*)(p.ws + OFF_OB);
  const int h = lane >> 4, cb = (lane & 15) * 8;
  uint4 uo = *(const uint4*)(MIX + (size_t)row * 1024 + 512 + h * 128 + cb);
  uint4 ub = *(const uint4*)(OB + (size_t)row * 512 + h * 128 + cb);
  uint4 uz = *(const uint4*)(P + (size_t)row * INWP + C_DZ + h * 128 + cb);
  float o[8], z[8];
  o[0] = bflo(uo.x) + bflo(ub.x); o[1] = bfhi(uo.x) + bfhi(ub.x); o[2] = bflo(uo.y) + bflo(ub.y); o[3] = bfhi(uo.y) + bfhi(ub.y);
  o[4] = bflo(uo.z) + bflo(ub.z); o[5] = bfhi(uo.z) + bfhi(ub.z); o[6] = bflo(uo.w) + bflo(ub.w); o[7] = bfhi(uo.w) + bfhi(ub.w);
  z[0] = bflo(uz.x); z[1] = bfhi(uz.x); z[2] = bflo(uz.y); z[3] = bfhi(uz.y);
  z[4] = bflo(uz.z); z[5] = bfhi(uz.z); z[6] = bflo(uz.w); z[7] = bfhi(uz.w);
  float ss = 0.f;
#pragma unroll
  for (int e = 0; e < 8; ++e) ss += o[e] * o[e];
  ss += __shfl_xor(ss, 1);
  ss += __shfl_xor(ss, 2);
  ss += __shfl_xor(ss, 4);
  ss += __shfl_xor(ss, 8);
  const float r = rsqrtf(ss * (1.f / 128.f) + 1e-6f);
  const float* go = p.g_out + l * 128 + cb;
  float y[8];
#pragma unroll
  for (int e = 0; e < 8; ++e) y[e] = o[e] * r * go[e] * silu_f(z[e]);
  uint4 u;
  u.x = pack2(y[0], y[1]); u.y = pack2(y[2], y[3]); u.z = pack2(y[4], y[5]); u.w = pack2(y[6], y[7]);
  *(uint4*)(MIX + (size_t)row * 1024 + 512 + h * 128 + cb) = u;
}

__device__ void final_item(const Params& p, int item) {
  const int w = otid() >> 6, lane = otid() & 63;
  const int row = item * 4 + w;
  const float4* xr = (const float4*)((const float*)(p.ws + OFF_X) + (size_t)row * 1024);
  float4 v[4];
  float ss = 0.f;
#pragma unroll
  for (int i = 0; i < 4; ++i) {
    v[i] = xr[lane + 64 * i];
    ss += v[i].x * v[i].x + v[i].y * v[i].y + v[i].z * v[i].z + v[i].w * v[i].w;
  }
  ss = wave_sum(ss);
  const float r = rsqrtf(ss * (1.f / 1024.f) + 1e-6f);
  const float4* g4 = (const float4*)p.g_final;
  float4* o4 = (float4*)(p.out + (size_t)row * 1024);
#pragma unroll
  for (int i = 0; i < 4; ++i) {
    float4 gg = g4[lane + 64 * i];
    float4 y;
    y.x = v[i].x * r * gg.x; y.y = v[i].y * r * gg.y; y.z = v[i].z * r * gg.z; y.w = v[i].w * r * gg.w;
    o4[lane + 64 * i] = y;
  }
}

constexpr int N_PHASES = 1 + 9 * 4 + 1;

__global__ void __launch_bounds__(256, 2) mega(Params p) {
  __shared__ __attribute__((aligned(16))) char smem[50176];
  cg::grid_group grid = cg::this_grid();
  const int nb = gridDim.x, bid = blockIdx.x;
  for (int ph = p.ph_lo; ph < p.ph_hi; ++ph) {
    if (ph == 0) {
      phase0(p, smem);
    } else if (ph == N_PHASES - 1) {
      for (int it = bid; it < M_LAT / 4; it += nb) final_item(p, it);
    } else {
      const int l = (ph - 1) / 9, s = (ph - 1) % 9;
      if (s == 0) {
        phaseA(p, l, smem);
      } else if (s == 1) {
        for (int it = bid; it < 144 * 26; it += nb)
          gemm_tile<EPI_P>(p, l, (const bf16_t*)(p.ws + OFF_HM), 1024, (const bf16_t*)(p.ws + OFF_WIN), 1024,
                           (it / 26) * 128, (it % 26) * 128, 0, smem);
      } else if (s == 2) {
        phaseC(p, l, smem);
      } else if (s == 3) {
        phaseD(p, l, smem);
      } else if (s == 4) {
        for (int it = bid; it < M_ALL / 4; it += nb) outgate_item(p, l, it);
      } else if (s == 5) {
        for (int it = bid; it < 144 * 8; it += nb)
          gemm_tile<EPI_RES>(p, l, (const bf16_t*)(p.ws + OFF_HM), 1024, (const bf16_t*)(p.ws + OFF_WOUT), 1024,
                             (it / 8) * 128, (it % 8) * 128, 2, smem);
      } else if (s == 6) {
        for (int it = bid; it < M_ALL / 4; it += nb)
          norm_rows((const float*)(p.ws + OFF_X), (bf16_t*)(p.ws + OFF_HM), p.g_ffn + l * 1024,
                    (const float*)(p.ws + OFF_MOD) + (size_t)l * 9 * 6144, 3, 4, it);
      } else if (s == 7) {
        for (int it = bid; it < 144 * 44; it += nb)
          gemm_tile<EPI_GU>(p, l, (const bf16_t*)(p.ws + OFF_HM), 1024, (const bf16_t*)(p.ws + OFF_WGU), 1024,
                            (it / 44) * 128, (it % 44) * 128, 0, smem);
      } else {
        for (int it = bid; it < 144 * 8; it += nb)
          gemm_tile<EPI_RES>(p, l, (const bf16_t*)(p.ws + OFF_P), FFN, (const bf16_t*)(p.ws + OFF_WDN), FFN,
                             (it / 8) * 128, (it % 8) * 128, 5, smem);
      }
    }
    if (ph + 1 < p.ph_hi) grid.sync();
  }
}

extern "C" void kernel_launch(void* const* d_in, const int* in_sizes, int n_in, void* d_out, int out_size, void* d_ws,
                              size_t ws_size, hipStream_t stream) {
  static int grid_blocks = 0;
  if (!grid_blocks) {
    int dev = 0, cus = 0, per_cu = 0;
    hipGetDevice(&dev);
    hipDeviceGetAttribute(&cus, hipDeviceAttributeMultiprocessorCount, dev);
    hipOccupancyMaxActiveBlocksPerMultiprocessor(&per_cu, mega, 256, 0);
    if (per_cu < 1) per_cu = 1;
    if (per_cu > 2) per_cu = 2;
    grid_blocks = cus * per_cu;
  }
  Params p{};
  const float** pp = (const float**)&p;
  for (int i = 0; i < 23; ++i) pp[i] = (const float*)d_in[i];
  p.out = (float*)d_out;
  p.ws = (char*)d_ws;
  p.ph_lo = 0;
  p.ph_hi = N_PHASES;
  void* args[] = {&p};
  hipError_t e = hipLaunchCooperativeKernel((void*)mega, dim3(grid_blocks), dim3(256), args, 0, stream);
  if (e != hipSuccess) {
    fprintf(stderr, "cooperative launch failed: %s (grid %d)\n", hipGetErrorString(e), grid_blocks);
    (void)hipGetLastError();
    for (int ph = 0; ph < N_PHASES; ++ph) {
      p.ph_lo = ph;
      p.ph_hi = ph + 1;
      hipLaunchKernelGGL(mega, dim3(grid_blocks), dim3(256), 0, stream, p);
    }
  }
}
```

```cpp
#include <hip/hip_runtime.h>
#include <hip/hip_bf16.h>
#include <hip/hip_cooperative_groups.h>
#include <cstdio>
namespace cg = cooperative_groups;

#define DEVI __device__ __forceinline__
typedef unsigned short bf16_t;
typedef short bf16x8 __attribute__((ext_vector_type(8)));
typedef float f32x16 __attribute__((ext_vector_type(16)));

constexpr int M_LAT = 16384, M_CTX = 2048, M_ALL = 18432;
constexpr int DM = 1024, INW = 3248, INWP = 3328, FFN = 2816;
constexpr int C_MQ = 0, C_MKV = 256, C_MPE = 384, C_NQ = 416, C_NK = 672, C_NV = 928, C_DN = 1184;
constexpr int C_DZ = C_DN + 1536, C_DA = C_DN + 2048;

constexpr size_t OFF_WIN = 0;
constexpr size_t OFF_WOUT = OFF_WIN + (size_t)INWP * 1024 * 2;
constexpr size_t OFF_WGU = OFF_WOUT + (size_t)1024 * 1024 * 2;
constexpr size_t OFF_WDN = OFF_WGU + (size_t)2 * FFN * 1024 * 2;
constexpr size_t OFF_WQUP = OFF_WDN + (size_t)1024 * FFN * 2;
constexpr size_t OFF_WKVUP = OFF_WQUP + (size_t)384 * 256 * 2;
constexpr size_t OFF_MOD = OFF_WKVUP + (size_t)512 * 128 * 2;
constexpr size_t OFF_ROPE = OFF_MOD + (size_t)4 * 9 * 6144 * 4;
constexpr size_t OFF_X = OFF_ROPE + (size_t)2048 * 16 * 2 * 4;
constexpr size_t OFF_HM = OFF_X + (size_t)M_ALL * 1024 * 4;
constexpr size_t OFF_P = OFF_HM + (size_t)M_ALL * 1024 * 2;
constexpr size_t OFF_QH = OFF_P + (size_t)M_ALL * INWP * 2;
constexpr size_t OFF_KH = OFF_QH + (size_t)M_ALL * 384 * 2;
constexpr size_t OFF_VH = OFF_KH + (size_t)M_ALL * 384 * 2;
constexpr size_t OFF_DNQKV = OFF_VH + (size_t)M_ALL * 256 * 2;
constexpr size_t OFF_OB = OFF_DNQKV + (size_t)M_ALL * 1536 * 2;
constexpr size_t OFF_AB = OFF_OB + (size_t)M_ALL * 512 * 2;
constexpr size_t OFF_GC = OFF_AB + (size_t)M_ALL * 16 * 4;
constexpr size_t OFF_BETA = OFF_GC + (size_t)M_ALL * 8 * 4;
constexpr size_t WS_TOTAL = OFF_BETA + (size_t)M_ALL * 8 * 4;
constexpr int SMEM_BYTES = 70656;

struct Params {
  const float *x, *c, *ctx, *c_ctx, *w_ada, *b_ada, *g_mix, *w_in, *g_q, *g_kv, *w_qup, *w_kvup, *rel_bias,
      *conv_w, *a_log, *dt_bias, *g_out, *w_out, *g_ffn, *w_gate, *w_up, *w_down, *g_final;
  float* out;
  char* ws;
  int ph_lo, ph_hi;
};

DEVI bf16_t f2bf(float f) {
  __bf16 r = (__bf16)f;
  return __builtin_bit_cast(unsigned short, r);
}
DEVI int otid() {
  int t = threadIdx.x;
  asm volatile("" : "+v"(t));
  return t;
}
DEVI float bf2f(bf16_t h) { return __uint_as_float(((unsigned)h) << 16); }
DEVI float bflo(unsigned u) { return __uint_as_float(u << 16); }
DEVI float bfhi(unsigned u) { return __uint_as_float(u & 0xffff0000u); }
typedef __bf16 bf16v2_t __attribute__((ext_vector_type(2)));
typedef float f32v2_t __attribute__((ext_vector_type(2)));
DEVI unsigned pack2(float a, float b) {
  f32v2_t v = {a, b};
  bf16v2_t r = __builtin_convertvector(v, bf16v2_t);
  return __builtin_bit_cast(unsigned, r);
}
DEVI float silu_f(float x) { return x / (1.f + __expf(-x)); }
DEVI float wave_sum(float v) {
#pragma unroll
  for (int o = 32; o >= 1; o >>= 1) v += __shfl_xor(v, o);
  return v;
}

__device__ void phase0(const Params& p, char* smem) {
  const int tid = otid(), nb = gridDim.x, bid = blockIdx.x;
  {
    float4* X4 = (float4*)(p.ws + OFF_X);
    const float4* x4 = (const float4*)p.x;
    const float4* c4 = (const float4*)p.ctx;
    const size_t n1 = (size_t)M_LAT * 256, n2 = (size_t)M_CTX * 256;
    for (size_t i = (size_t)bid * 256 + tid; i < n1 + n2; i += (size_t)nb * 256) X4[i] = i < n1 ? x4[i] : c4[i - n1];
  }
  {
    float* rc = (float*)(p.ws + OFF_ROPE);
    float* rs = rc + 2048 * 16;
    for (int i = bid * 256 + tid; i < 2048 * 16; i += nb * 256) {
      int t = i >> 4, a = (i >> 3) & 1, j = i & 7;
      float pos = a ? (float)(t & 63) : (float)(t >> 6);
      float inv = powf(10000.f, -(float)j / 8.f);
      float ang = pos * inv;
      rc[i] = cosf(ang);
      rs[i] = sinf(ang);
    }
  }
  float* sc = (float*)smem;
  float* red = sc + 9 * 1024;
  float* MOD = (float*)(p.ws + OFF_MOD);
  bool loaded = false;
  for (int it = bid; it < 4 * 96; it += nb) {
    if (!loaded) {
      for (int i = tid; i < 9 * 1024; i += 256) {
        float v = i < 8192 ? p.c[i] : p.c_ctx[i - 8192];
        sc[i] = silu_f(v);
      }
      __syncthreads();
      loaded = true;
    }
    const int l = it / 96, n0 = (it % 96) * 64;
    const int cc = tid & 63, kg = tid >> 6;
    const float* w = p.w_ada + (size_t)l * 1024 * 6144 + n0 + cc;
    float acc[9];
#pragma unroll
    for (int b = 0; b < 9; ++b) acc[b] = 0.f;
    for (int k = kg * 256; k < kg * 256 + 256; ++k) {
      float wv = w[(size_t)k * 6144];
#pragma unroll
      for (int b = 0; b < 9; ++b) acc[b] += sc[b * 1024 + k] * wv;
    }
#pragma unroll
    for (int b = 0; b < 9; ++b) red[(kg * 9 + b) * 64 + cc] = acc[b];
    __syncthreads();
    for (int i = tid; i < 9 * 64; i += 256) {
      int b = i >> 6, c2 = i & 63;
      float s = red[(0 * 9 + b) * 64 + c2] + red[(1 * 9 + b) * 64 + c2] + red[(2 * 9 + b) * 64 + c2] +
                red[(3 * 9 + b) * 64 + c2];
      MOD[(size_t)(l * 9 + b) * 6144 + n0 + c2] = s + p.b_ada[l * 6144 + n0 + c2];
    }
    __syncthreads();
  }
}

__device__ void convT_tile(const float* __restrict__ src, int K, int N, bf16_t* __restrict__ dst, int mode,
                           const float* __restrict__ gs, int kt, int nt, float* tl) {
  const int tid = otid();
  const int k0 = kt * 64, n0 = nt * 64;
  __syncthreads();
#pragma unroll 4
  for (int i = 0; i < 16; ++i) {
    int kk = i * 4 + (tid >> 6), nn = tid & 63;
    float v = 0.f;
    if (n0 + nn < N) v = src[(size_t)(k0 + kk) * N + n0 + nn];
    if (gs) v *= gs[k0 + kk];
    tl[kk * 65 + nn] = v;
  }
  __syncthreads();
#pragma unroll 2
  for (int i = 0; i < 8; ++i) {
    int nn = i * 8 + (tid >> 5), kk = (tid & 31) * 2;
    unsigned pk = pack2(tl[kk * 65 + nn], tl[(kk + 1) * 65 + nn]);
    int n = n0 + nn;
    int drow = mode == 0 ? n : ((n >> 5) * 64 + (n & 31) + (mode == 2 ? 32 : 0));
    *(unsigned*)(dst + (size_t)drow * K + k0 + kk) = pk;
  }
}

__device__ void norm_rows(const float* __restrict__ X, bf16_t* __restrict__ H, const float* __restrict__ g,
                          const float* __restrict__ modl, int shift_i, int scale_i, int item) {
  const int w = otid() >> 6, lane = otid() & 63;
  const int row = item * 4 + w;
  const float4* xr = (const float4*)(X + (size_t)row * 1024);
  float4 v[4];
  float ss = 0.f;
#pragma unroll
  for (int i = 0; i < 4; ++i) {
    v[i] = xr[lane + 64 * i];
    ss += v[i].x * v[i].x + v[i].y * v[i].y + v[i].z * v[i].z + v[i].w * v[i].w;
  }
  ss = wave_sum(ss);
  const float r = rsqrtf(ss * (1.f / 1024.f) + 1e-6f);
  const int b = row < M_LAT ? (row >> 11) : 8;
  const float4* sh = (const float4*)(modl + b * 6144 + shift_i * 1024);
  const float4* sl = (const float4*)(modl + b * 6144 + scale_i * 1024);
  const float4* g4 = (const float4*)g;
#pragma unroll
  for (int i = 0; i < 4; ++i) {
    int c4 = lane + 64 * i;
    float4 gg = g4[c4], s4 = sh[c4], l4 = sl[c4];
    float y0 = v[i].x * r * gg.x * (1.f + l4.x) + s4.x;
    float y1 = v[i].y * r * gg.y * (1.f + l4.y) + s4.y;
    float y2 = v[i].z * r * gg.z * (1.f + l4.z) + s4.z;
    float y3 = v[i].w * r * gg.w * (1.f + l4.w) + s4.w;
    uint2 pk;
    pk.x = pack2(y0, y1);
    pk.y = pack2(y2, y3);
    *(uint2*)(H + (size_t)row * 1024 + c4 * 4) = pk;
  }
}

__device__ void phaseA(const Params& p, int l, char* smem) {
  const int nb = gridDim.x, bid = blockIdx.x;
  float* tl = (float*)smem;
  bf16_t* Win = (bf16_t*)(p.ws + OFF_WIN);
  bf16_t* Wout = (bf16_t*)(p.ws + OFF_WOUT);
  bf16_t* Wgu = (bf16_t*)(p.ws + OFF_WGU);
  bf16_t* Wdn = (bf16_t*)(p.ws + OFF_WDN);
  bf16_t* Wq = (bf16_t*)(p.ws + OFF_WQUP);
  bf16_t* Wkv = (bf16_t*)(p.ws + OFF_WKVUP);
  constexpr int T0 = 16 * 52, T1 = T0 + 256, T2 = T1 + 704, T3 = T2 + 704, T4 = T3 + 704, T5 = T4 + 24, T6 = T5 + 16;
  constexpr int NORM_ITEMS = M_ALL / 4;
  for (int it = bid; it < T6 + NORM_ITEMS; it += nb) {
    if (it < T6) {
      const float* src;
      const float* gs = nullptr;
      bf16_t* dst;
      int K, N, mode = 0, ntn, i;
      if (it < T0) {
        i = it; src = p.w_in + (size_t)l * 1024 * INW; K = 1024; N = INW; dst = Win; ntn = 52;
      } else if (it < T1) {
        i = it - T0; src = p.w_out + (size_t)l * 1024 * 1024; K = 1024; N = 1024; dst = Wout; ntn = 16;
      } else if (it < T2) {
        i = it - T1; src = p.w_gate + (size_t)l * 1024 * FFN; K = 1024; N = FFN; dst = Wgu; ntn = 44; mode = 1;
      } else if (it < T3) {
        i = it - T2; src = p.w_up + (size_t)l * 1024 * FFN; K = 1024; N = FFN; dst = Wgu; ntn = 44; mode = 2;
      } else if (it < T4) {
        i = it - T3; src = p.w_down + (size_t)l * FFN * 1024; K = FFN; N = 1024; dst = Wdn; ntn = 16;
      } else if (it < T5) {
        i = it - T4; src = p.w_qup + (size_t)l * 256 * 384; K = 256; N = 384; dst = Wq; ntn = 6; gs = p.g_q + l * 256;
      } else {
        i = it - T5; src = p.w_kvup + (size_t)l * 128 * 512; K = 128; N = 512; dst = Wkv; ntn = 8; gs = p.g_kv + l * 128;
      }
      convT_tile(src, K, N, dst, mode, gs, i / ntn, i % ntn, tl);
    } else {
      norm_rows((const float*)(p.ws + OFF_X), (bf16_t*)(p.ws + OFF_HM), p.g_mix + l * 1024,
                (const float*)(p.ws + OFF_MOD) + (size_t)l * 9 * 6144, 0, 1, it - T6);
    }
  }
}

enum { EPI_P = 0, EPI_QUP = 1, EPI_KVUP = 2, EPI_RES = 3, EPI_GU = 4 };

template <int EPI>
__device__ void gemm_tile(const Params& p, int l, const bf16_t* __restrict__ A, int lda,
                          const bf16_t* __restrict__ BT, int K, int m0, int n0, int gate_i, char* smem) {
  bf16_t* sA = (bf16_t*)smem;
  bf16_t* sB = sA + 128 * 72;
  float* rsv = (float*)(smem + 2 * 128 * 72 * 2);
  const int tid = otid(), lane = tid & 63, w = tid >> 6, wm = w >> 1, wn = w & 1;
  const int lr = tid >> 3, lc = (tid & 7) * 8;
  __syncthreads();
  if (EPI == EPI_QUP || EPI == EPI_KVUP) {
    const int row = tid >> 1, hf = tid & 1;
    const int n8 = K / 16;
    const uint4* ap = (const uint4*)(A + (size_t)(m0 + row) * lda + hf * (K / 2));
    float ss = 0.f;
    for (int i = 0; i < n8; ++i) {
      uint4 u = ap[i];
      float a0 = bflo(u.x), a1 = bfhi(u.x), a2 = bflo(u.y), a3 = bfhi(u.y), a4 = bflo(u.z), a5 = bfhi(u.z),
            a6 = bflo(u.w), a7 = bfhi(u.w);
      ss += a0 * a0 + a1 * a1 + a2 * a2 + a3 * a3 + a4 * a4 + a5 * a5 + a6 * a6 + a7 * a7;
    }
    ss += __shfl_xor(ss, 1);
    if (hf == 0) rsv[row] = rsqrtf(ss / (float)K + 1e-6f);
  }
  const bf16_t* Ap = A + (size_t)(m0 + lr) * lda + lc;
  const bf16_t* Bp = BT + (size_t)(n0 + lr) * K + lc;
  uint4 ra0, ra1, ra2, ra3, rb0, rb1, rb2, rb3;
  ra0 = *(const uint4*)(Ap);
  ra1 = *(const uint4*)(Ap + (size_t)32 * lda);
  ra2 = *(const uint4*)(Ap + (size_t)64 * lda);
  ra3 = *(const uint4*)(Ap + (size_t)96 * lda);
  rb0 = *(const uint4*)(Bp);
  rb1 = *(const uint4*)(Bp + (size_t)32 * K);
  rb2 = *(const uint4*)(Bp + (size_t)64 * K);
  rb3 = *(const uint4*)(Bp + (size_t)96 * K);
  f32x16 acc[2][2];
#pragma unroll
  for (int i = 0; i < 2; ++i)
#pragma unroll
    for (int j = 0; j < 2; ++j)
#pragma unroll
      for (int r = 0; r < 16; ++r) acc[i][j][r] = 0.f;
  const int nk = K / 64;
  for (int kt = 0; kt < nk; ++kt) {
    __syncthreads();
    *(uint4*)(sA + (lr + 0) * 72 + lc) = ra0;
    *(uint4*)(sA + (lr + 32) * 72 + lc) = ra1;
    *(uint4*)(sA + (lr + 64) * 72 + lc) = ra2;
    *(uint4*)(sA + (lr + 96) * 72 + lc) = ra3;
    *(uint4*)(sB + (lr + 0) * 72 + lc) = rb0;
    *(uint4*)(sB + (lr + 32) * 72 + lc) = rb1;
    *(uint4*)(sB + (lr + 64) * 72 + lc) = rb2;
    *(uint4*)(sB + (lr + 96) * 72 + lc) = rb3;
    __syncthreads();
    if (kt + 1 < nk) {
      Ap += 64;
      Bp += 64;
      ra0 = *(const uint4*)(Ap);
      ra1 = *(const uint4*)(Ap + (size_t)32 * lda);
      ra2 = *(const uint4*)(Ap + (size_t)64 * lda);
      ra3 = *(const uint4*)(Ap + (size_t)96 * lda);
      rb0 = *(const uint4*)(Bp);
      rb1 = *(const uint4*)(Bp + (size_t)32 * K);
      rb2 = *(const uint4*)(Bp + (size_t)64 * K);
      rb3 = *(const uint4*)(Bp + (size_t)96 * K);
    }
#pragma unroll
    for (int ks = 0; ks < 4; ++ks) {
      const int ko = ks * 16 + (lane >> 5) * 8;
      bf16x8 a0 = *(const bf16x8*)(sA + (wm * 64 + (lane & 31)) * 72 + ko);
      bf16x8 a1 = *(const bf16x8*)(sA + (wm * 64 + 32 + (lane & 31)) * 72 + ko);
      bf16x8 b0 = *(const bf16x8*)(sB + (wn * 64 + (lane & 31)) * 72 + ko);
      bf16x8 b1 = *(const bf16x8*)(sB + (wn * 64 + 32 + (lane & 31)) * 72 + ko);
      acc[0][0] = __builtin_amdgcn_mfma_f32_32x32x16_bf16(a0, b0, acc[0][0], 0, 0, 0);
      acc[0][1] = __builtin_amdgcn_mfma_f32_32x32x16_bf16(a0, b1, acc[0][1], 0, 0, 0);
      acc[1][0] = __builtin_amdgcn_mfma_f32_32x32x16_bf16(a1, b0, acc[1][0], 0, 0, 0);
      acc[1][1] = __builtin_amdgcn_mfma_f32_32x32x16_bf16(a1, b1, acc[1][1], 0, 0, 0);
    }
  }
  const int ci = lane & 31;
  const int rbase = m0 + wm * 64 + 4 * (lane >> 5);
  const int cbase = n0 + wn * 64;
  if (EPI == EPI_P) {
    bf16_t* P = (bf16_t*)(p.ws + OFF_P);
    float* AB = (float*)(p.ws + OFF_AB);
#pragma unroll
    for (int mt = 0; mt < 2; ++mt)
#pragma unroll
      for (int nt = 0; nt < 2; ++nt)
#pragma unroll
        for (int r = 0; r < 16; ++r) {
          int row = rbase + mt * 32 + (r & 3) + 8 * (r >> 2);
          int col = cbase + nt * 32 + ci;
          float v = acc[mt][nt][r];
          P[(size_t)row * INWP + col] = f2bf(v);
          if (col >= C_DA && col < C_DA + 16) AB[(size_t)row * 16 + col - C_DA] = v;
        }
  } else if (EPI == EPI_QUP) {
    bf16_t* QH = (bf16_t*)(p.ws + OFF_QH);
    const float* rc = (const float*)(p.ws + OFF_ROPE);
    const float* rsn = rc + 2048 * 16;
#pragma unroll
    for (int mt = 0; mt < 2; ++mt)
#pragma unroll
      for (int nt = 0; nt < 2; ++nt) {
        const int base = cbase + nt * 32;
        const bool rope = ((base % 96) == 64) && (m0 < M_LAT);
#pragma unroll
        for (int r = 0; r < 16; ++r) {
          int row = rbase + mt * 32 + (r & 3) + 8 * (r >> 2);
          float v = acc[mt][nt][r] * rsv[row - m0];
          float o = __shfl_xor(v, 8);
          if (rope) {
            int t = row & 2047;
            int a = ci >> 4, hf = (ci >> 3) & 1, j = ci & 7;
            float c = rc[t * 16 + a * 8 + j], s = rsn[t * 16 + a * 8 + j];
            v = hf ? (o * s + v * c) : (v * c - o * s);
          }
          QH[(size_t)row * 384 + base + ci] = f2bf(v);
        }
      }
  } else if (EPI == EPI_KVUP) {
    bf16_t* KA = (bf16_t*)(p.ws + OFF_KH);
    bf16_t* VT = (bf16_t*)(p.ws + OFF_VH);
#pragma unroll
    for (int mt = 0; mt < 2; ++mt)
#pragma unroll
      for (int nt = 0; nt < 2; ++nt) {
        const int base = cbase + nt * 32;
        const int h = base >> 7, cc = (base & 127) + ci;
#pragma unroll
        for (int g = 0; g < 4; ++g) {
          const int row0 = rbase + mt * 32 + 8 * g;
          int bb, key0;
          if (row0 < M_LAT) { bb = row0 >> 11; key0 = 256 + (row0 & 2047); }
          else { bb = (row0 - M_LAT) >> 8; key0 = (row0 - M_LAT) & 255; }
          float v0 = acc[mt][nt][4 * g + 0] * rsv[row0 - m0 + 0];
          float v1 = acc[mt][nt][4 * g + 1] * rsv[row0 - m0 + 1];
          float v2 = acc[mt][nt][4 * g + 2] * rsv[row0 - m0 + 2];
          float v3 = acc[mt][nt][4 * g + 3] * rsv[row0 - m0 + 3];
          if (cc < 64) {
            bf16_t* kp = KA + ((size_t)(bb * 4 + h) * 2304 + key0) * 96 + cc;
            kp[0] = f2bf(v0); kp[96] = f2bf(v1); kp[192] = f2bf(v2); kp[288] = f2bf(v3);
          } else {
            uint2 u;
            u.x = pack2(v0, v1);
            u.y = pack2(v2, v3);
            *(uint2*)(VT + ((size_t)(bb * 4 + h) * 64 + (cc - 64)) * 2304 + key0) = u;
          }
        }
      }
  } else if (EPI == EPI_RES) {
    float* X = (float*)(p.ws + OFF_X);
    const float* modl = (const float*)(p.ws + OFF_MOD) + (size_t)l * 9 * 6144 + gate_i * 1024;
#pragma unroll
    for (int mt = 0; mt < 2; ++mt)
#pragma unroll
      for (int nt = 0; nt < 2; ++nt)
#pragma unroll
        for (int r = 0; r < 16; ++r) {
          int row = rbase + mt * 32 + (r & 3) + 8 * (r >> 2);
          int col = cbase + nt * 32 + ci;
          int b = row < M_LAT ? (row >> 11) : 8;
          float g = modl[b * 6144 + col];
          size_t idx = (size_t)row * 1024 + col;
          X[idx] = X[idx] + g * acc[mt][nt][r];
        }
  } else if (EPI == EPI_GU) {
    bf16_t* ACT = (bf16_t*)(p.ws + OFF_P);
#pragma unroll
    for (int mt = 0; mt < 2; ++mt)
#pragma unroll
      for (int r = 0; r < 16; ++r) {
        int row = rbase + mt * 32 + (r & 3) + 8 * (r >> 2);
        float gt = acc[mt][0][r], up = acc[mt][1][r];
        float a = silu_f(gt) * up;
        ACT[(size_t)row * FFN + (cbase >> 6) * 32 + ci] = f2bf(a);
      }
  }
}

__device__ void kpe_item(const Params& p, int it) {
  const int tid = otid();
  const bf16_t* P = (const bf16_t*)(p.ws + OFF_P);
  bf16_t* KH = (bf16_t*)(p.ws + OFF_KH);
  const float* rc = (const float*)(p.ws + OFF_ROPE);
  const float* rsn = rc + 2048 * 16;
  const int row = it * 8 + (tid >> 5), i = tid & 31;
  float v = bf2f(P[(size_t)row * INWP + C_MPE + i]);
  float o = __shfl_xor(v, 8);
  if (row < M_LAT) {
    int t = row & 2047;
    int a = i >> 4, hf = (i >> 3) & 1, j = i & 7;
    float c = rc[t * 16 + a * 8 + j], s = rsn[t * 16 + a * 8 + j];
    v = hf ? (o * s + v * c) : (v * c - o * s);
  }
  bf16_t bv = f2bf(v);
  int bb, key;
  if (row < M_LAT) { bb = row >> 11; key = 256 + (row & 2047); }
  else { bb = (row - M_LAT) >> 8; key = (row - M_LAT) & 255; }
#pragma unroll
  for (int h = 0; h < 4; ++h) KH[((size_t)(bb * 4 + h) * 2304 + key) * 96 + 64 + i] = bv;
}

__device__ void dn_prep(const Params& p, int l, int it, char* smem) {
  float* buf = (float*)smem;
  float* nrm = buf + 8 * 1536;
  const int tid = otid();
  const bf16_t* P = (const bf16_t*)(p.ws + OFF_P);
  bf16_t* DQ = (bf16_t*)(p.ws + OFF_DNQKV);
  const int r0 = it * 8;
  int seq_lo, seq_hi;
  if (r0 < M_LAT) {
    seq_lo = (r0 >> 11) << 11;
    seq_hi = seq_lo + 2048;
  } else {
    int rr = r0 - M_LAT;
    seq_lo = M_LAT + ((rr >> 8) << 8);
    seq_hi = seq_lo + 256;
  }
  const float* cw = p.conv_w + (size_t)l * 5 * 1536;
  __syncthreads();
  for (int c6 = 0; c6 < 6; ++c6) {
    const int ch = c6 * 256 + tid;
    float w0 = cw[ch], w1 = cw[1536 + ch], w2 = cw[2 * 1536 + ch], w3 = cw[3 * 1536 + ch], w4 = cw[4 * 1536 + ch];
    float xw[12];
#pragma unroll
    for (int j = 0; j < 12; ++j) {
      int r = r0 - 2 + j;
      xw[j] = (r >= seq_lo && r < seq_hi) ? bf2f(P[(size_t)r * INWP + C_DN + ch]) : 0.f;
    }
#pragma unroll
    for (int j = 0; j < 8; ++j) {
      float y = w0 * xw[j] + w1 * xw[j + 1] + w2 * xw[j + 2] + w3 * xw[j + 3] + w4 * xw[j + 4];
      buf[j * 1536 + ch] = silu_f(y);
    }
  }
  __syncthreads();
  {
    int vec = tid >> 2, part = tid & 3;
    int rr = vec >> 3, hv = vec & 7;
    const float* v = buf + rr * 1536 + hv * 128 + part * 32;
    float ss = 0.f;
#pragma unroll
    for (int i = 0; i < 32; ++i) ss += v[i] * v[i];
    ss += __shfl_xor(ss, 1);
    ss += __shfl_xor(ss, 2);
    if (part == 0) nrm[vec] = rsqrtf(ss + 1e-6f);
  }
  __syncthreads();
  for (int i = tid; i < 8 * 1536; i += 256) {
    int rr = i / 1536, ch = i - rr * 1536;
    float v = buf[i];
    if (ch < 1024) v *= nrm[rr * 8 + (ch >> 7)];
    DQ[(size_t)(r0 + rr) * 1536 + ch] = f2bf(v);
  }
}


DEVI int rowmap(int r, int hh) { return (r & 3) + 8 * (r >> 2) + 4 * hh; }

__device__ void dn_chunk_prep(const Params& p, int l, int item, char* smem) {
  float* tile = (float*)smem;
  float* sL0 = (float*)smem;
  float* sL1 = sL0 + 64 * 68;
  bf16_t* sKb = (bf16_t*)(smem + 34816);
  float* sg = (float*)(smem + 52224);
  float* sbt = sg + 128;
  const int tid = otid(), lane = tid & 63, w = tid >> 6, li = lane & 31, hh = lane >> 5;
  const int chunk = item >> 2, h = item & 3;
  int row0, seq_lo, seq_hi;
  if (chunk < 256) {
    int b = chunk >> 5;
    row0 = b * 2048 + (chunk & 31) * 64; seq_lo = b * 2048; seq_hi = seq_lo + 2048;
  } else {
    int cc = chunk - 256, b = cc >> 2;
    row0 = M_LAT + b * 256 + (cc & 3) * 64; seq_lo = M_LAT + b * 256; seq_hi = seq_lo + 256;
  }
  const bf16_t* P = (const bf16_t*)(p.ws + OFF_P);
  bf16_t* DQ = (bf16_t*)(p.ws + OFF_DNQKV);
  const float* AB = (const float*)(p.ws + OFF_AB);
  const float* cw = p.conv_w + (size_t)l * 5 * 1536;
  __syncthreads();
  if (w < 2) {
    const int d = w;
    const int row = d ? (row0 + 63 - lane) : (row0 + lane);
    const float Aneg = -__expf(p.a_log[l * 8 + d * 4 + h]);
    const float dtb = p.dt_bias[l * 8 + d * 4 + h];
    float a = AB[(size_t)row * 16 + d * 4 + h];
    float bb = AB[(size_t)row * 16 + 8 + d * 4 + h];
    float xx = a + dtb;
    float sp = xx > 20.f ? xx : log1pf(__expf(xx));
    float g = Aneg * sp;
#pragma unroll
    for (int o = 1; o < 64; o <<= 1) {
      float y = __shfl_up(g, o);
      if (lane >= o) g += y;
    }
    float be = 1.f / (1.f + __expf(-bb));
    sg[d * 64 + lane] = g;
    sbt[d * 64 + lane] = be;
    ((float*)(p.ws + OFF_GC))[(size_t)row * 8 + d * 4 + h] = g;
    ((float*)(p.ws + OFF_BETA))[(size_t)row * 8 + d * 4 + h] = be;
  }
  const int c = tid & 127, rh = tid >> 7;
  for (int pass = 0; pass < 3; ++pass) {
    const int off = pass == 0 ? 512 : (pass == 1 ? 0 : 1024);
    const int ch = off + h * 128 + c;
    const float w0 = cw[ch], w1 = cw[1536 + ch], w2 = cw[2 * 1536 + ch], w3 = cw[3 * 1536 + ch], w4 = cw[4 * 1536 + ch];
    float x0, x1, x2, x3, x4;
    {
      const int rb = row0 + rh * 32 - 2;
      x0 = (rb + 0 >= seq_lo) ? bf2f(P[(size_t)(rb + 0) * INWP + C_DN + ch]) : 0.f;
      x1 = (rb + 1 >= seq_lo) ? bf2f(P[(size_t)(rb + 1) * INWP + C_DN + ch]) : 0.f;
      x2 = bf2f(P[(size_t)(rb + 2) * INWP + C_DN + ch]);
      x3 = bf2f(P[(size_t)(rb + 3) * INWP + C_DN + ch]);
    }
#pragma unroll 8
    for (int j = 0; j < 32; ++j) {
      const int r = row0 + rh * 32 + j + 2;
      x4 = (r < seq_hi) ? bf2f(P[(size_t)r * INWP + C_DN + ch]) : 0.f;
      float y = w0 * x0 + w1 * x1 + w2 * x2 + w3 * x3 + w4 * x4;
      y = silu_f(y);
      if (pass == 2)
        DQ[(size_t)(row0 + rh * 32 + j) * 1536 + ch] = f2bf(y);
      else
        tile[(rh * 32 + j) * 129 + c] = y;
      x0 = x1; x1 = x2; x2 = x3; x3 = x4;
    }
    if (pass < 2) {
      __syncthreads();
      const int row = tid >> 2, part = tid & 3;
      const float* tv = tile + row * 129 + part * 32;
      float ss = 0.f;
#pragma unroll
      for (int i = 0; i < 32; ++i) ss += tv[i] * tv[i];
      ss += __shfl_xor(ss, 1);
      ss += __shfl_xor(ss, 2);
      const float rn = rsqrtf(ss + 1e-6f);
      bf16_t* gp = DQ + (size_t)(row0 + row) * 1536 + off + h * 128 + part * 32;
#pragma unroll
      for (int i8 = 0; i8 < 4; ++i8) {
        uint4 u;
        u.x = pack2(tv[i8 * 8 + 0] * rn, tv[i8 * 8 + 1] * rn);
        u.y = pack2(tv[i8 * 8 + 2] * rn, tv[i8 * 8 + 3] * rn);
        u.z = pack2(tv[i8 * 8 + 4] * rn, tv[i8 * 8 + 5] * rn);
        u.w = pack2(tv[i8 * 8 + 6] * rn, tv[i8 * 8 + 7] * rn);
        *(uint4*)(gp + i8 * 8) = u;
        if (pass == 0) *(uint4*)(sKb + row * 136 + part * 32 + i8 * 8) = u;
      }
      __syncthreads();
    }
  }
  __syncthreads();
  {
    const int mi = w >> 1, ni = w & 1;
    f32x16 g;
#pragma unroll
    for (int r = 0; r < 16; ++r) g[r] = 0.f;
#pragma unroll
    for (int ks = 0; ks < 8; ++ks) {
      bf16x8 a = *(const bf16x8*)(sKb + (mi * 32 + li) * 136 + ks * 16 + hh * 8);
      bf16x8 b = *(const bf16x8*)(sKb + (ni * 32 + li) * 136 + ks * 16 + hh * 8);
      g = __builtin_amdgcn_mfma_f32_32x32x16_bf16(a, b, g, 0, 0, 0);
    }
#pragma unroll
    for (int r = 0; r < 16; ++r) {
      const int i = mi * 32 + rowmap(r, hh), m = ni * 32 + li;
      const float G = g[r];
      sL0[i * 68 + m] = (i > m) ? sbt[i] * G * __expf(sg[i] - sg[m]) : 0.f;
      const int i1 = 63 - i, m1 = 63 - m;
      sL1[i1 * 68 + m1] = (i1 > m1) ? sbt[64 + i1] * G * __expf(sg[64 + i1] - sg[64 + m1]) : 0.f;
    }
  }
  __syncthreads();
  if (w < 2) {
    const float* L = w == 0 ? sL0 : sL1;
    float t[64];
#pragma unroll
    for (int i = 0; i < 64; ++i) {
      float acc = (i == lane) ? 1.f : 0.f;
#pragma unroll
      for (int m = 0; m < i; ++m) acc -= L[i * 68 + m] * t[m];
      t[i] = acc;
    }
    bf16_t* Tg = (bf16_t*)(p.ws + OFF_OB) + (size_t)((chunk * 4 + h) * 2 + w) * 4096;
#pragma unroll
    for (int i = 0; i < 64; ++i) Tg[i * 64 + lane] = f2bf(t[i]);
  }
}

DEVI bf16x8 ld_perm(const bf16_t* p) {
  union { bf16x8 v; uint2 d[2]; } u;
  u.d[0] = *(const uint2*)(p);
  u.d[1] = *(const uint2*)(p + 8);
  return u.v;
}
DEVI bf16x8 pack8(const f32x16& x, int s) {
  union { bf16x8 v; unsigned w[4]; } u;
  u.w[0] = pack2(x[8 * s + 0], x[8 * s + 1]);
  u.w[1] = pack2(x[8 * s + 2], x[8 * s + 3]);
  u.w[2] = pack2(x[8 * s + 4], x[8 * s + 5]);
  u.w[3] = pack2(x[8 * s + 6], x[8 * s + 7]);
  return u.v;
}

__device__ void dn_scan(const Params& p, int l, int item, char* smem) {
  bf16_t* sK = (bf16_t*)smem;
  bf16_t* sQ = (bf16_t*)(smem + 17408);
  bf16_t* sKT = (bf16_t*)(smem + 34816);
  bf16_t* sT = (bf16_t*)(smem + 52224);
  bf16_t* sA = (bf16_t*)(smem + 60928);
  float* sg = (float*)(smem + 69632);
  float* sbt = sg + 64;
  float* seg = sbt + 64;
  float* sdt = seg + 64;
  const int d = item & 1, h = (item >> 1) & 3, b = item >> 3;
  const bf16_t* DQ = (const bf16_t*)(p.ws + OFF_DNQKV);
  const bf16_t* TB = (const bf16_t*)(p.ws + OFF_OB);
  const float* GC = (const float*)(p.ws + OFF_GC);
  const float* BE = (const float*)(p.ws + OFF_BETA);
  bf16_t* MIX = (bf16_t*)(p.ws + OFF_HM);
  bf16_t* Pw = (bf16_t*)(p.ws + OFF_P);
  const float qscale = 0.08838834764831845f;
  f32x16 S0, S1, S2, S3;
#pragma unroll
  for (int r = 0; r < 16; ++r) { S0[r] = 0.f; S1[r] = 0.f; S2[r] = 0.f; S3[r] = 0.f; }
  for (int n = 0; n < 36; ++n) {
    const int tid = otid(), lane = tid & 63, w = tid >> 6, li = lane & 31, hh = lane >> 5;
    int chunk, row0;
    if (n < 4) {
      int cn = d ? (3 - n) : n;
      chunk = 256 + b * 4 + cn; row0 = M_LAT + b * 256 + cn * 64;
    } else {
      int ln = n - 4;
      ln = d ? (31 - ln) : ln;
      chunk = b * 32 + ln; row0 = b * 2048 + ln * 64;
    }
    __syncthreads();
#pragma unroll
    for (int e = 0; e < 4; ++e) {
      const int idx = tid + 256 * e, tok = idx >> 4, c8 = idx & 15;
      const int row = d ? (row0 + 63 - tok) : (row0 + tok);
      const bf16_t* gp = DQ + (size_t)row * 1536 + h * 128 + c8 * 8;
      uint4 uq = *(const uint4*)(gp);
      uint4 uk = *(const uint4*)(gp + 512);
      *(uint4*)(sQ + tok * 136 + c8 * 8) = uq;
      *(uint4*)(sK + tok * 136 + c8 * 8) = uk;
      bf16_t* kt = sKT + (c8 * 8) * 68 + tok;
      kt[0 * 68] = (bf16_t)(uk.x & 0xffff); kt[1 * 68] = (bf16_t)(uk.x >> 16);
      kt[2 * 68] = (bf16_t)(uk.y & 0xffff); kt[3 * 68] = (bf16_t)(uk.y >> 16);
      kt[4 * 68] = (bf16_t)(uk.z & 0xffff); kt[5 * 68] = (bf16_t)(uk.z >> 16);
      kt[6 * 68] = (bf16_t)(uk.w & 0xffff); kt[7 * 68] = (bf16_t)(uk.w >> 16);
    }
    {
      const bf16_t* Tg = TB + (size_t)((chunk * 4 + h) * 2 + d) * 4096;
#pragma unroll
      for (int e = 0; e < 2; ++e) {
        const int idx = tid + 256 * e, i = idx >> 3, c8 = idx & 7;
        uint4 u = *(const uint4*)(Tg + i * 64 + c8 * 8);
        *(uint2*)(sT + i * 68 + c8 * 8) = make_uint2(u.x, u.y);
        *(uint2*)(sT + i * 68 + c8 * 8 + 4) = make_uint2(u.z, u.w);
      }
    }
    if (w == 0) {
      const int row = d ? (row0 + 63 - lane) : (row0 + lane);
      float gc = GC[(size_t)row * 8 + d * 4 + h];
      float be = BE[(size_t)row * 8 + d * 4 + h];
      float g63 = __shfl(gc, 63);
      sg[lane] = gc;
      sbt[lane] = be;
      seg[lane] = __expf(gc);
      sdt[lane] = __expf(g63 - gc);
    }
    f32x16 v0, v1;
    const int rsign = d ? -1 : 1;
    const int rfirst = (d ? (row0 + 63) : row0) + rsign * 4 * hh;
    const bf16_t* vbase = DQ + (size_t)rfirst * 1536 + 1024 + h * 128 + w * 32 + li;
    const int vstep = rsign * 1536;
#pragma unroll
    for (int r = 0; r < 16; ++r) {
      const int t0 = (r & 3) + 8 * (r >> 2);
      v0[r] = bf2f(vbase[(t0)*vstep]);
      v1[r] = bf2f(vbase[(32 + t0) * vstep]);
    }
    __syncthreads();
    {
      const int mi = w >> 1, ni = w & 1;
      f32x16 a;
#pragma unroll
      for (int r = 0; r < 16; ++r) a[r] = 0.f;
      if (!(mi == 0 && ni == 1)) {
#pragma unroll
        for (int ks = 0; ks < 8; ++ks) {
          bf16x8 qa = *(const bf16x8*)(sQ + (mi * 32 + li) * 136 + ks * 16 + hh * 8);
          bf16x8 kb = *(const bf16x8*)(sK + (ni * 32 + li) * 136 + ks * 16 + hh * 8);
          a = __builtin_amdgcn_mfma_f32_32x32x16_bf16(qa, kb, a, 0, 0, 0);
        }
      }
#pragma unroll
      for (int r = 0; r < 16; ++r) {
        const int i = mi * 32 + rowmap(r, hh), j = ni * 32 + li;
        float val = (i >= j) ? a[r] * qscale * __expf(sg[i] - sg[j]) : 0.f;
        sA[i * 68 + j] = f2bf(val);
      }
    }
    __syncthreads();
    f32x16 ks0, ks1;
#pragma unroll
    for (int r = 0; r < 16; ++r) { ks0[r] = 0.f; ks1[r] = 0.f; }
    {
      const bf16_t* ka = sK + li * 136 + 4 * hh;
#define K_STEP(OFFS, SX, SS)                                                                           \
  {                                                                                                    \
    bf16x8 sb = pack8(SX, SS);                                                                         \
    ks0 = __builtin_amdgcn_mfma_f32_32x32x16_bf16(ld_perm(ka + (OFFS)), sb, ks0, 0, 0, 0);             \
    ks1 = __builtin_amdgcn_mfma_f32_32x32x16_bf16(ld_perm(ka + 32 * 136 + (OFFS)), sb, ks1, 0, 0, 0);  \
  }
      K_STEP(0, S0, 0) K_STEP(16, S0, 1) K_STEP(32, S1, 0) K_STEP(48, S1, 1)
      K_STEP(64, S2, 0) K_STEP(80, S2, 1) K_STEP(96, S3, 0) K_STEP(112, S3, 1)
#undef K_STEP
    }
#pragma unroll
    for (int r = 0; r < 16; ++r) {
      const int t0 = rowmap(r, hh), t1 = 32 + t0;
      v0[r] = sbt[t0] * (v0[r] - seg[t0] * ks0[r]);
      v1[r] = sbt[t1] * (v1[r] - seg[t1] * ks1[r]);
    }
    __builtin_amdgcn_sched_barrier(0);
    bf16x8 rb00 = pack8(v0, 0), rb01 = pack8(v0, 1), rb10 = pack8(v1, 0), rb11 = pack8(v1, 1);
    f32x16 n0, n1;
#pragma unroll
    for (int r = 0; r < 16; ++r) { n0[r] = 0.f; n1[r] = 0.f; }
    {
      const bf16_t* ta = sT + li * 68 + 4 * hh;
      n0 = __builtin_amdgcn_mfma_f32_32x32x16_bf16(ld_perm(ta + 0), rb00, n0, 0, 0, 0);
      n0 = __builtin_amdgcn_mfma_f32_32x32x16_bf16(ld_perm(ta + 16), rb01, n0, 0, 0, 0);
      const bf16_t* tb = ta + 32 * 68;
      n1 = __builtin_amdgcn_mfma_f32_32x32x16_bf16(ld_perm(tb + 0), rb00, n1, 0, 0, 0);
      n1 = __builtin_amdgcn_mfma_f32_32x32x16_bf16(ld_perm(tb + 16), rb01, n1, 0, 0, 0);
      n1 = __builtin_amdgcn_mfma_f32_32x32x16_bf16(ld_perm(tb + 32), rb10, n1, 0, 0, 0);
      n1 = __builtin_amdgcn_mfma_f32_32x32x16_bf16(ld_perm(tb + 48), rb11, n1, 0, 0, 0);
    }
    __builtin_amdgcn_sched_barrier(0);
    f32x16 o0, o1;
#pragma unroll
    for (int r = 0; r < 16; ++r) { o0[r] = 0.f; o1[r] = 0.f; }
    {
      const bf16_t* qa = sQ + li * 136 + 4 * hh;
#define Q_STEP(OFFS, SX, SS)                                                                           \
  {                                                                                                    \
    bf16x8 sb = pack8(SX, SS);                                                                         \
    o0 = __builtin_amdgcn_mfma_f32_32x32x16_bf16(ld_perm(qa + (OFFS)), sb, o0, 0, 0, 0);               \
    o1 = __builtin_amdgcn_mfma_f32_32x32x16_bf16(ld_perm(qa + 32 * 136 + (OFFS)), sb, o1, 0, 0, 0);    \
  }
      Q_STEP(0, S0, 0) Q_STEP(16, S0, 1) Q_STEP(32, S1, 0) Q_STEP(48, S1, 1)
      Q_STEP(64, S2, 0) Q_STEP(80, S2, 1) Q_STEP(96, S3, 0) Q_STEP(112, S3, 1)
#undef Q_STEP
    }
#pragma unroll
    for (int r = 0; r < 16; ++r) {
      const int t0 = rowmap(r, hh), t1 = 32 + t0;
      o0[r] *= seg[t0] * qscale;
      o1[r] *= seg[t1] * qscale;
    }
    {
      bf16x8 nb00 = pack8(n0, 0), nb01 = pack8(n0, 1), nb10 = pack8(n1, 0), nb11 = pack8(n1, 1);
      const bf16_t* aa = sA + li * 68 + 4 * hh;
      o0 = __builtin_amdgcn_mfma_f32_32x32x16_bf16(ld_perm(aa + 0), nb00, o0, 0, 0, 0);
      o0 = __builtin_amdgcn_mfma_f32_32x32x16_bf16(ld_perm(aa + 16), nb01, o0, 0, 0, 0);
      const bf16_t* ab = aa + 32 * 68;
      o1 = __builtin_amdgcn_mfma_f32_32x32x16_bf16(ld_perm(ab + 0), nb00, o1, 0, 0, 0);
      o1 = __builtin_amdgcn_mfma_f32_32x32x16_bf16(ld_perm(ab + 16), nb01, o1, 0, 0, 0);
      o1 = __builtin_amdgcn_mfma_f32_32x32x16_bf16(ld_perm(ab + 32), nb10, o1, 0, 0, 0);
      o1 = __builtin_amdgcn_mfma_f32_32x32x16_bf16(ld_perm(ab + 48), nb11, o1, 0, 0, 0);
    }
    bf16_t* obase = d ? (Pw + (size_t)rfirst * INWP + C_DN + h * 128 + w * 32 + li)
                      : (MIX + (size_t)rfirst * 1024 + 512 + h * 128 + w * 32 + li);
    const int ostep = d ? -INWP : 1024;
#pragma unroll
    for (int r = 0; r < 16; ++r) {
      const int t0 = (r & 3) + 8 * (r >> 2);
      obase[(t0)*ostep] = f2bf(o0[r]);
      obase[(32 + t0) * ostep] = f2bf(o1[r]);
    }
    __builtin_amdgcn_sched_barrier(0);
#pragma unroll
    for (int r = 0; r < 16; ++r) {
      const int t0 = rowmap(r, hh), t1 = 32 + t0;
      n0[r] *= sdt[t0];
      n1[r] *= sdt[t1];
    }
    {
      bf16x8 nb00 = pack8(n0, 0), nb01 = pack8(n0, 1), nb10 = pack8(n1, 0), nb11 = pack8(n1, 1);
      const float eg63 = seg[63];
#pragma unroll
      for (int r = 0; r < 16; ++r) { S0[r] *= eg63; S1[r] *= eg63; S2[r] *= eg63; S3[r] *= eg63; }
      const bf16_t* kt = sKT + li * 68 + 4 * hh;
#define S_UPD(SX, DKT)                                                                                   \
  SX = __builtin_amdgcn_mfma_f32_32x32x16_bf16(ld_perm(kt + (DKT) * 32 * 68 + 0), nb00, SX, 0, 0, 0);    \
  SX = __builtin_amdgcn_mfma_f32_32x32x16_bf16(ld_perm(kt + (DKT) * 32 * 68 + 16), nb01, SX, 0, 0, 0);   \
  SX = __builtin_amdgcn_mfma_f32_32x32x16_bf16(ld_perm(kt + (DKT) * 32 * 68 + 32), nb10, SX, 0, 0, 0);   \
  SX = __builtin_amdgcn_mfma_f32_32x32x16_bf16(ld_perm(kt + (DKT) * 32 * 68 + 48), nb11, SX, 0, 0, 0);
      S_UPD(S0, 0) S_UPD(S1, 1) S_UPD(S2, 2) S_UPD(S3, 3)
#undef S_UPD
    }
  }
}

__device__ void phaseC(const Params& p, int l, char* smem) {
  const int nb = gridDim.x, bid = blockIdx.x;
  const bf16_t* P = (const bf16_t*)(p.ws + OFF_P);
  constexpr int T0 = 144 * 3, T1 = T0 + 144 * 4, T2 = T1 + M_ALL / 8, T3 = T2 + 1152;
  for (int it = bid; it < T3; it += nb) {
    if (it < T0) {
      int i = it;
      gemm_tile<EPI_QUP>(p, l, P + C_MQ, INWP, (const bf16_t*)(p.ws + OFF_WQUP), 256, (i / 3) * 128, (i % 3) * 128, 0,
                         smem);
    } else if (it < T1) {
      int i = it - T0;
      gemm_tile<EPI_KVUP>(p, l, P + C_MKV, INWP, (const bf16_t*)(p.ws + OFF_WKVUP), 128, (i / 4) * 128, (i % 4) * 128,
                          0, smem);
    } else if (it < T2) {
      kpe_item(p, it - T1);
    } else {
      dn_chunk_prep(p, l, it - T2, smem);
    }
  }
}

__device__ void mla_flash(const Params& p, int item, char* smem) {
  bf16_t* sK = (bf16_t*)smem;
  bf16_t* sV = sK + 64 * 104;
  const int tid = otid(), lane = tid & 63, w = tid >> 6;
  const int li = lane & 31, hh = lane >> 5;
  int b, h, q0row, nkeys;
  if (item < 512) {
    b = item >> 6; h = (item >> 4) & 3; q0row = b * 2048 + (item & 15) * 128; nkeys = 2304;
  } else {
    int i = item - 512;
    b = i >> 3; h = (i >> 1) & 3; q0row = M_LAT + b * 256 + (i & 1) * 128; nkeys = 256;
  }
  const bf16_t* Kg = (const bf16_t*)(p.ws + OFF_KH) + (size_t)(b * 4 + h) * 2304 * 96;
  const bf16_t* Vg = (const bf16_t*)(p.ws + OFF_VH) + (size_t)(b * 4 + h) * 64 * 2304;
  const bf16_t* QH = (const bf16_t*)(p.ws + OFF_QH);
  bf16_t* MIX = (bf16_t*)(p.ws + OFF_HM);
  const int qrow = q0row + w * 32 + li;
  bf16x8 qf0, qf1, qf2, qf3, qf4, qf5;
  {
    const bf16_t* qp = QH + (size_t)qrow * 384 + h * 96 + hh * 8;
    qf0 = *(const bf16x8*)(qp); qf1 = *(const bf16x8*)(qp + 16); qf2 = *(const bf16x8*)(qp + 32);
    qf3 = *(const bf16x8*)(qp + 48); qf4 = *(const bf16x8*)(qp + 64); qf5 = *(const bf16x8*)(qp + 80);
  }
  const int k_i0 = tid, k_i1 = tid + 256, k_i2 = tid + 512;
  const int kk0 = k_i0 / 12, kc0 = k_i0 % 12, kk1 = k_i1 / 12, kc1 = k_i1 % 12, kk2 = k_i2 / 12, kc2 = k_i2 % 12;
  const int vd0 = tid >> 3, vc0 = tid & 7, vd1 = vd0 + 32;
  uint4 rk0, rk1, rk2, rv0, rv1;
  rk0 = *(const uint4*)(Kg + (size_t)kk0 * 96 + kc0 * 8);
  rk1 = *(const uint4*)(Kg + (size_t)kk1 * 96 + kc1 * 8);
  rk2 = *(const uint4*)(Kg + (size_t)kk2 * 96 + kc2 * 8);
  rv0 = *(const uint4*)(Vg + (size_t)vd0 * 2304 + vc0 * 8);
  rv1 = *(const uint4*)(Vg + (size_t)vd1 * 2304 + vc0 * 8);
  f32x16 o0, o1;
#pragma unroll
  for (int r = 0; r < 16; ++r) { o0[r] = 0.f; o1[r] = 0.f; }
  float m = -1e30f, lp = 0.f;
  const float sc = 0.10206207261596577f * 1.4426950408889634f;
  const int nt = nkeys >> 6;
  for (int t = 0; t < nt; ++t) {
    __syncthreads();
    *(uint4*)(sK + kk0 * 104 + kc0 * 8) = rk0;
    *(uint4*)(sK + kk1 * 104 + kc1 * 8) = rk1;
    *(uint4*)(sK + kk2 * 104 + kc2 * 8) = rk2;
    *(uint2*)(sV + vd0 * 68 + vc0 * 8) = make_uint2(rv0.x, rv0.y);
    *(uint2*)(sV + vd0 * 68 + vc0 * 8 + 4) = make_uint2(rv0.z, rv0.w);
    *(uint2*)(sV + vd1 * 68 + vc0 * 8) = make_uint2(rv1.x, rv1.y);
    *(uint2*)(sV + vd1 * 68 + vc0 * 8 + 4) = make_uint2(rv1.z, rv1.w);
    __syncthreads();
    if (t + 1 < nt) {
      const int k0 = (t + 1) * 64;
      rk0 = *(const uint4*)(Kg + (size_t)(k0 + kk0) * 96 + kc0 * 8);
      rk1 = *(const uint4*)(Kg + (size_t)(k0 + kk1) * 96 + kc1 * 8);
      rk2 = *(const uint4*)(Kg + (size_t)(k0 + kk2) * 96 + kc2 * 8);
      rv0 = *(const uint4*)(Vg + (size_t)vd0 * 2304 + k0 + vc0 * 8);
      rv1 = *(const uint4*)(Vg + (size_t)vd1 * 2304 + k0 + vc0 * 8);
    }
    f32x16 s0, s1;
#pragma unroll
    for (int r = 0; r < 16; ++r) { s0[r] = 0.f; s1[r] = 0.f; }
    {
      const bf16_t* ka = sK + li * 104 + hh * 8;
      const bf16_t* kb = ka + 32 * 104;
      s0 = __builtin_amdgcn_mfma_f32_32x32x16_bf16(*(const bf16x8*)(ka), qf0, s0, 0, 0, 0);
      s1 = __builtin_amdgcn_mfma_f32_32x32x16_bf16(*(const bf16x8*)(kb), qf0, s1, 0, 0, 0);
      s0 = __builtin_amdgcn_mfma_f32_32x32x16_bf16(*(const bf16x8*)(ka + 16), qf1, s0, 0, 0, 0);
      s1 = __builtin_amdgcn_mfma_f32_32x32x16_bf16(*(const bf16x8*)(kb + 16), qf1, s1, 0, 0, 0);
      s0 = __builtin_amdgcn_mfma_f32_32x32x16_bf16(*(const bf16x8*)(ka + 32), qf2, s0, 0, 0, 0);
      s1 = __builtin_amdgcn_mfma_f32_32x32x16_bf16(*(const bf16x8*)(kb + 32), qf2, s1, 0, 0, 0);
      s0 = __builtin_amdgcn_mfma_f32_32x32x16_bf16(*(const bf16x8*)(ka + 48), qf3, s0, 0, 0, 0);
      s1 = __builtin_amdgcn_mfma_f32_32x32x16_bf16(*(const bf16x8*)(kb + 48), qf3, s1, 0, 0, 0);
      s0 = __builtin_amdgcn_mfma_f32_32x32x16_bf16(*(const bf16x8*)(ka + 64), qf4, s0, 0, 0, 0);
      s1 = __builtin_amdgcn_mfma_f32_32x32x16_bf16(*(const bf16x8*)(kb + 64), qf4, s1, 0, 0, 0);
      s0 = __builtin_amdgcn_mfma_f32_32x32x16_bf16(*(const bf16x8*)(ka + 80), qf5, s0, 0, 0, 0);
      s1 = __builtin_amdgcn_mfma_f32_32x32x16_bf16(*(const bf16x8*)(kb + 80), qf5, s1, 0, 0, 0);
    }
    float mx = s0[0];
#pragma unroll
    for (int r = 1; r < 16; ++r) mx = fmaxf(mx, s0[r]);
#pragma unroll
    for (int r = 0; r < 16; ++r) mx = fmaxf(mx, s1[r]);
    mx = fmaxf(mx, __shfl_xor(mx, 32));
    const float mn = fmaxf(m, mx * sc);
    const float corr = __builtin_amdgcn_exp2f(m - mn);
    m = mn;
    lp *= corr;
#pragma unroll
    for (int r = 0; r < 16; ++r) { o0[r] *= corr; o1[r] *= corr; }
#pragma unroll
    for (int r = 0; r < 16; ++r) {
      s0[r] = __builtin_amdgcn_exp2f(s0[r] * sc - mn);
      s1[r] = __builtin_amdgcn_exp2f(s1[r] * sc - mn);
      lp += s0[r] + s1[r];
    }
#pragma unroll
    for (int u = 0; u < 2; ++u) {
#pragma unroll
      for (int s = 0; s < 2; ++s) {
        union { bf16x8 v; unsigned w[4]; } pb;
        if (u == 0) {
          pb.w[0] = pack2(s0[8 * s + 0], s0[8 * s + 1]); pb.w[1] = pack2(s0[8 * s + 2], s0[8 * s + 3]);
          pb.w[2] = pack2(s0[8 * s + 4], s0[8 * s + 5]); pb.w[3] = pack2(s0[8 * s + 6], s0[8 * s + 7]);
        } else {
          pb.w[0] = pack2(s1[8 * s + 0], s1[8 * s + 1]); pb.w[1] = pack2(s1[8 * s + 2], s1[8 * s + 3]);
          pb.w[2] = pack2(s1[8 * s + 4], s1[8 * s + 5]); pb.w[3] = pack2(s1[8 * s + 6], s1[8 * s + 7]);
        }
        const bf16_t* va = sV + li * 68 + 32 * u + 16 * s + 4 * hh;
        union { bf16x8 v; uint2 d[2]; } a0, a1;
        a0.d[0] = *(const uint2*)(va);
        a0.d[1] = *(const uint2*)(va + 8);
        a1.d[0] = *(const uint2*)(va + 32 * 68);
        a1.d[1] = *(const uint2*)(va + 32 * 68 + 8);
        o0 = __builtin_amdgcn_mfma_f32_32x32x16_bf16(a0.v, pb.v, o0, 0, 0, 0);
        o1 = __builtin_amdgcn_mfma_f32_32x32x16_bf16(a1.v, pb.v, o1, 0, 0, 0);
      }
    }
  }
  lp += __shfl_xor(lp, 32);
  const float inv = 1.f / lp;
  bf16_t* op = MIX + (size_t)qrow * 1024 + h * 64 + 4 * hh;
#pragma unroll
  for (int g = 0; g < 4; ++g) {
    uint2 u0, u1;
    u0.x = pack2(o0[4 * g + 0] * inv, o0[4 * g + 1] * inv);
    u0.y = pack2(o0[4 * g + 2] * inv, o0[4 * g + 3] * inv);
    u1.x = pack2(o1[4 * g + 0] * inv, o1[4 * g + 1] * inv);
    u1.y = pack2(o1[4 * g + 2] * inv, o1[4 * g + 3] * inv);
    *(uint2*)(op + 8 * g) = u0;
    *(uint2*)(op + 32 + 8 * g) = u1;
  }
}

__device__ void na_naive(const Params& p, int l, int ti) {
  const int h = otid() >> 6, lane = otid() & 63;
  const bf16_t* P = (const bf16_t*)(p.ws + OFF_P);
  bf16_t* MIX = (bf16_t*)(p.ws + OFF_HM);
  const bool lat = ti < 256;
  const int b = lat ? (ti >> 5) : ((ti - 256) >> 2);
  const int r = ti & 31;
  const int row = lat ? (ti * 64 + lane) : (M_LAT + (ti - 256) * 64 + lane);
  uint4 qk[8];
  float acc[64];
  {
    const uint4* qp = (const uint4*)(P + (size_t)row * INWP + C_NQ + h * 64);
#pragma unroll
    for (int c = 0; c < 8; ++c) qk[c] = qp[c];
  }
#pragma unroll
  for (int i = 0; i < 64; ++i) acc[i] = 0.f;
  float m = -INFINITY, ls = 0.f;
  const int qc = lane;
  const int rs0 = min(max(r - 4, 0), 24);
  const int cs0 = min(max(qc - 8, 0), 48);
  const float* rb = p.rel_bias + (size_t)l * 4 * 15 * 31 + h * 15 * 31;
  const int nloc = lat ? 128 : 0;
  for (int j = 0; j < nloc + 256; ++j) {
    int krow;
    float bias = 0.f;
    if (j < nloc) {
      int kr = rs0 + (j >> 4), kc = cs0 + (j & 15);
      krow = b * 2048 + kr * 64 + kc;
      bias = rb[(kr - r + 7) * 31 + (kc - qc + 15)];
    } else {
      krow = M_LAT + b * 256 + (j - nloc);
    }
    const uint4* kp = (const uint4*)(P + (size_t)krow * INWP + C_NK + h * 64);
    float s = 0.f;
#pragma unroll
    for (int c = 0; c < 8; ++c) {
      uint4 u = kp[c];
      uint4 q = qk[c];
      s += bflo(q.x) * bflo(u.x) + bfhi(q.x) * bfhi(u.x) + bflo(q.y) * bflo(u.y) + bfhi(q.y) * bfhi(u.y) +
           bflo(q.z) * bflo(u.z) + bfhi(q.z) * bfhi(u.z) + bflo(q.w) * bflo(u.w) + bfhi(q.w) * bfhi(u.w);
    }
    s = s * 0.125f + bias;
    float mn = fmaxf(m, s);
    float corr = __expf(m - mn), pe = __expf(s - mn);
    ls = ls * corr + pe;
    m = mn;
    const uint4* vp = (const uint4*)(P + (size_t)krow * INWP + C_NV + h * 64);
#pragma unroll
    for (int c = 0; c < 8; ++c) {
      uint4 u = vp[c];
      acc[c * 8 + 0] = acc[c * 8 + 0] * corr + pe * bflo(u.x);
      acc[c * 8 + 1] = acc[c * 8 + 1] * corr + pe * bfhi(u.x);
      acc[c * 8 + 2] = acc[c * 8 + 2] * corr + pe * bflo(u.y);
      acc[c * 8 + 3] = acc[c * 8 + 3] * corr + pe * bfhi(u.y);
      acc[c * 8 + 4] = acc[c * 8 + 4] * corr + pe * bflo(u.z);
      acc[c * 8 + 5] = acc[c * 8 + 5] * corr + pe * bfhi(u.z);
      acc[c * 8 + 6] = acc[c * 8 + 6] * corr + pe * bflo(u.w);
      acc[c * 8 + 7] = acc[c * 8 + 7] * corr + pe * bfhi(u.w);
    }
  }
  const float inv = 1.f / ls;
  uint4* op = (uint4*)(MIX + (size_t)row * 1024 + 256 + h * 64);
#pragma unroll
  for (int c = 0; c < 8; ++c) {
    uint4 u;
    u.x = pack2(acc[c * 8 + 0] * inv, acc[c * 8 + 1] * inv);
    u.y = pack2(acc[c * 8 + 2] * inv, acc[c * 8 + 3] * inv);
    u.z = pack2(acc[c * 8 + 4] * inv, acc[c * 8 + 5] * inv);
    u.w = pack2(acc[c * 8 + 6] * inv, acc[c * 8 + 7] * inv);
    op[c] = u;
  }
}

DEVI int dn_rowof(int s, int b, int d) {
  if (s < 256) {
    int c = d ? (255 - s) : s;
    return M_LAT + b * 256 + c;
  }
  int t = s - 256;
  t = d ? (2047 - t) : t;
  return b * 2048 + t;
}

__device__ void dn_naive(const Params& p, int l, int it, char* smem) {
  float* ks = (float*)smem;
  float* qs = ks + 32 * 128;
  float* vs = qs + 32 * 128;
  float* gs = vs + 32 * 64;
  float* bs = gs + 32;
  const int half = it & 1, d = (it >> 1) & 1, h = (it >> 2) & 3, b = it >> 4;
  const int tid = otid(), w = tid >> 6, lane = tid & 63, c = lane & 15, kg = lane >> 4;
  const int col = half * 64 + w * 16 + c;
  const bf16_t* DQ = (const bf16_t*)(p.ws + OFF_DNQKV);
  const float* AB = (const float*)(p.ws + OFF_AB);
  bf16_t* MIX = (bf16_t*)(p.ws + OFF_HM);
  bf16_t* OB = (bf16_t*)(p.ws + OFF_OB);
  float S[32];
#pragma unroll
  for (int i = 0; i < 32; ++i) S[i] = 0.f;
  const float Aneg = -__expf(p.a_log[l * 8 + d * 4 + h]);
  const float dtb = p.dt_bias[l * 8 + d * 4 + h];
  for (int s0 = 0; s0 < 2304; s0 += 32) {
    __syncthreads();
    for (int i = tid; i < 32 * 128; i += 256) {
      int tk = i >> 7, ch = i & 127;
      int row = dn_rowof(s0 + tk, b, d);
      qs[i] = bf2f(DQ[(size_t)row * 1536 + h * 128 + ch]);
      ks[i] = bf2f(DQ[(size_t)row * 1536 + 512 + h * 128 + ch]);
    }
    for (int i = tid; i < 32 * 64; i += 256) {
      int tk = i >> 6, ch = i & 63;
      int row = dn_rowof(s0 + tk, b, d);
      vs[i] = bf2f(DQ[(size_t)row * 1536 + 1024 + h * 128 + half * 64 + ch]);
    }
    if (tid < 32) {
      int row = dn_rowof(s0 + tid, b, d);
      float a = AB[(size_t)row * 16 + d * 4 + h];
      float bb = AB[(size_t)row * 16 + 8 + d * 4 + h];
      float xx = a + dtb;
      float sp = xx > 20.f ? xx : log1pf(__expf(xx));
      gs[tid] = __expf(Aneg * sp);
      bs[tid] = 1.f / (1.f + __expf(-bb));
    }
    __syncthreads();
    for (int tk = 0; tk < 32; ++tk) {
      const float eg = gs[tk], beta = bs[tk];
      const float vv = vs[tk * 64 + w * 16 + c];
      const float4* k4 = (const float4*)(ks + tk * 128 + kg * 32);
      const float4* q4 = (const float4*)(qs + tk * 128 + kg * 32);
      float part = 0.f;
#pragma unroll
      for (int i = 0; i < 8; ++i) {
        float4 kk = k4[i];
        S[4 * i + 0] *= eg; S[4 * i + 1] *= eg; S[4 * i + 2] *= eg; S[4 * i + 3] *= eg;
        part += kk.x * S[4 * i + 0] + kk.y * S[4 * i + 1] + kk.z * S[4 * i + 2] + kk.w * S[4 * i + 3];
      }
      part += __shfl_xor(part, 16);
      part += __shfl_xor(part, 32);
      const float delta = beta * (vv - part);
      float po = 0.f;
#pragma unroll
      for (int i = 0; i < 8; ++i) {
        float4 kk = k4[i];
        float4 qq = q4[i];
        S[4 * i + 0] += kk.x * delta; S[4 * i + 1] += kk.y * delta; S[4 * i + 2] += kk.z * delta; S[4 * i + 3] += kk.w * delta;
        po += qq.x * S[4 * i + 0] + qq.y * S[4 * i + 1] + qq.z * S[4 * i + 2] + qq.w * S[4 * i + 3];
      }
      po += __shfl_xor(po, 16);
      po += __shfl_xor(po, 32);
      if (kg == 0) {
        int row = dn_rowof(s0 + tk, b, d);
        float o = po * 0.08838834764831845f;
        if (d == 0)
          MIX[(size_t)row * 1024 + 512 + h * 128 + col] = f2bf(o);
        else
          OB[(size_t)row * 512 + h * 128 + col] = f2bf(o);
      }
    }
  }
}

__device__ void phaseD(const Params& p, int l, char* smem) {
  const int nb = gridDim.x, bid = blockIdx.x;
  constexpr int T0 = 64, T1 = T0 + 576, T2 = T1 + 288;
  for (int it = bid; it < T2; it += nb) {
    if (it < T0)
      dn_scan(p, l, it, smem);
    else if (it < T1)
      mla_flash(p, it - T0, smem);
    else
      na_naive(p, l, it - T1);
  }
}

__device__ void outgate_item(const Params& p, int l, int item) {
  const int w = otid() >> 6, lane = otid() & 63;
  const int row = item * 4 + w;
  const bf16_t* P = (const bf16_t*)(p.ws + OFF_P);
  bf16_t* MIX = (bf16_t*)(p.ws + OFF_HM);
  const int h = lane >> 4, cb = (lane & 15) * 8;
  uint4 uo = *(const uint4*)(MIX + (size_t)row * 1024 + 512 + h * 128 + cb);
  uint4 ub = *(const uint4*)(P + (size_t)row * INWP + C_DN + h * 128 + cb);
  uint4 uz = *(const uint4*)(P + (size_t)row * INWP + C_DZ + h * 128 + cb);
  float o[8], z[8];
  o[0] = bflo(uo.x) + bflo(ub.x); o[1] = bfhi(uo.x) + bfhi(ub.x); o[2] = bflo(uo.y) + bflo(ub.y); o[3] = bfhi(uo.y) + bfhi(ub.y);
  o[4] = bflo(uo.z) + bflo(ub.z); o[5] = bfhi(uo.z) + bfhi(ub.z); o[6] = bflo(uo.w) + bflo(ub.w); o[7] = bfhi(uo.w) + bfhi(ub.w);
  z[0] = bflo(uz.x); z[1] = bfhi(uz.x); z[2] = bflo(uz.y); z[3] = bfhi(uz.y);
  z[4] = bflo(uz.z); z[5] = bfhi(uz.z); z[6] = bflo(uz.w); z[7] = bfhi(uz.w);
  float ss = 0.f;
#pragma unroll
  for (int e = 0; e < 8; ++e) ss += o[e] * o[e];
  ss += __shfl_xor(ss, 1);
  ss += __shfl_xor(ss, 2);
  ss += __shfl_xor(ss, 4);
  ss += __shfl_xor(ss, 8);
  const float r = rsqrtf(ss * (1.f / 128.f) + 1e-6f);
  const float* go = p.g_out + l * 128 + cb;
  float y[8];
#pragma unroll
  for (int e = 0; e < 8; ++e) y[e] = o[e] * r * go[e] * silu_f(z[e]);
  uint4 u;
  u.x = pack2(y[0], y[1]); u.y = pack2(y[2], y[3]); u.z = pack2(y[4], y[5]); u.w = pack2(y[6], y[7]);
  *(uint4*)(MIX + (size_t)row * 1024 + 512 + h * 128 + cb) = u;
}

__device__ void final_item(const Params& p, int item) {
  const int w = otid() >> 6, lane = otid() & 63;
  const int row = item * 4 + w;
  const float4* xr = (const float4*)((const float*)(p.ws + OFF_X) + (size_t)row * 1024);
  float4 v[4];
  float ss = 0.f;
#pragma unroll
  for (int i = 0; i < 4; ++i) {
    v[i] = xr[lane + 64 * i];
    ss += v[i].x * v[i].x + v[i].y * v[i].y + v[i].z * v[i].z + v[i].w * v[i].w;
  }
  ss = wave_sum(ss);
  const float r = rsqrtf(ss * (1.f / 1024.f) + 1e-6f);
  const float4* g4 = (const float4*)p.g_final;
  float4* o4 = (float4*)(p.out + (size_t)row * 1024);
#pragma unroll
  for (int i = 0; i < 4; ++i) {
    float4 gg = g4[lane + 64 * i];
    float4 y;
    y.x = v[i].x * r * gg.x; y.y = v[i].y * r * gg.y; y.z = v[i].z * r * gg.z; y.w = v[i].w * r * gg.w;
    o4[lane + 64 * i] = y;
  }
}

constexpr int N_PHASES = 1 + 9 * 4 + 1;

__global__ void __launch_bounds__(256, 2) mega(Params p) {
  __shared__ __attribute__((aligned(16))) char smem[SMEM_BYTES];
  cg::grid_group grid = cg::this_grid();
  const int nb = gridDim.x, bid = blockIdx.x;
  for (int ph = p.ph_lo; ph < p.ph_hi; ++ph) {
    if (ph == 0) {
      phase0(p, smem);
    } else if (ph == N_PHASES - 1) {
      for (int it = bid; it < M_LAT / 4; it += nb) final_item(p, it);
    } else {
      const int l = (ph - 1) / 9, s = (ph - 1) % 9;
      if (s == 0) {
        phaseA(p, l, smem);
      } else if (s == 1) {
        for (int it = bid; it < 144 * 26; it += nb)
          gemm_tile<EPI_P>(p, l, (const bf16_t*)(p.ws + OFF_HM), 1024, (const bf16_t*)(p.ws + OFF_WIN), 1024,
                           (it / 26) * 128, (it % 26) * 128, 0, smem);
      } else if (s == 2) {
        phaseC(p, l, smem);
      } else if (s == 3) {
        phaseD(p, l, smem);
      } else if (s == 4) {
        for (int it = bid; it < M_ALL / 4; it += nb) outgate_item(p, l, it);
      } else if (s == 5) {
        for (int it = bid; it < 144 * 8; it += nb)
          gemm_tile<EPI_RES>(p, l, (const bf16_t*)(p.ws + OFF_HM), 1024, (const bf16_t*)(p.ws + OFF_WOUT), 1024,
                             (it / 8) * 128, (it % 8) * 128, 2, smem);
      } else if (s == 6) {
        for (int it = bid; it < M_ALL / 4; it += nb)
          norm_rows((const float*)(p.ws + OFF_X), (bf16_t*)(p.ws + OFF_HM), p.g_ffn + l * 1024,
                    (const float*)(p.ws + OFF_MOD) + (size_t)l * 9 * 6144, 3, 4, it);
      } else if (s == 7) {
        for (int it = bid; it < 144 * 44; it += nb)
          gemm_tile<EPI_GU>(p, l, (const bf16_t*)(p.ws + OFF_HM), 1024, (const bf16_t*)(p.ws + OFF_WGU), 1024,
                            (it / 44) * 128, (it % 44) * 128, 0, smem);
      } else {
        for (int it = bid; it < 144 * 8; it += nb)
          gemm_tile<EPI_RES>(p, l, (const bf16_t*)(p.ws + OFF_P), FFN, (const bf16_t*)(p.ws + OFF_WDN), FFN,
                             (it / 8) * 128, (it % 8) * 128, 5, smem);
      }
    }
    if (ph + 1 < p.ph_hi) grid.sync();
  }
}

extern "C" void kernel_launch(void* const* d_in, const int* in_sizes, int n_in, void* d_out, int out_size, void* d_ws,
                              size_t ws_size, hipStream_t stream) {
  static int grid_blocks = 0;
  if (!grid_blocks) {
    int dev = 0, cus = 0, per_cu = 0;
    hipGetDevice(&dev);
    hipDeviceGetAttribute(&cus, hipDeviceAttributeMultiprocessorCount, dev);
    hipOccupancyMaxActiveBlocksPerMultiprocessor(&per_cu, mega, 256, 0);
    if (per_cu < 1) per_cu = 1;
    if (per_cu > 2) per_cu = 2;
    grid_blocks = cus * per_cu;
  }
  Params p{};
  const float** pp = (const float**)&p;
  for (int i = 0; i < 23; ++i) pp[i] = (const float*)d_in[i];
  p.out = (float*)d_out;
  p.ws = (char*)d_ws;
  p.ph_lo = 0;
  p.ph_hi = N_PHASES;
  void* args[] = {&p};
  hipError_t e = hipLaunchCooperativeKernel((void*)mega, dim3(grid_blocks), dim3(256), args, 0, stream);
  if (e != hipSuccess) {
    fprintf(stderr, "cooperative launch failed: %s (grid %d)\n", hipGetErrorString(e), grid_blocks);
    (void)hipGetLastError();
    for (int ph = 0; ph < N_PHASES; ++ph) {
      p.ph_lo = ph;
      p.ph_hi = ph + 1;
      hipLaunchKernelGGL(mega, dim3(grid_blocks), dim3(256), 0, stream, p);
    }
  }
}
```

```cpp
#include <hip/hip_runtime.h>
#include <hip/hip_bf16.h>
#include <hip/hip_cooperative_groups.h>
#include <cstdio>
namespace cg = cooperative_groups;

#define DEVI __device__ __forceinline__
typedef unsigned short bf16_t;
typedef short bf16x8 __attribute__((ext_vector_type(8)));
typedef float f32x16 __attribute__((ext_vector_type(16)));

constexpr int M_LAT = 16384, M_CTX = 2048, M_ALL = 18432;
constexpr int DM = 1024, INW = 3248, INWP = 3328, FFN = 2816;
constexpr int C_MQ = 0, C_MKV = 256, C_MPE = 384, C_NQ = 416, C_NK = 672, C_NV = 928, C_DN = 1184;
constexpr int C_DZ = C_DN + 1536, C_DA = C_DN + 2048;

constexpr size_t OFF_WIN = 0;
constexpr size_t OFF_WOUT = OFF_WIN + (size_t)INWP * 1024 * 2;
constexpr size_t OFF_WGU = OFF_WOUT + (size_t)1024 * 1024 * 2;
constexpr size_t OFF_WDN = OFF_WGU + (size_t)2 * FFN * 1024 * 2;
constexpr size_t OFF_WQUP = OFF_WDN + (size_t)1024 * FFN * 2;
constexpr size_t OFF_WKVUP = OFF_WQUP + (size_t)384 * 256 * 2;
constexpr size_t OFF_MOD = OFF_WKVUP + (size_t)512 * 128 * 2;
constexpr size_t OFF_ROPE = OFF_MOD + (size_t)4 * 9 * 6144 * 4;
constexpr size_t OFF_X = OFF_ROPE + (size_t)2048 * 16 * 2 * 4;
constexpr size_t OFF_HM = OFF_X + (size_t)M_ALL * 1024 * 4;
constexpr size_t OFF_P = OFF_HM + (size_t)M_ALL * 1024 * 2;
constexpr size_t OFF_QH = OFF_P + (size_t)M_ALL * INWP * 2;
constexpr size_t OFF_KH = OFF_QH + (size_t)M_ALL * 384 * 2;
constexpr size_t OFF_VH = OFF_KH + (size_t)M_ALL * 384 * 2;
constexpr size_t OFF_DNQKV = OFF_VH + (size_t)M_ALL * 256 * 2;
constexpr size_t OFF_OB = OFF_DNQKV + (size_t)M_ALL * 1536 * 2;
constexpr size_t OFF_AB = OFF_OB + (size_t)M_ALL * 512 * 2;
constexpr size_t OFF_GC = OFF_AB + (size_t)M_ALL * 16 * 4;
constexpr size_t OFF_BETA = OFF_GC + (size_t)M_ALL * 8 * 4;
constexpr size_t OFF_NVT = OFF_BETA + (size_t)M_ALL * 8 * 4;
constexpr size_t WS_TOTAL = OFF_NVT + (size_t)M_ALL * 256 * 2;
constexpr int SMEM_BYTES = 70656;
constexpr size_t OFF_BAR = (WS_TOTAL + 255) & ~(size_t)255;

struct Params {
  const float *x, *c, *ctx, *c_ctx, *w_ada, *b_ada, *g_mix, *w_in, *g_q, *g_kv, *w_qup, *w_kvup, *rel_bias,
      *conv_w, *a_log, *dt_bias, *g_out, *w_out, *g_ffn, *w_gate, *w_up, *w_down, *g_final;
  float* out;
  char* ws;
  int ph_lo, ph_hi;
  int use_cg, pad0;
};

DEVI bf16_t f2bf(float f) {
  __bf16 r = (__bf16)f;
  return __builtin_bit_cast(unsigned short, r);
}
DEVI int otid() {
  int t = threadIdx.x;
  asm volatile("" : "+v"(t));
  return t;
}
DEVI float bf2f(bf16_t h) { return __uint_as_float(((unsigned)h) << 16); }
DEVI float bflo(unsigned u) { return __uint_as_float(u << 16); }
DEVI float bfhi(unsigned u) { return __uint_as_float(u & 0xffff0000u); }
typedef __bf16 bf16v2_t __attribute__((ext_vector_type(2)));
typedef float f32v2_t __attribute__((ext_vector_type(2)));
DEVI unsigned pack2(float a, float b) {
  f32v2_t v = {a, b};
  bf16v2_t r = __builtin_convertvector(v, bf16v2_t);
  return __builtin_bit_cast(unsigned, r);
}
DEVI float silu_f(float x) { return x / (1.f + __expf(-x)); }
DEVI float wave_sum(float v) {
#pragma unroll
  for (int o = 32; o >= 1; o >>= 1) v += __shfl_xor(v, o);
  return v;
}

#define XB_TMO 128
#define XB_XCNT(j) (256 + 64 * (j))
#define XB_XSUB(j) (1280 + 64 * (j))
#define XB_XGEN(j) (2304 + 64 * (j))
#define XB_TOP 3328
#define XB_TOPGEN 3392
#define XCD_BAR_WORDS 3456
#define XB_SPIN_CAP (1u << 22)
#define LAS __attribute__((address_space(3)))
DEVI unsigned xb_ld(unsigned* p) { return __hip_atomic_load(p, __ATOMIC_RELAXED, __HIP_MEMORY_SCOPE_AGENT); }
DEVI unsigned xb_add(unsigned* p, unsigned v) { return __hip_atomic_fetch_add(p, v, __ATOMIC_RELAXED, __HIP_MEMORY_SCOPE_AGENT); }
DEVI unsigned xb_xcc_id() { return (unsigned)__builtin_amdgcn_s_getreg((3 << 11) | 20) & 0xFu; }
#define XB_SPIN(cond, bar)                                                     \
  do {                                                                         \
    unsigned _sp = 0;                                                          \
    while (cond) {                                                             \
      __builtin_amdgcn_s_sleep(1);                                             \
      if ((++_sp & 255u) == 0u) {                                              \
        if (xb_ld(&(bar)[XB_TMO])) break;                                      \
        if (_sp > XB_SPIN_CAP) { atomicAdd(&(bar)[XB_TMO], 1u); break; }       \
      }                                                                        \
    }                                                                          \
  } while (0)
struct XcdBarrier {
  unsigned* bar;
  unsigned x;
  volatile LAS unsigned* st;
};
DEVI XcdBarrier xcd_barrier_post(unsigned* bar, volatile LAS unsigned* st) {
  XcdBarrier b;
  b.bar = bar;
  b.x = xb_xcc_id();
  b.st = st;
  if (threadIdx.x == 0) (void)xb_add(&bar[XB_XCNT(b.x)], 1u);
  return b;
}
DEVI void xcd_barrier_complete(unsigned* bar, unsigned x, unsigned& nloc, unsigned& nx) {
  const unsigned G = gridDim.x * gridDim.y * gridDim.z;
  unsigned sum, cnt, mine, sp = 0u;
  for (;;) {
    sum = 0u; cnt = 0u; mine = 0u;
#pragma unroll
    for (unsigned j = 0; j < 16; ++j) {
      const unsigned c = xb_ld(&bar[XB_XCNT(j)]);
      sum += c;
      cnt += (c > 0u) ? 1u : 0u;
      mine = (j == x) ? c : mine;
    }
    if (sum == G) break;
    __builtin_amdgcn_s_sleep(1);
    if ((++sp & 255u) == 0u) {
      if (xb_ld(&bar[XB_TMO])) break;
      if (sp > XB_SPIN_CAP) { atomicAdd(&bar[XB_TMO], 1u); break; }
    }
  }
  nloc = mine > 0u ? mine : 1u;
  nx = cnt > 0u ? cnt : 1u;
}
DEVI void xcd_barrier(const XcdBarrier& b) {
  asm volatile("s_waitcnt vmcnt(0)" ::: "memory");
  __syncthreads();
  if (threadIdx.x == 0) {
    unsigned* bar = b.bar;
    __builtin_amdgcn_s_waitcnt(0);
    unsigned nloc = b.st[0], nx = b.st[1];
    if (nloc == 0u) {
      xcd_barrier_complete(bar, b.x, nloc, nx);
      b.st[0] = nloc;
      b.st[1] = nx;
    }
    const unsigned old = xb_add(&bar[XB_XSUB(b.x)], 1u);
    const unsigned gen = old / nloc;
    if (old + 1u == (gen + 1u) * nloc) {
      __builtin_amdgcn_fence(__ATOMIC_RELEASE, "agent");
      asm volatile("s_waitcnt vmcnt(0)" ::: "memory");
      const unsigned og = xb_add(&bar[XB_TOP], 1u);
      const unsigned tg = og / nx;
      if (og + 1u == (tg + 1u) * nx) xb_add(&bar[XB_TOPGEN], 1u);
      else XB_SPIN(xb_ld(&bar[XB_TOPGEN]) == tg, bar);
      __builtin_amdgcn_fence(__ATOMIC_ACQUIRE, "agent");
      xb_add(&bar[XB_XGEN(b.x)], 1u);
      asm volatile("s_waitcnt vmcnt(0)" ::: "memory");
    } else {
      XB_SPIN(xb_ld(&bar[XB_XGEN(b.x)]) == gen, bar);
      __builtin_amdgcn_fence(__ATOMIC_ACQUIRE, "agent");
      asm volatile("s_waitcnt vmcnt(0)" ::: "memory");
    }
  }
  __syncthreads();
}

__device__ void phase0(const Params& p, char* smem) {
  const int tid = otid(), nb = gridDim.x, bid = blockIdx.x;
  {
    float4* X4 = (float4*)(p.ws + OFF_X);
    const float4* x4 = (const float4*)p.x;
    const float4* c4 = (const float4*)p.ctx;
    const size_t n1 = (size_t)M_LAT * 256, n2 = (size_t)M_CTX * 256;
    for (size_t i = (size_t)bid * 256 + tid; i < n1 + n2; i += (size_t)nb * 256) X4[i] = i < n1 ? x4[i] : c4[i - n1];
  }
  {
    float* rc = (float*)(p.ws + OFF_ROPE);
    float* rs = rc + 2048 * 16;
    for (int i = bid * 256 + tid; i < 2048 * 16; i += nb * 256) {
      int t = i >> 4, a = (i >> 3) & 1, j = i & 7;
      float pos = a ? (float)(t & 63) : (float)(t >> 6);
      float inv = powf(10000.f, -(float)j / 8.f);
      float ang = pos * inv;
      rc[i] = cosf(ang);
      rs[i] = sinf(ang);
    }
  }
  float* sc = (float*)smem;
  float* red = sc + 9 * 1024;
  float* MOD = (float*)(p.ws + OFF_MOD);
  bool loaded = false;
  for (int it = bid; it < 4 * 96; it += nb) {
    if (!loaded) {
      for (int i = tid; i < 9 * 1024; i += 256) {
        float v = i < 8192 ? p.c[i] : p.c_ctx[i - 8192];
        sc[i] = silu_f(v);
      }
      __syncthreads();
      loaded = true;
    }
    const int l = it / 96, n0 = (it % 96) * 64;
    const int cc = tid & 63, kg = tid >> 6;
    const float* w = p.w_ada + (size_t)l * 1024 * 6144 + n0 + cc;
    float acc[9];
#pragma unroll
    for (int b = 0; b < 9; ++b) acc[b] = 0.f;
    for (int k = kg * 256; k < kg * 256 + 256; ++k) {
      float wv = w[(size_t)k * 6144];
#pragma unroll
      for (int b = 0; b < 9; ++b) acc[b] += sc[b * 1024 + k] * wv;
    }
#pragma unroll
    for (int b = 0; b < 9; ++b) red[(kg * 9 + b) * 64 + cc] = acc[b];
    __syncthreads();
    for (int i = tid; i < 9 * 64; i += 256) {
      int b = i >> 6, c2 = i & 63;
      float s = red[(0 * 9 + b) * 64 + c2] + red[(1 * 9 + b) * 64 + c2] + red[(2 * 9 + b) * 64 + c2] +
                red[(3 * 9 + b) * 64 + c2];
      MOD[(size_t)(l * 9 + b) * 6144 + n0 + c2] = s + p.b_ada[l * 6144 + n0 + c2];
    }
    __syncthreads();
  }
}

__device__ void convT_tile(const float* __restrict__ src, int K, int N, bf16_t* __restrict__ dst, int mode,
                           const float* __restrict__ gs, int kt, int nt, float* tl) {
  const int tid = otid();
  const int k0 = kt * 64, n0 = nt * 64;
  __syncthreads();
#pragma unroll 4
  for (int i = 0; i < 16; ++i) {
    int kk = i * 4 + (tid >> 6), nn = tid & 63;
    float v = 0.f;
    if (n0 + nn < N) v = src[(size_t)(k0 + kk) * N + n0 + nn];
    if (gs) v *= gs[k0 + kk];
    tl[kk * 65 + nn] = v;
  }
  __syncthreads();
#pragma unroll 2
  for (int i = 0; i < 8; ++i) {
    int nn = i * 8 + (tid >> 5), kk = (tid & 31) * 2;
    unsigned pk = pack2(tl[kk * 65 + nn], tl[(kk + 1) * 65 + nn]);
    int n = n0 + nn;
    int drow = mode == 0 ? n : ((n >> 5) * 64 + (n & 31) + (mode == 2 ? 32 : 0));
    *(unsigned*)(dst + (size_t)drow * K + k0 + kk) = pk;
  }
}

__device__ void norm_rows(const float* __restrict__ X, bf16_t* __restrict__ H, const float* __restrict__ g,
                          const float* __restrict__ modl, int shift_i, int scale_i, int item) {
  const int w = otid() >> 6, lane = otid() & 63;
  const int row = item * 4 + w;
  const float4* xr = (const float4*)(X + (size_t)row * 1024);
  float4 v[4];
  float ss = 0.f;
#pragma unroll
  for (int i = 0; i < 4; ++i) {
    v[i] = xr[lane + 64 * i];
    ss += v[i].x * v[i].x + v[i].y * v[i].y + v[i].z * v[i].z + v[i].w * v[i].w;
  }
  ss = wave_sum(ss);
  const float r = rsqrtf(ss * (1.f / 1024.f) + 1e-6f);
  const int b = row < M_LAT ? (row >> 11) : 8;
  const float4* sh = (const float4*)(modl + b * 6144 + shift_i * 1024);
  const float4* sl = (const float4*)(modl + b * 6144 + scale_i * 1024);
  const float4* g4 = (const float4*)g;
#pragma unroll
  for (int i = 0; i < 4; ++i) {
    int c4 = lane + 64 * i;
    float4 gg = g4[c4], s4 = sh[c4], l4 = sl[c4];
    float y0 = v[i].x * r * gg.x * (1.f + l4.x) + s4.x;
    float y1 = v[i].y * r * gg.y * (1.f + l4.y) + s4.y;
    float y2 = v[i].z * r * gg.z * (1.f + l4.z) + s4.z;
    float y3 = v[i].w * r * gg.w * (1.f + l4.w) + s4.w;
    uint2 pk;
    pk.x = pack2(y0, y1);
    pk.y = pack2(y2, y3);
    *(uint2*)(H + (size_t)row * 1024 + c4 * 4) = pk;
  }
}

__device__ void phaseA(const Params& p, int l, char* smem) {
  const int nb = gridDim.x, bid = blockIdx.x;
  float* tl = (float*)smem;
  bf16_t* Win = (bf16_t*)(p.ws + OFF_WIN);
  bf16_t* Wout = (bf16_t*)(p.ws + OFF_WOUT);
  bf16_t* Wgu = (bf16_t*)(p.ws + OFF_WGU);
  bf16_t* Wdn = (bf16_t*)(p.ws + OFF_WDN);
  bf16_t* Wq = (bf16_t*)(p.ws + OFF_WQUP);
  bf16_t* Wkv = (bf16_t*)(p.ws + OFF_WKVUP);
  constexpr int T0 = 16 * 52, T1 = T0 + 256, T2 = T1 + 704, T3 = T2 + 704, T4 = T3 + 704, T5 = T4 + 24, T6 = T5 + 16;
  constexpr int NORM_ITEMS = M_ALL / 4;
  for (int it = bid; it < T6 + NORM_ITEMS; it += nb) {
    if (it < T6) {
      const float* src;
      const float* gs = nullptr;
      bf16_t* dst;
      int K, N, mode = 0, ntn, i;
      if (it < T0) {
        i = it; src = p.w_in + (size_t)l * 1024 * INW; K = 1024; N = INW; dst = Win; ntn = 52;
      } else if (it < T1) {
        i = it - T0; src = p.w_out + (size_t)l * 1024 * 1024; K = 1024; N = 1024; dst = Wout; ntn = 16;
      } else if (it < T2) {
        i = it - T1; src = p.w_gate + (size_t)l * 1024 * FFN; K = 1024; N = FFN; dst = Wgu; ntn = 44; mode = 1;
      } else if (it < T3) {
        i = it - T2; src = p.w_up + (size_t)l * 1024 * FFN; K = 1024; N = FFN; dst = Wgu; ntn = 44; mode = 2;
      } else if (it < T4) {
        i = it - T3; src = p.w_down + (size_t)l * FFN * 1024; K = FFN; N = 1024; dst = Wdn; ntn = 16;
      } else if (it < T5) {
        i = it - T4; src = p.w_qup + (size_t)l * 256 * 384; K = 256; N = 384; dst = Wq; ntn = 6; gs = p.g_q + l * 256;
      } else {
        i = it - T5; src = p.w_kvup + (size_t)l * 128 * 512; K = 128; N = 512; dst = Wkv; ntn = 8; gs = p.g_kv + l * 128;
      }
      convT_tile(src, K, N, dst, mode, gs, i / ntn, i % ntn, tl);
    } else {
      norm_rows((const float*)(p.ws + OFF_X), (bf16_t*)(p.ws + OFF_HM), p.g_mix + l * 1024,
                (const float*)(p.ws + OFF_MOD) + (size_t)l * 9 * 6144, 0, 1, it - T6);
    }
  }
}

DEVI void tile_map(int it, int NT, int& mt, int& nt) {
  const int xcd = it & 7, idx = it >> 3;
  const int per_group = 8 * NT;
  const int g = idx / per_group, r = idx - g * per_group;
  const int gs = min(8, 18 - 8 * g);
  mt = xcd * 18 + g * 8 + r % gs;
  nt = r / gs;
}

enum { EPI_P = 0, EPI_QUP = 1, EPI_KVUP = 2, EPI_RES = 3, EPI_GU = 4 };

template <int EPI>
__device__ void gemm_tile(const Params& p, int l, const bf16_t* __restrict__ A, int lda,
                          const bf16_t* __restrict__ BT, int K, int m0, int n0, int gate_i, char* smem) {
  bf16_t* sA = (bf16_t*)smem;
  bf16_t* sB = sA + 128 * 72;
  float* rsv = (float*)(smem + 2 * 128 * 72 * 2);
  const int tid = otid(), lane = tid & 63, w = tid >> 6, wm = w >> 1, wn = w & 1;
  const int lr = tid >> 3, lc = (tid & 7) * 8;
  __syncthreads();
  if (EPI == EPI_QUP || EPI == EPI_KVUP) {
    const int row = tid >> 1, hf = tid & 1;
    const int n8 = K / 16;
    const uint4* ap = (const uint4*)(A + (size_t)(m0 + row) * lda + hf * (K / 2));
    float ss = 0.f;
    for (int i = 0; i < n8; ++i) {
      uint4 u = ap[i];
      float a0 = bflo(u.x), a1 = bfhi(u.x), a2 = bflo(u.y), a3 = bfhi(u.y), a4 = bflo(u.z), a5 = bfhi(u.z),
            a6 = bflo(u.w), a7 = bfhi(u.w);
      ss += a0 * a0 + a1 * a1 + a2 * a2 + a3 * a3 + a4 * a4 + a5 * a5 + a6 * a6 + a7 * a7;
    }
    ss += __shfl_xor(ss, 1);
    if (hf == 0) rsv[row] = rsqrtf(ss / (float)K + 1e-6f);
  }
  const bf16_t* Ap = A + (size_t)(m0 + lr) * lda + lc;
  const bf16_t* Bp = BT + (size_t)(n0 + lr) * K + lc;
  uint4 ra0, ra1, ra2, ra3, rb0, rb1, rb2, rb3;
  ra0 = *(const uint4*)(Ap);
  ra1 = *(const uint4*)(Ap + (size_t)32 * lda);
  ra2 = *(const uint4*)(Ap + (size_t)64 * lda);
  ra3 = *(const uint4*)(Ap + (size_t)96 * lda);
  rb0 = *(const uint4*)(Bp);
  rb1 = *(const uint4*)(Bp + (size_t)32 * K);
  rb2 = *(const uint4*)(Bp + (size_t)64 * K);
  rb3 = *(const uint4*)(Bp + (size_t)96 * K);
  f32x16 acc[2][2];
#pragma unroll
  for (int i = 0; i < 2; ++i)
#pragma unroll
    for (int j = 0; j < 2; ++j)
#pragma unroll
      for (int r = 0; r < 16; ++r) acc[i][j][r] = 0.f;
  const int nk = K / 64;
  for (int kt = 0; kt < nk; ++kt) {
    __syncthreads();
    *(uint4*)(sA + (lr + 0) * 72 + lc) = ra0;
    *(uint4*)(sA + (lr + 32) * 72 + lc) = ra1;
    *(uint4*)(sA + (lr + 64) * 72 + lc) = ra2;
    *(uint4*)(sA + (lr + 96) * 72 + lc) = ra3;
    *(uint4*)(sB + (lr + 0) * 72 + lc) = rb0;
    *(uint4*)(sB + (lr + 32) * 72 + lc) = rb1;
    *(uint4*)(sB + (lr + 64) * 72 + lc) = rb2;
    *(uint4*)(sB + (lr + 96) * 72 + lc) = rb3;
    __syncthreads();
    if (kt + 1 < nk) {
      Ap += 64;
      Bp += 64;
      ra0 = *(const uint4*)(Ap);
      ra1 = *(const uint4*)(Ap + (size_t)32 * lda);
      ra2 = *(const uint4*)(Ap + (size_t)64 * lda);
      ra3 = *(const uint4*)(Ap + (size_t)96 * lda);
      rb0 = *(const uint4*)(Bp);
      rb1 = *(const uint4*)(Bp + (size_t)32 * K);
      rb2 = *(const uint4*)(Bp + (size_t)64 * K);
      rb3 = *(const uint4*)(Bp + (size_t)96 * K);
    }
#pragma unroll
    for (int ks = 0; ks < 4; ++ks) {
      const int ko = ks * 16 + (lane >> 5) * 8;
      bf16x8 a0 = *(const bf16x8*)(sA + (wm * 64 + (lane & 31)) * 72 + ko);
      bf16x8 a1 = *(const bf16x8*)(sA + (wm * 64 + 32 + (lane & 31)) * 72 + ko);
      bf16x8 b0 = *(const bf16x8*)(sB + (wn * 64 + (lane & 31)) * 72 + ko);
      bf16x8 b1 = *(const bf16x8*)(sB + (wn * 64 + 32 + (lane & 31)) * 72 + ko);
      acc[0][0] = __builtin_amdgcn_mfma_f32_32x32x16_bf16(a0, b0, acc[0][0], 0, 0, 0);
      acc[0][1] = __builtin_amdgcn_mfma_f32_32x32x16_bf16(a0, b1, acc[0][1], 0, 0, 0);
      acc[1][0] = __builtin_amdgcn_mfma_f32_32x32x16_bf16(a1, b0, acc[1][0], 0, 0, 0);
      acc[1][1] = __builtin_amdgcn_mfma_f32_32x32x16_bf16(a1, b1, acc[1][1], 0, 0, 0);
    }
  }
  const int ci = lane & 31;
  const int rbase = m0 + wm * 64 + 4 * (lane >> 5);
  const int cbase = n0 + wn * 64;
  if (EPI == EPI_P) {
    bf16_t* P = (bf16_t*)(p.ws + OFF_P);
    float* AB = (float*)(p.ws + OFF_AB);
#pragma unroll
    for (int mt = 0; mt < 2; ++mt)
#pragma unroll
      for (int nt = 0; nt < 2; ++nt)
#pragma unroll
        for (int r = 0; r < 16; ++r) {
          int row = rbase + mt * 32 + (r & 3) + 8 * (r >> 2);
          int col = cbase + nt * 32 + ci;
          float v = acc[mt][nt][r];
          P[(size_t)row * INWP + col] = f2bf(v);
          if (col >= C_DA && col < C_DA + 16) AB[(size_t)row * 16 + col - C_DA] = v;
        }
    bf16_t* NVT = (bf16_t*)(p.ws + OFF_NVT);
#pragma unroll
    for (int mt = 0; mt < 2; ++mt)
#pragma unroll
      for (int nt = 0; nt < 2; ++nt) {
        const int base = cbase + nt * 32;
        if (base >= C_NV && base < C_NV + 256) {
          const int hv = (base - C_NV) >> 6, dv = ((base - C_NV) & 63) + ci;
#pragma unroll
          for (int g = 0; g < 4; ++g) {
            const int row0 = rbase + mt * 32 + 8 * g;
            int bb, key0;
            if (row0 < M_LAT) { bb = row0 >> 11; key0 = 256 + (row0 & 2047); }
            else { bb = (row0 - M_LAT) >> 8; key0 = (row0 - M_LAT) & 255; }
            uint2 u;
            u.x = pack2(acc[mt][nt][4 * g + 0], acc[mt][nt][4 * g + 1]);
            u.y = pack2(acc[mt][nt][4 * g + 2], acc[mt][nt][4 * g + 3]);
            *(uint2*)(NVT + ((size_t)(bb * 4 + hv) * 64 + dv) * 2304 + key0) = u;
          }
        }
      }
  } else if (EPI == EPI_QUP) {
    bf16_t* QH = (bf16_t*)(p.ws + OFF_QH);
    const float* rc = (const float*)(p.ws + OFF_ROPE);
    const float* rsn = rc + 2048 * 16;
#pragma unroll
    for (int mt = 0; mt < 2; ++mt)
#pragma unroll
      for (int nt = 0; nt < 2; ++nt) {
        const int base = cbase + nt * 32;
        const bool rope = ((base % 96) == 64) && (m0 < M_LAT);
#pragma unroll
        for (int r = 0; r < 16; ++r) {
          int row = rbase + mt * 32 + (r & 3) + 8 * (r >> 2);
          float v = acc[mt][nt][r] * rsv[row - m0];
          float o = __shfl_xor(v, 8);
          if (rope) {
            int t = row & 2047;
            int a = ci >> 4, hf = (ci >> 3) & 1, j = ci & 7;
            float c = rc[t * 16 + a * 8 + j], s = rsn[t * 16 + a * 8 + j];
            v = hf ? (o * s + v * c) : (v * c - o * s);
          }
          QH[(size_t)row * 384 + base + ci] = f2bf(v);
        }
      }
  } else if (EPI == EPI_KVUP) {
    bf16_t* KA = (bf16_t*)(p.ws + OFF_KH);
    bf16_t* VT = (bf16_t*)(p.ws + OFF_VH);
#pragma unroll
    for (int mt = 0; mt < 2; ++mt)
#pragma unroll
      for (int nt = 0; nt < 2; ++nt) {
        const int base = cbase + nt * 32;
        const int h = base >> 7, cc = (base & 127) + ci;
#pragma unroll
        for (int g = 0; g < 4; ++g) {
          const int row0 = rbase + mt * 32 + 8 * g;
          int bb, key0;
          if (row0 < M_LAT) { bb = row0 >> 11; key0 = 256 + (row0 & 2047); }
          else { bb = (row0 - M_LAT) >> 8; key0 = (row0 - M_LAT) & 255; }
          float v0 = acc[mt][nt][4 * g + 0] * rsv[row0 - m0 + 0];
          float v1 = acc[mt][nt][4 * g + 1] * rsv[row0 - m0 + 1];
          float v2 = acc[mt][nt][4 * g + 2] * rsv[row0 - m0 + 2];
          float v3 = acc[mt][nt][4 * g + 3] * rsv[row0 - m0 + 3];
          if (cc < 64) {
            bf16_t* kp = KA + ((size_t)(bb * 4 + h) * 2304 + key0) * 96 + cc;
            kp[0] = f2bf(v0); kp[96] = f2bf(v1); kp[192] = f2bf(v2); kp[288] = f2bf(v3);
          } else {
            uint2 u;
            u.x = pack2(v0, v1);
            u.y = pack2(v2, v3);
            *(uint2*)(VT + ((size_t)(bb * 4 + h) * 64 + (cc - 64)) * 2304 + key0) = u;
          }
        }
      }
  } else if (EPI == EPI_RES) {
    float* X = (float*)(p.ws + OFF_X);
    const float* modl = (const float*)(p.ws + OFF_MOD) + (size_t)l * 9 * 6144 + gate_i * 1024;
#pragma unroll
    for (int mt = 0; mt < 2; ++mt)
#pragma unroll
      for (int nt = 0; nt < 2; ++nt)
#pragma unroll
        for (int r = 0; r < 16; ++r) {
          int row = rbase + mt * 32 + (r & 3) + 8 * (r >> 2);
          int col = cbase + nt * 32 + ci;
          int b = row < M_LAT ? (row >> 11) : 8;
          float g = modl[b * 6144 + col];
          size_t idx = (size_t)row * 1024 + col;
          X[idx] = X[idx] + g * acc[mt][nt][r];
        }
  } else if (EPI == EPI_GU) {
    bf16_t* ACT = (bf16_t*)(p.ws + OFF_P);
#pragma unroll
    for (int mt = 0; mt < 2; ++mt)
#pragma unroll
      for (int r = 0; r < 16; ++r) {
        int row = rbase + mt * 32 + (r & 3) + 8 * (r >> 2);
        float gt = acc[mt][0][r], up = acc[mt][1][r];
        float a = silu_f(gt) * up;
        ACT[(size_t)row * FFN + (cbase >> 6) * 32 + ci] = f2bf(a);
      }
  }
}

template <int EPI>
__device__ void gemm_wide(const Params& p, int l, const bf16_t* __restrict__ A, int lda,
                          const bf16_t* __restrict__ BT, int K, int m0, int n0, int gate_i, char* smem) {
  bf16_t* sA = (bf16_t*)smem;
  bf16_t* sB = sA + 128 * 72;
  const int tid = otid(), lane = tid & 63, w = tid >> 6, wm = w >> 1, wn = w & 1;
  const int lr = tid >> 3, lc = (tid & 7) * 8;
  const bf16_t* Ap = A + (size_t)(m0 + lr) * lda + lc;
  const bf16_t* Bp = BT + (size_t)(n0 + lr) * K + lc;
  uint4 ra0, ra1, ra2, ra3, rb0, rb1, rb2, rb3, rb4, rb5, rb6, rb7;
#define LOAD_AB()                                   \
  ra0 = *(const uint4*)(Ap);                        \
  ra1 = *(const uint4*)(Ap + (size_t)32 * lda);     \
  ra2 = *(const uint4*)(Ap + (size_t)64 * lda);     \
  ra3 = *(const uint4*)(Ap + (size_t)96 * lda);     \
  rb0 = *(const uint4*)(Bp);                        \
  rb1 = *(const uint4*)(Bp + (size_t)32 * K);       \
  rb2 = *(const uint4*)(Bp + (size_t)64 * K);       \
  rb3 = *(const uint4*)(Bp + (size_t)96 * K);       \
  rb4 = *(const uint4*)(Bp + (size_t)128 * K);      \
  rb5 = *(const uint4*)(Bp + (size_t)160 * K);      \
  rb6 = *(const uint4*)(Bp + (size_t)192 * K);      \
  rb7 = *(const uint4*)(Bp + (size_t)224 * K);
  LOAD_AB()
  f32x16 acc[2][4];
#pragma unroll
  for (int i = 0; i < 2; ++i)
#pragma unroll
    for (int j = 0; j < 4; ++j)
#pragma unroll
      for (int r = 0; r < 16; ++r) acc[i][j][r] = 0.f;
  const int nk = K / 64;
  for (int kt = 0; kt < nk; ++kt) {
    __syncthreads();
    *(uint4*)(sA + (lr + 0) * 72 + lc) = ra0;
    *(uint4*)(sA + (lr + 32) * 72 + lc) = ra1;
    *(uint4*)(sA + (lr + 64) * 72 + lc) = ra2;
    *(uint4*)(sA + (lr + 96) * 72 + lc) = ra3;
    *(uint4*)(sB + (lr + 0) * 72 + lc) = rb0;
    *(uint4*)(sB + (lr + 32) * 72 + lc) = rb1;
    *(uint4*)(sB + (lr + 64) * 72 + lc) = rb2;
    *(uint4*)(sB + (lr + 96) * 72 + lc) = rb3;
    *(uint4*)(sB + (lr + 128) * 72 + lc) = rb4;
    *(uint4*)(sB + (lr + 160) * 72 + lc) = rb5;
    *(uint4*)(sB + (lr + 192) * 72 + lc) = rb6;
    *(uint4*)(sB + (lr + 224) * 72 + lc) = rb7;
    __syncthreads();
    if (kt + 1 < nk) {
      Ap += 64;
      Bp += 64;
      LOAD_AB()
    }
#pragma unroll
    for (int ks = 0; ks < 4; ++ks) {
      const int ko = ks * 16 + (lane >> 5) * 8;
      bf16x8 a0 = *(const bf16x8*)(sA + (wm * 64 + (lane & 31)) * 72 + ko);
      bf16x8 a1 = *(const bf16x8*)(sA + (wm * 64 + 32 + (lane & 31)) * 72 + ko);
#pragma unroll
      for (int nt = 0; nt < 4; ++nt) {
        bf16x8 b = *(const bf16x8*)(sB + (wn * 128 + nt * 32 + (lane & 31)) * 72 + ko);
        acc[0][nt] = __builtin_amdgcn_mfma_f32_32x32x16_bf16(a0, b, acc[0][nt], 0, 0, 0);
        acc[1][nt] = __builtin_amdgcn_mfma_f32_32x32x16_bf16(a1, b, acc[1][nt], 0, 0, 0);
      }
    }
  }
#undef LOAD_AB
  const int ci = lane & 31;
  const int rbase = m0 + wm * 64 + 4 * (lane >> 5);
  const int cbase = n0 + wn * 128;
  if (EPI == EPI_P) {
    bf16_t* P = (bf16_t*)(p.ws + OFF_P);
    float* AB = (float*)(p.ws + OFF_AB);
    bf16_t* NVT = (bf16_t*)(p.ws + OFF_NVT);
#pragma unroll
    for (int mt = 0; mt < 2; ++mt)
#pragma unroll
      for (int nt = 0; nt < 4; ++nt) {
        const int base = cbase + nt * 32;
#pragma unroll
        for (int r = 0; r < 16; ++r) {
          int row = rbase + mt * 32 + (r & 3) + 8 * (r >> 2);
          int col = base + ci;
          float v = acc[mt][nt][r];
          P[(size_t)row * INWP + col] = f2bf(v);
          if (col >= C_DA && col < C_DA + 16) AB[(size_t)row * 16 + col - C_DA] = v;
        }
        if (base >= C_NV && base < C_NV + 256) {
          const int hv = (base - C_NV) >> 6, dv = ((base - C_NV) & 63) + ci;
#pragma unroll
          for (int g = 0; g < 4; ++g) {
            const int row0 = rbase + mt * 32 + 8 * g;
            int bb, key0;
            if (row0 < M_LAT) { bb = row0 >> 11; key0 = 256 + (row0 & 2047); }
            else { bb = (row0 - M_LAT) >> 8; key0 = (row0 - M_LAT) & 255; }
            uint2 u;
            u.x = pack2(acc[mt][nt][4 * g + 0], acc[mt][nt][4 * g + 1]);
            u.y = pack2(acc[mt][nt][4 * g + 2], acc[mt][nt][4 * g + 3]);
            *(uint2*)(NVT + ((size_t)(bb * 4 + hv) * 64 + dv) * 2304 + key0) = u;
          }
        }
      }
  } else if (EPI == EPI_GU) {
    bf16_t* ACT = (bf16_t*)(p.ws + OFF_P);
#pragma unroll
    for (int mt = 0; mt < 2; ++mt)
#pragma unroll
      for (int pr = 0; pr < 2; ++pr)
#pragma unroll
        for (int r = 0; r < 16; ++r) {
          int row = rbase + mt * 32 + (r & 3) + 8 * (r >> 2);
          float gt = acc[mt][2 * pr][r], up = acc[mt][2 * pr + 1][r];
          float a = silu_f(gt) * up;
          ACT[(size_t)row * FFN + ((cbase >> 6) + pr) * 32 + ci] = f2bf(a);
        }
  }
}

__device__ void kpe_item(const Params& p, int it) {
  const int tid = otid();
  const bf16_t* P = (const bf16_t*)(p.ws + OFF_P);
  bf16_t* KH = (bf16_t*)(p.ws + OFF_KH);
  const float* rc = (const float*)(p.ws + OFF_ROPE);
  const float* rsn = rc + 2048 * 16;
  const int row = it * 8 + (tid >> 5), i = tid & 31;
  float v = bf2f(P[(size_t)row * INWP + C_MPE + i]);
  float o = __shfl_xor(v, 8);
  if (row < M_LAT) {
    int t = row & 2047;
    int a = i >> 4, hf = (i >> 3) & 1, j = i & 7;
    float c = rc[t * 16 + a * 8 + j], s = rsn[t * 16 + a * 8 + j];
    v = hf ? (o * s + v * c) : (v * c - o * s);
  }
  bf16_t bv = f2bf(v);
  int bb, key;
  if (row < M_LAT) { bb = row >> 11; key = 256 + (row & 2047); }
  else { bb = (row - M_LAT) >> 8; key = (row - M_LAT) & 255; }
#pragma unroll
  for (int h = 0; h < 4; ++h) KH[((size_t)(bb * 4 + h) * 2304 + key) * 96 + 64 + i] = bv;
}

__device__ void dn_prep(const Params& p, int l, int it, char* smem) {
  float* buf = (float*)smem;
  float* nrm = buf + 8 * 1536;
  const int tid = otid();
  const bf16_t* P = (const bf16_t*)(p.ws + OFF_P);
  bf16_t* DQ = (bf16_t*)(p.ws + OFF_DNQKV);
  const int r0 = it * 8;
  int seq_lo, seq_hi;
  if (r0 < M_LAT) {
    seq_lo = (r0 >> 11) << 11;
    seq_hi = seq_lo + 2048;
  } else {
    int rr = r0 - M_LAT;
    seq_lo = M_LAT + ((rr >> 8) << 8);
    seq_hi = seq_lo + 256;
  }
  const float* cw = p.conv_w + (size_t)l * 5 * 1536;
  __syncthreads();
  for (int c6 = 0; c6 < 6; ++c6) {
    const int ch = c6 * 256 + tid;
    float w0 = cw[ch], w1 = cw[1536 + ch], w2 = cw[2 * 1536 + ch], w3 = cw[3 * 1536 + ch], w4 = cw[4 * 1536 + ch];
    float xw[12];
#pragma unroll
    for (int j = 0; j < 12; ++j) {
      int r = r0 - 2 + j;
      xw[j] = (r >= seq_lo && r < seq_hi) ? bf2f(P[(size_t)r * INWP + C_DN + ch]) : 0.f;
    }
#pragma unroll
    for (int j = 0; j < 8; ++j) {
      float y = w0 * xw[j] + w1 * xw[j + 1] + w2 * xw[j + 2] + w3 * xw[j + 3] + w4 * xw[j + 4];
      buf[j * 1536 + ch] = silu_f(y);
    }
  }
  __syncthreads();
  {
    int vec = tid >> 2, part = tid & 3;
    int rr = vec >> 3, hv = vec & 7;
    const float* v = buf + rr * 1536 + hv * 128 + part * 32;
    float ss = 0.f;
#pragma unroll
    for (int i = 0; i < 32; ++i) ss += v[i] * v[i];
    ss += __shfl_xor(ss, 1);
    ss += __shfl_xor(ss, 2);
    if (part == 0) nrm[vec] = rsqrtf(ss + 1e-6f);
  }
  __syncthreads();
  for (int i = tid; i < 8 * 1536; i += 256) {
    int rr = i / 1536, ch = i - rr * 1536;
    float v = buf[i];
    if (ch < 1024) v *= nrm[rr * 8 + (ch >> 7)];
    DQ[(size_t)(r0 + rr) * 1536 + ch] = f2bf(v);
  }
}


DEVI int rowmap(int r, int hh) { return (r & 3) + 8 * (r >> 2) + 4 * hh; }

__device__ void dn_chunk_prep(const Params& p, int l, int item, char* smem) {
  float* tile = (float*)smem;
  float* sL0 = (float*)smem;
  float* sL1 = sL0 + 64 * 68;
  bf16_t* sKb = (bf16_t*)(smem + 34816);
  float* sg = (float*)(smem + 52224);
  float* sbt = sg + 128;
  const int tid = otid(), lane = tid & 63, w = tid >> 6, li = lane & 31, hh = lane >> 5;
  const int chunk = item >> 2, h = item & 3;
  int row0, seq_lo, seq_hi;
  if (chunk < 256) {
    int b = chunk >> 5;
    row0 = b * 2048 + (chunk & 31) * 64; seq_lo = b * 2048; seq_hi = seq_lo + 2048;
  } else {
    int cc = chunk - 256, b = cc >> 2;
    row0 = M_LAT + b * 256 + (cc & 3) * 64; seq_lo = M_LAT + b * 256; seq_hi = seq_lo + 256;
  }
  const bf16_t* P = (const bf16_t*)(p.ws + OFF_P);
  bf16_t* DQ = (bf16_t*)(p.ws + OFF_DNQKV);
  const float* AB = (const float*)(p.ws + OFF_AB);
  const float* cw = p.conv_w + (size_t)l * 5 * 1536;
  __syncthreads();
  if (w < 2) {
    const int d = w;
    const int row = d ? (row0 + 63 - lane) : (row0 + lane);
    const float Aneg = -__expf(p.a_log[l * 8 + d * 4 + h]);
    const float dtb = p.dt_bias[l * 8 + d * 4 + h];
    float a = AB[(size_t)row * 16 + d * 4 + h];
    float bb = AB[(size_t)row * 16 + 8 + d * 4 + h];
    float xx = a + dtb;
    float sp = xx > 20.f ? xx : log1pf(__expf(xx));
    float g = Aneg * sp;
#pragma unroll
    for (int o = 1; o < 64; o <<= 1) {
      float y = __shfl_up(g, o);
      if (lane >= o) g += y;
    }
    float be = 1.f / (1.f + __expf(-bb));
    sg[d * 64 + lane] = g;
    sbt[d * 64 + lane] = be;
    ((float*)(p.ws + OFF_GC))[(size_t)row * 8 + d * 4 + h] = g;
    ((float*)(p.ws + OFF_BETA))[(size_t)row * 8 + d * 4 + h] = be;
  }
  const int c = tid & 127, rh = tid >> 7;
  for (int pass = 0; pass < 3; ++pass) {
    const int off = pass == 0 ? 512 : (pass == 1 ? 0 : 1024);
    const int ch = off + h * 128 + c;
    const float w0 = cw[ch], w1 = cw[1536 + ch], w2 = cw[2 * 1536 + ch], w3 = cw[3 * 1536 + ch], w4 = cw[4 * 1536 + ch];
    float x0, x1, x2, x3, x4;
    {
      const int rb = row0 + rh * 32 - 2;
      x0 = (rb + 0 >= seq_lo) ? bf2f(P[(size_t)(rb + 0) * INWP + C_DN + ch]) : 0.f;
      x1 = (rb + 1 >= seq_lo) ? bf2f(P[(size_t)(rb + 1) * INWP + C_DN + ch]) : 0.f;
      x2 = bf2f(P[(size_t)(rb + 2) * INWP + C_DN + ch]);
      x3 = bf2f(P[(size_t)(rb + 3) * INWP + C_DN + ch]);
    }
#pragma unroll 8
    for (int j = 0; j < 32; ++j) {
      const int r = row0 + rh * 32 + j + 2;
      x4 = (r < seq_hi) ? bf2f(P[(size_t)r * INWP + C_DN + ch]) : 0.f;
      float y = w0 * x0 + w1 * x1 + w2 * x2 + w3 * x3 + w4 * x4;
      y = silu_f(y);
      if (pass == 2)
        DQ[(size_t)(row0 + rh * 32 + j) * 1536 + ch] = f2bf(y);
      else
        tile[(rh * 32 + j) * 129 + c] = y;
      x0 = x1; x1 = x2; x2 = x3; x3 = x4;
    }
    if (pass < 2) {
      __syncthreads();
      const int row = tid >> 2, part = tid & 3;
      const float* tv = tile + row * 129 + part * 32;
      float ss = 0.f;
#pragma unroll
      for (int i = 0; i < 32; ++i) ss += tv[i] * tv[i];
      ss += __shfl_xor(ss, 1);
      ss += __shfl_xor(ss, 2);
      const float rn = rsqrtf(ss + 1e-6f);
      bf16_t* gp = DQ + (size_t)(row0 + row) * 1536 + off + h * 128 + part * 32;
#pragma unroll
      for (int i8 = 0; i8 < 4; ++i8) {
        uint4 u;
        u.x = pack2(tv[i8 * 8 + 0] * rn, tv[i8 * 8 + 1] * rn);
        u.y = pack2(tv[i8 * 8 + 2] * rn, tv[i8 * 8 + 3] * rn);
        u.z = pack2(tv[i8 * 8 + 4] * rn, tv[i8 * 8 + 5] * rn);
        u.w = pack2(tv[i8 * 8 + 6] * rn, tv[i8 * 8 + 7] * rn);
        *(uint4*)(gp + i8 * 8) = u;
        if (pass == 0) *(uint4*)(sKb + row * 136 + part * 32 + i8 * 8) = u;
      }
      __syncthreads();
    }
  }
  __syncthreads();
  {
    const int mi = w >> 1, ni = w & 1;
    f32x16 g;
#pragma unroll
    for (int r = 0; r < 16; ++r) g[r] = 0.f;
#pragma unroll
    for (int ks = 0; ks < 8; ++ks) {
      bf16x8 a = *(const bf16x8*)(sKb + (mi * 32 + li) * 136 + ks * 16 + hh * 8);
      bf16x8 b = *(const bf16x8*)(sKb + (ni * 32 + li) * 136 + ks * 16 + hh * 8);
      g = __builtin_amdgcn_mfma_f32_32x32x16_bf16(a, b, g, 0, 0, 0);
    }
#pragma unroll
    for (int r = 0; r < 16; ++r) {
      const int i = mi * 32 + rowmap(r, hh), m = ni * 32 + li;
      const float G = g[r];
      sL0[i * 68 + m] = (i > m) ? sbt[i] * G * __expf(sg[i] - sg[m]) : 0.f;
      const int i1 = 63 - i, m1 = 63 - m;
      sL1[i1 * 68 + m1] = (i1 > m1) ? sbt[64 + i1] * G * __expf(sg[64 + i1] - sg[64 + m1]) : 0.f;
    }
  }
  __syncthreads();
  if (w < 2) {
    const float* L = w == 0 ? sL0 : sL1;
    float t[64];
#pragma unroll
    for (int i = 0; i < 64; ++i) {
      float acc = (i == lane) ? 1.f : 0.f;
#pragma unroll
      for (int m = 0; m < i; ++m) acc -= L[i * 68 + m] * t[m];
      t[i] = acc;
    }
    bf16_t* Tg = (bf16_t*)(p.ws + OFF_OB) + (size_t)((chunk * 4 + h) * 2 + w) * 4096;
#pragma unroll
    for (int i = 0; i < 64; ++i) Tg[i * 64 + lane] = f2bf(t[i]);
  }
}

DEVI bf16x8 ld_perm(const bf16_t* p) {
  union { bf16x8 v; uint2 d[2]; } u;
  u.d[0] = *(const uint2*)(p);
  u.d[1] = *(const uint2*)(p + 8);
  return u.v;
}
DEVI bf16x8 pack8(const f32x16& x, int s) {
  union { bf16x8 v; unsigned w[4]; } u;
  u.w[0] = pack2(x[8 * s + 0], x[8 * s + 1]);
  u.w[1] = pack2(x[8 * s + 2], x[8 * s + 3]);
  u.w[2] = pack2(x[8 * s + 4], x[8 * s + 5]);
  u.w[3] = pack2(x[8 * s + 6], x[8 * s + 7]);
  return u.v;
}

__device__ void dn_scan(const Params& p, int l, int item, char* smem) {
  bf16_t* sK = (bf16_t*)smem;
  bf16_t* sQ = (bf16_t*)(smem + 17408);
  bf16_t* sKT = (bf16_t*)(smem + 34816);
  bf16_t* sT = (bf16_t*)(smem + 52224);
  bf16_t* sA = (bf16_t*)(smem + 60928);
  float* sg = (float*)(smem + 69632);
  float* sbt = sg + 64;
  float* seg = sbt + 64;
  float* sdt = seg + 64;
  const int d = item & 1, h = (item >> 1) & 3, b = item >> 3;
  const bf16_t* DQ = (const bf16_t*)(p.ws + OFF_DNQKV);
  const bf16_t* TB = (const bf16_t*)(p.ws + OFF_OB);
  const float* GC = (const float*)(p.ws + OFF_GC);
  const float* BE = (const float*)(p.ws + OFF_BETA);
  bf16_t* MIX = (bf16_t*)(p.ws + OFF_HM);
  bf16_t* Pw = (bf16_t*)(p.ws + OFF_P);
  const float qscale = 0.08838834764831845f;
  f32x16 S0, S1, S2, S3;
#pragma unroll
  for (int r = 0; r < 16; ++r) { S0[r] = 0.f; S1[r] = 0.f; S2[r] = 0.f; S3[r] = 0.f; }
  __builtin_amdgcn_s_setprio(3);
  for (int n = 0; n < 36; ++n) {
    const int tid = otid(), lane = tid & 63, w = tid >> 6, li = lane & 31, hh = lane >> 5;
    int chunk, row0;
    if (n < 4) {
      int cn = d ? (3 - n) : n;
      chunk = 256 + b * 4 + cn; row0 = M_LAT + b * 256 + cn * 64;
    } else {
      int ln = n - 4;
      ln = d ? (31 - ln) : ln;
      chunk = b * 32 + ln; row0 = b * 2048 + ln * 64;
    }
    __syncthreads();
#pragma unroll
    for (int e = 0; e < 4; ++e) {
      const int idx = tid + 256 * e, tok = idx >> 4, c8 = idx & 15;
      const int row = d ? (row0 + 63 - tok) : (row0 + tok);
      const bf16_t* gp = DQ + (size_t)row * 1536 + h * 128 + c8 * 8;
      uint4 uq = *(const uint4*)(gp);
      uint4 uk = *(const uint4*)(gp + 512);
      *(uint4*)(sQ + tok * 136 + c8 * 8) = uq;
      *(uint4*)(sK + tok * 136 + c8 * 8) = uk;
      bf16_t* kt = sKT + (c8 * 8) * 68 + tok;
      kt[0 * 68] = (bf16_t)(uk.x & 0xffff); kt[1 * 68] = (bf16_t)(uk.x >> 16);
      kt[2 * 68] = (bf16_t)(uk.y & 0xffff); kt[3 * 68] = (bf16_t)(uk.y >> 16);
      kt[4 * 68] = (bf16_t)(uk.z & 0xffff); kt[5 * 68] = (bf16_t)(uk.z >> 16);
      kt[6 * 68] = (bf16_t)(uk.w & 0xffff); kt[7 * 68] = (bf16_t)(uk.w >> 16);
    }
    {
      const bf16_t* Tg = TB + (size_t)((chunk * 4 + h) * 2 + d) * 4096;
#pragma unroll
      for (int e = 0; e < 2; ++e) {
        const int idx = tid + 256 * e, i = idx >> 3, c8 = idx & 7;
        uint4 u = *(const uint4*)(Tg + i * 64 + c8 * 8);
        *(uint2*)(sT + i * 68 + c8 * 8) = make_uint2(u.x, u.y);
        *(uint2*)(sT + i * 68 + c8 * 8 + 4) = make_uint2(u.z, u.w);
      }
    }
    if (w == 0) {
      const int row = d ? (row0 + 63 - lane) : (row0 + lane);
      float gc = GC[(size_t)row * 8 + d * 4 + h];
      float be = BE[(size_t)row * 8 + d * 4 + h];
      float g63 = __shfl(gc, 63);
      sg[lane] = gc;
      sbt[lane] = be;
      seg[lane] = __expf(gc);
      sdt[lane] = __expf(g63 - gc);
    }
    f32x16 v0, v1;
    const int rsign = d ? -1 : 1;
    const int rfirst = (d ? (row0 + 63) : row0) + rsign * 4 * hh;
    const bf16_t* vbase = DQ + (size_t)rfirst * 1536 + 1024 + h * 128 + w * 32 + li;
    const int vstep = rsign * 1536;
#pragma unroll
    for (int r = 0; r < 16; ++r) {
      const int t0 = (r & 3) + 8 * (r >> 2);
      v0[r] = bf2f(vbase[(t0)*vstep]);
      v1[r] = bf2f(vbase[(32 + t0) * vstep]);
    }
    __syncthreads();
    {
      const int mi = w >> 1, ni = w & 1;
      f32x16 a;
#pragma unroll
      for (int r = 0; r < 16; ++r) a[r] = 0.f;
      if (!(mi == 0 && ni == 1)) {
#pragma unroll
        for (int ks = 0; ks < 8; ++ks) {
          bf16x8 qa = *(const bf16x8*)(sQ + (mi * 32 + li) * 136 + ks * 16 + hh * 8);
          bf16x8 kb = *(const bf16x8*)(sK + (ni * 32 + li) * 136 + ks * 16 + hh * 8);
          a = __builtin_amdgcn_mfma_f32_32x32x16_bf16(qa, kb, a, 0, 0, 0);
        }
      }
#pragma unroll
      for (int r = 0; r < 16; ++r) {
        const int i = mi * 32 + rowmap(r, hh), j = ni * 32 + li;
        float val = (i >= j) ? a[r] * qscale * __expf(sg[i] - sg[j]) : 0.f;
        sA[i * 68 + j] = f2bf(val);
      }
    }
    __syncthreads();
    f32x16 ks0, ks1;
#pragma unroll
    for (int r = 0; r < 16; ++r) { ks0[r] = 0.f; ks1[r] = 0.f; }
    {
      const bf16_t* ka = sK + li * 136 + 4 * hh;
#define K_STEP(OFFS, SX, SS)                                                                           \
  {                                                                                                    \
    bf16x8 sb = pack8(SX, SS);                                                                         \
    ks0 = __builtin_amdgcn_mfma_f32_32x32x16_bf16(ld_perm(ka + (OFFS)), sb, ks0, 0, 0, 0);             \
    ks1 = __builtin_amdgcn_mfma_f32_32x32x16_bf16(ld_perm(ka + 32 * 136 + (OFFS)), sb, ks1, 0, 0, 0);  \
  }
      K_STEP(0, S0, 0) K_STEP(16, S0, 1) K_STEP(32, S1, 0) K_STEP(48, S1, 1)
      K_STEP(64, S2, 0) K_STEP(80, S2, 1) K_STEP(96, S3, 0) K_STEP(112, S3, 1)
#undef K_STEP
    }
#pragma unroll
    for (int r = 0; r < 16; ++r) {
      const int t0 = rowmap(r, hh), t1 = 32 + t0;
      v0[r] = sbt[t0] * (v0[r] - seg[t0] * ks0[r]);
      v1[r] = sbt[t1] * (v1[r] - seg[t1] * ks1[r]);
    }
    __builtin_amdgcn_sched_barrier(0);
    bf16x8 rb00 = pack8(v0, 0), rb01 = pack8(v0, 1), rb10 = pack8(v1, 0), rb11 = pack8(v1, 1);
    f32x16 n0, n1;
#pragma unroll
    for (int r = 0; r < 16; ++r) { n0[r] = 0.f; n1[r] = 0.f; }
    {
      const bf16_t* ta = sT + li * 68 + 4 * hh;
      n0 = __builtin_amdgcn_mfma_f32_32x32x16_bf16(ld_perm(ta + 0), rb00, n0, 0, 0, 0);
      n0 = __builtin_amdgcn_mfma_f32_32x32x16_bf16(ld_perm(ta + 16), rb01, n0, 0, 0, 0);
      const bf16_t* tb = ta + 32 * 68;
      n1 = __builtin_amdgcn_mfma_f32_32x32x16_bf16(ld_perm(tb + 0), rb00, n1, 0, 0, 0);
      n1 = __builtin_amdgcn_mfma_f32_32x32x16_bf16(ld_perm(tb + 16), rb01, n1, 0, 0, 0);
      n1 = __builtin_amdgcn_mfma_f32_32x32x16_bf16(ld_perm(tb + 32), rb10, n1, 0, 0, 0);
      n1 = __builtin_amdgcn_mfma_f32_32x32x16_bf16(ld_perm(tb + 48), rb11, n1, 0, 0, 0);
    }
    __builtin_amdgcn_sched_barrier(0);
    f32x16 o0, o1;
#pragma unroll
    for (int r = 0; r < 16; ++r) { o0[r] = 0.f; o1[r] = 0.f; }
    {
      const bf16_t* qa = sQ + li * 136 + 4 * hh;
#define Q_STEP(OFFS, SX, SS)                                                                           \
  {                                                                                                    \
    bf16x8 sb = pack8(SX, SS);                                                                         \
    o0 = __builtin_amdgcn_mfma_f32_32x32x16_bf16(ld_perm(qa + (OFFS)), sb, o0, 0, 0, 0);               \
    o1 = __builtin_amdgcn_mfma_f32_32x32x16_bf16(ld_perm(qa + 32 * 136 + (OFFS)), sb, o1, 0, 0, 0);    \
  }
      Q_STEP(0, S0, 0) Q_STEP(16, S0, 1) Q_STEP(32, S1, 0) Q_STEP(48, S1, 1)
      Q_STEP(64, S2, 0) Q_STEP(80, S2, 1) Q_STEP(96, S3, 0) Q_STEP(112, S3, 1)
#undef Q_STEP
    }
#pragma unroll
    for (int r = 0; r < 16; ++r) {
      const int t0 = rowmap(r, hh), t1 = 32 + t0;
      o0[r] *= seg[t0] * qscale;
      o1[r] *= seg[t1] * qscale;
    }
    {
      bf16x8 nb00 = pack8(n0, 0), nb01 = pack8(n0, 1), nb10 = pack8(n1, 0), nb11 = pack8(n1, 1);
      const bf16_t* aa = sA + li * 68 + 4 * hh;
      o0 = __builtin_amdgcn_mfma_f32_32x32x16_bf16(ld_perm(aa + 0), nb00, o0, 0, 0, 0);
      o0 = __builtin_amdgcn_mfma_f32_32x32x16_bf16(ld_perm(aa + 16), nb01, o0, 0, 0, 0);
      const bf16_t* ab = aa + 32 * 68;
      o1 = __builtin_amdgcn_mfma_f32_32x32x16_bf16(ld_perm(ab + 0), nb00, o1, 0, 0, 0);
      o1 = __builtin_amdgcn_mfma_f32_32x32x16_bf16(ld_perm(ab + 16), nb01, o1, 0, 0, 0);
      o1 = __builtin_amdgcn_mfma_f32_32x32x16_bf16(ld_perm(ab + 32), nb10, o1, 0, 0, 0);
      o1 = __builtin_amdgcn_mfma_f32_32x32x16_bf16(ld_perm(ab + 48), nb11, o1, 0, 0, 0);
    }
    bf16_t* obase = d ? (Pw + (size_t)rfirst * INWP + C_DN + h * 128 + w * 32 + li)
                      : (MIX + (size_t)rfirst * 1024 + 512 + h * 128 + w * 32 + li);
    const int ostep = d ? -INWP : 1024;
#pragma unroll
    for (int r = 0; r < 16; ++r) {
      const int t0 = (r & 3) + 8 * (r >> 2);
      obase[(t0)*ostep] = f2bf(o0[r]);
      obase[(32 + t0) * ostep] = f2bf(o1[r]);
    }
    __builtin_amdgcn_sched_barrier(0);
#pragma unroll
    for (int r = 0; r < 16; ++r) {
      const int t0 = rowmap(r, hh), t1 = 32 + t0;
      n0[r] *= sdt[t0];
      n1[r] *= sdt[t1];
    }
    {
      bf16x8 nb00 = pack8(n0, 0), nb01 = pack8(n0, 1), nb10 = pack8(n1, 0), nb11 = pack8(n1, 1);
      const float eg63 = seg[63];
#pragma unroll
      for (int r = 0; r < 16; ++r) { S0[r] *= eg63; S1[r] *= eg63; S2[r] *= eg63; S3[r] *= eg63; }
      const bf16_t* kt = sKT + li * 68 + 4 * hh;
#define S_UPD(SX, DKT)                                                                                   \
  SX = __builtin_amdgcn_mfma_f32_32x32x16_bf16(ld_perm(kt + (DKT) * 32 * 68 + 0), nb00, SX, 0, 0, 0);    \
  SX = __builtin_amdgcn_mfma_f32_32x32x16_bf16(ld_perm(kt + (DKT) * 32 * 68 + 16), nb01, SX, 0, 0, 0);   \
  SX = __builtin_amdgcn_mfma_f32_32x32x16_bf16(ld_perm(kt + (DKT) * 32 * 68 + 32), nb10, SX, 0, 0, 0);   \
  SX = __builtin_amdgcn_mfma_f32_32x32x16_bf16(ld_perm(kt + (DKT) * 32 * 68 + 48), nb11, SX, 0, 0, 0);
      S_UPD(S0, 0) S_UPD(S1, 1) S_UPD(S2, 2) S_UPD(S3, 3)
#undef S_UPD
    }
  }
  __builtin_amdgcn_s_setprio(0);
}

__device__ void phaseC(const Params& p, int l, char* smem) {
  const int nb = gridDim.x, bid = blockIdx.x;
  const bf16_t* P = (const bf16_t*)(p.ws + OFF_P);
  constexpr int T0 = 144 * 3, T1 = T0 + 144 * 4, T2 = T1 + M_ALL / 8, T3 = T2 + 1152;
  for (int it = bid; it < T3; it += nb) {
    if (it < T0) {
      int i = it;
      gemm_tile<EPI_QUP>(p, l, P + C_MQ, INWP, (const bf16_t*)(p.ws + OFF_WQUP), 256, (i / 3) * 128, (i % 3) * 128, 0,
                         smem);
    } else if (it < T1) {
      int i = it - T0;
      gemm_tile<EPI_KVUP>(p, l, P + C_MKV, INWP, (const bf16_t*)(p.ws + OFF_WKVUP), 128, (i / 4) * 128, (i % 4) * 128,
                          0, smem);
    } else if (it < T2) {
      kpe_item(p, it - T1);
    } else {
      dn_chunk_prep(p, l, it - T2, smem);
    }
  }
}

__device__ void mla_flash(const Params& p, int item, char* smem) {
  bf16_t* sK = (bf16_t*)smem;
  bf16_t* sV = sK + 64 * 104;
  const int tid = otid(), lane = tid & 63, w = tid >> 6;
  const int li = lane & 31, hh = lane >> 5;
  int b, h, q0row, nkeys;
  if (item < 512) {
    b = item >> 6; h = (item >> 4) & 3; q0row = b * 2048 + (item & 15) * 128; nkeys = 2304;
  } else {
    int i = item - 512;
    b = i >> 3; h = (i >> 1) & 3; q0row = M_LAT + b * 256 + (i & 1) * 128; nkeys = 256;
  }
  const bf16_t* Kg = (const bf16_t*)(p.ws + OFF_KH) + (size_t)(b * 4 + h) * 2304 * 96;
  const bf16_t* Vg = (const bf16_t*)(p.ws + OFF_VH) + (size_t)(b * 4 + h) * 64 * 2304;
  const bf16_t* QH = (const bf16_t*)(p.ws + OFF_QH);
  bf16_t* MIX = (bf16_t*)(p.ws + OFF_HM);
  const int qrow = q0row + w * 32 + li;
  bf16x8 qf0, qf1, qf2, qf3, qf4, qf5;
  {
    const bf16_t* qp = QH + (size_t)qrow * 384 + h * 96 + hh * 8;
    qf0 = *(const bf16x8*)(qp); qf1 = *(const bf16x8*)(qp + 16); qf2 = *(const bf16x8*)(qp + 32);
    qf3 = *(const bf16x8*)(qp + 48); qf4 = *(const bf16x8*)(qp + 64); qf5 = *(const bf16x8*)(qp + 80);
  }
  const int k_i0 = tid, k_i1 = tid + 256, k_i2 = tid + 512;
  const int kk0 = k_i0 / 12, kc0 = k_i0 % 12, kk1 = k_i1 / 12, kc1 = k_i1 % 12, kk2 = k_i2 / 12, kc2 = k_i2 % 12;
  const int vd0 = tid >> 3, vc0 = tid & 7, vd1 = vd0 + 32;
  uint4 rk0, rk1, rk2, rv0, rv1;
  rk0 = *(const uint4*)(Kg + (size_t)kk0 * 96 + kc0 * 8);
  rk1 = *(const uint4*)(Kg + (size_t)kk1 * 96 + kc1 * 8);
  rk2 = *(const uint4*)(Kg + (size_t)kk2 * 96 + kc2 * 8);
  rv0 = *(const uint4*)(Vg + (size_t)vd0 * 2304 + vc0 * 8);
  rv1 = *(const uint4*)(Vg + (size_t)vd1 * 2304 + vc0 * 8);
  f32x16 o0, o1;
#pragma unroll
  for (int r = 0; r < 16; ++r) { o0[r] = 0.f; o1[r] = 0.f; }
  float m = -1e30f, lp = 0.f;
  const float sc = 0.10206207261596577f * 1.4426950408889634f;
  const int nt = nkeys >> 6;
  for (int t = 0; t < nt; ++t) {
    __syncthreads();
    *(uint4*)(sK + kk0 * 104 + kc0 * 8) = rk0;
    *(uint4*)(sK + kk1 * 104 + kc1 * 8) = rk1;
    *(uint4*)(sK + kk2 * 104 + kc2 * 8) = rk2;
    *(uint2*)(sV + vd0 * 68 + vc0 * 8) = make_uint2(rv0.x, rv0.y);
    *(uint2*)(sV + vd0 * 68 + vc0 * 8 + 4) = make_uint2(rv0.z, rv0.w);
    *(uint2*)(sV + vd1 * 68 + vc0 * 8) = make_uint2(rv1.x, rv1.y);
    *(uint2*)(sV + vd1 * 68 + vc0 * 8 + 4) = make_uint2(rv1.z, rv1.w);
    __syncthreads();
    if (t + 1 < nt) {
      const int k0 = (t + 1) * 64;
      rk0 = *(const uint4*)(Kg + (size_t)(k0 + kk0) * 96 + kc0 * 8);
      rk1 = *(const uint4*)(Kg + (size_t)(k0 + kk1) * 96 + kc1 * 8);
      rk2 = *(const uint4*)(Kg + (size_t)(k0 + kk2) * 96 + kc2 * 8);
      rv0 = *(const uint4*)(Vg + (size_t)vd0 * 2304 + k0 + vc0 * 8);
      rv1 = *(const uint4*)(Vg + (size_t)vd1 * 2304 + k0 + vc0 * 8);
    }
    f32x16 s0, s1;
#pragma unroll
    for (int r = 0; r < 16; ++r) { s0[r] = 0.f; s1[r] = 0.f; }
    {
      const bf16_t* ka = sK + li * 104 + hh * 8;
      const bf16_t* kb = ka + 32 * 104;
      s0 = __builtin_amdgcn_mfma_f32_32x32x16_bf16(*(const bf16x8*)(ka), qf0, s0, 0, 0, 0);
      s1 = __builtin_amdgcn_mfma_f32_32x32x16_bf16(*(const bf16x8*)(kb), qf0, s1, 0, 0, 0);
      s0 = __builtin_amdgcn_mfma_f32_32x32x16_bf16(*(const bf16x8*)(ka + 16), qf1, s0, 0, 0, 0);
      s1 = __builtin_amdgcn_mfma_f32_32x32x16_bf16(*(const bf16x8*)(kb + 16), qf1, s1, 0, 0, 0);
      s0 = __builtin_amdgcn_mfma_f32_32x32x16_bf16(*(const bf16x8*)(ka + 32), qf2, s0, 0, 0, 0);
      s1 = __builtin_amdgcn_mfma_f32_32x32x16_bf16(*(const bf16x8*)(kb + 32), qf2, s1, 0, 0, 0);
      s0 = __builtin_amdgcn_mfma_f32_32x32x16_bf16(*(const bf16x8*)(ka + 48), qf3, s0, 0, 0, 0);
      s1 = __builtin_amdgcn_mfma_f32_32x32x16_bf16(*(const bf16x8*)(kb + 48), qf3, s1, 0, 0, 0);
      s0 = __builtin_amdgcn_mfma_f32_32x32x16_bf16(*(const bf16x8*)(ka + 64), qf4, s0, 0, 0, 0);
      s1 = __builtin_amdgcn_mfma_f32_32x32x16_bf16(*(const bf16x8*)(kb + 64), qf4, s1, 0, 0, 0);
      s0 = __builtin_amdgcn_mfma_f32_32x32x16_bf16(*(const bf16x8*)(ka + 80), qf5, s0, 0, 0, 0);
      s1 = __builtin_amdgcn_mfma_f32_32x32x16_bf16(*(const bf16x8*)(kb + 80), qf5, s1, 0, 0, 0);
    }
    float mx = s0[0];
#pragma unroll
    for (int r = 1; r < 16; ++r) mx = fmaxf(mx, s0[r]);
#pragma unroll
    for (int r = 0; r < 16; ++r) mx = fmaxf(mx, s1[r]);
    mx = fmaxf(mx, __shfl_xor(mx, 32));
    const float mn = fmaxf(m, mx * sc);
    const float corr = __builtin_amdgcn_exp2f(m - mn);
    m = mn;
    lp *= corr;
#pragma unroll
    for (int r = 0; r < 16; ++r) { o0[r] *= corr; o1[r] *= corr; }
#pragma unroll
    for (int r = 0; r < 16; ++r) {
      s0[r] = __builtin_amdgcn_exp2f(s0[r] * sc - mn);
      s1[r] = __builtin_amdgcn_exp2f(s1[r] * sc - mn);
      lp += s0[r] + s1[r];
    }
#pragma unroll
    for (int u = 0; u < 2; ++u) {
#pragma unroll
      for (int s = 0; s < 2; ++s) {
        union { bf16x8 v; unsigned w[4]; } pb;
        if (u == 0) {
          pb.w[0] = pack2(s0[8 * s + 0], s0[8 * s + 1]); pb.w[1] = pack2(s0[8 * s + 2], s0[8 * s + 3]);
          pb.w[2] = pack2(s0[8 * s + 4], s0[8 * s + 5]); pb.w[3] = pack2(s0[8 * s + 6], s0[8 * s + 7]);
        } else {
          pb.w[0] = pack2(s1[8 * s + 0], s1[8 * s + 1]); pb.w[1] = pack2(s1[8 * s + 2], s1[8 * s + 3]);
          pb.w[2] = pack2(s1[8 * s + 4], s1[8 * s + 5]); pb.w[3] = pack2(s1[8 * s + 6], s1[8 * s + 7]);
        }
        const bf16_t* va = sV + li * 68 + 32 * u + 16 * s + 4 * hh;
        union { bf16x8 v; uint2 d[2]; } a0, a1;
        a0.d[0] = *(const uint2*)(va);
        a0.d[1] = *(const uint2*)(va + 8);
        a1.d[0] = *(const uint2*)(va + 32 * 68);
        a1.d[1] = *(const uint2*)(va + 32 * 68 + 8);
        o0 = __builtin_amdgcn_mfma_f32_32x32x16_bf16(a0.v, pb.v, o0, 0, 0, 0);
        o1 = __builtin_amdgcn_mfma_f32_32x32x16_bf16(a1.v, pb.v, o1, 0, 0, 0);
      }
    }
  }
  lp += __shfl_xor(lp, 32);
  const float inv = 1.f / lp;
  bf16_t* op = MIX + (size_t)qrow * 1024 + h * 64 + 4 * hh;
#pragma unroll
  for (int g = 0; g < 4; ++g) {
    uint2 u0, u1;
    u0.x = pack2(o0[4 * g + 0] * inv, o0[4 * g + 1] * inv);
    u0.y = pack2(o0[4 * g + 2] * inv, o0[4 * g + 3] * inv);
    u1.x = pack2(o1[4 * g + 0] * inv, o1[4 * g + 1] * inv);
    u1.y = pack2(o1[4 * g + 2] * inv, o1[4 * g + 3] * inv);
    *(uint2*)(op + 8 * g) = u0;
    *(uint2*)(op + 32 + 8 * g) = u1;
  }
}

__device__ void na_naive(const Params& p, int l, int ti) {
  const int h = otid() >> 6, lane = otid() & 63;
  const bf16_t* P = (const bf16_t*)(p.ws + OFF_P);
  bf16_t* MIX = (bf16_t*)(p.ws + OFF_HM);
  const bool lat = ti < 256;
  const int b = lat ? (ti >> 5) : ((ti - 256) >> 2);
  const int r = ti & 31;
  const int row = lat ? (ti * 64 + lane) : (M_LAT + (ti - 256) * 64 + lane);
  uint4 qk[8];
  float acc[64];
  {
    const uint4* qp = (const uint4*)(P + (size_t)row * INWP + C_NQ + h * 64);
#pragma unroll
    for (int c = 0; c < 8; ++c) qk[c] = qp[c];
  }
#pragma unroll
  for (int i = 0; i < 64; ++i) acc[i] = 0.f;
  float m = -INFINITY, ls = 0.f;
  const int qc = lane;
  const int rs0 = min(max(r - 4, 0), 24);
  const int cs0 = min(max(qc - 8, 0), 48);
  const float* rb = p.rel_bias + (size_t)l * 4 * 15 * 31 + h * 15 * 31;
  const int nloc = lat ? 128 : 0;
  for (int j = 0; j < nloc + 256; ++j) {
    int krow;
    float bias = 0.f;
    if (j < nloc) {
      int kr = rs0 + (j >> 4), kc = cs0 + (j & 15);
      krow = b * 2048 + kr * 64 + kc;
      bias = rb[(kr - r + 7) * 31 + (kc - qc + 15)];
    } else {
      krow = M_LAT + b * 256 + (j - nloc);
    }
    const uint4* kp = (const uint4*)(P + (size_t)krow * INWP + C_NK + h * 64);
    float s = 0.f;
#pragma unroll
    for (int c = 0; c < 8; ++c) {
      uint4 u = kp[c];
      uint4 q = qk[c];
      s += bflo(q.x) * bflo(u.x) + bfhi(q.x) * bfhi(u.x) + bflo(q.y) * bflo(u.y) + bfhi(q.y) * bfhi(u.y) +
           bflo(q.z) * bflo(u.z) + bfhi(q.z) * bfhi(u.z) + bflo(q.w) * bflo(u.w) + bfhi(q.w) * bfhi(u.w);
    }
    s = s * 0.125f + bias;
    float mn = fmaxf(m, s);
    float corr = __expf(m - mn), pe = __expf(s - mn);
    ls = ls * corr + pe;
    m = mn;
    const uint4* vp = (const uint4*)(P + (size_t)krow * INWP + C_NV + h * 64);
#pragma unroll
    for (int c = 0; c < 8; ++c) {
      uint4 u = vp[c];
      acc[c * 8 + 0] = acc[c * 8 + 0] * corr + pe * bflo(u.x);
      acc[c * 8 + 1] = acc[c * 8 + 1] * corr + pe * bfhi(u.x);
      acc[c * 8 + 2] = acc[c * 8 + 2] * corr + pe * bflo(u.y);
      acc[c * 8 + 3] = acc[c * 8 + 3] * corr + pe * bfhi(u.y);
      acc[c * 8 + 4] = acc[c * 8 + 4] * corr + pe * bflo(u.z);
      acc[c * 8 + 5] = acc[c * 8 + 5] * corr + pe * bfhi(u.z);
      acc[c * 8 + 6] = acc[c * 8 + 6] * corr + pe * bflo(u.w);
      acc[c * 8 + 7] = acc[c * 8 + 7] * corr + pe * bfhi(u.w);
    }
  }
  const float inv = 1.f / ls;
  uint4* op = (uint4*)(MIX + (size_t)row * 1024 + 256 + h * 64);
#pragma unroll
  for (int c = 0; c < 8; ++c) {
    uint4 u;
    u.x = pack2(acc[c * 8 + 0] * inv, acc[c * 8 + 1] * inv);
    u.y = pack2(acc[c * 8 + 2] * inv, acc[c * 8 + 3] * inv);
    u.z = pack2(acc[c * 8 + 4] * inv, acc[c * 8 + 5] * inv);
    u.w = pack2(acc[c * 8 + 6] * inv, acc[c * 8 + 7] * inv);
    op[c] = u;
  }
}

__device__ void na_flash(const Params& p, int l, int item, char* smem) {
  bf16_t* sK = (bf16_t*)smem;
  bf16_t* sV = sK + 64 * 72;
  float* sBias = (float*)(smem + 18432);
  const int tid = otid(), lane = tid & 63, w = tid >> 6;
  const int li = lane & 31, hh = lane >> 5;
  const bf16_t* P = (const bf16_t*)(p.ws + OFF_P);
  bf16_t* MIX = (bf16_t*)(p.ws + OFF_HM);
  int b, h, qrow, qr = 0, qc = 0, rs0 = 0, ntiles, krow0 = 0;
  bool lat;
  if (item < 512) {
    lat = true;
    b = item >> 6; h = item & 3;
    const int r0 = ((item >> 2) & 15) * 2;
    qr = r0 + (w >> 1); qc = (w & 1) * 32 + li;
    qrow = b * 2048 + qr * 64 + qc;
    krow0 = min(max(r0 - 4, 0), 24);
    const int klast = min(max(r0 + 1 - 4, 0), 24) + 7;
    ntiles = 4 + (klast - krow0 + 1);
    rs0 = min(max(qr - 4, 0), 24);
  } else {
    lat = false;
    const int i = item - 512;
    b = i >> 3; h = i & 3;
    qrow = M_LAT + b * 256 + ((i >> 2) & 1) * 128 + w * 32 + li;
    ntiles = 4;
  }
  const int cs0 = min(max(qc - 8, 0), 48);
  const bf16_t* Vg = (const bf16_t*)(p.ws + OFF_NVT) + (size_t)(b * 4 + h) * 64 * 2304;
  bf16x8 qf0, qf1, qf2, qf3;
  {
    const bf16_t* qp = P + (size_t)qrow * INWP + C_NQ + h * 64 + hh * 8;
    qf0 = *(const bf16x8*)(qp); qf1 = *(const bf16x8*)(qp + 16); qf2 = *(const bf16x8*)(qp + 32); qf3 = *(const bf16x8*)(qp + 48);
  }
  __syncthreads();
  for (int i = tid; i < 465; i += 256)
    sBias[i] = p.rel_bias[(size_t)l * 4 * 465 + h * 465 + i] * 1.4426950408889634f;
  const int kk0 = tid >> 3, kc8 = tid & 7, kk1 = kk0 + 32;
  uint4 rk0, rk1, rv0, rv1;
  {
    const size_t kr = (size_t)(M_LAT + b * 256);
    rk0 = *(const uint4*)(P + (kr + kk0) * INWP + C_NK + h * 64 + kc8 * 8);
    rk1 = *(const uint4*)(P + (kr + kk1) * INWP + C_NK + h * 64 + kc8 * 8);
    rv0 = *(const uint4*)(Vg + (size_t)kk0 * 2304 + kc8 * 8);
    rv1 = *(const uint4*)(Vg + (size_t)kk1 * 2304 + kc8 * 8);
  }
  f32x16 o0, o1;
#pragma unroll
  for (int r = 0; r < 16; ++r) { o0[r] = 0.f; o1[r] = 0.f; }
  float m = -1e30f, lp = 0.f;
  const float sc = 0.125f * 1.4426950408889634f;
  for (int t = 0; t < ntiles; ++t) {
    __syncthreads();
    *(uint4*)(sK + kk0 * 72 + kc8 * 8) = rk0;
    *(uint4*)(sK + kk1 * 72 + kc8 * 8) = rk1;
    *(uint2*)(sV + kk0 * 68 + kc8 * 8) = make_uint2(rv0.x, rv0.y);
    *(uint2*)(sV + kk0 * 68 + kc8 * 8 + 4) = make_uint2(rv0.z, rv0.w);
    *(uint2*)(sV + kk1 * 68 + kc8 * 8) = make_uint2(rv1.x, rv1.y);
    *(uint2*)(sV + kk1 * 68 + kc8 * 8 + 4) = make_uint2(rv1.z, rv1.w);
    __syncthreads();
    if (t + 1 < ntiles) {
      const int tn = t + 1;
      size_t kr;
      int vk;
      if (tn < 4) { kr = (size_t)(M_LAT + b * 256 + tn * 64); vk = tn * 64; }
      else { kr = (size_t)(b * 2048 + (krow0 + tn - 4) * 64); vk = 256 + (krow0 + tn - 4) * 64; }
      rk0 = *(const uint4*)(P + (kr + kk0) * INWP + C_NK + h * 64 + kc8 * 8);
      rk1 = *(const uint4*)(P + (kr + kk1) * INWP + C_NK + h * 64 + kc8 * 8);
      rv0 = *(const uint4*)(Vg + (size_t)kk0 * 2304 + vk + kc8 * 8);
      rv1 = *(const uint4*)(Vg + (size_t)kk1 * 2304 + vk + kc8 * 8);
    }
    const int kr_abs = krow0 + t - 4;
    const bool local = t >= 4;
    if (local && (kr_abs < rs0 || kr_abs >= rs0 + 8)) continue;
    f32x16 s0, s1;
#pragma unroll
    for (int r = 0; r < 16; ++r) { s0[r] = 0.f; s1[r] = 0.f; }
    {
      const bf16_t* ka = sK + li * 72 + hh * 8;
      const bf16_t* kb = ka + 32 * 72;
      s0 = __builtin_amdgcn_mfma_f32_32x32x16_bf16(*(const bf16x8*)(ka), qf0, s0, 0, 0, 0);
      s1 = __builtin_amdgcn_mfma_f32_32x32x16_bf16(*(const bf16x8*)(kb), qf0, s1, 0, 0, 0);
      s0 = __builtin_amdgcn_mfma_f32_32x32x16_bf16(*(const bf16x8*)(ka + 16), qf1, s0, 0, 0, 0);
      s1 = __builtin_amdgcn_mfma_f32_32x32x16_bf16(*(const bf16x8*)(kb + 16), qf1, s1, 0, 0, 0);
      s0 = __builtin_amdgcn_mfma_f32_32x32x16_bf16(*(const bf16x8*)(ka + 32), qf2, s0, 0, 0, 0);
      s1 = __builtin_amdgcn_mfma_f32_32x32x16_bf16(*(const bf16x8*)(kb + 32), qf2, s1, 0, 0, 0);
      s0 = __builtin_amdgcn_mfma_f32_32x32x16_bf16(*(const bf16x8*)(ka + 48), qf3, s0, 0, 0, 0);
      s1 = __builtin_amdgcn_mfma_f32_32x32x16_bf16(*(const bf16x8*)(kb + 48), qf3, s1, 0, 0, 0);
    }
    if (local) {
      const float* bp = sBias + (kr_abs - qr + 7) * 31 - qc + 15;
#pragma unroll
      for (int r = 0; r < 16; ++r) {
        const int kc0 = rowmap(r, hh), kc1 = 32 + kc0;
        const bool v0 = (kc0 >= cs0) && (kc0 < cs0 + 16);
        const bool v1 = (kc1 >= cs0) && (kc1 < cs0 + 16);
        const float b0 = v0 ? bp[kc0] : 0.f;
        const float b1 = v1 ? bp[kc1] : 0.f;
        s0[r] = v0 ? (s0[r] * sc + b0) : -1e30f;
        s1[r] = v1 ? (s1[r] * sc + b1) : -1e30f;
      }
    } else {
#pragma unroll
      for (int r = 0; r < 16; ++r) { s0[r] *= sc; s1[r] *= sc; }
    }
    float mx = s0[0];
#pragma unroll
    for (int r = 1; r < 16; ++r) mx = fmaxf(mx, s0[r]);
#pragma unroll
    for (int r = 0; r < 16; ++r) mx = fmaxf(mx, s1[r]);
    mx = fmaxf(mx, __shfl_xor(mx, 32));
    const float mn = fmaxf(m, mx);
    const float corr = __builtin_amdgcn_exp2f(m - mn);
    m = mn;
    lp *= corr;
#pragma unroll
    for (int r = 0; r < 16; ++r) { o0[r] *= corr; o1[r] *= corr; }
#pragma unroll
    for (int r = 0; r < 16; ++r) {
      s0[r] = __builtin_amdgcn_exp2f(s0[r] - mn);
      s1[r] = __builtin_amdgcn_exp2f(s1[r] - mn);
      lp += s0[r] + s1[r];
    }
#pragma unroll
    for (int u = 0; u < 2; ++u) {
#pragma unroll
      for (int s = 0; s < 2; ++s) {
        bf16x8 pb = u == 0 ? pack8(s0, s) : pack8(s1, s);
        const bf16_t* va = sV + li * 68 + 32 * u + 16 * s + 4 * hh;
        o0 = __builtin_amdgcn_mfma_f32_32x32x16_bf16(ld_perm(va), pb, o0, 0, 0, 0);
        o1 = __builtin_amdgcn_mfma_f32_32x32x16_bf16(ld_perm(va + 32 * 68), pb, o1, 0, 0, 0);
      }
    }
  }
  lp += __shfl_xor(lp, 32);
  const float inv = 1.f / lp;
  bf16_t* op = MIX + (size_t)qrow * 1024 + 256 + h * 64 + 4 * hh;
#pragma unroll
  for (int g = 0; g < 4; ++g) {
    uint2 u0, u1;
    u0.x = pack2(o0[4 * g + 0] * inv, o0[4 * g + 1] * inv);
    u0.y = pack2(o0[4 * g + 2] * inv, o0[4 * g + 3] * inv);
    u1.x = pack2(o1[4 * g + 0] * inv, o1[4 * g + 1] * inv);
    u1.y = pack2(o1[4 * g + 2] * inv, o1[4 * g + 3] * inv);
    *(uint2*)(op + 8 * g) = u0;
    *(uint2*)(op + 32 + 8 * g) = u1;
  }
}

DEVI int dn_rowof(int s, int b, int d) {
  if (s < 256) {
    int c = d ? (255 - s) : s;
    return M_LAT + b * 256 + c;
  }
  int t = s - 256;
  t = d ? (2047 - t) : t;
  return b * 2048 + t;
}

__device__ void dn_naive(const Params& p, int l, int it, char* smem) {
  float* ks = (float*)smem;
  float* qs = ks + 32 * 128;
  float* vs = qs + 32 * 128;
  float* gs = vs + 32 * 64;
  float* bs = gs + 32;
  const int half = it & 1, d = (it >> 1) & 1, h = (it >> 2) & 3, b = it >> 4;
  const int tid = otid(), w = tid >> 6, lane = tid & 63, c = lane & 15, kg = lane >> 4;
  const int col = half * 64 + w * 16 + c;
  const bf16_t* DQ = (const bf16_t*)(p.ws + OFF_DNQKV);
  const float* AB = (const float*)(p.ws + OFF_AB);
  bf16_t* MIX = (bf16_t*)(p.ws + OFF_HM);
  bf16_t* OB = (bf16_t*)(p.ws + OFF_OB);
  float S[32];
#pragma unroll
  for (int i = 0; i < 32; ++i) S[i] = 0.f;
  const float Aneg = -__expf(p.a_log[l * 8 + d * 4 + h]);
  const float dtb = p.dt_bias[l * 8 + d * 4 + h];
  for (int s0 = 0; s0 < 2304; s0 += 32) {
    __syncthreads();
    for (int i = tid; i < 32 * 128; i += 256) {
      int tk = i >> 7, ch = i & 127;
      int row = dn_rowof(s0 + tk, b, d);
      qs[i] = bf2f(DQ[(size_t)row * 1536 + h * 128 + ch]);
      ks[i] = bf2f(DQ[(size_t)row * 1536 + 512 + h * 128 + ch]);
    }
    for (int i = tid; i < 32 * 64; i += 256) {
      int tk = i >> 6, ch = i & 63;
      int row = dn_rowof(s0 + tk, b, d);
      vs[i] = bf2f(DQ[(size_t)row * 1536 + 1024 + h * 128 + half * 64 + ch]);
    }
    if (tid < 32) {
      int row = dn_rowof(s0 + tid, b, d);
      float a = AB[(size_t)row * 16 + d * 4 + h];
      float bb = AB[(size_t)row * 16 + 8 + d * 4 + h];
      float xx = a + dtb;
      float sp = xx > 20.f ? xx : log1pf(__expf(xx));
      gs[tid] = __expf(Aneg * sp);
      bs[tid] = 1.f / (1.f + __expf(-bb));
    }
    __syncthreads();
    for (int tk = 0; tk < 32; ++tk) {
      const float eg = gs[tk], beta = bs[tk];
      const float vv = vs[tk * 64 + w * 16 + c];
      const float4* k4 = (const float4*)(ks + tk * 128 + kg * 32);
      const float4* q4 = (const float4*)(qs + tk * 128 + kg * 32);
      float part = 0.f;
#pragma unroll
      for (int i = 0; i < 8; ++i) {
        float4 kk = k4[i];
        S[4 * i + 0] *= eg; S[4 * i + 1] *= eg; S[4 * i + 2] *= eg; S[4 * i + 3] *= eg;
        part += kk.x * S[4 * i + 0] + kk.y * S[4 * i + 1] + kk.z * S[4 * i + 2] + kk.w * S[4 * i + 3];
      }
      part += __shfl_xor(part, 16);
      part += __shfl_xor(part, 32);
      const float delta = beta * (vv - part);
      float po = 0.f;
#pragma unroll
      for (int i = 0; i < 8; ++i) {
        float4 kk = k4[i];
        float4 qq = q4[i];
        S[4 * i + 0] += kk.x * delta; S[4 * i + 1] += kk.y * delta; S[4 * i + 2] += kk.z * delta; S[4 * i + 3] += kk.w * delta;
        po += qq.x * S[4 * i + 0] + qq.y * S[4 * i + 1] + qq.z * S[4 * i + 2] + qq.w * S[4 * i + 3];
      }
      po += __shfl_xor(po, 16);
      po += __shfl_xor(po, 32);
      if (kg == 0) {
        int row = dn_rowof(s0 + tk, b, d);
        float o = po * 0.08838834764831845f;
        if (d == 0)
          MIX[(size_t)row * 1024 + 512 + h * 128 + col] = f2bf(o);
        else
          OB[(size_t)row * 512 + h * 128 + col] = f2bf(o);
      }
    }
  }
}

__device__ void phaseD(const Params& p, int l, char* smem) {
  const int nb = gridDim.x, bid = blockIdx.x;
  constexpr int T0 = 64, T1 = T0 + 576, T2 = T1 + 576;
  for (int it = bid; it < T2; it += nb) {
    if (it < T0)
      dn_scan(p, l, it, smem);
    else if (it < T1)
    {
      const int j = it - T0;
      int item = j;
      if (j < 512) item = ((j & 7) * 64) + (j >> 3);
      mla_flash(p, item, smem);
    }
    else
      na_flash(p, l, it - T1, smem);
  }
}

__device__ void outgate_item(const Params& p, int l, int item) {
  const int w = otid() >> 6, lane = otid() & 63;
  const int row = item * 4 + w;
  const bf16_t* P = (const bf16_t*)(p.ws + OFF_P);
  bf16_t* MIX = (bf16_t*)(p.ws + OFF_HM);
  const int h = lane >> 4, cb = (lane & 15) * 8;
  uint4 uo = *(const uint4*)(MIX + (size_t)row * 1024 + 512 + h * 128 + cb);
  uint4 ub = *(const uint4*)(P + (size_t)row * INWP + C_DN + h * 128 + cb);
  uint4 uz = *(const uint4*)(P + (size_t)row * INWP + C_DZ + h * 128 + cb);
  float o[8], z[8];
  o[0] = bflo(uo.x) + bflo(ub.x); o[1] = bfhi(uo.x) + bfhi(ub.x); o[2] = bflo(uo.y) + bflo(ub.y); o[3] = bfhi(uo.y) + bfhi(ub.y);
  o[4] = bflo(uo.z) + bflo(ub.z); o[5] = bfhi(uo.z) + bfhi(ub.z); o[6] = bflo(uo.w) + bflo(ub.w); o[7] = bfhi(uo.w) + bfhi(ub.w);
  z[0] = bflo(uz.x); z[1] = bfhi(uz.x); z[2] = bflo(uz.y); z[3] = bfhi(uz.y);
  z[4] = bflo(uz.z); z[5] = bfhi(uz.z); z[6] = bflo(uz.w); z[7] = bfhi(uz.w);
  float ss = 0.f;
#pragma unroll
  for (int e = 0; e < 8; ++e) ss += o[e] * o[e];
  ss += __shfl_xor(ss, 1);
  ss += __shfl_xor(ss, 2);
  ss += __shfl_xor(ss, 4);
  ss += __shfl_xor(ss, 8);
  const float r = rsqrtf(ss * (1.f / 128.f) + 1e-6f);
  const float* go = p.g_out + l * 128 + cb;
  float y[8];
#pragma unroll
  for (int e = 0; e < 8; ++e) y[e] = o[e] * r * go[e] * silu_f(z[e]);
  uint4 u;
  u.x = pack2(y[0], y[1]); u.y = pack2(y[2], y[3]); u.z = pack2(y[4], y[5]); u.w = pack2(y[6], y[7]);
  *(uint4*)(MIX + (size_t)row * 1024 + 512 + h * 128 + cb) = u;
}

__device__ void final_item(const Params& p, int item) {
  const int w = otid() >> 6, lane = otid() & 63;
  const int row = item * 4 + w;
  const float4* xr = (const float4*)((const float*)(p.ws + OFF_X) + (size_t)row * 1024);
  float4 v[4];
  float ss = 0.f;
#pragma unroll
  for (int i = 0; i < 4; ++i) {
    v[i] = xr[lane + 64 * i];
    ss += v[i].x * v[i].x + v[i].y * v[i].y + v[i].z * v[i].z + v[i].w * v[i].w;
  }
  ss = wave_sum(ss);
  const float r = rsqrtf(ss * (1.f / 1024.f) + 1e-6f);
  const float4* g4 = (const float4*)p.g_final;
  float4* o4 = (float4*)(p.out + (size_t)row * 1024);
#pragma unroll
  for (int i = 0; i < 4; ++i) {
    float4 gg = g4[lane + 64 * i];
    float4 y;
    y.x = v[i].x * r * gg.x; y.y = v[i].y * r * gg.y; y.z = v[i].z * r * gg.z; y.w = v[i].w * r * gg.w;
    o4[lane + 64 * i] = y;
  }
}

constexpr int N_PHASES = 1 + 9 * 4 + 1;

__global__ void __launch_bounds__(256, 2) mega(Params p) {
  __shared__ __attribute__((aligned(16))) char smem[SMEM_BYTES];
  cg::grid_group grid = cg::this_grid();
  const int nb = gridDim.x, bid = blockIdx.x;
  __shared__ uint4 xb_words;
  if (threadIdx.x == 0) xb_words = make_uint4(0u, 0u, 0u, 0u);
  __syncthreads();
  XcdBarrier xb = xcd_barrier_post((unsigned*)(p.ws + OFF_BAR), (volatile LAS unsigned*)&xb_words);
#ifdef PROBE_S
  bool again = false;
#endif
  for (int ph = p.ph_lo; ph < p.ph_hi; ++ph) {
    if (ph == 0) {
      phase0(p, smem);
    } else if (ph == N_PHASES - 1) {
      for (int it = bid; it < M_LAT / 4; it += nb) final_item(p, it);
    } else {
      const int l = (ph - 1) / 9, s = (ph - 1) % 9;
      if (s == 0) {
        phaseA(p, l, smem);
      } else if (s == 1) {
        for (int it = bid; it < 144 * 13; it += nb) {
          int mt, nt;
          tile_map(it, 13, mt, nt);
          gemm_wide<EPI_P>(p, l, (const bf16_t*)(p.ws + OFF_HM), 1024, (const bf16_t*)(p.ws + OFF_WIN), 1024,
                           mt * 128, nt * 256, 0, smem);
        }
      } else if (s == 2) {
        phaseC(p, l, smem);
      } else if (s == 3) {
        phaseD(p, l, smem);
      } else if (s == 4) {
        for (int it = bid; it < M_ALL / 4; it += nb) outgate_item(p, l, it);
      } else if (s == 5) {
        for (int it = bid; it < 144 * 8; it += nb) {
          int mt, nt;
          tile_map(it, 8, mt, nt);
          gemm_tile<EPI_RES>(p, l, (const bf16_t*)(p.ws + OFF_HM), 1024, (const bf16_t*)(p.ws + OFF_WOUT), 1024,
                             mt * 128, nt * 128, 2, smem);
        }
      } else if (s == 6) {
        for (int it = bid; it < M_ALL / 4; it += nb)
          norm_rows((const float*)(p.ws + OFF_X), (bf16_t*)(p.ws + OFF_HM), p.g_ffn + l * 1024,
                    (const float*)(p.ws + OFF_MOD) + (size_t)l * 9 * 6144, 3, 4, it);
      } else if (s == 7) {
        for (int it = bid; it < 144 * 22; it += nb) {
          int mt, nt;
          tile_map(it, 22, mt, nt);
          gemm_wide<EPI_GU>(p, l, (const bf16_t*)(p.ws + OFF_HM), 1024, (const bf16_t*)(p.ws + OFF_WGU), 1024,
                            mt * 128, nt * 256, 0, smem);
        }
      } else {
        for (int it = bid; it < 144 * 8; it += nb) {
          int mt, nt;
          tile_map(it, 8, mt, nt);
          gemm_tile<EPI_RES>(p, l, (const bf16_t*)(p.ws + OFF_P), FFN, (const bf16_t*)(p.ws + OFF_WDN), FFN,
                             mt * 128, nt * 128, 5, smem);
        }
      }
    }
#ifdef PROBE_S
    {
      const bool hit = (PROBE_S == 9) ? (ph == 0) : (ph != 0 && ph != N_PHASES - 1 && ((ph - 1) % 9) == PROBE_S);
      if (hit && !again) {
        again = true;
        if (p.use_cg) grid.sync(); else xcd_barrier(xb);
        --ph;
        continue;
      }
      again = false;
    }
#endif
    if (ph + 1 < p.ph_hi) {
      if (p.use_cg) grid.sync();
      else xcd_barrier(xb);
    }
  }
}

extern "C" void kernel_launch(void* const* d_in, const int* in_sizes, int n_in, void* d_out, int out_size, void* d_ws,
                              size_t ws_size, hipStream_t stream) {
  static int grid_blocks = 0;
  if (!grid_blocks) {
    int dev = 0, cus = 0, per_cu = 0;
    hipGetDevice(&dev);
    hipDeviceGetAttribute(&cus, hipDeviceAttributeMultiprocessorCount, dev);
    hipOccupancyMaxActiveBlocksPerMultiprocessor(&per_cu, mega, 256, 0);
    if (per_cu < 1) per_cu = 1;
    if (per_cu > 2) per_cu = 2;
    grid_blocks = cus * per_cu;
  }
  Params p{};
  const float** pp = (const float**)&p;
  for (int i = 0; i < 23; ++i) pp[i] = (const float*)d_in[i];
  p.out = (float*)d_out;
  p.ws = (char*)d_ws;
  p.ph_lo = 0;
  p.ph_hi = N_PHASES;
  p.use_cg = 0;
  p.pad0 = 0;
  hipMemsetAsync((char*)d_ws + OFF_BAR, 0, XCD_BAR_WORDS * sizeof(unsigned), stream);
  void* args[] = {&p};
  hipError_t e = hipLaunchCooperativeKernel((void*)mega, dim3(grid_blocks), dim3(256), args, 0, stream);
  if (e != hipSuccess) {
    fprintf(stderr, "cooperative launch failed: %s (grid %d)\n", hipGetErrorString(e), grid_blocks);
    (void)hipGetLastError();
    for (int ph = 0; ph < N_PHASES; ++ph) {
      p.ph_lo = ph;
      p.ph_hi = ph + 1;
      hipLaunchKernelGGL(mega, dim3(grid_blocks), dim3(256), 0, stream, p);
    }
  }
}
```

```cpp
#include <hip/hip_runtime.h>
#include <hip/hip_bf16.h>
#include <hip/hip_cooperative_groups.h>
#include <cstdio>
namespace cg = cooperative_groups;

#define DEVI __device__ __forceinline__
typedef unsigned short bf16_t;
typedef short bf16x8 __attribute__((ext_vector_type(8)));
typedef float f32x16 __attribute__((ext_vector_type(16)));

constexpr int M_LAT = 16384, M_CTX = 2048, M_ALL = 18432;
constexpr int DM = 1024, INW = 3248, INWP = 3328, FFN = 2816;
constexpr int C_MQ = 0, C_MKV = 256, C_MPE = 384, C_NQ = 416, C_NK = 672, C_NV = 928, C_DN = 1184;
constexpr int C_DZ = C_DN + 1536, C_DA = C_DN + 2048;

constexpr size_t OFF_WIN = 0;
constexpr size_t OFF_WOUT = OFF_WIN + (size_t)INWP * 1024 * 2;
constexpr size_t OFF_WGU = OFF_WOUT + (size_t)1024 * 1024 * 2;
constexpr size_t OFF_WDN = OFF_WGU + (size_t)2 * FFN * 1024 * 2;
constexpr size_t OFF_WQUP = OFF_WDN + (size_t)1024 * FFN * 2;
constexpr size_t OFF_WKVUP = OFF_WQUP + (size_t)384 * 256 * 2;
constexpr size_t OFF_MOD = OFF_WKVUP + (size_t)512 * 128 * 2;
constexpr size_t OFF_ROPE = OFF_MOD + (size_t)4 * 9 * 6144 * 4;
constexpr size_t OFF_X = OFF_ROPE + (size_t)2048 * 16 * 2 * 4;
constexpr size_t OFF_HM = OFF_X + (size_t)M_ALL * 1024 * 4;
constexpr size_t OFF_P = OFF_HM + (size_t)M_ALL * 1024 * 2;
constexpr size_t OFF_QH = OFF_P + (size_t)M_ALL * INWP * 2;
constexpr size_t OFF_KH = OFF_QH + (size_t)M_ALL * 384 * 2;
constexpr size_t OFF_VH = OFF_KH + (size_t)M_ALL * 384 * 2;
constexpr size_t OFF_DNQKV = OFF_VH + (size_t)M_ALL * 256 * 2;
constexpr size_t OFF_OB = OFF_DNQKV + (size_t)M_ALL * 1536 * 2;
constexpr size_t OFF_AB = OFF_OB + (size_t)M_ALL * 512 * 2;
constexpr size_t OFF_GC = OFF_AB + (size_t)M_ALL * 16 * 4;
constexpr size_t OFF_BETA = OFF_GC + (size_t)M_ALL * 8 * 4;
constexpr size_t OFF_NVT = OFF_BETA + (size_t)M_ALL * 8 * 4;
constexpr size_t WS_TOTAL = OFF_NVT + (size_t)M_ALL * 256 * 2;
constexpr int SMEM_BYTES = 74240;
constexpr size_t OFF_BAR = (WS_TOTAL + 255) & ~(size_t)255;

struct Params {
  const float *x, *c, *ctx, *c_ctx, *w_ada, *b_ada, *g_mix, *w_in, *g_q, *g_kv, *w_qup, *w_kvup, *rel_bias,
      *conv_w, *a_log, *dt_bias, *g_out, *w_out, *g_ffn, *w_gate, *w_up, *w_down, *g_final;
  float* out;
  char* ws;
  int ph_lo, ph_hi;
  int use_cg, pad0;
};

DEVI bf16_t f2bf(float f) {
  __bf16 r = (__bf16)f;
  return __builtin_bit_cast(unsigned short, r);
}
DEVI int otid() {
  int t = threadIdx.x;
  asm volatile("" : "+v"(t));
  return t;
}
DEVI float bf2f(bf16_t h) { return __uint_as_float(((unsigned)h) << 16); }
DEVI float bflo(unsigned u) { return __uint_as_float(u << 16); }
DEVI float bfhi(unsigned u) { return __uint_as_float(u & 0xffff0000u); }
typedef __bf16 bf16v2_t __attribute__((ext_vector_type(2)));
typedef float f32v2_t __attribute__((ext_vector_type(2)));
DEVI unsigned pack2(float a, float b) {
  f32v2_t v = {a, b};
  bf16v2_t r = __builtin_convertvector(v, bf16v2_t);
  return __builtin_bit_cast(unsigned, r);
}
DEVI float silu_f(float x) { return x / (1.f + __expf(-x)); }
DEVI float wave_sum(float v) {
#pragma unroll
  for (int o = 32; o >= 1; o >>= 1) v += __shfl_xor(v, o);
  return v;
}

#define XB_TMO 128
#define XB_XCNT(j) (256 + 64 * (j))
#define XB_XSUB(j) (1280 + 64 * (j))
#define XB_XGEN(j) (2304 + 64 * (j))
#define XB_TOP 3328
#define XB_TOPGEN 3392
#define XCD_BAR_WORDS 3456
#define XB_SPIN_CAP (1u << 22)
#define LAS __attribute__((address_space(3)))
DEVI unsigned xb_ld(unsigned* p) { return __hip_atomic_load(p, __ATOMIC_RELAXED, __HIP_MEMORY_SCOPE_AGENT); }
DEVI unsigned xb_add(unsigned* p, unsigned v) { return __hip_atomic_fetch_add(p, v, __ATOMIC_RELAXED, __HIP_MEMORY_SCOPE_AGENT); }
DEVI unsigned xb_xcc_id() { return (unsigned)__builtin_amdgcn_s_getreg((3 << 11) | 20) & 0xFu; }
#define XB_SPIN(cond, bar)                                                     \
  do {                                                                         \
    unsigned _sp = 0;                                                          \
    while (cond) {                                                             \
      __builtin_amdgcn_s_sleep(1);                                             \
      if ((++_sp & 255u) == 0u) {                                              \
        if (xb_ld(&(bar)[XB_TMO])) break;                                      \
        if (_sp > XB_SPIN_CAP) { atomicAdd(&(bar)[XB_TMO], 1u); break; }       \
      }                                                                        \
    }                                                                          \
  } while (0)
struct XcdBarrier {
  unsigned* bar;
  unsigned x;
  volatile LAS unsigned* st;
};
DEVI XcdBarrier xcd_barrier_post(unsigned* bar, volatile LAS unsigned* st) {
  XcdBarrier b;
  b.bar = bar;
  b.x = xb_xcc_id();
  b.st = st;
  if (threadIdx.x == 0) (void)xb_add(&bar[XB_XCNT(b.x)], 1u);
  return b;
}
DEVI void xcd_barrier_complete(unsigned* bar, unsigned x, unsigned& nloc, unsigned& nx) {
  const unsigned G = gridDim.x * gridDim.y * gridDim.z;
  unsigned sum, cnt, mine, sp = 0u;
  for (;;) {
    sum = 0u; cnt = 0u; mine = 0u;
#pragma unroll
    for (unsigned j = 0; j < 16; ++j) {
      const unsigned c = xb_ld(&bar[XB_XCNT(j)]);
      sum += c;
      cnt += (c > 0u) ? 1u : 0u;
      mine = (j == x) ? c : mine;
    }
    if (sum == G) break;
    __builtin_amdgcn_s_sleep(1);
    if ((++sp & 255u) == 0u) {
      if (xb_ld(&bar[XB_TMO])) break;
      if (sp > XB_SPIN_CAP) { atomicAdd(&bar[XB_TMO], 1u); break; }
    }
  }
  nloc = mine > 0u ? mine : 1u;
  nx = cnt > 0u ? cnt : 1u;
}
DEVI void xcd_barrier(const XcdBarrier& b) {
  asm volatile("s_waitcnt vmcnt(0)" ::: "memory");
  __syncthreads();
  if (threadIdx.x == 0) {
    unsigned* bar = b.bar;
    __builtin_amdgcn_s_waitcnt(0);
    unsigned nloc = b.st[0], nx = b.st[1];
    if (nloc == 0u) {
      xcd_barrier_complete(bar, b.x, nloc, nx);
      b.st[0] = nloc;
      b.st[1] = nx;
    }
    const unsigned old = xb_add(&bar[XB_XSUB(b.x)], 1u);
    const unsigned gen = old / nloc;
    if (old + 1u == (gen + 1u) * nloc) {
      __builtin_amdgcn_fence(__ATOMIC_RELEASE, "agent");
      asm volatile("s_waitcnt vmcnt(0)" ::: "memory");
      const unsigned og = xb_add(&bar[XB_TOP], 1u);
      const unsigned tg = og / nx;
      if (og + 1u == (tg + 1u) * nx) xb_add(&bar[XB_TOPGEN], 1u);
      else XB_SPIN(xb_ld(&bar[XB_TOPGEN]) == tg, bar);
      __builtin_amdgcn_fence(__ATOMIC_ACQUIRE, "agent");
      xb_add(&bar[XB_XGEN(b.x)], 1u);
      asm volatile("s_waitcnt vmcnt(0)" ::: "memory");
    } else {
      XB_SPIN(xb_ld(&bar[XB_XGEN(b.x)]) == gen, bar);
      __builtin_amdgcn_fence(__ATOMIC_ACQUIRE, "agent");
      asm volatile("s_waitcnt vmcnt(0)" ::: "memory");
    }
  }
  __syncthreads();
}

__device__ void phase0(const Params& p, char* smem) {
  const int tid = otid(), nb = gridDim.x, bid = blockIdx.x;
  {
    float4* X4 = (float4*)(p.ws + OFF_X);
    const float4* x4 = (const float4*)p.x;
    const float4* c4 = (const float4*)p.ctx;
    const size_t n1 = (size_t)M_LAT * 256, n2 = (size_t)M_CTX * 256;
    for (size_t i = (size_t)bid * 256 + tid; i < n1 + n2; i += (size_t)nb * 256) X4[i] = i < n1 ? x4[i] : c4[i - n1];
  }
  {
    float* rc = (float*)(p.ws + OFF_ROPE);
    float* rs = rc + 2048 * 16;
    for (int i = bid * 256 + tid; i < 2048 * 16; i += nb * 256) {
      int t = i >> 4, a = (i >> 3) & 1, j = i & 7;
      float pos = a ? (float)(t & 63) : (float)(t >> 6);
      float inv = powf(10000.f, -(float)j / 8.f);
      float ang = pos * inv;
      rc[i] = cosf(ang);
      rs[i] = sinf(ang);
    }
  }
  float* sc = (float*)smem;
  float* red = sc + 9 * 1024;
  float* MOD = (float*)(p.ws + OFF_MOD);
  bool loaded = false;
  for (int it = bid; it < 4 * 96; it += nb) {
    if (!loaded) {
      for (int i = tid; i < 9 * 1024; i += 256) {
        float v = i < 8192 ? p.c[i] : p.c_ctx[i - 8192];
        sc[i] = silu_f(v);
      }
      __syncthreads();
      loaded = true;
    }
    const int l = it / 96, n0 = (it % 96) * 64;
    const int cc = tid & 63, kg = tid >> 6;
    const float* w = p.w_ada + (size_t)l * 1024 * 6144 + n0 + cc;
    float acc[9];
#pragma unroll
    for (int b = 0; b < 9; ++b) acc[b] = 0.f;
    for (int k = kg * 256; k < kg * 256 + 256; ++k) {
      float wv = w[(size_t)k * 6144];
#pragma unroll
      for (int b = 0; b < 9; ++b) acc[b] += sc[b * 1024 + k] * wv;
    }
#pragma unroll
    for (int b = 0; b < 9; ++b) red[(kg * 9 + b) * 64 + cc] = acc[b];
    __syncthreads();
    for (int i = tid; i < 9 * 64; i += 256) {
      int b = i >> 6, c2 = i & 63;
      float s = red[(0 * 9 + b) * 64 + c2] + red[(1 * 9 + b) * 64 + c2] + red[(2 * 9 + b) * 64 + c2] +
                red[(3 * 9 + b) * 64 + c2];
      MOD[(size_t)(l * 9 + b) * 6144 + n0 + c2] = s + p.b_ada[l * 6144 + n0 + c2];
    }
    __syncthreads();
  }
}

__device__ void convT_tile(const float* __restrict__ src, int K, int N, bf16_t* __restrict__ dst, int mode,
                           const float* __restrict__ gs, int kt, int nt, float* tl) {
  const int tid = otid();
  const int k0 = kt * 64, n0 = nt * 64;
  __syncthreads();
#pragma unroll 4
  for (int i = 0; i < 16; ++i) {
    int kk = i * 4 + (tid >> 6), nn = tid & 63;
    float v = 0.f;
    if (n0 + nn < N) v = src[(size_t)(k0 + kk) * N + n0 + nn];
    if (gs) v *= gs[k0 + kk];
    tl[kk * 65 + nn] = v;
  }
  __syncthreads();
#pragma unroll 2
  for (int i = 0; i < 8; ++i) {
    int nn = i * 8 + (tid >> 5), kk = (tid & 31) * 2;
    unsigned pk = pack2(tl[kk * 65 + nn], tl[(kk + 1) * 65 + nn]);
    int n = n0 + nn;
    int drow = mode == 0 ? n : ((n >> 5) * 64 + (n & 31) + (mode == 2 ? 32 : 0));
    *(unsigned*)(dst + (size_t)drow * K + k0 + kk) = pk;
  }
}

__device__ void norm_rows(const float* __restrict__ X, bf16_t* __restrict__ H, const float* __restrict__ g,
                          const float* __restrict__ modl, int shift_i, int scale_i, int item) {
  const int w = otid() >> 6, lane = otid() & 63;
  const int row = item * 4 + w;
  const float4* xr = (const float4*)(X + (size_t)row * 1024);
  float4 v[4];
  float ss = 0.f;
#pragma unroll
  for (int i = 0; i < 4; ++i) {
    v[i] = xr[lane + 64 * i];
    ss += v[i].x * v[i].x + v[i].y * v[i].y + v[i].z * v[i].z + v[i].w * v[i].w;
  }
  ss = wave_sum(ss);
  const float r = rsqrtf(ss * (1.f / 1024.f) + 1e-6f);
  const int b = row < M_LAT ? (row >> 11) : 8;
  const float4* sh = (const float4*)(modl + b * 6144 + shift_i * 1024);
  const float4* sl = (const float4*)(modl + b * 6144 + scale_i * 1024);
  const float4* g4 = (const float4*)g;
#pragma unroll
  for (int i = 0; i < 4; ++i) {
    int c4 = lane + 64 * i;
    float4 gg = g4[c4], s4 = sh[c4], l4 = sl[c4];
    float y0 = v[i].x * r * gg.x * (1.f + l4.x) + s4.x;
    float y1 = v[i].y * r * gg.y * (1.f + l4.y) + s4.y;
    float y2 = v[i].z * r * gg.z * (1.f + l4.z) + s4.z;
    float y3 = v[i].w * r * gg.w * (1.f + l4.w) + s4.w;
    uint2 pk;
    pk.x = pack2(y0, y1);
    pk.y = pack2(y2, y3);
    *(uint2*)(H + (size_t)row * 1024 + c4 * 4) = pk;
  }
}

__device__ void conv_item_late(const Params& p, int l, int i, float* tl) {
  bf16_t* Wout = (bf16_t*)(p.ws + OFF_WOUT);
  bf16_t* Wgu = (bf16_t*)(p.ws + OFF_WGU);
  bf16_t* Wdn = (bf16_t*)(p.ws + OFF_WDN);
  const float* src;
  bf16_t* dst;
  int K, N, mode = 0, ntn;
  if (i < 256) {
    src = p.w_out + (size_t)l * 1024 * 1024; K = 1024; N = 1024; dst = Wout; ntn = 16;
  } else if (i < 960) {
    i -= 256; src = p.w_gate + (size_t)l * 1024 * FFN; K = 1024; N = FFN; dst = Wgu; ntn = 44; mode = 1;
  } else if (i < 1664) {
    i -= 960; src = p.w_up + (size_t)l * 1024 * FFN; K = 1024; N = FFN; dst = Wgu; ntn = 44; mode = 2;
  } else {
    i -= 1664; src = p.w_down + (size_t)l * FFN * 1024; K = FFN; N = 1024; dst = Wdn; ntn = 16;
  }
  convT_tile(src, K, N, dst, mode, nullptr, i / ntn, i % ntn, tl);
}
constexpr int N_CONV_LATE = 256 + 3 * 704;

__device__ void phaseA(const Params& p, int l, char* smem) {
  const int nb = gridDim.x, bid = blockIdx.x;
  float* tl = (float*)smem;
  bf16_t* Win = (bf16_t*)(p.ws + OFF_WIN);
  bf16_t* Wq = (bf16_t*)(p.ws + OFF_WQUP);
  bf16_t* Wkv = (bf16_t*)(p.ws + OFF_WKVUP);
  constexpr int T0 = 16 * 52, T5 = T0 + 24, T6 = T5 + 16;
  constexpr int NORM_ITEMS = M_ALL / 4;
  for (int it = bid; it < T6 + NORM_ITEMS; it += nb) {
    if (it < T6) {
      const float* src;
      const float* gs = nullptr;
      bf16_t* dst;
      int K, N, ntn, i;
      if (it < T0) {
        i = it; src = p.w_in + (size_t)l * 1024 * INW; K = 1024; N = INW; dst = Win; ntn = 52;
      } else if (it < T5) {
        i = it - T0; src = p.w_qup + (size_t)l * 256 * 384; K = 256; N = 384; dst = Wq; ntn = 6; gs = p.g_q + l * 256;
      } else {
        i = it - T5; src = p.w_kvup + (size_t)l * 128 * 512; K = 128; N = 512; dst = Wkv; ntn = 8; gs = p.g_kv + l * 128;
      }
      convT_tile(src, K, N, dst, 0, gs, i / ntn, i % ntn, tl);
    } else {
      norm_rows((const float*)(p.ws + OFF_X), (bf16_t*)(p.ws + OFF_HM), p.g_mix + l * 1024,
                (const float*)(p.ws + OFF_MOD) + (size_t)l * 9 * 6144, 0, 1, it - T6);
    }
  }
}

DEVI void tile_map(int it, int NT, int& mt, int& nt) {
  const int xcd = it & 7, idx = it >> 3;
  const int per_group = 8 * NT;
  const int g = idx / per_group, r = idx - g * per_group;
  const int gs = min(8, 18 - 8 * g);
  mt = xcd * 18 + g * 8 + r % gs;
  nt = r / gs;
}

enum { EPI_P = 0, EPI_QUP = 1, EPI_KVUP = 2, EPI_RES = 3, EPI_GU = 4 };

template <int EPI>
__device__ void gemm_tile(const Params& p, int l, const bf16_t* __restrict__ A, int lda,
                          const bf16_t* __restrict__ BT, int K, int m0, int n0, int gate_i, char* smem) {
  constexpr int STAGE = 2 * 128 * 72;
  bf16_t* sbase = (bf16_t*)smem;
  float* rsv = (float*)(smem + 2 * STAGE * 2);
  const int tid = otid(), lane = tid & 63, w = tid >> 6, wm = w >> 1, wn = w & 1;
  const int lr = tid >> 3, lc = (tid & 7) * 8;
  __syncthreads();
  if (EPI == EPI_QUP || EPI == EPI_KVUP) {
    const int row = tid >> 1, hf = tid & 1;
    const int n8 = K / 16;
    const uint4* ap = (const uint4*)(A + (size_t)(m0 + row) * lda + hf * (K / 2));
    float ss = 0.f;
    for (int i = 0; i < n8; ++i) {
      uint4 u = ap[i];
      float a0 = bflo(u.x), a1 = bfhi(u.x), a2 = bflo(u.y), a3 = bfhi(u.y), a4 = bflo(u.z), a5 = bfhi(u.z),
            a6 = bflo(u.w), a7 = bfhi(u.w);
      ss += a0 * a0 + a1 * a1 + a2 * a2 + a3 * a3 + a4 * a4 + a5 * a5 + a6 * a6 + a7 * a7;
    }
    ss += __shfl_xor(ss, 1);
    if (hf == 0) rsv[row] = rsqrtf(ss / (float)K + 1e-6f);
  }
  const bf16_t* Ap = A + (size_t)(m0 + lr) * lda + lc;
  const bf16_t* Bp = BT + (size_t)(n0 + lr) * K + lc;
  uint4 ra0, ra1, ra2, ra3, rb0, rb1, rb2, rb3;
#define G_LOAD()                                  \
  ra0 = *(const uint4*)(Ap);                      \
  ra1 = *(const uint4*)(Ap + (size_t)32 * lda);   \
  ra2 = *(const uint4*)(Ap + (size_t)64 * lda);   \
  ra3 = *(const uint4*)(Ap + (size_t)96 * lda);   \
  rb0 = *(const uint4*)(Bp);                      \
  rb1 = *(const uint4*)(Bp + (size_t)32 * K);     \
  rb2 = *(const uint4*)(Bp + (size_t)64 * K);     \
  rb3 = *(const uint4*)(Bp + (size_t)96 * K);
#define S_WRITE(ST)                                                   \
  {                                                                   \
    bf16_t* wa = sbase + (ST) * STAGE + lr * 72 + lc;                 \
    bf16_t* wb = wa + 128 * 72;                                       \
    *(uint4*)(wa) = ra0;                                              \
    *(uint4*)(wa + 32 * 72) = ra1;                                    \
    *(uint4*)(wa + 64 * 72) = ra2;                                    \
    *(uint4*)(wa + 96 * 72) = ra3;                                    \
    *(uint4*)(wb) = rb0;                                              \
    *(uint4*)(wb + 32 * 72) = rb1;                                    \
    *(uint4*)(wb + 64 * 72) = rb2;                                    \
    *(uint4*)(wb + 96 * 72) = rb3;                                    \
  }
  const int nk = K / 64;
  G_LOAD()
  S_WRITE(0)
  if (nk > 1) {
    Ap += 64;
    Bp += 64;
    G_LOAD()
  }
  f32x16 acc[2][2];
#pragma unroll
  for (int i = 0; i < 2; ++i)
#pragma unroll
    for (int j = 0; j < 2; ++j)
#pragma unroll
      for (int r = 0; r < 16; ++r) acc[i][j][r] = 0.f;
  __syncthreads();
  for (int kt = 0; kt < nk; ++kt) {
    const int cur = kt & 1;
    const bf16_t* pa = sbase + cur * STAGE + (wm * 64 + (lane & 31)) * 72 + (lane >> 5) * 8;
    const bf16_t* pb = sbase + cur * STAGE + 128 * 72 + (wn * 64 + (lane & 31)) * 72 + (lane >> 5) * 8;
    bf16x8 fa00 = *(const bf16x8*)(pa), fa01 = *(const bf16x8*)(pa + 32 * 72);
    bf16x8 fb00 = *(const bf16x8*)(pb), fb01 = *(const bf16x8*)(pb + 32 * 72);
    bf16x8 fa10 = *(const bf16x8*)(pa + 16), fa11 = *(const bf16x8*)(pa + 32 * 72 + 16);
    bf16x8 fb10 = *(const bf16x8*)(pb + 16), fb11 = *(const bf16x8*)(pb + 32 * 72 + 16);
    bf16x8 fa20 = *(const bf16x8*)(pa + 32), fa21 = *(const bf16x8*)(pa + 32 * 72 + 32);
    bf16x8 fb20 = *(const bf16x8*)(pb + 32), fb21 = *(const bf16x8*)(pb + 32 * 72 + 32);
    bf16x8 fa30 = *(const bf16x8*)(pa + 48), fa31 = *(const bf16x8*)(pa + 32 * 72 + 48);
    bf16x8 fb30 = *(const bf16x8*)(pb + 48), fb31 = *(const bf16x8*)(pb + 32 * 72 + 48);
    __builtin_amdgcn_sched_barrier(0);
#define MM4(A0, A1, B0, B1)                                                           \
  acc[0][0] = __builtin_amdgcn_mfma_f32_32x32x16_bf16(A0, B0, acc[0][0], 0, 0, 0);    \
  acc[0][1] = __builtin_amdgcn_mfma_f32_32x32x16_bf16(A0, B1, acc[0][1], 0, 0, 0);    \
  acc[1][0] = __builtin_amdgcn_mfma_f32_32x32x16_bf16(A1, B0, acc[1][0], 0, 0, 0);    \
  acc[1][1] = __builtin_amdgcn_mfma_f32_32x32x16_bf16(A1, B1, acc[1][1], 0, 0, 0);
    MM4(fa00, fa01, fb00, fb01)
    MM4(fa10, fa11, fb10, fb11)
    MM4(fa20, fa21, fb20, fb21)
    MM4(fa30, fa31, fb30, fb31)
#undef MM4
    __builtin_amdgcn_sched_barrier(0);
    if (kt + 1 < nk) {
      S_WRITE(cur ^ 1)
      if (kt + 2 < nk) {
        Ap += 64;
        Bp += 64;
        G_LOAD()
      }
    }
    __syncthreads();
  }
#undef G_LOAD
#undef S_WRITE
  const int ci = lane & 31;
  const int rbase = m0 + wm * 64 + 4 * (lane >> 5);
  const int cbase = n0 + wn * 64;
  if (EPI == EPI_P) {
    bf16_t* P = (bf16_t*)(p.ws + OFF_P);
    float* AB = (float*)(p.ws + OFF_AB);
#pragma unroll
    for (int mt = 0; mt < 2; ++mt)
#pragma unroll
      for (int nt = 0; nt < 2; ++nt)
#pragma unroll
        for (int r = 0; r < 16; ++r) {
          int row = rbase + mt * 32 + (r & 3) + 8 * (r >> 2);
          int col = cbase + nt * 32 + ci;
          float v = acc[mt][nt][r];
          P[(size_t)row * INWP + col] = f2bf(v);
          if (col >= C_DA && col < C_DA + 16) AB[(size_t)row * 16 + col - C_DA] = v;
        }
    bf16_t* NVT = (bf16_t*)(p.ws + OFF_NVT);
#pragma unroll
    for (int mt = 0; mt < 2; ++mt)
#pragma unroll
      for (int nt = 0; nt < 2; ++nt) {
        const int base = cbase + nt * 32;
        if (base >= C_NV && base < C_NV + 256) {
          const int hv = (base - C_NV) >> 6, dv = ((base - C_NV) & 63) + ci;
#pragma unroll
          for (int g = 0; g < 4; ++g) {
            const int row0 = rbase + mt * 32 + 8 * g;
            int bb, key0;
            if (row0 < M_LAT) { bb = row0 >> 11; key0 = 256 + (row0 & 2047); }
            else { bb = (row0 - M_LAT) >> 8; key0 = (row0 - M_LAT) & 255; }
            uint2 u;
            u.x = pack2(acc[mt][nt][4 * g + 0], acc[mt][nt][4 * g + 1]);
            u.y = pack2(acc[mt][nt][4 * g + 2], acc[mt][nt][4 * g + 3]);
            *(uint2*)(NVT + ((size_t)(bb * 4 + hv) * 64 + dv) * 2304 + key0) = u;
          }
        }
      }
  } else if (EPI == EPI_QUP) {
    bf16_t* QH = (bf16_t*)(p.ws + OFF_QH);
    const float* rc = (const float*)(p.ws + OFF_ROPE);
    const float* rsn = rc + 2048 * 16;
#pragma unroll
    for (int mt = 0; mt < 2; ++mt)
#pragma unroll
      for (int nt = 0; nt < 2; ++nt) {
        const int base = cbase + nt * 32;
        const bool rope = ((base % 96) == 64) && (m0 < M_LAT);
#pragma unroll
        for (int r = 0; r < 16; ++r) {
          int row = rbase + mt * 32 + (r & 3) + 8 * (r >> 2);
          float v = acc[mt][nt][r] * rsv[row - m0];
          float o = __shfl_xor(v, 8);
          if (rope) {
            int t = row & 2047;
            int a = ci >> 4, hf = (ci >> 3) & 1, j = ci & 7;
            float c = rc[t * 16 + a * 8 + j], s = rsn[t * 16 + a * 8 + j];
            v = hf ? (o * s + v * c) : (v * c - o * s);
          }
          QH[(size_t)row * 384 + base + ci] = f2bf(v);
        }
      }
  } else if (EPI == EPI_KVUP) {
    bf16_t* KA = (bf16_t*)(p.ws + OFF_KH);
    bf16_t* VT = (bf16_t*)(p.ws + OFF_VH);
#pragma unroll
    for (int mt = 0; mt < 2; ++mt)
#pragma unroll
      for (int nt = 0; nt < 2; ++nt) {
        const int base = cbase + nt * 32;
        const int h = base >> 7, cc = (base & 127) + ci;
#pragma unroll
        for (int g = 0; g < 4; ++g) {
          const int row0 = rbase + mt * 32 + 8 * g;
          int bb, key0;
          if (row0 < M_LAT) { bb = row0 >> 11; key0 = 256 + (row0 & 2047); }
          else { bb = (row0 - M_LAT) >> 8; key0 = (row0 - M_LAT) & 255; }
          float v0 = acc[mt][nt][4 * g + 0] * rsv[row0 - m0 + 0];
          float v1 = acc[mt][nt][4 * g + 1] * rsv[row0 - m0 + 1];
          float v2 = acc[mt][nt][4 * g + 2] * rsv[row0 - m0 + 2];
          float v3 = acc[mt][nt][4 * g + 3] * rsv[row0 - m0 + 3];
          if (cc < 64) {
            bf16_t* kp = KA + ((size_t)(bb * 4 + h) * 2304 + key0) * 96 + cc;
            kp[0] = f2bf(v0); kp[96] = f2bf(v1); kp[192] = f2bf(v2); kp[288] = f2bf(v3);
          } else {
            uint2 u;
            u.x = pack2(v0, v1);
            u.y = pack2(v2, v3);
            *(uint2*)(VT + ((size_t)(bb * 4 + h) * 64 + (cc - 64)) * 2304 + key0) = u;
          }
        }
      }
  } else if (EPI == EPI_RES) {
    float* X = (float*)(p.ws + OFF_X);
    const float* modl = (const float*)(p.ws + OFF_MOD) + (size_t)l * 9 * 6144 + gate_i * 1024;
#pragma unroll
    for (int mt = 0; mt < 2; ++mt)
#pragma unroll
      for (int nt = 0; nt < 2; ++nt)
#pragma unroll
        for (int r = 0; r < 16; ++r) {
          int row = rbase + mt * 32 + (r & 3) + 8 * (r >> 2);
          int col = cbase + nt * 32 + ci;
          int b = row < M_LAT ? (row >> 11) : 8;
          float g = modl[b * 6144 + col];
          size_t idx = (size_t)row * 1024 + col;
          X[idx] = X[idx] + g * acc[mt][nt][r];
        }
  } else if (EPI == EPI_GU) {
    bf16_t* ACT = (bf16_t*)(p.ws + OFF_P);
#pragma unroll
    for (int mt = 0; mt < 2; ++mt)
#pragma unroll
      for (int r = 0; r < 16; ++r) {
        int row = rbase + mt * 32 + (r & 3) + 8 * (r >> 2);
        float gt = acc[mt][0][r], up = acc[mt][1][r];
        float a = silu_f(gt) * up;
        ACT[(size_t)row * FFN + (cbase >> 6) * 32 + ci] = f2bf(a);
      }
  }
}

template <int EPI>
__device__ void gemm_wide(const Params& p, int l, const bf16_t* __restrict__ A, int lda,
                          const bf16_t* __restrict__ BT, int K, int m0, int n0, int gate_i, char* smem) {
  bf16_t* sA = (bf16_t*)smem;
  bf16_t* sB = sA + 128 * 72;
  const int tid = otid(), lane = tid & 63, w = tid >> 6, wm = w >> 1, wn = w & 1;
  const int lr = tid >> 3, lc = (tid & 7) * 8;
  const bf16_t* Ap = A + (size_t)(m0 + lr) * lda + lc;
  const bf16_t* Bp = BT + (size_t)(n0 + lr) * K + lc;
  uint4 ra0, ra1, ra2, ra3, rb0, rb1, rb2, rb3, rb4, rb5, rb6, rb7;
#define LOAD_AB()                                   \
  ra0 = *(const uint4*)(Ap);                        \
  ra1 = *(const uint4*)(Ap + (size_t)32 * lda);     \
  ra2 = *(const uint4*)(Ap + (size_t)64 * lda);     \
  ra3 = *(const uint4*)(Ap + (size_t)96 * lda);     \
  rb0 = *(const uint4*)(Bp);                        \
  rb1 = *(const uint4*)(Bp + (size_t)32 * K);       \
  rb2 = *(const uint4*)(Bp + (size_t)64 * K);       \
  rb3 = *(const uint4*)(Bp + (size_t)96 * K);       \
  rb4 = *(const uint4*)(Bp + (size_t)128 * K);      \
  rb5 = *(const uint4*)(Bp + (size_t)160 * K);      \
  rb6 = *(const uint4*)(Bp + (size_t)192 * K);      \
  rb7 = *(const uint4*)(Bp + (size_t)224 * K);
  LOAD_AB()
  f32x16 acc[2][4];
#pragma unroll
  for (int i = 0; i < 2; ++i)
#pragma unroll
    for (int j = 0; j < 4; ++j)
#pragma unroll
      for (int r = 0; r < 16; ++r) acc[i][j][r] = 0.f;
  const int nk = K / 64;
  for (int kt = 0; kt < nk; ++kt) {
    __syncthreads();
    *(uint4*)(sA + (lr + 0) * 72 + lc) = ra0;
    *(uint4*)(sA + (lr + 32) * 72 + lc) = ra1;
    *(uint4*)(sA + (lr + 64) * 72 + lc) = ra2;
    *(uint4*)(sA + (lr + 96) * 72 + lc) = ra3;
    *(uint4*)(sB + (lr + 0) * 72 + lc) = rb0;
    *(uint4*)(sB + (lr + 32) * 72 + lc) = rb1;
    *(uint4*)(sB + (lr + 64) * 72 + lc) = rb2;
    *(uint4*)(sB + (lr + 96) * 72 + lc) = rb3;
    *(uint4*)(sB + (lr + 128) * 72 + lc) = rb4;
    *(uint4*)(sB + (lr + 160) * 72 + lc) = rb5;
    *(uint4*)(sB + (lr + 192) * 72 + lc) = rb6;
    *(uint4*)(sB + (lr + 224) * 72 + lc) = rb7;
    __syncthreads();
    if (kt + 1 < nk) {
      Ap += 64;
      Bp += 64;
      LOAD_AB()
    }
    __builtin_amdgcn_sched_barrier(0);
#pragma unroll
    for (int ks = 0; ks < 4; ++ks) {
      const int ko = ks * 16 + (lane >> 5) * 8;
      bf16x8 a0 = *(const bf16x8*)(sA + (wm * 64 + (lane & 31)) * 72 + ko);
      bf16x8 a1 = *(const bf16x8*)(sA + (wm * 64 + 32 + (lane & 31)) * 72 + ko);
#pragma unroll
      for (int nt = 0; nt < 4; ++nt) {
        bf16x8 b = *(const bf16x8*)(sB + (wn * 128 + nt * 32 + (lane & 31)) * 72 + ko);
        acc[0][nt] = __builtin_amdgcn_mfma_f32_32x32x16_bf16(a0, b, acc[0][nt], 0, 0, 0);
        acc[1][nt] = __builtin_amdgcn_mfma_f32_32x32x16_bf16(a1, b, acc[1][nt], 0, 0, 0);
      }
    }
  }
#undef LOAD_AB
  const int ci = lane & 31;
  const int rbase = m0 + wm * 64 + 4 * (lane >> 5);
  const int cbase = n0 + wn * 128;
  if (EPI == EPI_P) {
    bf16_t* P = (bf16_t*)(p.ws + OFF_P);
    float* AB = (float*)(p.ws + OFF_AB);
    bf16_t* NVT = (bf16_t*)(p.ws + OFF_NVT);
#pragma unroll
    for (int mt = 0; mt < 2; ++mt)
#pragma unroll
      for (int nt = 0; nt < 4; ++nt) {
        const int base = cbase + nt * 32;
#pragma unroll
        for (int r = 0; r < 16; ++r) {
          int row = rbase + mt * 32 + (r & 3) + 8 * (r >> 2);
          int col = base + ci;
          float v = acc[mt][nt][r];
          P[(size_t)row * INWP + col] = f2bf(v);
          if (col >= C_DA && col < C_DA + 16) AB[(size_t)row * 16 + col - C_DA] = v;
        }
        if (base >= C_NV && base < C_NV + 256) {
          const int hv = (base - C_NV) >> 6, dv = ((base - C_NV) & 63) + ci;
#pragma unroll
          for (int g = 0; g < 4; ++g) {
            const int row0 = rbase + mt * 32 + 8 * g;
            int bb, key0;
            if (row0 < M_LAT) { bb = row0 >> 11; key0 = 256 + (row0 & 2047); }
            else { bb = (row0 - M_LAT) >> 8; key0 = (row0 - M_LAT) & 255; }
            uint2 u;
            u.x = pack2(acc[mt][nt][4 * g + 0], acc[mt][nt][4 * g + 1]);
            u.y = pack2(acc[mt][nt][4 * g + 2], acc[mt][nt][4 * g + 3]);
            *(uint2*)(NVT + ((size_t)(bb * 4 + hv) * 64 + dv) * 2304 + key0) = u;
          }
        }
      }
  } else if (EPI == EPI_GU) {
    bf16_t* ACT = (bf16_t*)(p.ws + OFF_P);
#pragma unroll
    for (int mt = 0; mt < 2; ++mt)
#pragma unroll
      for (int pr = 0; pr < 2; ++pr)
#pragma unroll
        for (int r = 0; r < 16; ++r) {
          int row = rbase + mt * 32 + (r & 3) + 8 * (r >> 2);
          float gt = acc[mt][2 * pr][r], up = acc[mt][2 * pr + 1][r];
          float a = silu_f(gt) * up;
          ACT[(size_t)row * FFN + ((cbase >> 6) + pr) * 32 + ci] = f2bf(a);
        }
  }
}

__device__ void kpe_item(const Params& p, int it) {
  const int tid = otid();
  const bf16_t* P = (const bf16_t*)(p.ws + OFF_P);
  bf16_t* KH = (bf16_t*)(p.ws + OFF_KH);
  const float* rc = (const float*)(p.ws + OFF_ROPE);
  const float* rsn = rc + 2048 * 16;
  const int row = it * 8 + (tid >> 5), i = tid & 31;
  float v = bf2f(P[(size_t)row * INWP + C_MPE + i]);
  float o = __shfl_xor(v, 8);
  if (row < M_LAT) {
    int t = row & 2047;
    int a = i >> 4, hf = (i >> 3) & 1, j = i & 7;
    float c = rc[t * 16 + a * 8 + j], s = rsn[t * 16 + a * 8 + j];
    v = hf ? (o * s + v * c) : (v * c - o * s);
  }
  bf16_t bv = f2bf(v);
  int bb, key;
  if (row < M_LAT) { bb = row >> 11; key = 256 + (row & 2047); }
  else { bb = (row - M_LAT) >> 8; key = (row - M_LAT) & 255; }
#pragma unroll
  for (int h = 0; h < 4; ++h) KH[((size_t)(bb * 4 + h) * 2304 + key) * 96 + 64 + i] = bv;
}

__device__ void dn_prep(const Params& p, int l, int it, char* smem) {
  float* buf = (float*)smem;
  float* nrm = buf + 8 * 1536;
  const int tid = otid();
  const bf16_t* P = (const bf16_t*)(p.ws + OFF_P);
  bf16_t* DQ = (bf16_t*)(p.ws + OFF_DNQKV);
  const int r0 = it * 8;
  int seq_lo, seq_hi;
  if (r0 < M_LAT) {
    seq_lo = (r0 >> 11) << 11;
    seq_hi = seq_lo + 2048;
  } else {
    int rr = r0 - M_LAT;
    seq_lo = M_LAT + ((rr >> 8) << 8);
    seq_hi = seq_lo + 256;
  }
  const float* cw = p.conv_w + (size_t)l * 5 * 1536;
  __syncthreads();
  for (int c6 = 0; c6 < 6; ++c6) {
    const int ch = c6 * 256 + tid;
    float w0 = cw[ch], w1 = cw[1536 + ch], w2 = cw[2 * 1536 + ch], w3 = cw[3 * 1536 + ch], w4 = cw[4 * 1536 + ch];
    float xw[12];
#pragma unroll
    for (int j = 0; j < 12; ++j) {
      int r = r0 - 2 + j;
      xw[j] = (r >= seq_lo && r < seq_hi) ? bf2f(P[(size_t)r * INWP + C_DN + ch]) : 0.f;
    }
#pragma unroll
    for (int j = 0; j < 8; ++j) {
      float y = w0 * xw[j] + w1 * xw[j + 1] + w2 * xw[j + 2] + w3 * xw[j + 3] + w4 * xw[j + 4];
      buf[j * 1536 + ch] = silu_f(y);
    }
  }
  __syncthreads();
  {
    int vec = tid >> 2, part = tid & 3;
    int rr = vec >> 3, hv = vec & 7;
    const float* v = buf + rr * 1536 + hv * 128 + part * 32;
    float ss = 0.f;
#pragma unroll
    for (int i = 0; i < 32; ++i) ss += v[i] * v[i];
    ss += __shfl_xor(ss, 1);
    ss += __shfl_xor(ss, 2);
    if (part == 0) nrm[vec] = rsqrtf(ss + 1e-6f);
  }
  __syncthreads();
  for (int i = tid; i < 8 * 1536; i += 256) {
    int rr = i / 1536, ch = i - rr * 1536;
    float v = buf[i];
    if (ch < 1024) v *= nrm[rr * 8 + (ch >> 7)];
    DQ[(size_t)(r0 + rr) * 1536 + ch] = f2bf(v);
  }
}


DEVI int rowmap(int r, int hh) { return (r & 3) + 8 * (r >> 2) + 4 * hh; }

__device__ void dn_chunk_prep(const Params& p, int l, int item, char* smem) {
  float* tile = (float*)smem;
  float* sL0 = (float*)smem;
  float* sL1 = sL0 + 64 * 68;
  bf16_t* sKb = (bf16_t*)(smem + 34816);
  float* sg = (float*)(smem + 52224);
  float* sbt = sg + 128;
  const int tid = otid(), lane = tid & 63, w = tid >> 6, li = lane & 31, hh = lane >> 5;
  const int chunk = item >> 2, h = item & 3;
  int row0, seq_lo, seq_hi;
  if (chunk < 256) {
    int b = chunk >> 5;
    row0 = b * 2048 + (chunk & 31) * 64; seq_lo = b * 2048; seq_hi = seq_lo + 2048;
  } else {
    int cc = chunk - 256, b = cc >> 2;
    row0 = M_LAT + b * 256 + (cc & 3) * 64; seq_lo = M_LAT + b * 256; seq_hi = seq_lo + 256;
  }
  const bf16_t* P = (const bf16_t*)(p.ws + OFF_P);
  bf16_t* DQ = (bf16_t*)(p.ws + OFF_DNQKV);
  const float* AB = (const float*)(p.ws + OFF_AB);
  const float* cw = p.conv_w + (size_t)l * 5 * 1536;
  __syncthreads();
  if (w < 2) {
    const int d = w;
    const int row = d ? (row0 + 63 - lane) : (row0 + lane);
    const float Aneg = -__expf(p.a_log[l * 8 + d * 4 + h]);
    const float dtb = p.dt_bias[l * 8 + d * 4 + h];
    float a = AB[(size_t)row * 16 + d * 4 + h];
    float bb = AB[(size_t)row * 16 + 8 + d * 4 + h];
    float xx = a + dtb;
    float sp = xx > 20.f ? xx : log1pf(__expf(xx));
    float g = Aneg * sp;
#pragma unroll
    for (int o = 1; o < 64; o <<= 1) {
      float y = __shfl_up(g, o);
      if (lane >= o) g += y;
    }
    float be = 1.f / (1.f + __expf(-bb));
    sg[d * 64 + lane] = g;
    sbt[d * 64 + lane] = be;
    ((float*)(p.ws + OFF_GC))[(size_t)row * 8 + d * 4 + h] = g;
    ((float*)(p.ws + OFF_BETA))[(size_t)row * 8 + d * 4 + h] = be;
  }
  const int c = tid & 127, rh = tid >> 7;
  for (int pass = 0; pass < 3; ++pass) {
    const int off = pass == 0 ? 512 : (pass == 1 ? 0 : 1024);
    const int ch = off + h * 128 + c;
    const float w0 = cw[ch], w1 = cw[1536 + ch], w2 = cw[2 * 1536 + ch], w3 = cw[3 * 1536 + ch], w4 = cw[4 * 1536 + ch];
    float x0, x1, x2, x3, x4;
    bf16_t xr[32];
    {
      const int rb = row0 + rh * 32 - 2;
      x0 = (rb + 0 >= seq_lo) ? bf2f(P[(size_t)(rb + 0) * INWP + C_DN + ch]) : 0.f;
      x1 = (rb + 1 >= seq_lo) ? bf2f(P[(size_t)(rb + 1) * INWP + C_DN + ch]) : 0.f;
      x2 = bf2f(P[(size_t)(rb + 2) * INWP + C_DN + ch]);
      x3 = bf2f(P[(size_t)(rb + 3) * INWP + C_DN + ch]);
#pragma unroll
      for (int j = 0; j < 32; ++j) {
        const int r = rb + 4 + j;
        xr[j] = (r < seq_hi) ? P[(size_t)r * INWP + C_DN + ch] : (bf16_t)0;
      }
    }
#pragma unroll
    for (int j = 0; j < 32; ++j) {
      x4 = bf2f(xr[j]);
      float y = w0 * x0 + w1 * x1 + w2 * x2 + w3 * x3 + w4 * x4;
      y = silu_f(y);
      if (pass == 2)
        DQ[(size_t)(row0 + rh * 32 + j) * 1536 + ch] = f2bf(y);
      else
        tile[(rh * 32 + j) * 129 + c] = y;
      x0 = x1; x1 = x2; x2 = x3; x3 = x4;
    }
    if (pass < 2) {
      __syncthreads();
      const int row = tid >> 2, part = tid & 3;
      const float* tv = tile + row * 129 + part * 32;
      float ss = 0.f;
#pragma unroll
      for (int i = 0; i < 32; ++i) ss += tv[i] * tv[i];
      ss += __shfl_xor(ss, 1);
      ss += __shfl_xor(ss, 2);
      const float rn = rsqrtf(ss + 1e-6f);
      bf16_t* gp = DQ + (size_t)(row0 + row) * 1536 + off + h * 128 + part * 32;
#pragma unroll
      for (int i8 = 0; i8 < 4; ++i8) {
        uint4 u;
        u.x = pack2(tv[i8 * 8 + 0] * rn, tv[i8 * 8 + 1] * rn);
        u.y = pack2(tv[i8 * 8 + 2] * rn, tv[i8 * 8 + 3] * rn);
        u.z = pack2(tv[i8 * 8 + 4] * rn, tv[i8 * 8 + 5] * rn);
        u.w = pack2(tv[i8 * 8 + 6] * rn, tv[i8 * 8 + 7] * rn);
        *(uint4*)(gp + i8 * 8) = u;
        if (pass == 0) *(uint4*)(sKb + row * 136 + part * 32 + i8 * 8) = u;
      }
      __syncthreads();
    }
  }
  __syncthreads();
  {
    const int mi = w >> 1, ni = w & 1;
    f32x16 g;
#pragma unroll
    for (int r = 0; r < 16; ++r) g[r] = 0.f;
#pragma unroll
    for (int ks = 0; ks < 8; ++ks) {
      bf16x8 a = *(const bf16x8*)(sKb + (mi * 32 + li) * 136 + ks * 16 + hh * 8);
      bf16x8 b = *(const bf16x8*)(sKb + (ni * 32 + li) * 136 + ks * 16 + hh * 8);
      g = __builtin_amdgcn_mfma_f32_32x32x16_bf16(a, b, g, 0, 0, 0);
    }
#pragma unroll
    for (int r = 0; r < 16; ++r) {
      const int i = mi * 32 + rowmap(r, hh), m = ni * 32 + li;
      const float G = g[r];
      sL0[i * 68 + m] = (i > m) ? sbt[i] * G * __expf(sg[i] - sg[m]) : 0.f;
      const int i1 = 63 - i, m1 = 63 - m;
      sL1[i1 * 68 + m1] = (i1 > m1) ? sbt[64 + i1] * G * __expf(sg[64 + i1] - sg[64 + m1]) : 0.f;
    }
  }
  __syncthreads();
  if (w < 2) {
    const float* L = w == 0 ? sL0 : sL1;
    float t[64];
#pragma unroll
    for (int i = 0; i < 64; ++i) {
      float acc = (i == lane) ? 1.f : 0.f;
#pragma unroll
      for (int m = 0; m < i; ++m) acc -= L[i * 68 + m] * t[m];
      t[i] = acc;
    }
    bf16_t* Tg = (bf16_t*)(p.ws + OFF_OB) + (size_t)((chunk * 4 + h) * 2 + w) * 4096;
#pragma unroll
    for (int i = 0; i < 64; ++i) Tg[i * 64 + lane] = f2bf(t[i]);
  }
}

DEVI bf16x8 ld_perm(const bf16_t* p) {
  union { bf16x8 v; uint2 d[2]; } u;
  u.d[0] = *(const uint2*)(p);
  u.d[1] = *(const uint2*)(p + 8);
  return u.v;
}
DEVI bf16x8 pack8(const f32x16& x, int s) {
  union { bf16x8 v; unsigned w[4]; } u;
  u.w[0] = pack2(x[8 * s + 0], x[8 * s + 1]);
  u.w[1] = pack2(x[8 * s + 2], x[8 * s + 3]);
  u.w[2] = pack2(x[8 * s + 4], x[8 * s + 5]);
  u.w[3] = pack2(x[8 * s + 6], x[8 * s + 7]);
  return u.v;
}

__device__ void dn_scan(const Params& p, int l, int item, char* smem) {
  bf16_t* sK = (bf16_t*)smem;
  bf16_t* sQ = (bf16_t*)(smem + 17408);
  bf16_t* sKT = (bf16_t*)(smem + 34816);
  bf16_t* sT = (bf16_t*)(smem + 52224);
  bf16_t* sA = (bf16_t*)(smem + 60928);
  bf16_t* sV = (bf16_t*)(smem + 52224);
  float* sg = (float*)(smem + 69632);
  float* sbt = sg + 64;
  float* seg = sbt + 64;
  float* sdt = seg + 64;
  const int d = item & 1, h = (item >> 1) & 3, b = item >> 3;
  const bf16_t* DQ = (const bf16_t*)(p.ws + OFF_DNQKV);
  const bf16_t* TB = (const bf16_t*)(p.ws + OFF_OB);
  const float* GC = (const float*)(p.ws + OFF_GC);
  const float* BE = (const float*)(p.ws + OFF_BETA);
  bf16_t* MIX = (bf16_t*)(p.ws + OFF_HM);
  bf16_t* Pw = (bf16_t*)(p.ws + OFF_P);
  const float qscale = 0.08838834764831845f;
  const int rsign = d ? -1 : 1;
  f32x16 S0, S1, S2, S3;
#pragma unroll
  for (int r = 0; r < 16; ++r) { S0[r] = 0.f; S1[r] = 0.f; S2[r] = 0.f; S3[r] = 0.f; }
  __builtin_amdgcn_s_setprio(3);
  uint4 qA0, qB0, kA0, kB0, vA0, vB0, qA1, qB1, kA1, kB1, vA1, vB1, tq0, tq1;
  float pgc = 0.f, pbe = 0.f;
#define SCAN_ROW0(N, CHUNK, ROW0)                                    \
  {                                                                  \
    if ((N) < 4) {                                                   \
      int cn = d ? (3 - (N)) : (N);                                  \
      CHUNK = 256 + b * 4 + cn;                                      \
      ROW0 = M_LAT + b * 256 + cn * 64;                              \
    } else {                                                         \
      int ln = (N)-4;                                                \
      ln = d ? (31 - ln) : ln;                                       \
      CHUNK = b * 32 + ln;                                           \
      ROW0 = b * 2048 + ln * 64;                                     \
    }                                                                \
  }
#define SCAN_LOADS(N)                                                                         \
  {                                                                                           \
    const int tid_ = otid();                                                                  \
    int chunk_, row0_;                                                                        \
    SCAN_ROW0(N, chunk_, row0_)                                                               \
    const int rstart_ = d ? (row0_ + 63) : row0_;                                             \
    {                                                                                         \
      const int u = tid_, c8 = u & 15, tp = u >> 4;                                           \
      const bf16_t* ga = DQ + (size_t)(rstart_ + rsign * 2 * tp) * 1536 + h * 128 + c8 * 8;   \
      const bf16_t* gb = ga + rsign * 1536;                                                   \
      qA0 = *(const uint4*)(ga); kA0 = *(const uint4*)(ga + 512); vA0 = *(const uint4*)(ga + 1024); \
      qB0 = *(const uint4*)(gb); kB0 = *(const uint4*)(gb + 512); vB0 = *(const uint4*)(gb + 1024); \
    }                                                                                         \
    {                                                                                         \
      const int u = tid_ + 256, c8 = u & 15, tp = u >> 4;                                     \
      const bf16_t* ga = DQ + (size_t)(rstart_ + rsign * 2 * tp) * 1536 + h * 128 + c8 * 8;   \
      const bf16_t* gb = ga + rsign * 1536;                                                   \
      qA1 = *(const uint4*)(ga); kA1 = *(const uint4*)(ga + 512); vA1 = *(const uint4*)(ga + 1024); \
      qB1 = *(const uint4*)(gb); kB1 = *(const uint4*)(gb + 512); vB1 = *(const uint4*)(gb + 1024); \
    }                                                                                         \
    {                                                                                         \
      const bf16_t* Tg = TB + (size_t)((chunk_ * 4 + h) * 2 + d) * 4096;                      \
      tq0 = *(const uint4*)(Tg + (tid_ >> 3) * 64 + (tid_ & 7) * 8);                          \
      tq1 = *(const uint4*)(Tg + ((tid_ >> 3) + 32) * 64 + (tid_ & 7) * 8);                   \
    }                                                                                         \
    if (tid_ < 64) {                                                                          \
      const int row = rstart_ + rsign * tid_;                                                 \
      pgc = GC[(size_t)row * 8 + d * 4 + h];                                                  \
      pbe = BE[(size_t)row * 8 + d * 4 + h];                                                  \
    }                                                                                         \
  }
  SCAN_LOADS(0)
  for (int n = 0; n < 36; ++n) {
    const int tid = otid(), lane = tid & 63, w = tid >> 6, li = lane & 31, hh = lane >> 5;
    int chunk, row0;
    SCAN_ROW0(n, chunk, row0)
    (void)chunk;
    const int rstart = d ? (row0 + 63) : row0;
    __syncthreads();
#define STAGE_UNIT(U, QA, QB, KA, KB, VA, VB)                                                   \
  {                                                                                             \
    const int c8 = (U)&15, tp = (U) >> 4;                                                       \
    *(uint4*)(sQ + (2 * tp) * 136 + c8 * 8) = QA;                                               \
    *(uint4*)(sQ + (2 * tp + 1) * 136 + c8 * 8) = QB;                                           \
    *(uint4*)(sK + (2 * tp) * 136 + c8 * 8) = KA;                                               \
    *(uint4*)(sK + (2 * tp + 1) * 136 + c8 * 8) = KB;                                           \
    *(uint4*)(sV + (2 * tp) * 136 + c8 * 8) = VA;                                               \
    *(uint4*)(sV + (2 * tp + 1) * 136 + c8 * 8) = VB;                                           \
    unsigned* kt = (unsigned*)(sKT + (c8 * 8) * 68 + 2 * tp);                                   \
    kt[0 * 34] = (KA.x & 0xffffu) | (KB.x << 16);                                               \
    kt[1 * 34] = (KA.x >> 16) | (KB.x & 0xffff0000u);                                           \
    kt[2 * 34] = (KA.y & 0xffffu) | (KB.y << 16);                                               \
    kt[3 * 34] = (KA.y >> 16) | (KB.y & 0xffff0000u);                                           \
    kt[4 * 34] = (KA.z & 0xffffu) | (KB.z << 16);                                               \
    kt[5 * 34] = (KA.z >> 16) | (KB.z & 0xffff0000u);                                           \
    kt[6 * 34] = (KA.w & 0xffffu) | (KB.w << 16);                                               \
    kt[7 * 34] = (KA.w >> 16) | (KB.w & 0xffff0000u);                                           \
  }
    STAGE_UNIT(tid, qA0, qB0, kA0, kB0, vA0, vB0)
    STAGE_UNIT(tid + 256, qA1, qB1, kA1, kB1, vA1, vB1)
#undef STAGE_UNIT
    if (tid < 64) {
      float g63 = __shfl(pgc, 63);
      sg[lane] = pgc;
      sbt[lane] = pbe;
      seg[lane] = __expf(pgc);
      sdt[lane] = __expf(g63 - pgc);
    }
    __syncthreads();
    f32x16 v0, v1;
#pragma unroll
    for (int r = 0; r < 16; ++r) {
      const int t0 = rowmap(r, hh);
      v0[r] = bf2f(sV[t0 * 136 + w * 32 + li]);
      v1[r] = bf2f(sV[(32 + t0) * 136 + w * 32 + li]);
    }
    __syncthreads();
    {
      const int i0 = tid >> 3, c8 = tid & 7;
      *(uint2*)(sT + i0 * 68 + c8 * 8) = make_uint2(tq0.x, tq0.y);
      *(uint2*)(sT + i0 * 68 + c8 * 8 + 4) = make_uint2(tq0.z, tq0.w);
      *(uint2*)(sT + (i0 + 32) * 68 + c8 * 8) = make_uint2(tq1.x, tq1.y);
      *(uint2*)(sT + (i0 + 32) * 68 + c8 * 8 + 4) = make_uint2(tq1.z, tq1.w);
    }
    {
      const int mi = w >> 1, ni = w & 1;
      f32x16 a;
#pragma unroll
      for (int r = 0; r < 16; ++r) a[r] = 0.f;
      if (!(mi == 0 && ni == 1)) {
#pragma unroll
        for (int ks = 0; ks < 8; ++ks) {
          bf16x8 qa = *(const bf16x8*)(sQ + (mi * 32 + li) * 136 + ks * 16 + hh * 8);
          bf16x8 kb = *(const bf16x8*)(sK + (ni * 32 + li) * 136 + ks * 16 + hh * 8);
          a = __builtin_amdgcn_mfma_f32_32x32x16_bf16(qa, kb, a, 0, 0, 0);
        }
      }
#pragma unroll
      for (int r = 0; r < 16; ++r) {
        const int i = mi * 32 + rowmap(r, hh), j = ni * 32 + li;
        float val = (i >= j) ? a[r] * qscale * __expf(sg[i] - sg[j]) : 0.f;
        sA[i * 68 + j] = f2bf(val);
      }
    }
    __syncthreads();
    f32x16 ks0, ks1;
#pragma unroll
    for (int r = 0; r < 16; ++r) { ks0[r] = 0.f; ks1[r] = 0.f; }
    {
      const bf16_t* ka = sK + li * 136 + 4 * hh;
#define K_STEP(OFFS, SX, SS)                                                                           \
  {                                                                                                    \
    bf16x8 sb = pack8(SX, SS);                                                                         \
    ks0 = __builtin_amdgcn_mfma_f32_32x32x16_bf16(ld_perm(ka + (OFFS)), sb, ks0, 0, 0, 0);             \
    ks1 = __builtin_amdgcn_mfma_f32_32x32x16_bf16(ld_perm(ka + 32 * 136 + (OFFS)), sb, ks1, 0, 0, 0);  \
  }
      K_STEP(0, S0, 0) K_STEP(16, S0, 1) K_STEP(32, S1, 0) K_STEP(48, S1, 1)
      K_STEP(64, S2, 0) K_STEP(80, S2, 1) K_STEP(96, S3, 0) K_STEP(112, S3, 1)
#undef K_STEP
    }
#pragma unroll
    for (int r = 0; r < 16; ++r) {
      const int t0 = rowmap(r, hh), t1 = 32 + t0;
      v0[r] = sbt[t0] * (v0[r] - seg[t0] * ks0[r]);
      v1[r] = sbt[t1] * (v1[r] - seg[t1] * ks1[r]);
    }
    __builtin_amdgcn_sched_barrier(0);
    bf16x8 rb00 = pack8(v0, 0), rb01 = pack8(v0, 1), rb10 = pack8(v1, 0), rb11 = pack8(v1, 1);
    f32x16 n0, n1;
#pragma unroll
    for (int r = 0; r < 16; ++r) { n0[r] = 0.f; n1[r] = 0.f; }
    {
      const bf16_t* ta = sT + li * 68 + 4 * hh;
      n0 = __builtin_amdgcn_mfma_f32_32x32x16_bf16(ld_perm(ta + 0), rb00, n0, 0, 0, 0);
      n0 = __builtin_amdgcn_mfma_f32_32x32x16_bf16(ld_perm(ta + 16), rb01, n0, 0, 0, 0);
      const bf16_t* tb = ta + 32 * 68;
      n1 = __builtin_amdgcn_mfma_f32_32x32x16_bf16(ld_perm(tb + 0), rb00, n1, 0, 0, 0);
      n1 = __builtin_amdgcn_mfma_f32_32x32x16_bf16(ld_perm(tb + 16), rb01, n1, 0, 0, 0);
      n1 = __builtin_amdgcn_mfma_f32_32x32x16_bf16(ld_perm(tb + 32), rb10, n1, 0, 0, 0);
      n1 = __builtin_amdgcn_mfma_f32_32x32x16_bf16(ld_perm(tb + 48), rb11, n1, 0, 0, 0);
    }
    __builtin_amdgcn_sched_barrier(0);
    f32x16 o0, o1;
#pragma unroll
    for (int r = 0; r < 16; ++r) { o0[r] = 0.f; o1[r] = 0.f; }
    {
      const bf16_t* qa = sQ + li * 136 + 4 * hh;
#define Q_STEP(OFFS, SX, SS)                                                                           \
  {                                                                                                    \
    bf16x8 sb = pack8(SX, SS);                                                                         \
    o0 = __builtin_amdgcn_mfma_f32_32x32x16_bf16(ld_perm(qa + (OFFS)), sb, o0, 0, 0, 0);               \
    o1 = __builtin_amdgcn_mfma_f32_32x32x16_bf16(ld_perm(qa + 32 * 136 + (OFFS)), sb, o1, 0, 0, 0);    \
  }
      Q_STEP(0, S0, 0) Q_STEP(16, S0, 1) Q_STEP(32, S1, 0) Q_STEP(48, S1, 1)
      Q_STEP(64, S2, 0) Q_STEP(80, S2, 1) Q_STEP(96, S3, 0) Q_STEP(112, S3, 1)
#undef Q_STEP
    }
#pragma unroll
    for (int r = 0; r < 16; ++r) {
      const int t0 = rowmap(r, hh), t1 = 32 + t0;
      o0[r] *= seg[t0] * qscale;
      o1[r] *= seg[t1] * qscale;
    }
    {
      bf16x8 nb00 = pack8(n0, 0), nb01 = pack8(n0, 1), nb10 = pack8(n1, 0), nb11 = pack8(n1, 1);
      const bf16_t* aa = sA + li * 68 + 4 * hh;
      o0 = __builtin_amdgcn_mfma_f32_32x32x16_bf16(ld_perm(aa + 0), nb00, o0, 0, 0, 0);
      o0 = __builtin_amdgcn_mfma_f32_32x32x16_bf16(ld_perm(aa + 16), nb01, o0, 0, 0, 0);
      const bf16_t* ab = aa + 32 * 68;
      o1 = __builtin_amdgcn_mfma_f32_32x32x16_bf16(ld_perm(ab + 0), nb00, o1, 0, 0, 0);
      o1 = __builtin_amdgcn_mfma_f32_32x32x16_bf16(ld_perm(ab + 16), nb01, o1, 0, 0, 0);
      o1 = __builtin_amdgcn_mfma_f32_32x32x16_bf16(ld_perm(ab + 32), nb10, o1, 0, 0, 0);
      o1 = __builtin_amdgcn_mfma_f32_32x32x16_bf16(ld_perm(ab + 48), nb11, o1, 0, 0, 0);
    }
    __syncthreads();
#pragma unroll
    for (int r = 0; r < 16; ++r) {
      const int t0 = rowmap(r, hh);
      sQ[t0 * 136 + w * 32 + li] = f2bf(o0[r]);
      sQ[(32 + t0) * 136 + w * 32 + li] = f2bf(o1[r]);
    }
#pragma unroll
    for (int r = 0; r < 16; ++r) {
      const int t0 = rowmap(r, hh), t1 = 32 + t0;
      n0[r] *= sdt[t0];
      n1[r] *= sdt[t1];
    }
    {
      bf16x8 nb00 = pack8(n0, 0), nb01 = pack8(n0, 1), nb10 = pack8(n1, 0), nb11 = pack8(n1, 1);
      const float eg63 = seg[63];
#pragma unroll
      for (int r = 0; r < 16; ++r) { S0[r] *= eg63; S1[r] *= eg63; S2[r] *= eg63; S3[r] *= eg63; }
      __builtin_amdgcn_sched_barrier(0);
      SCAN_LOADS(min(n + 1, 35))
      __builtin_amdgcn_sched_barrier(0);
      const bf16_t* kt = sKT + li * 68 + 4 * hh;
#define S_UPD(SX, DKT)                                                                                   \
  SX = __builtin_amdgcn_mfma_f32_32x32x16_bf16(ld_perm(kt + (DKT) * 32 * 68 + 0), nb00, SX, 0, 0, 0);    \
  SX = __builtin_amdgcn_mfma_f32_32x32x16_bf16(ld_perm(kt + (DKT) * 32 * 68 + 16), nb01, SX, 0, 0, 0);   \
  SX = __builtin_amdgcn_mfma_f32_32x32x16_bf16(ld_perm(kt + (DKT) * 32 * 68 + 32), nb10, SX, 0, 0, 0);   \
  SX = __builtin_amdgcn_mfma_f32_32x32x16_bf16(ld_perm(kt + (DKT) * 32 * 68 + 48), nb11, SX, 0, 0, 0);
      S_UPD(S0, 0) S_UPD(S1, 1) S_UPD(S2, 2) S_UPD(S3, 3)
#undef S_UPD
    }
    __syncthreads();
    {
      bf16_t* obase = d ? (Pw + C_DN + h * 128) : (MIX + 512 + h * 128);
      const int ostride = d ? INWP : 1024;
#pragma unroll
      for (int e = 0; e < 4; ++e) {
        const int idx = tid + 256 * e, tok = idx >> 4, c8 = idx & 15;
        const int row = rstart + rsign * tok;
        *(uint4*)(obase + (size_t)row * ostride + c8 * 8) = *(const uint4*)(sQ + tok * 136 + c8 * 8);
      }
    }
  }
#undef SCAN_LOADS
#undef SCAN_ROW0
  __builtin_amdgcn_s_setprio(0);
}

__device__ void phaseC(const Params& p, int l, char* smem) {
  const int nb = gridDim.x, bid = blockIdx.x;
  const bf16_t* P = (const bf16_t*)(p.ws + OFF_P);
  constexpr int T0 = 144 * 3, T1 = T0 + 144 * 4, T2 = T1 + M_ALL / 8, T3 = T2 + 1152;
  for (int it = bid; it < T3; it += nb) {
    if (it < T0) {
      int i = it;
      gemm_tile<EPI_QUP>(p, l, P + C_MQ, INWP, (const bf16_t*)(p.ws + OFF_WQUP), 256, (i / 3) * 128, (i % 3) * 128, 0,
                         smem);
    } else if (it < T1) {
      int i = it - T0;
      gemm_tile<EPI_KVUP>(p, l, P + C_MKV, INWP, (const bf16_t*)(p.ws + OFF_WKVUP), 128, (i / 4) * 128, (i % 4) * 128,
                          0, smem);
    } else if (it < T2) {
      kpe_item(p, it - T1);
    } else {
      dn_chunk_prep(p, l, it - T2, smem);
    }
  }
}

__device__ void mla_flash(const Params& p, int item, char* smem) {
  bf16_t* sK = (bf16_t*)smem;
  bf16_t* sV = sK + 64 * 104;
  const int tid = otid(), lane = tid & 63, w = tid >> 6;
  const int li = lane & 31, hh = lane >> 5;
  int b, h, q0row, nkeys;
  if (item < 512) {
    b = item >> 6; h = (item >> 4) & 3; q0row = b * 2048 + (item & 15) * 128; nkeys = 2304;
  } else {
    int i = item - 512;
    b = i >> 3; h = (i >> 1) & 3; q0row = M_LAT + b * 256 + (i & 1) * 128; nkeys = 256;
  }
  const bf16_t* Kg = (const bf16_t*)(p.ws + OFF_KH) + (size_t)(b * 4 + h) * 2304 * 96;
  const bf16_t* Vg = (const bf16_t*)(p.ws + OFF_VH) + (size_t)(b * 4 + h) * 64 * 2304;
  const bf16_t* QH = (const bf16_t*)(p.ws + OFF_QH);
  bf16_t* MIX = (bf16_t*)(p.ws + OFF_HM);
  const int qrow = q0row + w * 32 + li;
  bf16x8 qf0, qf1, qf2, qf3, qf4, qf5;
  {
    const bf16_t* qp = QH + (size_t)qrow * 384 + h * 96 + hh * 8;
    qf0 = *(const bf16x8*)(qp); qf1 = *(const bf16x8*)(qp + 16); qf2 = *(const bf16x8*)(qp + 32);
    qf3 = *(const bf16x8*)(qp + 48); qf4 = *(const bf16x8*)(qp + 64); qf5 = *(const bf16x8*)(qp + 80);
  }
  const int k_i0 = tid, k_i1 = tid + 256, k_i2 = tid + 512;
  const int kk0 = k_i0 / 12, kc0 = k_i0 % 12, kk1 = k_i1 / 12, kc1 = k_i1 % 12, kk2 = k_i2 / 12, kc2 = k_i2 % 12;
  const int vd0 = tid >> 3, vc0 = tid & 7, vd1 = vd0 + 32;
  uint4 rk0, rk1, rk2, rv0, rv1;
  rk0 = *(const uint4*)(Kg + (size_t)kk0 * 96 + kc0 * 8);
  rk1 = *(const uint4*)(Kg + (size_t)kk1 * 96 + kc1 * 8);
  rk2 = *(const uint4*)(Kg + (size_t)kk2 * 96 + kc2 * 8);
  rv0 = *(const uint4*)(Vg + (size_t)vd0 * 2304 + vc0 * 8);
  rv1 = *(const uint4*)(Vg + (size_t)vd1 * 2304 + vc0 * 8);
  f32x16 o0, o1;
#pragma unroll
  for (int r = 0; r < 16; ++r) { o0[r] = 0.f; o1[r] = 0.f; }
  float m = -1e30f, lp = 0.f;
  const float sc = 0.10206207261596577f * 1.4426950408889634f;
  const int nt = nkeys >> 6;
  for (int t = 0; t < nt; ++t) {
    __syncthreads();
    *(uint4*)(sK + kk0 * 104 + kc0 * 8) = rk0;
    *(uint4*)(sK + kk1 * 104 + kc1 * 8) = rk1;
    *(uint4*)(sK + kk2 * 104 + kc2 * 8) = rk2;
    *(uint2*)(sV + vd0 * 68 + vc0 * 8) = make_uint2(rv0.x, rv0.y);
    *(uint2*)(sV + vd0 * 68 + vc0 * 8 + 4) = make_uint2(rv0.z, rv0.w);
    *(uint2*)(sV + vd1 * 68 + vc0 * 8) = make_uint2(rv1.x, rv1.y);
    *(uint2*)(sV + vd1 * 68 + vc0 * 8 + 4) = make_uint2(rv1.z, rv1.w);
    __syncthreads();
    if (t + 1 < nt) {
      const int k0 = (t + 1) * 64;
      rk0 = *(const uint4*)(Kg + (size_t)(k0 + kk0) * 96 + kc0 * 8);
      rk1 = *(const uint4*)(Kg + (size_t)(k0 + kk1) * 96 + kc1 * 8);
      rk2 = *(const uint4*)(Kg + (size_t)(k0 + kk2) * 96 + kc2 * 8);
      rv0 = *(const uint4*)(Vg + (size_t)vd0 * 2304 + k0 + vc0 * 8);
      rv1 = *(const uint4*)(Vg + (size_t)vd1 * 2304 + k0 + vc0 * 8);
    }
    f32x16 s0, s1;
#pragma unroll
    for (int r = 0; r < 16; ++r) { s0[r] = 0.f; s1[r] = 0.f; }
    {
      const bf16_t* ka = sK + li * 104 + hh * 8;
      const bf16_t* kb = ka + 32 * 104;
      s0 = __builtin_amdgcn_mfma_f32_32x32x16_bf16(*(const bf16x8*)(ka), qf0, s0, 0, 0, 0);
      s1 = __builtin_amdgcn_mfma_f32_32x32x16_bf16(*(const bf16x8*)(kb), qf0, s1, 0, 0, 0);
      s0 = __builtin_amdgcn_mfma_f32_32x32x16_bf16(*(const bf16x8*)(ka + 16), qf1, s0, 0, 0, 0);
      s1 = __builtin_amdgcn_mfma_f32_32x32x16_bf16(*(const bf16x8*)(kb + 16), qf1, s1, 0, 0, 0);
      s0 = __builtin_amdgcn_mfma_f32_32x32x16_bf16(*(const bf16x8*)(ka + 32), qf2, s0, 0, 0, 0);
      s1 = __builtin_amdgcn_mfma_f32_32x32x16_bf16(*(const bf16x8*)(kb + 32), qf2, s1, 0, 0, 0);
      s0 = __builtin_amdgcn_mfma_f32_32x32x16_bf16(*(const bf16x8*)(ka + 48), qf3, s0, 0, 0, 0);
      s1 = __builtin_amdgcn_mfma_f32_32x32x16_bf16(*(const bf16x8*)(kb + 48), qf3, s1, 0, 0, 0);
      s0 = __builtin_amdgcn_mfma_f32_32x32x16_bf16(*(const bf16x8*)(ka + 64), qf4, s0, 0, 0, 0);
      s1 = __builtin_amdgcn_mfma_f32_32x32x16_bf16(*(const bf16x8*)(kb + 64), qf4, s1, 0, 0, 0);
      s0 = __builtin_amdgcn_mfma_f32_32x32x16_bf16(*(const bf16x8*)(ka + 80), qf5, s0, 0, 0, 0);
      s1 = __builtin_amdgcn_mfma_f32_32x32x16_bf16(*(const bf16x8*)(kb + 80), qf5, s1, 0, 0, 0);
    }
    float mx = s0[0];
#pragma unroll
    for (int r = 1; r < 16; ++r) mx = fmaxf(mx, s0[r]);
#pragma unroll
    for (int r = 0; r < 16; ++r) mx = fmaxf(mx, s1[r]);
    mx = fmaxf(mx, __shfl_xor(mx, 32));
    const float mn = fmaxf(m, mx * sc);
    const float corr = __builtin_amdgcn_exp2f(m - mn);
    m = mn;
    lp *= corr;
#pragma unroll
    for (int r = 0; r < 16; ++r) { o0[r] *= corr; o1[r] *= corr; }
#pragma unroll
    for (int r = 0; r < 16; ++r) {
      s0[r] = __builtin_amdgcn_exp2f(s0[r] * sc - mn);
      s1[r] = __builtin_amdgcn_exp2f(s1[r] * sc - mn);
      lp += s0[r] + s1[r];
    }
#pragma unroll
    for (int u = 0; u < 2; ++u) {
#pragma unroll
      for (int s = 0; s < 2; ++s) {
        union { bf16x8 v; unsigned w[4]; } pb;
        if (u == 0) {
          pb.w[0] = pack2(s0[8 * s + 0], s0[8 * s + 1]); pb.w[1] = pack2(s0[8 * s + 2], s0[8 * s + 3]);
          pb.w[2] = pack2(s0[8 * s + 4], s0[8 * s + 5]); pb.w[3] = pack2(s0[8 * s + 6], s0[8 * s + 7]);
        } else {
          pb.w[0] = pack2(s1[8 * s + 0], s1[8 * s + 1]); pb.w[1] = pack2(s1[8 * s + 2], s1[8 * s + 3]);
          pb.w[2] = pack2(s1[8 * s + 4], s1[8 * s + 5]); pb.w[3] = pack2(s1[8 * s + 6], s1[8 * s + 7]);
        }
        const bf16_t* va = sV + li * 68 + 32 * u + 16 * s + 4 * hh;
        union { bf16x8 v; uint2 d[2]; } a0, a1;
        a0.d[0] = *(const uint2*)(va);
        a0.d[1] = *(const uint2*)(va + 8);
        a1.d[0] = *(const uint2*)(va + 32 * 68);
        a1.d[1] = *(const uint2*)(va + 32 * 68 + 8);
        o0 = __builtin_amdgcn_mfma_f32_32x32x16_bf16(a0.v, pb.v, o0, 0, 0, 0);
        o1 = __builtin_amdgcn_mfma_f32_32x32x16_bf16(a1.v, pb.v, o1, 0, 0, 0);
      }
    }
  }
  lp += __shfl_xor(lp, 32);
  const float inv = 1.f / lp;
  bf16_t* op = MIX + (size_t)qrow * 1024 + h * 64 + 4 * hh;
#pragma unroll
  for (int g = 0; g < 4; ++g) {
    uint2 u0, u1;
    u0.x = pack2(o0[4 * g + 0] * inv, o0[4 * g + 1] * inv);
    u0.y = pack2(o0[4 * g + 2] * inv, o0[4 * g + 3] * inv);
    u1.x = pack2(o1[4 * g + 0] * inv, o1[4 * g + 1] * inv);
    u1.y = pack2(o1[4 * g + 2] * inv, o1[4 * g + 3] * inv);
    *(uint2*)(op + 8 * g) = u0;
    *(uint2*)(op + 32 + 8 * g) = u1;
  }
}

__device__ void na_naive(const Params& p, int l, int ti) {
  const int h = otid() >> 6, lane = otid() & 63;
  const bf16_t* P = (const bf16_t*)(p.ws + OFF_P);
  bf16_t* MIX = (bf16_t*)(p.ws + OFF_HM);
  const bool lat = ti < 256;
  const int b = lat ? (ti >> 5) : ((ti - 256) >> 2);
  const int r = ti & 31;
  const int row = lat ? (ti * 64 + lane) : (M_LAT + (ti - 256) * 64 + lane);
  uint4 qk[8];
  float acc[64];
  {
    const uint4* qp = (const uint4*)(P + (size_t)row * INWP + C_NQ + h * 64);
#pragma unroll
    for (int c = 0; c < 8; ++c) qk[c] = qp[c];
  }
#pragma unroll
  for (int i = 0; i < 64; ++i) acc[i] = 0.f;
  float m = -INFINITY, ls = 0.f;
  const int qc = lane;
  const int rs0 = min(max(r - 4, 0), 24);
  const int cs0 = min(max(qc - 8, 0), 48);
  const float* rb = p.rel_bias + (size_t)l * 4 * 15 * 31 + h * 15 * 31;
  const int nloc = lat ? 128 : 0;
  for (int j = 0; j < nloc + 256; ++j) {
    int krow;
    float bias = 0.f;
    if (j < nloc) {
      int kr = rs0 + (j >> 4), kc = cs0 + (j & 15);
      krow = b * 2048 + kr * 64 + kc;
      bias = rb[(kr - r + 7) * 31 + (kc - qc + 15)];
    } else {
      krow = M_LAT + b * 256 + (j - nloc);
    }
    const uint4* kp = (const uint4*)(P + (size_t)krow * INWP + C_NK + h * 64);
    float s = 0.f;
#pragma unroll
    for (int c = 0; c < 8; ++c) {
      uint4 u = kp[c];
      uint4 q = qk[c];
      s += bflo(q.x) * bflo(u.x) + bfhi(q.x) * bfhi(u.x) + bflo(q.y) * bflo(u.y) + bfhi(q.y) * bfhi(u.y) +
           bflo(q.z) * bflo(u.z) + bfhi(q.z) * bfhi(u.z) + bflo(q.w) * bflo(u.w) + bfhi(q.w) * bfhi(u.w);
    }
    s = s * 0.125f + bias;
    float mn = fmaxf(m, s);
    float corr = __expf(m - mn), pe = __expf(s - mn);
    ls = ls * corr + pe;
    m = mn;
    const uint4* vp = (const uint4*)(P + (size_t)krow * INWP + C_NV + h * 64);
#pragma unroll
    for (int c = 0; c < 8; ++c) {
      uint4 u = vp[c];
      acc[c * 8 + 0] = acc[c * 8 + 0] * corr + pe * bflo(u.x);
      acc[c * 8 + 1] = acc[c * 8 + 1] * corr + pe * bfhi(u.x);
      acc[c * 8 + 2] = acc[c * 8 + 2] * corr + pe * bflo(u.y);
      acc[c * 8 + 3] = acc[c * 8 + 3] * corr + pe * bfhi(u.y);
      acc[c * 8 + 4] = acc[c * 8 + 4] * corr + pe * bflo(u.z);
      acc[c * 8 + 5] = acc[c * 8 + 5] * corr + pe * bfhi(u.z);
      acc[c * 8 + 6] = acc[c * 8 + 6] * corr + pe * bflo(u.w);
      acc[c * 8 + 7] = acc[c * 8 + 7] * corr + pe * bfhi(u.w);
    }
  }
  const float inv = 1.f / ls;
  uint4* op = (uint4*)(MIX + (size_t)row * 1024 + 256 + h * 64);
#pragma unroll
  for (int c = 0; c < 8; ++c) {
    uint4 u;
    u.x = pack2(acc[c * 8 + 0] * inv, acc[c * 8 + 1] * inv);
    u.y = pack2(acc[c * 8 + 2] * inv, acc[c * 8 + 3] * inv);
    u.z = pack2(acc[c * 8 + 4] * inv, acc[c * 8 + 5] * inv);
    u.w = pack2(acc[c * 8 + 6] * inv, acc[c * 8 + 7] * inv);
    op[c] = u;
  }
}

__device__ void na_flash(const Params& p, int l, int item, char* smem) {
  bf16_t* sK = (bf16_t*)smem;
  bf16_t* sV = sK + 64 * 72;
  float* sBias = (float*)(smem + 18432);
  const int tid = otid(), lane = tid & 63, w = tid >> 6;
  const int li = lane & 31, hh = lane >> 5;
  const bf16_t* P = (const bf16_t*)(p.ws + OFF_P);
  bf16_t* MIX = (bf16_t*)(p.ws + OFF_HM);
  int b, h, qrow, qr = 0, qc = 0, rs0 = 0, ntiles, krow0 = 0;
  bool lat;
  if (item < 512) {
    lat = true;
    b = item >> 6; h = item & 3;
    const int r0 = ((item >> 2) & 15) * 2;
    qr = r0 + (w >> 1); qc = (w & 1) * 32 + li;
    qrow = b * 2048 + qr * 64 + qc;
    krow0 = min(max(r0 - 4, 0), 24);
    const int klast = min(max(r0 + 1 - 4, 0), 24) + 7;
    ntiles = 4 + (klast - krow0 + 1);
    rs0 = min(max(qr - 4, 0), 24);
  } else {
    lat = false;
    const int i = item - 512;
    b = i >> 3; h = i & 3;
    qrow = M_LAT + b * 256 + ((i >> 2) & 1) * 128 + w * 32 + li;
    ntiles = 4;
  }
  const int cs0 = min(max(qc - 8, 0), 48);
  const bf16_t* Vg = (const bf16_t*)(p.ws + OFF_NVT) + (size_t)(b * 4 + h) * 64 * 2304;
  bf16x8 qf0, qf1, qf2, qf3;
  {
    const bf16_t* qp = P + (size_t)qrow * INWP + C_NQ + h * 64 + hh * 8;
    qf0 = *(const bf16x8*)(qp); qf1 = *(const bf16x8*)(qp + 16); qf2 = *(const bf16x8*)(qp + 32); qf3 = *(const bf16x8*)(qp + 48);
  }
  __syncthreads();
  for (int i = tid; i < 465; i += 256)
    sBias[i] = p.rel_bias[(size_t)l * 4 * 465 + h * 465 + i] * 1.4426950408889634f;
  const int kk0 = tid >> 3, kc8 = tid & 7, kk1 = kk0 + 32;
  uint4 rk0, rk1, rv0, rv1;
  {
    const size_t kr = (size_t)(M_LAT + b * 256);
    rk0 = *(const uint4*)(P + (kr + kk0) * INWP + C_NK + h * 64 + kc8 * 8);
    rk1 = *(const uint4*)(P + (kr + kk1) * INWP + C_NK + h * 64 + kc8 * 8);
    rv0 = *(const uint4*)(Vg + (size_t)kk0 * 2304 + kc8 * 8);
    rv1 = *(const uint4*)(Vg + (size_t)kk1 * 2304 + kc8 * 8);
  }
  f32x16 o0, o1;
#pragma unroll
  for (int r = 0; r < 16; ++r) { o0[r] = 0.f; o1[r] = 0.f; }
  float m = -1e30f, lp = 0.f;
  const float sc = 0.125f * 1.4426950408889634f;
  for (int t = 0; t < ntiles; ++t) {
    __syncthreads();
    *(uint4*)(sK + kk0 * 72 + kc8 * 8) = rk0;
    *(uint4*)(sK + kk1 * 72 + kc8 * 8) = rk1;
    *(uint2*)(sV + kk0 * 68 + kc8 * 8) = make_uint2(rv0.x, rv0.y);
    *(uint2*)(sV + kk0 * 68 + kc8 * 8 + 4) = make_uint2(rv0.z, rv0.w);
    *(uint2*)(sV + kk1 * 68 + kc8 * 8) = make_uint2(rv1.x, rv1.y);
    *(uint2*)(sV + kk1 * 68 + kc8 * 8 + 4) = make_uint2(rv1.z, rv1.w);
    __syncthreads();
    if (t + 1 < ntiles) {
      const int tn = t + 1;
      size_t kr;
      int vk;
      if (tn < 4) { kr = (size_t)(M_LAT + b * 256 + tn * 64); vk = tn * 64; }
      else { kr = (size_t)(b * 2048 + (krow0 + tn - 4) * 64); vk = 256 + (krow0 + tn - 4) * 64; }
      rk0 = *(const uint4*)(P + (kr + kk0) * INWP + C_NK + h * 64 + kc8 * 8);
      rk1 = *(const uint4*)(P + (kr + kk1) * INWP + C_NK + h * 64 + kc8 * 8);
      rv0 = *(const uint4*)(Vg + (size_t)kk0 * 2304 + vk + kc8 * 8);
      rv1 = *(const uint4*)(Vg + (size_t)kk1 * 2304 + vk + kc8 * 8);
    }
    const int kr_abs = krow0 + t - 4;
    const bool local = t >= 4;
    if (local && (kr_abs < rs0 || kr_abs >= rs0 + 8)) continue;
    f32x16 s0, s1;
#pragma unroll
    for (int r = 0; r < 16; ++r) { s0[r] = 0.f; s1[r] = 0.f; }
    {
      const bf16_t* ka = sK + li * 72 + hh * 8;
      const bf16_t* kb = ka + 32 * 72;
      s0 = __builtin_amdgcn_mfma_f32_32x32x16_bf16(*(const bf16x8*)(ka), qf0, s0, 0, 0, 0);
      s1 = __builtin_amdgcn_mfma_f32_32x32x16_bf16(*(const bf16x8*)(kb), qf0, s1, 0, 0, 0);
      s0 = __builtin_amdgcn_mfma_f32_32x32x16_bf16(*(const bf16x8*)(ka + 16), qf1, s0, 0, 0, 0);
      s1 = __builtin_amdgcn_mfma_f32_32x32x16_bf16(*(const bf16x8*)(kb + 16), qf1, s1, 0, 0, 0);
      s0 = __builtin_amdgcn_mfma_f32_32x32x16_bf16(*(const bf16x8*)(ka + 32), qf2, s0, 0, 0, 0);
      s1 = __builtin_amdgcn_mfma_f32_32x32x16_bf16(*(const bf16x8*)(kb + 32), qf2, s1, 0, 0, 0);
      s0 = __builtin_amdgcn_mfma_f32_32x32x16_bf16(*(const bf16x8*)(ka + 48), qf3, s0, 0, 0, 0);
      s1 = __builtin_amdgcn_mfma_f32_32x32x16_bf16(*(const bf16x8*)(kb + 48), qf3, s1, 0, 0, 0);
    }
    if (local) {
      const float* bp = sBias + (kr_abs - qr + 7) * 31 - qc + 15;
#pragma unroll
      for (int r = 0; r < 16; ++r) {
        const int kc0 = rowmap(r, hh), kc1 = 32 + kc0;
        const bool v0 = (kc0 >= cs0) && (kc0 < cs0 + 16);
        const bool v1 = (kc1 >= cs0) && (kc1 < cs0 + 16);
        const float b0 = v0 ? bp[kc0] : 0.f;
        const float b1 = v1 ? bp[kc1] : 0.f;
        s0[r] = v0 ? (s0[r] * sc + b0) : -1e30f;
        s1[r] = v1 ? (s1[r] * sc + b1) : -1e30f;
      }
    } else {
#pragma unroll
      for (int r = 0; r < 16; ++r) { s0[r] *= sc; s1[r] *= sc; }
    }
    float mx = s0[0];
#pragma unroll
    for (int r = 1; r < 16; ++r) mx = fmaxf(mx, s0[r]);
#pragma unroll
    for (int r = 0; r < 16; ++r) mx = fmaxf(mx, s1[r]);
    mx = fmaxf(mx, __shfl_xor(mx, 32));
    const float mn = fmaxf(m, mx);
    const float corr = __builtin_amdgcn_exp2f(m - mn);
    m = mn;
    lp *= corr;
#pragma unroll
    for (int r = 0; r < 16; ++r) { o0[r] *= corr; o1[r] *= corr; }
#pragma unroll
    for (int r = 0; r < 16; ++r) {
      s0[r] = __builtin_amdgcn_exp2f(s0[r] - mn);
      s1[r] = __builtin_amdgcn_exp2f(s1[r] - mn);
      lp += s0[r] + s1[r];
    }
#pragma unroll
    for (int u = 0; u < 2; ++u) {
#pragma unroll
      for (int s = 0; s < 2; ++s) {
        bf16x8 pb = u == 0 ? pack8(s0, s) : pack8(s1, s);
        const bf16_t* va = sV + li * 68 + 32 * u + 16 * s + 4 * hh;
        o0 = __builtin_amdgcn_mfma_f32_32x32x16_bf16(ld_perm(va), pb, o0, 0, 0, 0);
        o1 = __builtin_amdgcn_mfma_f32_32x32x16_bf16(ld_perm(va + 32 * 68), pb, o1, 0, 0, 0);
      }
    }
  }
  lp += __shfl_xor(lp, 32);
  const float inv = 1.f / lp;
  bf16_t* op = MIX + (size_t)qrow * 1024 + 256 + h * 64 + 4 * hh;
#pragma unroll
  for (int g = 0; g < 4; ++g) {
    uint2 u0, u1;
    u0.x = pack2(o0[4 * g + 0] * inv, o0[4 * g + 1] * inv);
    u0.y = pack2(o0[4 * g + 2] * inv, o0[4 * g + 3] * inv);
    u1.x = pack2(o1[4 * g + 0] * inv, o1[4 * g + 1] * inv);
    u1.y = pack2(o1[4 * g + 2] * inv, o1[4 * g + 3] * inv);
    *(uint2*)(op + 8 * g) = u0;
    *(uint2*)(op + 32 + 8 * g) = u1;
  }
}

DEVI int dn_rowof(int s, int b, int d) {
  if (s < 256) {
    int c = d ? (255 - s) : s;
    return M_LAT + b * 256 + c;
  }
  int t = s - 256;
  t = d ? (2047 - t) : t;
  return b * 2048 + t;
}

__device__ void dn_naive(const Params& p, int l, int it, char* smem) {
  float* ks = (float*)smem;
  float* qs = ks + 32 * 128;
  float* vs = qs + 32 * 128;
  float* gs = vs + 32 * 64;
  float* bs = gs + 32;
  const int half = it & 1, d = (it >> 1) & 1, h = (it >> 2) & 3, b = it >> 4;
  const int tid = otid(), w = tid >> 6, lane = tid & 63, c = lane & 15, kg = lane >> 4;
  const int col = half * 64 + w * 16 + c;
  const bf16_t* DQ = (const bf16_t*)(p.ws + OFF_DNQKV);
  const float* AB = (const float*)(p.ws + OFF_AB);
  bf16_t* MIX = (bf16_t*)(p.ws + OFF_HM);
  bf16_t* OB = (bf16_t*)(p.ws + OFF_OB);
  float S[32];
#pragma unroll
  for (int i = 0; i < 32; ++i) S[i] = 0.f;
  const float Aneg = -__expf(p.a_log[l * 8 + d * 4 + h]);
  const float dtb = p.dt_bias[l * 8 + d * 4 + h];
  for (int s0 = 0; s0 < 2304; s0 += 32) {
    __syncthreads();
    for (int i = tid; i < 32 * 128; i += 256) {
      int tk = i >> 7, ch = i & 127;
      int row = dn_rowof(s0 + tk, b, d);
      qs[i] = bf2f(DQ[(size_t)row * 1536 + h * 128 + ch]);
      ks[i] = bf2f(DQ[(size_t)row * 1536 + 512 + h * 128 + ch]);
    }
    for (int i = tid; i < 32 * 64; i += 256) {
      int tk = i >> 6, ch = i & 63;
      int row = dn_rowof(s0 + tk, b, d);
      vs[i] = bf2f(DQ[(size_t)row * 1536 + 1024 + h * 128 + half * 64 + ch]);
    }
    if (tid < 32) {
      int row = dn_rowof(s0 + tid, b, d);
      float a = AB[(size_t)row * 16 + d * 4 + h];
      float bb = AB[(size_t)row * 16 + 8 + d * 4 + h];
      float xx = a + dtb;
      float sp = xx > 20.f ? xx : log1pf(__expf(xx));
      gs[tid] = __expf(Aneg * sp);
      bs[tid] = 1.f / (1.f + __expf(-bb));
    }
    __syncthreads();
    for (int tk = 0; tk < 32; ++tk) {
      const float eg = gs[tk], beta = bs[tk];
      const float vv = vs[tk * 64 + w * 16 + c];
      const float4* k4 = (const float4*)(ks + tk * 128 + kg * 32);
      const float4* q4 = (const float4*)(qs + tk * 128 + kg * 32);
      float part = 0.f;
#pragma unroll
      for (int i = 0; i < 8; ++i) {
        float4 kk = k4[i];
        S[4 * i + 0] *= eg; S[4 * i + 1] *= eg; S[4 * i + 2] *= eg; S[4 * i + 3] *= eg;
        part += kk.x * S[4 * i + 0] + kk.y * S[4 * i + 1] + kk.z * S[4 * i + 2] + kk.w * S[4 * i + 3];
      }
      part += __shfl_xor(part, 16);
      part += __shfl_xor(part, 32);
      const float delta = beta * (vv - part);
      float po = 0.f;
#pragma unroll
      for (int i = 0; i < 8; ++i) {
        float4 kk = k4[i];
        float4 qq = q4[i];
        S[4 * i + 0] += kk.x * delta; S[4 * i + 1] += kk.y * delta; S[4 * i + 2] += kk.z * delta; S[4 * i + 3] += kk.w * delta;
        po += qq.x * S[4 * i + 0] + qq.y * S[4 * i + 1] + qq.z * S[4 * i + 2] + qq.w * S[4 * i + 3];
      }
      po += __shfl_xor(po, 16);
      po += __shfl_xor(po, 32);
      if (kg == 0) {
        int row = dn_rowof(s0 + tk, b, d);
        float o = po * 0.08838834764831845f;
        if (d == 0)
          MIX[(size_t)row * 1024 + 512 + h * 128 + col] = f2bf(o);
        else
          OB[(size_t)row * 512 + h * 128 + col] = f2bf(o);
      }
    }
  }
}

__device__ void phaseD(const Params& p, int l, char* smem) {
  const int nb = gridDim.x, bid = blockIdx.x;
  if (bid < 64) {
    dn_scan(p, l, bid, smem);
    return;
  }
  const int nb2 = nb - 64;
  for (int it = bid - 64; it < 1152 + N_CONV_LATE; it += nb2) {
    if (it < 576) {
      int item = it;
      if (it < 512) item = ((it & 7) * 64) + (it >> 3);
      mla_flash(p, item, smem);
    } else if (it < 1152) {
      na_flash(p, l, it - 576, smem);
    } else {
      conv_item_late(p, l, it - 1152, (float*)smem);
    }
  }
}

__device__ void outgate_item(const Params& p, int l, int item) {
  const int w = otid() >> 6, lane = otid() & 63;
  const int row = item * 4 + w;
  const bf16_t* P = (const bf16_t*)(p.ws + OFF_P);
  bf16_t* MIX = (bf16_t*)(p.ws + OFF_HM);
  const int h = lane >> 4, cb = (lane & 15) * 8;
  uint4 uo = *(const uint4*)(MIX + (size_t)row * 1024 + 512 + h * 128 + cb);
  uint4 ub = *(const uint4*)(P + (size_t)row * INWP + C_DN + h * 128 + cb);
  uint4 uz = *(const uint4*)(P + (size_t)row * INWP + C_DZ + h * 128 + cb);
  float o[8], z[8];
  o[0] = bflo(uo.x) + bflo(ub.x); o[1] = bfhi(uo.x) + bfhi(ub.x); o[2] = bflo(uo.y) + bflo(ub.y); o[3] = bfhi(uo.y) + bfhi(ub.y);
  o[4] = bflo(uo.z) + bflo(ub.z); o[5] = bfhi(uo.z) + bfhi(ub.z); o[6] = bflo(uo.w) + bflo(ub.w); o[7] = bfhi(uo.w) + bfhi(ub.w);
  z[0] = bflo(uz.x); z[1] = bfhi(uz.x); z[2] = bflo(uz.y); z[3] = bfhi(uz.y);
  z[4] = bflo(uz.z); z[5] = bfhi(uz.z); z[6] = bflo(uz.w); z[7] = bfhi(uz.w);
  float ss = 0.f;
#pragma unroll
  for (int e = 0; e < 8; ++e) ss += o[e] * o[e];
  ss += __shfl_xor(ss, 1);
  ss += __shfl_xor(ss, 2);
  ss += __shfl_xor(ss, 4);
  ss += __shfl_xor(ss, 8);
  const float r = rsqrtf(ss * (1.f / 128.f) + 1e-6f);
  const float* go = p.g_out + l * 128 + cb;
  float y[8];
#pragma unroll
  for (int e = 0; e < 8; ++e) y[e] = o[e] * r * go[e] * silu_f(z[e]);
  uint4 u;
  u.x = pack2(y[0], y[1]); u.y = pack2(y[2], y[3]); u.z = pack2(y[4], y[5]); u.w = pack2(y[6], y[7]);
  *(uint4*)(MIX + (size_t)row * 1024 + 512 + h * 128 + cb) = u;
}

__device__ void final_item(const Params& p, int item) {
  const int w = otid() >> 6, lane = otid() & 63;
  const int row = item * 4 + w;
  const float4* xr = (const float4*)((const float*)(p.ws + OFF_X) + (size_t)row * 1024);
  float4 v[4];
  float ss = 0.f;
#pragma unroll
  for (int i = 0; i < 4; ++i) {
    v[i] = xr[lane + 64 * i];
    ss += v[i].x * v[i].x + v[i].y * v[i].y + v[i].z * v[i].z + v[i].w * v[i].w;
  }
  ss = wave_sum(ss);
  const float r = rsqrtf(ss * (1.f / 1024.f) + 1e-6f);
  const float4* g4 = (const float4*)p.g_final;
  float4* o4 = (float4*)(p.out + (size_t)row * 1024);
#pragma unroll
  for (int i = 0; i < 4; ++i) {
    float4 gg = g4[lane + 64 * i];
    float4 y;
    y.x = v[i].x * r * gg.x; y.y = v[i].y * r * gg.y; y.z = v[i].z * r * gg.z; y.w = v[i].w * r * gg.w;
    o4[lane + 64 * i] = y;
  }
}

constexpr int N_PHASES = 1 + 9 * 4 + 1;

__global__ void __launch_bounds__(256, 2) mega(Params p) {
  __shared__ __attribute__((aligned(16))) char smem[SMEM_BYTES];
  cg::grid_group grid = cg::this_grid();
  const int nb = gridDim.x, bid = blockIdx.x;
  __shared__ uint4 xb_words;
  if (threadIdx.x == 0) xb_words = make_uint4(0u, 0u, 0u, 0u);
  __syncthreads();
  XcdBarrier xb = xcd_barrier_post((unsigned*)(p.ws + OFF_BAR), (volatile LAS unsigned*)&xb_words);
#ifdef PROBE_S
  bool again = false;
#endif
  for (int ph = p.ph_lo; ph < p.ph_hi; ++ph) {
    if (ph == 0) {
      phase0(p, smem);
    } else if (ph == N_PHASES - 1) {
      for (int it = bid; it < M_LAT / 4; it += nb) final_item(p, it);
    } else {
      const int l = (ph - 1) / 9, s = (ph - 1) % 9;
      if (s == 0) {
        phaseA(p, l, smem);
      } else if (s == 1) {
        for (int it = bid; it < 144 * 26; it += nb) {
          int mt, nt;
          tile_map(it, 26, mt, nt);
          gemm_tile<EPI_P>(p, l, (const bf16_t*)(p.ws + OFF_HM), 1024, (const bf16_t*)(p.ws + OFF_WIN), 1024,
                           mt * 128, nt * 128, 0, smem);
        }
      } else if (s == 2) {
        phaseC(p, l, smem);
      } else if (s == 3) {
        phaseD(p, l, smem);
      } else if (s == 4) {
        for (int it = bid; it < M_ALL / 4; it += nb) outgate_item(p, l, it);
      } else if (s == 5) {
        for (int it = bid; it < 144 * 8; it += nb) {
          int mt, nt;
          tile_map(it, 8, mt, nt);
          gemm_tile<EPI_RES>(p, l, (const bf16_t*)(p.ws + OFF_HM), 1024, (const bf16_t*)(p.ws + OFF_WOUT), 1024,
                             mt * 128, nt * 128, 2, smem);
        }
      } else if (s == 6) {
        for (int it = bid; it < M_ALL / 4; it += nb)
          norm_rows((const float*)(p.ws + OFF_X), (bf16_t*)(p.ws + OFF_HM), p.g_ffn + l * 1024,
                    (const float*)(p.ws + OFF_MOD) + (size_t)l * 9 * 6144, 3, 4, it);
      } else if (s == 7) {
        for (int it = bid; it < 144 * 44; it += nb) {
          int mt, nt;
          tile_map(it, 44, mt, nt);
          gemm_tile<EPI_GU>(p, l, (const bf16_t*)(p.ws + OFF_HM), 1024, (const bf16_t*)(p.ws + OFF_WGU), 1024,
                            mt * 128, nt * 128, 0, smem);
        }
      } else {
        for (int it = bid; it < 144 * 8; it += nb) {
          int mt, nt;
          tile_map(it, 8, mt, nt);
          gemm_tile<EPI_RES>(p, l, (const bf16_t*)(p.ws + OFF_P), FFN, (const bf16_t*)(p.ws + OFF_WDN), FFN,
                             mt * 128, nt * 128, 5, smem);
        }
      }
    }
#ifdef PROBE_S
    {
      const bool hit = (PROBE_S == 9) ? (ph == 0) : (ph != 0 && ph != N_PHASES - 1 && ((ph - 1) % 9) == PROBE_S);
      if (hit && !again) {
        again = true;
        if (p.use_cg) grid.sync(); else xcd_barrier(xb);
        --ph;
        continue;
      }
      again = false;
    }
#endif
    if (ph + 1 < p.ph_hi) {
      if (p.use_cg) grid.sync();
      else xcd_barrier(xb);
    }
  }
}

extern "C" void kernel_launch(void* const* d_in, const int* in_sizes, int n_in, void* d_out, int out_size, void* d_ws,
                              size_t ws_size, hipStream_t stream) {
  static int grid_blocks = 0;
  if (!grid_blocks) {
    int dev = 0, cus = 0, per_cu = 0;
    hipGetDevice(&dev);
    hipDeviceGetAttribute(&cus, hipDeviceAttributeMultiprocessorCount, dev);
    hipOccupancyMaxActiveBlocksPerMultiprocessor(&per_cu, mega, 256, 0);
    if (per_cu < 1) per_cu = 1;
    if (per_cu > 2) per_cu = 2;
    grid_blocks = cus * per_cu;
  }
  Params p{};
  const float** pp = (const float**)&p;
  for (int i = 0; i < 23; ++i) pp[i] = (const float*)d_in[i];
  p.out = (float*)d_out;
  p.ws = (char*)d_ws;
  p.ph_lo = 0;
  p.ph_hi = N_PHASES;
  p.use_cg = 0;
  p.pad0 = 0;
  hipMemsetAsync((char*)d_ws + OFF_BAR, 0, XCD_BAR_WORDS * sizeof(unsigned), stream);
  void* args[] = {&p};
  hipError_t e = hipLaunchCooperativeKernel((void*)mega, dim3(grid_blocks), dim3(256), args, 0, stream);
  if (e != hipSuccess) {
    fprintf(stderr, "cooperative launch failed: %s (grid %d)\n", hipGetErrorString(e), grid_blocks);
    (void)hipGetLastError();
    for (int ph = 0; ph < N_PHASES; ++ph) {
      p.ph_lo = ph;
      p.ph_hi = ph + 1;
      hipLaunchKernelGGL(mega, dim3(grid_blocks), dim3(256), 0, stream, p);
    }
  }
}
```

```cpp
#include <hip/hip_runtime.h>
#include <hip/hip_bf16.h>
#include <hip/hip_cooperative_groups.h>
#include <cstdio>
namespace cg = cooperative_groups;

#define DEVI __device__ __forceinline__
typedef unsigned short bf16_t;
typedef short bf16x8 __attribute__((ext_vector_type(8)));
typedef float f32x16 __attribute__((ext_vector_type(16)));

constexpr int M_LAT = 16384, M_CTX = 2048, M_ALL = 18432;
constexpr int DM = 1024, INW = 3248, INWP = 3328, FFN = 2816;
constexpr int C_MQ = 0, C_MKV = 256, C_MPE = 384, C_NQ = 416, C_NK = 672, C_NV = 928, C_DN = 1184;
constexpr int C_DZ = C_DN + 1536, C_DA = C_DN + 2048;

constexpr size_t OFF_WIN = 0;
constexpr size_t OFF_WOUT = OFF_WIN + (size_t)INWP * 1024 * 2;
constexpr size_t OFF_WGU = OFF_WOUT + (size_t)1024 * 1024 * 2;
constexpr size_t OFF_WDN = OFF_WGU + (size_t)2 * FFN * 1024 * 2;
constexpr size_t OFF_WQUP = OFF_WDN + (size_t)1024 * FFN * 2;
constexpr size_t OFF_WKVUP = OFF_WQUP + (size_t)384 * 256 * 2;
constexpr size_t OFF_MOD = OFF_WKVUP + (size_t)512 * 128 * 2;
constexpr size_t OFF_ROPE = OFF_MOD + (size_t)4 * 9 * 6144 * 4;
constexpr size_t OFF_X = OFF_ROPE + (size_t)2048 * 16 * 2 * 4;
constexpr size_t OFF_HM = OFF_X + (size_t)M_ALL * 1024 * 4;
constexpr size_t OFF_P = OFF_HM + (size_t)M_ALL * 1024 * 2;
constexpr size_t OFF_QH = OFF_P + (size_t)M_ALL * INWP * 2;
constexpr size_t OFF_KH = OFF_QH + (size_t)M_ALL * 384 * 2;
constexpr size_t OFF_VH = OFF_KH + (size_t)M_ALL * 384 * 2;
constexpr size_t OFF_DNQKV = OFF_VH + (size_t)M_ALL * 256 * 2;
constexpr size_t OFF_OB = OFF_DNQKV + (size_t)M_ALL * 1536 * 2;
constexpr size_t OFF_AB = OFF_OB + (size_t)M_ALL * 512 * 2;
constexpr size_t OFF_GC = OFF_AB + (size_t)M_ALL * 16 * 4;
constexpr size_t OFF_BETA = OFF_GC + (size_t)M_ALL * 8 * 4;
constexpr size_t OFF_NVT = OFF_BETA + (size_t)M_ALL * 8 * 4;
constexpr size_t WS_TOTAL = OFF_NVT + (size_t)M_ALL * 256 * 2;
constexpr int SMEM_BYTES = 74240;
constexpr size_t OFF_BAR = (WS_TOTAL + 255) & ~(size_t)255;

struct Params {
  const float *x, *c, *ctx, *c_ctx, *w_ada, *b_ada, *g_mix, *w_in, *g_q, *g_kv, *w_qup, *w_kvup, *rel_bias,
      *conv_w, *a_log, *dt_bias, *g_out, *w_out, *g_ffn, *w_gate, *w_up, *w_down, *g_final;
  float* out;
  char* ws;
  int ph_lo, ph_hi;
  int use_cg, pad0;
};

DEVI bf16_t f2bf(float f) {
  __bf16 r = (__bf16)f;
  return __builtin_bit_cast(unsigned short, r);
}
DEVI int otid() {
  int t = threadIdx.x;
  asm volatile("" : "+v"(t));
  return t;
}
DEVI float bf2f(bf16_t h) { return __uint_as_float(((unsigned)h) << 16); }
DEVI float bflo(unsigned u) { return __uint_as_float(u << 16); }
DEVI float bfhi(unsigned u) { return __uint_as_float(u & 0xffff0000u); }
typedef __bf16 bf16v2_t __attribute__((ext_vector_type(2)));
typedef float f32v2_t __attribute__((ext_vector_type(2)));
DEVI unsigned pack2(float a, float b) {
  f32v2_t v = {a, b};
  bf16v2_t r = __builtin_convertvector(v, bf16v2_t);
  return __builtin_bit_cast(unsigned, r);
}
DEVI float silu_f(float x) { return x / (1.f + __expf(-x)); }
DEVI float wave_sum(float v) {
#pragma unroll
  for (int o = 32; o >= 1; o >>= 1) v += __shfl_xor(v, o);
  return v;
}

#define XB_TMO 128
#define XB_XCNT(j) (256 + 64 * (j))
#define XB_XSUB(j) (1280 + 64 * (j))
#define XB_XGEN(j) (2304 + 64 * (j))
#define XB_TOP 3328
#define XB_TOPGEN 3392
#define XCD_BAR_WORDS 3456
#define XB_SPIN_CAP (1u << 22)
#define LAS __attribute__((address_space(3)))
DEVI unsigned xb_ld(unsigned* p) { return __hip_atomic_load(p, __ATOMIC_RELAXED, __HIP_MEMORY_SCOPE_AGENT); }
DEVI unsigned xb_add(unsigned* p, unsigned v) { return __hip_atomic_fetch_add(p, v, __ATOMIC_RELAXED, __HIP_MEMORY_SCOPE_AGENT); }
DEVI unsigned xb_xcc_id() { return (unsigned)__builtin_amdgcn_s_getreg((3 << 11) | 20) & 0xFu; }
#define XB_SPIN(cond, bar)                                                     \
  do {                                                                         \
    unsigned _sp = 0;                                                          \
    while (cond) {                                                             \
      __builtin_amdgcn_s_sleep(1);                                             \
      if ((++_sp & 255u) == 0u) {                                              \
        if (xb_ld(&(bar)[XB_TMO])) break;                                      \
        if (_sp > XB_SPIN_CAP) { atomicAdd(&(bar)[XB_TMO], 1u); break; }       \
      }                                                                        \
    }                                                                          \
  } while (0)
struct XcdBarrier {
  unsigned* bar;
  unsigned x;
  volatile LAS unsigned* st;
};
DEVI XcdBarrier xcd_barrier_post(unsigned* bar, volatile LAS unsigned* st) {
  XcdBarrier b;
  b.bar = bar;
  b.x = xb_xcc_id();
  b.st = st;
  if (threadIdx.x == 0) (void)xb_add(&bar[XB_XCNT(b.x)], 1u);
  return b;
}
DEVI void xcd_barrier_complete(unsigned* bar, unsigned x, unsigned& nloc, unsigned& nx) {
  const unsigned G = gridDim.x * gridDim.y * gridDim.z;
  unsigned sum, cnt, mine, sp = 0u;
  for (;;) {
    sum = 0u; cnt = 0u; mine = 0u;
#pragma unroll
    for (unsigned j = 0; j < 16; ++j) {
      const unsigned c = xb_ld(&bar[XB_XCNT(j)]);
      sum += c;
      cnt += (c > 0u) ? 1u : 0u;
      mine = (j == x) ? c : mine;
    }
    if (sum == G) break;
    __builtin_amdgcn_s_sleep(1);
    if ((++sp & 255u) == 0u) {
      if (xb_ld(&bar[XB_TMO])) break;
      if (sp > XB_SPIN_CAP) { atomicAdd(&bar[XB_TMO], 1u); break; }
    }
  }
  nloc = mine > 0u ? mine : 1u;
  nx = cnt > 0u ? cnt : 1u;
}
DEVI void xcd_barrier(const XcdBarrier& b) {
  asm volatile("s_waitcnt vmcnt(0)" ::: "memory");
  __syncthreads();
  if (threadIdx.x == 0) {
    unsigned* bar = b.bar;
    __builtin_amdgcn_s_waitcnt(0);
    unsigned nloc = b.st[0], nx = b.st[1];
    if (nloc == 0u) {
      xcd_barrier_complete(bar, b.x, nloc, nx);
      b.st[0] = nloc;
      b.st[1] = nx;
    }
    const unsigned old = xb_add(&bar[XB_XSUB(b.x)], 1u);
    const unsigned gen = old / nloc;
    if (old + 1u == (gen + 1u) * nloc) {
      __builtin_amdgcn_fence(__ATOMIC_RELEASE, "agent");
      asm volatile("s_waitcnt vmcnt(0)" ::: "memory");
      const unsigned og = xb_add(&bar[XB_TOP], 1u);
      const unsigned tg = og / nx;
      if (og + 1u == (tg + 1u) * nx) xb_add(&bar[XB_TOPGEN], 1u);
      else XB_SPIN(xb_ld(&bar[XB_TOPGEN]) == tg, bar);
      __builtin_amdgcn_fence(__ATOMIC_ACQUIRE, "agent");
      xb_add(&bar[XB_XGEN(b.x)], 1u);
      asm volatile("s_waitcnt vmcnt(0)" ::: "memory");
    } else {
      XB_SPIN(xb_ld(&bar[XB_XGEN(b.x)]) == gen, bar);
      __builtin_amdgcn_fence(__ATOMIC_ACQUIRE, "agent");
      asm volatile("s_waitcnt vmcnt(0)" ::: "memory");
    }
  }
  __syncthreads();
}

constexpr int N_CONV_EARLY = 16 * 52 + 24 + 16;
__device__ void conv_item_early(const Params& p, int l, int it, float* tl);

__device__ void phase0(const Params& p, char* smem) {
  const int tid = otid(), nb = gridDim.x, bid = blockIdx.x;
  {
    float* rc = (float*)(p.ws + OFF_ROPE);
    float* rs = rc + 2048 * 16;
    for (int i = bid * 256 + tid; i < 2048 * 16; i += nb * 256) {
      int t = i >> 4, a = (i >> 3) & 1, j = i & 7;
      float pos = a ? (float)(t & 63) : (float)(t >> 6);
      float inv = __builtin_amdgcn_exp2f(-(float)j * (13.287712379549449f / 8.f));
      float ang = pos * inv;
      rc[i] = cosf(ang);
      rs[i] = sinf(ang);
    }
  }
  for (int it = bid; it < N_CONV_EARLY; it += nb) conv_item_early(p, 0, it, (float*)smem);
  __syncthreads();
  float* sc = (float*)smem;
  float* red = sc + 1024 * 12;
  float* MOD = (float*)(p.ws + OFF_MOD);
  bool loaded = false;
  for (int it = bid; it < 4 * 96; it += nb) {
    if (!loaded) {
      for (int i = tid; i < 9 * 1024; i += 256) {
        float v = i < 8192 ? p.c[i] : p.c_ctx[i - 8192];
        sc[(i & 1023) * 12 + (i >> 10)] = silu_f(v);
      }
      __syncthreads();
      loaded = true;
    }
    const int l = it / 96, n0 = (it % 96) * 64;
    const int cc = tid & 63, kg = tid >> 6;
    const float* w = p.w_ada + (size_t)l * 1024 * 6144 + n0 + cc;
    float acc[9];
#pragma unroll
    for (int b = 0; b < 9; ++b) acc[b] = 0.f;
    for (int k0 = kg * 256; k0 < kg * 256 + 256; k0 += 16) {
      float wvv[16];
#pragma unroll
      for (int j = 0; j < 16; ++j) wvv[j] = w[(size_t)(k0 + j) * 6144];
#pragma unroll
      for (int j = 0; j < 16; ++j) {
      const int k = k0 + j;
      const float wv = wvv[j];
      const float4 s0 = *(const float4*)(sc + k * 12);
      const float4 s1 = *(const float4*)(sc + k * 12 + 4);
      const float s2 = sc[k * 12 + 8];
      acc[0] += s0.x * wv; acc[1] += s0.y * wv; acc[2] += s0.z * wv; acc[3] += s0.w * wv;
      acc[4] += s1.x * wv; acc[5] += s1.y * wv; acc[6] += s1.z * wv; acc[7] += s1.w * wv;
      acc[8] += s2 * wv;
      }
    }
#pragma unroll
    for (int b = 0; b < 9; ++b) red[(kg * 9 + b) * 64 + cc] = acc[b];
    __syncthreads();
    for (int i = tid; i < 9 * 64; i += 256) {
      int b = i >> 6, c2 = i & 63;
      float s = red[(0 * 9 + b) * 64 + c2] + red[(1 * 9 + b) * 64 + c2] + red[(2 * 9 + b) * 64 + c2] +
                red[(3 * 9 + b) * 64 + c2];
      MOD[(size_t)(l * 9 + b) * 6144 + n0 + c2] = s + p.b_ada[l * 6144 + n0 + c2];
    }
    __syncthreads();
  }
}

__device__ void convT_tile(const float* __restrict__ src, int K, int N, bf16_t* __restrict__ dst, int mode,
                           const float* __restrict__ gs, int kt, int nt, float* tl) {
  const int tid = otid();
  const int k0 = kt * 64, n0 = nt * 64;
  __syncthreads();
#pragma unroll 4
  for (int i = 0; i < 16; ++i) {
    int kk = i * 4 + (tid >> 6), nn = tid & 63;
    float v = 0.f;
    if (n0 + nn < N) v = src[(size_t)(k0 + kk) * N + n0 + nn];
    if (gs) v *= gs[k0 + kk];
    tl[kk * 65 + nn] = v;
  }
  __syncthreads();
#pragma unroll 2
  for (int i = 0; i < 8; ++i) {
    int nn = i * 8 + (tid >> 5), kk = (tid & 31) * 2;
    unsigned pk = pack2(tl[kk * 65 + nn], tl[(kk + 1) * 65 + nn]);
    int n = n0 + nn;
    int drow = mode == 0 ? n : ((n >> 5) * 64 + (n & 31) + (mode == 2 ? 32 : 0));
    *(unsigned*)(dst + (size_t)drow * K + k0 + kk) = pk;
  }
}

__device__ void norm_rows(const Params& p, bool from_input, bf16_t* __restrict__ H, const float* __restrict__ g,
                          const float* __restrict__ modl, int shift_i, int scale_i, int item) {
  const int w = otid() >> 6, lane = otid() & 63;
  const int row = item * 4 + w;
  const float* xsrc = from_input ? (row < M_LAT ? p.x + (size_t)row * 1024 : p.ctx + (size_t)(row - M_LAT) * 1024)
                                 : (const float*)(p.ws + OFF_X) + (size_t)row * 1024;
  const float4* xr = (const float4*)xsrc;
  float4 v[4];
  float ss = 0.f;
#pragma unroll
  for (int i = 0; i < 4; ++i) {
    v[i] = xr[lane + 64 * i];
    ss += v[i].x * v[i].x + v[i].y * v[i].y + v[i].z * v[i].z + v[i].w * v[i].w;
  }
  ss = wave_sum(ss);
  const float r = rsqrtf(ss * (1.f / 1024.f) + 1e-6f);
  const int b = row < M_LAT ? (row >> 11) : 8;
  const float4* sh = (const float4*)(modl + b * 6144 + shift_i * 1024);
  const float4* sl = (const float4*)(modl + b * 6144 + scale_i * 1024);
  const float4* g4 = (const float4*)g;
#pragma unroll
  for (int i = 0; i < 4; ++i) {
    int c4 = lane + 64 * i;
    float4 gg = g4[c4], s4 = sh[c4], l4 = sl[c4];
    float y0 = v[i].x * r * gg.x * (1.f + l4.x) + s4.x;
    float y1 = v[i].y * r * gg.y * (1.f + l4.y) + s4.y;
    float y2 = v[i].z * r * gg.z * (1.f + l4.z) + s4.z;
    float y3 = v[i].w * r * gg.w * (1.f + l4.w) + s4.w;
    uint2 pk;
    pk.x = pack2(y0, y1);
    pk.y = pack2(y2, y3);
    *(uint2*)(H + (size_t)row * 1024 + c4 * 4) = pk;
  }
}

__device__ void conv_item_late(const Params& p, int l, int i, float* tl) {
  bf16_t* Wout = (bf16_t*)(p.ws + OFF_WOUT);
  bf16_t* Wgu = (bf16_t*)(p.ws + OFF_WGU);
  bf16_t* Wdn = (bf16_t*)(p.ws + OFF_WDN);
  const float* src;
  bf16_t* dst;
  int K, N, mode = 0, ntn;
  if (i < 256) {
    src = p.w_out + (size_t)l * 1024 * 1024; K = 1024; N = 1024; dst = Wout; ntn = 16;
  } else if (i < 960) {
    i -= 256; src = p.w_gate + (size_t)l * 1024 * FFN; K = 1024; N = FFN; dst = Wgu; ntn = 44; mode = 1;
  } else if (i < 1664) {
    i -= 960; src = p.w_up + (size_t)l * 1024 * FFN; K = 1024; N = FFN; dst = Wgu; ntn = 44; mode = 2;
  } else {
    i -= 1664; src = p.w_down + (size_t)l * FFN * 1024; K = FFN; N = 1024; dst = Wdn; ntn = 16;
  }
  convT_tile(src, K, N, dst, mode, nullptr, i / ntn, i % ntn, tl);
}
constexpr int N_CONV_LATE = 256 + 3 * 704;
__device__ void conv_item_early(const Params& p, int l, int it, float* tl) {
  const float* src;
  const float* gs = nullptr;
  bf16_t* dst;
  int K, N, ntn, i;
  if (it < 832) {
    i = it; src = p.w_in + (size_t)l * 1024 * INW; K = 1024; N = INW; dst = (bf16_t*)(p.ws + OFF_WIN); ntn = 52;
  } else if (it < 856) {
    i = it - 832; src = p.w_qup + (size_t)l * 256 * 384; K = 256; N = 384; dst = (bf16_t*)(p.ws + OFF_WQUP); ntn = 6;
    gs = p.g_q + l * 256;
  } else {
    i = it - 856; src = p.w_kvup + (size_t)l * 128 * 512; K = 128; N = 512; dst = (bf16_t*)(p.ws + OFF_WKVUP); ntn = 8;
    gs = p.g_kv + l * 128;
  }
  convT_tile(src, K, N, dst, 0, gs, i / ntn, i % ntn, tl);
}

__device__ void phaseA(const Params& p, int l, char* smem) {
  const int nb = gridDim.x, bid = blockIdx.x;
  for (int it = bid; it < M_ALL / 4; it += nb)
    norm_rows(p, l == 0, (bf16_t*)(p.ws + OFF_HM), p.g_mix + l * 1024,
              (const float*)(p.ws + OFF_MOD) + (size_t)l * 9 * 6144, 0, 1, it);
}

DEVI void tile_map(int it, int NT, int& mt, int& nt, int MPX = 18) {
  const int xcd = it & 7, idx = it >> 3;
  const int per_group = 8 * NT;
  const int g = idx / per_group, r = idx - g * per_group;
  const int gs = min(8, MPX - 8 * g);
  mt = xcd * MPX + g * 8 + r % gs;
  nt = r / gs;
}

enum { EPI_P = 0, EPI_QUP = 1, EPI_KVUP = 2, EPI_RES = 3, EPI_GU = 4 };

template <int EPI>
__device__ void gemm_tile(const Params& p, int l, const bf16_t* __restrict__ A, int lda,
                          const bf16_t* __restrict__ BT, int K, int m0, int n0, int gate_i, char* smem) {
  constexpr int STAGE = 2 * 128 * 72;
  bf16_t* sbase = (bf16_t*)smem;
  float* rsv = (float*)(smem + 2 * STAGE * 2);
  const int tid = otid(), lane = tid & 63, w = tid >> 6, wm = w >> 1, wn = w & 1;
  const int lr = tid >> 3, lc = (tid & 7) * 8;
  __syncthreads();
  if (EPI == EPI_QUP || EPI == EPI_KVUP) {
    const int row = tid >> 1, hf = tid & 1;
    const int n8 = K / 16;
    const uint4* ap = (const uint4*)(A + (size_t)(m0 + row) * lda + hf * (K / 2));
    float ss = 0.f;
    for (int i = 0; i < n8; ++i) {
      uint4 u = ap[i];
      float a0 = bflo(u.x), a1 = bfhi(u.x), a2 = bflo(u.y), a3 = bfhi(u.y), a4 = bflo(u.z), a5 = bfhi(u.z),
            a6 = bflo(u.w), a7 = bfhi(u.w);
      ss += a0 * a0 + a1 * a1 + a2 * a2 + a3 * a3 + a4 * a4 + a5 * a5 + a6 * a6 + a7 * a7;
    }
    ss += __shfl_xor(ss, 1);
    if (hf == 0) rsv[row] = rsqrtf(ss / (float)K + 1e-6f);
  }
  const bf16_t* Ap = A + (size_t)(m0 + lr) * lda + lc;
  const bf16_t* Bp = BT + (size_t)(n0 + lr) * K + lc;
  uint4 ra0, ra1, ra2, ra3, rb0, rb1, rb2, rb3;
#define G_LOAD()                                  \
  ra0 = *(const uint4*)(Ap);                      \
  ra1 = *(const uint4*)(Ap + (size_t)32 * lda);   \
  ra2 = *(const uint4*)(Ap + (size_t)64 * lda);   \
  ra3 = *(const uint4*)(Ap + (size_t)96 * lda);   \
  rb0 = *(const uint4*)(Bp);                      \
  rb1 = *(const uint4*)(Bp + (size_t)32 * K);     \
  rb2 = *(const uint4*)(Bp + (size_t)64 * K);     \
  rb3 = *(const uint4*)(Bp + (size_t)96 * K);
#define S_WRITE(ST)                                                   \
  {                                                                   \
    bf16_t* wa = sbase + (ST) * STAGE + lr * 72 + lc;                 \
    bf16_t* wb = wa + 128 * 72;                                       \
    *(uint4*)(wa) = ra0;                                              \
    *(uint4*)(wa + 32 * 72) = ra1;                                    \
    *(uint4*)(wa + 64 * 72) = ra2;                                    \
    *(uint4*)(wa + 96 * 72) = ra3;                                    \
    *(uint4*)(wb) = rb0;                                              \
    *(uint4*)(wb + 32 * 72) = rb1;                                    \
    *(uint4*)(wb + 64 * 72) = rb2;                                    \
    *(uint4*)(wb + 96 * 72) = rb3;                                    \
  }
  const int nk = K / 64;
  G_LOAD()
  S_WRITE(0)
  if (nk > 1) {
    Ap += 64;
    Bp += 64;
    G_LOAD()
  }
  f32x16 acc[2][2];
#pragma unroll
  for (int i = 0; i < 2; ++i)
#pragma unroll
    for (int j = 0; j < 2; ++j)
#pragma unroll
      for (int r = 0; r < 16; ++r) acc[i][j][r] = 0.f;
  __syncthreads();
  for (int kt = 0; kt < nk; ++kt) {
    const int cur = kt & 1;
    const bf16_t* pa = sbase + cur * STAGE + (wm * 64 + (lane & 31)) * 72 + (lane >> 5) * 8;
    const bf16_t* pb = sbase + cur * STAGE + 128 * 72 + (wn * 64 + (lane & 31)) * 72 + (lane >> 5) * 8;
    bf16x8 fa00 = *(const bf16x8*)(pa), fa01 = *(const bf16x8*)(pa + 32 * 72);
    bf16x8 fb00 = *(const bf16x8*)(pb), fb01 = *(const bf16x8*)(pb + 32 * 72);
    bf16x8 fa10 = *(const bf16x8*)(pa + 16), fa11 = *(const bf16x8*)(pa + 32 * 72 + 16);
    bf16x8 fb10 = *(const bf16x8*)(pb + 16), fb11 = *(const bf16x8*)(pb + 32 * 72 + 16);
    bf16x8 fa20 = *(const bf16x8*)(pa + 32), fa21 = *(const bf16x8*)(pa + 32 * 72 + 32);
    bf16x8 fb20 = *(const bf16x8*)(pb + 32), fb21 = *(const bf16x8*)(pb + 32 * 72 + 32);
    bf16x8 fa30 = *(const bf16x8*)(pa + 48), fa31 = *(const bf16x8*)(pa + 32 * 72 + 48);
    bf16x8 fb30 = *(const bf16x8*)(pb + 48), fb31 = *(const bf16x8*)(pb + 32 * 72 + 48);
    __builtin_amdgcn_sched_barrier(0);
#define MM4(A0, A1, B0, B1)                                                           \
  acc[0][0] = __builtin_amdgcn_mfma_f32_32x32x16_bf16(A0, B0, acc[0][0], 0, 0, 0);    \
  acc[0][1] = __builtin_amdgcn_mfma_f32_32x32x16_bf16(A0, B1, acc[0][1], 0, 0, 0);    \
  acc[1][0] = __builtin_amdgcn_mfma_f32_32x32x16_bf16(A1, B0, acc[1][0], 0, 0, 0);    \
  acc[1][1] = __builtin_amdgcn_mfma_f32_32x32x16_bf16(A1, B1, acc[1][1], 0, 0, 0);
    MM4(fa00, fa01, fb00, fb01)
    MM4(fa10, fa11, fb10, fb11)
    MM4(fa20, fa21, fb20, fb21)
    MM4(fa30, fa31, fb30, fb31)
#undef MM4
    __builtin_amdgcn_sched_barrier(0);
    if (kt + 1 < nk) {
      S_WRITE(cur ^ 1)
      if (kt + 2 < nk) {
        Ap += 64;
        Bp += 64;
        G_LOAD()
      }
    }
    __syncthreads();
  }
#undef G_LOAD
#undef S_WRITE
  const int ci = lane & 31;
  const int rbase = m0 + wm * 64 + 4 * (lane >> 5);
  const int cbase = n0 + wn * 64;
  if (EPI == EPI_P) {
    bf16_t* P = (bf16_t*)(p.ws + OFF_P);
    float* AB = (float*)(p.ws + OFF_AB);
#pragma unroll
    for (int mt = 0; mt < 2; ++mt)
#pragma unroll
      for (int nt = 0; nt < 2; ++nt)
#pragma unroll
        for (int r = 0; r < 16; ++r) {
          int row = rbase + mt * 32 + (r & 3) + 8 * (r >> 2);
          int col = cbase + nt * 32 + ci;
          float v = acc[mt][nt][r];
          P[(size_t)row * INWP + col] = f2bf(v);
          if (col >= C_DA && col < C_DA + 16) AB[(size_t)row * 16 + col - C_DA] = v;
        }
    bf16_t* NVT = (bf16_t*)(p.ws + OFF_NVT);
#pragma unroll
    for (int mt = 0; mt < 2; ++mt)
#pragma unroll
      for (int nt = 0; nt < 2; ++nt) {
        const int base = cbase + nt * 32;
        if (base >= C_NV && base < C_NV + 256) {
          const int hv = (base - C_NV) >> 6, dv = ((base - C_NV) & 63) + ci;
#pragma unroll
          for (int g = 0; g < 4; ++g) {
            const int row0 = rbase + mt * 32 + 8 * g;
            int bb, key0;
            if (row0 < M_LAT) { bb = row0 >> 11; key0 = 256 + (row0 & 2047); }
            else { bb = (row0 - M_LAT) >> 8; key0 = (row0 - M_LAT) & 255; }
            uint2 u;
            u.x = pack2(acc[mt][nt][4 * g + 0], acc[mt][nt][4 * g + 1]);
            u.y = pack2(acc[mt][nt][4 * g + 2], acc[mt][nt][4 * g + 3]);
            *(uint2*)(NVT + ((size_t)(bb * 4 + hv) * 64 + dv) * 2304 + key0) = u;
          }
        }
      }
  } else if (EPI == EPI_QUP) {
    bf16_t* QH = (bf16_t*)(p.ws + OFF_QH);
    const float* rc = (const float*)(p.ws + OFF_ROPE);
    const float* rsn = rc + 2048 * 16;
#pragma unroll
    for (int mt = 0; mt < 2; ++mt)
#pragma unroll
      for (int nt = 0; nt < 2; ++nt) {
        const int base = cbase + nt * 32;
        const bool rope = ((base % 96) == 64) && (m0 < M_LAT);
#pragma unroll
        for (int r = 0; r < 16; ++r) {
          int row = rbase + mt * 32 + (r & 3) + 8 * (r >> 2);
          float v = acc[mt][nt][r] * rsv[row - m0];
          float o = __shfl_xor(v, 8);
          if (rope) {
            int t = row & 2047;
            int a = ci >> 4, hf = (ci >> 3) & 1, j = ci & 7;
            float c = rc[t * 16 + a * 8 + j], s = rsn[t * 16 + a * 8 + j];
            v = hf ? (o * s + v * c) : (v * c - o * s);
          }
          QH[(size_t)row * 384 + base + ci] = f2bf(v);
        }
      }
  } else if (EPI == EPI_KVUP) {
    bf16_t* KA = (bf16_t*)(p.ws + OFF_KH);
    bf16_t* VT = (bf16_t*)(p.ws + OFF_VH);
#pragma unroll
    for (int mt = 0; mt < 2; ++mt)
#pragma unroll
      for (int nt = 0; nt < 2; ++nt) {
        const int base = cbase + nt * 32;
        const int h = base >> 7, cc = (base & 127) + ci;
#pragma unroll
        for (int g = 0; g < 4; ++g) {
          const int row0 = rbase + mt * 32 + 8 * g;
          int bb, key0;
          if (row0 < M_LAT) { bb = row0 >> 11; key0 = 256 + (row0 & 2047); }
          else { bb = (row0 - M_LAT) >> 8; key0 = (row0 - M_LAT) & 255; }
          float v0 = acc[mt][nt][4 * g + 0] * rsv[row0 - m0 + 0];
          float v1 = acc[mt][nt][4 * g + 1] * rsv[row0 - m0 + 1];
          float v2 = acc[mt][nt][4 * g + 2] * rsv[row0 - m0 + 2];
          float v3 = acc[mt][nt][4 * g + 3] * rsv[row0 - m0 + 3];
          if (cc < 64) {
            bf16_t* kp = KA + ((size_t)(bb * 4 + h) * 2304 + key0) * 96 + cc;
            kp[0] = f2bf(v0); kp[96] = f2bf(v1); kp[192] = f2bf(v2); kp[288] = f2bf(v3);
          } else {
            uint2 u;
            u.x = pack2(v0, v1);
            u.y = pack2(v2, v3);
            *(uint2*)(VT + ((size_t)(bb * 4 + h) * 64 + (cc - 64)) * 2304 + key0) = u;
          }
        }
      }
  } else if (EPI == EPI_RES) {
    float* X = (float*)(p.ws + OFF_X);
    const float* Xsrc = (l == 0 && gate_i == 2) ? (m0 < M_LAT ? p.x : p.ctx - (size_t)M_LAT * 1024) : X;
    const float* modl = (const float*)(p.ws + OFF_MOD) + (size_t)l * 9 * 6144 + gate_i * 1024;
#pragma unroll
    for (int mt = 0; mt < 2; ++mt)
#pragma unroll
      for (int nt = 0; nt < 2; ++nt)
#pragma unroll
        for (int r = 0; r < 16; ++r) {
          int row = rbase + mt * 32 + (r & 3) + 8 * (r >> 2);
          int col = cbase + nt * 32 + ci;
          int b = row < M_LAT ? (row >> 11) : 8;
          float g = modl[b * 6144 + col];
          size_t idx = (size_t)row * 1024 + col;
          X[idx] = Xsrc[idx] + g * acc[mt][nt][r];
        }
  } else if (EPI == EPI_GU) {
    bf16_t* ACT = (bf16_t*)(p.ws + OFF_P);
#pragma unroll
    for (int mt = 0; mt < 2; ++mt)
#pragma unroll
      for (int r = 0; r < 16; ++r) {
        int row = rbase + mt * 32 + (r & 3) + 8 * (r >> 2);
        float gt = acc[mt][0][r], up = acc[mt][1][r];
        float a = silu_f(gt) * up;
        ACT[(size_t)row * FFN + (cbase >> 6) * 32 + ci] = f2bf(a);
      }
  }
}

template <int EPI>
__device__ void gemm_wide(const Params& p, int l, const bf16_t* __restrict__ A, int lda,
                          const bf16_t* __restrict__ BT, int K, int m0, int n0, int gate_i, char* smem) {
  bf16_t* sA = (bf16_t*)smem;
  bf16_t* sB = sA + 128 * 72;
  const int tid = otid(), lane = tid & 63, w = tid >> 6, wm = w >> 1, wn = w & 1;
  const int lr = tid >> 3, lc = (tid & 7) * 8;
  const bf16_t* Ap = A + (size_t)(m0 + lr) * lda + lc;
  const bf16_t* Bp = BT + (size_t)(n0 + lr) * K + lc;
  uint4 ra0, ra1, ra2, ra3, rb0, rb1, rb2, rb3, rb4, rb5, rb6, rb7;
#define LOAD_AB()                                   \
  ra0 = *(const uint4*)(Ap);                        \
  ra1 = *(const uint4*)(Ap + (size_t)32 * lda);     \
  ra2 = *(const uint4*)(Ap + (size_t)64 * lda);     \
  ra3 = *(const uint4*)(Ap + (size_t)96 * lda);     \
  rb0 = *(const uint4*)(Bp);                        \
  rb1 = *(const uint4*)(Bp + (size_t)32 * K);       \
  rb2 = *(const uint4*)(Bp + (size_t)64 * K);       \
  rb3 = *(const uint4*)(Bp + (size_t)96 * K);       \
  rb4 = *(const uint4*)(Bp + (size_t)128 * K);      \
  rb5 = *(const uint4*)(Bp + (size_t)160 * K);      \
  rb6 = *(const uint4*)(Bp + (size_t)192 * K);      \
  rb7 = *(const uint4*)(Bp + (size_t)224 * K);
  LOAD_AB()
  f32x16 acc[2][4];
#pragma unroll
  for (int i = 0; i < 2; ++i)
#pragma unroll
    for (int j = 0; j < 4; ++j)
#pragma unroll
      for (int r = 0; r < 16; ++r) acc[i][j][r] = 0.f;
  const int nk = K / 64;
  for (int kt = 0; kt < nk; ++kt) {
    __syncthreads();
    *(uint4*)(sA + (lr + 0) * 72 + lc) = ra0;
    *(uint4*)(sA + (lr + 32) * 72 + lc) = ra1;
    *(uint4*)(sA + (lr + 64) * 72 + lc) = ra2;
    *(uint4*)(sA + (lr + 96) * 72 + lc) = ra3;
    *(uint4*)(sB + (lr + 0) * 72 + lc) = rb0;
    *(uint4*)(sB + (lr + 32) * 72 + lc) = rb1;
    *(uint4*)(sB + (lr + 64) * 72 + lc) = rb2;
    *(uint4*)(sB + (lr + 96) * 72 + lc) = rb3;
    *(uint4*)(sB + (lr + 128) * 72 + lc) = rb4;
    *(uint4*)(sB + (lr + 160) * 72 + lc) = rb5;
    *(uint4*)(sB + (lr + 192) * 72 + lc) = rb6;
    *(uint4*)(sB + (lr + 224) * 72 + lc) = rb7;
    __syncthreads();
    if (kt + 1 < nk) {
      Ap += 64;
      Bp += 64;
      LOAD_AB()
    }
    __builtin_amdgcn_sched_barrier(0);
#pragma unroll
    for (int ks = 0; ks < 4; ++ks) {
      const int ko = ks * 16 + (lane >> 5) * 8;
      bf16x8 a0 = *(const bf16x8*)(sA + (wm * 64 + (lane & 31)) * 72 + ko);
      bf16x8 a1 = *(const bf16x8*)(sA + (wm * 64 + 32 + (lane & 31)) * 72 + ko);
#pragma unroll
      for (int nt = 0; nt < 4; ++nt) {
        bf16x8 b = *(const bf16x8*)(sB + (wn * 128 + nt * 32 + (lane & 31)) * 72 + ko);
        acc[0][nt] = __builtin_amdgcn_mfma_f32_32x32x16_bf16(a0, b, acc[0][nt], 0, 0, 0);
        acc[1][nt] = __builtin_amdgcn_mfma_f32_32x32x16_bf16(a1, b, acc[1][nt], 0, 0, 0);
      }
    }
  }
#undef LOAD_AB
  const int ci = lane & 31;
  const int rbase = m0 + wm * 64 + 4 * (lane >> 5);
  const int cbase = n0 + wn * 128;
  if (EPI == EPI_P) {
    bf16_t* P = (bf16_t*)(p.ws + OFF_P);
    float* AB = (float*)(p.ws + OFF_AB);
    bf16_t* NVT = (bf16_t*)(p.ws + OFF_NVT);
#pragma unroll
    for (int mt = 0; mt < 2; ++mt)
#pragma unroll
      for (int nt = 0; nt < 4; ++nt) {
        const int base = cbase + nt * 32;
#pragma unroll
        for (int r = 0; r < 16; ++r) {
          int row = rbase + mt * 32 + (r & 3) + 8 * (r >> 2);
          int col = base + ci;
          float v = acc[mt][nt][r];
          P[(size_t)row * INWP + col] = f2bf(v);
          if (col >= C_DA && col < C_DA + 16) AB[(size_t)row * 16 + col - C_DA] = v;
        }
        if (base >= C_NV && base < C_NV + 256) {
          const int hv = (base - C_NV) >> 6, dv = ((base - C_NV) & 63) + ci;
#pragma unroll
          for (int g = 0; g < 4; ++g) {
            const int row0 = rbase + mt * 32 + 8 * g;
            int bb, key0;
            if (row0 < M_LAT) { bb = row0 >> 11; key0 = 256 + (row0 & 2047); }
            else { bb = (row0 - M_LAT) >> 8; key0 = (row0 - M_LAT) & 255; }
            uint2 u;
            u.x = pack2(acc[mt][nt][4 * g + 0], acc[mt][nt][4 * g + 1]);
            u.y = pack2(acc[mt][nt][4 * g + 2], acc[mt][nt][4 * g + 3]);
            *(uint2*)(NVT + ((size_t)(bb * 4 + hv) * 64 + dv) * 2304 + key0) = u;
          }
        }
      }
  } else if (EPI == EPI_GU) {
    bf16_t* ACT = (bf16_t*)(p.ws + OFF_P);
#pragma unroll
    for (int mt = 0; mt < 2; ++mt)
#pragma unroll
      for (int pr = 0; pr < 2; ++pr)
#pragma unroll
        for (int r = 0; r < 16; ++r) {
          int row = rbase + mt * 32 + (r & 3) + 8 * (r >> 2);
          float gt = acc[mt][2 * pr][r], up = acc[mt][2 * pr + 1][r];
          float a = silu_f(gt) * up;
          ACT[(size_t)row * FFN + ((cbase >> 6) + pr) * 32 + ci] = f2bf(a);
        }
  }
}

__device__ void kpe_item(const Params& p, int it) {
  const int tid = otid();
  const bf16_t* P = (const bf16_t*)(p.ws + OFF_P);
  bf16_t* KH = (bf16_t*)(p.ws + OFF_KH);
  const float* rc = (const float*)(p.ws + OFF_ROPE);
  const float* rsn = rc + 2048 * 16;
  const int row = it * 8 + (tid >> 5), i = tid & 31;
  float v = bf2f(P[(size_t)row * INWP + C_MPE + i]);
  float o = __shfl_xor(v, 8);
  if (row < M_LAT) {
    int t = row & 2047;
    int a = i >> 4, hf = (i >> 3) & 1, j = i & 7;
    float c = rc[t * 16 + a * 8 + j], s = rsn[t * 16 + a * 8 + j];
    v = hf ? (o * s + v * c) : (v * c - o * s);
  }
  bf16_t bv = f2bf(v);
  int bb, key;
  if (row < M_LAT) { bb = row >> 11; key = 256 + (row & 2047); }
  else { bb = (row - M_LAT) >> 8; key = (row - M_LAT) & 255; }
#pragma unroll
  for (int h = 0; h < 4; ++h) KH[((size_t)(bb * 4 + h) * 2304 + key) * 96 + 64 + i] = bv;
}

__device__ void dn_prep(const Params& p, int l, int it, char* smem) {
  float* buf = (float*)smem;
  float* nrm = buf + 8 * 1536;
  const int tid = otid();
  const bf16_t* P = (const bf16_t*)(p.ws + OFF_P);
  bf16_t* DQ = (bf16_t*)(p.ws + OFF_DNQKV);
  const int r0 = it * 8;
  int seq_lo, seq_hi;
  if (r0 < M_LAT) {
    seq_lo = (r0 >> 11) << 11;
    seq_hi = seq_lo + 2048;
  } else {
    int rr = r0 - M_LAT;
    seq_lo = M_LAT + ((rr >> 8) << 8);
    seq_hi = seq_lo + 256;
  }
  const float* cw = p.conv_w + (size_t)l * 5 * 1536;
  __syncthreads();
  for (int c6 = 0; c6 < 6; ++c6) {
    const int ch = c6 * 256 + tid;
    float w0 = cw[ch], w1 = cw[1536 + ch], w2 = cw[2 * 1536 + ch], w3 = cw[3 * 1536 + ch], w4 = cw[4 * 1536 + ch];
    float xw[12];
#pragma unroll
    for (int j = 0; j < 12; ++j) {
      int r = r0 - 2 + j;
      xw[j] = (r >= seq_lo && r < seq_hi) ? bf2f(P[(size_t)r * INWP + C_DN + ch]) : 0.f;
    }
#pragma unroll
    for (int j = 0; j < 8; ++j) {
      float y = w0 * xw[j] + w1 * xw[j + 1] + w2 * xw[j + 2] + w3 * xw[j + 3] + w4 * xw[j + 4];
      buf[j * 1536 + ch] = silu_f(y);
    }
  }
  __syncthreads();
  {
    int vec = tid >> 2, part = tid & 3;
    int rr = vec >> 3, hv = vec & 7;
    const float* v = buf + rr * 1536 + hv * 128 + part * 32;
    float ss = 0.f;
#pragma unroll
    for (int i = 0; i < 32; ++i) ss += v[i] * v[i];
    ss += __shfl_xor(ss, 1);
    ss += __shfl_xor(ss, 2);
    if (part == 0) nrm[vec] = rsqrtf(ss + 1e-6f);
  }
  __syncthreads();
  for (int i = tid; i < 8 * 1536; i += 256) {
    int rr = i / 1536, ch = i - rr * 1536;
    float v = buf[i];
    if (ch < 1024) v *= nrm[rr * 8 + (ch >> 7)];
    DQ[(size_t)(r0 + rr) * 1536 + ch] = f2bf(v);
  }
}


DEVI int rowmap(int r, int hh) { return (r & 3) + 8 * (r >> 2) + 4 * hh; }

DEVI void unpack8(const uint4& u, float* f) {
  f[0] = bflo(u.x); f[1] = bfhi(u.x); f[2] = bflo(u.y); f[3] = bfhi(u.y);
  f[4] = bflo(u.z); f[5] = bfhi(u.z); f[6] = bflo(u.w); f[7] = bfhi(u.w);
}
__device__ void dn_chunk_prep(const Params& p, int l, int item, char* smem) {
  float* sW = (float*)smem;
  bf16_t* sKb = (bf16_t*)(smem + 7680);
  float* sL0 = (float*)(smem + 25088);
  float* sL1 = sL0 + 64 * 68;
  float* sg = (float*)(smem + 59904);
  float* sbt = sg + 128;
  const int tid = otid(), lane = tid & 63, w = tid >> 6, li = lane & 31, hh = lane >> 5;
  const int chunk = item >> 2, h = item & 3;
  int row0, seq_lo, seq_hi;
  if (chunk < 256) {
    int b = chunk >> 5;
    row0 = b * 2048 + (chunk & 31) * 64; seq_lo = b * 2048; seq_hi = seq_lo + 2048;
  } else {
    int cc = chunk - 256, b = cc >> 2;
    row0 = M_LAT + b * 256 + (cc & 3) * 64; seq_lo = M_LAT + b * 256; seq_hi = seq_lo + 256;
  }
  const bf16_t* P = (const bf16_t*)(p.ws + OFF_P);
  bf16_t* DQ = (bf16_t*)(p.ws + OFF_DNQKV);
  const float* AB = (const float*)(p.ws + OFF_AB);
  const float* cw = p.conv_w + (size_t)l * 5 * 1536;
  __syncthreads();
  for (int i = tid; i < 5 * 384; i += 256) {
    const int tap = i / 384, cc = i - tap * 384, type = cc >> 7, c = cc & 127;
    const int off = type == 0 ? 512 : (type == 1 ? 0 : 1024);
    sW[i] = cw[tap * 1536 + off + h * 128 + c];
  }
  if (w < 2) {
    const int d = w;
    const int row = d ? (row0 + 63 - lane) : (row0 + lane);
    const float Aneg = -__expf(p.a_log[l * 8 + d * 4 + h]);
    const float dtb = p.dt_bias[l * 8 + d * 4 + h];
    float a = AB[(size_t)row * 16 + d * 4 + h];
    float bb = AB[(size_t)row * 16 + 8 + d * 4 + h];
    float xx = a + dtb;
    const float ee = __expf(xx);
    float sp = ee < 0.25f ? ee * (1.f - ee * (0.5f - ee * (0.33333333f - ee * (0.25f - 0.2f * ee))))
                          : (xx > 20.f ? xx : __logf(1.f + ee));
    float g = Aneg * sp;
#pragma unroll
    for (int o = 1; o < 64; o <<= 1) {
      float y = __shfl_up(g, o);
      if (lane >= o) g += y;
    }
    float be = 1.f / (1.f + __expf(-bb));
    sg[d * 64 + lane] = g;
    sbt[d * 64 + lane] = be;
    ((float*)(p.ws + OFF_GC))[(size_t)row * 8 + d * 4 + h] = g;
    ((float*)(p.ws + OFF_BETA))[(size_t)row * 8 + d * 4 + h] = be;
  }
  __syncthreads();
  const int cg = tid & 15, rsub = tid >> 4;
#pragma unroll 1
  for (int type = 0; type < 3; ++type) {
    const int off = type == 0 ? 512 : (type == 1 ? 0 : 1024);
    uint4 xv[4][5];
#pragma unroll
    for (int e = 0; e < 4; ++e) {
      const int row = rsub + 16 * e;
      const bf16_t* base = P + (size_t)(row0 + row) * INWP + C_DN + off + h * 128 + cg * 8;
#pragma unroll
      for (int dd = 0; dd < 5; ++dd) {
        const int r = row0 + row + dd - 2;
        xv[e][dd] = (r >= seq_lo && r < seq_hi) ? *(const uint4*)(base + (dd - 2) * INWP) : make_uint4(0u, 0u, 0u, 0u);
      }
    }
#pragma unroll
    for (int e = 0; e < 4; ++e) {
      const int row = rsub + 16 * e;
      float y[8];
#pragma unroll
      for (int j = 0; j < 8; ++j) y[j] = 0.f;
#pragma unroll
      for (int dd = 0; dd < 5; ++dd) {
        float xf[8];
        unpack8(xv[e][dd], xf);
        const float4 wa = *(const float4*)(sW + dd * 384 + type * 128 + cg * 8);
        const float4 wb = *(const float4*)(sW + dd * 384 + type * 128 + cg * 8 + 4);
        y[0] += wa.x * xf[0]; y[1] += wa.y * xf[1]; y[2] += wa.z * xf[2]; y[3] += wa.w * xf[3];
        y[4] += wb.x * xf[4]; y[5] += wb.y * xf[5]; y[6] += wb.z * xf[6]; y[7] += wb.w * xf[7];
      }
      float ss = 0.f;
#pragma unroll
      for (int j = 0; j < 8; ++j) {
        y[j] = silu_f(y[j]);
        ss += y[j] * y[j];
      }
      if (type < 2) {
        ss += __shfl_xor(ss, 1);
        ss += __shfl_xor(ss, 2);
        ss += __shfl_xor(ss, 4);
        ss += __shfl_xor(ss, 8);
        const float rn = rsqrtf(ss + 1e-6f);
#pragma unroll
        for (int j = 0; j < 8; ++j) y[j] *= rn;
      }
      uint4 u;
      u.x = pack2(y[0], y[1]); u.y = pack2(y[2], y[3]); u.z = pack2(y[4], y[5]); u.w = pack2(y[6], y[7]);
      *(uint4*)(DQ + (size_t)(row0 + row) * 1536 + off + h * 128 + cg * 8) = u;
      if (type == 0) *(uint4*)(sKb + row * 136 + cg * 8) = u;
    }
  }
  __syncthreads();
  {
    const int mi = w >> 1, ni = w & 1;
    f32x16 g;
#pragma unroll
    for (int r = 0; r < 16; ++r) g[r] = 0.f;
#pragma unroll
    for (int ks = 0; ks < 8; ++ks) {
      bf16x8 a = *(const bf16x8*)(sKb + (mi * 32 + li) * 136 + ks * 16 + hh * 8);
      bf16x8 b = *(const bf16x8*)(sKb + (ni * 32 + li) * 136 + ks * 16 + hh * 8);
      g = __builtin_amdgcn_mfma_f32_32x32x16_bf16(a, b, g, 0, 0, 0);
    }
#pragma unroll
    for (int r = 0; r < 16; ++r) {
      const int i = mi * 32 + rowmap(r, hh), m = ni * 32 + li;
      const float G = g[r];
      sL0[i * 68 + m] = (i > m) ? sbt[i] * G * __expf(sg[i] - sg[m]) : 0.f;
      const int i1 = 63 - i, m1 = 63 - m;
      sL1[i1 * 68 + m1] = (i1 > m1) ? sbt[64 + i1] * G * __expf(sg[64 + i1] - sg[64 + m1]) : 0.f;
    }
  }
  __syncthreads();
  if (w < 2) {
    const float* L = w == 0 ? sL0 : sL1;
    float t[64];
#pragma unroll
    for (int i = 0; i < 64; ++i) {
      float a0 = (i == lane) ? 1.f : 0.f, a1 = 0.f, a2 = 0.f, a3 = 0.f;
#pragma unroll
      for (int m = 0; m < i; ++m) {
        const float pr = L[i * 68 + m] * t[m];
        if ((m & 3) == 0) a0 -= pr;
        else if ((m & 3) == 1) a1 -= pr;
        else if ((m & 3) == 2) a2 -= pr;
        else a3 -= pr;
      }
      t[i] = (a0 + a1) + (a2 + a3);
    }
    bf16_t* Tg = (bf16_t*)(p.ws + OFF_OB) + (size_t)((chunk * 4 + h) * 2 + w) * 4096;
#pragma unroll
    for (int i = 0; i < 64; ++i) Tg[i * 64 + lane] = f2bf(t[i]);
  }
}

DEVI bf16x8 ld_perm(const bf16_t* p) {
  union { bf16x8 v; uint2 d[2]; } u;
  u.d[0] = *(const uint2*)(p);
  u.d[1] = *(const uint2*)(p + 8);
  return u.v;
}
DEVI bf16x8 pack8(const f32x16& x, int s) {
  union { bf16x8 v; unsigned w[4]; } u;
  u.w[0] = pack2(x[8 * s + 0], x[8 * s + 1]);
  u.w[1] = pack2(x[8 * s + 2], x[8 * s + 3]);
  u.w[2] = pack2(x[8 * s + 4], x[8 * s + 5]);
  u.w[3] = pack2(x[8 * s + 6], x[8 * s + 7]);
  return u.v;
}

__device__ void dn_scan(const Params& p, int l, int item, char* smem) {
  bf16_t* sK = (bf16_t*)smem;
  bf16_t* sQ = (bf16_t*)(smem + 17408);
  bf16_t* sKT = (bf16_t*)(smem + 34816);
  bf16_t* sT = (bf16_t*)(smem + 52224);
  bf16_t* sA = (bf16_t*)(smem + 60928);
  bf16_t* sV = (bf16_t*)(smem + 52224);
  float* sg = (float*)(smem + 69632);
  float* sbt = sg + 64;
  float* seg = sbt + 64;
  float* sdt = seg + 64;
  const int d = item & 1, h = (item >> 1) & 3, b = item >> 3;
  const bf16_t* DQ = (const bf16_t*)(p.ws + OFF_DNQKV);
  const bf16_t* TB = (const bf16_t*)(p.ws + OFF_OB);
  const float* GC = (const float*)(p.ws + OFF_GC);
  const float* BE = (const float*)(p.ws + OFF_BETA);
  bf16_t* MIX = (bf16_t*)(p.ws + OFF_HM);
  bf16_t* Pw = (bf16_t*)(p.ws + OFF_P);
  const float qscale = 0.08838834764831845f;
  const int rsign = d ? -1 : 1;
  f32x16 S0, S1, S2, S3;
#pragma unroll
  for (int r = 0; r < 16; ++r) { S0[r] = 0.f; S1[r] = 0.f; S2[r] = 0.f; S3[r] = 0.f; }
  __builtin_amdgcn_s_setprio(3);
  uint4 qA0, qB0, kA0, kB0, vA0, vB0, qA1, qB1, kA1, kB1, vA1, vB1, tq0, tq1;
  float pgc = 0.f, pbe = 0.f;
#define SCAN_ROW0(N, CHUNK, ROW0)                                    \
  {                                                                  \
    if ((N) < 4) {                                                   \
      int cn = d ? (3 - (N)) : (N);                                  \
      CHUNK = 256 + b * 4 + cn;                                      \
      ROW0 = M_LAT + b * 256 + cn * 64;                              \
    } else {                                                         \
      int ln = (N)-4;                                                \
      ln = d ? (31 - ln) : ln;                                       \
      CHUNK = b * 32 + ln;                                           \
      ROW0 = b * 2048 + ln * 64;                                     \
    }                                                                \
  }
#define SCAN_LOADS(N)                                                                         \
  {                                                                                           \
    const int tid_ = otid();                                                                  \
    int chunk_, row0_;                                                                        \
    SCAN_ROW0(N, chunk_, row0_)                                                               \
    const int rstart_ = d ? (row0_ + 63) : row0_;                                             \
    {                                                                                         \
      const int u = tid_, c8 = u & 15, tp = u >> 4;                                           \
      const bf16_t* ga = DQ + (size_t)(rstart_ + rsign * 2 * tp) * 1536 + h * 128 + c8 * 8;   \
      const bf16_t* gb = ga + rsign * 1536;                                                   \
      qA0 = *(const uint4*)(ga); kA0 = *(const uint4*)(ga + 512); vA0 = *(const uint4*)(ga + 1024); \
      qB0 = *(const uint4*)(gb); kB0 = *(const uint4*)(gb + 512); vB0 = *(const uint4*)(gb + 1024); \
    }                                                                                         \
    {                                                                                         \
      const int u = tid_ + 256, c8 = u & 15, tp = u >> 4;                                     \
      const bf16_t* ga = DQ + (size_t)(rstart_ + rsign * 2 * tp) * 1536 + h * 128 + c8 * 8;   \
      const bf16_t* gb = ga + rsign * 1536;                                                   \
      qA1 = *(const uint4*)(ga); kA1 = *(const uint4*)(ga + 512); vA1 = *(const uint4*)(ga + 1024); \
      qB1 = *(const uint4*)(gb); kB1 = *(const uint4*)(gb + 512); vB1 = *(const uint4*)(gb + 1024); \
    }                                                                                         \
    {                                                                                         \
      const bf16_t* Tg = TB + (size_t)((chunk_ * 4 + h) * 2 + d) * 4096;                      \
      tq0 = *(const uint4*)(Tg + (tid_ >> 3) * 64 + (tid_ & 7) * 8);                          \
      tq1 = *(const uint4*)(Tg + ((tid_ >> 3) + 32) * 64 + (tid_ & 7) * 8);                   \
    }                                                                                         \
    if (tid_ < 64) {                                                                          \
      const int row = rstart_ + rsign * tid_;                                                 \
      pgc = GC[(size_t)row * 8 + d * 4 + h];                                                  \
      pbe = BE[(size_t)row * 8 + d * 4 + h];                                                  \
    }                                                                                         \
  }
  SCAN_LOADS(0)
  for (int n = 0; n < 36; ++n) {
    const int tid = otid(), lane = tid & 63, w = tid >> 6, li = lane & 31, hh = lane >> 5;
    int chunk, row0;
    SCAN_ROW0(n, chunk, row0)
    (void)chunk;
    const int rstart = d ? (row0 + 63) : row0;
    __syncthreads();
#define STAGE_UNIT(U, QA, QB, KA, KB, VA, VB)                                                   \
  {                                                                                             \
    const int c8 = (U)&15, tp = (U) >> 4;                                                       \
    *(uint4*)(sQ + (2 * tp) * 136 + c8 * 8) = QA;                                               \
    *(uint4*)(sQ + (2 * tp + 1) * 136 + c8 * 8) = QB;                                           \
    *(uint4*)(sK + (2 * tp) * 136 + c8 * 8) = KA;                                               \
    *(uint4*)(sK + (2 * tp + 1) * 136 + c8 * 8) = KB;                                           \
    *(uint4*)(sV + (2 * tp) * 136 + c8 * 8) = VA;                                               \
    *(uint4*)(sV + (2 * tp + 1) * 136 + c8 * 8) = VB;                                           \
    unsigned* kt = (unsigned*)(sKT + (c8 * 8) * 68 + 2 * tp);                                   \
    kt[0 * 34] = (KA.x & 0xffffu) | (KB.x << 16);                                               \
    kt[1 * 34] = (KA.x >> 16) | (KB.x & 0xffff0000u);                                           \
    kt[2 * 34] = (KA.y & 0xffffu) | (KB.y << 16);                                               \
    kt[3 * 34] = (KA.y >> 16) | (KB.y & 0xffff0000u);                                           \
    kt[4 * 34] = (KA.z & 0xffffu) | (KB.z << 16);                                               \
    kt[5 * 34] = (KA.z >> 16) | (KB.z & 0xffff0000u);                                           \
    kt[6 * 34] = (KA.w & 0xffffu) | (KB.w << 16);                                               \
    kt[7 * 34] = (KA.w >> 16) | (KB.w & 0xffff0000u);                                           \
  }
    STAGE_UNIT(tid, qA0, qB0, kA0, kB0, vA0, vB0)
    STAGE_UNIT(tid + 256, qA1, qB1, kA1, kB1, vA1, vB1)
#undef STAGE_UNIT
    if (tid < 64) {
      float g63 = __shfl(pgc, 63);
      sg[lane] = pgc;
      sbt[lane] = pbe;
      seg[lane] = __expf(pgc);
      sdt[lane] = __expf(g63 - pgc);
    }
    __syncthreads();
    f32x16 v0, v1;
#pragma unroll
    for (int r = 0; r < 16; ++r) {
      const int t0 = rowmap(r, hh);
      v0[r] = bf2f(sV[t0 * 136 + w * 32 + li]);
      v1[r] = bf2f(sV[(32 + t0) * 136 + w * 32 + li]);
    }
    __syncthreads();
    {
      const int i0 = tid >> 3, c8 = tid & 7;
      *(uint2*)(sT + i0 * 68 + c8 * 8) = make_uint2(tq0.x, tq0.y);
      *(uint2*)(sT + i0 * 68 + c8 * 8 + 4) = make_uint2(tq0.z, tq0.w);
      *(uint2*)(sT + (i0 + 32) * 68 + c8 * 8) = make_uint2(tq1.x, tq1.y);
      *(uint2*)(sT + (i0 + 32) * 68 + c8 * 8 + 4) = make_uint2(tq1.z, tq1.w);
    }
    {
      const int mi = w >> 1, ni = w & 1;
      f32x16 a;
#pragma unroll
      for (int r = 0; r < 16; ++r) a[r] = 0.f;
      if (!(mi == 0 && ni == 1)) {
#pragma unroll
        for (int ks = 0; ks < 8; ++ks) {
          bf16x8 qa = *(const bf16x8*)(sQ + (mi * 32 + li) * 136 + ks * 16 + hh * 8);
          bf16x8 kb = *(const bf16x8*)(sK + (ni * 32 + li) * 136 + ks * 16 + hh * 8);
          a = __builtin_amdgcn_mfma_f32_32x32x16_bf16(qa, kb, a, 0, 0, 0);
        }
      }
#pragma unroll
      for (int r = 0; r < 16; ++r) {
        const int i = mi * 32 + rowmap(r, hh), j = ni * 32 + li;
        float val = (i >= j) ? a[r] * qscale * __expf(sg[i] - sg[j]) : 0.f;
        sA[i * 68 + j] = f2bf(val);
      }
    }
    __syncthreads();
    f32x16 ks0, ks1;
#pragma unroll
    for (int r = 0; r < 16; ++r) { ks0[r] = 0.f; ks1[r] = 0.f; }
    {
      const bf16_t* ka = sK + li * 136 + 4 * hh;
#define K_STEP(OFFS, SX, SS)                                                                           \
  {                                                                                                    \
    bf16x8 sb = pack8(SX, SS);                                                                         \
    ks0 = __builtin_amdgcn_mfma_f32_32x32x16_bf16(ld_perm(ka + (OFFS)), sb, ks0, 0, 0, 0);             \
    ks1 = __builtin_amdgcn_mfma_f32_32x32x16_bf16(ld_perm(ka + 32 * 136 + (OFFS)), sb, ks1, 0, 0, 0);  \
  }
      K_STEP(0, S0, 0) K_STEP(16, S0, 1) K_STEP(32, S1, 0) K_STEP(48, S1, 1)
      K_STEP(64, S2, 0) K_STEP(80, S2, 1) K_STEP(96, S3, 0) K_STEP(112, S3, 1)
#undef K_STEP
    }
#pragma unroll
    for (int r = 0; r < 16; ++r) {
      const int t0 = rowmap(r, hh), t1 = 32 + t0;
      v0[r] = sbt[t0] * (v0[r] - seg[t0] * ks0[r]);
      v1[r] = sbt[t1] * (v1[r] - seg[t1] * ks1[r]);
    }
    __builtin_amdgcn_sched_barrier(0);
    bf16x8 rb00 = pack8(v0, 0), rb01 = pack8(v0, 1), rb10 = pack8(v1, 0), rb11 = pack8(v1, 1);
    f32x16 n0, n1;
#pragma unroll
    for (int r = 0; r < 16; ++r) { n0[r] = 0.f; n1[r] = 0.f; }
    {
      const bf16_t* ta = sT + li * 68 + 4 * hh;
      n0 = __builtin_amdgcn_mfma_f32_32x32x16_bf16(ld_perm(ta + 0), rb00, n0, 0, 0, 0);
      n0 = __builtin_amdgcn_mfma_f32_32x32x16_bf16(ld_perm(ta + 16), rb01, n0, 0, 0, 0);
      const bf16_t* tb = ta + 32 * 68;
      n1 = __builtin_amdgcn_mfma_f32_32x32x16_bf16(ld_perm(tb + 0), rb00, n1, 0, 0, 0);
      n1 = __builtin_amdgcn_mfma_f32_32x32x16_bf16(ld_perm(tb + 16), rb01, n1, 0, 0, 0);
      n1 = __builtin_amdgcn_mfma_f32_32x32x16_bf16(ld_perm(tb + 32), rb10, n1, 0, 0, 0);
      n1 = __builtin_amdgcn_mfma_f32_32x32x16_bf16(ld_perm(tb + 48), rb11, n1, 0, 0, 0);
    }
    __builtin_amdgcn_sched_barrier(0);
    f32x16 o0, o1;
#pragma unroll
    for (int r = 0; r < 16; ++r) { o0[r] = 0.f; o1[r] = 0.f; }
    {
      const bf16_t* qa = sQ + li * 136 + 4 * hh;
#define Q_STEP(OFFS, SX, SS)                                                                           \
  {                                                                                                    \
    bf16x8 sb = pack8(SX, SS);                                                                         \
    o0 = __builtin_amdgcn_mfma_f32_32x32x16_bf16(ld_perm(qa + (OFFS)), sb, o0, 0, 0, 0);               \
    o1 = __builtin_amdgcn_mfma_f32_32x32x16_bf16(ld_perm(qa + 32 * 136 + (OFFS)), sb, o1, 0, 0, 0);    \
  }
      Q_STEP(0, S0, 0) Q_STEP(16, S0, 1) Q_STEP(32, S1, 0) Q_STEP(48, S1, 1)
      Q_STEP(64, S2, 0) Q_STEP(80, S2, 1) Q_STEP(96, S3, 0) Q_STEP(112, S3, 1)
#undef Q_STEP
    }
#pragma unroll
    for (int r = 0; r < 16; ++r) {
      const int t0 = rowmap(r, hh), t1 = 32 + t0;
      o0[r] *= seg[t0] * qscale;
      o1[r] *= seg[t1] * qscale;
    }
    {
      bf16x8 nb00 = pack8(n0, 0), nb01 = pack8(n0, 1), nb10 = pack8(n1, 0), nb11 = pack8(n1, 1);
      const bf16_t* aa = sA + li * 68 + 4 * hh;
      o0 = __builtin_amdgcn_mfma_f32_32x32x16_bf16(ld_perm(aa + 0), nb00, o0, 0, 0, 0);
      o0 = __builtin_amdgcn_mfma_f32_32x32x16_bf16(ld_perm(aa + 16), nb01, o0, 0, 0, 0);
      const bf16_t* ab = aa + 32 * 68;
      o1 = __builtin_amdgcn_mfma_f32_32x32x16_bf16(ld_perm(ab + 0), nb00, o1, 0, 0, 0);
      o1 = __builtin_amdgcn_mfma_f32_32x32x16_bf16(ld_perm(ab + 16), nb01, o1, 0, 0, 0);
      o1 = __builtin_amdgcn_mfma_f32_32x32x16_bf16(ld_perm(ab + 32), nb10, o1, 0, 0, 0);
      o1 = __builtin_amdgcn_mfma_f32_32x32x16_bf16(ld_perm(ab + 48), nb11, o1, 0, 0, 0);
    }
    __syncthreads();
#pragma unroll
    for (int r = 0; r < 16; ++r) {
      const int t0 = rowmap(r, hh);
      sQ[t0 * 136 + w * 32 + li] = f2bf(o0[r]);
      sQ[(32 + t0) * 136 + w * 32 + li] = f2bf(o1[r]);
    }
#pragma unroll
    for (int r = 0; r < 16; ++r) {
      const int t0 = rowmap(r, hh), t1 = 32 + t0;
      n0[r] *= sdt[t0];
      n1[r] *= sdt[t1];
    }
    {
      bf16x8 nb00 = pack8(n0, 0), nb01 = pack8(n0, 1), nb10 = pack8(n1, 0), nb11 = pack8(n1, 1);
      const float eg63 = seg[63];
#pragma unroll
      for (int r = 0; r < 16; ++r) { S0[r] *= eg63; S1[r] *= eg63; S2[r] *= eg63; S3[r] *= eg63; }
      __builtin_amdgcn_sched_barrier(0);
      SCAN_LOADS(min(n + 1, 35))
      __builtin_amdgcn_sched_barrier(0);
      const bf16_t* kt = sKT + li * 68 + 4 * hh;
#define S_UPD(SX, DKT)                                                                                   \
  SX = __builtin_amdgcn_mfma_f32_32x32x16_bf16(ld_perm(kt + (DKT) * 32 * 68 + 0), nb00, SX, 0, 0, 0);    \
  SX = __builtin_amdgcn_mfma_f32_32x32x16_bf16(ld_perm(kt + (DKT) * 32 * 68 + 16), nb01, SX, 0, 0, 0);   \
  SX = __builtin_amdgcn_mfma_f32_32x32x16_bf16(ld_perm(kt + (DKT) * 32 * 68 + 32), nb10, SX, 0, 0, 0);   \
  SX = __builtin_amdgcn_mfma_f32_32x32x16_bf16(ld_perm(kt + (DKT) * 32 * 68 + 48), nb11, SX, 0, 0, 0);
      S_UPD(S0, 0) S_UPD(S1, 1) S_UPD(S2, 2) S_UPD(S3, 3)
#undef S_UPD
    }
    __syncthreads();
    {
      bf16_t* obase = d ? (Pw + C_DN + h * 128) : (MIX + 512 + h * 128);
      const int ostride = d ? INWP : 1024;
#pragma unroll
      for (int e = 0; e < 4; ++e) {
        const int idx = tid + 256 * e, tok = idx >> 4, c8 = idx & 15;
        const int row = rstart + rsign * tok;
        *(uint4*)(obase + (size_t)row * ostride + c8 * 8) = *(const uint4*)(sQ + tok * 136 + c8 * 8);
      }
    }
  }
#undef SCAN_LOADS
#undef SCAN_ROW0
  __builtin_amdgcn_s_setprio(0);
}

__device__ void phaseC(const Params& p, int l, char* smem) {
  const int nb = gridDim.x, bid = blockIdx.x;
  const bf16_t* P = (const bf16_t*)(p.ws + OFF_P);
  constexpr int T0 = 144 * 3, T1 = T0 + 144 * 4, T2 = T1 + M_ALL / 8, T3 = T2 + 1152;
  for (int it = bid; it < T3; it += nb) {
    if (it < T0) {
      int i = it;
      if (l == 3 && i >= 128 * 3) continue;
      gemm_tile<EPI_QUP>(p, l, P + C_MQ, INWP, (const bf16_t*)(p.ws + OFF_WQUP), 256, (i / 3) * 128, (i % 3) * 128, 0,
                         smem);
    } else if (it < T1) {
      int i = it - T0;
      gemm_tile<EPI_KVUP>(p, l, P + C_MKV, INWP, (const bf16_t*)(p.ws + OFF_WKVUP), 128, (i / 4) * 128, (i % 4) * 128,
                          0, smem);
    } else if (it < T2) {
      kpe_item(p, it - T1);
    } else {
      dn_chunk_prep(p, l, it - T2, smem);
    }
  }
}

__device__ void mla_flash(const Params& p, int item, char* smem) {
  bf16_t* sK = (bf16_t*)smem;
  bf16_t* sV = sK + 64 * 104;
  const int tid = otid(), lane = tid & 63, w = tid >> 6;
  const int li = lane & 31, hh = lane >> 5;
  int b, h, q0row, nkeys;
  if (item < 512) {
    b = item >> 6; h = (item >> 4) & 3; q0row = b * 2048 + (item & 15) * 128; nkeys = 2304;
  } else {
    int i = item - 512;
    b = i >> 3; h = (i >> 1) & 3; q0row = M_LAT + b * 256 + (i & 1) * 128; nkeys = 256;
  }
  const bf16_t* Kg = (const bf16_t*)(p.ws + OFF_KH) + (size_t)(b * 4 + h) * 2304 * 96;
  const bf16_t* Vg = (const bf16_t*)(p.ws + OFF_VH) + (size_t)(b * 4 + h) * 64 * 2304;
  const bf16_t* QH = (const bf16_t*)(p.ws + OFF_QH);
  bf16_t* MIX = (bf16_t*)(p.ws + OFF_HM);
  const int qrow = q0row + w * 32 + li;
  bf16x8 qf0, qf1, qf2, qf3, qf4, qf5;
  {
    const bf16_t* qp = QH + (size_t)qrow * 384 + h * 96 + hh * 8;
    qf0 = *(const bf16x8*)(qp); qf1 = *(const bf16x8*)(qp + 16); qf2 = *(const bf16x8*)(qp + 32);
    qf3 = *(const bf16x8*)(qp + 48); qf4 = *(const bf16x8*)(qp + 64); qf5 = *(const bf16x8*)(qp + 80);
  }
  const int k_i0 = tid, k_i1 = tid + 256, k_i2 = tid + 512;
  const int kk0 = k_i0 / 12, kc0 = k_i0 % 12, kk1 = k_i1 / 12, kc1 = k_i1 % 12, kk2 = k_i2 / 12, kc2 = k_i2 % 12;
  const int vd0 = tid >> 3, vc0 = tid & 7, vd1 = vd0 + 32;
  uint4 rk0, rk1, rk2, rv0, rv1;
  rk0 = *(const uint4*)(Kg + (size_t)kk0 * 96 + kc0 * 8);
  rk1 = *(const uint4*)(Kg + (size_t)kk1 * 96 + kc1 * 8);
  rk2 = *(const uint4*)(Kg + (size_t)kk2 * 96 + kc2 * 8);
  rv0 = *(const uint4*)(Vg + (size_t)vd0 * 2304 + vc0 * 8);
  rv1 = *(const uint4*)(Vg + (size_t)vd1 * 2304 + vc0 * 8);
  f32x16 o0, o1;
#pragma unroll
  for (int r = 0; r < 16; ++r) { o0[r] = 0.f; o1[r] = 0.f; }
  float m = -1e30f, lp = 0.f;
  const float sc = 0.10206207261596577f * 1.4426950408889634f;
  const int nt = nkeys >> 6;
  for (int t = 0; t < nt; ++t) {
    __syncthreads();
    *(uint4*)(sK + kk0 * 104 + kc0 * 8) = rk0;
    *(uint4*)(sK + kk1 * 104 + kc1 * 8) = rk1;
    *(uint4*)(sK + kk2 * 104 + kc2 * 8) = rk2;
    *(uint2*)(sV + vd0 * 68 + vc0 * 8) = make_uint2(rv0.x, rv0.y);
    *(uint2*)(sV + vd0 * 68 + vc0 * 8 + 4) = make_uint2(rv0.z, rv0.w);
    *(uint2*)(sV + vd1 * 68 + vc0 * 8) = make_uint2(rv1.x, rv1.y);
    *(uint2*)(sV + vd1 * 68 + vc0 * 8 + 4) = make_uint2(rv1.z, rv1.w);
    __syncthreads();
    if (t + 1 < nt) {
      const int k0 = (t + 1) * 64;
      rk0 = *(const uint4*)(Kg + (size_t)(k0 + kk0) * 96 + kc0 * 8);
      rk1 = *(const uint4*)(Kg + (size_t)(k0 + kk1) * 96 + kc1 * 8);
      rk2 = *(const uint4*)(Kg + (size_t)(k0 + kk2) * 96 + kc2 * 8);
      rv0 = *(const uint4*)(Vg + (size_t)vd0 * 2304 + k0 + vc0 * 8);
      rv1 = *(const uint4*)(Vg + (size_t)vd1 * 2304 + k0 + vc0 * 8);
    }
    f32x16 s0, s1;
#pragma unroll
    for (int r = 0; r < 16; ++r) { s0[r] = 0.f; s1[r] = 0.f; }
    {
      const bf16_t* ka = sK + li * 104 + hh * 8;
      const bf16_t* kb = ka + 32 * 104;
      s0 = __builtin_amdgcn_mfma_f32_32x32x16_bf16(*(const bf16x8*)(ka), qf0, s0, 0, 0, 0);
      s1 = __builtin_amdgcn_mfma_f32_32x32x16_bf16(*(const bf16x8*)(kb), qf0, s1, 0, 0, 0);
      s0 = __builtin_amdgcn_mfma_f32_32x32x16_bf16(*(const bf16x8*)(ka + 16), qf1, s0, 0, 0, 0);
      s1 = __builtin_amdgcn_mfma_f32_32x32x16_bf16(*(const bf16x8*)(kb + 16), qf1, s1, 0, 0, 0);
      s0 = __builtin_amdgcn_mfma_f32_32x32x16_bf16(*(const bf16x8*)(ka + 32), qf2, s0, 0, 0, 0);
      s1 = __builtin_amdgcn_mfma_f32_32x32x16_bf16(*(const bf16x8*)(kb + 32), qf2, s1, 0, 0, 0);
      s0 = __builtin_amdgcn_mfma_f32_32x32x16_bf16(*(const bf16x8*)(ka + 48), qf3, s0, 0, 0, 0);
      s1 = __builtin_amdgcn_mfma_f32_32x32x16_bf16(*(const bf16x8*)(kb + 48), qf3, s1, 0, 0, 0);
      s0 = __builtin_amdgcn_mfma_f32_32x32x16_bf16(*(const bf16x8*)(ka + 64), qf4, s0, 0, 0, 0);
      s1 = __builtin_amdgcn_mfma_f32_32x32x16_bf16(*(const bf16x8*)(kb + 64), qf4, s1, 0, 0, 0);
      s0 = __builtin_amdgcn_mfma_f32_32x32x16_bf16(*(const bf16x8*)(ka + 80), qf5, s0, 0, 0, 0);
      s1 = __builtin_amdgcn_mfma_f32_32x32x16_bf16(*(const bf16x8*)(kb + 80), qf5, s1, 0, 0, 0);
    }
    float mx = s0[0];
#pragma unroll
    for (int r = 1; r < 16; ++r) mx = fmaxf(mx, s0[r]);
#pragma unroll
    for (int r = 0; r < 16; ++r) mx = fmaxf(mx, s1[r]);
    mx = fmaxf(mx, __shfl_xor(mx, 32));
    const float mn = fmaxf(m, mx * sc);
    const float corr = __builtin_amdgcn_exp2f(m - mn);
    m = mn;
    lp *= corr;
#pragma unroll
    for (int r = 0; r < 16; ++r) { o0[r] *= corr; o1[r] *= corr; }
#pragma unroll
    for (int r = 0; r < 16; ++r) {
      s0[r] = __builtin_amdgcn_exp2f(s0[r] * sc - mn);
      s1[r] = __builtin_amdgcn_exp2f(s1[r] * sc - mn);
      lp += s0[r] + s1[r];
    }
#pragma unroll
    for (int u = 0; u < 2; ++u) {
#pragma unroll
      for (int s = 0; s < 2; ++s) {
        union { bf16x8 v; unsigned w[4]; } pb;
        if (u == 0) {
          pb.w[0] = pack2(s0[8 * s + 0], s0[8 * s + 1]); pb.w[1] = pack2(s0[8 * s + 2], s0[8 * s + 3]);
          pb.w[2] = pack2(s0[8 * s + 4], s0[8 * s + 5]); pb.w[3] = pack2(s0[8 * s + 6], s0[8 * s + 7]);
        } else {
          pb.w[0] = pack2(s1[8 * s + 0], s1[8 * s + 1]); pb.w[1] = pack2(s1[8 * s + 2], s1[8 * s + 3]);
          pb.w[2] = pack2(s1[8 * s + 4], s1[8 * s + 5]); pb.w[3] = pack2(s1[8 * s + 6], s1[8 * s + 7]);
        }
        const bf16_t* va = sV + li * 68 + 32 * u + 16 * s + 4 * hh;
        union { bf16x8 v; uint2 d[2]; } a0, a1;
        a0.d[0] = *(const uint2*)(va);
        a0.d[1] = *(const uint2*)(va + 8);
        a1.d[0] = *(const uint2*)(va + 32 * 68);
        a1.d[1] = *(const uint2*)(va + 32 * 68 + 8);
        o0 = __builtin_amdgcn_mfma_f32_32x32x16_bf16(a0.v, pb.v, o0, 0, 0, 0);
        o1 = __builtin_amdgcn_mfma_f32_32x32x16_bf16(a1.v, pb.v, o1, 0, 0, 0);
      }
    }
  }
  lp += __shfl_xor(lp, 32);
  const float inv = 1.f / lp;
  bf16_t* op = MIX + (size_t)qrow * 1024 + h * 64 + 4 * hh;
#pragma unroll
  for (int g = 0; g < 4; ++g) {
    uint2 u0, u1;
    u0.x = pack2(o0[4 * g + 0] * inv, o0[4 * g + 1] * inv);
    u0.y = pack2(o0[4 * g + 2] * inv, o0[4 * g + 3] * inv);
    u1.x = pack2(o1[4 * g + 0] * inv, o1[4 * g + 1] * inv);
    u1.y = pack2(o1[4 * g + 2] * inv, o1[4 * g + 3] * inv);
    *(uint2*)(op + 8 * g) = u0;
    *(uint2*)(op + 32 + 8 * g) = u1;
  }
}

__device__ void na_naive(const Params& p, int l, int ti) {
  const int h = otid() >> 6, lane = otid() & 63;
  const bf16_t* P = (const bf16_t*)(p.ws + OFF_P);
  bf16_t* MIX = (bf16_t*)(p.ws + OFF_HM);
  const bool lat = ti < 256;
  const int b = lat ? (ti >> 5) : ((ti - 256) >> 2);
  const int r = ti & 31;
  const int row = lat ? (ti * 64 + lane) : (M_LAT + (ti - 256) * 64 + lane);
  uint4 qk[8];
  float acc[64];
  {
    const uint4* qp = (const uint4*)(P + (size_t)row * INWP + C_NQ + h * 64);
#pragma unroll
    for (int c = 0; c < 8; ++c) qk[c] = qp[c];
  }
#pragma unroll
  for (int i = 0; i < 64; ++i) acc[i] = 0.f;
  float m = -INFINITY, ls = 0.f;
  const int qc = lane;
  const int rs0 = min(max(r - 4, 0), 24);
  const int cs0 = min(max(qc - 8, 0), 48);
  const float* rb = p.rel_bias + (size_t)l * 4 * 15 * 31 + h * 15 * 31;
  const int nloc = lat ? 128 : 0;
  for (int j = 0; j < nloc + 256; ++j) {
    int krow;
    float bias = 0.f;
    if (j < nloc) {
      int kr = rs0 + (j >> 4), kc = cs0 + (j & 15);
      krow = b * 2048 + kr * 64 + kc;
      bias = rb[(kr - r + 7) * 31 + (kc - qc + 15)];
    } else {
      krow = M_LAT + b * 256 + (j - nloc);
    }
    const uint4* kp = (const uint4*)(P + (size_t)krow * INWP + C_NK + h * 64);
    float s = 0.f;
#pragma unroll
    for (int c = 0; c < 8; ++c) {
      uint4 u = kp[c];
      uint4 q = qk[c];
      s += bflo(q.x) * bflo(u.x) + bfhi(q.x) * bfhi(u.x) + bflo(q.y) * bflo(u.y) + bfhi(q.y) * bfhi(u.y) +
           bflo(q.z) * bflo(u.z) + bfhi(q.z) * bfhi(u.z) + bflo(q.w) * bflo(u.w) + bfhi(q.w) * bfhi(u.w);
    }
    s = s * 0.125f + bias;
    float mn = fmaxf(m, s);
    float corr = __expf(m - mn), pe = __expf(s - mn);
    ls = ls * corr + pe;
    m = mn;
    const uint4* vp = (const uint4*)(P + (size_t)krow * INWP + C_NV + h * 64);
#pragma unroll
    for (int c = 0; c < 8; ++c) {
      uint4 u = vp[c];
      acc[c * 8 + 0] = acc[c * 8 + 0] * corr + pe * bflo(u.x);
      acc[c * 8 + 1] = acc[c * 8 + 1] * corr + pe * bfhi(u.x);
      acc[c * 8 + 2] = acc[c * 8 + 2] * corr + pe * bflo(u.y);
      acc[c * 8 + 3] = acc[c * 8 + 3] * corr + pe * bfhi(u.y);
      acc[c * 8 + 4] = acc[c * 8 + 4] * corr + pe * bflo(u.z);
      acc[c * 8 + 5] = acc[c * 8 + 5] * corr + pe * bfhi(u.z);
      acc[c * 8 + 6] = acc[c * 8 + 6] * corr + pe * bflo(u.w);
      acc[c * 8 + 7] = acc[c * 8 + 7] * corr + pe * bfhi(u.w);
    }
  }
  const float inv = 1.f / ls;
  uint4* op = (uint4*)(MIX + (size_t)row * 1024 + 256 + h * 64);
#pragma unroll
  for (int c = 0; c < 8; ++c) {
    uint4 u;
    u.x = pack2(acc[c * 8 + 0] * inv, acc[c * 8 + 1] * inv);
    u.y = pack2(acc[c * 8 + 2] * inv, acc[c * 8 + 3] * inv);
    u.z = pack2(acc[c * 8 + 4] * inv, acc[c * 8 + 5] * inv);
    u.w = pack2(acc[c * 8 + 6] * inv, acc[c * 8 + 7] * inv);
    op[c] = u;
  }
}

__device__ void na_flash(const Params& p, int l, int item, char* smem) {
  bf16_t* sK = (bf16_t*)smem;
  bf16_t* sV = sK + 64 * 72;
  float* sBias = (float*)(smem + 18432);
  const int tid = otid(), lane = tid & 63, w = tid >> 6;
  const int li = lane & 31, hh = lane >> 5;
  const bf16_t* P = (const bf16_t*)(p.ws + OFF_P);
  bf16_t* MIX = (bf16_t*)(p.ws + OFF_HM);
  int b, h, qrow, qr = 0, qc = 0, rs0 = 0, ntiles, krow0 = 0;
  bool lat;
  if (item < 512) {
    lat = true;
    b = item >> 6; h = item & 3;
    const int r0 = ((item >> 2) & 15) * 2;
    qr = r0 + (w >> 1); qc = (w & 1) * 32 + li;
    qrow = b * 2048 + qr * 64 + qc;
    krow0 = min(max(r0 - 4, 0), 24);
    const int klast = min(max(r0 + 1 - 4, 0), 24) + 7;
    ntiles = 4 + (klast - krow0 + 1);
    rs0 = min(max(qr - 4, 0), 24);
  } else {
    lat = false;
    const int i = item - 512;
    b = i >> 3; h = i & 3;
    qrow = M_LAT + b * 256 + ((i >> 2) & 1) * 128 + w * 32 + li;
    ntiles = 4;
  }
  const int cs0 = min(max(qc - 8, 0), 48);
  const bf16_t* Vg = (const bf16_t*)(p.ws + OFF_NVT) + (size_t)(b * 4 + h) * 64 * 2304;
  bf16x8 qf0, qf1, qf2, qf3;
  {
    const bf16_t* qp = P + (size_t)qrow * INWP + C_NQ + h * 64 + hh * 8;
    qf0 = *(const bf16x8*)(qp); qf1 = *(const bf16x8*)(qp + 16); qf2 = *(const bf16x8*)(qp + 32); qf3 = *(const bf16x8*)(qp + 48);
  }
  __syncthreads();
  for (int i = tid; i < 465; i += 256)
    sBias[i] = p.rel_bias[(size_t)l * 4 * 465 + h * 465 + i] * 1.4426950408889634f;
  const int kk0 = tid >> 3, kc8 = tid & 7, kk1 = kk0 + 32;
  uint4 rk0, rk1, rv0, rv1;
  {
    const size_t kr = (size_t)(M_LAT + b * 256);
    rk0 = *(const uint4*)(P + (kr + kk0) * INWP + C_NK + h * 64 + kc8 * 8);
    rk1 = *(const uint4*)(P + (kr + kk1) * INWP + C_NK + h * 64 + kc8 * 8);
    rv0 = *(const uint4*)(Vg + (size_t)kk0 * 2304 + kc8 * 8);
    rv1 = *(const uint4*)(Vg + (size_t)kk1 * 2304 + kc8 * 8);
  }
  f32x16 o0, o1;
#pragma unroll
  for (int r = 0; r < 16; ++r) { o0[r] = 0.f; o1[r] = 0.f; }
  float m = -1e30f, lp = 0.f;
  const float sc = 0.125f * 1.4426950408889634f;
  for (int t = 0; t < ntiles; ++t) {
    __syncthreads();
    *(uint4*)(sK + kk0 * 72 + kc8 * 8) = rk0;
    *(uint4*)(sK + kk1 * 72 + kc8 * 8) = rk1;
    *(uint2*)(sV + kk0 * 68 + kc8 * 8) = make_uint2(rv0.x, rv0.y);
    *(uint2*)(sV + kk0 * 68 + kc8 * 8 + 4) = make_uint2(rv0.z, rv0.w);
    *(uint2*)(sV + kk1 * 68 + kc8 * 8) = make_uint2(rv1.x, rv1.y);
    *(uint2*)(sV + kk1 * 68 + kc8 * 8 + 4) = make_uint2(rv1.z, rv1.w);
    __syncthreads();
    if (t + 1 < ntiles) {
      const int tn = t + 1;
      size_t kr;
      int vk;
      if (tn < 4) { kr = (size_t)(M_LAT + b * 256 + tn * 64); vk = tn * 64; }
      else { kr = (size_t)(b * 2048 + (krow0 + tn - 4) * 64); vk = 256 + (krow0 + tn - 4) * 64; }
      rk0 = *(const uint4*)(P + (kr + kk0) * INWP + C_NK + h * 64 + kc8 * 8);
      rk1 = *(const uint4*)(P + (kr + kk1) * INWP + C_NK + h * 64 + kc8 * 8);
      rv0 = *(const uint4*)(Vg + (size_t)kk0 * 2304 + vk + kc8 * 8);
      rv1 = *(const uint4*)(Vg + (size_t)kk1 * 2304 + vk + kc8 * 8);
    }
    const int kr_abs = krow0 + t - 4;
    const bool local = t >= 4;
    if (local && (kr_abs < rs0 || kr_abs >= rs0 + 8)) continue;
    f32x16 s0, s1;
#pragma unroll
    for (int r = 0; r < 16; ++r) { s0[r] = 0.f; s1[r] = 0.f; }
    {
      const bf16_t* ka = sK + li * 72 + hh * 8;
      const bf16_t* kb = ka + 32 * 72;
      s0 = __builtin_amdgcn_mfma_f32_32x32x16_bf16(*(const bf16x8*)(ka), qf0, s0, 0, 0, 0);
      s1 = __builtin_amdgcn_mfma_f32_32x32x16_bf16(*(const bf16x8*)(kb), qf0, s1, 0, 0, 0);
      s0 = __builtin_amdgcn_mfma_f32_32x32x16_bf16(*(const bf16x8*)(ka + 16), qf1, s0, 0, 0, 0);
      s1 = __builtin_amdgcn_mfma_f32_32x32x16_bf16(*(const bf16x8*)(kb + 16), qf1, s1, 0, 0, 0);
      s0 = __builtin_amdgcn_mfma_f32_32x32x16_bf16(*(const bf16x8*)(ka + 32), qf2, s0, 0, 0, 0);
      s1 = __builtin_amdgcn_mfma_f32_32x32x16_bf16(*(const bf16x8*)(kb + 32), qf2, s1, 0, 0, 0);
      s0 = __builtin_amdgcn_mfma_f32_32x32x16_bf16(*(const bf16x8*)(ka + 48), qf3, s0, 0, 0, 0);
      s1 = __builtin_amdgcn_mfma_f32_32x32x16_bf16(*(const bf16x8*)(kb + 48), qf3, s1, 0, 0, 0);
    }
    if (local) {
      const float* bp = sBias + (kr_abs - qr + 7) * 31 - qc + 15;
#pragma unroll
      for (int r = 0; r < 16; ++r) {
        const int kc0 = rowmap(r, hh), kc1 = 32 + kc0;
        const bool v0 = (kc0 >= cs0) && (kc0 < cs0 + 16);
        const bool v1 = (kc1 >= cs0) && (kc1 < cs0 + 16);
        const float b0 = v0 ? bp[kc0] : 0.f;
        const float b1 = v1 ? bp[kc1] : 0.f;
        s0[r] = v0 ? (s0[r] * sc + b0) : -1e30f;
        s1[r] = v1 ? (s1[r] * sc + b1) : -1e30f;
      }
    } else {
#pragma unroll
      for (int r = 0; r < 16; ++r) { s0[r] *= sc; s1[r] *= sc; }
    }
    float mx = s0[0];
#pragma unroll
    for (int r = 1; r < 16; ++r) mx = fmaxf(mx, s0[r]);
#pragma unroll
    for (int r = 0; r < 16; ++r) mx = fmaxf(mx, s1[r]);
    mx = fmaxf(mx, __shfl_xor(mx, 32));
    const float mn = fmaxf(m, mx);
    const float corr = __builtin_amdgcn_exp2f(m - mn);
    m = mn;
    lp *= corr;
#pragma unroll
    for (int r = 0; r < 16; ++r) { o0[r] *= corr; o1[r] *= corr; }
#pragma unroll
    for (int r = 0; r < 16; ++r) {
      s0[r] = __builtin_amdgcn_exp2f(s0[r] - mn);
      s1[r] = __builtin_amdgcn_exp2f(s1[r] - mn);
      lp += s0[r] + s1[r];
    }
#pragma unroll
    for (int u = 0; u < 2; ++u) {
#pragma unroll
      for (int s = 0; s < 2; ++s) {
        bf16x8 pb = u == 0 ? pack8(s0, s) : pack8(s1, s);
        const bf16_t* va = sV + li * 68 + 32 * u + 16 * s + 4 * hh;
        o0 = __builtin_amdgcn_mfma_f32_32x32x16_bf16(ld_perm(va), pb, o0, 0, 0, 0);
        o1 = __builtin_amdgcn_mfma_f32_32x32x16_bf16(ld_perm(va + 32 * 68), pb, o1, 0, 0, 0);
      }
    }
  }
  lp += __shfl_xor(lp, 32);
  const float inv = 1.f / lp;
  bf16_t* op = MIX + (size_t)qrow * 1024 + 256 + h * 64 + 4 * hh;
#pragma unroll
  for (int g = 0; g < 4; ++g) {
    uint2 u0, u1;
    u0.x = pack2(o0[4 * g + 0] * inv, o0[4 * g + 1] * inv);
    u0.y = pack2(o0[4 * g + 2] * inv, o0[4 * g + 3] * inv);
    u1.x = pack2(o1[4 * g + 0] * inv, o1[4 * g + 1] * inv);
    u1.y = pack2(o1[4 * g + 2] * inv, o1[4 * g + 3] * inv);
    *(uint2*)(op + 8 * g) = u0;
    *(uint2*)(op + 32 + 8 * g) = u1;
  }
}

DEVI int dn_rowof(int s, int b, int d) {
  if (s < 256) {
    int c = d ? (255 - s) : s;
    return M_LAT + b * 256 + c;
  }
  int t = s - 256;
  t = d ? (2047 - t) : t;
  return b * 2048 + t;
}

__device__ void dn_naive(const Params& p, int l, int it, char* smem) {
  float* ks = (float*)smem;
  float* qs = ks + 32 * 128;
  float* vs = qs + 32 * 128;
  float* gs = vs + 32 * 64;
  float* bs = gs + 32;
  const int half = it & 1, d = (it >> 1) & 1, h = (it >> 2) & 3, b = it >> 4;
  const int tid = otid(), w = tid >> 6, lane = tid & 63, c = lane & 15, kg = lane >> 4;
  const int col = half * 64 + w * 16 + c;
  const bf16_t* DQ = (const bf16_t*)(p.ws + OFF_DNQKV);
  const float* AB = (const float*)(p.ws + OFF_AB);
  bf16_t* MIX = (bf16_t*)(p.ws + OFF_HM);
  bf16_t* OB = (bf16_t*)(p.ws + OFF_OB);
  float S[32];
#pragma unroll
  for (int i = 0; i < 32; ++i) S[i] = 0.f;
  const float Aneg = -__expf(p.a_log[l * 8 + d * 4 + h]);
  const float dtb = p.dt_bias[l * 8 + d * 4 + h];
  for (int s0 = 0; s0 < 2304; s0 += 32) {
    __syncthreads();
    for (int i = tid; i < 32 * 128; i += 256) {
      int tk = i >> 7, ch = i & 127;
      int row = dn_rowof(s0 + tk, b, d);
      qs[i] = bf2f(DQ[(size_t)row * 1536 + h * 128 + ch]);
      ks[i] = bf2f(DQ[(size_t)row * 1536 + 512 + h * 128 + ch]);
    }
    for (int i = tid; i < 32 * 64; i += 256) {
      int tk = i >> 6, ch = i & 63;
      int row = dn_rowof(s0 + tk, b, d);
      vs[i] = bf2f(DQ[(size_t)row * 1536 + 1024 + h * 128 + half * 64 + ch]);
    }
    if (tid < 32) {
      int row = dn_rowof(s0 + tid, b, d);
      float a = AB[(size_t)row * 16 + d * 4 + h];
      float bb = AB[(size_t)row * 16 + 8 + d * 4 + h];
      float xx = a + dtb;
      const float ee = __expf(xx);
    float sp = ee < 0.25f ? ee * (1.f - ee * (0.5f - ee * (0.33333333f - ee * (0.25f - 0.2f * ee))))
                          : (xx > 20.f ? xx : __logf(1.f + ee));
      gs[tid] = __expf(Aneg * sp);
      bs[tid] = 1.f / (1.f + __expf(-bb));
    }
    __syncthreads();
    for (int tk = 0; tk < 32; ++tk) {
      const float eg = gs[tk], beta = bs[tk];
      const float vv = vs[tk * 64 + w * 16 + c];
      const float4* k4 = (const float4*)(ks + tk * 128 + kg * 32);
      const float4* q4 = (const float4*)(qs + tk * 128 + kg * 32);
      float part = 0.f;
#pragma unroll
      for (int i = 0; i < 8; ++i) {
        float4 kk = k4[i];
        S[4 * i + 0] *= eg; S[4 * i + 1] *= eg; S[4 * i + 2] *= eg; S[4 * i + 3] *= eg;
        part += kk.x * S[4 * i + 0] + kk.y * S[4 * i + 1] + kk.z * S[4 * i + 2] + kk.w * S[4 * i + 3];
      }
      part += __shfl_xor(part, 16);
      part += __shfl_xor(part, 32);
      const float delta = beta * (vv - part);
      float po = 0.f;
#pragma unroll
      for (int i = 0; i < 8; ++i) {
        float4 kk = k4[i];
        float4 qq = q4[i];
        S[4 * i + 0] += kk.x * delta; S[4 * i + 1] += kk.y * delta; S[4 * i + 2] += kk.z * delta; S[4 * i + 3] += kk.w * delta;
        po += qq.x * S[4 * i + 0] + qq.y * S[4 * i + 1] + qq.z * S[4 * i + 2] + qq.w * S[4 * i + 3];
      }
      po += __shfl_xor(po, 16);
      po += __shfl_xor(po, 32);
      if (kg == 0) {
        int row = dn_rowof(s0 + tk, b, d);
        float o = po * 0.08838834764831845f;
        if (d == 0)
          MIX[(size_t)row * 1024 + 512 + h * 128 + col] = f2bf(o);
        else
          OB[(size_t)row * 512 + h * 128 + col] = f2bf(o);
      }
    }
  }
}

__device__ void phaseD(const Params& p, int l, char* smem) {
  const int nb = gridDim.x, bid = blockIdx.x;
  if (bid < 64) {
    dn_scan(p, l, bid, smem);
    return;
  }
  const int nb2 = nb - 64;
  const int n_early = l < 3 ? N_CONV_EARLY : 0;
  for (int it = bid - 64; it < 1152 + N_CONV_LATE + n_early; it += nb2) {
    if (it < 576) {
      int item = it;
      if (it < 512) item = ((it & 7) * 64) + (it >> 3);
      else if (l == 3) continue;
      mla_flash(p, item, smem);
    } else if (it < 1152) {
      if (l == 3 && it - 576 >= 512) continue;
      na_flash(p, l, it - 576, smem);
    } else if (it < 1152 + N_CONV_LATE) {
      conv_item_late(p, l, it - 1152, (float*)smem);
    } else {
      conv_item_early(p, l + 1, it - 1152 - N_CONV_LATE, (float*)smem);
    }
  }
}

__device__ void outgate_item(const Params& p, int l, int item) {
  const int w = otid() >> 6, lane = otid() & 63;
  const int row = item * 4 + w;
  const bf16_t* P = (const bf16_t*)(p.ws + OFF_P);
  bf16_t* MIX = (bf16_t*)(p.ws + OFF_HM);
  const int h = lane >> 4, cb = (lane & 15) * 8;
  uint4 uo = *(const uint4*)(MIX + (size_t)row * 1024 + 512 + h * 128 + cb);
  uint4 ub = *(const uint4*)(P + (size_t)row * INWP + C_DN + h * 128 + cb);
  uint4 uz = *(const uint4*)(P + (size_t)row * INWP + C_DZ + h * 128 + cb);
  float o[8], z[8];
  o[0] = bflo(uo.x) + bflo(ub.x); o[1] = bfhi(uo.x) + bfhi(ub.x); o[2] = bflo(uo.y) + bflo(ub.y); o[3] = bfhi(uo.y) + bfhi(ub.y);
  o[4] = bflo(uo.z) + bflo(ub.z); o[5] = bfhi(uo.z) + bfhi(ub.z); o[6] = bflo(uo.w) + bflo(ub.w); o[7] = bfhi(uo.w) + bfhi(ub.w);
  z[0] = bflo(uz.x); z[1] = bfhi(uz.x); z[2] = bflo(uz.y); z[3] = bfhi(uz.y);
  z[4] = bflo(uz.z); z[5] = bfhi(uz.z); z[6] = bflo(uz.w); z[7] = bfhi(uz.w);
  float ss = 0.f;
#pragma unroll
  for (int e = 0; e < 8; ++e) ss += o[e] * o[e];
  ss += __shfl_xor(ss, 1);
  ss += __shfl_xor(ss, 2);
  ss += __shfl_xor(ss, 4);
  ss += __shfl_xor(ss, 8);
  const float r = rsqrtf(ss * (1.f / 128.f) + 1e-6f);
  const float* go = p.g_out + l * 128 + cb;
  float y[8];
#pragma unroll
  for (int e = 0; e < 8; ++e) y[e] = o[e] * r * go[e] * silu_f(z[e]);
  uint4 u;
  u.x = pack2(y[0], y[1]); u.y = pack2(y[2], y[3]); u.z = pack2(y[4], y[5]); u.w = pack2(y[6], y[7]);
  *(uint4*)(MIX + (size_t)row * 1024 + 512 + h * 128 + cb) = u;
}

__device__ void final_item(const Params& p, int item) {
  const int w = otid() >> 6, lane = otid() & 63;
  const int row = item * 4 + w;
  const float4* xr = (const float4*)((const float*)(p.ws + OFF_X) + (size_t)row * 1024);
  float4 v[4];
  float ss = 0.f;
#pragma unroll
  for (int i = 0; i < 4; ++i) {
    v[i] = xr[lane + 64 * i];
    ss += v[i].x * v[i].x + v[i].y * v[i].y + v[i].z * v[i].z + v[i].w * v[i].w;
  }
  ss = wave_sum(ss);
  const float r = rsqrtf(ss * (1.f / 1024.f) + 1e-6f);
  const float4* g4 = (const float4*)p.g_final;
  float4* o4 = (float4*)(p.out + (size_t)row * 1024);
#pragma unroll
  for (int i = 0; i < 4; ++i) {
    float4 gg = g4[lane + 64 * i];
    float4 y;
    y.x = v[i].x * r * gg.x; y.y = v[i].y * r * gg.y; y.z = v[i].z * r * gg.z; y.w = v[i].w * r * gg.w;
    o4[lane + 64 * i] = y;
  }
}

constexpr int N_PHASES = 1 + 9 * 4 + 1;

__global__ void __launch_bounds__(256, 2) mega(Params p) {
  __shared__ __attribute__((aligned(16))) char smem[SMEM_BYTES];
  cg::grid_group grid = cg::this_grid();
  const int nb = gridDim.x, bid = blockIdx.x;
  __shared__ uint4 xb_words;
  if (threadIdx.x == 0) xb_words = make_uint4(0u, 0u, 0u, 0u);
  __syncthreads();
  XcdBarrier xb = xcd_barrier_post((unsigned*)(p.ws + OFF_BAR), (volatile LAS unsigned*)&xb_words);
#ifdef PROBE_S
  bool again = false;
#endif
  for (int ph = p.ph_lo; ph < p.ph_hi; ++ph) {
    if (ph == 0) {
      phase0(p, smem);
    } else if (ph == N_PHASES - 1) {
      for (int it = bid; it < M_LAT / 4; it += nb) final_item(p, it);
    } else {
      const int l = (ph - 1) / 9, s = (ph - 1) % 9;
      if (s == 0) {
        phaseA(p, l, smem);
      } else if (s == 1) {
        for (int it = bid; it < 144 * 26; it += nb) {
          int mt, nt;
          tile_map(it, 26, mt, nt);
          gemm_tile<EPI_P>(p, l, (const bf16_t*)(p.ws + OFF_HM), 1024, (const bf16_t*)(p.ws + OFF_WIN), 1024,
                           mt * 128, nt * 128, 0, smem);
        }
      } else if (s == 2) {
        phaseC(p, l, smem);
      } else if (s == 3) {
        phaseD(p, l, smem);
      } else if (s == 4) {
        for (int it = bid; it < (l == 3 ? M_LAT : M_ALL) / 4; it += nb) outgate_item(p, l, it);
      } else if (s == 5) {
        const int mpx = l == 3 ? 16 : 18;
        for (int it = bid; it < 8 * mpx * 8; it += nb) {
          int mt, nt;
          tile_map(it, 8, mt, nt, mpx);
          gemm_tile<EPI_RES>(p, l, (const bf16_t*)(p.ws + OFF_HM), 1024, (const bf16_t*)(p.ws + OFF_WOUT), 1024,
                             mt * 128, nt * 128, 2, smem);
        }
      } else if (s == 6) {
        for (int it = bid; it < (l == 3 ? M_LAT : M_ALL) / 4; it += nb)
          norm_rows(p, false, (bf16_t*)(p.ws + OFF_HM), p.g_ffn + l * 1024,
                    (const float*)(p.ws + OFF_MOD) + (size_t)l * 9 * 6144, 3, 4, it);
      } else if (s == 7) {
        const int mpx = l == 3 ? 16 : 18;
        for (int it = bid; it < 8 * mpx * 44; it += nb) {
          int mt, nt;
          tile_map(it, 44, mt, nt, mpx);
          gemm_tile<EPI_GU>(p, l, (const bf16_t*)(p.ws + OFF_HM), 1024, (const bf16_t*)(p.ws + OFF_WGU), 1024,
                            mt * 128, nt * 128, 0, smem);
        }
      } else {
        const int mpx = l == 3 ? 16 : 18;
        for (int it = bid; it < 8 * mpx * 8; it += nb) {
          int mt, nt;
          tile_map(it, 8, mt, nt, mpx);
          gemm_tile<EPI_RES>(p, l, (const bf16_t*)(p.ws + OFF_P), FFN, (const bf16_t*)(p.ws + OFF_WDN), FFN,
                             mt * 128, nt * 128, 5, smem);
        }
      }
    }
#ifdef PROBE_S
    {
      const bool hit = (PROBE_S == 9) ? (ph == 0) : (ph != 0 && ph != N_PHASES - 1 && ((ph - 1) % 9) == PROBE_S);
      if (hit && !again) {
        again = true;
        if (p.use_cg) grid.sync(); else xcd_barrier(xb);
        --ph;
        continue;
      }
      again = false;
    }
#endif
    if (ph + 1 < p.ph_hi) {
      if (p.use_cg) grid.sync();
      else xcd_barrier(xb);
    }
  }
}

extern "C" void kernel_launch(void* const* d_in, const int* in_sizes, int n_in, void* d_out, int out_size, void* d_ws,
                              size_t ws_size, hipStream_t stream) {
  static int grid_blocks = 0;
  if (!grid_blocks) {
    int dev = 0, cus = 0, per_cu = 0;
    hipGetDevice(&dev);
    hipDeviceGetAttribute(&cus, hipDeviceAttributeMultiprocessorCount, dev);
    hipOccupancyMaxActiveBlocksPerMultiprocessor(&per_cu, mega, 256, 0);
    if (per_cu < 1) per_cu = 1;
    if (per_cu > 2) per_cu = 2;
    grid_blocks = cus * per_cu;
  }
  Params p{};
  const float** pp = (const float**)&p;
  for (int i = 0; i < 23; ++i) pp[i] = (const float*)d_in[i];
  p.out = (float*)d_out;
  p.ws = (char*)d_ws;
  p.ph_lo = 0;
  p.ph_hi = N_PHASES;
  p.use_cg = 0;
  p.pad0 = 0;
  hipMemsetAsync((char*)d_ws + OFF_BAR, 0, XCD_BAR_WORDS * sizeof(unsigned), stream);
  void* args[] = {&p};
  hipError_t e = hipLaunchCooperativeKernel((void*)mega, dim3(grid_blocks), dim3(256), args, 0, stream);
  if (e != hipSuccess) {
    fprintf(stderr, "cooperative launch failed: %s (grid %d)\n", hipGetErrorString(e), grid_blocks);
    (void)hipGetLastError();
    for (int ph = 0; ph < N_PHASES; ++ph) {
      p.ph_lo = ph;
      p.ph_hi = ph + 1;
      hipLaunchKernelGGL(mega, dim3(grid_blocks), dim3(256), 0, stream, p);
    }
  }
}
```

```cpp
#include <hip/hip_runtime.h>
#include <hip/hip_bf16.h>
#include <hip/hip_cooperative_groups.h>
#include <cstdio>
namespace cg = cooperative_groups;

#define DEVI __device__ __forceinline__
typedef unsigned short bf16_t;
typedef short bf16x8 __attribute__((ext_vector_type(8)));
typedef float f32x16 __attribute__((ext_vector_type(16)));

constexpr int M_LAT = 16384, M_CTX = 2048, M_ALL = 18432;
constexpr int DM = 1024, INW = 3248, INWP = 3328, FFN = 2816;
constexpr int C_MQ = 0, C_MKV = 256, C_MPE = 384, C_NQ = 416, C_NK = 672, C_NV = 928, C_DN = 1184;
constexpr int C_DZ = C_DN + 1536, C_DA = C_DN + 2048;

constexpr size_t OFF_WIN = 0;
constexpr size_t OFF_WOUT = OFF_WIN + (size_t)INWP * 1024 * 2;
constexpr size_t OFF_WGU = OFF_WOUT + (size_t)1024 * 1024 * 2;
constexpr size_t OFF_WDN = OFF_WGU + (size_t)2 * FFN * 1024 * 2;
constexpr size_t OFF_WQUP = OFF_WDN + (size_t)1024 * FFN * 2;
constexpr size_t OFF_WKVUP = OFF_WQUP + (size_t)384 * 256 * 2;
constexpr size_t OFF_MOD = OFF_WKVUP + (size_t)512 * 128 * 2;
constexpr size_t OFF_ROPE = OFF_MOD + (size_t)4 * 9 * 6144 * 4;
constexpr size_t OFF_X = OFF_ROPE + (size_t)2048 * 16 * 2 * 4;
constexpr size_t OFF_HM = OFF_X + (size_t)M_ALL * 1024 * 4;
constexpr size_t OFF_P = OFF_HM + (size_t)M_ALL * 1024 * 2;
constexpr size_t OFF_QH = OFF_P + (size_t)M_ALL * INWP * 2;
constexpr size_t OFF_KH = OFF_QH + (size_t)M_ALL * 384 * 2;
constexpr size_t OFF_VH = OFF_KH + (size_t)M_ALL * 384 * 2;
constexpr size_t OFF_DNQKV = OFF_VH + (size_t)M_ALL * 256 * 2;
constexpr size_t OFF_OB = OFF_DNQKV + (size_t)M_ALL * 1536 * 2;
constexpr size_t OFF_AB = OFF_OB + (size_t)M_ALL * 512 * 2;
constexpr size_t OFF_GC = OFF_AB + (size_t)M_ALL * 16 * 4;
constexpr size_t OFF_BETA = OFF_GC + (size_t)M_ALL * 8 * 4;
constexpr size_t OFF_NVT = OFF_BETA + (size_t)M_ALL * 8 * 4;
constexpr size_t WS_TOTAL = OFF_NVT + (size_t)M_ALL * 256 * 2;
constexpr int SMEM_BYTES = 74240;
constexpr size_t OFF_BAR = (WS_TOTAL + 255) & ~(size_t)255;

struct Params {
  const float *x, *c, *ctx, *c_ctx, *w_ada, *b_ada, *g_mix, *w_in, *g_q, *g_kv, *w_qup, *w_kvup, *rel_bias,
      *conv_w, *a_log, *dt_bias, *g_out, *w_out, *g_ffn, *w_gate, *w_up, *w_down, *g_final;
  float* out;
  char* ws;
  int ph_lo, ph_hi;
  int use_cg, pad0;
};

DEVI bf16_t f2bf(float f) {
  __bf16 r = (__bf16)f;
  return __builtin_bit_cast(unsigned short, r);
}
DEVI int otid() {
  int t = threadIdx.x;
  asm volatile("" : "+v"(t));
  return t;
}
DEVI float bf2f(bf16_t h) { return __uint_as_float(((unsigned)h) << 16); }
DEVI float bflo(unsigned u) { return __uint_as_float(u << 16); }
DEVI float bfhi(unsigned u) { return __uint_as_float(u & 0xffff0000u); }
typedef __bf16 bf16v2_t __attribute__((ext_vector_type(2)));
typedef float f32v2_t __attribute__((ext_vector_type(2)));
DEVI unsigned pack2(float a, float b) {
  f32v2_t v = {a, b};
  bf16v2_t r = __builtin_convertvector(v, bf16v2_t);
  return __builtin_bit_cast(unsigned, r);
}
DEVI float silu_f(float x) { return x / (1.f + __expf(-x)); }
DEVI float wave_sum(float v) {
#pragma unroll
  for (int o = 32; o >= 1; o >>= 1) v += __shfl_xor(v, o);
  return v;
}

#define XB_TMO 128
#define XB_XCNT(j) (256 + 64 * (j))
#define XB_XSUB(j) (1280 + 64 * (j))
#define XB_XGEN(j) (2304 + 64 * (j))
#define XB_TOP 3328
#define XB_TOPGEN 3392
#define XCD_BAR_WORDS 3456
#define XB_SPIN_CAP (1u << 22)
#define LAS __attribute__((address_space(3)))
DEVI unsigned xb_ld(unsigned* p) { return __hip_atomic_load(p, __ATOMIC_RELAXED, __HIP_MEMORY_SCOPE_AGENT); }
DEVI unsigned xb_add(unsigned* p, unsigned v) { return __hip_atomic_fetch_add(p, v, __ATOMIC_RELAXED, __HIP_MEMORY_SCOPE_AGENT); }
DEVI unsigned xb_xcc_id() { return (unsigned)__builtin_amdgcn_s_getreg((3 << 11) | 20) & 0xFu; }
#define XB_SPIN(cond, bar)                                                     \
  do {                                                                         \
    unsigned _sp = 0;                                                          \
    while (cond) {                                                             \
      __builtin_amdgcn_s_sleep(1);                                             \
      if ((++_sp & 255u) == 0u) {                                              \
        if (xb_ld(&(bar)[XB_TMO])) break;                                      \
        if (_sp > XB_SPIN_CAP) { atomicAdd(&(bar)[XB_TMO], 1u); break; }       \
      }                                                                        \
    }                                                                          \
  } while (0)
struct XcdBarrier {
  unsigned* bar;
  unsigned x;
  volatile LAS unsigned* st;
};
DEVI XcdBarrier xcd_barrier_post(unsigned* bar, volatile LAS unsigned* st) {
  XcdBarrier b;
  b.bar = bar;
  b.x = xb_xcc_id();
  b.st = st;
  if (threadIdx.x == 0) (void)xb_add(&bar[XB_XCNT(b.x)], 1u);
  return b;
}
DEVI void xcd_barrier_complete(unsigned* bar, unsigned x, unsigned& nloc, unsigned& nx) {
  const unsigned G = gridDim.x * gridDim.y * gridDim.z;
  unsigned sum, cnt, mine, sp = 0u;
  for (;;) {
    sum = 0u; cnt = 0u; mine = 0u;
#pragma unroll
    for (unsigned j = 0; j < 16; ++j) {
      const unsigned c = xb_ld(&bar[XB_XCNT(j)]);
      sum += c;
      cnt += (c > 0u) ? 1u : 0u;
      mine = (j == x) ? c : mine;
    }
    if (sum == G) break;
    __builtin_amdgcn_s_sleep(1);
    if ((++sp & 255u) == 0u) {
      if (xb_ld(&bar[XB_TMO])) break;
      if (sp > XB_SPIN_CAP) { atomicAdd(&bar[XB_TMO], 1u); break; }
    }
  }
  nloc = mine > 0u ? mine : 1u;
  nx = cnt > 0u ? cnt : 1u;
}
DEVI void xcd_barrier(const XcdBarrier& b) {
  asm volatile("s_waitcnt vmcnt(0)" ::: "memory");
  __syncthreads();
  if (threadIdx.x == 0) {
    unsigned* bar = b.bar;
    __builtin_amdgcn_s_waitcnt(0);
    unsigned nloc = b.st[0], nx = b.st[1];
    if (nloc == 0u) {
      xcd_barrier_complete(bar, b.x, nloc, nx);
      b.st[0] = nloc;
      b.st[1] = nx;
    }
    const unsigned old = xb_add(&bar[XB_XSUB(b.x)], 1u);
    const unsigned gen = old / nloc;
    if (old + 1u == (gen + 1u) * nloc) {
      __builtin_amdgcn_fence(__ATOMIC_RELEASE, "agent");
      asm volatile("s_waitcnt vmcnt(0)" ::: "memory");
      const unsigned og = xb_add(&bar[XB_TOP], 1u);
      const unsigned tg = og / nx;
      if (og + 1u == (tg + 1u) * nx) xb_add(&bar[XB_TOPGEN], 1u);
      else XB_SPIN(xb_ld(&bar[XB_TOPGEN]) == tg, bar);
      __builtin_amdgcn_fence(__ATOMIC_ACQUIRE, "agent");
      xb_add(&bar[XB_XGEN(b.x)], 1u);
      asm volatile("s_waitcnt vmcnt(0)" ::: "memory");
    } else {
      XB_SPIN(xb_ld(&bar[XB_XGEN(b.x)]) == gen, bar);
      __builtin_amdgcn_fence(__ATOMIC_ACQUIRE, "agent");
      asm volatile("s_waitcnt vmcnt(0)" ::: "memory");
    }
  }
  __syncthreads();
}

constexpr int N_CONV_EARLY = 16 * 52 + 24 + 16;
__device__ void conv_item_early(const Params& p, int l, int it, float* tl);

__device__ void phase0(const Params& p, char* smem) {
  const int tid = otid(), nb = gridDim.x, bid = blockIdx.x;
  {
    float* rc = (float*)(p.ws + OFF_ROPE);
    float* rs = rc + 2048 * 16;
    for (int i = bid * 256 + tid; i < 2048 * 16; i += nb * 256) {
      int t = i >> 4, a = (i >> 3) & 1, j = i & 7;
      float pos = a ? (float)(t & 63) : (float)(t >> 6);
      float inv = __builtin_amdgcn_exp2f(-(float)j * (13.287712379549449f / 8.f));
      float ang = pos * inv;
      rc[i] = cosf(ang);
      rs[i] = sinf(ang);
    }
  }
  for (int it = bid; it < N_CONV_EARLY; it += nb) conv_item_early(p, 0, it, (float*)smem);
  __syncthreads();
  float* sc = (float*)smem;
  float* red = sc + 1024 * 12;
  float* MOD = (float*)(p.ws + OFF_MOD);
  bool loaded = false;
  for (int it = bid; it < 4 * 96; it += nb) {
    if (!loaded) {
      for (int i = tid; i < 9 * 1024; i += 256) {
        float v = i < 8192 ? p.c[i] : p.c_ctx[i - 8192];
        sc[(i & 1023) * 12 + (i >> 10)] = silu_f(v);
      }
      __syncthreads();
      loaded = true;
    }
    const int l = it / 96, n0 = (it % 96) * 64;
    const int cc = tid & 63, kg = tid >> 6;
    const float* w = p.w_ada + (size_t)l * 1024 * 6144 + n0 + cc;
    float acc[9];
#pragma unroll
    for (int b = 0; b < 9; ++b) acc[b] = 0.f;
    for (int k0 = kg * 256; k0 < kg * 256 + 256; k0 += 16) {
      float wvv[16];
#pragma unroll
      for (int j = 0; j < 16; ++j) wvv[j] = w[(size_t)(k0 + j) * 6144];
#pragma unroll
      for (int j = 0; j < 16; ++j) {
      const int k = k0 + j;
      const float wv = wvv[j];
      const float4 s0 = *(const float4*)(sc + k * 12);
      const float4 s1 = *(const float4*)(sc + k * 12 + 4);
      const float s2 = sc[k * 12 + 8];
      acc[0] += s0.x * wv; acc[1] += s0.y * wv; acc[2] += s0.z * wv; acc[3] += s0.w * wv;
      acc[4] += s1.x * wv; acc[5] += s1.y * wv; acc[6] += s1.z * wv; acc[7] += s1.w * wv;
      acc[8] += s2 * wv;
      }
    }
#pragma unroll
    for (int b = 0; b < 9; ++b) red[(kg * 9 + b) * 64 + cc] = acc[b];
    __syncthreads();
    for (int i = tid; i < 9 * 64; i += 256) {
      int b = i >> 6, c2 = i & 63;
      float s = red[(0 * 9 + b) * 64 + c2] + red[(1 * 9 + b) * 64 + c2] + red[(2 * 9 + b) * 64 + c2] +
                red[(3 * 9 + b) * 64 + c2];
      MOD[(size_t)(l * 9 + b) * 6144 + n0 + c2] = s + p.b_ada[l * 6144 + n0 + c2];
    }
    __syncthreads();
  }
}

__device__ void convT_tile(const float* __restrict__ src, int K, int N, bf16_t* __restrict__ dst, int mode,
                           const float* __restrict__ gs, int kt, int nt, float* tl) {
  const int tid = otid();
  const int k0 = kt * 64, n0 = nt * 64;
  __syncthreads();
#pragma unroll 4
  for (int i = 0; i < 16; ++i) {
    int kk = i * 4 + (tid >> 6), nn = tid & 63;
    float v = 0.f;
    if (n0 + nn < N) v = src[(size_t)(k0 + kk) * N + n0 + nn];
    if (gs) v *= gs[k0 + kk];
    tl[kk * 65 + nn] = v;
  }
  __syncthreads();
#pragma unroll 2
  for (int i = 0; i < 8; ++i) {
    int nn = i * 8 + (tid >> 5), kk = (tid & 31) * 2;
    unsigned pk = pack2(tl[kk * 65 + nn], tl[(kk + 1) * 65 + nn]);
    int n = n0 + nn;
    int drow = mode == 0 ? n : ((n >> 5) * 64 + (n & 31) + (mode == 2 ? 32 : 0));
    *(unsigned*)(dst + (size_t)drow * K + k0 + kk) = pk;
  }
}

__device__ void norm_rows(const Params& p, bool from_input, bf16_t* __restrict__ H, const float* __restrict__ g,
                          const float* __restrict__ modl, int shift_i, int scale_i, int item) {
  const int w = otid() >> 6, lane = otid() & 63;
  const int row = item * 4 + w;
  const float* xsrc = from_input ? (row < M_LAT ? p.x + (size_t)row * 1024 : p.ctx + (size_t)(row - M_LAT) * 1024)
                                 : (const float*)(p.ws + OFF_X) + (size_t)row * 1024;
  const float4* xr = (const float4*)xsrc;
  float4 v[4];
  float ss = 0.f;
#pragma unroll
  for (int i = 0; i < 4; ++i) {
    v[i] = xr[lane + 64 * i];
    ss += v[i].x * v[i].x + v[i].y * v[i].y + v[i].z * v[i].z + v[i].w * v[i].w;
  }
  ss = wave_sum(ss);
  const float r = rsqrtf(ss * (1.f / 1024.f) + 1e-6f);
  const int b = row < M_LAT ? (row >> 11) : 8;
  const float4* sh = (const float4*)(modl + b * 6144 + shift_i * 1024);
  const float4* sl = (const float4*)(modl + b * 6144 + scale_i * 1024);
  const float4* g4 = (const float4*)g;
#pragma unroll
  for (int i = 0; i < 4; ++i) {
    int c4 = lane + 64 * i;
    float4 gg = g4[c4], s4 = sh[c4], l4 = sl[c4];
    float y0 = v[i].x * r * gg.x * (1.f + l4.x) + s4.x;
    float y1 = v[i].y * r * gg.y * (1.f + l4.y) + s4.y;
    float y2 = v[i].z * r * gg.z * (1.f + l4.z) + s4.z;
    float y3 = v[i].w * r * gg.w * (1.f + l4.w) + s4.w;
    uint2 pk;
    pk.x = pack2(y0, y1);
    pk.y = pack2(y2, y3);
    *(uint2*)(H + (size_t)row * 1024 + c4 * 4) = pk;
  }
}

__device__ void conv_item_late(const Params& p, int l, int i, float* tl) {
  bf16_t* Wout = (bf16_t*)(p.ws + OFF_WOUT);
  bf16_t* Wgu = (bf16_t*)(p.ws + OFF_WGU);
  bf16_t* Wdn = (bf16_t*)(p.ws + OFF_WDN);
  const float* src;
  bf16_t* dst;
  int K, N, mode = 0, ntn;
  if (i < 256) {
    src = p.w_out + (size_t)l * 1024 * 1024; K = 1024; N = 1024; dst = Wout; ntn = 16;
  } else if (i < 960) {
    i -= 256; src = p.w_gate + (size_t)l * 1024 * FFN; K = 1024; N = FFN; dst = Wgu; ntn = 44; mode = 1;
  } else if (i < 1664) {
    i -= 960; src = p.w_up + (size_t)l * 1024 * FFN; K = 1024; N = FFN; dst = Wgu; ntn = 44; mode = 2;
  } else {
    i -= 1664; src = p.w_down + (size_t)l * FFN * 1024; K = FFN; N = 1024; dst = Wdn; ntn = 16;
  }
  convT_tile(src, K, N, dst, mode, nullptr, i / ntn, i % ntn, tl);
}
constexpr int N_CONV_LATE = 256 + 3 * 704;
__device__ void conv_item_early(const Params& p, int l, int it, float* tl) {
  const float* src;
  const float* gs = nullptr;
  bf16_t* dst;
  int K, N, ntn, i;
  if (it < 832) {
    i = it; src = p.w_in + (size_t)l * 1024 * INW; K = 1024; N = INW; dst = (bf16_t*)(p.ws + OFF_WIN); ntn = 52;
  } else if (it < 856) {
    i = it - 832; src = p.w_qup + (size_t)l * 256 * 384; K = 256; N = 384; dst = (bf16_t*)(p.ws + OFF_WQUP); ntn = 6;
    gs = p.g_q + l * 256;
  } else {
    i = it - 856; src = p.w_kvup + (size_t)l * 128 * 512; K = 128; N = 512; dst = (bf16_t*)(p.ws + OFF_WKVUP); ntn = 8;
    gs = p.g_kv + l * 128;
  }
  convT_tile(src, K, N, dst, 0, gs, i / ntn, i % ntn, tl);
}

__device__ void phaseA(const Params& p, int l, char* smem) {
  const int nb = gridDim.x, bid = blockIdx.x;
  for (int it = bid; it < M_ALL / 4; it += nb)
    norm_rows(p, l == 0, (bf16_t*)(p.ws + OFF_HM), p.g_mix + l * 1024,
              (const float*)(p.ws + OFF_MOD) + (size_t)l * 9 * 6144, 0, 1, it);
}

DEVI void tile_map(int it, int NT, int& mt, int& nt, int MPX = 18) {
  const int xcd = it & 7, idx = it >> 3;
  const int per_group = 8 * NT;
  const int g = idx / per_group, r = idx - g * per_group;
  const int gs = min(8, MPX - 8 * g);
  mt = xcd * MPX + g * 8 + r % gs;
  nt = r / gs;
}

enum { EPI_P = 0, EPI_QUP = 1, EPI_KVUP = 2, EPI_RES = 3, EPI_GU = 4 };

template <int EPI>
__device__ void gemm_tile(const Params& p, int l, const bf16_t* __restrict__ A, int lda,
                          const bf16_t* __restrict__ BT, int K, int m0, int n0, int gate_i, char* smem) {
  constexpr int STAGE = 2 * 128 * 72;
  bf16_t* sbase = (bf16_t*)smem;
  float* rsv = (float*)(smem + 2 * STAGE * 2);
  const int tid = otid(), lane = tid & 63, w = tid >> 6, wm = w >> 1, wn = w & 1;
  const int lr = tid >> 3, lc = (tid & 7) * 8;
  __syncthreads();
  if (EPI == EPI_QUP || EPI == EPI_KVUP) {
    const int row = tid >> 1, hf = tid & 1;
    const int n8 = K / 16;
    const uint4* ap = (const uint4*)(A + (size_t)(m0 + row) * lda + hf * (K / 2));
    float ss = 0.f;
    for (int i = 0; i < n8; ++i) {
      uint4 u = ap[i];
      float a0 = bflo(u.x), a1 = bfhi(u.x), a2 = bflo(u.y), a3 = bfhi(u.y), a4 = bflo(u.z), a5 = bfhi(u.z),
            a6 = bflo(u.w), a7 = bfhi(u.w);
      ss += a0 * a0 + a1 * a1 + a2 * a2 + a3 * a3 + a4 * a4 + a5 * a5 + a6 * a6 + a7 * a7;
    }
    ss += __shfl_xor(ss, 1);
    if (hf == 0) rsv[row] = rsqrtf(ss / (float)K + 1e-6f);
  }
  const bf16_t* Ap = A + (size_t)(m0 + lr) * lda + lc;
  const bf16_t* Bp = BT + (size_t)(n0 + lr) * K + lc;
  uint4 ra0, ra1, ra2, ra3, rb0, rb1, rb2, rb3;
#define G_LOAD()                                  \
  ra0 = *(const uint4*)(Ap);                      \
  ra1 = *(const uint4*)(Ap + (size_t)32 * lda);   \
  ra2 = *(const uint4*)(Ap + (size_t)64 * lda);   \
  ra3 = *(const uint4*)(Ap + (size_t)96 * lda);   \
  rb0 = *(const uint4*)(Bp);                      \
  rb1 = *(const uint4*)(Bp + (size_t)32 * K);     \
  rb2 = *(const uint4*)(Bp + (size_t)64 * K);     \
  rb3 = *(const uint4*)(Bp + (size_t)96 * K);
#define S_WRITE(ST)                                                   \
  {                                                                   \
    bf16_t* wa = sbase + (ST) * STAGE + lr * 72 + lc;                 \
    bf16_t* wb = wa + 128 * 72;                                       \
    *(uint4*)(wa) = ra0;                                              \
    *(uint4*)(wa + 32 * 72) = ra1;                                    \
    *(uint4*)(wa + 64 * 72) = ra2;                                    \
    *(uint4*)(wa + 96 * 72) = ra3;                                    \
    *(uint4*)(wb) = rb0;                                              \
    *(uint4*)(wb + 32 * 72) = rb1;                                    \
    *(uint4*)(wb + 64 * 72) = rb2;                                    \
    *(uint4*)(wb + 96 * 72) = rb3;                                    \
  }
  const int nk = K / 64;
  G_LOAD()
  S_WRITE(0)
  if (nk > 1) {
    Ap += 64;
    Bp += 64;
    G_LOAD()
  }
  f32x16 acc[2][2];
#pragma unroll
  for (int i = 0; i < 2; ++i)
#pragma unroll
    for (int j = 0; j < 2; ++j)
#pragma unroll
      for (int r = 0; r < 16; ++r) acc[i][j][r] = 0.f;
  __syncthreads();
  for (int kt = 0; kt < nk; ++kt) {
    const int cur = kt & 1;
    const bf16_t* pa = sbase + cur * STAGE + (wm * 64 + (lane & 31)) * 72 + (lane >> 5) * 8;
    const bf16_t* pb = sbase + cur * STAGE + 128 * 72 + (wn * 64 + (lane & 31)) * 72 + (lane >> 5) * 8;
    bf16x8 fa00 = *(const bf16x8*)(pa), fa01 = *(const bf16x8*)(pa + 32 * 72);
    bf16x8 fb00 = *(const bf16x8*)(pb), fb01 = *(const bf16x8*)(pb + 32 * 72);
    bf16x8 fa10 = *(const bf16x8*)(pa + 16), fa11 = *(const bf16x8*)(pa + 32 * 72 + 16);
    bf16x8 fb10 = *(const bf16x8*)(pb + 16), fb11 = *(const bf16x8*)(pb + 32 * 72 + 16);
    bf16x8 fa20 = *(const bf16x8*)(pa + 32), fa21 = *(const bf16x8*)(pa + 32 * 72 + 32);
    bf16x8 fb20 = *(const bf16x8*)(pb + 32), fb21 = *(const bf16x8*)(pb + 32 * 72 + 32);
    bf16x8 fa30 = *(const bf16x8*)(pa + 48), fa31 = *(const bf16x8*)(pa + 32 * 72 + 48);
    bf16x8 fb30 = *(const bf16x8*)(pb + 48), fb31 = *(const bf16x8*)(pb + 32 * 72 + 48);
    __builtin_amdgcn_sched_barrier(0);
    __builtin_amdgcn_s_setprio(1);
#define MM4(A0, A1, B0, B1)                                                           \
  acc[0][0] = __builtin_amdgcn_mfma_f32_32x32x16_bf16(A0, B0, acc[0][0], 0, 0, 0);    \
  acc[0][1] = __builtin_amdgcn_mfma_f32_32x32x16_bf16(A0, B1, acc[0][1], 0, 0, 0);    \
  acc[1][0] = __builtin_amdgcn_mfma_f32_32x32x16_bf16(A1, B0, acc[1][0], 0, 0, 0);    \
  acc[1][1] = __builtin_amdgcn_mfma_f32_32x32x16_bf16(A1, B1, acc[1][1], 0, 0, 0);
    MM4(fa00, fa01, fb00, fb01)
    MM4(fa10, fa11, fb10, fb11)
    MM4(fa20, fa21, fb20, fb21)
    MM4(fa30, fa31, fb30, fb31)
#undef MM4
    __builtin_amdgcn_s_setprio(0);
    __builtin_amdgcn_sched_barrier(0);
    if (kt + 1 < nk) {
      S_WRITE(cur ^ 1)
      if (kt + 2 < nk) {
        Ap += 64;
        Bp += 64;
        G_LOAD()
      }
    }
    __syncthreads();
  }
#undef G_LOAD
#undef S_WRITE
  const int ci = lane & 31;
  const int rbase = m0 + wm * 64 + 4 * (lane >> 5);
  const int cbase = n0 + wn * 64;
  if (EPI == EPI_P) {
    bf16_t* P = (bf16_t*)(p.ws + OFF_P);
    float* AB = (float*)(p.ws + OFF_AB);
    bf16_t* sO = (bf16_t*)smem;
#pragma unroll
    for (int mt = 0; mt < 2; ++mt)
#pragma unroll
      for (int nt = 0; nt < 2; ++nt)
#pragma unroll
        for (int r = 0; r < 16; ++r) {
          const int rl = wm * 64 + 4 * (lane >> 5) + mt * 32 + (r & 3) + 8 * (r >> 2);
          const int cl = wn * 64 + nt * 32 + ci;
          const float v = acc[mt][nt][r];
          sO[rl * 136 + cl] = f2bf(v);
          const int col = n0 + cl;
          if (col >= C_DA && col < C_DA + 16) AB[(size_t)(m0 + rl) * 16 + col - C_DA] = v;
        }
    __syncthreads();
#pragma unroll
    for (int e = 0; e < 8; ++e) {
      const int c = tid + 256 * e, rl = c >> 4, ch = c & 15;
      *(uint4*)(P + (size_t)(m0 + rl) * INWP + n0 + ch * 8) = *(const uint4*)(sO + rl * 136 + ch * 8);
    }
    bf16_t* NVT = (bf16_t*)(p.ws + OFF_NVT);
#pragma unroll
    for (int mt = 0; mt < 2; ++mt)
#pragma unroll
      for (int nt = 0; nt < 2; ++nt) {
        const int base = cbase + nt * 32;
        if (base >= C_NV && base < C_NV + 256) {
          const int hv = (base - C_NV) >> 6, dv = ((base - C_NV) & 63) + ci;
#pragma unroll
          for (int g = 0; g < 4; ++g) {
            const int row0 = rbase + mt * 32 + 8 * g;
            int bb, key0;
            if (row0 < M_LAT) { bb = row0 >> 11; key0 = 256 + (row0 & 2047); }
            else { bb = (row0 - M_LAT) >> 8; key0 = (row0 - M_LAT) & 255; }
            uint2 u;
            u.x = pack2(acc[mt][nt][4 * g + 0], acc[mt][nt][4 * g + 1]);
            u.y = pack2(acc[mt][nt][4 * g + 2], acc[mt][nt][4 * g + 3]);
            *(uint2*)(NVT + ((size_t)(bb * 4 + hv) * 64 + dv) * 2304 + key0) = u;
          }
        }
      }
  } else if (EPI == EPI_QUP) {
    bf16_t* QH = (bf16_t*)(p.ws + OFF_QH);
    const float* rc = (const float*)(p.ws + OFF_ROPE);
    const float* rsn = rc + 2048 * 16;
#pragma unroll
    for (int mt = 0; mt < 2; ++mt)
#pragma unroll
      for (int nt = 0; nt < 2; ++nt) {
        const int base = cbase + nt * 32;
        const bool rope = ((base % 96) == 64) && (m0 < M_LAT);
#pragma unroll
        for (int r = 0; r < 16; ++r) {
          int row = rbase + mt * 32 + (r & 3) + 8 * (r >> 2);
          float v = acc[mt][nt][r] * rsv[row - m0];
          float o = __shfl_xor(v, 8);
          if (rope) {
            int t = row & 2047;
            int a = ci >> 4, hf = (ci >> 3) & 1, j = ci & 7;
            float c = rc[t * 16 + a * 8 + j], s = rsn[t * 16 + a * 8 + j];
            v = hf ? (o * s + v * c) : (v * c - o * s);
          }
          QH[(size_t)row * 384 + base + ci] = f2bf(v);
        }
      }
  } else if (EPI == EPI_KVUP) {
    bf16_t* KA = (bf16_t*)(p.ws + OFF_KH);
    bf16_t* VT = (bf16_t*)(p.ws + OFF_VH);
#pragma unroll
    for (int mt = 0; mt < 2; ++mt)
#pragma unroll
      for (int nt = 0; nt < 2; ++nt) {
        const int base = cbase + nt * 32;
        const int h = base >> 7, cc = (base & 127) + ci;
#pragma unroll
        for (int g = 0; g < 4; ++g) {
          const int row0 = rbase + mt * 32 + 8 * g;
          int bb, key0;
          if (row0 < M_LAT) { bb = row0 >> 11; key0 = 256 + (row0 & 2047); }
          else { bb = (row0 - M_LAT) >> 8; key0 = (row0 - M_LAT) & 255; }
          float v0 = acc[mt][nt][4 * g + 0] * rsv[row0 - m0 + 0];
          float v1 = acc[mt][nt][4 * g + 1] * rsv[row0 - m0 + 1];
          float v2 = acc[mt][nt][4 * g + 2] * rsv[row0 - m0 + 2];
          float v3 = acc[mt][nt][4 * g + 3] * rsv[row0 - m0 + 3];
          if (cc < 64) {
            bf16_t* kp = KA + ((size_t)(bb * 4 + h) * 2304 + key0) * 96 + cc;
            kp[0] = f2bf(v0); kp[96] = f2bf(v1); kp[192] = f2bf(v2); kp[288] = f2bf(v3);
          } else {
            uint2 u;
            u.x = pack2(v0, v1);
            u.y = pack2(v2, v3);
            *(uint2*)(VT + ((size_t)(bb * 4 + h) * 64 + (cc - 64)) * 2304 + key0) = u;
          }
        }
      }
  } else if (EPI == EPI_RES) {
    float* X = (float*)(p.ws + OFF_X);
    const float* Xsrc = (l == 0 && gate_i == 2) ? (m0 < M_LAT ? p.x : p.ctx - (size_t)M_LAT * 1024) : X;
    const float* modl = (const float*)(p.ws + OFF_MOD) + (size_t)l * 9 * 6144 + gate_i * 1024;
#pragma unroll
    for (int mt = 0; mt < 2; ++mt)
#pragma unroll
      for (int nt = 0; nt < 2; ++nt)
#pragma unroll
        for (int r = 0; r < 16; ++r) {
          int row = rbase + mt * 32 + (r & 3) + 8 * (r >> 2);
          int col = cbase + nt * 32 + ci;
          int b = row < M_LAT ? (row >> 11) : 8;
          float g = modl[b * 6144 + col];
          size_t idx = (size_t)row * 1024 + col;
          X[idx] = Xsrc[idx] + g * acc[mt][nt][r];
        }
  } else if (EPI == EPI_GU) {
    bf16_t* ACT = (bf16_t*)(p.ws + OFF_P);
    bf16_t* sO = (bf16_t*)smem;
#pragma unroll
    for (int mt = 0; mt < 2; ++mt)
#pragma unroll
      for (int r = 0; r < 16; ++r) {
        const int rl = wm * 64 + 4 * (lane >> 5) + mt * 32 + (r & 3) + 8 * (r >> 2);
        float gt = acc[mt][0][r], up = acc[mt][1][r];
        float a = silu_f(gt) * up;
        sO[rl * 72 + wn * 32 + ci] = f2bf(a);
      }
    __syncthreads();
#pragma unroll
    for (int e = 0; e < 4; ++e) {
      const int c = tid + 256 * e, rl = c >> 3, ch = c & 7;
      *(uint4*)(ACT + (size_t)(m0 + rl) * FFN + (n0 >> 1) + ch * 8) = *(const uint4*)(sO + rl * 72 + ch * 8);
    }
  }
}

template <int EPI>
__device__ void gemm_wide(const Params& p, int l, const bf16_t* __restrict__ A, int lda,
                          const bf16_t* __restrict__ BT, int K, int m0, int n0, int gate_i, char* smem) {
  bf16_t* sA = (bf16_t*)smem;
  bf16_t* sB = sA + 128 * 72;
  const int tid = otid(), lane = tid & 63, w = tid >> 6, wm = w >> 1, wn = w & 1;
  const int lr = tid >> 3, lc = (tid & 7) * 8;
  const bf16_t* Ap = A + (size_t)(m0 + lr) * lda + lc;
  const bf16_t* Bp = BT + (size_t)(n0 + lr) * K + lc;
  uint4 ra0, ra1, ra2, ra3, rb0, rb1, rb2, rb3, rb4, rb5, rb6, rb7;
#define LOAD_AB()                                   \
  ra0 = *(const uint4*)(Ap);                        \
  ra1 = *(const uint4*)(Ap + (size_t)32 * lda);     \
  ra2 = *(const uint4*)(Ap + (size_t)64 * lda);     \
  ra3 = *(const uint4*)(Ap + (size_t)96 * lda);     \
  rb0 = *(const uint4*)(Bp);                        \
  rb1 = *(const uint4*)(Bp + (size_t)32 * K);       \
  rb2 = *(const uint4*)(Bp + (size_t)64 * K);       \
  rb3 = *(const uint4*)(Bp + (size_t)96 * K);       \
  rb4 = *(const uint4*)(Bp + (size_t)128 * K);      \
  rb5 = *(const uint4*)(Bp + (size_t)160 * K);      \
  rb6 = *(const uint4*)(Bp + (size_t)192 * K);      \
  rb7 = *(const uint4*)(Bp + (size_t)224 * K);
  LOAD_AB()
  f32x16 acc[2][4];
#pragma unroll
  for (int i = 0; i < 2; ++i)
#pragma unroll
    for (int j = 0; j < 4; ++j)
#pragma unroll
      for (int r = 0; r < 16; ++r) acc[i][j][r] = 0.f;
  const int nk = K / 64;
  for (int kt = 0; kt < nk; ++kt) {
    __syncthreads();
    *(uint4*)(sA + (lr + 0) * 72 + lc) = ra0;
    *(uint4*)(sA + (lr + 32) * 72 + lc) = ra1;
    *(uint4*)(sA + (lr + 64) * 72 + lc) = ra2;
    *(uint4*)(sA + (lr + 96) * 72 + lc) = ra3;
    *(uint4*)(sB + (lr + 0) * 72 + lc) = rb0;
    *(uint4*)(sB + (lr + 32) * 72 + lc) = rb1;
    *(uint4*)(sB + (lr + 64) * 72 + lc) = rb2;
    *(uint4*)(sB + (lr + 96) * 72 + lc) = rb3;
    *(uint4*)(sB + (lr + 128) * 72 + lc) = rb4;
    *(uint4*)(sB + (lr + 160) * 72 + lc) = rb5;
    *(uint4*)(sB + (lr + 192) * 72 + lc) = rb6;
    *(uint4*)(sB + (lr + 224) * 72 + lc) = rb7;
    __syncthreads();
    if (kt + 1 < nk) {
      Ap += 64;
      Bp += 64;
      LOAD_AB()
    }
    __builtin_amdgcn_sched_barrier(0);
#pragma unroll
    for (int ks = 0; ks < 4; ++ks) {
      const int ko = ks * 16 + (lane >> 5) * 8;
      bf16x8 a0 = *(const bf16x8*)(sA + (wm * 64 + (lane & 31)) * 72 + ko);
      bf16x8 a1 = *(const bf16x8*)(sA + (wm * 64 + 32 + (lane & 31)) * 72 + ko);
#pragma unroll
      for (int nt = 0; nt < 4; ++nt) {
        bf16x8 b = *(const bf16x8*)(sB + (wn * 128 + nt * 32 + (lane & 31)) * 72 + ko);
        acc[0][nt] = __builtin_amdgcn_mfma_f32_32x32x16_bf16(a0, b, acc[0][nt], 0, 0, 0);
        acc[1][nt] = __builtin_amdgcn_mfma_f32_32x32x16_bf16(a1, b, acc[1][nt], 0, 0, 0);
      }
    }
  }
#undef LOAD_AB
  const int ci = lane & 31;
  const int rbase = m0 + wm * 64 + 4 * (lane >> 5);
  const int cbase = n0 + wn * 128;
  if (EPI == EPI_P) {
    bf16_t* P = (bf16_t*)(p.ws + OFF_P);
    float* AB = (float*)(p.ws + OFF_AB);
    bf16_t* NVT = (bf16_t*)(p.ws + OFF_NVT);
#pragma unroll
    for (int mt = 0; mt < 2; ++mt)
#pragma unroll
      for (int nt = 0; nt < 4; ++nt) {
        const int base = cbase + nt * 32;
#pragma unroll
        for (int r = 0; r < 16; ++r) {
          int row = rbase + mt * 32 + (r & 3) + 8 * (r >> 2);
          int col = base + ci;
          float v = acc[mt][nt][r];
          P[(size_t)row * INWP + col] = f2bf(v);
          if (col >= C_DA && col < C_DA + 16) AB[(size_t)row * 16 + col - C_DA] = v;
        }
        if (base >= C_NV && base < C_NV + 256) {
          const int hv = (base - C_NV) >> 6, dv = ((base - C_NV) & 63) + ci;
#pragma unroll
          for (int g = 0; g < 4; ++g) {
            const int row0 = rbase + mt * 32 + 8 * g;
            int bb, key0;
            if (row0 < M_LAT) { bb = row0 >> 11; key0 = 256 + (row0 & 2047); }
            else { bb = (row0 - M_LAT) >> 8; key0 = (row0 - M_LAT) & 255; }
            uint2 u;
            u.x = pack2(acc[mt][nt][4 * g + 0], acc[mt][nt][4 * g + 1]);
            u.y = pack2(acc[mt][nt][4 * g + 2], acc[mt][nt][4 * g + 3]);
            *(uint2*)(NVT + ((size_t)(bb * 4 + hv) * 64 + dv) * 2304 + key0) = u;
          }
        }
      }
  } else if (EPI == EPI_GU) {
    bf16_t* ACT = (bf16_t*)(p.ws + OFF_P);
#pragma unroll
    for (int mt = 0; mt < 2; ++mt)
#pragma unroll
      for (int pr = 0; pr < 2; ++pr)
#pragma unroll
        for (int r = 0; r < 16; ++r) {
          int row = rbase + mt * 32 + (r & 3) + 8 * (r >> 2);
          float gt = acc[mt][2 * pr][r], up = acc[mt][2 * pr + 1][r];
          float a = silu_f(gt) * up;
          ACT[(size_t)row * FFN + ((cbase >> 6) + pr) * 32 + ci] = f2bf(a);
        }
  }
}

__device__ void kpe_item(const Params& p, int it) {
  const int tid = otid();
  const bf16_t* P = (const bf16_t*)(p.ws + OFF_P);
  bf16_t* KH = (bf16_t*)(p.ws + OFF_KH);
  const float* rc = (const float*)(p.ws + OFF_ROPE);
  const float* rsn = rc + 2048 * 16;
  const int row = it * 8 + (tid >> 5), i = tid & 31;
  float v = bf2f(P[(size_t)row * INWP + C_MPE + i]);
  float o = __shfl_xor(v, 8);
  if (row < M_LAT) {
    int t = row & 2047;
    int a = i >> 4, hf = (i >> 3) & 1, j = i & 7;
    float c = rc[t * 16 + a * 8 + j], s = rsn[t * 16 + a * 8 + j];
    v = hf ? (o * s + v * c) : (v * c - o * s);
  }
  bf16_t bv = f2bf(v);
  int bb, key;
  if (row < M_LAT) { bb = row >> 11; key = 256 + (row & 2047); }
  else { bb = (row - M_LAT) >> 8; key = (row - M_LAT) & 255; }
#pragma unroll
  for (int h = 0; h < 4; ++h) KH[((size_t)(bb * 4 + h) * 2304 + key) * 96 + 64 + i] = bv;
}

__device__ void dn_prep(const Params& p, int l, int it, char* smem) {
  float* buf = (float*)smem;
  float* nrm = buf + 8 * 1536;
  const int tid = otid();
  const bf16_t* P = (const bf16_t*)(p.ws + OFF_P);
  bf16_t* DQ = (bf16_t*)(p.ws + OFF_DNQKV);
  const int r0 = it * 8;
  int seq_lo, seq_hi;
  if (r0 < M_LAT) {
    seq_lo = (r0 >> 11) << 11;
    seq_hi = seq_lo + 2048;
  } else {
    int rr = r0 - M_LAT;
    seq_lo = M_LAT + ((rr >> 8) << 8);
    seq_hi = seq_lo + 256;
  }
  const float* cw = p.conv_w + (size_t)l * 5 * 1536;
  __syncthreads();
  for (int c6 = 0; c6 < 6; ++c6) {
    const int ch = c6 * 256 + tid;
    float w0 = cw[ch], w1 = cw[1536 + ch], w2 = cw[2 * 1536 + ch], w3 = cw[3 * 1536 + ch], w4 = cw[4 * 1536 + ch];
    float xw[12];
#pragma unroll
    for (int j = 0; j < 12; ++j) {
      int r = r0 - 2 + j;
      xw[j] = (r >= seq_lo && r < seq_hi) ? bf2f(P[(size_t)r * INWP + C_DN + ch]) : 0.f;
    }
#pragma unroll
    for (int j = 0; j < 8; ++j) {
      float y = w0 * xw[j] + w1 * xw[j + 1] + w2 * xw[j + 2] + w3 * xw[j + 3] + w4 * xw[j + 4];
      buf[j * 1536 + ch] = silu_f(y);
    }
  }
  __syncthreads();
  {
    int vec = tid >> 2, part = tid & 3;
    int rr = vec >> 3, hv = vec & 7;
    const float* v = buf + rr * 1536 + hv * 128 + part * 32;
    float ss = 0.f;
#pragma unroll
    for (int i = 0; i < 32; ++i) ss += v[i] * v[i];
    ss += __shfl_xor(ss, 1);
    ss += __shfl_xor(ss, 2);
    if (part == 0) nrm[vec] = rsqrtf(ss + 1e-6f);
  }
  __syncthreads();
  for (int i = tid; i < 8 * 1536; i += 256) {
    int rr = i / 1536, ch = i - rr * 1536;
    float v = buf[i];
    if (ch < 1024) v *= nrm[rr * 8 + (ch >> 7)];
    DQ[(size_t)(r0 + rr) * 1536 + ch] = f2bf(v);
  }
}


DEVI int rowmap(int r, int hh) { return (r & 3) + 8 * (r >> 2) + 4 * hh; }

DEVI void unpack8(const uint4& u, float* f) {
  f[0] = bflo(u.x); f[1] = bfhi(u.x); f[2] = bflo(u.y); f[3] = bfhi(u.y);
  f[4] = bflo(u.z); f[5] = bfhi(u.z); f[6] = bflo(u.w); f[7] = bfhi(u.w);
}
__device__ void dn_chunk_prep(const Params& p, int l, int item, char* smem) {
  float* sW = (float*)smem;
  bf16_t* sKb = (bf16_t*)(smem + 7680);
  float* sL0 = (float*)(smem + 25088);
  float* sL1 = sL0 + 64 * 68;
  float* sg = (float*)(smem + 59904);
  float* sbt = sg + 128;
  const int tid = otid(), lane = tid & 63, w = tid >> 6, li = lane & 31, hh = lane >> 5;
  const int chunk = item >> 2, h = item & 3;
  int row0, seq_lo, seq_hi;
  if (chunk < 256) {
    int b = chunk >> 5;
    row0 = b * 2048 + (chunk & 31) * 64; seq_lo = b * 2048; seq_hi = seq_lo + 2048;
  } else {
    int cc = chunk - 256, b = cc >> 2;
    row0 = M_LAT + b * 256 + (cc & 3) * 64; seq_lo = M_LAT + b * 256; seq_hi = seq_lo + 256;
  }
  const bf16_t* P = (const bf16_t*)(p.ws + OFF_P);
  bf16_t* DQ = (bf16_t*)(p.ws + OFF_DNQKV);
  const float* AB = (const float*)(p.ws + OFF_AB);
  const float* cw = p.conv_w + (size_t)l * 5 * 1536;
  __syncthreads();
  for (int i = tid; i < 5 * 384; i += 256) {
    const int tap = i / 384, cc = i - tap * 384, type = cc >> 7, c = cc & 127;
    const int off = type == 0 ? 512 : (type == 1 ? 0 : 1024);
    sW[i] = cw[tap * 1536 + off + h * 128 + c];
  }
  if (w < 2) {
    const int d = w;
    const int row = d ? (row0 + 63 - lane) : (row0 + lane);
    const float Aneg = -__expf(p.a_log[l * 8 + d * 4 + h]);
    const float dtb = p.dt_bias[l * 8 + d * 4 + h];
    float a = AB[(size_t)row * 16 + d * 4 + h];
    float bb = AB[(size_t)row * 16 + 8 + d * 4 + h];
    float xx = a + dtb;
    const float ee = __expf(xx);
    float sp = ee < 0.25f ? ee * (1.f - ee * (0.5f - ee * (0.33333333f - ee * (0.25f - 0.2f * ee))))
                          : (xx > 20.f ? xx : __logf(1.f + ee));
    float g = Aneg * sp;
#pragma unroll
    for (int o = 1; o < 64; o <<= 1) {
      float y = __shfl_up(g, o);
      if (lane >= o) g += y;
    }
    float be = 1.f / (1.f + __expf(-bb));
    sg[d * 64 + lane] = g;
    sbt[d * 64 + lane] = be;
    ((float*)(p.ws + OFF_GC))[(size_t)row * 8 + d * 4 + h] = g;
    ((float*)(p.ws + OFF_BETA))[(size_t)row * 8 + d * 4 + h] = be;
  }
  __syncthreads();
  const int cg = tid & 15, rsub = tid >> 4;
#pragma unroll 1
  for (int type = 0; type < 3; ++type) {
    const int off = type == 0 ? 512 : (type == 1 ? 0 : 1024);
    uint4 xv[4][5];
#pragma unroll
    for (int e = 0; e < 4; ++e) {
      const int row = rsub + 16 * e;
      const bf16_t* base = P + (size_t)(row0 + row) * INWP + C_DN + off + h * 128 + cg * 8;
#pragma unroll
      for (int dd = 0; dd < 5; ++dd) {
        const int r = row0 + row + dd - 2;
        xv[e][dd] = (r >= seq_lo && r < seq_hi) ? *(const uint4*)(base + (dd - 2) * INWP) : make_uint4(0u, 0u, 0u, 0u);
      }
    }
#pragma unroll
    for (int e = 0; e < 4; ++e) {
      const int row = rsub + 16 * e;
      float y[8];
#pragma unroll
      for (int j = 0; j < 8; ++j) y[j] = 0.f;
#pragma unroll
      for (int dd = 0; dd < 5; ++dd) {
        float xf[8];
        unpack8(xv[e][dd], xf);
        const float4 wa = *(const float4*)(sW + dd * 384 + type * 128 + cg * 8);
        const float4 wb = *(const float4*)(sW + dd * 384 + type * 128 + cg * 8 + 4);
        y[0] += wa.x * xf[0]; y[1] += wa.y * xf[1]; y[2] += wa.z * xf[2]; y[3] += wa.w * xf[3];
        y[4] += wb.x * xf[4]; y[5] += wb.y * xf[5]; y[6] += wb.z * xf[6]; y[7] += wb.w * xf[7];
      }
      float ss = 0.f;
#pragma unroll
      for (int j = 0; j < 8; ++j) {
        y[j] = silu_f(y[j]);
        ss += y[j] * y[j];
      }
      if (type < 2) {
        ss += __shfl_xor(ss, 1);
        ss += __shfl_xor(ss, 2);
        ss += __shfl_xor(ss, 4);
        ss += __shfl_xor(ss, 8);
        const float rn = rsqrtf(ss + 1e-6f);
#pragma unroll
        for (int j = 0; j < 8; ++j) y[j] *= rn;
      }
      uint4 u;
      u.x = pack2(y[0], y[1]); u.y = pack2(y[2], y[3]); u.z = pack2(y[4], y[5]); u.w = pack2(y[6], y[7]);
      *(uint4*)(DQ + (size_t)(row0 + row) * 1536 + off + h * 128 + cg * 8) = u;
      if (type == 0) *(uint4*)(sKb + row * 136 + cg * 8) = u;
    }
  }
  __syncthreads();
  {
    const int mi = w >> 1, ni = w & 1;
    f32x16 g;
#pragma unroll
    for (int r = 0; r < 16; ++r) g[r] = 0.f;
#pragma unroll
    for (int ks = 0; ks < 8; ++ks) {
      bf16x8 a = *(const bf16x8*)(sKb + (mi * 32 + li) * 136 + ks * 16 + hh * 8);
      bf16x8 b = *(const bf16x8*)(sKb + (ni * 32 + li) * 136 + ks * 16 + hh * 8);
      g = __builtin_amdgcn_mfma_f32_32x32x16_bf16(a, b, g, 0, 0, 0);
    }
#pragma unroll
    for (int r = 0; r < 16; ++r) {
      const int i = mi * 32 + rowmap(r, hh), m = ni * 32 + li;
      const float G = g[r];
      sL0[i * 68 + m] = (i > m) ? sbt[i] * G * __expf(sg[i] - sg[m]) : 0.f;
      const int i1 = 63 - i, m1 = 63 - m;
      sL1[i1 * 68 + m1] = (i1 > m1) ? sbt[64 + i1] * G * __expf(sg[64 + i1] - sg[64 + m1]) : 0.f;
    }
  }
  __syncthreads();
  if (w < 2) {
    const float* L = w == 0 ? sL0 : sL1;
    float t[64];
#pragma unroll
    for (int i = 0; i < 64; ++i) {
      float a0 = (i == lane) ? 1.f : 0.f, a1 = 0.f, a2 = 0.f, a3 = 0.f;
#pragma unroll
      for (int m = 0; m < i; ++m) {
        const float pr = L[i * 68 + m] * t[m];
        if ((m & 3) == 0) a0 -= pr;
        else if ((m & 3) == 1) a1 -= pr;
        else if ((m & 3) == 2) a2 -= pr;
        else a3 -= pr;
      }
      t[i] = (a0 + a1) + (a2 + a3);
    }
    bf16_t* Tg = (bf16_t*)(p.ws + OFF_OB) + (size_t)((chunk * 4 + h) * 2 + w) * 4096;
#pragma unroll
    for (int i = 0; i < 64; ++i) Tg[i * 64 + lane] = f2bf(t[i]);
  }
}

DEVI bf16x8 ld_perm(const bf16_t* p) {
  union { bf16x8 v; uint2 d[2]; } u;
  u.d[0] = *(const uint2*)(p);
  u.d[1] = *(const uint2*)(p + 8);
  return u.v;
}
DEVI bf16x8 pack8(const f32x16& x, int s) {
  union { bf16x8 v; unsigned w[4]; } u;
  u.w[0] = pack2(x[8 * s + 0], x[8 * s + 1]);
  u.w[1] = pack2(x[8 * s + 2], x[8 * s + 3]);
  u.w[2] = pack2(x[8 * s + 4], x[8 * s + 5]);
  u.w[3] = pack2(x[8 * s + 6], x[8 * s + 7]);
  return u.v;
}

__device__ void dn_scan(const Params& p, int l, int item, char* smem) {
  bf16_t* sK = (bf16_t*)smem;
  bf16_t* sQ = (bf16_t*)(smem + 17408);
  bf16_t* sKT = (bf16_t*)(smem + 34816);
  bf16_t* sT = (bf16_t*)(smem + 52224);
  bf16_t* sA = (bf16_t*)(smem + 60928);
  bf16_t* sV = (bf16_t*)(smem + 52224);
  float* sg = (float*)(smem + 69632);
  float* sbt = sg + 64;
  float* seg = sbt + 64;
  float* sdt = seg + 64;
  const int d = item & 1, h = (item >> 1) & 3, b = item >> 3;
  const bf16_t* DQ = (const bf16_t*)(p.ws + OFF_DNQKV);
  const bf16_t* TB = (const bf16_t*)(p.ws + OFF_OB);
  const float* GC = (const float*)(p.ws + OFF_GC);
  const float* BE = (const float*)(p.ws + OFF_BETA);
  bf16_t* MIX = (bf16_t*)(p.ws + OFF_HM);
  bf16_t* Pw = (bf16_t*)(p.ws + OFF_P);
  const float qscale = 0.08838834764831845f;
  const int rsign = d ? -1 : 1;
  f32x16 S0, S1, S2, S3;
#pragma unroll
  for (int r = 0; r < 16; ++r) { S0[r] = 0.f; S1[r] = 0.f; S2[r] = 0.f; S3[r] = 0.f; }
  __builtin_amdgcn_s_setprio(3);
  uint4 qA0, qB0, kA0, kB0, vA0, vB0, qA1, qB1, kA1, kB1, vA1, vB1, tq0, tq1;
  float pgc = 0.f, pbe = 0.f;
#define SCAN_ROW0(N, CHUNK, ROW0)                                    \
  {                                                                  \
    if ((N) < 4) {                                                   \
      int cn = d ? (3 - (N)) : (N);                                  \
      CHUNK = 256 + b * 4 + cn;                                      \
      ROW0 = M_LAT + b * 256 + cn * 64;                              \
    } else {                                                         \
      int ln = (N)-4;                                                \
      ln = d ? (31 - ln) : ln;                                       \
      CHUNK = b * 32 + ln;                                           \
      ROW0 = b * 2048 + ln * 64;                                     \
    }                                                                \
  }
#define SCAN_LOADS(N)                                                                         \
  {                                                                                           \
    const int tid_ = otid();                                                                  \
    int chunk_, row0_;                                                                        \
    SCAN_ROW0(N, chunk_, row0_)                                                               \
    const int rstart_ = d ? (row0_ + 63) : row0_;                                             \
    {                                                                                         \
      const int u = tid_, c8 = u & 15, tp = u >> 4;                                           \
      const bf16_t* ga = DQ + (size_t)(rstart_ + rsign * 2 * tp) * 1536 + h * 128 + c8 * 8;   \
      const bf16_t* gb = ga + rsign * 1536;                                                   \
      qA0 = *(const uint4*)(ga); kA0 = *(const uint4*)(ga + 512); vA0 = *(const uint4*)(ga + 1024); \
      qB0 = *(const uint4*)(gb); kB0 = *(const uint4*)(gb + 512); vB0 = *(const uint4*)(gb + 1024); \
    }                                                                                         \
    {                                                                                         \
      const int u = tid_ + 256, c8 = u & 15, tp = u >> 4;                                     \
      const bf16_t* ga = DQ + (size_t)(rstart_ + rsign * 2 * tp) * 1536 + h * 128 + c8 * 8;   \
      const bf16_t* gb = ga + rsign * 1536;                                                   \
      qA1 = *(const uint4*)(ga); kA1 = *(const uint4*)(ga + 512); vA1 = *(const uint4*)(ga + 1024); \
      qB1 = *(const uint4*)(gb); kB1 = *(const uint4*)(gb + 512); vB1 = *(const uint4*)(gb + 1024); \
    }                                                                                         \
    {                                                                                         \
      const bf16_t* Tg = TB + (size_t)((chunk_ * 4 + h) * 2 + d) * 4096;                      \
      tq0 = *(const uint4*)(Tg + (tid_ >> 3) * 64 + (tid_ & 7) * 8);                          \
      tq1 = *(const uint4*)(Tg + ((tid_ >> 3) + 32) * 64 + (tid_ & 7) * 8);                   \
    }                                                                                         \
    if (tid_ < 64) {                                                                          \
      const int row = rstart_ + rsign * tid_;                                                 \
      pgc = GC[(size_t)row * 8 + d * 4 + h];                                                  \
      pbe = BE[(size_t)row * 8 + d * 4 + h];                                                  \
    }                                                                                         \
  }
  SCAN_LOADS(0)
  for (int n = 0; n < 36; ++n) {
    const int tid = otid(), lane = tid & 63, w = tid >> 6, li = lane & 31, hh = lane >> 5;
    int chunk, row0;
    SCAN_ROW0(n, chunk, row0)
    (void)chunk;
    const int rstart = d ? (row0 + 63) : row0;
    __syncthreads();
#define STAGE_UNIT(U, QA, QB, KA, KB, VA, VB)                                                   \
  {                                                                                             \
    const int c8 = (U)&15, tp = (U) >> 4;                                                       \
    *(uint4*)(sQ + (2 * tp) * 136 + c8 * 8) = QA;                                               \
    *(uint4*)(sQ + (2 * tp + 1) * 136 + c8 * 8) = QB;                                           \
    *(uint4*)(sK + (2 * tp) * 136 + c8 * 8) = KA;                                               \
    *(uint4*)(sK + (2 * tp + 1) * 136 + c8 * 8) = KB;                                           \
    *(uint4*)(sV + (2 * tp) * 136 + c8 * 8) = VA;                                               \
    *(uint4*)(sV + (2 * tp + 1) * 136 + c8 * 8) = VB;                                           \
    unsigned* kt = (unsigned*)(sKT + (c8 * 8) * 68 + 2 * tp);                                   \
    kt[0 * 34] = (KA.x & 0xffffu) | (KB.x << 16);                                               \
    kt[1 * 34] = (KA.x >> 16) | (KB.x & 0xffff0000u);                                           \
    kt[2 * 34] = (KA.y & 0xffffu) | (KB.y << 16);                                               \
    kt[3 * 34] = (KA.y >> 16) | (KB.y & 0xffff0000u);                                           \
    kt[4 * 34] = (KA.z & 0xffffu) | (KB.z << 16);                                               \
    kt[5 * 34] = (KA.z >> 16) | (KB.z & 0xffff0000u);                                           \
    kt[6 * 34] = (KA.w & 0xffffu) | (KB.w << 16);                                               \
    kt[7 * 34] = (KA.w >> 16) | (KB.w & 0xffff0000u);                                           \
  }
    STAGE_UNIT(tid, qA0, qB0, kA0, kB0, vA0, vB0)
    STAGE_UNIT(tid + 256, qA1, qB1, kA1, kB1, vA1, vB1)
#undef STAGE_UNIT
    if (tid < 64) {
      float g63 = __shfl(pgc, 63);
      sg[lane] = pgc;
      sbt[lane] = pbe;
      seg[lane] = __expf(pgc);
      sdt[lane] = __expf(g63 - pgc);
    }
    __syncthreads();
    f32x16 v0, v1;
#pragma unroll
    for (int r = 0; r < 16; ++r) {
      const int t0 = rowmap(r, hh);
      v0[r] = bf2f(sV[t0 * 136 + w * 32 + li]);
      v1[r] = bf2f(sV[(32 + t0) * 136 + w * 32 + li]);
    }
    __syncthreads();
    {
      const int i0 = tid >> 3, c8 = tid & 7;
      *(uint2*)(sT + i0 * 68 + c8 * 8) = make_uint2(tq0.x, tq0.y);
      *(uint2*)(sT + i0 * 68 + c8 * 8 + 4) = make_uint2(tq0.z, tq0.w);
      *(uint2*)(sT + (i0 + 32) * 68 + c8 * 8) = make_uint2(tq1.x, tq1.y);
      *(uint2*)(sT + (i0 + 32) * 68 + c8 * 8 + 4) = make_uint2(tq1.z, tq1.w);
    }
    {
      const int mi = w >> 1, ni = w & 1;
      f32x16 a;
#pragma unroll
      for (int r = 0; r < 16; ++r) a[r] = 0.f;
      if (!(mi == 0 && ni == 1)) {
#pragma unroll
        for (int ks = 0; ks < 8; ++ks) {
          bf16x8 qa = *(const bf16x8*)(sQ + (mi * 32 + li) * 136 + ks * 16 + hh * 8);
          bf16x8 kb = *(const bf16x8*)(sK + (ni * 32 + li) * 136 + ks * 16 + hh * 8);
          a = __builtin_amdgcn_mfma_f32_32x32x16_bf16(qa, kb, a, 0, 0, 0);
        }
      }
#pragma unroll
      for (int r = 0; r < 16; ++r) {
        const int i = mi * 32 + rowmap(r, hh), j = ni * 32 + li;
        float val = (i >= j) ? a[r] * qscale * __expf(sg[i] - sg[j]) : 0.f;
        sA[i * 68 + j] = f2bf(val);
      }
    }
    __syncthreads();
    f32x16 ks0, ks1;
#pragma unroll
    for (int r = 0; r < 16; ++r) { ks0[r] = 0.f; ks1[r] = 0.f; }
    {
      const bf16_t* ka = sK + li * 136 + 4 * hh;
#define K_STEP(OFFS, SX, SS)                                                                           \
  {                                                                                                    \
    bf16x8 sb = pack8(SX, SS);                                                                         \
    ks0 = __builtin_amdgcn_mfma_f32_32x32x16_bf16(ld_perm(ka + (OFFS)), sb, ks0, 0, 0, 0);             \
    ks1 = __builtin_amdgcn_mfma_f32_32x32x16_bf16(ld_perm(ka + 32 * 136 + (OFFS)), sb, ks1, 0, 0, 0);  \
  }
      K_STEP(0, S0, 0) K_STEP(16, S0, 1) K_STEP(32, S1, 0) K_STEP(48, S1, 1)
      K_STEP(64, S2, 0) K_STEP(80, S2, 1) K_STEP(96, S3, 0) K_STEP(112, S3, 1)
#undef K_STEP
    }
#pragma unroll
    for (int r = 0; r < 16; ++r) {
      const int t0 = rowmap(r, hh), t1 = 32 + t0;
      v0[r] = sbt[t0] * (v0[r] - seg[t0] * ks0[r]);
      v1[r] = sbt[t1] * (v1[r] - seg[t1] * ks1[r]);
    }
    __builtin_amdgcn_sched_barrier(0);
    bf16x8 rb00 = pack8(v0, 0), rb01 = pack8(v0, 1), rb10 = pack8(v1, 0), rb11 = pack8(v1, 1);
    f32x16 n0, n1;
#pragma unroll
    for (int r = 0; r < 16; ++r) { n0[r] = 0.f; n1[r] = 0.f; }
    {
      const bf16_t* ta = sT + li * 68 + 4 * hh;
      n0 = __builtin_amdgcn_mfma_f32_32x32x16_bf16(ld_perm(ta + 0), rb00, n0, 0, 0, 0);
      n0 = __builtin_amdgcn_mfma_f32_32x32x16_bf16(ld_perm(ta + 16), rb01, n0, 0, 0, 0);
      const bf16_t* tb = ta + 32 * 68;
      n1 = __builtin_amdgcn_mfma_f32_32x32x16_bf16(ld_perm(tb + 0), rb00, n1, 0, 0, 0);
      n1 = __builtin_amdgcn_mfma_f32_32x32x16_bf16(ld_perm(tb + 16), rb01, n1, 0, 0, 0);
      n1 = __builtin_amdgcn_mfma_f32_32x32x16_bf16(ld_perm(tb + 32), rb10, n1, 0, 0, 0);
      n1 = __builtin_amdgcn_mfma_f32_32x32x16_bf16(ld_perm(tb + 48), rb11, n1, 0, 0, 0);
    }
    __builtin_amdgcn_sched_barrier(0);
    f32x16 o0, o1;
#pragma unroll
    for (int r = 0; r < 16; ++r) { o0[r] = 0.f; o1[r] = 0.f; }
    {
      const bf16_t* qa = sQ + li * 136 + 4 * hh;
#define Q_STEP(OFFS, SX, SS)                                                                           \
  {                                                                                                    \
    bf16x8 sb = pack8(SX, SS);                                                                         \
    o0 = __builtin_amdgcn_mfma_f32_32x32x16_bf16(ld_perm(qa + (OFFS)), sb, o0, 0, 0, 0);               \
    o1 = __builtin_amdgcn_mfma_f32_32x32x16_bf16(ld_perm(qa + 32 * 136 + (OFFS)), sb, o1, 0, 0, 0);    \
  }
      Q_STEP(0, S0, 0) Q_STEP(16, S0, 1) Q_STEP(32, S1, 0) Q_STEP(48, S1, 1)
      Q_STEP(64, S2, 0) Q_STEP(80, S2, 1) Q_STEP(96, S3, 0) Q_STEP(112, S3, 1)
#undef Q_STEP
    }
#pragma unroll
    for (int r = 0; r < 16; ++r) {
      const int t0 = rowmap(r, hh), t1 = 32 + t0;
      o0[r] *= seg[t0] * qscale;
      o1[r] *= seg[t1] * qscale;
    }
    {
      bf16x8 nb00 = pack8(n0, 0), nb01 = pack8(n0, 1), nb10 = pack8(n1, 0), nb11 = pack8(n1, 1);
      const bf16_t* aa = sA + li * 68 + 4 * hh;
      o0 = __builtin_amdgcn_mfma_f32_32x32x16_bf16(ld_perm(aa + 0), nb00, o0, 0, 0, 0);
      o0 = __builtin_amdgcn_mfma_f32_32x32x16_bf16(ld_perm(aa + 16), nb01, o0, 0, 0, 0);
      const bf16_t* ab = aa + 32 * 68;
      o1 = __builtin_amdgcn_mfma_f32_32x32x16_bf16(ld_perm(ab + 0), nb00, o1, 0, 0, 0);
      o1 = __builtin_amdgcn_mfma_f32_32x32x16_bf16(ld_perm(ab + 16), nb01, o1, 0, 0, 0);
      o1 = __builtin_amdgcn_mfma_f32_32x32x16_bf16(ld_perm(ab + 32), nb10, o1, 0, 0, 0);
      o1 = __builtin_amdgcn_mfma_f32_32x32x16_bf16(ld_perm(ab + 48), nb11, o1, 0, 0, 0);
    }
    __syncthreads();
#pragma unroll
    for (int r = 0; r < 16; ++r) {
      const int t0 = rowmap(r, hh);
      sQ[t0 * 136 + w * 32 + li] = f2bf(o0[r]);
      sQ[(32 + t0) * 136 + w * 32 + li] = f2bf(o1[r]);
    }
#pragma unroll
    for (int r = 0; r < 16; ++r) {
      const int t0 = rowmap(r, hh), t1 = 32 + t0;
      n0[r] *= sdt[t0];
      n1[r] *= sdt[t1];
    }
    {
      bf16x8 nb00 = pack8(n0, 0), nb01 = pack8(n0, 1), nb10 = pack8(n1, 0), nb11 = pack8(n1, 1);
      const float eg63 = seg[63];
#pragma unroll
      for (int r = 0; r < 16; ++r) { S0[r] *= eg63; S1[r] *= eg63; S2[r] *= eg63; S3[r] *= eg63; }
      __builtin_amdgcn_sched_barrier(0);
      SCAN_LOADS(min(n + 1, 35))
      __builtin_amdgcn_sched_barrier(0);
      const bf16_t* kt = sKT + li * 68 + 4 * hh;
#define S_UPD(SX, DKT)                                                                                   \
  SX = __builtin_amdgcn_mfma_f32_32x32x16_bf16(ld_perm(kt + (DKT) * 32 * 68 + 0), nb00, SX, 0, 0, 0);    \
  SX = __builtin_amdgcn_mfma_f32_32x32x16_bf16(ld_perm(kt + (DKT) * 32 * 68 + 16), nb01, SX, 0, 0, 0);   \
  SX = __builtin_amdgcn_mfma_f32_32x32x16_bf16(ld_perm(kt + (DKT) * 32 * 68 + 32), nb10, SX, 0, 0, 0);   \
  SX = __builtin_amdgcn_mfma_f32_32x32x16_bf16(ld_perm(kt + (DKT) * 32 * 68 + 48), nb11, SX, 0, 0, 0);
      S_UPD(S0, 0) S_UPD(S1, 1) S_UPD(S2, 2) S_UPD(S3, 3)
#undef S_UPD
    }
    __syncthreads();
    {
      bf16_t* obase = d ? (Pw + C_DN + h * 128) : (MIX + 512 + h * 128);
      const int ostride = d ? INWP : 1024;
#pragma unroll
      for (int e = 0; e < 4; ++e) {
        const int idx = tid + 256 * e, tok = idx >> 4, c8 = idx & 15;
        const int row = rstart + rsign * tok;
        *(uint4*)(obase + (size_t)row * ostride + c8 * 8) = *(const uint4*)(sQ + tok * 136 + c8 * 8);
      }
    }
  }
#undef SCAN_LOADS
#undef SCAN_ROW0
  __builtin_amdgcn_s_setprio(0);
}

__device__ void phaseC(const Params& p, int l, char* smem) {
  const int nb = gridDim.x, bid = blockIdx.x;
  const bf16_t* P = (const bf16_t*)(p.ws + OFF_P);
  constexpr int T0 = 1152, T1 = T0 + 144 * 3, T2 = T1 + 144 * 4, T3 = T2 + M_ALL / 8;
  for (int it = bid; it < T3; it += nb) {
    if (it < T0) {
      dn_chunk_prep(p, l, it, smem);
    } else if (it < T1) {
      int i = it - T0;
      if (l == 3 && i >= 128 * 3) continue;
      gemm_tile<EPI_QUP>(p, l, P + C_MQ, INWP, (const bf16_t*)(p.ws + OFF_WQUP), 256, (i / 3) * 128, (i % 3) * 128, 0,
                         smem);
    } else if (it < T2) {
      int i = it - T1;
      gemm_tile<EPI_KVUP>(p, l, P + C_MKV, INWP, (const bf16_t*)(p.ws + OFF_WKVUP), 128, (i / 4) * 128, (i % 4) * 128,
                          0, smem);
    } else {
      kpe_item(p, it - T2);
    }
  }
}

__device__ void mla_flash(const Params& p, int item, char* smem) {
  bf16_t* sK = (bf16_t*)smem;
  bf16_t* sV = sK + 64 * 104;
  const int tid = otid(), lane = tid & 63, w = tid >> 6;
  const int li = lane & 31, hh = lane >> 5;
  int b, h, q0row, nkeys;
  if (item < 512) {
    b = item >> 6; h = (item >> 4) & 3; q0row = b * 2048 + (item & 15) * 128; nkeys = 2304;
  } else {
    int i = item - 512;
    b = i >> 3; h = (i >> 1) & 3; q0row = M_LAT + b * 256 + (i & 1) * 128; nkeys = 256;
  }
  const bf16_t* Kg = (const bf16_t*)(p.ws + OFF_KH) + (size_t)(b * 4 + h) * 2304 * 96;
  const bf16_t* Vg = (const bf16_t*)(p.ws + OFF_VH) + (size_t)(b * 4 + h) * 64 * 2304;
  const bf16_t* QH = (const bf16_t*)(p.ws + OFF_QH);
  bf16_t* MIX = (bf16_t*)(p.ws + OFF_HM);
  const int qrow = q0row + w * 32 + li;
  bf16x8 qf0, qf1, qf2, qf3, qf4, qf5;
  {
    const bf16_t* qp = QH + (size_t)qrow * 384 + h * 96 + hh * 8;
    qf0 = *(const bf16x8*)(qp); qf1 = *(const bf16x8*)(qp + 16); qf2 = *(const bf16x8*)(qp + 32);
    qf3 = *(const bf16x8*)(qp + 48); qf4 = *(const bf16x8*)(qp + 64); qf5 = *(const bf16x8*)(qp + 80);
  }
  const int k_i0 = tid, k_i1 = tid + 256, k_i2 = tid + 512;
  const int kk0 = k_i0 / 12, kc0 = k_i0 % 12, kk1 = k_i1 / 12, kc1 = k_i1 % 12, kk2 = k_i2 / 12, kc2 = k_i2 % 12;
  const int vd0 = tid >> 3, vc0 = tid & 7, vd1 = vd0 + 32;
  uint4 rk0, rk1, rk2, rv0, rv1;
  rk0 = *(const uint4*)(Kg + (size_t)kk0 * 96 + kc0 * 8);
  rk1 = *(const uint4*)(Kg + (size_t)kk1 * 96 + kc1 * 8);
  rk2 = *(const uint4*)(Kg + (size_t)kk2 * 96 + kc2 * 8);
  rv0 = *(const uint4*)(Vg + (size_t)vd0 * 2304 + vc0 * 8);
  rv1 = *(const uint4*)(Vg + (size_t)vd1 * 2304 + vc0 * 8);
  f32x16 o0, o1;
#pragma unroll
  for (int r = 0; r < 16; ++r) { o0[r] = 0.f; o1[r] = 0.f; }
  float m = -1e30f, lp = 0.f;
  const float sc = 0.10206207261596577f * 1.4426950408889634f;
  const int nt = nkeys >> 6;
  for (int t = 0; t < nt; ++t) {
    __syncthreads();
    *(uint4*)(sK + kk0 * 104 + kc0 * 8) = rk0;
    *(uint4*)(sK + kk1 * 104 + kc1 * 8) = rk1;
    *(uint4*)(sK + kk2 * 104 + kc2 * 8) = rk2;
    *(uint2*)(sV + vd0 * 68 + vc0 * 8) = make_uint2(rv0.x, rv0.y);
    *(uint2*)(sV + vd0 * 68 + vc0 * 8 + 4) = make_uint2(rv0.z, rv0.w);
    *(uint2*)(sV + vd1 * 68 + vc0 * 8) = make_uint2(rv1.x, rv1.y);
    *(uint2*)(sV + vd1 * 68 + vc0 * 8 + 4) = make_uint2(rv1.z, rv1.w);
    __syncthreads();
    if (t + 1 < nt) {
      const int k0 = (t + 1) * 64;
      rk0 = *(const uint4*)(Kg + (size_t)(k0 + kk0) * 96 + kc0 * 8);
      rk1 = *(const uint4*)(Kg + (size_t)(k0 + kk1) * 96 + kc1 * 8);
      rk2 = *(const uint4*)(Kg + (size_t)(k0 + kk2) * 96 + kc2 * 8);
      rv0 = *(const uint4*)(Vg + (size_t)vd0 * 2304 + k0 + vc0 * 8);
      rv1 = *(const uint4*)(Vg + (size_t)vd1 * 2304 + k0 + vc0 * 8);
    }
    f32x16 s0, s1;
#pragma unroll
    for (int r = 0; r < 16; ++r) { s0[r] = 0.f; s1[r] = 0.f; }
    {
      const bf16_t* ka = sK + li * 104 + hh * 8;
      const bf16_t* kb = ka + 32 * 104;
      s0 = __builtin_amdgcn_mfma_f32_32x32x16_bf16(*(const bf16x8*)(ka), qf0, s0, 0, 0, 0);
      s1 = __builtin_amdgcn_mfma_f32_32x32x16_bf16(*(const bf16x8*)(kb), qf0, s1, 0, 0, 0);
      s0 = __builtin_amdgcn_mfma_f32_32x32x16_bf16(*(const bf16x8*)(ka + 16), qf1, s0, 0, 0, 0);
      s1 = __builtin_amdgcn_mfma_f32_32x32x16_bf16(*(const bf16x8*)(kb + 16), qf1, s1, 0, 0, 0);
      s0 = __builtin_amdgcn_mfma_f32_32x32x16_bf16(*(const bf16x8*)(ka + 32), qf2, s0, 0, 0, 0);
      s1 = __builtin_amdgcn_mfma_f32_32x32x16_bf16(*(const bf16x8*)(kb + 32), qf2, s1, 0, 0, 0);
      s0 = __builtin_amdgcn_mfma_f32_32x32x16_bf16(*(const bf16x8*)(ka + 48), qf3, s0, 0, 0, 0);
      s1 = __builtin_amdgcn_mfma_f32_32x32x16_bf16(*(const bf16x8*)(kb + 48), qf3, s1, 0, 0, 0);
      s0 = __builtin_amdgcn_mfma_f32_32x32x16_bf16(*(const bf16x8*)(ka + 64), qf4, s0, 0, 0, 0);
      s1 = __builtin_amdgcn_mfma_f32_32x32x16_bf16(*(const bf16x8*)(kb + 64), qf4, s1, 0, 0, 0);
      s0 = __builtin_amdgcn_mfma_f32_32x32x16_bf16(*(const bf16x8*)(ka + 80), qf5, s0, 0, 0, 0);
      s1 = __builtin_amdgcn_mfma_f32_32x32x16_bf16(*(const bf16x8*)(kb + 80), qf5, s1, 0, 0, 0);
    }
    float mx = s0[0];
#pragma unroll
    for (int r = 1; r < 16; ++r) mx = fmaxf(mx, s0[r]);
#pragma unroll
    for (int r = 0; r < 16; ++r) mx = fmaxf(mx, s1[r]);
    mx = fmaxf(mx, __shfl_xor(mx, 32));
    const float mn = fmaxf(m, mx * sc);
    const float corr = __builtin_amdgcn_exp2f(m - mn);
    m = mn;
    lp *= corr;
#pragma unroll
    for (int r = 0; r < 16; ++r) { o0[r] *= corr; o1[r] *= corr; }
#pragma unroll
    for (int r = 0; r < 16; ++r) {
      s0[r] = __builtin_amdgcn_exp2f(s0[r] * sc - mn);
      s1[r] = __builtin_amdgcn_exp2f(s1[r] * sc - mn);
      lp += s0[r] + s1[r];
    }
#pragma unroll
    for (int u = 0; u < 2; ++u) {
#pragma unroll
      for (int s = 0; s < 2; ++s) {
        union { bf16x8 v; unsigned w[4]; } pb;
        if (u == 0) {
          pb.w[0] = pack2(s0[8 * s + 0], s0[8 * s + 1]); pb.w[1] = pack2(s0[8 * s + 2], s0[8 * s + 3]);
          pb.w[2] = pack2(s0[8 * s + 4], s0[8 * s + 5]); pb.w[3] = pack2(s0[8 * s + 6], s0[8 * s + 7]);
        } else {
          pb.w[0] = pack2(s1[8 * s + 0], s1[8 * s + 1]); pb.w[1] = pack2(s1[8 * s + 2], s1[8 * s + 3]);
          pb.w[2] = pack2(s1[8 * s + 4], s1[8 * s + 5]); pb.w[3] = pack2(s1[8 * s + 6], s1[8 * s + 7]);
        }
        const bf16_t* va = sV + li * 68 + 32 * u + 16 * s + 4 * hh;
        union { bf16x8 v; uint2 d[2]; } a0, a1;
        a0.d[0] = *(const uint2*)(va);
        a0.d[1] = *(const uint2*)(va + 8);
        a1.d[0] = *(const uint2*)(va + 32 * 68);
        a1.d[1] = *(const uint2*)(va + 32 * 68 + 8);
        o0 = __builtin_amdgcn_mfma_f32_32x32x16_bf16(a0.v, pb.v, o0, 0, 0, 0);
        o1 = __builtin_amdgcn_mfma_f32_32x32x16_bf16(a1.v, pb.v, o1, 0, 0, 0);
      }
    }
  }
  lp += __shfl_xor(lp, 32);
  const float inv = 1.f / lp;
  bf16_t* op = MIX + (size_t)qrow * 1024 + h * 64 + 4 * hh;
#pragma unroll
  for (int g = 0; g < 4; ++g) {
    uint2 u0, u1;
    u0.x = pack2(o0[4 * g + 0] * inv, o0[4 * g + 1] * inv);
    u0.y = pack2(o0[4 * g + 2] * inv, o0[4 * g + 3] * inv);
    u1.x = pack2(o1[4 * g + 0] * inv, o1[4 * g + 1] * inv);
    u1.y = pack2(o1[4 * g + 2] * inv, o1[4 * g + 3] * inv);
    *(uint2*)(op + 8 * g) = u0;
    *(uint2*)(op + 32 + 8 * g) = u1;
  }
}

__device__ void na_naive(const Params& p, int l, int ti) {
  const int h = otid() >> 6, lane = otid() & 63;
  const bf16_t* P = (const bf16_t*)(p.ws + OFF_P);
  bf16_t* MIX = (bf16_t*)(p.ws + OFF_HM);
  const bool lat = ti < 256;
  const int b = lat ? (ti >> 5) : ((ti - 256) >> 2);
  const int r = ti & 31;
  const int row = lat ? (ti * 64 + lane) : (M_LAT + (ti - 256) * 64 + lane);
  uint4 qk[8];
  float acc[64];
  {
    const uint4* qp = (const uint4*)(P + (size_t)row * INWP + C_NQ + h * 64);
#pragma unroll
    for (int c = 0; c < 8; ++c) qk[c] = qp[c];
  }
#pragma unroll
  for (int i = 0; i < 64; ++i) acc[i] = 0.f;
  float m = -INFINITY, ls = 0.f;
  const int qc = lane;
  const int rs0 = min(max(r - 4, 0), 24);
  const int cs0 = min(max(qc - 8, 0), 48);
  const float* rb = p.rel_bias + (size_t)l * 4 * 15 * 31 + h * 15 * 31;
  const int nloc = lat ? 128 : 0;
  for (int j = 0; j < nloc + 256; ++j) {
    int krow;
    float bias = 0.f;
    if (j < nloc) {
      int kr = rs0 + (j >> 4), kc = cs0 + (j & 15);
      krow = b * 2048 + kr * 64 + kc;
      bias = rb[(kr - r + 7) * 31 + (kc - qc + 15)];
    } else {
      krow = M_LAT + b * 256 + (j - nloc);
    }
    const uint4* kp = (const uint4*)(P + (size_t)krow * INWP + C_NK + h * 64);
    float s = 0.f;
#pragma unroll
    for (int c = 0; c < 8; ++c) {
      uint4 u = kp[c];
      uint4 q = qk[c];
      s += bflo(q.x) * bflo(u.x) + bfhi(q.x) * bfhi(u.x) + bflo(q.y) * bflo(u.y) + bfhi(q.y) * bfhi(u.y) +
           bflo(q.z) * bflo(u.z) + bfhi(q.z) * bfhi(u.z) + bflo(q.w) * bflo(u.w) + bfhi(q.w) * bfhi(u.w);
    }
    s = s * 0.125f + bias;
    float mn = fmaxf(m, s);
    float corr = __expf(m - mn), pe = __expf(s - mn);
    ls = ls * corr + pe;
    m = mn;
    const uint4* vp = (const uint4*)(P + (size_t)krow * INWP + C_NV + h * 64);
#pragma unroll
    for (int c = 0; c < 8; ++c) {
      uint4 u = vp[c];
      acc[c * 8 + 0] = acc[c * 8 + 0] * corr + pe * bflo(u.x);
      acc[c * 8 + 1] = acc[c * 8 + 1] * corr + pe * bfhi(u.x);
      acc[c * 8 + 2] = acc[c * 8 + 2] * corr + pe * bflo(u.y);
      acc[c * 8 + 3] = acc[c * 8 + 3] * corr + pe * bfhi(u.y);
      acc[c * 8 + 4] = acc[c * 8 + 4] * corr + pe * bflo(u.z);
      acc[c * 8 + 5] = acc[c * 8 + 5] * corr + pe * bfhi(u.z);
      acc[c * 8 + 6] = acc[c * 8 + 6] * corr + pe * bflo(u.w);
      acc[c * 8 + 7] = acc[c * 8 + 7] * corr + pe * bfhi(u.w);
    }
  }
  const float inv = 1.f / ls;
  uint4* op = (uint4*)(MIX + (size_t)row * 1024 + 256 + h * 64);
#pragma unroll
  for (int c = 0; c < 8; ++c) {
    uint4 u;
    u.x = pack2(acc[c * 8 + 0] * inv, acc[c * 8 + 1] * inv);
    u.y = pack2(acc[c * 8 + 2] * inv, acc[c * 8 + 3] * inv);
    u.z = pack2(acc[c * 8 + 4] * inv, acc[c * 8 + 5] * inv);
    u.w = pack2(acc[c * 8 + 6] * inv, acc[c * 8 + 7] * inv);
    op[c] = u;
  }
}

__device__ void na_flash(const Params& p, int l, int item, char* smem) {
  bf16_t* sK = (bf16_t*)smem;
  bf16_t* sV = sK + 64 * 72;
  float* sBias = (float*)(smem + 18432);
  const int tid = otid(), lane = tid & 63, w = tid >> 6;
  const int li = lane & 31, hh = lane >> 5;
  const bf16_t* P = (const bf16_t*)(p.ws + OFF_P);
  bf16_t* MIX = (bf16_t*)(p.ws + OFF_HM);
  int b, h, qrow, qr = 0, qc = 0, rs0 = 0, ntiles, krow0 = 0;
  bool lat;
  if (item < 512) {
    lat = true;
    b = item >> 6; h = item & 3;
    const int r0 = ((item >> 2) & 15) * 2;
    qr = r0 + (w >> 1); qc = (w & 1) * 32 + li;
    qrow = b * 2048 + qr * 64 + qc;
    krow0 = min(max(r0 - 4, 0), 24);
    const int klast = min(max(r0 + 1 - 4, 0), 24) + 7;
    ntiles = 4 + (klast - krow0 + 1);
    rs0 = min(max(qr - 4, 0), 24);
  } else {
    lat = false;
    const int i = item - 512;
    b = i >> 3; h = i & 3;
    qrow = M_LAT + b * 256 + ((i >> 2) & 1) * 128 + w * 32 + li;
    ntiles = 4;
  }
  const int cs0 = min(max(qc - 8, 0), 48);
  const bf16_t* Vg = (const bf16_t*)(p.ws + OFF_NVT) + (size_t)(b * 4 + h) * 64 * 2304;
  bf16x8 qf0, qf1, qf2, qf3;
  {
    const bf16_t* qp = P + (size_t)qrow * INWP + C_NQ + h * 64 + hh * 8;
    qf0 = *(const bf16x8*)(qp); qf1 = *(const bf16x8*)(qp + 16); qf2 = *(const bf16x8*)(qp + 32); qf3 = *(const bf16x8*)(qp + 48);
  }
  __syncthreads();
  for (int i = tid; i < 465; i += 256)
    sBias[i] = p.rel_bias[(size_t)l * 4 * 465 + h * 465 + i] * 1.4426950408889634f;
  const int kk0 = tid >> 3, kc8 = tid & 7, kk1 = kk0 + 32;
  uint4 rk0, rk1, rv0, rv1;
  {
    const size_t kr = (size_t)(M_LAT + b * 256);
    rk0 = *(const uint4*)(P + (kr + kk0) * INWP + C_NK + h * 64 + kc8 * 8);
    rk1 = *(const uint4*)(P + (kr + kk1) * INWP + C_NK + h * 64 + kc8 * 8);
    rv0 = *(const uint4*)(Vg + (size_t)kk0 * 2304 + kc8 * 8);
    rv1 = *(const uint4*)(Vg + (size_t)kk1 * 2304 + kc8 * 8);
  }
  f32x16 o0, o1;
#pragma unroll
  for (int r = 0; r < 16; ++r) { o0[r] = 0.f; o1[r] = 0.f; }
  float m = -1e30f, lp = 0.f;
  const float sc = 0.125f * 1.4426950408889634f;
  for (int t = 0; t < ntiles; ++t) {
    __syncthreads();
    *(uint4*)(sK + kk0 * 72 + kc8 * 8) = rk0;
    *(uint4*)(sK + kk1 * 72 + kc8 * 8) = rk1;
    *(uint2*)(sV + kk0 * 68 + kc8 * 8) = make_uint2(rv0.x, rv0.y);
    *(uint2*)(sV + kk0 * 68 + kc8 * 8 + 4) = make_uint2(rv0.z, rv0.w);
    *(uint2*)(sV + kk1 * 68 + kc8 * 8) = make_uint2(rv1.x, rv1.y);
    *(uint2*)(sV + kk1 * 68 + kc8 * 8 + 4) = make_uint2(rv1.z, rv1.w);
    __syncthreads();
    if (t + 1 < ntiles) {
      const int tn = t + 1;
      size_t kr;
      int vk;
      if (tn < 4) { kr = (size_t)(M_LAT + b * 256 + tn * 64); vk = tn * 64; }
      else { kr = (size_t)(b * 2048 + (krow0 + tn - 4) * 64); vk = 256 + (krow0 + tn - 4) * 64; }
      rk0 = *(const uint4*)(P + (kr + kk0) * INWP + C_NK + h * 64 + kc8 * 8);
      rk1 = *(const uint4*)(P + (kr + kk1) * INWP + C_NK + h * 64 + kc8 * 8);
      rv0 = *(const uint4*)(Vg + (size_t)kk0 * 2304 + vk + kc8 * 8);
      rv1 = *(const uint4*)(Vg + (size_t)kk1 * 2304 + vk + kc8 * 8);
    }
    const int kr_abs = krow0 + t - 4;
    const bool local = t >= 4;
    if (local && (kr_abs < rs0 || kr_abs >= rs0 + 8)) continue;
    f32x16 s0, s1;
#pragma unroll
    for (int r = 0; r < 16; ++r) { s0[r] = 0.f; s1[r] = 0.f; }
    {
      const bf16_t* ka = sK + li * 72 + hh * 8;
      const bf16_t* kb = ka + 32 * 72;
      s0 = __builtin_amdgcn_mfma_f32_32x32x16_bf16(*(const bf16x8*)(ka), qf0, s0, 0, 0, 0);
      s1 = __builtin_amdgcn_mfma_f32_32x32x16_bf16(*(const bf16x8*)(kb), qf0, s1, 0, 0, 0);
      s0 = __builtin_amdgcn_mfma_f32_32x32x16_bf16(*(const bf16x8*)(ka + 16), qf1, s0, 0, 0, 0);
      s1 = __builtin_amdgcn_mfma_f32_32x32x16_bf16(*(const bf16x8*)(kb + 16), qf1, s1, 0, 0, 0);
      s0 = __builtin_amdgcn_mfma_f32_32x32x16_bf16(*(const bf16x8*)(ka + 32), qf2, s0, 0, 0, 0);
      s1 = __builtin_amdgcn_mfma_f32_32x32x16_bf16(*(const bf16x8*)(kb + 32), qf2, s1, 0, 0, 0);
      s0 = __builtin_amdgcn_mfma_f32_32x32x16_bf16(*(const bf16x8*)(ka + 48), qf3, s0, 0, 0, 0);
      s1 = __builtin_amdgcn_mfma_f32_32x32x16_bf16(*(const bf16x8*)(kb + 48), qf3, s1, 0, 0, 0);
    }
    if (local) {
      const float* bp = sBias + (kr_abs - qr + 7) * 31 - qc + 15;
#pragma unroll
      for (int r = 0; r < 16; ++r) {
        const int kc0 = rowmap(r, hh), kc1 = 32 + kc0;
        const bool v0 = (kc0 >= cs0) && (kc0 < cs0 + 16);
        const bool v1 = (kc1 >= cs0) && (kc1 < cs0 + 16);
        const float b0 = v0 ? bp[kc0] : 0.f;
        const float b1 = v1 ? bp[kc1] : 0.f;
        s0[r] = v0 ? (s0[r] * sc + b0) : -1e30f;
        s1[r] = v1 ? (s1[r] * sc + b1) : -1e30f;
      }
    } else {
#pragma unroll
      for (int r = 0; r < 16; ++r) { s0[r] *= sc; s1[r] *= sc; }
    }
    float mx = s0[0];
#pragma unroll
    for (int r = 1; r < 16; ++r) mx = fmaxf(mx, s0[r]);
#pragma unroll
    for (int r = 0; r < 16; ++r) mx = fmaxf(mx, s1[r]);
    mx = fmaxf(mx, __shfl_xor(mx, 32));
    const float mn = fmaxf(m, mx);
    const float corr = __builtin_amdgcn_exp2f(m - mn);
    m = mn;
    lp *= corr;
#pragma unroll
    for (int r = 0; r < 16; ++r) { o0[r] *= corr; o1[r] *= corr; }
#pragma unroll
    for (int r = 0; r < 16; ++r) {
      s0[r] = __builtin_amdgcn_exp2f(s0[r] - mn);
      s1[r] = __builtin_amdgcn_exp2f(s1[r] - mn);
      lp += s0[r] + s1[r];
    }
#pragma unroll
    for (int u = 0; u < 2; ++u) {
#pragma unroll
      for (int s = 0; s < 2; ++s) {
        bf16x8 pb = u == 0 ? pack8(s0, s) : pack8(s1, s);
        const bf16_t* va = sV + li * 68 + 32 * u + 16 * s + 4 * hh;
        o0 = __builtin_amdgcn_mfma_f32_32x32x16_bf16(ld_perm(va), pb, o0, 0, 0, 0);
        o1 = __builtin_amdgcn_mfma_f32_32x32x16_bf16(ld_perm(va + 32 * 68), pb, o1, 0, 0, 0);
      }
    }
  }
  lp += __shfl_xor(lp, 32);
  const float inv = 1.f / lp;
  bf16_t* op = MIX + (size_t)qrow * 1024 + 256 + h * 64 + 4 * hh;
#pragma unroll
  for (int g = 0; g < 4; ++g) {
    uint2 u0, u1;
    u0.x = pack2(o0[4 * g + 0] * inv, o0[4 * g + 1] * inv);
    u0.y = pack2(o0[4 * g + 2] * inv, o0[4 * g + 3] * inv);
    u1.x = pack2(o1[4 * g + 0] * inv, o1[4 * g + 1] * inv);
    u1.y = pack2(o1[4 * g + 2] * inv, o1[4 * g + 3] * inv);
    *(uint2*)(op + 8 * g) = u0;
    *(uint2*)(op + 32 + 8 * g) = u1;
  }
}

DEVI int dn_rowof(int s, int b, int d) {
  if (s < 256) {
    int c = d ? (255 - s) : s;
    return M_LAT + b * 256 + c;
  }
  int t = s - 256;
  t = d ? (2047 - t) : t;
  return b * 2048 + t;
}

__device__ void dn_naive(const Params& p, int l, int it, char* smem) {
  float* ks = (float*)smem;
  float* qs = ks + 32 * 128;
  float* vs = qs + 32 * 128;
  float* gs = vs + 32 * 64;
  float* bs = gs + 32;
  const int half = it & 1, d = (it >> 1) & 1, h = (it >> 2) & 3, b = it >> 4;
  const int tid = otid(), w = tid >> 6, lane = tid & 63, c = lane & 15, kg = lane >> 4;
  const int col = half * 64 + w * 16 + c;
  const bf16_t* DQ = (const bf16_t*)(p.ws + OFF_DNQKV);
  const float* AB = (const float*)(p.ws + OFF_AB);
  bf16_t* MIX = (bf16_t*)(p.ws + OFF_HM);
  bf16_t* OB = (bf16_t*)(p.ws + OFF_OB);
  float S[32];
#pragma unroll
  for (int i = 0; i < 32; ++i) S[i] = 0.f;
  const float Aneg = -__expf(p.a_log[l * 8 + d * 4 + h]);
  const float dtb = p.dt_bias[l * 8 + d * 4 + h];
  for (int s0 = 0; s0 < 2304; s0 += 32) {
    __syncthreads();
    for (int i = tid; i < 32 * 128; i += 256) {
      int tk = i >> 7, ch = i & 127;
      int row = dn_rowof(s0 + tk, b, d);
      qs[i] = bf2f(DQ[(size_t)row * 1536 + h * 128 + ch]);
      ks[i] = bf2f(DQ[(size_t)row * 1536 + 512 + h * 128 + ch]);
    }
    for (int i = tid; i < 32 * 64; i += 256) {
      int tk = i >> 6, ch = i & 63;
      int row = dn_rowof(s0 + tk, b, d);
      vs[i] = bf2f(DQ[(size_t)row * 1536 + 1024 + h * 128 + half * 64 + ch]);
    }
    if (tid < 32) {
      int row = dn_rowof(s0 + tid, b, d);
      float a = AB[(size_t)row * 16 + d * 4 + h];
      float bb = AB[(size_t)row * 16 + 8 + d * 4 + h];
      float xx = a + dtb;
      const float ee = __expf(xx);
    float sp = ee < 0.25f ? ee * (1.f - ee * (0.5f - ee * (0.33333333f - ee * (0.25f - 0.2f * ee))))
                          : (xx > 20.f ? xx : __logf(1.f + ee));
      gs[tid] = __expf(Aneg * sp);
      bs[tid] = 1.f / (1.f + __expf(-bb));
    }
    __syncthreads();
    for (int tk = 0; tk < 32; ++tk) {
      const float eg = gs[tk], beta = bs[tk];
      const float vv = vs[tk * 64 + w * 16 + c];
      const float4* k4 = (const float4*)(ks + tk * 128 + kg * 32);
      const float4* q4 = (const float4*)(qs + tk * 128 + kg * 32);
      float part = 0.f;
#pragma unroll
      for (int i = 0; i < 8; ++i) {
        float4 kk = k4[i];
        S[4 * i + 0] *= eg; S[4 * i + 1] *= eg; S[4 * i + 2] *= eg; S[4 * i + 3] *= eg;
        part += kk.x * S[4 * i + 0] + kk.y * S[4 * i + 1] + kk.z * S[4 * i + 2] + kk.w * S[4 * i + 3];
      }
      part += __shfl_xor(part, 16);
      part += __shfl_xor(part, 32);
      const float delta = beta * (vv - part);
      float po = 0.f;
#pragma unroll
      for (int i = 0; i < 8; ++i) {
        float4 kk = k4[i];
        float4 qq = q4[i];
        S[4 * i + 0] += kk.x * delta; S[4 * i + 1] += kk.y * delta; S[4 * i + 2] += kk.z * delta; S[4 * i + 3] += kk.w * delta;
        po += qq.x * S[4 * i + 0] + qq.y * S[4 * i + 1] + qq.z * S[4 * i + 2] + qq.w * S[4 * i + 3];
      }
      po += __shfl_xor(po, 16);
      po += __shfl_xor(po, 32);
      if (kg == 0) {
        int row = dn_rowof(s0 + tk, b, d);
        float o = po * 0.08838834764831845f;
        if (d == 0)
          MIX[(size_t)row * 1024 + 512 + h * 128 + col] = f2bf(o);
        else
          OB[(size_t)row * 512 + h * 128 + col] = f2bf(o);
      }
    }
  }
}

__device__ void phaseD(const Params& p, int l, char* smem) {
  const int nb = gridDim.x, bid = blockIdx.x;
  if (bid < 64) {
    dn_scan(p, l, bid, smem);
    return;
  }
  const int nb2 = nb - 64;
  const int n_early = l < 3 ? N_CONV_EARLY : 0;
  for (int it = bid - 64; it < 1152 + N_CONV_LATE + n_early; it += nb2) {
    if (it < 576) {
      int item = it;
      if (it < 512) item = ((it & 7) * 64) + (it >> 3);
      else if (l == 3) continue;
      mla_flash(p, item, smem);
    } else if (it < 1152) {
      if (l == 3 && it - 576 >= 512) continue;
      na_flash(p, l, it - 576, smem);
    } else if (it < 1152 + N_CONV_LATE) {
      conv_item_late(p, l, it - 1152, (float*)smem);
    } else {
      conv_item_early(p, l + 1, it - 1152 - N_CONV_LATE, (float*)smem);
    }
  }
}

__device__ void outgate_item(const Params& p, int l, int item) {
  const int w = otid() >> 6, lane = otid() & 63;
  const int row = item * 4 + w;
  const bf16_t* P = (const bf16_t*)(p.ws + OFF_P);
  bf16_t* MIX = (bf16_t*)(p.ws + OFF_HM);
  const int h = lane >> 4, cb = (lane & 15) * 8;
  uint4 uo = *(const uint4*)(MIX + (size_t)row * 1024 + 512 + h * 128 + cb);
  uint4 ub = *(const uint4*)(P + (size_t)row * INWP + C_DN + h * 128 + cb);
  uint4 uz = *(const uint4*)(P + (size_t)row * INWP + C_DZ + h * 128 + cb);
  float o[8], z[8];
  o[0] = bflo(uo.x) + bflo(ub.x); o[1] = bfhi(uo.x) + bfhi(ub.x); o[2] = bflo(uo.y) + bflo(ub.y); o[3] = bfhi(uo.y) + bfhi(ub.y);
  o[4] = bflo(uo.z) + bflo(ub.z); o[5] = bfhi(uo.z) + bfhi(ub.z); o[6] = bflo(uo.w) + bflo(ub.w); o[7] = bfhi(uo.w) + bfhi(ub.w);
  z[0] = bflo(uz.x); z[1] = bfhi(uz.x); z[2] = bflo(uz.y); z[3] = bfhi(uz.y);
  z[4] = bflo(uz.z); z[5] = bfhi(uz.z); z[6] = bflo(uz.w); z[7] = bfhi(uz.w);
  float ss = 0.f;
#pragma unroll
  for (int e = 0; e < 8; ++e) ss += o[e] * o[e];
  ss += __shfl_xor(ss, 1);
  ss += __shfl_xor(ss, 2);
  ss += __shfl_xor(ss, 4);
  ss += __shfl_xor(ss, 8);
  const float r = rsqrtf(ss * (1.f / 128.f) + 1e-6f);
  const float* go = p.g_out + l * 128 + cb;
  float y[8];
#pragma unroll
  for (int e = 0; e < 8; ++e) y[e] = o[e] * r * go[e] * silu_f(z[e]);
  uint4 u;
  u.x = pack2(y[0], y[1]); u.y = pack2(y[2], y[3]); u.z = pack2(y[4], y[5]); u.w = pack2(y[6], y[7]);
  *(uint4*)(MIX + (size_t)row * 1024 + 512 + h * 128 + cb) = u;
}

__device__ void final_item(const Params& p, int item) {
  const int w = otid() >> 6, lane = otid() & 63;
  const int row = item * 4 + w;
  const float4* xr = (const float4*)((const float*)(p.ws + OFF_X) + (size_t)row * 1024);
  float4 v[4];
  float ss = 0.f;
#pragma unroll
  for (int i = 0; i < 4; ++i) {
    v[i] = xr[lane + 64 * i];
    ss += v[i].x * v[i].x + v[i].y * v[i].y + v[i].z * v[i].z + v[i].w * v[i].w;
  }
  ss = wave_sum(ss);
  const float r = rsqrtf(ss * (1.f / 1024.f) + 1e-6f);
  const float4* g4 = (const float4*)p.g_final;
  float4* o4 = (float4*)(p.out + (size_t)row * 1024);
#pragma unroll
  for (int i = 0; i < 4; ++i) {
    float4 gg = g4[lane + 64 * i];
    float4 y;
    y.x = v[i].x * r * gg.x; y.y = v[i].y * r * gg.y; y.z = v[i].z * r * gg.z; y.w = v[i].w * r * gg.w;
    o4[lane + 64 * i] = y;
  }
}

constexpr int N_PHASES = 1 + 9 * 4 + 1;

__global__ void __launch_bounds__(256, 2) mega(Params p) {
  __shared__ __attribute__((aligned(16))) char smem[SMEM_BYTES];
  cg::grid_group grid = cg::this_grid();
  const int nb = gridDim.x, bid = blockIdx.x;
  __shared__ uint4 xb_words;
  if (threadIdx.x == 0) xb_words = make_uint4(0u, 0u, 0u, 0u);
  __syncthreads();
  XcdBarrier xb = xcd_barrier_post((unsigned*)(p.ws + OFF_BAR), (volatile LAS unsigned*)&xb_words);
#ifdef PROBE_S
  bool again = false;
#endif
  for (int ph = p.ph_lo; ph < p.ph_hi; ++ph) {
    if (ph == 0) {
      phase0(p, smem);
    } else if (ph == N_PHASES - 1) {
      for (int it = bid; it < M_LAT / 4; it += nb) final_item(p, it);
    } else {
      const int l = (ph - 1) / 9, s = (ph - 1) % 9;
      if (s == 0) {
        phaseA(p, l, smem);
      } else if (s == 1) {
        for (int it = bid; it < 144 * 26; it += nb) {
          int mt, nt;
          tile_map(it, 26, mt, nt);
          gemm_tile<EPI_P>(p, l, (const bf16_t*)(p.ws + OFF_HM), 1024, (const bf16_t*)(p.ws + OFF_WIN), 1024,
                           mt * 128, nt * 128, 0, smem);
        }
      } else if (s == 2) {
        phaseC(p, l, smem);
      } else if (s == 3) {
        phaseD(p, l, smem);
      } else if (s == 4) {
        for (int it = bid; it < (l == 3 ? M_LAT : M_ALL) / 4; it += nb) outgate_item(p, l, it);
      } else if (s == 5) {
        const int mpx = l == 3 ? 16 : 18;
        for (int it = bid; it < 8 * mpx * 8; it += nb) {
          int mt, nt;
          tile_map(it, 8, mt, nt, mpx);
          gemm_tile<EPI_RES>(p, l, (const bf16_t*)(p.ws + OFF_HM), 1024, (const bf16_t*)(p.ws + OFF_WOUT), 1024,
                             mt * 128, nt * 128, 2, smem);
        }
      } else if (s == 6) {
        for (int it = bid; it < (l == 3 ? M_LAT : M_ALL) / 4; it += nb)
          norm_rows(p, false, (bf16_t*)(p.ws + OFF_HM), p.g_ffn + l * 1024,
                    (const float*)(p.ws + OFF_MOD) + (size_t)l * 9 * 6144, 3, 4, it);
      } else if (s == 7) {
        const int mpx = l == 3 ? 16 : 18;
        for (int it = bid; it < 8 * mpx * 44; it += nb) {
          int mt, nt;
          tile_map(it, 44, mt, nt, mpx);
          gemm_tile<EPI_GU>(p, l, (const bf16_t*)(p.ws + OFF_HM), 1024, (const bf16_t*)(p.ws + OFF_WGU), 1024,
                            mt * 128, nt * 128, 0, smem);
        }
      } else {
        const int mpx = l == 3 ? 16 : 18;
        for (int it = bid; it < 8 * mpx * 8; it += nb) {
          int mt, nt;
          tile_map(it, 8, mt, nt, mpx);
          gemm_tile<EPI_RES>(p, l, (const bf16_t*)(p.ws + OFF_P), FFN, (const bf16_t*)(p.ws + OFF_WDN), FFN,
                             mt * 128, nt * 128, 5, smem);
        }
      }
    }
#ifdef PROBE_S
    {
      const bool hit = (PROBE_S == 9) ? (ph == 0) : (ph != 0 && ph != N_PHASES - 1 && ((ph - 1) % 9) == PROBE_S);
      if (hit && !again) {
        again = true;
        if (p.use_cg) grid.sync(); else xcd_barrier(xb);
        --ph;
        continue;
      }
      again = false;
    }
#endif
    if (ph + 1 < p.ph_hi) {
      if (p.use_cg) grid.sync();
      else xcd_barrier(xb);
    }
  }
}

extern "C" void kernel_launch(void* const* d_in, const int* in_sizes, int n_in, void* d_out, int out_size, void* d_ws,
                              size_t ws_size, hipStream_t stream) {
  static int grid_blocks = 0;
  if (!grid_blocks) {
    int dev = 0, cus = 0, per_cu = 0;
    hipGetDevice(&dev);
    hipDeviceGetAttribute(&cus, hipDeviceAttributeMultiprocessorCount, dev);
    hipOccupancyMaxActiveBlocksPerMultiprocessor(&per_cu, mega, 256, 0);
    if (per_cu < 1) per_cu = 1;
    if (per_cu > 2) per_cu = 2;
    grid_blocks = cus * per_cu;
  }
  Params p{};
  const float** pp = (const float**)&p;
  for (int i = 0; i < 23; ++i) pp[i] = (const float*)d_in[i];
  p.out = (float*)d_out;
  p.ws = (char*)d_ws;
  p.ph_lo = 0;
  p.ph_hi = N_PHASES;
  p.use_cg = 0;
  p.pad0 = 0;
  hipMemsetAsync((char*)d_ws + OFF_BAR, 0, XCD_BAR_WORDS * sizeof(unsigned), stream);
  void* args[] = {&p};
  hipError_t e = hipLaunchCooperativeKernel((void*)mega, dim3(grid_blocks), dim3(256), args, 0, stream);
  if (e != hipSuccess) {
    fprintf(stderr, "cooperative launch failed: %s (grid %d)\n", hipGetErrorString(e), grid_blocks);
    (void)hipGetLastError();
    for (int ph = 0; ph < N_PHASES; ++ph) {
      p.ph_lo = ph;
      p.ph_hi = ph + 1;
      hipLaunchKernelGGL(mega, dim3(grid_blocks), dim3(256), 0, stream, p);
    }
  }
}
```

```cpp
#include <hip/hip_runtime.h>
#include <hip/hip_bf16.h>
#include <hip/hip_cooperative_groups.h>
#include <cstdio>
namespace cg = cooperative_groups;

#define DEVI __device__ __forceinline__
typedef unsigned short bf16_t;
typedef short bf16x8 __attribute__((ext_vector_type(8)));
typedef float f32x16 __attribute__((ext_vector_type(16)));

constexpr int M_LAT = 16384, M_CTX = 2048, M_ALL = 18432;
constexpr int DM = 1024, INW = 3248, INWP = 3328, FFN = 2816;
constexpr int C_MQ = 0, C_MKV = 256, C_MPE = 384, C_NQ = 416, C_NK = 672, C_NV = 928, C_DN = 1184;
constexpr int C_DZ = C_DN + 1536, C_DA = C_DN + 2048;

constexpr size_t OFF_WIN = 0;
constexpr size_t OFF_WOUT = OFF_WIN + (size_t)INWP * 1024 * 2;
constexpr size_t OFF_WGU = OFF_WOUT + (size_t)1024 * 1024 * 2;
constexpr size_t OFF_WDN = OFF_WGU + (size_t)2 * FFN * 1024 * 2;
constexpr size_t OFF_WQUP = OFF_WDN + (size_t)1024 * FFN * 2;
constexpr size_t OFF_WKVUP = OFF_WQUP + (size_t)384 * 256 * 2;
constexpr size_t OFF_MOD = OFF_WKVUP + (size_t)512 * 128 * 2;
constexpr size_t OFF_ROPE = OFF_MOD + (size_t)4 * 9 * 6144 * 4;
constexpr size_t OFF_X = OFF_ROPE + (size_t)2048 * 16 * 2 * 4;
constexpr size_t OFF_HM = OFF_X + (size_t)M_ALL * 1024 * 4;
constexpr size_t OFF_P = OFF_HM + (size_t)M_ALL * 1024 * 2;
constexpr size_t OFF_QH = OFF_P + (size_t)M_ALL * INWP * 2;
constexpr size_t OFF_KH = OFF_QH + (size_t)M_ALL * 384 * 2;
constexpr size_t OFF_VH = OFF_KH + (size_t)M_ALL * 384 * 2;
constexpr size_t OFF_DNQKV = OFF_VH + (size_t)M_ALL * 256 * 2;
constexpr size_t OFF_OB = OFF_DNQKV + (size_t)M_ALL * 1536 * 2;
constexpr size_t OFF_AB = OFF_OB + (size_t)M_ALL * 512 * 2;
constexpr size_t OFF_GC = OFF_AB + (size_t)M_ALL * 16 * 4;
constexpr size_t OFF_BETA = OFF_GC + (size_t)M_ALL * 8 * 4;
constexpr size_t OFF_NVT = OFF_BETA + (size_t)M_ALL * 8 * 4;
constexpr size_t WS_TOTAL = OFF_NVT + (size_t)M_ALL * 256 * 2;
constexpr int SMEM_BYTES = 74240;
constexpr size_t OFF_BAR = (WS_TOTAL + 255) & ~(size_t)255;

struct Params {
  const float *x, *c, *ctx, *c_ctx, *w_ada, *b_ada, *g_mix, *w_in, *g_q, *g_kv, *w_qup, *w_kvup, *rel_bias,
      *conv_w, *a_log, *dt_bias, *g_out, *w_out, *g_ffn, *w_gate, *w_up, *w_down, *g_final;
  float* out;
  char* ws;
  int ph_lo, ph_hi;
  int use_cg, pad0;
};

DEVI bf16_t f2bf(float f) {
  __bf16 r = (__bf16)f;
  return __builtin_bit_cast(unsigned short, r);
}
DEVI int otid() {
  int t = threadIdx.x;
  asm volatile("" : "+v"(t));
  return t;
}
DEVI float bf2f(bf16_t h) { return __uint_as_float(((unsigned)h) << 16); }
DEVI float bflo(unsigned u) { return __uint_as_float(u << 16); }
DEVI float bfhi(unsigned u) { return __uint_as_float(u & 0xffff0000u); }
typedef __bf16 bf16v2_t __attribute__((ext_vector_type(2)));
typedef float f32v2_t __attribute__((ext_vector_type(2)));
DEVI unsigned pack2(float a, float b) {
  f32v2_t v = {a, b};
  bf16v2_t r = __builtin_convertvector(v, bf16v2_t);
  return __builtin_bit_cast(unsigned, r);
}
DEVI float silu_f(float x) { return x / (1.f + __expf(-x)); }
DEVI float wave_sum(float v) {
#pragma unroll
  for (int o = 32; o >= 1; o >>= 1) v += __shfl_xor(v, o);
  return v;
}

#define XB_TMO 128
#define XB_XCNT(j) (256 + 64 * (j))
#define XB_XSUB(j) (1280 + 64 * (j))
#define XB_XGEN(j) (2304 + 64 * (j))
#define XB_TOP 3328
#define XB_TOPGEN 3392
#define XCD_BAR_WORDS 3456
#define XB_SPIN_CAP (1u << 22)
#define LAS __attribute__((address_space(3)))
DEVI unsigned xb_ld(unsigned* p) { return __hip_atomic_load(p, __ATOMIC_RELAXED, __HIP_MEMORY_SCOPE_AGENT); }
DEVI unsigned xb_add(unsigned* p, unsigned v) { return __hip_atomic_fetch_add(p, v, __ATOMIC_RELAXED, __HIP_MEMORY_SCOPE_AGENT); }
DEVI unsigned xb_xcc_id() { return (unsigned)__builtin_amdgcn_s_getreg((3 << 11) | 20) & 0xFu; }
#define XB_SPIN(cond, bar)                                                     \
  do {                                                                         \
    unsigned _sp = 0;                                                          \
    while (cond) {                                                             \
      __builtin_amdgcn_s_sleep(1);                                             \
      if ((++_sp & 255u) == 0u) {                                              \
        if (xb_ld(&(bar)[XB_TMO])) break;                                      \
        if (_sp > XB_SPIN_CAP) { atomicAdd(&(bar)[XB_TMO], 1u); break; }       \
      }                                                                        \
    }                                                                          \
  } while (0)
struct XcdBarrier {
  unsigned* bar;
  unsigned x;
  volatile LAS unsigned* st;
};
DEVI XcdBarrier xcd_barrier_post(unsigned* bar, volatile LAS unsigned* st) {
  XcdBarrier b;
  b.bar = bar;
  b.x = xb_xcc_id();
  b.st = st;
  if (threadIdx.x == 0) (void)xb_add(&bar[XB_XCNT(b.x)], 1u);
  return b;
}
DEVI void xcd_barrier_complete(unsigned* bar, unsigned x, unsigned& nloc, unsigned& nx) {
  const unsigned G = gridDim.x * gridDim.y * gridDim.z;
  unsigned sum, cnt, mine, sp = 0u;
  for (;;) {
    sum = 0u; cnt = 0u; mine = 0u;
#pragma unroll
    for (unsigned j = 0; j < 16; ++j) {
      const unsigned c = xb_ld(&bar[XB_XCNT(j)]);
      sum += c;
      cnt += (c > 0u) ? 1u : 0u;
      mine = (j == x) ? c : mine;
    }
    if (sum == G) break;
    __builtin_amdgcn_s_sleep(1);
    if ((++sp & 255u) == 0u) {
      if (xb_ld(&bar[XB_TMO])) break;
      if (sp > XB_SPIN_CAP) { atomicAdd(&bar[XB_TMO], 1u); break; }
    }
  }
  nloc = mine > 0u ? mine : 1u;
  nx = cnt > 0u ? cnt : 1u;
}
DEVI void xcd_barrier(const XcdBarrier& b) {
  asm volatile("s_waitcnt vmcnt(0)" ::: "memory");
  __syncthreads();
  if (threadIdx.x == 0) {
    unsigned* bar = b.bar;
    __builtin_amdgcn_s_waitcnt(0);
    unsigned nloc = b.st[0], nx = b.st[1];
    if (nloc == 0u) {
      xcd_barrier_complete(bar, b.x, nloc, nx);
      b.st[0] = nloc;
      b.st[1] = nx;
    }
    const unsigned old = xb_add(&bar[XB_XSUB(b.x)], 1u);
    const unsigned gen = old / nloc;
    if (old + 1u == (gen + 1u) * nloc) {
      __builtin_amdgcn_fence(__ATOMIC_RELEASE, "agent");
      asm volatile("s_waitcnt vmcnt(0)" ::: "memory");
      const unsigned og = xb_add(&bar[XB_TOP], 1u);
      const unsigned tg = og / nx;
      if (og + 1u == (tg + 1u) * nx) xb_add(&bar[XB_TOPGEN], 1u);
      else XB_SPIN(xb_ld(&bar[XB_TOPGEN]) == tg, bar);
      __builtin_amdgcn_fence(__ATOMIC_ACQUIRE, "agent");
      xb_add(&bar[XB_XGEN(b.x)], 1u);
      asm volatile("s_waitcnt vmcnt(0)" ::: "memory");
    } else {
      XB_SPIN(xb_ld(&bar[XB_XGEN(b.x)]) == gen, bar);
      __builtin_amdgcn_fence(__ATOMIC_ACQUIRE, "agent");
      asm volatile("s_waitcnt vmcnt(0)" ::: "memory");
    }
  }
  __syncthreads();
}

constexpr int N_CONV_EARLY = 16 * 52 + 24 + 16;
__device__ void conv_item_early(const Params& p, int l, int it, float* tl);

__device__ void phase0(const Params& p, char* smem) {
  const int tid = otid(), nb = gridDim.x, bid = blockIdx.x;
  {
    float* rc = (float*)(p.ws + OFF_ROPE);
    float* rs = rc + 2048 * 16;
    for (int i = bid * 256 + tid; i < 2048 * 16; i += nb * 256) {
      int t = i >> 4, a = (i >> 3) & 1, j = i & 7;
      float pos = a ? (float)(t & 63) : (float)(t >> 6);
      float inv = __builtin_amdgcn_exp2f(-(float)j * (13.287712379549449f / 8.f));
      float ang = pos * inv;
      rc[i] = cosf(ang);
      rs[i] = sinf(ang);
    }
  }
  for (int it = bid; it < N_CONV_EARLY; it += nb) conv_item_early(p, 0, it, (float*)smem);
  __syncthreads();
  float* sc = (float*)smem;
  float* red = sc + 1024 * 12;
  float* MOD = (float*)(p.ws + OFF_MOD);
  bool loaded = false;
  for (int it = bid; it < 4 * 96; it += nb) {
    if (!loaded) {
      for (int i = tid; i < 9 * 1024; i += 256) {
        float v = i < 8192 ? p.c[i] : p.c_ctx[i - 8192];
        sc[(i & 1023) * 12 + (i >> 10)] = silu_f(v);
      }
      __syncthreads();
      loaded = true;
    }
    const int l = it / 96, n0 = (it % 96) * 64;
    const int cc = tid & 63, kg = tid >> 6;
    const float* w = p.w_ada + (size_t)l * 1024 * 6144 + n0 + cc;
    float acc[9];
#pragma unroll
    for (int b = 0; b < 9; ++b) acc[b] = 0.f;
    for (int k0 = kg * 256; k0 < kg * 256 + 256; k0 += 16) {
      float wvv[16];
#pragma unroll
      for (int j = 0; j < 16; ++j) wvv[j] = w[(size_t)(k0 + j) * 6144];
#pragma unroll
      for (int j = 0; j < 16; ++j) {
      const int k = k0 + j;
      const float wv = wvv[j];
      const float4 s0 = *(const float4*)(sc + k * 12);
      const float4 s1 = *(const float4*)(sc + k * 12 + 4);
      const float s2 = sc[k * 12 + 8];
      acc[0] += s0.x * wv; acc[1] += s0.y * wv; acc[2] += s0.z * wv; acc[3] += s0.w * wv;
      acc[4] += s1.x * wv; acc[5] += s1.y * wv; acc[6] += s1.z * wv; acc[7] += s1.w * wv;
      acc[8] += s2 * wv;
      }
    }
#pragma unroll
    for (int b = 0; b < 9; ++b) red[(kg * 9 + b) * 64 + cc] = acc[b];
    __syncthreads();
    for (int i = tid; i < 9 * 64; i += 256) {
      int b = i >> 6, c2 = i & 63;
      float s = red[(0 * 9 + b) * 64 + c2] + red[(1 * 9 + b) * 64 + c2] + red[(2 * 9 + b) * 64 + c2] +
                red[(3 * 9 + b) * 64 + c2];
      MOD[(size_t)(l * 9 + b) * 6144 + n0 + c2] = s + p.b_ada[l * 6144 + n0 + c2];
    }
    __syncthreads();
  }
}

__device__ void convT_tile(const float* __restrict__ src, int K, int N, bf16_t* __restrict__ dst, int mode,
                           const float* __restrict__ gs, int kt, int nt, float* tl) {
  const int tid = otid();
  const int k0 = kt * 64, n0 = nt * 64;
  __syncthreads();
#pragma unroll 4
  for (int i = 0; i < 16; ++i) {
    int kk = i * 4 + (tid >> 6), nn = tid & 63;
    float v = 0.f;
    if (n0 + nn < N) v = src[(size_t)(k0 + kk) * N + n0 + nn];
    if (gs) v *= gs[k0 + kk];
    tl[kk * 65 + nn] = v;
  }
  __syncthreads();
#pragma unroll 2
  for (int i = 0; i < 8; ++i) {
    int nn = i * 8 + (tid >> 5), kk = (tid & 31) * 2;
    unsigned pk = pack2(tl[kk * 65 + nn], tl[(kk + 1) * 65 + nn]);
    int n = n0 + nn;
    int drow = mode == 0 ? n : ((n >> 5) * 64 + (n & 31) + (mode == 2 ? 32 : 0));
    *(unsigned*)(dst + (size_t)drow * K + k0 + kk) = pk;
  }
}

__device__ void norm_rows(const Params& p, bool from_input, bf16_t* __restrict__ H, const float* __restrict__ g,
                          const float* __restrict__ modl, int shift_i, int scale_i, int item) {
  const int w = otid() >> 6, lane = otid() & 63;
  const int row = item * 4 + w;
  const float* xsrc = from_input ? (row < M_LAT ? p.x + (size_t)row * 1024 : p.ctx + (size_t)(row - M_LAT) * 1024)
                                 : (const float*)(p.ws + OFF_X) + (size_t)row * 1024;
  const float4* xr = (const float4*)xsrc;
  float4 v[4];
  float ss = 0.f;
#pragma unroll
  for (int i = 0; i < 4; ++i) {
    v[i] = xr[lane + 64 * i];
    ss += v[i].x * v[i].x + v[i].y * v[i].y + v[i].z * v[i].z + v[i].w * v[i].w;
  }
  ss = wave_sum(ss);
  const float r = rsqrtf(ss * (1.f / 1024.f) + 1e-6f);
  const int b = row < M_LAT ? (row >> 11) : 8;
  const float4* sh = (const float4*)(modl + b * 6144 + shift_i * 1024);
  const float4* sl = (const float4*)(modl + b * 6144 + scale_i * 1024);
  const float4* g4 = (const float4*)g;
#pragma unroll
  for (int i = 0; i < 4; ++i) {
    int c4 = lane + 64 * i;
    float4 gg = g4[c4], s4 = sh[c4], l4 = sl[c4];
    float y0 = v[i].x * r * gg.x * (1.f + l4.x) + s4.x;
    float y1 = v[i].y * r * gg.y * (1.f + l4.y) + s4.y;
    float y2 = v[i].z * r * gg.z * (1.f + l4.z) + s4.z;
    float y3 = v[i].w * r * gg.w * (1.f + l4.w) + s4.w;
    uint2 pk;
    pk.x = pack2(y0, y1);
    pk.y = pack2(y2, y3);
    *(uint2*)(H + (size_t)row * 1024 + c4 * 4) = pk;
  }
}

__device__ void conv_item_late(const Params& p, int l, int i, float* tl) {
  bf16_t* Wout = (bf16_t*)(p.ws + OFF_WOUT);
  bf16_t* Wgu = (bf16_t*)(p.ws + OFF_WGU);
  bf16_t* Wdn = (bf16_t*)(p.ws + OFF_WDN);
  const float* src;
  bf16_t* dst;
  int K, N, mode = 0, ntn;
  if (i < 256) {
    src = p.w_out + (size_t)l * 1024 * 1024; K = 1024; N = 1024; dst = Wout; ntn = 16;
  } else if (i < 960) {
    i -= 256; src = p.w_gate + (size_t)l * 1024 * FFN; K = 1024; N = FFN; dst = Wgu; ntn = 44; mode = 1;
  } else if (i < 1664) {
    i -= 960; src = p.w_up + (size_t)l * 1024 * FFN; K = 1024; N = FFN; dst = Wgu; ntn = 44; mode = 2;
  } else {
    i -= 1664; src = p.w_down + (size_t)l * FFN * 1024; K = FFN; N = 1024; dst = Wdn; ntn = 16;
  }
  convT_tile(src, K, N, dst, mode, nullptr, i / ntn, i % ntn, tl);
}
constexpr int N_CONV_LATE = 256 + 3 * 704;
__device__ void conv_item_early(const Params& p, int l, int it, float* tl) {
  const float* src;
  const float* gs = nullptr;
  bf16_t* dst;
  int K, N, ntn, i;
  if (it < 832) {
    i = it; src = p.w_in + (size_t)l * 1024 * INW; K = 1024; N = INW; dst = (bf16_t*)(p.ws + OFF_WIN); ntn = 52;
  } else if (it < 856) {
    i = it - 832; src = p.w_qup + (size_t)l * 256 * 384; K = 256; N = 384; dst = (bf16_t*)(p.ws + OFF_WQUP); ntn = 6;
    gs = p.g_q + l * 256;
  } else {
    i = it - 856; src = p.w_kvup + (size_t)l * 128 * 512; K = 128; N = 512; dst = (bf16_t*)(p.ws + OFF_WKVUP); ntn = 8;
    gs = p.g_kv + l * 128;
  }
  convT_tile(src, K, N, dst, 0, gs, i / ntn, i % ntn, tl);
}

__device__ void phaseA(const Params& p, int l, char* smem) {
  const int nb = gridDim.x, bid = blockIdx.x;
  for (int it = bid; it < M_ALL / 4; it += nb)
    norm_rows(p, l == 0, (bf16_t*)(p.ws + OFF_HM), p.g_mix + l * 1024,
              (const float*)(p.ws + OFF_MOD) + (size_t)l * 9 * 6144, 0, 1, it);
}

DEVI void tile_map(int it, int NT, int& mt, int& nt, int MPX = 18) {
  const int xcd = it & 7, idx = it >> 3;
  const int per_group = 8 * NT;
  const int g = idx / per_group, r = idx - g * per_group;
  const int gs = min(8, MPX - 8 * g);
  mt = xcd * MPX + g * 8 + r % gs;
  nt = r / gs;
}

enum { EPI_P = 0, EPI_QUP = 1, EPI_KVUP = 2, EPI_RES = 3, EPI_GU = 4 };

template <int EPI>
__device__ void gemm_tile(const Params& p, int l, const bf16_t* __restrict__ A, int lda,
                          const bf16_t* __restrict__ BT, int K, int m0, int n0, int gate_i, char* smem) {
  constexpr int STAGE = 2 * 128 * 72;
  bf16_t* sbase = (bf16_t*)smem;
  float* rsv = (float*)(smem + 2 * STAGE * 2);
  const int tid = otid(), lane = tid & 63, w = tid >> 6, wm = w >> 1, wn = w & 1;
  const int lr = tid >> 3, lc = (tid & 7) * 8;
  __syncthreads();
  if (EPI == EPI_QUP || EPI == EPI_KVUP) {
    const int row = tid >> 1, hf = tid & 1;
    const int n8 = K / 16;
    const uint4* ap = (const uint4*)(A + (size_t)(m0 + row) * lda + hf * (K / 2));
    float ss = 0.f;
    for (int i = 0; i < n8; ++i) {
      uint4 u = ap[i];
      float a0 = bflo(u.x), a1 = bfhi(u.x), a2 = bflo(u.y), a3 = bfhi(u.y), a4 = bflo(u.z), a5 = bfhi(u.z),
            a6 = bflo(u.w), a7 = bfhi(u.w);
      ss += a0 * a0 + a1 * a1 + a2 * a2 + a3 * a3 + a4 * a4 + a5 * a5 + a6 * a6 + a7 * a7;
    }
    ss += __shfl_xor(ss, 1);
    if (hf == 0) rsv[row] = rsqrtf(ss / (float)K + 1e-6f);
  }
  const bf16_t* Ap = A + (size_t)(m0 + lr) * lda + lc;
  const bf16_t* Bp = BT + (size_t)(n0 + lr) * K + lc;
  uint4 ra0, ra1, ra2, ra3, rb0, rb1, rb2, rb3;
#define G_LOAD()                                  \
  ra0 = *(const uint4*)(Ap);                      \
  ra1 = *(const uint4*)(Ap + (size_t)32 * lda);   \
  ra2 = *(const uint4*)(Ap + (size_t)64 * lda);   \
  ra3 = *(const uint4*)(Ap + (size_t)96 * lda);   \
  rb0 = *(const uint4*)(Bp);                      \
  rb1 = *(const uint4*)(Bp + (size_t)32 * K);     \
  rb2 = *(const uint4*)(Bp + (size_t)64 * K);     \
  rb3 = *(const uint4*)(Bp + (size_t)96 * K);
#define S_WRITE(ST)                                                   \
  {                                                                   \
    bf16_t* wa = sbase + (ST) * STAGE + lr * 72 + lc;                 \
    bf16_t* wb = wa + 128 * 72;                                       \
    *(uint4*)(wa) = ra0;                                              \
    *(uint4*)(wa + 32 * 72) = ra1;                                    \
    *(uint4*)(wa + 64 * 72) = ra2;                                    \
    *(uint4*)(wa + 96 * 72) = ra3;                                    \
    *(uint4*)(wb) = rb0;                                              \
    *(uint4*)(wb + 32 * 72) = rb1;                                    \
    *(uint4*)(wb + 64 * 72) = rb2;                                    \
    *(uint4*)(wb + 96 * 72) = rb3;                                    \
  }
  const int nk = K / 64;
  G_LOAD()
  S_WRITE(0)
  if (nk > 1) {
    Ap += 64;
    Bp += 64;
    G_LOAD()
  }
  f32x16 acc[2][2];
#pragma unroll
  for (int i = 0; i < 2; ++i)
#pragma unroll
    for (int j = 0; j < 2; ++j)
#pragma unroll
      for (int r = 0; r < 16; ++r) acc[i][j][r] = 0.f;
  __syncthreads();
  for (int kt = 0; kt < nk; ++kt) {
    const int cur = kt & 1;
    const bf16_t* pa = sbase + cur * STAGE + (wm * 64 + (lane & 31)) * 72 + (lane >> 5) * 8;
    const bf16_t* pb = sbase + cur * STAGE + 128 * 72 + (wn * 64 + (lane & 31)) * 72 + (lane >> 5) * 8;
    bf16x8 fa00 = *(const bf16x8*)(pa), fa01 = *(const bf16x8*)(pa + 32 * 72);
    bf16x8 fb00 = *(const bf16x8*)(pb), fb01 = *(const bf16x8*)(pb + 32 * 72);
    bf16x8 fa10 = *(const bf16x8*)(pa + 16), fa11 = *(const bf16x8*)(pa + 32 * 72 + 16);
    bf16x8 fb10 = *(const bf16x8*)(pb + 16), fb11 = *(const bf16x8*)(pb + 32 * 72 + 16);
    bf16x8 fa20 = *(const bf16x8*)(pa + 32), fa21 = *(const bf16x8*)(pa + 32 * 72 + 32);
    bf16x8 fb20 = *(const bf16x8*)(pb + 32), fb21 = *(const bf16x8*)(pb + 32 * 72 + 32);
    bf16x8 fa30 = *(const bf16x8*)(pa + 48), fa31 = *(const bf16x8*)(pa + 32 * 72 + 48);
    bf16x8 fb30 = *(const bf16x8*)(pb + 48), fb31 = *(const bf16x8*)(pb + 32 * 72 + 48);
    __builtin_amdgcn_sched_barrier(0);
    __builtin_amdgcn_s_setprio(1);
#define MM4(A0, A1, B0, B1)                                                           \
  acc[0][0] = __builtin_amdgcn_mfma_f32_32x32x16_bf16(A0, B0, acc[0][0], 0, 0, 0);    \
  acc[0][1] = __builtin_amdgcn_mfma_f32_32x32x16_bf16(A0, B1, acc[0][1], 0, 0, 0);    \
  acc[1][0] = __builtin_amdgcn_mfma_f32_32x32x16_bf16(A1, B0, acc[1][0], 0, 0, 0);    \
  acc[1][1] = __builtin_amdgcn_mfma_f32_32x32x16_bf16(A1, B1, acc[1][1], 0, 0, 0);
    MM4(fa00, fa01, fb00, fb01)
    MM4(fa10, fa11, fb10, fb11)
    MM4(fa20, fa21, fb20, fb21)
    MM4(fa30, fa31, fb30, fb31)
#undef MM4
    __builtin_amdgcn_s_setprio(0);
    __builtin_amdgcn_sched_barrier(0);
    if (kt + 1 < nk) {
      S_WRITE(cur ^ 1)
      if (kt + 2 < nk) {
        Ap += 64;
        Bp += 64;
        G_LOAD()
      }
    }
    __syncthreads();
  }
#undef G_LOAD
#undef S_WRITE
  const int ci = lane & 31;
  const int rbase = m0 + wm * 64 + 4 * (lane >> 5);
  const int cbase = n0 + wn * 64;
  if (EPI == EPI_P) {
    bf16_t* P = (bf16_t*)(p.ws + OFF_P);
    float* AB = (float*)(p.ws + OFF_AB);
    bf16_t* sO = (bf16_t*)smem;
#pragma unroll
    for (int mt = 0; mt < 2; ++mt)
#pragma unroll
      for (int nt = 0; nt < 2; ++nt)
#pragma unroll
        for (int r = 0; r < 16; ++r) {
          const int rl = wm * 64 + 4 * (lane >> 5) + mt * 32 + (r & 3) + 8 * (r >> 2);
          const int cl = wn * 64 + nt * 32 + ci;
          const float v = acc[mt][nt][r];
          sO[rl * 136 + cl] = f2bf(v);
          const int col = n0 + cl;
          if (col >= C_DA && col < C_DA + 16) AB[(size_t)(m0 + rl) * 16 + col - C_DA] = v;
        }
    __syncthreads();
#pragma unroll
    for (int e = 0; e < 8; ++e) {
      const int c = tid + 256 * e, rl = c >> 4, ch = c & 15;
      *(uint4*)(P + (size_t)(m0 + rl) * INWP + n0 + ch * 8) = *(const uint4*)(sO + rl * 136 + ch * 8);
    }
    bf16_t* NVT = (bf16_t*)(p.ws + OFF_NVT);
#pragma unroll
    for (int mt = 0; mt < 2; ++mt)
#pragma unroll
      for (int nt = 0; nt < 2; ++nt) {
        const int base = cbase + nt * 32;
        if (base >= C_NV && base < C_NV + 256) {
          const int hv = (base - C_NV) >> 6, dv = ((base - C_NV) & 63) + ci;
#pragma unroll
          for (int g = 0; g < 4; ++g) {
            const int row0 = rbase + mt * 32 + 8 * g;
            int bb, key0;
            if (row0 < M_LAT) { bb = row0 >> 11; key0 = 256 + (row0 & 2047); }
            else { bb = (row0 - M_LAT) >> 8; key0 = (row0 - M_LAT) & 255; }
            uint2 u;
            u.x = pack2(acc[mt][nt][4 * g + 0], acc[mt][nt][4 * g + 1]);
            u.y = pack2(acc[mt][nt][4 * g + 2], acc[mt][nt][4 * g + 3]);
            *(uint2*)(NVT + ((size_t)(bb * 4 + hv) * 64 + dv) * 2304 + key0) = u;
          }
        }
      }
  } else if (EPI == EPI_QUP) {
    bf16_t* QH = (bf16_t*)(p.ws + OFF_QH);
    const float* rc = (const float*)(p.ws + OFF_ROPE);
    const float* rsn = rc + 2048 * 16;
#pragma unroll
    for (int mt = 0; mt < 2; ++mt)
#pragma unroll
      for (int nt = 0; nt < 2; ++nt) {
        const int base = cbase + nt * 32;
        const bool rope = ((base % 96) == 64) && (m0 < M_LAT);
#pragma unroll
        for (int r = 0; r < 16; ++r) {
          int row = rbase + mt * 32 + (r & 3) + 8 * (r >> 2);
          float v = acc[mt][nt][r] * rsv[row - m0];
          float o = __shfl_xor(v, 8);
          if (rope) {
            int t = row & 2047;
            int a = ci >> 4, hf = (ci >> 3) & 1, j = ci & 7;
            float c = rc[t * 16 + a * 8 + j], s = rsn[t * 16 + a * 8 + j];
            v = hf ? (o * s + v * c) : (v * c - o * s);
          }
          QH[(size_t)row * 384 + base + ci] = f2bf(v);
        }
      }
  } else if (EPI == EPI_KVUP) {
    bf16_t* KA = (bf16_t*)(p.ws + OFF_KH);
    bf16_t* VT = (bf16_t*)(p.ws + OFF_VH);
#pragma unroll
    for (int mt = 0; mt < 2; ++mt)
#pragma unroll
      for (int nt = 0; nt < 2; ++nt) {
        const int base = cbase + nt * 32;
        const int h = base >> 7, cc = (base & 127) + ci;
#pragma unroll
        for (int g = 0; g < 4; ++g) {
          const int row0 = rbase + mt * 32 + 8 * g;
          int bb, key0;
          if (row0 < M_LAT) { bb = row0 >> 11; key0 = 256 + (row0 & 2047); }
          else { bb = (row0 - M_LAT) >> 8; key0 = (row0 - M_LAT) & 255; }
          float v0 = acc[mt][nt][4 * g + 0] * rsv[row0 - m0 + 0];
          float v1 = acc[mt][nt][4 * g + 1] * rsv[row0 - m0 + 1];
          float v2 = acc[mt][nt][4 * g + 2] * rsv[row0 - m0 + 2];
          float v3 = acc[mt][nt][4 * g + 3] * rsv[row0 - m0 + 3];
          if (cc < 64) {
            bf16_t* kp = KA + ((size_t)(bb * 4 + h) * 2304 + key0) * 96 + cc;
            kp[0] = f2bf(v0); kp[96] = f2bf(v1); kp[192] = f2bf(v2); kp[288] = f2bf(v3);
          } else {
            uint2 u;
            u.x = pack2(v0, v1);
            u.y = pack2(v2, v3);
            *(uint2*)(VT + ((size_t)(bb * 4 + h) * 64 + (cc - 64)) * 2304 + key0) = u;
          }
        }
      }
  } else if (EPI == EPI_RES) {
    float* X = (float*)(p.ws + OFF_X);
    const float* Xsrc = (l == 0 && gate_i == 2) ? (m0 < M_LAT ? p.x : p.ctx - (size_t)M_LAT * 1024) : X;
    const float* modl = (const float*)(p.ws + OFF_MOD) + (size_t)l * 9 * 6144 + gate_i * 1024;
#pragma unroll
    for (int mt = 0; mt < 2; ++mt)
#pragma unroll
      for (int nt = 0; nt < 2; ++nt)
#pragma unroll
        for (int r = 0; r < 16; ++r) {
          int row = rbase + mt * 32 + (r & 3) + 8 * (r >> 2);
          int col = cbase + nt * 32 + ci;
          int b = row < M_LAT ? (row >> 11) : 8;
          float g = modl[b * 6144 + col];
          size_t idx = (size_t)row * 1024 + col;
          X[idx] = Xsrc[idx] + g * acc[mt][nt][r];
        }
  } else if (EPI == EPI_GU) {
    bf16_t* ACT = (bf16_t*)(p.ws + OFF_P);
    bf16_t* sO = (bf16_t*)smem;
#pragma unroll
    for (int mt = 0; mt < 2; ++mt)
#pragma unroll
      for (int r = 0; r < 16; ++r) {
        const int rl = wm * 64 + 4 * (lane >> 5) + mt * 32 + (r & 3) + 8 * (r >> 2);
        float gt = acc[mt][0][r], up = acc[mt][1][r];
        float a = silu_f(gt) * up;
        sO[rl * 72 + wn * 32 + ci] = f2bf(a);
      }
    __syncthreads();
#pragma unroll
    for (int e = 0; e < 4; ++e) {
      const int c = tid + 256 * e, rl = c >> 3, ch = c & 7;
      *(uint4*)(ACT + (size_t)(m0 + rl) * FFN + (n0 >> 1) + ch * 8) = *(const uint4*)(sO + rl * 72 + ch * 8);
    }
  }
}

template <int EPI>
__device__ void gemm_wide(const Params& p, int l, const bf16_t* __restrict__ A, int lda,
                          const bf16_t* __restrict__ BT, int K, int m0, int n0, int gate_i, char* smem) {
  bf16_t* sA = (bf16_t*)smem;
  bf16_t* sB = sA + 128 * 72;
  const int tid = otid(), lane = tid & 63, w = tid >> 6, wm = w >> 1, wn = w & 1;
  const int lr = tid >> 3, lc = (tid & 7) * 8;
  const bf16_t* Ap = A + (size_t)(m0 + lr) * lda + lc;
  const bf16_t* Bp = BT + (size_t)(n0 + lr) * K + lc;
  uint4 ra0, ra1, ra2, ra3, rb0, rb1, rb2, rb3, rb4, rb5, rb6, rb7;
#define LOAD_AB()                                   \
  ra0 = *(const uint4*)(Ap);                        \
  ra1 = *(const uint4*)(Ap + (size_t)32 * lda);     \
  ra2 = *(const uint4*)(Ap + (size_t)64 * lda);     \
  ra3 = *(const uint4*)(Ap + (size_t)96 * lda);     \
  rb0 = *(const uint4*)(Bp);                        \
  rb1 = *(const uint4*)(Bp + (size_t)32 * K);       \
  rb2 = *(const uint4*)(Bp + (size_t)64 * K);       \
  rb3 = *(const uint4*)(Bp + (size_t)96 * K);       \
  rb4 = *(const uint4*)(Bp + (size_t)128 * K);      \
  rb5 = *(const uint4*)(Bp + (size_t)160 * K);      \
  rb6 = *(const uint4*)(Bp + (size_t)192 * K);      \
  rb7 = *(const uint4*)(Bp + (size_t)224 * K);
  __syncthreads();
  LOAD_AB()
  f32x16 acc[2][4];
#pragma unroll
  for (int i = 0; i < 2; ++i)
#pragma unroll
    for (int j = 0; j < 4; ++j)
#pragma unroll
      for (int r = 0; r < 16; ++r) acc[i][j][r] = 0.f;
  const int nk = K / 64;
  const bf16_t* pa = sA + (wm * 64 + (lane & 31)) * 72 + (lane >> 5) * 8;
  const bf16_t* pb = sB + (wn * 128 + (lane & 31)) * 72 + (lane >> 5) * 8;
#define MM8(A0, A1, B0, B1, B2, B3)                                                   \
  acc[0][0] = __builtin_amdgcn_mfma_f32_32x32x16_bf16(A0, B0, acc[0][0], 0, 0, 0);    \
  acc[1][0] = __builtin_amdgcn_mfma_f32_32x32x16_bf16(A1, B0, acc[1][0], 0, 0, 0);    \
  acc[0][1] = __builtin_amdgcn_mfma_f32_32x32x16_bf16(A0, B1, acc[0][1], 0, 0, 0);    \
  acc[1][1] = __builtin_amdgcn_mfma_f32_32x32x16_bf16(A1, B1, acc[1][1], 0, 0, 0);    \
  acc[0][2] = __builtin_amdgcn_mfma_f32_32x32x16_bf16(A0, B2, acc[0][2], 0, 0, 0);    \
  acc[1][2] = __builtin_amdgcn_mfma_f32_32x32x16_bf16(A1, B2, acc[1][2], 0, 0, 0);    \
  acc[0][3] = __builtin_amdgcn_mfma_f32_32x32x16_bf16(A0, B3, acc[0][3], 0, 0, 0);    \
  acc[1][3] = __builtin_amdgcn_mfma_f32_32x32x16_bf16(A1, B3, acc[1][3], 0, 0, 0);
#define HALF_STEP(KO)                                                                                   \
  {                                                                                                     \
    bf16x8 fa00 = *(const bf16x8*)(pa + (KO)), fa01 = *(const bf16x8*)(pa + 32 * 72 + (KO));            \
    bf16x8 fb00 = *(const bf16x8*)(pb + (KO)), fb01 = *(const bf16x8*)(pb + 32 * 72 + (KO));            \
    bf16x8 fb02 = *(const bf16x8*)(pb + 64 * 72 + (KO)), fb03 = *(const bf16x8*)(pb + 96 * 72 + (KO));  \
    bf16x8 fa10 = *(const bf16x8*)(pa + (KO) + 16), fa11 = *(const bf16x8*)(pa + 32 * 72 + (KO) + 16);  \
    bf16x8 fb10 = *(const bf16x8*)(pb + (KO) + 16), fb11 = *(const bf16x8*)(pb + 32 * 72 + (KO) + 16);  \
    bf16x8 fb12 = *(const bf16x8*)(pb + 64 * 72 + (KO) + 16), fb13 = *(const bf16x8*)(pb + 96 * 72 + (KO) + 16); \
    __builtin_amdgcn_sched_barrier(0);                                                                  \
    __builtin_amdgcn_s_setprio(1);                                                                      \
    MM8(fa00, fa01, fb00, fb01, fb02, fb03)                                                             \
    MM8(fa10, fa11, fb10, fb11, fb12, fb13)                                                             \
    __builtin_amdgcn_s_setprio(0);                                                                      \
    __builtin_amdgcn_sched_barrier(0);                                                                  \
  }
  for (int kt = 0; kt < nk; ++kt) {
    __syncthreads();
    *(uint4*)(sA + (lr + 0) * 72 + lc) = ra0;
    *(uint4*)(sA + (lr + 32) * 72 + lc) = ra1;
    *(uint4*)(sA + (lr + 64) * 72 + lc) = ra2;
    *(uint4*)(sA + (lr + 96) * 72 + lc) = ra3;
    *(uint4*)(sB + (lr + 0) * 72 + lc) = rb0;
    *(uint4*)(sB + (lr + 32) * 72 + lc) = rb1;
    *(uint4*)(sB + (lr + 64) * 72 + lc) = rb2;
    *(uint4*)(sB + (lr + 96) * 72 + lc) = rb3;
    *(uint4*)(sB + (lr + 128) * 72 + lc) = rb4;
    *(uint4*)(sB + (lr + 160) * 72 + lc) = rb5;
    *(uint4*)(sB + (lr + 192) * 72 + lc) = rb6;
    *(uint4*)(sB + (lr + 224) * 72 + lc) = rb7;
    __syncthreads();
    if (kt + 1 < nk) {
      Ap += 64;
      Bp += 64;
      LOAD_AB()
    }
    __builtin_amdgcn_sched_barrier(0);
    HALF_STEP(0)
    HALF_STEP(32)
  }
#undef HALF_STEP
#undef MM8
#undef LOAD_AB
  const int ci = lane & 31;
  const int rbase = m0 + wm * 64 + 4 * (lane >> 5);
  const int cbase = n0 + wn * 128;
  if (EPI == EPI_P) {
    bf16_t* P = (bf16_t*)(p.ws + OFF_P);
    float* AB = (float*)(p.ws + OFF_AB);
    bf16_t* NVT = (bf16_t*)(p.ws + OFF_NVT);
#pragma unroll
    for (int mt = 0; mt < 2; ++mt)
#pragma unroll
      for (int nt = 0; nt < 4; ++nt) {
        const int base = cbase + nt * 32;
#pragma unroll
        for (int r = 0; r < 16; ++r) {
          int row = rbase + mt * 32 + (r & 3) + 8 * (r >> 2);
          int col = base + ci;
          float v = acc[mt][nt][r];
          P[(size_t)row * INWP + col] = f2bf(v);
          if (col >= C_DA && col < C_DA + 16) AB[(size_t)row * 16 + col - C_DA] = v;
        }
        if (base >= C_NV && base < C_NV + 256) {
          const int hv = (base - C_NV) >> 6, dv = ((base - C_NV) & 63) + ci;
#pragma unroll
          for (int g = 0; g < 4; ++g) {
            const int row0 = rbase + mt * 32 + 8 * g;
            int bb, key0;
            if (row0 < M_LAT) { bb = row0 >> 11; key0 = 256 + (row0 & 2047); }
            else { bb = (row0 - M_LAT) >> 8; key0 = (row0 - M_LAT) & 255; }
            uint2 u;
            u.x = pack2(acc[mt][nt][4 * g + 0], acc[mt][nt][4 * g + 1]);
            u.y = pack2(acc[mt][nt][4 * g + 2], acc[mt][nt][4 * g + 3]);
            *(uint2*)(NVT + ((size_t)(bb * 4 + hv) * 64 + dv) * 2304 + key0) = u;
          }
        }
      }
  } else if (EPI == EPI_GU) {
    bf16_t* ACT = (bf16_t*)(p.ws + OFF_P);
#pragma unroll
    for (int mt = 0; mt < 2; ++mt)
#pragma unroll
      for (int pr = 0; pr < 2; ++pr)
#pragma unroll
        for (int r = 0; r < 16; ++r) {
          int row = rbase + mt * 32 + (r & 3) + 8 * (r >> 2);
          float gt = acc[mt][2 * pr][r], up = acc[mt][2 * pr + 1][r];
          float a = silu_f(gt) * up;
          ACT[(size_t)row * FFN + ((cbase >> 6) + pr) * 32 + ci] = f2bf(a);
        }
  }
}

__device__ void kpe_item(const Params& p, int it) {
  const int tid = otid();
  const bf16_t* P = (const bf16_t*)(p.ws + OFF_P);
  bf16_t* KH = (bf16_t*)(p.ws + OFF_KH);
  const float* rc = (const float*)(p.ws + OFF_ROPE);
  const float* rsn = rc + 2048 * 16;
  const int row = it * 8 + (tid >> 5), i = tid & 31;
  float v = bf2f(P[(size_t)row * INWP + C_MPE + i]);
  float o = __shfl_xor(v, 8);
  if (row < M_LAT) {
    int t = row & 2047;
    int a = i >> 4, hf = (i >> 3) & 1, j = i & 7;
    float c = rc[t * 16 + a * 8 + j], s = rsn[t * 16 + a * 8 + j];
    v = hf ? (o * s + v * c) : (v * c - o * s);
  }
  bf16_t bv = f2bf(v);
  int bb, key;
  if (row < M_LAT) { bb = row >> 11; key = 256 + (row & 2047); }
  else { bb = (row - M_LAT) >> 8; key = (row - M_LAT) & 255; }
#pragma unroll
  for (int h = 0; h < 4; ++h) KH[((size_t)(bb * 4 + h) * 2304 + key) * 96 + 64 + i] = bv;
}

__device__ void dn_prep(const Params& p, int l, int it, char* smem) {
  float* buf = (float*)smem;
  float* nrm = buf + 8 * 1536;
  const int tid = otid();
  const bf16_t* P = (const bf16_t*)(p.ws + OFF_P);
  bf16_t* DQ = (bf16_t*)(p.ws + OFF_DNQKV);
  const int r0 = it * 8;
  int seq_lo, seq_hi;
  if (r0 < M_LAT) {
    seq_lo = (r0 >> 11) << 11;
    seq_hi = seq_lo + 2048;
  } else {
    int rr = r0 - M_LAT;
    seq_lo = M_LAT + ((rr >> 8) << 8);
    seq_hi = seq_lo + 256;
  }
  const float* cw = p.conv_w + (size_t)l * 5 * 1536;
  __syncthreads();
  for (int c6 = 0; c6 < 6; ++c6) {
    const int ch = c6 * 256 + tid;
    float w0 = cw[ch], w1 = cw[1536 + ch], w2 = cw[2 * 1536 + ch], w3 = cw[3 * 1536 + ch], w4 = cw[4 * 1536 + ch];
    float xw[12];
#pragma unroll
    for (int j = 0; j < 12; ++j) {
      int r = r0 - 2 + j;
      xw[j] = (r >= seq_lo && r < seq_hi) ? bf2f(P[(size_t)r * INWP + C_DN + ch]) : 0.f;
    }
#pragma unroll
    for (int j = 0; j < 8; ++j) {
      float y = w0 * xw[j] + w1 * xw[j + 1] + w2 * xw[j + 2] + w3 * xw[j + 3] + w4 * xw[j + 4];
      buf[j * 1536 + ch] = silu_f(y);
    }
  }
  __syncthreads();
  {
    int vec = tid >> 2, part = tid & 3;
    int rr = vec >> 3, hv = vec & 7;
    const float* v = buf + rr * 1536 + hv * 128 + part * 32;
    float ss = 0.f;
#pragma unroll
    for (int i = 0; i < 32; ++i) ss += v[i] * v[i];
    ss += __shfl_xor(ss, 1);
    ss += __shfl_xor(ss, 2);
    if (part == 0) nrm[vec] = rsqrtf(ss + 1e-6f);
  }
  __syncthreads();
  for (int i = tid; i < 8 * 1536; i += 256) {
    int rr = i / 1536, ch = i - rr * 1536;
    float v = buf[i];
    if (ch < 1024) v *= nrm[rr * 8 + (ch >> 7)];
    DQ[(size_t)(r0 + rr) * 1536 + ch] = f2bf(v);
  }
}


DEVI int rowmap(int r, int hh) { return (r & 3) + 8 * (r >> 2) + 4 * hh; }

DEVI void unpack8(const uint4& u, float* f) {
  f[0] = bflo(u.x); f[1] = bfhi(u.x); f[2] = bflo(u.y); f[3] = bfhi(u.y);
  f[4] = bflo(u.z); f[5] = bfhi(u.z); f[6] = bflo(u.w); f[7] = bfhi(u.w);
}
__device__ void dn_chunk_prep(const Params& p, int l, int item, char* smem) {
  float* sW = (float*)smem;
  bf16_t* sKb = (bf16_t*)(smem + 7680);
  float* sL0 = (float*)(smem + 25088);
  float* sL1 = sL0 + 64 * 68;
  float* sg = (float*)(smem + 59904);
  float* sbt = sg + 128;
  const int tid = otid(), lane = tid & 63, w = tid >> 6, li = lane & 31, hh = lane >> 5;
  const int chunk = item >> 2, h = item & 3;
  int row0, seq_lo, seq_hi;
  if (chunk < 256) {
    int b = chunk >> 5;
    row0 = b * 2048 + (chunk & 31) * 64; seq_lo = b * 2048; seq_hi = seq_lo + 2048;
  } else {
    int cc = chunk - 256, b = cc >> 2;
    row0 = M_LAT + b * 256 + (cc & 3) * 64; seq_lo = M_LAT + b * 256; seq_hi = seq_lo + 256;
  }
  const bf16_t* P = (const bf16_t*)(p.ws + OFF_P);
  bf16_t* DQ = (bf16_t*)(p.ws + OFF_DNQKV);
  const float* AB = (const float*)(p.ws + OFF_AB);
  const float* cw = p.conv_w + (size_t)l * 5 * 1536;
  __syncthreads();
  for (int i = tid; i < 5 * 384; i += 256) {
    const int tap = i / 384, cc = i - tap * 384, type = cc >> 7, c = cc & 127;
    const int off = type == 0 ? 512 : (type == 1 ? 0 : 1024);
    sW[i] = cw[tap * 1536 + off + h * 128 + c];
  }
  if (w < 2) {
    const int d = w;
    const int row = d ? (row0 + 63 - lane) : (row0 + lane);
    const float Aneg = -__expf(p.a_log[l * 8 + d * 4 + h]);
    const float dtb = p.dt_bias[l * 8 + d * 4 + h];
    float a = AB[(size_t)row * 16 + d * 4 + h];
    float bb = AB[(size_t)row * 16 + 8 + d * 4 + h];
    float xx = a + dtb;
    const float ee = __expf(xx);
    float sp = ee < 0.25f ? ee * (1.f - ee * (0.5f - ee * (0.33333333f - ee * (0.25f - 0.2f * ee))))
                          : (xx > 20.f ? xx : __logf(1.f + ee));
    float g = Aneg * sp;
#pragma unroll
    for (int o = 1; o < 64; o <<= 1) {
      float y = __shfl_up(g, o);
      if (lane >= o) g += y;
    }
    float be = 1.f / (1.f + __expf(-bb));
    sg[d * 64 + lane] = g;
    sbt[d * 64 + lane] = be;
    ((float*)(p.ws + OFF_GC))[(size_t)row * 8 + d * 4 + h] = g;
    ((float*)(p.ws + OFF_BETA))[(size_t)row * 8 + d * 4 + h] = be;
  }
  __syncthreads();
  const int cg = tid & 15, rsub = tid >> 4;
#pragma unroll 1
  for (int type = 0; type < 3; ++type) {
    const int off = type == 0 ? 512 : (type == 1 ? 0 : 1024);
    uint4 xv[4][5];
#pragma unroll
    for (int e = 0; e < 4; ++e) {
      const int row = rsub + 16 * e;
      const bf16_t* base = P + (size_t)(row0 + row) * INWP + C_DN + off + h * 128 + cg * 8;
#pragma unroll
      for (int dd = 0; dd < 5; ++dd) {
        const int r = row0 + row + dd - 2;
        xv[e][dd] = (r >= seq_lo && r < seq_hi) ? *(const uint4*)(base + (dd - 2) * INWP) : make_uint4(0u, 0u, 0u, 0u);
      }
    }
#pragma unroll
    for (int e = 0; e < 4; ++e) {
      const int row = rsub + 16 * e;
      float y[8];
#pragma unroll
      for (int j = 0; j < 8; ++j) y[j] = 0.f;
#pragma unroll
      for (int dd = 0; dd < 5; ++dd) {
        float xf[8];
        unpack8(xv[e][dd], xf);
        const float4 wa = *(const float4*)(sW + dd * 384 + type * 128 + cg * 8);
        const float4 wb = *(const float4*)(sW + dd * 384 + type * 128 + cg * 8 + 4);
        y[0] += wa.x * xf[0]; y[1] += wa.y * xf[1]; y[2] += wa.z * xf[2]; y[3] += wa.w * xf[3];
        y[4] += wb.x * xf[4]; y[5] += wb.y * xf[5]; y[6] += wb.z * xf[6]; y[7] += wb.w * xf[7];
      }
      float ss = 0.f;
#pragma unroll
      for (int j = 0; j < 8; ++j) {
        y[j] = silu_f(y[j]);
        ss += y[j] * y[j];
      }
      if (type < 2) {
        ss += __shfl_xor(ss, 1);
        ss += __shfl_xor(ss, 2);
        ss += __shfl_xor(ss, 4);
        ss += __shfl_xor(ss, 8);
        const float rn = rsqrtf(ss + 1e-6f);
#pragma unroll
        for (int j = 0; j < 8; ++j) y[j] *= rn;
      }
      uint4 u;
      u.x = pack2(y[0], y[1]); u.y = pack2(y[2], y[3]); u.z = pack2(y[4], y[5]); u.w = pack2(y[6], y[7]);
      *(uint4*)(DQ + (size_t)(row0 + row) * 1536 + off + h * 128 + cg * 8) = u;
      if (type == 0) *(uint4*)(sKb + row * 136 + cg * 8) = u;
    }
  }
  __syncthreads();
  {
    const int mi = w >> 1, ni = w & 1;
    f32x16 g;
#pragma unroll
    for (int r = 0; r < 16; ++r) g[r] = 0.f;
#pragma unroll
    for (int ks = 0; ks < 8; ++ks) {
      bf16x8 a = *(const bf16x8*)(sKb + (mi * 32 + li) * 136 + ks * 16 + hh * 8);
      bf16x8 b = *(const bf16x8*)(sKb + (ni * 32 + li) * 136 + ks * 16 + hh * 8);
      g = __builtin_amdgcn_mfma_f32_32x32x16_bf16(a, b, g, 0, 0, 0);
    }
#pragma unroll
    for (int r = 0; r < 16; ++r) {
      const int i = mi * 32 + rowmap(r, hh), m = ni * 32 + li;
      const float G = g[r];
      sL0[i * 68 + m] = (i > m) ? sbt[i] * G * __expf(sg[i] - sg[m]) : 0.f;
      const int i1 = 63 - i, m1 = 63 - m;
      sL1[i1 * 68 + m1] = (i1 > m1) ? sbt[64 + i1] * G * __expf(sg[64 + i1] - sg[64 + m1]) : 0.f;
    }
  }
  __syncthreads();
  if (w < 2) {
    const float* L = w == 0 ? sL0 : sL1;
    float t[64];
#pragma unroll
    for (int i = 0; i < 64; ++i) {
      float a0 = (i == lane) ? 1.f : 0.f, a1 = 0.f, a2 = 0.f, a3 = 0.f;
#pragma unroll
      for (int m = 0; m < i; ++m) {
        const float pr = L[i * 68 + m] * t[m];
        if ((m & 3) == 0) a0 -= pr;
        else if ((m & 3) == 1) a1 -= pr;
        else if ((m & 3) == 2) a2 -= pr;
        else a3 -= pr;
      }
      t[i] = (a0 + a1) + (a2 + a3);
    }
    bf16_t* Tg = (bf16_t*)(p.ws + OFF_OB) + (size_t)((chunk * 4 + h) * 2 + w) * 4096;
#pragma unroll
    for (int i = 0; i < 64; ++i) Tg[i * 64 + lane] = f2bf(t[i]);
  }
}

DEVI bf16x8 ld_perm(const bf16_t* p) {
  union { bf16x8 v; uint2 d[2]; } u;
  u.d[0] = *(const uint2*)(p);
  u.d[1] = *(const uint2*)(p + 8);
  return u.v;
}
DEVI bf16x8 pack8(const f32x16& x, int s) {
  union { bf16x8 v; unsigned w[4]; } u;
  u.w[0] = pack2(x[8 * s + 0], x[8 * s + 1]);
  u.w[1] = pack2(x[8 * s + 2], x[8 * s + 3]);
  u.w[2] = pack2(x[8 * s + 4], x[8 * s + 5]);
  u.w[3] = pack2(x[8 * s + 6], x[8 * s + 7]);
  return u.v;
}

__device__ void dn_scan(const Params& p, int l, int item, char* smem) {
  bf16_t* sK = (bf16_t*)smem;
  bf16_t* sQ = (bf16_t*)(smem + 17408);
  bf16_t* sKT = (bf16_t*)(smem + 34816);
  bf16_t* sT = (bf16_t*)(smem + 52224);
  bf16_t* sA = (bf16_t*)(smem + 60928);
  bf16_t* sV = (bf16_t*)(smem + 52224);
  float* sg = (float*)(smem + 69632);
  float* sbt = sg + 64;
  float* seg = sbt + 64;
  float* sdt = seg + 64;
  const int d = item & 1, h = (item >> 1) & 3, b = item >> 3;
  const bf16_t* DQ = (const bf16_t*)(p.ws + OFF_DNQKV);
  const bf16_t* TB = (const bf16_t*)(p.ws + OFF_OB);
  const float* GC = (const float*)(p.ws + OFF_GC);
  const float* BE = (const float*)(p.ws + OFF_BETA);
  bf16_t* MIX = (bf16_t*)(p.ws + OFF_HM);
  bf16_t* Pw = (bf16_t*)(p.ws + OFF_P);
  const float qscale = 0.08838834764831845f;
  const int rsign = d ? -1 : 1;
  f32x16 S0, S1, S2, S3;
#pragma unroll
  for (int r = 0; r < 16; ++r) { S0[r] = 0.f; S1[r] = 0.f; S2[r] = 0.f; S3[r] = 0.f; }
  __builtin_amdgcn_s_setprio(3);
  uint4 qA0, qB0, kA0, kB0, vA0, vB0, qA1, qB1, kA1, kB1, vA1, vB1, tq0, tq1;
  float pgc = 0.f, pbe = 0.f;
#define SCAN_ROW0(N, CHUNK, ROW0)                                    \
  {                                                                  \
    if ((N) < 4) {                                                   \
      int cn = d ? (3 - (N)) : (N);                                  \
      CHUNK = 256 + b * 4 + cn;                                      \
      ROW0 = M_LAT + b * 256 + cn * 64;                              \
    } else {                                                         \
      int ln = (N)-4;                                                \
      ln = d ? (31 - ln) : ln;                                       \
      CHUNK = b * 32 + ln;                                           \
      ROW0 = b * 2048 + ln * 64;                                     \
    }                                                                \
  }
#define SCAN_LOADS(N)                                                                         \
  {                                                                                           \
    const int tid_ = otid();                                                                  \
    int chunk_, row0_;                                                                        \
    SCAN_ROW0(N, chunk_, row0_)                                                               \
    const int rstart_ = d ? (row0_ + 63) : row0_;                                             \
    {                                                                                         \
      const int u = tid_, c8 = u & 15, tp = u >> 4;                                           \
      const bf16_t* ga = DQ + (size_t)(rstart_ + rsign * 2 * tp) * 1536 + h * 128 + c8 * 8;   \
      const bf16_t* gb = ga + rsign * 1536;                                                   \
      qA0 = *(const uint4*)(ga); kA0 = *(const uint4*)(ga + 512); vA0 = *(const uint4*)(ga + 1024); \
      qB0 = *(const uint4*)(gb); kB0 = *(const uint4*)(gb + 512); vB0 = *(const uint4*)(gb + 1024); \
    }                                                                                         \
    {                                                                                         \
      const int u = tid_ + 256, c8 = u & 15, tp = u >> 4;                                     \
      const bf16_t* ga = DQ + (size_t)(rstart_ + rsign * 2 * tp) * 1536 + h * 128 + c8 * 8;   \
      const bf16_t* gb = ga + rsign * 1536;                                                   \
      qA1 = *(const uint4*)(ga); kA1 = *(const uint4*)(ga + 512); vA1 = *(const uint4*)(ga + 1024); \
      qB1 = *(const uint4*)(gb); kB1 = *(const uint4*)(gb + 512); vB1 = *(const uint4*)(gb + 1024); \
    }                                                                                         \
    {                                                                                         \
      const bf16_t* Tg = TB + (size_t)((chunk_ * 4 + h) * 2 + d) * 4096;                      \
      tq0 = *(const uint4*)(Tg + (tid_ >> 3) * 64 + (tid_ & 7) * 8);                          \
      tq1 = *(const uint4*)(Tg + ((tid_ >> 3) + 32) * 64 + (tid_ & 7) * 8);                   \
    }                                                                                         \
    if (tid_ < 64) {                                                                          \
      const int row = rstart_ + rsign * tid_;                                                 \
      pgc = GC[(size_t)row * 8 + d * 4 + h];                                                  \
      pbe = BE[(size_t)row * 8 + d * 4 + h];                                                  \
    }                                                                                         \
  }
  SCAN_LOADS(0)
  for (int n = 0; n < 36; ++n) {
    const int tid = otid(), lane = tid & 63, w = tid >> 6, li = lane & 31, hh = lane >> 5;
    int chunk, row0;
    SCAN_ROW0(n, chunk, row0)
    (void)chunk;
    const int rstart = d ? (row0 + 63) : row0;
    __syncthreads();
#define STAGE_UNIT(U, QA, QB, KA, KB, VA, VB)                                                   \
  {                                                                                             \
    const int c8 = (U)&15, tp = (U) >> 4;                                                       \
    *(uint4*)(sQ + (2 * tp) * 136 + c8 * 8) = QA;                                               \
    *(uint4*)(sQ + (2 * tp + 1) * 136 + c8 * 8) = QB;                                           \
    *(uint4*)(sK + (2 * tp) * 136 + c8 * 8) = KA;                                               \
    *(uint4*)(sK + (2 * tp + 1) * 136 + c8 * 8) = KB;                                           \
    *(uint4*)(sV + (2 * tp) * 136 + c8 * 8) = VA;                                               \
    *(uint4*)(sV + (2 * tp + 1) * 136 + c8 * 8) = VB;                                           \
    unsigned* kt = (unsigned*)(sKT + (c8 * 8) * 68 + 2 * tp);                                   \
    kt[0 * 34] = (KA.x & 0xffffu) | (KB.x << 16);                                               \
    kt[1 * 34] = (KA.x >> 16) | (KB.x & 0xffff0000u);                                           \
    kt[2 * 34] = (KA.y & 0xffffu) | (KB.y << 16);                                               \
    kt[3 * 34] = (KA.y >> 16) | (KB.y & 0xffff0000u);                                           \
    kt[4 * 34] = (KA.z & 0xffffu) | (KB.z << 16);                                               \
    kt[5 * 34] = (KA.z >> 16) | (KB.z & 0xffff0000u);                                           \
    kt[6 * 34] = (KA.w & 0xffffu) | (KB.w << 16);                                               \
    kt[7 * 34] = (KA.w >> 16) | (KB.w & 0xffff0000u);                                           \
  }
    STAGE_UNIT(tid, qA0, qB0, kA0, kB0, vA0, vB0)
    STAGE_UNIT(tid + 256, qA1, qB1, kA1, kB1, vA1, vB1)
#undef STAGE_UNIT
    if (tid < 64) {
      float g63 = __shfl(pgc, 63);
      sg[lane] = pgc;
      sbt[lane] = pbe;
      seg[lane] = __expf(pgc);
      sdt[lane] = __expf(g63 - pgc);
    }
    __syncthreads();
    f32x16 v0, v1;
#pragma unroll
    for (int r = 0; r < 16; ++r) {
      const int t0 = rowmap(r, hh);
      v0[r] = bf2f(sV[t0 * 136 + w * 32 + li]);
      v1[r] = bf2f(sV[(32 + t0) * 136 + w * 32 + li]);
    }
    __syncthreads();
    {
      const int i0 = tid >> 3, c8 = tid & 7;
      *(uint2*)(sT + i0 * 68 + c8 * 8) = make_uint2(tq0.x, tq0.y);
      *(uint2*)(sT + i0 * 68 + c8 * 8 + 4) = make_uint2(tq0.z, tq0.w);
      *(uint2*)(sT + (i0 + 32) * 68 + c8 * 8) = make_uint2(tq1.x, tq1.y);
      *(uint2*)(sT + (i0 + 32) * 68 + c8 * 8 + 4) = make_uint2(tq1.z, tq1.w);
    }
    {
      const int mi = w >> 1, ni = w & 1;
      f32x16 a;
#pragma unroll
      for (int r = 0; r < 16; ++r) a[r] = 0.f;
      if (!(mi == 0 && ni == 1)) {
#pragma unroll
        for (int ks = 0; ks < 8; ++ks) {
          bf16x8 qa = *(const bf16x8*)(sQ + (mi * 32 + li) * 136 + ks * 16 + hh * 8);
          bf16x8 kb = *(const bf16x8*)(sK + (ni * 32 + li) * 136 + ks * 16 + hh * 8);
          a = __builtin_amdgcn_mfma_f32_32x32x16_bf16(qa, kb, a, 0, 0, 0);
        }
      }
#pragma unroll
      for (int r = 0; r < 16; ++r) {
        const int i = mi * 32 + rowmap(r, hh), j = ni * 32 + li;
        float val = (i >= j) ? a[r] * qscale * __expf(sg[i] - sg[j]) : 0.f;
        sA[i * 68 + j] = f2bf(val);
      }
    }
    __syncthreads();
    f32x16 ks0, ks1;
#pragma unroll
    for (int r = 0; r < 16; ++r) { ks0[r] = 0.f; ks1[r] = 0.f; }
    {
      const bf16_t* ka = sK + li * 136 + 4 * hh;
#define K_STEP(OFFS, SX, SS)                                                                           \
  {                                                                                                    \
    bf16x8 sb = pack8(SX, SS);                                                                         \
    ks0 = __builtin_amdgcn_mfma_f32_32x32x16_bf16(ld_perm(ka + (OFFS)), sb, ks0, 0, 0, 0);             \
    ks1 = __builtin_amdgcn_mfma_f32_32x32x16_bf16(ld_perm(ka + 32 * 136 + (OFFS)), sb, ks1, 0, 0, 0);  \
  }
      K_STEP(0, S0, 0) K_STEP(16, S0, 1) K_STEP(32, S1, 0) K_STEP(48, S1, 1)
      K_STEP(64, S2, 0) K_STEP(80, S2, 1) K_STEP(96, S3, 0) K_STEP(112, S3, 1)
#undef K_STEP
    }
#pragma unroll
    for (int r = 0; r < 16; ++r) {
      const int t0 = rowmap(r, hh), t1 = 32 + t0;
      v0[r] = sbt[t0] * (v0[r] - seg[t0] * ks0[r]);
      v1[r] = sbt[t1] * (v1[r] - seg[t1] * ks1[r]);
    }
    __builtin_amdgcn_sched_barrier(0);
    bf16x8 rb00 = pack8(v0, 0), rb01 = pack8(v0, 1), rb10 = pack8(v1, 0), rb11 = pack8(v1, 1);
    f32x16 n0, n1;
#pragma unroll
    for (int r = 0; r < 16; ++r) { n0[r] = 0.f; n1[r] = 0.f; }
    {
      const bf16_t* ta = sT + li * 68 + 4 * hh;
      n0 = __builtin_amdgcn_mfma_f32_32x32x16_bf16(ld_perm(ta + 0), rb00, n0, 0, 0, 0);
      n0 = __builtin_amdgcn_mfma_f32_32x32x16_bf16(ld_perm(ta + 16), rb01, n0, 0, 0, 0);
      const bf16_t* tb = ta + 32 * 68;
      n1 = __builtin_amdgcn_mfma_f32_32x32x16_bf16(ld_perm(tb + 0), rb00, n1, 0, 0, 0);
      n1 = __builtin_amdgcn_mfma_f32_32x32x16_bf16(ld_perm(tb + 16), rb01, n1, 0, 0, 0);
      n1 = __builtin_amdgcn_mfma_f32_32x32x16_bf16(ld_perm(tb + 32), rb10, n1, 0, 0, 0);
      n1 = __builtin_amdgcn_mfma_f32_32x32x16_bf16(ld_perm(tb + 48), rb11, n1, 0, 0, 0);
    }
    __builtin_amdgcn_sched_barrier(0);
    f32x16 o0, o1;
#pragma unroll
    for (int r = 0; r < 16; ++r) { o0[r] = 0.f; o1[r] = 0.f; }
    {
      const bf16_t* qa = sQ + li * 136 + 4 * hh;
#define Q_STEP(OFFS, SX, SS)                                                                           \
  {                                                                                                    \
    bf16x8 sb = pack8(SX, SS);                                                                         \
    o0 = __builtin_amdgcn_mfma_f32_32x32x16_bf16(ld_perm(qa + (OFFS)), sb, o0, 0, 0, 0);               \
    o1 = __builtin_amdgcn_mfma_f32_32x32x16_bf16(ld_perm(qa + 32 * 136 + (OFFS)), sb, o1, 0, 0, 0);    \
  }
      Q_STEP(0, S0, 0) Q_STEP(16, S0, 1) Q_STEP(32, S1, 0) Q_STEP(48, S1, 1)
      Q_STEP(64, S2, 0) Q_STEP(80, S2, 1) Q_STEP(96, S3, 0) Q_STEP(112, S3, 1)
#undef Q_STEP
    }
#pragma unroll
    for (int r = 0; r < 16; ++r) {
      const int t0 = rowmap(r, hh), t1 = 32 + t0;
      o0[r] *= seg[t0] * qscale;
      o1[r] *= seg[t1] * qscale;
    }
    {
      bf16x8 nb00 = pack8(n0, 0), nb01 = pack8(n0, 1), nb10 = pack8(n1, 0), nb11 = pack8(n1, 1);
      const bf16_t* aa = sA + li * 68 + 4 * hh;
      o0 = __builtin_amdgcn_mfma_f32_32x32x16_bf16(ld_perm(aa + 0), nb00, o0, 0, 0, 0);
      o0 = __builtin_amdgcn_mfma_f32_32x32x16_bf16(ld_perm(aa + 16), nb01, o0, 0, 0, 0);
      const bf16_t* ab = aa + 32 * 68;
      o1 = __builtin_amdgcn_mfma_f32_32x32x16_bf16(ld_perm(ab + 0), nb00, o1, 0, 0, 0);
      o1 = __builtin_amdgcn_mfma_f32_32x32x16_bf16(ld_perm(ab + 16), nb01, o1, 0, 0, 0);
      o1 = __builtin_amdgcn_mfma_f32_32x32x16_bf16(ld_perm(ab + 32), nb10, o1, 0, 0, 0);
      o1 = __builtin_amdgcn_mfma_f32_32x32x16_bf16(ld_perm(ab + 48), nb11, o1, 0, 0, 0);
    }
    __syncthreads();
#pragma unroll
    for (int r = 0; r < 16; ++r) {
      const int t0 = rowmap(r, hh);
      sQ[t0 * 136 + w * 32 + li] = f2bf(o0[r]);
      sQ[(32 + t0) * 136 + w * 32 + li] = f2bf(o1[r]);
    }
#pragma unroll
    for (int r = 0; r < 16; ++r) {
      const int t0 = rowmap(r, hh), t1 = 32 + t0;
      n0[r] *= sdt[t0];
      n1[r] *= sdt[t1];
    }
    {
      bf16x8 nb00 = pack8(n0, 0), nb01 = pack8(n0, 1), nb10 = pack8(n1, 0), nb11 = pack8(n1, 1);
      const float eg63 = seg[63];
#pragma unroll
      for (int r = 0; r < 16; ++r) { S0[r] *= eg63; S1[r] *= eg63; S2[r] *= eg63; S3[r] *= eg63; }
      __builtin_amdgcn_sched_barrier(0);
      SCAN_LOADS(min(n + 1, 35))
      __builtin_amdgcn_sched_barrier(0);
      const bf16_t* kt = sKT + li * 68 + 4 * hh;
#define S_UPD(SX, DKT)                                                                                   \
  SX = __builtin_amdgcn_mfma_f32_32x32x16_bf16(ld_perm(kt + (DKT) * 32 * 68 + 0), nb00, SX, 0, 0, 0);    \
  SX = __builtin_amdgcn_mfma_f32_32x32x16_bf16(ld_perm(kt + (DKT) * 32 * 68 + 16), nb01, SX, 0, 0, 0);   \
  SX = __builtin_amdgcn_mfma_f32_32x32x16_bf16(ld_perm(kt + (DKT) * 32 * 68 + 32), nb10, SX, 0, 0, 0);   \
  SX = __builtin_amdgcn_mfma_f32_32x32x16_bf16(ld_perm(kt + (DKT) * 32 * 68 + 48), nb11, SX, 0, 0, 0);
      S_UPD(S0, 0) S_UPD(S1, 1) S_UPD(S2, 2) S_UPD(S3, 3)
#undef S_UPD
    }
    __syncthreads();
    {
      bf16_t* obase = d ? (Pw + C_DN + h * 128) : (MIX + 512 + h * 128);
      const int ostride = d ? INWP : 1024;
#pragma unroll
      for (int e = 0; e < 4; ++e) {
        const int idx = tid + 256 * e, tok = idx >> 4, c8 = idx & 15;
        const int row = rstart + rsign * tok;
        *(uint4*)(obase + (size_t)row * ostride + c8 * 8) = *(const uint4*)(sQ + tok * 136 + c8 * 8);
      }
    }
  }
#undef SCAN_LOADS
#undef SCAN_ROW0
  __builtin_amdgcn_s_setprio(0);
}

__device__ void phaseC(const Params& p, int l, char* smem) {
  const int nb = gridDim.x, bid = blockIdx.x;
  const bf16_t* P = (const bf16_t*)(p.ws + OFF_P);
  constexpr int T0 = 1152, T1 = T0 + 144 * 3, T2 = T1 + 144 * 4, T3 = T2 + M_ALL / 8;
  for (int it = bid; it < T3; it += nb) {
    if (it < T0) {
      dn_chunk_prep(p, l, it, smem);
    } else if (it < T1) {
      int i = it - T0;
      if (l == 3 && i >= 128 * 3) continue;
      gemm_tile<EPI_QUP>(p, l, P + C_MQ, INWP, (const bf16_t*)(p.ws + OFF_WQUP), 256, (i / 3) * 128, (i % 3) * 128, 0,
                         smem);
    } else if (it < T2) {
      int i = it - T1;
      gemm_tile<EPI_KVUP>(p, l, P + C_MKV, INWP, (const bf16_t*)(p.ws + OFF_WKVUP), 128, (i / 4) * 128, (i % 4) * 128,
                          0, smem);
    } else {
      kpe_item(p, it - T2);
    }
  }
}

__device__ void mla_flash(const Params& p, int item, char* smem) {
  bf16_t* sK = (bf16_t*)smem;
  bf16_t* sV = sK + 64 * 104;
  const int tid = otid(), lane = tid & 63, w = tid >> 6;
  const int li = lane & 31, hh = lane >> 5;
  int b, h, q0row, nkeys;
  if (item < 512) {
    b = item >> 6; h = (item >> 4) & 3; q0row = b * 2048 + (item & 15) * 128; nkeys = 2304;
  } else {
    int i = item - 512;
    b = i >> 3; h = (i >> 1) & 3; q0row = M_LAT + b * 256 + (i & 1) * 128; nkeys = 256;
  }
  const bf16_t* Kg = (const bf16_t*)(p.ws + OFF_KH) + (size_t)(b * 4 + h) * 2304 * 96;
  const bf16_t* Vg = (const bf16_t*)(p.ws + OFF_VH) + (size_t)(b * 4 + h) * 64 * 2304;
  const bf16_t* QH = (const bf16_t*)(p.ws + OFF_QH);
  bf16_t* MIX = (bf16_t*)(p.ws + OFF_HM);
  const int qrow = q0row + w * 32 + li;
  bf16x8 qf0, qf1, qf2, qf3, qf4, qf5;
  {
    const bf16_t* qp = QH + (size_t)qrow * 384 + h * 96 + hh * 8;
    qf0 = *(const bf16x8*)(qp); qf1 = *(const bf16x8*)(qp + 16); qf2 = *(const bf16x8*)(qp + 32);
    qf3 = *(const bf16x8*)(qp + 48); qf4 = *(const bf16x8*)(qp + 64); qf5 = *(const bf16x8*)(qp + 80);
  }
  const int k_i0 = tid, k_i1 = tid + 256, k_i2 = tid + 512;
  const int kk0 = k_i0 / 12, kc0 = k_i0 % 12, kk1 = k_i1 / 12, kc1 = k_i1 % 12, kk2 = k_i2 / 12, kc2 = k_i2 % 12;
  const int vd0 = tid >> 3, vc0 = tid & 7, vd1 = vd0 + 32;
  uint4 rk0, rk1, rk2, rv0, rv1;
  rk0 = *(const uint4*)(Kg + (size_t)kk0 * 96 + kc0 * 8);
  rk1 = *(const uint4*)(Kg + (size_t)kk1 * 96 + kc1 * 8);
  rk2 = *(const uint4*)(Kg + (size_t)kk2 * 96 + kc2 * 8);
  rv0 = *(const uint4*)(Vg + (size_t)vd0 * 2304 + vc0 * 8);
  rv1 = *(const uint4*)(Vg + (size_t)vd1 * 2304 + vc0 * 8);
  f32x16 o0, o1;
#pragma unroll
  for (int r = 0; r < 16; ++r) { o0[r] = 0.f; o1[r] = 0.f; }
  float m = -1e30f, lp = 0.f;
  const float sc = 0.10206207261596577f * 1.4426950408889634f;
  const int nt = nkeys >> 6;
  for (int t = 0; t < nt; ++t) {
    __syncthreads();
    *(uint4*)(sK + kk0 * 104 + kc0 * 8) = rk0;
    *(uint4*)(sK + kk1 * 104 + kc1 * 8) = rk1;
    *(uint4*)(sK + kk2 * 104 + kc2 * 8) = rk2;
    *(uint2*)(sV + vd0 * 68 + vc0 * 8) = make_uint2(rv0.x, rv0.y);
    *(uint2*)(sV + vd0 * 68 + vc0 * 8 + 4) = make_uint2(rv0.z, rv0.w);
    *(uint2*)(sV + vd1 * 68 + vc0 * 8) = make_uint2(rv1.x, rv1.y);
    *(uint2*)(sV + vd1 * 68 + vc0 * 8 + 4) = make_uint2(rv1.z, rv1.w);
    __syncthreads();
    if (t + 1 < nt) {
      const int k0 = (t + 1) * 64;
      rk0 = *(const uint4*)(Kg + (size_t)(k0 + kk0) * 96 + kc0 * 8);
      rk1 = *(const uint4*)(Kg + (size_t)(k0 + kk1) * 96 + kc1 * 8);
      rk2 = *(const uint4*)(Kg + (size_t)(k0 + kk2) * 96 + kc2 * 8);
      rv0 = *(const uint4*)(Vg + (size_t)vd0 * 2304 + k0 + vc0 * 8);
      rv1 = *(const uint4*)(Vg + (size_t)vd1 * 2304 + k0 + vc0 * 8);
    }
    f32x16 s0, s1;
#pragma unroll
    for (int r = 0; r < 16; ++r) { s0[r] = 0.f; s1[r] = 0.f; }
    {
      const bf16_t* ka = sK + li * 104 + hh * 8;
      const bf16_t* kb = ka + 32 * 104;
      s0 = __builtin_amdgcn_mfma_f32_32x32x16_bf16(*(const bf16x8*)(ka), qf0, s0, 0, 0, 0);
      s1 = __builtin_amdgcn_mfma_f32_32x32x16_bf16(*(const bf16x8*)(kb), qf0, s1, 0, 0, 0);
      s0 = __builtin_amdgcn_mfma_f32_32x32x16_bf16(*(const bf16x8*)(ka + 16), qf1, s0, 0, 0, 0);
      s1 = __builtin_amdgcn_mfma_f32_32x32x16_bf16(*(const bf16x8*)(kb + 16), qf1, s1, 0, 0, 0);
      s0 = __builtin_amdgcn_mfma_f32_32x32x16_bf16(*(const bf16x8*)(ka + 32), qf2, s0, 0, 0, 0);
      s1 = __builtin_amdgcn_mfma_f32_32x32x16_bf16(*(const bf16x8*)(kb + 32), qf2, s1, 0, 0, 0);
      s0 = __builtin_amdgcn_mfma_f32_32x32x16_bf16(*(const bf16x8*)(ka + 48), qf3, s0, 0, 0, 0);
      s1 = __builtin_amdgcn_mfma_f32_32x32x16_bf16(*(const bf16x8*)(kb + 48), qf3, s1, 0, 0, 0);
      s0 = __builtin_amdgcn_mfma_f32_32x32x16_bf16(*(const bf16x8*)(ka + 64), qf4, s0, 0, 0, 0);
      s1 = __builtin_amdgcn_mfma_f32_32x32x16_bf16(*(const bf16x8*)(kb + 64), qf4, s1, 0, 0, 0);
      s0 = __builtin_amdgcn_mfma_f32_32x32x16_bf16(*(const bf16x8*)(ka + 80), qf5, s0, 0, 0, 0);
      s1 = __builtin_amdgcn_mfma_f32_32x32x16_bf16(*(const bf16x8*)(kb + 80), qf5, s1, 0, 0, 0);
    }
    float mx = s0[0];
#pragma unroll
    for (int r = 1; r < 16; ++r) mx = fmaxf(mx, s0[r]);
#pragma unroll
    for (int r = 0; r < 16; ++r) mx = fmaxf(mx, s1[r]);
    mx = fmaxf(mx, __shfl_xor(mx, 32));
    const float mn = fmaxf(m, mx * sc);
    const float corr = __builtin_amdgcn_exp2f(m - mn);
    m = mn;
    lp *= corr;
#pragma unroll
    for (int r = 0; r < 16; ++r) { o0[r] *= corr; o1[r] *= corr; }
#pragma unroll
    for (int r = 0; r < 16; ++r) {
      s0[r] = __builtin_amdgcn_exp2f(s0[r] * sc - mn);
      s1[r] = __builtin_amdgcn_exp2f(s1[r] * sc - mn);
      lp += s0[r] + s1[r];
    }
#pragma unroll
    for (int u = 0; u < 2; ++u) {
#pragma unroll
      for (int s = 0; s < 2; ++s) {
        union { bf16x8 v; unsigned w[4]; } pb;
        if (u == 0) {
          pb.w[0] = pack2(s0[8 * s + 0], s0[8 * s + 1]); pb.w[1] = pack2(s0[8 * s + 2], s0[8 * s + 3]);
          pb.w[2] = pack2(s0[8 * s + 4], s0[8 * s + 5]); pb.w[3] = pack2(s0[8 * s + 6], s0[8 * s + 7]);
        } else {
          pb.w[0] = pack2(s1[8 * s + 0], s1[8 * s + 1]); pb.w[1] = pack2(s1[8 * s + 2], s1[8 * s + 3]);
          pb.w[2] = pack2(s1[8 * s + 4], s1[8 * s + 5]); pb.w[3] = pack2(s1[8 * s + 6], s1[8 * s + 7]);
        }
        const bf16_t* va = sV + li * 68 + 32 * u + 16 * s + 4 * hh;
        union { bf16x8 v; uint2 d[2]; } a0, a1;
        a0.d[0] = *(const uint2*)(va);
        a0.d[1] = *(const uint2*)(va + 8);
        a1.d[0] = *(const uint2*)(va + 32 * 68);
        a1.d[1] = *(const uint2*)(va + 32 * 68 + 8);
        o0 = __builtin_amdgcn_mfma_f32_32x32x16_bf16(a0.v, pb.v, o0, 0, 0, 0);
        o1 = __builtin_amdgcn_mfma_f32_32x32x16_bf16(a1.v, pb.v, o1, 0, 0, 0);
      }
    }
  }
  lp += __shfl_xor(lp, 32);
  const float inv = 1.f / lp;
  bf16_t* op = MIX + (size_t)qrow * 1024 + h * 64 + 4 * hh;
#pragma unroll
  for (int g = 0; g < 4; ++g) {
    uint2 u0, u1;
    u0.x = pack2(o0[4 * g + 0] * inv, o0[4 * g + 1] * inv);
    u0.y = pack2(o0[4 * g + 2] * inv, o0[4 * g + 3] * inv);
    u1.x = pack2(o1[4 * g + 0] * inv, o1[4 * g + 1] * inv);
    u1.y = pack2(o1[4 * g + 2] * inv, o1[4 * g + 3] * inv);
    *(uint2*)(op + 8 * g) = u0;
    *(uint2*)(op + 32 + 8 * g) = u1;
  }
}

__device__ void na_naive(const Params& p, int l, int ti) {
  const int h = otid() >> 6, lane = otid() & 63;
  const bf16_t* P = (const bf16_t*)(p.ws + OFF_P);
  bf16_t* MIX = (bf16_t*)(p.ws + OFF_HM);
  const bool lat = ti < 256;
  const int b = lat ? (ti >> 5) : ((ti - 256) >> 2);
  const int r = ti & 31;
  const int row = lat ? (ti * 64 + lane) : (M_LAT + (ti - 256) * 64 + lane);
  uint4 qk[8];
  float acc[64];
  {
    const uint4* qp = (const uint4*)(P + (size_t)row * INWP + C_NQ + h * 64);
#pragma unroll
    for (int c = 0; c < 8; ++c) qk[c] = qp[c];
  }
#pragma unroll
  for (int i = 0; i < 64; ++i) acc[i] = 0.f;
  float m = -INFINITY, ls = 0.f;
  const int qc = lane;
  const int rs0 = min(max(r - 4, 0), 24);
  const int cs0 = min(max(qc - 8, 0), 48);
  const float* rb = p.rel_bias + (size_t)l * 4 * 15 * 31 + h * 15 * 31;
  const int nloc = lat ? 128 : 0;
  for (int j = 0; j < nloc + 256; ++j) {
    int krow;
    float bias = 0.f;
    if (j < nloc) {
      int kr = rs0 + (j >> 4), kc = cs0 + (j & 15);
      krow = b * 2048 + kr * 64 + kc;
      bias = rb[(kr - r + 7) * 31 + (kc - qc + 15)];
    } else {
      krow = M_LAT + b * 256 + (j - nloc);
    }
    const uint4* kp = (const uint4*)(P + (size_t)krow * INWP + C_NK + h * 64);
    float s = 0.f;
#pragma unroll
    for (int c = 0; c < 8; ++c) {
      uint4 u = kp[c];
      uint4 q = qk[c];
      s += bflo(q.x) * bflo(u.x) + bfhi(q.x) * bfhi(u.x) + bflo(q.y) * bflo(u.y) + bfhi(q.y) * bfhi(u.y) +
           bflo(q.z) * bflo(u.z) + bfhi(q.z) * bfhi(u.z) + bflo(q.w) * bflo(u.w) + bfhi(q.w) * bfhi(u.w);
    }
    s = s * 0.125f + bias;
    float mn = fmaxf(m, s);
    float corr = __expf(m - mn), pe = __expf(s - mn);
    ls = ls * corr + pe;
    m = mn;
    const uint4* vp = (const uint4*)(P + (size_t)krow * INWP + C_NV + h * 64);
#pragma unroll
    for (int c = 0; c < 8; ++c) {
      uint4 u = vp[c];
      acc[c * 8 + 0] = acc[c * 8 + 0] * corr + pe * bflo(u.x);
      acc[c * 8 + 1] = acc[c * 8 + 1] * corr + pe * bfhi(u.x);
      acc[c * 8 + 2] = acc[c * 8 + 2] * corr + pe * bflo(u.y);
      acc[c * 8 + 3] = acc[c * 8 + 3] * corr + pe * bfhi(u.y);
      acc[c * 8 + 4] = acc[c * 8 + 4] * corr + pe * bflo(u.z);
      acc[c * 8 + 5] = acc[c * 8 + 5] * corr + pe * bfhi(u.z);
      acc[c * 8 + 6] = acc[c * 8 + 6] * corr + pe * bflo(u.w);
      acc[c * 8 + 7] = acc[c * 8 + 7] * corr + pe * bfhi(u.w);
    }
  }
  const float inv = 1.f / ls;
  uint4* op = (uint4*)(MIX + (size_t)row * 1024 + 256 + h * 64);
#pragma unroll
  for (int c = 0; c < 8; ++c) {
    uint4 u;
    u.x = pack2(acc[c * 8 + 0] * inv, acc[c * 8 + 1] * inv);
    u.y = pack2(acc[c * 8 + 2] * inv, acc[c * 8 + 3] * inv);
    u.z = pack2(acc[c * 8 + 4] * inv, acc[c * 8 + 5] * inv);
    u.w = pack2(acc[c * 8 + 6] * inv, acc[c * 8 + 7] * inv);
    op[c] = u;
  }
}

__device__ void na_flash(const Params& p, int l, int item, char* smem) {
  bf16_t* sK = (bf16_t*)smem;
  bf16_t* sV = sK + 64 * 72;
  float* sBias = (float*)(smem + 18432);
  const int tid = otid(), lane = tid & 63, w = tid >> 6;
  const int li = lane & 31, hh = lane >> 5;
  const bf16_t* P = (const bf16_t*)(p.ws + OFF_P);
  bf16_t* MIX = (bf16_t*)(p.ws + OFF_HM);
  int b, h, qrow, qr = 0, qc = 0, rs0 = 0, ntiles, krow0 = 0;
  bool lat;
  if (item < 512) {
    lat = true;
    b = item >> 6; h = item & 3;
    const int r0 = ((item >> 2) & 15) * 2;
    qr = r0 + (w >> 1); qc = (w & 1) * 32 + li;
    qrow = b * 2048 + qr * 64 + qc;
    krow0 = min(max(r0 - 4, 0), 24);
    const int klast = min(max(r0 + 1 - 4, 0), 24) + 7;
    ntiles = 4 + (klast - krow0 + 1);
    rs0 = min(max(qr - 4, 0), 24);
  } else {
    lat = false;
    const int i = item - 512;
    b = i >> 3; h = i & 3;
    qrow = M_LAT + b * 256 + ((i >> 2) & 1) * 128 + w * 32 + li;
    ntiles = 4;
  }
  const int cs0 = min(max(qc - 8, 0), 48);
  const bf16_t* Vg = (const bf16_t*)(p.ws + OFF_NVT) + (size_t)(b * 4 + h) * 64 * 2304;
  bf16x8 qf0, qf1, qf2, qf3;
  {
    const bf16_t* qp = P + (size_t)qrow * INWP + C_NQ + h * 64 + hh * 8;
    qf0 = *(const bf16x8*)(qp); qf1 = *(const bf16x8*)(qp + 16); qf2 = *(const bf16x8*)(qp + 32); qf3 = *(const bf16x8*)(qp + 48);
  }
  __syncthreads();
  for (int i = tid; i < 465; i += 256)
    sBias[i] = p.rel_bias[(size_t)l * 4 * 465 + h * 465 + i] * 1.4426950408889634f;
  const int kk0 = tid >> 3, kc8 = tid & 7, kk1 = kk0 + 32;
  uint4 rk0, rk1, rv0, rv1;
  {
    const size_t kr = (size_t)(M_LAT + b * 256);
    rk0 = *(const uint4*)(P + (kr + kk0) * INWP + C_NK + h * 64 + kc8 * 8);
    rk1 = *(const uint4*)(P + (kr + kk1) * INWP + C_NK + h * 64 + kc8 * 8);
    rv0 = *(const uint4*)(Vg + (size_t)kk0 * 2304 + kc8 * 8);
    rv1 = *(const uint4*)(Vg + (size_t)kk1 * 2304 + kc8 * 8);
  }
  f32x16 o0, o1;
#pragma unroll
  for (int r = 0; r < 16; ++r) { o0[r] = 0.f; o1[r] = 0.f; }
  float m = -1e30f, lp = 0.f;
  const float sc = 0.125f * 1.4426950408889634f;
  for (int t = 0; t < ntiles; ++t) {
    __syncthreads();
    *(uint4*)(sK + kk0 * 72 + kc8 * 8) = rk0;
    *(uint4*)(sK + kk1 * 72 + kc8 * 8) = rk1;
    *(uint2*)(sV + kk0 * 68 + kc8 * 8) = make_uint2(rv0.x, rv0.y);
    *(uint2*)(sV + kk0 * 68 + kc8 * 8 + 4) = make_uint2(rv0.z, rv0.w);
    *(uint2*)(sV + kk1 * 68 + kc8 * 8) = make_uint2(rv1.x, rv1.y);
    *(uint2*)(sV + kk1 * 68 + kc8 * 8 + 4) = make_uint2(rv1.z, rv1.w);
    __syncthreads();
    if (t + 1 < ntiles) {
      const int tn = t + 1;
      size_t kr;
      int vk;
      if (tn < 4) { kr = (size_t)(M_LAT + b * 256 + tn * 64); vk = tn * 64; }
      else { kr = (size_t)(b * 2048 + (krow0 + tn - 4) * 64); vk = 256 + (krow0 + tn - 4) * 64; }
      rk0 = *(const uint4*)(P + (kr + kk0) * INWP + C_NK + h * 64 + kc8 * 8);
      rk1 = *(const uint4*)(P + (kr + kk1) * INWP + C_NK + h * 64 + kc8 * 8);
      rv0 = *(const uint4*)(Vg + (size_t)kk0 * 2304 + vk + kc8 * 8);
      rv1 = *(const uint4*)(Vg + (size_t)kk1 * 2304 + vk + kc8 * 8);
    }
    const int kr_abs = krow0 + t - 4;
    const bool local = t >= 4;
    if (local && (kr_abs < rs0 || kr_abs >= rs0 + 8)) continue;
    f32x16 s0, s1;
#pragma unroll
    for (int r = 0; r < 16; ++r) { s0[r] = 0.f; s1[r] = 0.f; }
    {
      const bf16_t* ka = sK + li * 72 + hh * 8;
      const bf16_t* kb = ka + 32 * 72;
      s0 = __builtin_amdgcn_mfma_f32_32x32x16_bf16(*(const bf16x8*)(ka), qf0, s0, 0, 0, 0);
      s1 = __builtin_amdgcn_mfma_f32_32x32x16_bf16(*(const bf16x8*)(kb), qf0, s1, 0, 0, 0);
      s0 = __builtin_amdgcn_mfma_f32_32x32x16_bf16(*(const bf16x8*)(ka + 16), qf1, s0, 0, 0, 0);
      s1 = __builtin_amdgcn_mfma_f32_32x32x16_bf16(*(const bf16x8*)(kb + 16), qf1, s1, 0, 0, 0);
      s0 = __builtin_amdgcn_mfma_f32_32x32x16_bf16(*(const bf16x8*)(ka + 32), qf2, s0, 0, 0, 0);
      s1 = __builtin_amdgcn_mfma_f32_32x32x16_bf16(*(const bf16x8*)(kb + 32), qf2, s1, 0, 0, 0);
      s0 = __builtin_amdgcn_mfma_f32_32x32x16_bf16(*(const bf16x8*)(ka + 48), qf3, s0, 0, 0, 0);
      s1 = __builtin_amdgcn_mfma_f32_32x32x16_bf16(*(const bf16x8*)(kb + 48), qf3, s1, 0, 0, 0);
    }
    if (local) {
      const float* bp = sBias + (kr_abs - qr + 7) * 31 - qc + 15;
#pragma unroll
      for (int r = 0; r < 16; ++r) {
        const int kc0 = rowmap(r, hh), kc1 = 32 + kc0;
        const bool v0 = (kc0 >= cs0) && (kc0 < cs0 + 16);
        const bool v1 = (kc1 >= cs0) && (kc1 < cs0 + 16);
        const float b0 = v0 ? bp[kc0] : 0.f;
        const float b1 = v1 ? bp[kc1] : 0.f;
        s0[r] = v0 ? (s0[r] * sc + b0) : -1e30f;
        s1[r] = v1 ? (s1[r] * sc + b1) : -1e30f;
      }
    } else {
#pragma unroll
      for (int r = 0; r < 16; ++r) { s0[r] *= sc; s1[r] *= sc; }
    }
    float mx = s0[0];
#pragma unroll
    for (int r = 1; r < 16; ++r) mx = fmaxf(mx, s0[r]);
#pragma unroll
    for (int r = 0; r < 16; ++r) mx = fmaxf(mx, s1[r]);
    mx = fmaxf(mx, __shfl_xor(mx, 32));
    const float mn = fmaxf(m, mx);
    const float corr = __builtin_amdgcn_exp2f(m - mn);
    m = mn;
    lp *= corr;
#pragma unroll
    for (int r = 0; r < 16; ++r) { o0[r] *= corr; o1[r] *= corr; }
#pragma unroll
    for (int r = 0; r < 16; ++r) {
      s0[r] = __builtin_amdgcn_exp2f(s0[r] - mn);
      s1[r] = __builtin_amdgcn_exp2f(s1[r] - mn);
      lp += s0[r] + s1[r];
    }
#pragma unroll
    for (int u = 0; u < 2; ++u) {
#pragma unroll
      for (int s = 0; s < 2; ++s) {
        bf16x8 pb = u == 0 ? pack8(s0, s) : pack8(s1, s);
        const bf16_t* va = sV + li * 68 + 32 * u + 16 * s + 4 * hh;
        o0 = __builtin_amdgcn_mfma_f32_32x32x16_bf16(ld_perm(va), pb, o0, 0, 0, 0);
        o1 = __builtin_amdgcn_mfma_f32_32x32x16_bf16(ld_perm(va + 32 * 68), pb, o1, 0, 0, 0);
      }
    }
  }
  lp += __shfl_xor(lp, 32);
  const float inv = 1.f / lp;
  bf16_t* op = MIX + (size_t)qrow * 1024 + 256 + h * 64 + 4 * hh;
#pragma unroll
  for (int g = 0; g < 4; ++g) {
    uint2 u0, u1;
    u0.x = pack2(o0[4 * g + 0] * inv, o0[4 * g + 1] * inv);
    u0.y = pack2(o0[4 * g + 2] * inv, o0[4 * g + 3] * inv);
    u1.x = pack2(o1[4 * g + 0] * inv, o1[4 * g + 1] * inv);
    u1.y = pack2(o1[4 * g + 2] * inv, o1[4 * g + 3] * inv);
    *(uint2*)(op + 8 * g) = u0;
    *(uint2*)(op + 32 + 8 * g) = u1;
  }
}

DEVI int dn_rowof(int s, int b, int d) {
  if (s < 256) {
    int c = d ? (255 - s) : s;
    return M_LAT + b * 256 + c;
  }
  int t = s - 256;
  t = d ? (2047 - t) : t;
  return b * 2048 + t;
}

__device__ void dn_naive(const Params& p, int l, int it, char* smem) {
  float* ks = (float*)smem;
  float* qs = ks + 32 * 128;
  float* vs = qs + 32 * 128;
  float* gs = vs + 32 * 64;
  float* bs = gs + 32;
  const int half = it & 1, d = (it >> 1) & 1, h = (it >> 2) & 3, b = it >> 4;
  const int tid = otid(), w = tid >> 6, lane = tid & 63, c = lane & 15, kg = lane >> 4;
  const int col = half * 64 + w * 16 + c;
  const bf16_t* DQ = (const bf16_t*)(p.ws + OFF_DNQKV);
  const float* AB = (const float*)(p.ws + OFF_AB);
  bf16_t* MIX = (bf16_t*)(p.ws + OFF_HM);
  bf16_t* OB = (bf16_t*)(p.ws + OFF_OB);
  float S[32];
#pragma unroll
  for (int i = 0; i < 32; ++i) S[i] = 0.f;
  const float Aneg = -__expf(p.a_log[l * 8 + d * 4 + h]);
  const float dtb = p.dt_bias[l * 8 + d * 4 + h];
  for (int s0 = 0; s0 < 2304; s0 += 32) {
    __syncthreads();
    for (int i = tid; i < 32 * 128; i += 256) {
      int tk = i >> 7, ch = i & 127;
      int row = dn_rowof(s0 + tk, b, d);
      qs[i] = bf2f(DQ[(size_t)row * 1536 + h * 128 + ch]);
      ks[i] = bf2f(DQ[(size_t)row * 1536 + 512 + h * 128 + ch]);
    }
    for (int i = tid; i < 32 * 64; i += 256) {
      int tk = i >> 6, ch = i & 63;
      int row = dn_rowof(s0 + tk, b, d);
      vs[i] = bf2f(DQ[(size_t)row * 1536 + 1024 + h * 128 + half * 64 + ch]);
    }
    if (tid < 32) {
      int row = dn_rowof(s0 + tid, b, d);
      float a = AB[(size_t)row * 16 + d * 4 + h];
      float bb = AB[(size_t)row * 16 + 8 + d * 4 + h];
      float xx = a + dtb;
      const float ee = __expf(xx);
    float sp = ee < 0.25f ? ee * (1.f - ee * (0.5f - ee * (0.33333333f - ee * (0.25f - 0.2f * ee))))
                          : (xx > 20.f ? xx : __logf(1.f + ee));
      gs[tid] = __expf(Aneg * sp);
      bs[tid] = 1.f / (1.f + __expf(-bb));
    }
    __syncthreads();
    for (int tk = 0; tk < 32; ++tk) {
      const float eg = gs[tk], beta = bs[tk];
      const float vv = vs[tk * 64 + w * 16 + c];
      const float4* k4 = (const float4*)(ks + tk * 128 + kg * 32);
      const float4* q4 = (const float4*)(qs + tk * 128 + kg * 32);
      float part = 0.f;
#pragma unroll
      for (int i = 0; i < 8; ++i) {
        float4 kk = k4[i];
        S[4 * i + 0] *= eg; S[4 * i + 1] *= eg; S[4 * i + 2] *= eg; S[4 * i + 3] *= eg;
        part += kk.x * S[4 * i + 0] + kk.y * S[4 * i + 1] + kk.z * S[4 * i + 2] + kk.w * S[4 * i + 3];
      }
      part += __shfl_xor(part, 16);
      part += __shfl_xor(part, 32);
      const float delta = beta * (vv - part);
      float po = 0.f;
#pragma unroll
      for (int i = 0; i < 8; ++i) {
        float4 kk = k4[i];
        float4 qq = q4[i];
        S[4 * i + 0] += kk.x * delta; S[4 * i + 1] += kk.y * delta; S[4 * i + 2] += kk.z * delta; S[4 * i + 3] += kk.w * delta;
        po += qq.x * S[4 * i + 0] + qq.y * S[4 * i + 1] + qq.z * S[4 * i + 2] + qq.w * S[4 * i + 3];
      }
      po += __shfl_xor(po, 16);
      po += __shfl_xor(po, 32);
      if (kg == 0) {
        int row = dn_rowof(s0 + tk, b, d);
        float o = po * 0.08838834764831845f;
        if (d == 0)
          MIX[(size_t)row * 1024 + 512 + h * 128 + col] = f2bf(o);
        else
          OB[(size_t)row * 512 + h * 128 + col] = f2bf(o);
      }
    }
  }
}

__device__ void phaseD(const Params& p, int l, char* smem) {
  const int nb = gridDim.x, bid = blockIdx.x;
  if (bid < 64) {
    dn_scan(p, l, bid, smem);
    return;
  }
  const int nb2 = nb - 64;
  const int n_early = l < 3 ? N_CONV_EARLY : 0;
  for (int it = bid - 64; it < 1152 + N_CONV_LATE + n_early; it += nb2) {
    if (it < 576) {
      int item = it;
      if (it < 512) item = ((it & 7) * 64) + (it >> 3);
      else if (l == 3) continue;
      mla_flash(p, item, smem);
    } else if (it < 1152) {
      if (l == 3 && it - 576 >= 512) continue;
      na_flash(p, l, it - 576, smem);
    } else if (it < 1152 + N_CONV_LATE) {
      conv_item_late(p, l, it - 1152, (float*)smem);
    } else {
      conv_item_early(p, l + 1, it - 1152 - N_CONV_LATE, (float*)smem);
    }
  }
}

__device__ void outgate_item(const Params& p, int l, int item) {
  const int w = otid() >> 6, lane = otid() & 63;
  const int row = item * 4 + w;
  const bf16_t* P = (const bf16_t*)(p.ws + OFF_P);
  bf16_t* MIX = (bf16_t*)(p.ws + OFF_HM);
  const int h = lane >> 4, cb = (lane & 15) * 8;
  uint4 uo = *(const uint4*)(MIX + (size_t)row * 1024 + 512 + h * 128 + cb);
  uint4 ub = *(const uint4*)(P + (size_t)row * INWP + C_DN + h * 128 + cb);
  uint4 uz = *(const uint4*)(P + (size_t)row * INWP + C_DZ + h * 128 + cb);
  float o[8], z[8];
  o[0] = bflo(uo.x) + bflo(ub.x); o[1] = bfhi(uo.x) + bfhi(ub.x); o[2] = bflo(uo.y) + bflo(ub.y); o[3] = bfhi(uo.y) + bfhi(ub.y);
  o[4] = bflo(uo.z) + bflo(ub.z); o[5] = bfhi(uo.z) + bfhi(ub.z); o[6] = bflo(uo.w) + bflo(ub.w); o[7] = bfhi(uo.w) + bfhi(ub.w);
  z[0] = bflo(uz.x); z[1] = bfhi(uz.x); z[2] = bflo(uz.y); z[3] = bfhi(uz.y);
  z[4] = bflo(uz.z); z[5] = bfhi(uz.z); z[6] = bflo(uz.w); z[7] = bfhi(uz.w);
  float ss = 0.f;
#pragma unroll
  for (int e = 0; e < 8; ++e) ss += o[e] * o[e];
  ss += __shfl_xor(ss, 1);
  ss += __shfl_xor(ss, 2);
  ss += __shfl_xor(ss, 4);
  ss += __shfl_xor(ss, 8);
  const float r = rsqrtf(ss * (1.f / 128.f) + 1e-6f);
  const float* go = p.g_out + l * 128 + cb;
  float y[8];
#pragma unroll
  for (int e = 0; e < 8; ++e) y[e] = o[e] * r * go[e] * silu_f(z[e]);
  uint4 u;
  u.x = pack2(y[0], y[1]); u.y = pack2(y[2], y[3]); u.z = pack2(y[4], y[5]); u.w = pack2(y[6], y[7]);
  *(uint4*)(MIX + (size_t)row * 1024 + 512 + h * 128 + cb) = u;
}

__device__ void final_item(const Params& p, int item) {
  const int w = otid() >> 6, lane = otid() & 63;
  const int row = item * 4 + w;
  const float4* xr = (const float4*)((const float*)(p.ws + OFF_X) + (size_t)row * 1024);
  float4 v[4];
  float ss = 0.f;
#pragma unroll
  for (int i = 0; i < 4; ++i) {
    v[i] = xr[lane + 64 * i];
    ss += v[i].x * v[i].x + v[i].y * v[i].y + v[i].z * v[i].z + v[i].w * v[i].w;
  }
  ss = wave_sum(ss);
  const float r = rsqrtf(ss * (1.f / 1024.f) + 1e-6f);
  const float4* g4 = (const float4*)p.g_final;
  float4* o4 = (float4*)(p.out + (size_t)row * 1024);
#pragma unroll
  for (int i = 0; i < 4; ++i) {
    float4 gg = g4[lane + 64 * i];
    float4 y;
    y.x = v[i].x * r * gg.x; y.y = v[i].y * r * gg.y; y.z = v[i].z * r * gg.z; y.w = v[i].w * r * gg.w;
    o4[lane + 64 * i] = y;
  }
}

constexpr int N_PHASES = 1 + 9 * 4 + 1;

__global__ void __launch_bounds__(256, 2) mega(Params p) {
  __shared__ __attribute__((aligned(16))) char smem[SMEM_BYTES];
  cg::grid_group grid = cg::this_grid();
  const int nb = gridDim.x, bid = blockIdx.x;
  __shared__ uint4 xb_words;
  if (threadIdx.x == 0) xb_words = make_uint4(0u, 0u, 0u, 0u);
  __syncthreads();
  XcdBarrier xb = xcd_barrier_post((unsigned*)(p.ws + OFF_BAR), (volatile LAS unsigned*)&xb_words);
#ifdef PROBE_S
  bool again = false;
#endif
  for (int ph = p.ph_lo; ph < p.ph_hi; ++ph) {
    if (ph == 0) {
      phase0(p, smem);
    } else if (ph == N_PHASES - 1) {
      for (int it = bid; it < M_LAT / 4; it += nb) final_item(p, it);
    } else {
      const int l = (ph - 1) / 9, s = (ph - 1) % 9;
      if (s == 0) {
        phaseA(p, l, smem);
      } else if (s == 1) {
        for (int it = bid; it < 144 * 13; it += nb) {
          int mt, nt;
          tile_map(it, 13, mt, nt);
          gemm_wide<EPI_P>(p, l, (const bf16_t*)(p.ws + OFF_HM), 1024, (const bf16_t*)(p.ws + OFF_WIN), 1024,
                           mt * 128, nt * 256, 0, smem);
        }
      } else if (s == 2) {
        phaseC(p, l, smem);
      } else if (s == 3) {
        phaseD(p, l, smem);
      } else if (s == 4) {
        for (int it = bid; it < (l == 3 ? M_LAT : M_ALL) / 4; it += nb) outgate_item(p, l, it);
      } else if (s == 5) {
        const int mpx = l == 3 ? 16 : 18;
        for (int it = bid; it < 8 * mpx * 8; it += nb) {
          int mt, nt;
          tile_map(it, 8, mt, nt, mpx);
          gemm_tile<EPI_RES>(p, l, (const bf16_t*)(p.ws + OFF_HM), 1024, (const bf16_t*)(p.ws + OFF_WOUT), 1024,
                             mt * 128, nt * 128, 2, smem);
        }
      } else if (s == 6) {
        for (int it = bid; it < (l == 3 ? M_LAT : M_ALL) / 4; it += nb)
          norm_rows(p, false, (bf16_t*)(p.ws + OFF_HM), p.g_ffn + l * 1024,
                    (const float*)(p.ws + OFF_MOD) + (size_t)l * 9 * 6144, 3, 4, it);
      } else if (s == 7) {
        const int mpx = l == 3 ? 16 : 18;
        for (int it = bid; it < 8 * mpx * 22; it += nb) {
          int mt, nt;
          tile_map(it, 22, mt, nt, mpx);
          gemm_wide<EPI_GU>(p, l, (const bf16_t*)(p.ws + OFF_HM), 1024, (const bf16_t*)(p.ws + OFF_WGU), 1024,
                            mt * 128, nt * 256, 0, smem);
        }
      } else {
        const int mpx = l == 3 ? 16 : 18;
        for (int it = bid; it < 8 * mpx * 8; it += nb) {
          int mt, nt;
          tile_map(it, 8, mt, nt, mpx);
          gemm_tile<EPI_RES>(p, l, (const bf16_t*)(p.ws + OFF_P), FFN, (const bf16_t*)(p.ws + OFF_WDN), FFN,
                             mt * 128, nt * 128, 5, smem);
        }
      }
    }
#ifdef PROBE_S
    {
      const bool hit = (PROBE_S == 9) ? (ph == 0) : (ph != 0 && ph != N_PHASES - 1 && ((ph - 1) % 9) == PROBE_S);
      if (hit && !again) {
        again = true;
        if (p.use_cg) grid.sync(); else xcd_barrier(xb);
        --ph;
        continue;
      }
      again = false;
    }
#endif
    if (ph + 1 < p.ph_hi) {
      if (p.use_cg) grid.sync();
      else xcd_barrier(xb);
    }
  }
}

extern "C" void kernel_launch(void* const* d_in, const int* in_sizes, int n_in, void* d_out, int out_size, void* d_ws,
                              size_t ws_size, hipStream_t stream) {
  static int grid_blocks = 0;
  if (!grid_blocks) {
    int dev = 0, cus = 0, per_cu = 0;
    hipGetDevice(&dev);
    hipDeviceGetAttribute(&cus, hipDeviceAttributeMultiprocessorCount, dev);
    hipOccupancyMaxActiveBlocksPerMultiprocessor(&per_cu, mega, 256, 0);
    if (per_cu < 1) per_cu = 1;
    if (per_cu > 2) per_cu = 2;
    grid_blocks = cus * per_cu;
  }
  Params p{};
  const float** pp = (const float**)&p;
  for (int i = 0; i < 23; ++i) pp[i] = (const float*)d_in[i];
  p.out = (float*)d_out;
  p.ws = (char*)d_ws;
  p.ph_lo = 0;
  p.ph_hi = N_PHASES;
  p.use_cg = 0;
  p.pad0 = 0;
  hipMemsetAsync((char*)d_ws + OFF_BAR, 0, XCD_BAR_WORDS * sizeof(unsigned), stream);
  void* args[] = {&p};
  hipError_t e = hipLaunchCooperativeKernel((void*)mega, dim3(grid_blocks), dim3(256), args, 0, stream);
  if (e != hipSuccess) {
    fprintf(stderr, "cooperative launch failed: %s (grid %d)\n", hipGetErrorString(e), grid_blocks);
    (void)hipGetLastError();
    for (int ph = 0; ph < N_PHASES; ++ph) {
      p.ph_lo = ph;
      p.ph_hi = ph + 1;
      hipLaunchKernelGGL(mega, dim3(grid_blocks), dim3(256), 0, stream, p);
    }
  }
}
```

```cpp
#include <hip/hip_runtime.h>
#include <hip/hip_bf16.h>
#include <hip/hip_cooperative_groups.h>
#include <cstdio>
namespace cg = cooperative_groups;

#define DEVI __device__ __forceinline__
typedef unsigned short bf16_t;
typedef short bf16x8 __attribute__((ext_vector_type(8)));
typedef float f32x16 __attribute__((ext_vector_type(16)));

constexpr int M_LAT = 16384, M_CTX = 2048, M_ALL = 18432;
constexpr int DM = 1024, INW = 3248, INWP = 3328, FFN = 2816;
constexpr int C_MQ = 0, C_MKV = 256, C_MPE = 384, C_NQ = 416, C_NK = 672, C_NV = 928, C_DN = 1184;
constexpr int C_DZ = C_DN + 1536, C_DA = C_DN + 2048;

constexpr size_t OFF_WIN = 0;
constexpr size_t OFF_WOUT = OFF_WIN + (size_t)INWP * 1024 * 2;
constexpr size_t OFF_WGU = OFF_WOUT + (size_t)1024 * 1024 * 2;
constexpr size_t OFF_WDN = OFF_WGU + (size_t)2 * FFN * 1024 * 2;
constexpr size_t OFF_WQUP = OFF_WDN + (size_t)1024 * FFN * 2;
constexpr size_t OFF_WKVUP = OFF_WQUP + (size_t)384 * 256 * 2;
constexpr size_t OFF_MOD = OFF_WKVUP + (size_t)512 * 128 * 2;
constexpr size_t OFF_ROPE = OFF_MOD + (size_t)4 * 9 * 6144 * 4;
constexpr size_t OFF_X = OFF_ROPE + (size_t)2048 * 16 * 2 * 4;
constexpr size_t OFF_HM = OFF_X + (size_t)M_ALL * 1024 * 4;
constexpr size_t OFF_P = OFF_HM + (size_t)M_ALL * 1024 * 2;
constexpr size_t OFF_QH = OFF_P + (size_t)M_ALL * INWP * 2;
constexpr size_t OFF_KH = OFF_QH + (size_t)M_ALL * 384 * 2;
constexpr size_t OFF_VH = OFF_KH + (size_t)M_ALL * 384 * 2;
constexpr size_t OFF_DNQKV = OFF_VH + (size_t)M_ALL * 256 * 2;
constexpr size_t OFF_OB = OFF_DNQKV + (size_t)M_ALL * 1536 * 2;
constexpr size_t OFF_AB = OFF_OB + (size_t)M_ALL * 512 * 2;
constexpr size_t OFF_GC = OFF_AB + (size_t)M_ALL * 16 * 4;
constexpr size_t OFF_BETA = OFF_GC + (size_t)M_ALL * 8 * 4;
constexpr size_t OFF_NVT = OFF_BETA + (size_t)M_ALL * 8 * 4;
constexpr size_t WS_TOTAL = OFF_NVT + (size_t)M_ALL * 256 * 2;
constexpr int SMEM_BYTES = 74240;
constexpr size_t OFF_BAR = (WS_TOTAL + 255) & ~(size_t)255;

struct Params {
  const float *x, *c, *ctx, *c_ctx, *w_ada, *b_ada, *g_mix, *w_in, *g_q, *g_kv, *w_qup, *w_kvup, *rel_bias,
      *conv_w, *a_log, *dt_bias, *g_out, *w_out, *g_ffn, *w_gate, *w_up, *w_down, *g_final;
  float* out;
  char* ws;
  int ph_lo, ph_hi;
  int use_cg, pad0;
};

DEVI bf16_t f2bf(float f) {
  __bf16 r = (__bf16)f;
  return __builtin_bit_cast(unsigned short, r);
}
DEVI int otid() {
  int t = threadIdx.x;
  asm volatile("" : "+v"(t));
  return t;
}
DEVI float bf2f(bf16_t h) { return __uint_as_float(((unsigned)h) << 16); }
DEVI float bflo(unsigned u) { return __uint_as_float(u << 16); }
DEVI float bfhi(unsigned u) { return __uint_as_float(u & 0xffff0000u); }
typedef __bf16 bf16v2_t __attribute__((ext_vector_type(2)));
typedef float f32v2_t __attribute__((ext_vector_type(2)));
DEVI unsigned pack2(float a, float b) {
  f32v2_t v = {a, b};
  bf16v2_t r = __builtin_convertvector(v, bf16v2_t);
  return __builtin_bit_cast(unsigned, r);
}
DEVI float silu_f(float x) { return x / (1.f + __expf(-x)); }
DEVI float wave_sum(float v) {
#pragma unroll
  for (int o = 32; o >= 1; o >>= 1) v += __shfl_xor(v, o);
  return v;
}

#define XB_TMO 128
#define XB_XCNT(j) (256 + 64 * (j))
#define XB_XSUB(j) (1280 + 64 * (j))
#define XB_XGEN(j) (2304 + 64 * (j))
#define XB_TOP 3328
#define XB_TOPGEN 3392
#define XCD_BAR_WORDS 3456
#define XB_SPIN_CAP (1u << 22)
#define LAS __attribute__((address_space(3)))
DEVI unsigned xb_ld(unsigned* p) { return __hip_atomic_load(p, __ATOMIC_RELAXED, __HIP_MEMORY_SCOPE_AGENT); }
DEVI unsigned xb_add(unsigned* p, unsigned v) { return __hip_atomic_fetch_add(p, v, __ATOMIC_RELAXED, __HIP_MEMORY_SCOPE_AGENT); }
DEVI unsigned xb_xcc_id() { return (unsigned)__builtin_amdgcn_s_getreg((3 << 11) | 20) & 0xFu; }
#define XB_SPIN(cond, bar)                                                     \
  do {                                                                         \
    unsigned _sp = 0;                                                          \
    while (cond) {                                                             \
      __builtin_amdgcn_s_sleep(1);                                             \
      if ((++_sp & 255u) == 0u) {                                              \
        if (xb_ld(&(bar)[XB_TMO])) break;                                      \
        if (_sp > XB_SPIN_CAP) { atomicAdd(&(bar)[XB_TMO], 1u); break; }       \
      }                                                                        \
    }                                                                          \
  } while (0)
struct XcdBarrier {
  unsigned* bar;
  unsigned x;
  volatile LAS unsigned* st;
};
DEVI XcdBarrier xcd_barrier_post(unsigned* bar, volatile LAS unsigned* st) {
  XcdBarrier b;
  b.bar = bar;
  b.x = xb_xcc_id();
  b.st = st;
  if (threadIdx.x == 0) (void)xb_add(&bar[XB_XCNT(b.x)], 1u);
  return b;
}
DEVI void xcd_barrier_complete(unsigned* bar, unsigned x, unsigned& nloc, unsigned& nx) {
  const unsigned G = gridDim.x * gridDim.y * gridDim.z;
  unsigned sum, cnt, mine, sp = 0u;
  for (;;) {
    sum = 0u; cnt = 0u; mine = 0u;
#pragma unroll
    for (unsigned j = 0; j < 16; ++j) {
      const unsigned c = xb_ld(&bar[XB_XCNT(j)]);
      sum += c;
      cnt += (c > 0u) ? 1u : 0u;
      mine = (j == x) ? c : mine;
    }
    if (sum == G) break;
    __builtin_amdgcn_s_sleep(1);
    if ((++sp & 255u) == 0u) {
      if (xb_ld(&bar[XB_TMO])) break;
      if (sp > XB_SPIN_CAP) { atomicAdd(&bar[XB_TMO], 1u); break; }
    }
  }
  nloc = mine > 0u ? mine : 1u;
  nx = cnt > 0u ? cnt : 1u;
}
DEVI void xcd_barrier(const XcdBarrier& b) {
  asm volatile("s_waitcnt vmcnt(0)" ::: "memory");
  __syncthreads();
  if (threadIdx.x == 0) {
    unsigned* bar = b.bar;
    __builtin_amdgcn_s_waitcnt(0);
    unsigned nloc = b.st[0], nx = b.st[1];
    if (nloc == 0u) {
      xcd_barrier_complete(bar, b.x, nloc, nx);
      b.st[0] = nloc;
      b.st[1] = nx;
    }
    const unsigned old = xb_add(&bar[XB_XSUB(b.x)], 1u);
    const unsigned gen = old / nloc;
    if (old + 1u == (gen + 1u) * nloc) {
      __builtin_amdgcn_fence(__ATOMIC_RELEASE, "agent");
      asm volatile("s_waitcnt vmcnt(0)" ::: "memory");
      const unsigned og = xb_add(&bar[XB_TOP], 1u);
      const unsigned tg = og / nx;
      if (og + 1u == (tg + 1u) * nx) xb_add(&bar[XB_TOPGEN], 1u);
      else XB_SPIN(xb_ld(&bar[XB_TOPGEN]) == tg, bar);
      __builtin_amdgcn_fence(__ATOMIC_ACQUIRE, "agent");
      xb_add(&bar[XB_XGEN(b.x)], 1u);
      asm volatile("s_waitcnt vmcnt(0)" ::: "memory");
    } else {
      XB_SPIN(xb_ld(&bar[XB_XGEN(b.x)]) == gen, bar);
      __builtin_amdgcn_fence(__ATOMIC_ACQUIRE, "agent");
      asm volatile("s_waitcnt vmcnt(0)" ::: "memory");
    }
  }
  __syncthreads();
}

constexpr int N_CONV_EARLY = 16 * 52 + 24 + 16;
__device__ void conv_item_early(const Params& p, int l, int it, float* tl);

__device__ void phase0(const Params& p, char* smem) {
  const int tid = otid(), nb = gridDim.x, bid = blockIdx.x;
  {
    float* rc = (float*)(p.ws + OFF_ROPE);
    float* rs = rc + 2048 * 16;
    for (int i = bid * 256 + tid; i < 2048 * 16; i += nb * 256) {
      int t = i >> 4, a = (i >> 3) & 1, j = i & 7;
      float pos = a ? (float)(t & 63) : (float)(t >> 6);
      float inv = __builtin_amdgcn_exp2f(-(float)j * (13.287712379549449f / 8.f));
      float ang = pos * inv;
      rc[i] = cosf(ang);
      rs[i] = sinf(ang);
    }
  }
  for (int it = bid; it < N_CONV_EARLY; it += nb) conv_item_early(p, 0, it, (float*)smem);
  __syncthreads();
  float* sc = (float*)smem;
  float* red = sc + 1024 * 12;
  float* MOD = (float*)(p.ws + OFF_MOD);
  bool loaded = false;
  for (int it = bid; it < 4 * 96; it += nb) {
    if (!loaded) {
      for (int i = tid; i < 9 * 1024; i += 256) {
        float v = i < 8192 ? p.c[i] : p.c_ctx[i - 8192];
        sc[(i & 1023) * 12 + (i >> 10)] = silu_f(v);
      }
      __syncthreads();
      loaded = true;
    }
    const int l = it / 96, n0 = (it % 96) * 64;
    const int cc = tid & 63, kg = tid >> 6;
    const float* w = p.w_ada + (size_t)l * 1024 * 6144 + n0 + cc;
    float acc[9];
#pragma unroll
    for (int b = 0; b < 9; ++b) acc[b] = 0.f;
    for (int k0 = kg * 256; k0 < kg * 256 + 256; k0 += 16) {
      float wvv[16];
#pragma unroll
      for (int j = 0; j < 16; ++j) wvv[j] = w[(size_t)(k0 + j) * 6144];
#pragma unroll
      for (int j = 0; j < 16; ++j) {
      const int k = k0 + j;
      const float wv = wvv[j];
      const float4 s0 = *(const float4*)(sc + k * 12);
      const float4 s1 = *(const float4*)(sc + k * 12 + 4);
      const float s2 = sc[k * 12 + 8];
      acc[0] += s0.x * wv; acc[1] += s0.y * wv; acc[2] += s0.z * wv; acc[3] += s0.w * wv;
      acc[4] += s1.x * wv; acc[5] += s1.y * wv; acc[6] += s1.z * wv; acc[7] += s1.w * wv;
      acc[8] += s2 * wv;
      }
    }
#pragma unroll
    for (int b = 0; b < 9; ++b) red[(kg * 9 + b) * 64 + cc] = acc[b];
    __syncthreads();
    for (int i = tid; i < 9 * 64; i += 256) {
      int b = i >> 6, c2 = i & 63;
      float s = red[(0 * 9 + b) * 64 + c2] + red[(1 * 9 + b) * 64 + c2] + red[(2 * 9 + b) * 64 + c2] +
                red[(3 * 9 + b) * 64 + c2];
      MOD[(size_t)(l * 9 + b) * 6144 + n0 + c2] = s + p.b_ada[l * 6144 + n0 + c2];
    }
    __syncthreads();
  }
}

__device__ void convT_tile(const float* __restrict__ src, int K, int N, bf16_t* __restrict__ dst, int mode,
                           const float* __restrict__ gs, int kt, int nt, float* tl) {
  const int tid = otid();
  const int k0 = kt * 64, n0 = nt * 64;
  __syncthreads();
#pragma unroll 4
  for (int i = 0; i < 16; ++i) {
    int kk = i * 4 + (tid >> 6), nn = tid & 63;
    float v = 0.f;
    if (n0 + nn < N) v = src[(size_t)(k0 + kk) * N + n0 + nn];
    if (gs) v *= gs[k0 + kk];
    tl[kk * 65 + nn] = v;
  }
  __syncthreads();
#pragma unroll 2
  for (int i = 0; i < 8; ++i) {
    int nn = i * 8 + (tid >> 5), kk = (tid & 31) * 2;
    unsigned pk = pack2(tl[kk * 65 + nn], tl[(kk + 1) * 65 + nn]);
    int n = n0 + nn;
    int drow = mode == 0 ? n : ((n >> 5) * 64 + (n & 31) + (mode == 2 ? 32 : 0));
    *(unsigned*)(dst + (size_t)drow * K + k0 + kk) = pk;
  }
}

__device__ void norm_rows(const Params& p, bool from_input, bf16_t* __restrict__ H, const float* __restrict__ g,
                          const float* __restrict__ modl, int shift_i, int scale_i, int item) {
  const int w = otid() >> 6, lane = otid() & 63;
  const int row = item * 4 + w;
  const float* xsrc = from_input ? (row < M_LAT ? p.x + (size_t)row * 1024 : p.ctx + (size_t)(row - M_LAT) * 1024)
                                 : (const float*)(p.ws + OFF_X) + (size_t)row * 1024;
  const float4* xr = (const float4*)xsrc;
  float4 v[4];
  float ss = 0.f;
#pragma unroll
  for (int i = 0; i < 4; ++i) {
    v[i] = xr[lane + 64 * i];
    ss += v[i].x * v[i].x + v[i].y * v[i].y + v[i].z * v[i].z + v[i].w * v[i].w;
  }
  ss = wave_sum(ss);
  const float r = rsqrtf(ss * (1.f / 1024.f) + 1e-6f);
  const int b = row < M_LAT ? (row >> 11) : 8;
  const float4* sh = (const float4*)(modl + b * 6144 + shift_i * 1024);
  const float4* sl = (const float4*)(modl + b * 6144 + scale_i * 1024);
  const float4* g4 = (const float4*)g;
#pragma unroll
  for (int i = 0; i < 4; ++i) {
    int c4 = lane + 64 * i;
    float4 gg = g4[c4], s4 = sh[c4], l4 = sl[c4];
    float y0 = v[i].x * r * gg.x * (1.f + l4.x) + s4.x;
    float y1 = v[i].y * r * gg.y * (1.f + l4.y) + s4.y;
    float y2 = v[i].z * r * gg.z * (1.f + l4.z) + s4.z;
    float y3 = v[i].w * r * gg.w * (1.f + l4.w) + s4.w;
    uint2 pk;
    pk.x = pack2(y0, y1);
    pk.y = pack2(y2, y3);
    *(uint2*)(H + (size_t)row * 1024 + c4 * 4) = pk;
  }
}

__device__ void conv_item_late(const Params& p, int l, int i, float* tl) {
  bf16_t* Wout = (bf16_t*)(p.ws + OFF_WOUT);
  bf16_t* Wgu = (bf16_t*)(p.ws + OFF_WGU);
  bf16_t* Wdn = (bf16_t*)(p.ws + OFF_WDN);
  const float* src;
  bf16_t* dst;
  int K, N, mode = 0, ntn;
  if (i < 256) {
    src = p.w_out + (size_t)l * 1024 * 1024; K = 1024; N = 1024; dst = Wout; ntn = 16;
  } else if (i < 960) {
    i -= 256; src = p.w_gate + (size_t)l * 1024 * FFN; K = 1024; N = FFN; dst = Wgu; ntn = 44; mode = 1;
  } else if (i < 1664) {
    i -= 960; src = p.w_up + (size_t)l * 1024 * FFN; K = 1024; N = FFN; dst = Wgu; ntn = 44; mode = 2;
  } else {
    i -= 1664; src = p.w_down + (size_t)l * FFN * 1024; K = FFN; N = 1024; dst = Wdn; ntn = 16;
  }
  convT_tile(src, K, N, dst, mode, nullptr, i / ntn, i % ntn, tl);
}
constexpr int N_CONV_LATE = 256 + 3 * 704;
__device__ void conv_item_early(const Params& p, int l, int it, float* tl) {
  const float* src;
  const float* gs = nullptr;
  bf16_t* dst;
  int K, N, ntn, i;
  if (it < 832) {
    i = it; src = p.w_in + (size_t)l * 1024 * INW; K = 1024; N = INW; dst = (bf16_t*)(p.ws + OFF_WIN); ntn = 52;
  } else if (it < 856) {
    i = it - 832; src = p.w_qup + (size_t)l * 256 * 384; K = 256; N = 384; dst = (bf16_t*)(p.ws + OFF_WQUP); ntn = 6;
    gs = p.g_q + l * 256;
  } else {
    i = it - 856; src = p.w_kvup + (size_t)l * 128 * 512; K = 128; N = 512; dst = (bf16_t*)(p.ws + OFF_WKVUP); ntn = 8;
    gs = p.g_kv + l * 128;
  }
  convT_tile(src, K, N, dst, 0, gs, i / ntn, i % ntn, tl);
}

__device__ void phaseA(const Params& p, int l, char* smem) {
  const int nb = gridDim.x, bid = blockIdx.x;
  for (int it = bid; it < M_ALL / 4; it += nb)
    norm_rows(p, l == 0, (bf16_t*)(p.ws + OFF_HM), p.g_mix + l * 1024,
              (const float*)(p.ws + OFF_MOD) + (size_t)l * 9 * 6144, 0, 1, it);
}

DEVI void tile_map(int it, int NT, int& mt, int& nt, int MPX = 18) {
  const int xcd = it & 7, idx = it >> 3;
  const int per_group = 8 * NT;
  const int g = idx / per_group, r = idx - g * per_group;
  const int gs = min(8, MPX - 8 * g);
  mt = xcd * MPX + g * 8 + r % gs;
  nt = r / gs;
}

enum { EPI_P = 0, EPI_QUP = 1, EPI_KVUP = 2, EPI_RES = 3, EPI_GU = 4 };

template <int EPI>
__device__ void gemm_tile(const Params& p, int l, const bf16_t* __restrict__ A, int lda,
                          const bf16_t* __restrict__ BT, int K, int m0, int n0, int gate_i, char* smem) {
  constexpr int STAGE = 2 * 128 * 72;
  bf16_t* sbase = (bf16_t*)smem;
  float* rsv = (float*)(smem + 2 * STAGE * 2);
  const int tid = otid(), lane = tid & 63, w = tid >> 6, wm = w >> 1, wn = w & 1;
  const int lr = tid >> 3, lc = (tid & 7) * 8;
  __syncthreads();
  if (EPI == EPI_QUP || EPI == EPI_KVUP) {
    const int row = tid >> 1, hf = tid & 1;
    const int n8 = K / 16;
    const uint4* ap = (const uint4*)(A + (size_t)(m0 + row) * lda + hf * (K / 2));
    float ss = 0.f;
    for (int i = 0; i < n8; ++i) {
      uint4 u = ap[i];
      float a0 = bflo(u.x), a1 = bfhi(u.x), a2 = bflo(u.y), a3 = bfhi(u.y), a4 = bflo(u.z), a5 = bfhi(u.z),
            a6 = bflo(u.w), a7 = bfhi(u.w);
      ss += a0 * a0 + a1 * a1 + a2 * a2 + a3 * a3 + a4 * a4 + a5 * a5 + a6 * a6 + a7 * a7;
    }
    ss += __shfl_xor(ss, 1);
    if (hf == 0) rsv[row] = rsqrtf(ss / (float)K + 1e-6f);
  }
  const bf16_t* Ap = A + (size_t)(m0 + lr) * lda + lc;
  const bf16_t* Bp = BT + (size_t)(n0 + lr) * K + lc;
  uint4 ra0, ra1, ra2, ra3, rb0, rb1, rb2, rb3;
#define G_LOAD()                                  \
  ra0 = *(const uint4*)(Ap);                      \
  ra1 = *(const uint4*)(Ap + (size_t)32 * lda);   \
  ra2 = *(const uint4*)(Ap + (size_t)64 * lda);   \
  ra3 = *(const uint4*)(Ap + (size_t)96 * lda);   \
  rb0 = *(const uint4*)(Bp);                      \
  rb1 = *(const uint4*)(Bp + (size_t)32 * K);     \
  rb2 = *(const uint4*)(Bp + (size_t)64 * K);     \
  rb3 = *(const uint4*)(Bp + (size_t)96 * K);
#define S_WRITE(ST)                                                   \
  {                                                                   \
    bf16_t* wa = sbase + (ST) * STAGE + lr * 72 + lc;                 \
    bf16_t* wb = wa + 128 * 72;                                       \
    *(uint4*)(wa) = ra0;                                              \
    *(uint4*)(wa + 32 * 72) = ra1;                                    \
    *(uint4*)(wa + 64 * 72) = ra2;                                    \
    *(uint4*)(wa + 96 * 72) = ra3;                                    \
    *(uint4*)(wb) = rb0;                                              \
    *(uint4*)(wb + 32 * 72) = rb1;                                    \
    *(uint4*)(wb + 64 * 72) = rb2;                                    \
    *(uint4*)(wb + 96 * 72) = rb3;                                    \
  }
  const int nk = K / 64;
  G_LOAD()
  S_WRITE(0)
  if (nk > 1) {
    Ap += 64;
    Bp += 64;
    G_LOAD()
  }
  f32x16 acc[2][2];
#pragma unroll
  for (int i = 0; i < 2; ++i)
#pragma unroll
    for (int j = 0; j < 2; ++j)
#pragma unroll
      for (int r = 0; r < 16; ++r) acc[i][j][r] = 0.f;
  __syncthreads();
  for (int kt = 0; kt < nk; ++kt) {
    const int cur = kt & 1;
    const bf16_t* pa = sbase + cur * STAGE + (wm * 64 + (lane & 31)) * 72 + (lane >> 5) * 8;
    const bf16_t* pb = sbase + cur * STAGE + 128 * 72 + (wn * 64 + (lane & 31)) * 72 + (lane >> 5) * 8;
    bf16x8 fa00 = *(const bf16x8*)(pa), fa01 = *(const bf16x8*)(pa + 32 * 72);
    bf16x8 fb00 = *(const bf16x8*)(pb), fb01 = *(const bf16x8*)(pb + 32 * 72);
    bf16x8 fa10 = *(const bf16x8*)(pa + 16), fa11 = *(const bf16x8*)(pa + 32 * 72 + 16);
    bf16x8 fb10 = *(const bf16x8*)(pb + 16), fb11 = *(const bf16x8*)(pb + 32 * 72 + 16);
    bf16x8 fa20 = *(const bf16x8*)(pa + 32), fa21 = *(const bf16x8*)(pa + 32 * 72 + 32);
    bf16x8 fb20 = *(const bf16x8*)(pb + 32), fb21 = *(const bf16x8*)(pb + 32 * 72 + 32);
    bf16x8 fa30 = *(const bf16x8*)(pa + 48), fa31 = *(const bf16x8*)(pa + 32 * 72 + 48);
    bf16x8 fb30 = *(const bf16x8*)(pb + 48), fb31 = *(const bf16x8*)(pb + 32 * 72 + 48);
    __builtin_amdgcn_sched_barrier(0);
    __builtin_amdgcn_s_setprio(1);
#define MM4(A0, A1, B0, B1)                                                           \
  acc[0][0] = __builtin_amdgcn_mfma_f32_32x32x16_bf16(A0, B0, acc[0][0], 0, 0, 0);    \
  acc[0][1] = __builtin_amdgcn_mfma_f32_32x32x16_bf16(A0, B1, acc[0][1], 0, 0, 0);    \
  acc[1][0] = __builtin_amdgcn_mfma_f32_32x32x16_bf16(A1, B0, acc[1][0], 0, 0, 0);    \
  acc[1][1] = __builtin_amdgcn_mfma_f32_32x32x16_bf16(A1, B1, acc[1][1], 0, 0, 0);
    MM4(fa00, fa01, fb00, fb01)
    MM4(fa10, fa11, fb10, fb11)
    MM4(fa20, fa21, fb20, fb21)
    MM4(fa30, fa31, fb30, fb31)
#undef MM4
    __builtin_amdgcn_s_setprio(0);
    __builtin_amdgcn_sched_barrier(0);
    if (kt + 1 < nk) {
      S_WRITE(cur ^ 1)
      if (kt + 2 < nk) {
        Ap += 64;
        Bp += 64;
        G_LOAD()
      }
    }
    __syncthreads();
  }
#undef G_LOAD
#undef S_WRITE
  const int ci = lane & 31;
  const int rbase = m0 + wm * 64 + 4 * (lane >> 5);
  const int cbase = n0 + wn * 64;
  if (EPI == EPI_P) {
    bf16_t* P = (bf16_t*)(p.ws + OFF_P);
    float* AB = (float*)(p.ws + OFF_AB);
    bf16_t* sO = (bf16_t*)smem;
#pragma unroll
    for (int mt = 0; mt < 2; ++mt)
#pragma unroll
      for (int nt = 0; nt < 2; ++nt)
#pragma unroll
        for (int r = 0; r < 16; ++r) {
          const int rl = wm * 64 + 4 * (lane >> 5) + mt * 32 + (r & 3) + 8 * (r >> 2);
          const int cl = wn * 64 + nt * 32 + ci;
          const float v = acc[mt][nt][r];
          sO[rl * 136 + cl] = f2bf(v);
          const int col = n0 + cl;
          if (col >= C_DA && col < C_DA + 16) AB[(size_t)(m0 + rl) * 16 + col - C_DA] = v;
        }
    __syncthreads();
#pragma unroll
    for (int e = 0; e < 8; ++e) {
      const int c = tid + 256 * e, rl = c >> 4, ch = c & 15;
      *(uint4*)(P + (size_t)(m0 + rl) * INWP + n0 + ch * 8) = *(const uint4*)(sO + rl * 136 + ch * 8);
    }
    bf16_t* NVT = (bf16_t*)(p.ws + OFF_NVT);
#pragma unroll
    for (int mt = 0; mt < 2; ++mt)
#pragma unroll
      for (int nt = 0; nt < 2; ++nt) {
        const int base = cbase + nt * 32;
        if (base >= C_NV && base < C_NV + 256) {
          const int hv = (base - C_NV) >> 6, dv = ((base - C_NV) & 63) + ci;
#pragma unroll
          for (int g = 0; g < 4; ++g) {
            const int row0 = rbase + mt * 32 + 8 * g;
            int bb, key0;
            if (row0 < M_LAT) { bb = row0 >> 11; key0 = 256 + (row0 & 2047); }
            else { bb = (row0 - M_LAT) >> 8; key0 = (row0 - M_LAT) & 255; }
            uint2 u;
            u.x = pack2(acc[mt][nt][4 * g + 0], acc[mt][nt][4 * g + 1]);
            u.y = pack2(acc[mt][nt][4 * g + 2], acc[mt][nt][4 * g + 3]);
            *(uint2*)(NVT + ((size_t)(bb * 4 + hv) * 64 + dv) * 2304 + key0) = u;
          }
        }
      }
  } else if (EPI == EPI_QUP) {
    bf16_t* QH = (bf16_t*)(p.ws + OFF_QH);
    const float* rc = (const float*)(p.ws + OFF_ROPE);
    const float* rsn = rc + 2048 * 16;
#pragma unroll
    for (int mt = 0; mt < 2; ++mt)
#pragma unroll
      for (int nt = 0; nt < 2; ++nt) {
        const int base = cbase + nt * 32;
        const bool rope = ((base % 96) == 64) && (m0 < M_LAT);
#pragma unroll
        for (int r = 0; r < 16; ++r) {
          int row = rbase + mt * 32 + (r & 3) + 8 * (r >> 2);
          float v = acc[mt][nt][r] * rsv[row - m0];
          float o = __shfl_xor(v, 8);
          if (rope) {
            int t = row & 2047;
            int a = ci >> 4, hf = (ci >> 3) & 1, j = ci & 7;
            float c = rc[t * 16 + a * 8 + j], s = rsn[t * 16 + a * 8 + j];
            v = hf ? (o * s + v * c) : (v * c - o * s);
          }
          QH[(size_t)row * 384 + base + ci] = f2bf(v);
        }
      }
  } else if (EPI == EPI_KVUP) {
    bf16_t* KA = (bf16_t*)(p.ws + OFF_KH);
    bf16_t* VT = (bf16_t*)(p.ws + OFF_VH);
#pragma unroll
    for (int mt = 0; mt < 2; ++mt)
#pragma unroll
      for (int nt = 0; nt < 2; ++nt) {
        const int base = cbase + nt * 32;
        const int h = base >> 7, cc = (base & 127) + ci;
#pragma unroll
        for (int g = 0; g < 4; ++g) {
          const int row0 = rbase + mt * 32 + 8 * g;
          int bb, key0;
          if (row0 < M_LAT) { bb = row0 >> 11; key0 = 256 + (row0 & 2047); }
          else { bb = (row0 - M_LAT) >> 8; key0 = (row0 - M_LAT) & 255; }
          float v0 = acc[mt][nt][4 * g + 0] * rsv[row0 - m0 + 0];
          float v1 = acc[mt][nt][4 * g + 1] * rsv[row0 - m0 + 1];
          float v2 = acc[mt][nt][4 * g + 2] * rsv[row0 - m0 + 2];
          float v3 = acc[mt][nt][4 * g + 3] * rsv[row0 - m0 + 3];
          if (cc < 64) {
            bf16_t* kp = KA + ((size_t)(bb * 4 + h) * 2304 + key0) * 96 + cc;
            kp[0] = f2bf(v0); kp[96] = f2bf(v1); kp[192] = f2bf(v2); kp[288] = f2bf(v3);
          } else {
            uint2 u;
            u.x = pack2(v0, v1);
            u.y = pack2(v2, v3);
            *(uint2*)(VT + ((size_t)(bb * 4 + h) * 64 + (cc - 64)) * 2304 + key0) = u;
          }
        }
      }
  } else if (EPI == EPI_RES) {
    float* X = (float*)(p.ws + OFF_X);
    const float* Xsrc = (l == 0 && gate_i == 2) ? (m0 < M_LAT ? p.x : p.ctx - (size_t)M_LAT * 1024) : X;
    const float* modl = (const float*)(p.ws + OFF_MOD) + (size_t)l * 9 * 6144 + gate_i * 1024;
#pragma unroll
    for (int mt = 0; mt < 2; ++mt)
#pragma unroll
      for (int nt = 0; nt < 2; ++nt)
#pragma unroll
        for (int r = 0; r < 16; ++r) {
          int row = rbase + mt * 32 + (r & 3) + 8 * (r >> 2);
          int col = cbase + nt * 32 + ci;
          int b = row < M_LAT ? (row >> 11) : 8;
          float g = modl[b * 6144 + col];
          size_t idx = (size_t)row * 1024 + col;
          X[idx] = Xsrc[idx] + g * acc[mt][nt][r];
        }
  } else if (EPI == EPI_GU) {
    bf16_t* ACT = (bf16_t*)(p.ws + OFF_P);
    bf16_t* sO = (bf16_t*)smem;
#pragma unroll
    for (int mt = 0; mt < 2; ++mt)
#pragma unroll
      for (int r = 0; r < 16; ++r) {
        const int rl = wm * 64 + 4 * (lane >> 5) + mt * 32 + (r & 3) + 8 * (r >> 2);
        float gt = acc[mt][0][r], up = acc[mt][1][r];
        float a = silu_f(gt) * up;
        sO[rl * 72 + wn * 32 + ci] = f2bf(a);
      }
    __syncthreads();
#pragma unroll
    for (int e = 0; e < 4; ++e) {
      const int c = tid + 256 * e, rl = c >> 3, ch = c & 7;
      *(uint4*)(ACT + (size_t)(m0 + rl) * FFN + (n0 >> 1) + ch * 8) = *(const uint4*)(sO + rl * 72 + ch * 8);
    }
  }
}

template <int EPI>
__device__ void gemm_wide(const Params& p, int l, const bf16_t* __restrict__ A, int lda,
                          const bf16_t* __restrict__ BT, int K, int m0, int n0, int gate_i, char* smem) {
  bf16_t* sA = (bf16_t*)smem;
  bf16_t* sB = sA + 128 * 72;
  const int tid = otid(), lane = tid & 63, w = tid >> 6, wm = w >> 1, wn = w & 1;
  const int lr = tid >> 3, lc = (tid & 7) * 8;
  const bf16_t* Ap = A + (size_t)(m0 + lr) * lda + lc;
  const bf16_t* Bp = BT + (size_t)(n0 + lr) * K + lc;
  uint4 ra0, ra1, ra2, ra3, rb0, rb1, rb2, rb3, rb4, rb5, rb6, rb7;
#define LOAD_AB()                                   \
  ra0 = *(const uint4*)(Ap);                        \
  ra1 = *(const uint4*)(Ap + (size_t)32 * lda);     \
  ra2 = *(const uint4*)(Ap + (size_t)64 * lda);     \
  ra3 = *(const uint4*)(Ap + (size_t)96 * lda);     \
  rb0 = *(const uint4*)(Bp);                        \
  rb1 = *(const uint4*)(Bp + (size_t)32 * K);       \
  rb2 = *(const uint4*)(Bp + (size_t)64 * K);       \
  rb3 = *(const uint4*)(Bp + (size_t)96 * K);       \
  rb4 = *(const uint4*)(Bp + (size_t)128 * K);      \
  rb5 = *(const uint4*)(Bp + (size_t)160 * K);      \
  rb6 = *(const uint4*)(Bp + (size_t)192 * K);      \
  rb7 = *(const uint4*)(Bp + (size_t)224 * K);
  __syncthreads();
  LOAD_AB()
  f32x16 acc[2][4];
#pragma unroll
  for (int i = 0; i < 2; ++i)
#pragma unroll
    for (int j = 0; j < 4; ++j)
#pragma unroll
      for (int r = 0; r < 16; ++r) acc[i][j][r] = 0.f;
  const int nk = K / 64;
  const bf16_t* pa = sA + (wm * 64 + (lane & 31)) * 72 + (lane >> 5) * 8;
  const bf16_t* pb = sB + (wn * 128 + (lane & 31)) * 72 + (lane >> 5) * 8;
#define MM8(A0, A1, B0, B1, B2, B3)                                                   \
  acc[0][0] = __builtin_amdgcn_mfma_f32_32x32x16_bf16(A0, B0, acc[0][0], 0, 0, 0);    \
  acc[1][0] = __builtin_amdgcn_mfma_f32_32x32x16_bf16(A1, B0, acc[1][0], 0, 0, 0);    \
  acc[0][1] = __builtin_amdgcn_mfma_f32_32x32x16_bf16(A0, B1, acc[0][1], 0, 0, 0);    \
  acc[1][1] = __builtin_amdgcn_mfma_f32_32x32x16_bf16(A1, B1, acc[1][1], 0, 0, 0);    \
  acc[0][2] = __builtin_amdgcn_mfma_f32_32x32x16_bf16(A0, B2, acc[0][2], 0, 0, 0);    \
  acc[1][2] = __builtin_amdgcn_mfma_f32_32x32x16_bf16(A1, B2, acc[1][2], 0, 0, 0);    \
  acc[0][3] = __builtin_amdgcn_mfma_f32_32x32x16_bf16(A0, B3, acc[0][3], 0, 0, 0);    \
  acc[1][3] = __builtin_amdgcn_mfma_f32_32x32x16_bf16(A1, B3, acc[1][3], 0, 0, 0);
#define HALF_STEP(KO)                                                                                   \
  {                                                                                                     \
    bf16x8 fa00 = *(const bf16x8*)(pa + (KO)), fa01 = *(const bf16x8*)(pa + 32 * 72 + (KO));            \
    bf16x8 fb00 = *(const bf16x8*)(pb + (KO)), fb01 = *(const bf16x8*)(pb + 32 * 72 + (KO));            \
    bf16x8 fb02 = *(const bf16x8*)(pb + 64 * 72 + (KO)), fb03 = *(const bf16x8*)(pb + 96 * 72 + (KO));  \
    bf16x8 fa10 = *(const bf16x8*)(pa + (KO) + 16), fa11 = *(const bf16x8*)(pa + 32 * 72 + (KO) + 16);  \
    bf16x8 fb10 = *(const bf16x8*)(pb + (KO) + 16), fb11 = *(const bf16x8*)(pb + 32 * 72 + (KO) + 16);  \
    bf16x8 fb12 = *(const bf16x8*)(pb + 64 * 72 + (KO) + 16), fb13 = *(const bf16x8*)(pb + 96 * 72 + (KO) + 16); \
    __builtin_amdgcn_sched_barrier(0);                                                                  \
    __builtin_amdgcn_s_setprio(1);                                                                      \
    MM8(fa00, fa01, fb00, fb01, fb02, fb03)                                                             \
    MM8(fa10, fa11, fb10, fb11, fb12, fb13)                                                             \
    __builtin_amdgcn_s_setprio(0);                                                                      \
    __builtin_amdgcn_sched_barrier(0);                                                                  \
  }
  for (int kt = 0; kt < nk; ++kt) {
    __syncthreads();
    *(uint4*)(sA + (lr + 0) * 72 + lc) = ra0;
    *(uint4*)(sA + (lr + 32) * 72 + lc) = ra1;
    *(uint4*)(sA + (lr + 64) * 72 + lc) = ra2;
    *(uint4*)(sA + (lr + 96) * 72 + lc) = ra3;
    *(uint4*)(sB + (lr + 0) * 72 + lc) = rb0;
    *(uint4*)(sB + (lr + 32) * 72 + lc) = rb1;
    *(uint4*)(sB + (lr + 64) * 72 + lc) = rb2;
    *(uint4*)(sB + (lr + 96) * 72 + lc) = rb3;
    *(uint4*)(sB + (lr + 128) * 72 + lc) = rb4;
    *(uint4*)(sB + (lr + 160) * 72 + lc) = rb5;
    *(uint4*)(sB + (lr + 192) * 72 + lc) = rb6;
    *(uint4*)(sB + (lr + 224) * 72 + lc) = rb7;
    __syncthreads();
    if (kt + 1 < nk) {
      Ap += 64;
      Bp += 64;
      LOAD_AB()
    }
    __builtin_amdgcn_sched_barrier(0);
    HALF_STEP(0)
    HALF_STEP(32)
  }
#undef HALF_STEP
#undef MM8
#undef LOAD_AB
  const int ci = lane & 31;
  const int rbase = m0 + wm * 64 + 4 * (lane >> 5);
  const int cbase = n0 + wn * 128;
  if (EPI == EPI_P) {
    bf16_t* P = (bf16_t*)(p.ws + OFF_P);
    float* AB = (float*)(p.ws + OFF_AB);
    bf16_t* NVT = (bf16_t*)(p.ws + OFF_NVT);
#pragma unroll
    for (int mt = 0; mt < 2; ++mt)
#pragma unroll
      for (int nt = 0; nt < 4; ++nt) {
        const int base = cbase + nt * 32;
#pragma unroll
        for (int r = 0; r < 16; ++r) {
          int row = rbase + mt * 32 + (r & 3) + 8 * (r >> 2);
          int col = base + ci;
          float v = acc[mt][nt][r];
          P[(size_t)row * INWP + col] = f2bf(v);
          if (col >= C_DA && col < C_DA + 16) AB[(size_t)row * 16 + col - C_DA] = v;
        }
        if (base >= C_NV && base < C_NV + 256) {
          const int hv = (base - C_NV) >> 6, dv = ((base - C_NV) & 63) + ci;
#pragma unroll
          for (int g = 0; g < 4; ++g) {
            const int row0 = rbase + mt * 32 + 8 * g;
            int bb, key0;
            if (row0 < M_LAT) { bb = row0 >> 11; key0 = 256 + (row0 & 2047); }
            else { bb = (row0 - M_LAT) >> 8; key0 = (row0 - M_LAT) & 255; }
            uint2 u;
            u.x = pack2(acc[mt][nt][4 * g + 0], acc[mt][nt][4 * g + 1]);
            u.y = pack2(acc[mt][nt][4 * g + 2], acc[mt][nt][4 * g + 3]);
            *(uint2*)(NVT + ((size_t)(bb * 4 + hv) * 64 + dv) * 2304 + key0) = u;
          }
        }
      }
  } else if (EPI == EPI_GU) {
    bf16_t* ACT = (bf16_t*)(p.ws + OFF_P);
#pragma unroll
    for (int mt = 0; mt < 2; ++mt)
#pragma unroll
      for (int pr = 0; pr < 2; ++pr)
#pragma unroll
        for (int r = 0; r < 16; ++r) {
          int row = rbase + mt * 32 + (r & 3) + 8 * (r >> 2);
          float gt = acc[mt][2 * pr][r], up = acc[mt][2 * pr + 1][r];
          float a = silu_f(gt) * up;
          ACT[(size_t)row * FFN + ((cbase >> 6) + pr) * 32 + ci] = f2bf(a);
        }
  }
}

__device__ void kpe_item(const Params& p, int it) {
  const int tid = otid();
  const bf16_t* P = (const bf16_t*)(p.ws + OFF_P);
  bf16_t* KH = (bf16_t*)(p.ws + OFF_KH);
  const float* rc = (const float*)(p.ws + OFF_ROPE);
  const float* rsn = rc + 2048 * 16;
  const int row = it * 8 + (tid >> 5), i = tid & 31;
  float v = bf2f(P[(size_t)row * INWP + C_MPE + i]);
  float o = __shfl_xor(v, 8);
  if (row < M_LAT) {
    int t = row & 2047;
    int a = i >> 4, hf = (i >> 3) & 1, j = i & 7;
    float c = rc[t * 16 + a * 8 + j], s = rsn[t * 16 + a * 8 + j];
    v = hf ? (o * s + v * c) : (v * c - o * s);
  }
  bf16_t bv = f2bf(v);
  int bb, key;
  if (row < M_LAT) { bb = row >> 11; key = 256 + (row & 2047); }
  else { bb = (row - M_LAT) >> 8; key = (row - M_LAT) & 255; }
#pragma unroll
  for (int h = 0; h < 4; ++h) KH[((size_t)(bb * 4 + h) * 2304 + key) * 96 + 64 + i] = bv;
}

__device__ void dn_prep(const Params& p, int l, int it, char* smem) {
  float* buf = (float*)smem;
  float* nrm = buf + 8 * 1536;
  const int tid = otid();
  const bf16_t* P = (const bf16_t*)(p.ws + OFF_P);
  bf16_t* DQ = (bf16_t*)(p.ws + OFF_DNQKV);
  const int r0 = it * 8;
  int seq_lo, seq_hi;
  if (r0 < M_LAT) {
    seq_lo = (r0 >> 11) << 11;
    seq_hi = seq_lo + 2048;
  } else {
    int rr = r0 - M_LAT;
    seq_lo = M_LAT + ((rr >> 8) << 8);
    seq_hi = seq_lo + 256;
  }
  const float* cw = p.conv_w + (size_t)l * 5 * 1536;
  __syncthreads();
  for (int c6 = 0; c6 < 6; ++c6) {
    const int ch = c6 * 256 + tid;
    float w0 = cw[ch], w1 = cw[1536 + ch], w2 = cw[2 * 1536 + ch], w3 = cw[3 * 1536 + ch], w4 = cw[4 * 1536 + ch];
    float xw[12];
#pragma unroll
    for (int j = 0; j < 12; ++j) {
      int r = r0 - 2 + j;
      xw[j] = (r >= seq_lo && r < seq_hi) ? bf2f(P[(size_t)r * INWP + C_DN + ch]) : 0.f;
    }
#pragma unroll
    for (int j = 0; j < 8; ++j) {
      float y = w0 * xw[j] + w1 * xw[j + 1] + w2 * xw[j + 2] + w3 * xw[j + 3] + w4 * xw[j + 4];
      buf[j * 1536 + ch] = silu_f(y);
    }
  }
  __syncthreads();
  {
    int vec = tid >> 2, part = tid & 3;
    int rr = vec >> 3, hv = vec & 7;
    const float* v = buf + rr * 1536 + hv * 128 + part * 32;
    float ss = 0.f;
#pragma unroll
    for (int i = 0; i < 32; ++i) ss += v[i] * v[i];
    ss += __shfl_xor(ss, 1);
    ss += __shfl_xor(ss, 2);
    if (part == 0) nrm[vec] = rsqrtf(ss + 1e-6f);
  }
  __syncthreads();
  for (int i = tid; i < 8 * 1536; i += 256) {
    int rr = i / 1536, ch = i - rr * 1536;
    float v = buf[i];
    if (ch < 1024) v *= nrm[rr * 8 + (ch >> 7)];
    DQ[(size_t)(r0 + rr) * 1536 + ch] = f2bf(v);
  }
}


DEVI int rowmap(int r, int hh) { return (r & 3) + 8 * (r >> 2) + 4 * hh; }

DEVI void unpack8(const uint4& u, float* f) {
  f[0] = bflo(u.x); f[1] = bfhi(u.x); f[2] = bflo(u.y); f[3] = bfhi(u.y);
  f[4] = bflo(u.z); f[5] = bfhi(u.z); f[6] = bflo(u.w); f[7] = bfhi(u.w);
}
__device__ void dn_chunk_prep(const Params& p, int l, int item, char* smem) {
  float* sW = (float*)smem;
  bf16_t* sKb = (bf16_t*)(smem + 7680);
  float* sL0 = (float*)(smem + 25088);
  float* sL1 = sL0 + 64 * 68;
  float* sg = (float*)(smem + 59904);
  float* sbt = sg + 128;
  const int tid = otid(), lane = tid & 63, w = tid >> 6, li = lane & 31, hh = lane >> 5;
  const int chunk = item >> 2, h = item & 3;
  int row0, seq_lo, seq_hi;
  if (chunk < 256) {
    int b = chunk >> 5;
    row0 = b * 2048 + (chunk & 31) * 64; seq_lo = b * 2048; seq_hi = seq_lo + 2048;
  } else {
    int cc = chunk - 256, b = cc >> 2;
    row0 = M_LAT + b * 256 + (cc & 3) * 64; seq_lo = M_LAT + b * 256; seq_hi = seq_lo + 256;
  }
  const bf16_t* P = (const bf16_t*)(p.ws + OFF_P);
  bf16_t* DQ = (bf16_t*)(p.ws + OFF_DNQKV);
  const float* AB = (const float*)(p.ws + OFF_AB);
  const float* cw = p.conv_w + (size_t)l * 5 * 1536;
  __syncthreads();
  for (int i = tid; i < 5 * 384; i += 256) {
    const int tap = i / 384, cc = i - tap * 384, type = cc >> 7, c = cc & 127;
    const int off = type == 0 ? 512 : (type == 1 ? 0 : 1024);
    sW[i] = cw[tap * 1536 + off + h * 128 + c];
  }
  if (w < 2) {
    const int d = w;
    const int row = d ? (row0 + 63 - lane) : (row0 + lane);
    const float Aneg = -__expf(p.a_log[l * 8 + d * 4 + h]);
    const float dtb = p.dt_bias[l * 8 + d * 4 + h];
    float a = AB[(size_t)row * 16 + d * 4 + h];
    float bb = AB[(size_t)row * 16 + 8 + d * 4 + h];
    float xx = a + dtb;
    const float ee = __expf(xx);
    float sp = ee < 0.25f ? ee * (1.f - ee * (0.5f - ee * (0.33333333f - ee * (0.25f - 0.2f * ee))))
                          : (xx > 20.f ? xx : __logf(1.f + ee));
    float g = Aneg * sp;
#pragma unroll
    for (int o = 1; o < 64; o <<= 1) {
      float y = __shfl_up(g, o);
      if (lane >= o) g += y;
    }
    float be = 1.f / (1.f + __expf(-bb));
    sg[d * 64 + lane] = g;
    sbt[d * 64 + lane] = be;
    ((float*)(p.ws + OFF_GC))[(size_t)row * 8 + d * 4 + h] = g;
    ((float*)(p.ws + OFF_BETA))[(size_t)row * 8 + d * 4 + h] = be;
  }
  __syncthreads();
  const int cg = tid & 15, rsub = tid >> 4;
#pragma unroll 1
  for (int type = 0; type < 3; ++type) {
    const int off = type == 0 ? 512 : (type == 1 ? 0 : 1024);
    uint4 xv[4][5];
#pragma unroll
    for (int e = 0; e < 4; ++e) {
      const int row = rsub + 16 * e;
      const bf16_t* base = P + (size_t)(row0 + row) * INWP + C_DN + off + h * 128 + cg * 8;
#pragma unroll
      for (int dd = 0; dd < 5; ++dd) {
        const int r = row0 + row + dd - 2;
        xv[e][dd] = (r >= seq_lo && r < seq_hi) ? *(const uint4*)(base + (dd - 2) * INWP) : make_uint4(0u, 0u, 0u, 0u);
      }
    }
#pragma unroll
    for (int e = 0; e < 4; ++e) {
      const int row = rsub + 16 * e;
      float y[8];
#pragma unroll
      for (int j = 0; j < 8; ++j) y[j] = 0.f;
#pragma unroll
      for (int dd = 0; dd < 5; ++dd) {
        float xf[8];
        unpack8(xv[e][dd], xf);
        const float4 wa = *(const float4*)(sW + dd * 384 + type * 128 + cg * 8);
        const float4 wb = *(const float4*)(sW + dd * 384 + type * 128 + cg * 8 + 4);
        y[0] += wa.x * xf[0]; y[1] += wa.y * xf[1]; y[2] += wa.z * xf[2]; y[3] += wa.w * xf[3];
        y[4] += wb.x * xf[4]; y[5] += wb.y * xf[5]; y[6] += wb.z * xf[6]; y[7] += wb.w * xf[7];
      }
      float ss = 0.f;
#pragma unroll
      for (int j = 0; j < 8; ++j) {
        y[j] = silu_f(y[j]);
        ss += y[j] * y[j];
      }
      if (type < 2) {
        ss += __shfl_xor(ss, 1);
        ss += __shfl_xor(ss, 2);
        ss += __shfl_xor(ss, 4);
        ss += __shfl_xor(ss, 8);
        const float rn = rsqrtf(ss + 1e-6f);
#pragma unroll
        for (int j = 0; j < 8; ++j) y[j] *= rn;
      }
      uint4 u;
      u.x = pack2(y[0], y[1]); u.y = pack2(y[2], y[3]); u.z = pack2(y[4], y[5]); u.w = pack2(y[6], y[7]);
      *(uint4*)(DQ + (size_t)(row0 + row) * 1536 + off + h * 128 + cg * 8) = u;
      if (type == 0) *(uint4*)(sKb + row * 136 + cg * 8) = u;
    }
  }
  __syncthreads();
  {
    const int mi = w >> 1, ni = w & 1;
    f32x16 g;
#pragma unroll
    for (int r = 0; r < 16; ++r) g[r] = 0.f;
#pragma unroll
    for (int ks = 0; ks < 8; ++ks) {
      bf16x8 a = *(const bf16x8*)(sKb + (mi * 32 + li) * 136 + ks * 16 + hh * 8);
      bf16x8 b = *(const bf16x8*)(sKb + (ni * 32 + li) * 136 + ks * 16 + hh * 8);
      g = __builtin_amdgcn_mfma_f32_32x32x16_bf16(a, b, g, 0, 0, 0);
    }
#pragma unroll
    for (int r = 0; r < 16; ++r) {
      const int i = mi * 32 + rowmap(r, hh), m = ni * 32 + li;
      const float G = g[r];
      sL0[i * 68 + m] = (i > m) ? sbt[i] * G * __expf(sg[i] - sg[m]) : 0.f;
      const int i1 = 63 - i, m1 = 63 - m;
      sL1[i1 * 68 + m1] = (i1 > m1) ? sbt[64 + i1] * G * __expf(sg[64 + i1] - sg[64 + m1]) : 0.f;
    }
  }
  __syncthreads();
  if (w < 2) {
    const float* L = w == 0 ? sL0 : sL1;
    float t[64];
#pragma unroll
    for (int i = 0; i < 64; ++i) {
      float a0 = (i == lane) ? 1.f : 0.f, a1 = 0.f, a2 = 0.f, a3 = 0.f;
#pragma unroll
      for (int m = 0; m < i; ++m) {
        const float pr = L[i * 68 + m] * t[m];
        if ((m & 3) == 0) a0 -= pr;
        else if ((m & 3) == 1) a1 -= pr;
        else if ((m & 3) == 2) a2 -= pr;
        else a3 -= pr;
      }
      t[i] = (a0 + a1) + (a2 + a3);
    }
    bf16_t* Tg = (bf16_t*)(p.ws + OFF_OB) + (size_t)((chunk * 4 + h) * 2 + w) * 4096;
#pragma unroll
    for (int i = 0; i < 64; ++i) Tg[i * 64 + lane] = f2bf(t[i]);
  }
}

DEVI bf16x8 ld_perm(const bf16_t* p) {
  union { bf16x8 v; uint2 d[2]; } u;
  u.d[0] = *(const uint2*)(p);
  u.d[1] = *(const uint2*)(p + 8);
  return u.v;
}
DEVI bf16x8 pack8(const f32x16& x, int s) {
  union { bf16x8 v; unsigned w[4]; } u;
  u.w[0] = pack2(x[8 * s + 0], x[8 * s + 1]);
  u.w[1] = pack2(x[8 * s + 2], x[8 * s + 3]);
  u.w[2] = pack2(x[8 * s + 4], x[8 * s + 5]);
  u.w[3] = pack2(x[8 * s + 6], x[8 * s + 7]);
  return u.v;
}

__device__ void dn_scan(const Params& p, int l, int item, char* smem) {
  bf16_t* sK = (bf16_t*)smem;
  bf16_t* sQ = (bf16_t*)(smem + 17408);
  bf16_t* sKT = (bf16_t*)(smem + 34816);
  bf16_t* sT = (bf16_t*)(smem + 52224);
  bf16_t* sA = (bf16_t*)(smem + 60928);
  bf16_t* sV = (bf16_t*)(smem + 52224);
  float* sg = (float*)(smem + 69632);
  float* sbt = sg + 64;
  float* seg = sbt + 64;
  float* sdt = seg + 64;
  const int d = item & 1, h = (item >> 1) & 3, b = item >> 3;
  const bf16_t* DQ = (const bf16_t*)(p.ws + OFF_DNQKV);
  const bf16_t* TB = (const bf16_t*)(p.ws + OFF_OB);
  const float* GC = (const float*)(p.ws + OFF_GC);
  const float* BE = (const float*)(p.ws + OFF_BETA);
  bf16_t* MIX = (bf16_t*)(p.ws + OFF_HM);
  bf16_t* Pw = (bf16_t*)(p.ws + OFF_P);
  const float qscale = 0.08838834764831845f;
  const int rsign = d ? -1 : 1;
  f32x16 S0, S1, S2, S3;
#pragma unroll
  for (int r = 0; r < 16; ++r) { S0[r] = 0.f; S1[r] = 0.f; S2[r] = 0.f; S3[r] = 0.f; }
  __builtin_amdgcn_s_setprio(3);
  uint4 qA0, qB0, kA0, kB0, vA0, vB0, qA1, qB1, kA1, kB1, vA1, vB1, tq0, tq1;
  float pgc = 0.f, pbe = 0.f;
#define SCAN_ROW0(N, CHUNK, ROW0)                                    \
  {                                                                  \
    if ((N) < 4) {                                                   \
      int cn = d ? (3 - (N)) : (N);                                  \
      CHUNK = 256 + b * 4 + cn;                                      \
      ROW0 = M_LAT + b * 256 + cn * 64;                              \
    } else {                                                         \
      int ln = (N)-4;                                                \
      ln = d ? (31 - ln) : ln;                                       \
      CHUNK = b * 32 + ln;                                           \
      ROW0 = b * 2048 + ln * 64;                                     \
    }                                                                \
  }
#define SCAN_LOADS(N)                                                                         \
  {                                                                                           \
    const int tid_ = otid();                                                                  \
    int chunk_, row0_;                                                                        \
    SCAN_ROW0(N, chunk_, row0_)                                                               \
    const int rstart_ = d ? (row0_ + 63) : row0_;                                             \
    {                                                                                         \
      const int u = tid_, c8 = u & 15, tp = u >> 4;                                           \
      const bf16_t* ga = DQ + (size_t)(rstart_ + rsign * 2 * tp) * 1536 + h * 128 + c8 * 8;   \
      const bf16_t* gb = ga + rsign * 1536;                                                   \
      qA0 = *(const uint4*)(ga); kA0 = *(const uint4*)(ga + 512); vA0 = *(const uint4*)(ga + 1024); \
      qB0 = *(const uint4*)(gb); kB0 = *(const uint4*)(gb + 512); vB0 = *(const uint4*)(gb + 1024); \
    }                                                                                         \
    {                                                                                         \
      const int u = tid_ + 256, c8 = u & 15, tp = u >> 4;                                     \
      const bf16_t* ga = DQ + (size_t)(rstart_ + rsign * 2 * tp) * 1536 + h * 128 + c8 * 8;   \
      const bf16_t* gb = ga + rsign * 1536;                                                   \
      qA1 = *(const uint4*)(ga); kA1 = *(const uint4*)(ga + 512); vA1 = *(const uint4*)(ga + 1024); \
      qB1 = *(const uint4*)(gb); kB1 = *(const uint4*)(gb + 512); vB1 = *(const uint4*)(gb + 1024); \
    }                                                                                         \
    {                                                                                         \
      const bf16_t* Tg = TB + (size_t)((chunk_ * 4 + h) * 2 + d) * 4096;                      \
      tq0 = *(const uint4*)(Tg + (tid_ >> 3) * 64 + (tid_ & 7) * 8);                          \
      tq1 = *(const uint4*)(Tg + ((tid_ >> 3) + 32) * 64 + (tid_ & 7) * 8);                   \
    }                                                                                         \
    if (tid_ < 64) {                                                                          \
      const int row = rstart_ + rsign * tid_;                                                 \
      pgc = GC[(size_t)row * 8 + d * 4 + h];                                                  \
      pbe = BE[(size_t)row * 8 + d * 4 + h];                                                  \
    }                                                                                         \
  }
  SCAN_LOADS(0)
  for (int n = 0; n < 36; ++n) {
    const int tid = otid(), lane = tid & 63, w = tid >> 6, li = lane & 31, hh = lane >> 5;
    int chunk, row0;
    SCAN_ROW0(n, chunk, row0)
    (void)chunk;
    const int rstart = d ? (row0 + 63) : row0;
    __syncthreads();
#define STAGE_UNIT(U, QA, QB, KA, KB, VA, VB)                                                   \
  {                                                                                             \
    const int c8 = (U)&15, tp = (U) >> 4;                                                       \
    *(uint4*)(sQ + (2 * tp) * 136 + c8 * 8) = QA;                                               \
    *(uint4*)(sQ + (2 * tp + 1) * 136 + c8 * 8) = QB;                                           \
    *(uint4*)(sK + (2 * tp) * 136 + c8 * 8) = KA;                                               \
    *(uint4*)(sK + (2 * tp + 1) * 136 + c8 * 8) = KB;                                           \
    *(uint4*)(sV + (2 * tp) * 136 + c8 * 8) = VA;                                               \
    *(uint4*)(sV + (2 * tp + 1) * 136 + c8 * 8) = VB;                                           \
    unsigned* kt = (unsigned*)(sKT + (c8 * 8) * 68 + 2 * tp);                                   \
    kt[0 * 34] = (KA.x & 0xffffu) | (KB.x << 16);                                               \
    kt[1 * 34] = (KA.x >> 16) | (KB.x & 0xffff0000u);                                           \
    kt[2 * 34] = (KA.y & 0xffffu) | (KB.y << 16);                                               \
    kt[3 * 34] = (KA.y >> 16) | (KB.y & 0xffff0000u);                                           \
    kt[4 * 34] = (KA.z & 0xffffu) | (KB.z << 16);                                               \
    kt[5 * 34] = (KA.z >> 16) | (KB.z & 0xffff0000u);                                           \
    kt[6 * 34] = (KA.w & 0xffffu) | (KB.w << 16);                                               \
    kt[7 * 34] = (KA.w >> 16) | (KB.w & 0xffff0000u);                                           \
  }
    STAGE_UNIT(tid, qA0, qB0, kA0, kB0, vA0, vB0)
    STAGE_UNIT(tid + 256, qA1, qB1, kA1, kB1, vA1, vB1)
#undef STAGE_UNIT
    if (tid < 64) {
      float g63 = __shfl(pgc, 63);
      sg[lane] = pgc;
      sbt[lane] = pbe;
      seg[lane] = __expf(pgc);
      sdt[lane] = __expf(g63 - pgc);
    }
    __syncthreads();
    f32x16 v0, v1;
#pragma unroll
    for (int r = 0; r < 16; ++r) {
      const int t0 = rowmap(r, hh);
      v0[r] = bf2f(sV[t0 * 136 + w * 32 + li]);
      v1[r] = bf2f(sV[(32 + t0) * 136 + w * 32 + li]);
    }
    __syncthreads();
    {
      const int i0 = tid >> 3, c8 = tid & 7;
      *(uint2*)(sT + i0 * 68 + c8 * 8) = make_uint2(tq0.x, tq0.y);
      *(uint2*)(sT + i0 * 68 + c8 * 8 + 4) = make_uint2(tq0.z, tq0.w);
      *(uint2*)(sT + (i0 + 32) * 68 + c8 * 8) = make_uint2(tq1.x, tq1.y);
      *(uint2*)(sT + (i0 + 32) * 68 + c8 * 8 + 4) = make_uint2(tq1.z, tq1.w);
    }
    {
      const int mi = w >> 1, ni = w & 1;
      f32x16 a;
#pragma unroll
      for (int r = 0; r < 16; ++r) a[r] = 0.f;
      if (!(mi == 0 && ni == 1)) {
#pragma unroll
        for (int ks = 0; ks < 8; ++ks) {
          bf16x8 qa = *(const bf16x8*)(sQ + (mi * 32 + li) * 136 + ks * 16 + hh * 8);
          bf16x8 kb = *(const bf16x8*)(sK + (ni * 32 + li) * 136 + ks * 16 + hh * 8);
          a = __builtin_amdgcn_mfma_f32_32x32x16_bf16(qa, kb, a, 0, 0, 0);
        }
      }
#pragma unroll
      for (int r = 0; r < 16; ++r) {
        const int i = mi * 32 + rowmap(r, hh), j = ni * 32 + li;
        float val = (i >= j) ? a[r] * qscale * __expf(sg[i] - sg[j]) : 0.f;
        sA[i * 68 + j] = f2bf(val);
      }
    }
    __syncthreads();
    f32x16 ks0, ks1;
#pragma unroll
    for (int r = 0; r < 16; ++r) { ks0[r] = 0.f; ks1[r] = 0.f; }
    {
      const bf16_t* ka = sK + li * 136 + 4 * hh;
#define K_STEP(OFFS, SX, SS)                                                                           \
  {                                                                                                    \
    bf16x8 sb = pack8(SX, SS);                                                                         \
    ks0 = __builtin_amdgcn_mfma_f32_32x32x16_bf16(ld_perm(ka + (OFFS)), sb, ks0, 0, 0, 0);             \
    ks1 = __builtin_amdgcn_mfma_f32_32x32x16_bf16(ld_perm(ka + 32 * 136 + (OFFS)), sb, ks1, 0, 0, 0);  \
  }
      K_STEP(0, S0, 0) K_STEP(16, S0, 1) K_STEP(32, S1, 0) K_STEP(48, S1, 1)
      K_STEP(64, S2, 0) K_STEP(80, S2, 1) K_STEP(96, S3, 0) K_STEP(112, S3, 1)
#undef K_STEP
    }
#pragma unroll
    for (int r = 0; r < 16; ++r) {
      const int t0 = rowmap(r, hh), t1 = 32 + t0;
      v0[r] = sbt[t0] * (v0[r] - seg[t0] * ks0[r]);
      v1[r] = sbt[t1] * (v1[r] - seg[t1] * ks1[r]);
    }
    __builtin_amdgcn_sched_barrier(0);
    bf16x8 rb00 = pack8(v0, 0), rb01 = pack8(v0, 1), rb10 = pack8(v1, 0), rb11 = pack8(v1, 1);
    f32x16 n0, n1;
#pragma unroll
    for (int r = 0; r < 16; ++r) { n0[r] = 0.f; n1[r] = 0.f; }
    {
      const bf16_t* ta = sT + li * 68 + 4 * hh;
      n0 = __builtin_amdgcn_mfma_f32_32x32x16_bf16(ld_perm(ta + 0), rb00, n0, 0, 0, 0);
      n0 = __builtin_amdgcn_mfma_f32_32x32x16_bf16(ld_perm(ta + 16), rb01, n0, 0, 0, 0);
      const bf16_t* tb = ta + 32 * 68;
      n1 = __builtin_amdgcn_mfma_f32_32x32x16_bf16(ld_perm(tb + 0), rb00, n1, 0, 0, 0);
      n1 = __builtin_amdgcn_mfma_f32_32x32x16_bf16(ld_perm(tb + 16), rb01, n1, 0, 0, 0);
      n1 = __builtin_amdgcn_mfma_f32_32x32x16_bf16(ld_perm(tb + 32), rb10, n1, 0, 0, 0);
      n1 = __builtin_amdgcn_mfma_f32_32x32x16_bf16(ld_perm(tb + 48), rb11, n1, 0, 0, 0);
    }
    __builtin_amdgcn_sched_barrier(0);
    f32x16 o0, o1;
#pragma unroll
    for (int r = 0; r < 16; ++r) { o0[r] = 0.f; o1[r] = 0.f; }
    {
      const bf16_t* qa = sQ + li * 136 + 4 * hh;
#define Q_STEP(OFFS, SX, SS)                                                                           \
  {                                                                                                    \
    bf16x8 sb = pack8(SX, SS);                                                                         \
    o0 = __builtin_amdgcn_mfma_f32_32x32x16_bf16(ld_perm(qa + (OFFS)), sb, o0, 0, 0, 0);               \
    o1 = __builtin_amdgcn_mfma_f32_32x32x16_bf16(ld_perm(qa + 32 * 136 + (OFFS)), sb, o1, 0, 0, 0);    \
  }
      Q_STEP(0, S0, 0) Q_STEP(16, S0, 1) Q_STEP(32, S1, 0) Q_STEP(48, S1, 1)
      Q_STEP(64, S2, 0) Q_STEP(80, S2, 1) Q_STEP(96, S3, 0) Q_STEP(112, S3, 1)
#undef Q_STEP
    }
#pragma unroll
    for (int r = 0; r < 16; ++r) {
      const int t0 = rowmap(r, hh), t1 = 32 + t0;
      o0[r] *= seg[t0] * qscale;
      o1[r] *= seg[t1] * qscale;
    }
    {
      bf16x8 nb00 = pack8(n0, 0), nb01 = pack8(n0, 1), nb10 = pack8(n1, 0), nb11 = pack8(n1, 1);
      const bf16_t* aa = sA + li * 68 + 4 * hh;
      o0 = __builtin_amdgcn_mfma_f32_32x32x16_bf16(ld_perm(aa + 0), nb00, o0, 0, 0, 0);
      o0 = __builtin_amdgcn_mfma_f32_32x32x16_bf16(ld_perm(aa + 16), nb01, o0, 0, 0, 0);
      const bf16_t* ab = aa + 32 * 68;
      o1 = __builtin_amdgcn_mfma_f32_32x32x16_bf16(ld_perm(ab + 0), nb00, o1, 0, 0, 0);
      o1 = __builtin_amdgcn_mfma_f32_32x32x16_bf16(ld_perm(ab + 16), nb01, o1, 0, 0, 0);
      o1 = __builtin_amdgcn_mfma_f32_32x32x16_bf16(ld_perm(ab + 32), nb10, o1, 0, 0, 0);
      o1 = __builtin_amdgcn_mfma_f32_32x32x16_bf16(ld_perm(ab + 48), nb11, o1, 0, 0, 0);
    }
    __syncthreads();
#pragma unroll
    for (int r = 0; r < 16; ++r) {
      const int t0 = rowmap(r, hh);
      sQ[t0 * 136 + w * 32 + li] = f2bf(o0[r]);
      sQ[(32 + t0) * 136 + w * 32 + li] = f2bf(o1[r]);
    }
#pragma unroll
    for (int r = 0; r < 16; ++r) {
      const int t0 = rowmap(r, hh), t1 = 32 + t0;
      n0[r] *= sdt[t0];
      n1[r] *= sdt[t1];
    }
    {
      bf16x8 nb00 = pack8(n0, 0), nb01 = pack8(n0, 1), nb10 = pack8(n1, 0), nb11 = pack8(n1, 1);
      const float eg63 = seg[63];
#pragma unroll
      for (int r = 0; r < 16; ++r) { S0[r] *= eg63; S1[r] *= eg63; S2[r] *= eg63; S3[r] *= eg63; }
      __builtin_amdgcn_sched_barrier(0);
      SCAN_LOADS(min(n + 1, 35))
      __builtin_amdgcn_sched_barrier(0);
      const bf16_t* kt = sKT + li * 68 + 4 * hh;
#define S_UPD(SX, DKT)                                                                                   \
  SX = __builtin_amdgcn_mfma_f32_32x32x16_bf16(ld_perm(kt + (DKT) * 32 * 68 + 0), nb00, SX, 0, 0, 0);    \
  SX = __builtin_amdgcn_mfma_f32_32x32x16_bf16(ld_perm(kt + (DKT) * 32 * 68 + 16), nb01, SX, 0, 0, 0);   \
  SX = __builtin_amdgcn_mfma_f32_32x32x16_bf16(ld_perm(kt + (DKT) * 32 * 68 + 32), nb10, SX, 0, 0, 0);   \
  SX = __builtin_amdgcn_mfma_f32_32x32x16_bf16(ld_perm(kt + (DKT) * 32 * 68 + 48), nb11, SX, 0, 0, 0);
      S_UPD(S0, 0) S_UPD(S1, 1) S_UPD(S2, 2) S_UPD(S3, 3)
#undef S_UPD
    }
    __syncthreads();
    {
      bf16_t* obase = d ? (Pw + C_DN + h * 128) : (MIX + 512 + h * 128);
      const int ostride = d ? INWP : 1024;
#pragma unroll
      for (int e = 0; e < 4; ++e) {
        const int idx = tid + 256 * e, tok = idx >> 4, c8 = idx & 15;
        const int row = rstart + rsign * tok;
        *(uint4*)(obase + (size_t)row * ostride + c8 * 8) = *(const uint4*)(sQ + tok * 136 + c8 * 8);
      }
    }
  }
#undef SCAN_LOADS
#undef SCAN_ROW0
  __builtin_amdgcn_s_setprio(0);
}

__device__ void phaseC(const Params& p, int l, char* smem) {
  const int nb = gridDim.x, bid = blockIdx.x;
  const bf16_t* P = (const bf16_t*)(p.ws + OFF_P);
  constexpr int T0 = 1152, T1 = T0 + 144 * 3, T2 = T1 + 144 * 4, T3 = T2 + M_ALL / 8;
  for (int it = bid; it < T3; it += nb) {
    if (it < T0) {
      dn_chunk_prep(p, l, it, smem);
    } else if (it < T1) {
      int i = it - T0;
      if (l == 3 && i >= 128 * 3) continue;
      gemm_tile<EPI_QUP>(p, l, P + C_MQ, INWP, (const bf16_t*)(p.ws + OFF_WQUP), 256, (i / 3) * 128, (i % 3) * 128, 0,
                         smem);
    } else if (it < T2) {
      int i = it - T1;
      gemm_tile<EPI_KVUP>(p, l, P + C_MKV, INWP, (const bf16_t*)(p.ws + OFF_WKVUP), 128, (i / 4) * 128, (i % 4) * 128,
                          0, smem);
    } else {
      kpe_item(p, it - T2);
    }
  }
}

__device__ void mla_flash(const Params& p, int item, char* smem) {
  bf16_t* sK = (bf16_t*)smem;
  bf16_t* sV = sK + 64 * 104;
  const int tid = otid(), lane = tid & 63, w = tid >> 6;
  const int li = lane & 31, hh = lane >> 5;
  int b, h, q0row, nkeys;
  if (item < 512) {
    b = item >> 6; h = (item >> 4) & 3; q0row = b * 2048 + (item & 15) * 128; nkeys = 2304;
  } else {
    int i = item - 512;
    b = i >> 3; h = (i >> 1) & 3; q0row = M_LAT + b * 256 + (i & 1) * 128; nkeys = 256;
  }
  const bf16_t* Kg = (const bf16_t*)(p.ws + OFF_KH) + (size_t)(b * 4 + h) * 2304 * 96;
  const bf16_t* Vg = (const bf16_t*)(p.ws + OFF_VH) + (size_t)(b * 4 + h) * 64 * 2304;
  const bf16_t* QH = (const bf16_t*)(p.ws + OFF_QH);
  bf16_t* MIX = (bf16_t*)(p.ws + OFF_HM);
  const int qrow = q0row + w * 32 + li;
  bf16x8 qf0, qf1, qf2, qf3, qf4, qf5;
  {
    const bf16_t* qp = QH + (size_t)qrow * 384 + h * 96 + hh * 8;
    qf0 = *(const bf16x8*)(qp); qf1 = *(const bf16x8*)(qp + 16); qf2 = *(const bf16x8*)(qp + 32);
    qf3 = *(const bf16x8*)(qp + 48); qf4 = *(const bf16x8*)(qp + 64); qf5 = *(const bf16x8*)(qp + 80);
  }
  const int k_i0 = tid, k_i1 = tid + 256, k_i2 = tid + 512;
  const int kk0 = k_i0 / 12, kc0 = k_i0 % 12, kk1 = k_i1 / 12, kc1 = k_i1 % 12, kk2 = k_i2 / 12, kc2 = k_i2 % 12;
  const int vd0 = tid >> 3, vc0 = tid & 7, vd1 = vd0 + 32;
  uint4 rk0, rk1, rk2, rv0, rv1;
  rk0 = *(const uint4*)(Kg + (size_t)kk0 * 96 + kc0 * 8);
  rk1 = *(const uint4*)(Kg + (size_t)kk1 * 96 + kc1 * 8);
  rk2 = *(const uint4*)(Kg + (size_t)kk2 * 96 + kc2 * 8);
  rv0 = *(const uint4*)(Vg + (size_t)vd0 * 2304 + vc0 * 8);
  rv1 = *(const uint4*)(Vg + (size_t)vd1 * 2304 + vc0 * 8);
  f32x16 o0, o1;
#pragma unroll
  for (int r = 0; r < 16; ++r) { o0[r] = 0.f; o1[r] = 0.f; }
  float m = -1e30f, lp = 0.f;
  const float sc = 0.10206207261596577f * 1.4426950408889634f;
  const int nt = nkeys >> 6;
  for (int t = 0; t < nt; ++t) {
    __syncthreads();
    *(uint4*)(sK + kk0 * 104 + kc0 * 8) = rk0;
    *(uint4*)(sK + kk1 * 104 + kc1 * 8) = rk1;
    *(uint4*)(sK + kk2 * 104 + kc2 * 8) = rk2;
    *(uint2*)(sV + vd0 * 68 + vc0 * 8) = make_uint2(rv0.x, rv0.y);
    *(uint2*)(sV + vd0 * 68 + vc0 * 8 + 4) = make_uint2(rv0.z, rv0.w);
    *(uint2*)(sV + vd1 * 68 + vc0 * 8) = make_uint2(rv1.x, rv1.y);
    *(uint2*)(sV + vd1 * 68 + vc0 * 8 + 4) = make_uint2(rv1.z, rv1.w);
    __syncthreads();
    if (t + 1 < nt) {
      const int k0 = (t + 1) * 64;
      rk0 = *(const uint4*)(Kg + (size_t)(k0 + kk0) * 96 + kc0 * 8);
      rk1 = *(const uint4*)(Kg + (size_t)(k0 + kk1) * 96 + kc1 * 8);
      rk2 = *(const uint4*)(Kg + (size_t)(k0 + kk2) * 96 + kc2 * 8);
      rv0 = *(const uint4*)(Vg + (size_t)vd0 * 2304 + k0 + vc0 * 8);
      rv1 = *(const uint4*)(Vg + (size_t)vd1 * 2304 + k0 + vc0 * 8);
    }
    f32x16 s0, s1;
#pragma unroll
    for (int r = 0; r < 16; ++r) { s0[r] = 0.f; s1[r] = 0.f; }
    {
      const bf16_t* ka = sK + li * 104 + hh * 8;
      const bf16_t* kb = ka + 32 * 104;
      s0 = __builtin_amdgcn_mfma_f32_32x32x16_bf16(*(const bf16x8*)(ka), qf0, s0, 0, 0, 0);
      s1 = __builtin_amdgcn_mfma_f32_32x32x16_bf16(*(const bf16x8*)(kb), qf0, s1, 0, 0, 0);
      s0 = __builtin_amdgcn_mfma_f32_32x32x16_bf16(*(const bf16x8*)(ka + 16), qf1, s0, 0, 0, 0);
      s1 = __builtin_amdgcn_mfma_f32_32x32x16_bf16(*(const bf16x8*)(kb + 16), qf1, s1, 0, 0, 0);
      s0 = __builtin_amdgcn_mfma_f32_32x32x16_bf16(*(const bf16x8*)(ka + 32), qf2, s0, 0, 0, 0);
      s1 = __builtin_amdgcn_mfma_f32_32x32x16_bf16(*(const bf16x8*)(kb + 32), qf2, s1, 0, 0, 0);
      s0 = __builtin_amdgcn_mfma_f32_32x32x16_bf16(*(const bf16x8*)(ka + 48), qf3, s0, 0, 0, 0);
      s1 = __builtin_amdgcn_mfma_f32_32x32x16_bf16(*(const bf16x8*)(kb + 48), qf3, s1, 0, 0, 0);
      s0 = __builtin_amdgcn_mfma_f32_32x32x16_bf16(*(const bf16x8*)(ka + 64), qf4, s0, 0, 0, 0);
      s1 = __builtin_amdgcn_mfma_f32_32x32x16_bf16(*(const bf16x8*)(kb + 64), qf4, s1, 0, 0, 0);
      s0 = __builtin_amdgcn_mfma_f32_32x32x16_bf16(*(const bf16x8*)(ka + 80), qf5, s0, 0, 0, 0);
      s1 = __builtin_amdgcn_mfma_f32_32x32x16_bf16(*(const bf16x8*)(kb + 80), qf5, s1, 0, 0, 0);
    }
    float mx = s0[0];
#pragma unroll
    for (int r = 1; r < 16; ++r) mx = fmaxf(mx, s0[r]);
#pragma unroll
    for (int r = 0; r < 16; ++r) mx = fmaxf(mx, s1[r]);
    mx = fmaxf(mx, __shfl_xor(mx, 32));
    const float mn = fmaxf(m, mx * sc);
    const float corr = __builtin_amdgcn_exp2f(m - mn);
    m = mn;
    lp *= corr;
#pragma unroll
    for (int r = 0; r < 16; ++r) { o0[r] *= corr; o1[r] *= corr; }
#pragma unroll
    for (int r = 0; r < 16; ++r) {
      s0[r] = __builtin_amdgcn_exp2f(s0[r] * sc - mn);
      s1[r] = __builtin_amdgcn_exp2f(s1[r] * sc - mn);
      lp += s0[r] + s1[r];
    }
#pragma unroll
    for (int u = 0; u < 2; ++u) {
#pragma unroll
      for (int s = 0; s < 2; ++s) {
        union { bf16x8 v; unsigned w[4]; } pb;
        if (u == 0) {
          pb.w[0] = pack2(s0[8 * s + 0], s0[8 * s + 1]); pb.w[1] = pack2(s0[8 * s + 2], s0[8 * s + 3]);
          pb.w[2] = pack2(s0[8 * s + 4], s0[8 * s + 5]); pb.w[3] = pack2(s0[8 * s + 6], s0[8 * s + 7]);
        } else {
          pb.w[0] = pack2(s1[8 * s + 0], s1[8 * s + 1]); pb.w[1] = pack2(s1[8 * s + 2], s1[8 * s + 3]);
          pb.w[2] = pack2(s1[8 * s + 4], s1[8 * s + 5]); pb.w[3] = pack2(s1[8 * s + 6], s1[8 * s + 7]);
        }
        const bf16_t* va = sV + li * 68 + 32 * u + 16 * s + 4 * hh;
        union { bf16x8 v; uint2 d[2]; } a0, a1;
        a0.d[0] = *(const uint2*)(va);
        a0.d[1] = *(const uint2*)(va + 8);
        a1.d[0] = *(const uint2*)(va + 32 * 68);
        a1.d[1] = *(const uint2*)(va + 32 * 68 + 8);
        o0 = __builtin_amdgcn_mfma_f32_32x32x16_bf16(a0.v, pb.v, o0, 0, 0, 0);
        o1 = __builtin_amdgcn_mfma_f32_32x32x16_bf16(a1.v, pb.v, o1, 0, 0, 0);
      }
    }
  }
  lp += __shfl_xor(lp, 32);
  const float inv = 1.f / lp;
  bf16_t* op = MIX + (size_t)qrow * 1024 + h * 64 + 4 * hh;
#pragma unroll
  for (int g = 0; g < 4; ++g) {
    uint2 u0, u1;
    u0.x = pack2(o0[4 * g + 0] * inv, o0[4 * g + 1] * inv);
    u0.y = pack2(o0[4 * g + 2] * inv, o0[4 * g + 3] * inv);
    u1.x = pack2(o1[4 * g + 0] * inv, o1[4 * g + 1] * inv);
    u1.y = pack2(o1[4 * g + 2] * inv, o1[4 * g + 3] * inv);
    *(uint2*)(op + 8 * g) = u0;
    *(uint2*)(op + 32 + 8 * g) = u1;
  }
}

__device__ void na_naive(const Params& p, int l, int ti) {
  const int h = otid() >> 6, lane = otid() & 63;
  const bf16_t* P = (const bf16_t*)(p.ws + OFF_P);
  bf16_t* MIX = (bf16_t*)(p.ws + OFF_HM);
  const bool lat = ti < 256;
  const int b = lat ? (ti >> 5) : ((ti - 256) >> 2);
  const int r = ti & 31;
  const int row = lat ? (ti * 64 + lane) : (M_LAT + (ti - 256) * 64 + lane);
  uint4 qk[8];
  float acc[64];
  {
    const uint4* qp = (const uint4*)(P + (size_t)row * INWP + C_NQ + h * 64);
#pragma unroll
    for (int c = 0; c < 8; ++c) qk[c] = qp[c];
  }
#pragma unroll
  for (int i = 0; i < 64; ++i) acc[i] = 0.f;
  float m = -INFINITY, ls = 0.f;
  const int qc = lane;
  const int rs0 = min(max(r - 4, 0), 24);
  const int cs0 = min(max(qc - 8, 0), 48);
  const float* rb = p.rel_bias + (size_t)l * 4 * 15 * 31 + h * 15 * 31;
  const int nloc = lat ? 128 : 0;
  for (int j = 0; j < nloc + 256; ++j) {
    int krow;
    float bias = 0.f;
    if (j < nloc) {
      int kr = rs0 + (j >> 4), kc = cs0 + (j & 15);
      krow = b * 2048 + kr * 64 + kc;
      bias = rb[(kr - r + 7) * 31 + (kc - qc + 15)];
    } else {
      krow = M_LAT + b * 256 + (j - nloc);
    }
    const uint4* kp = (const uint4*)(P + (size_t)krow * INWP + C_NK + h * 64);
    float s = 0.f;
#pragma unroll
    for (int c = 0; c < 8; ++c) {
      uint4 u = kp[c];
      uint4 q = qk[c];
      s += bflo(q.x) * bflo(u.x) + bfhi(q.x) * bfhi(u.x) + bflo(q.y) * bflo(u.y) + bfhi(q.y) * bfhi(u.y) +
           bflo(q.z) * bflo(u.z) + bfhi(q.z) * bfhi(u.z) + bflo(q.w) * bflo(u.w) + bfhi(q.w) * bfhi(u.w);
    }
    s = s * 0.125f + bias;
    float mn = fmaxf(m, s);
    float corr = __expf(m - mn), pe = __expf(s - mn);
    ls = ls * corr + pe;
    m = mn;
    const uint4* vp = (const uint4*)(P + (size_t)krow * INWP + C_NV + h * 64);
#pragma unroll
    for (int c = 0; c < 8; ++c) {
      uint4 u = vp[c];
      acc[c * 8 + 0] = acc[c * 8 + 0] * corr + pe * bflo(u.x);
      acc[c * 8 + 1] = acc[c * 8 + 1] * corr + pe * bfhi(u.x);
      acc[c * 8 + 2] = acc[c * 8 + 2] * corr + pe * bflo(u.y);
      acc[c * 8 + 3] = acc[c * 8 + 3] * corr + pe * bfhi(u.y);
      acc[c * 8 + 4] = acc[c * 8 + 4] * corr + pe * bflo(u.z);
      acc[c * 8 + 5] = acc[c * 8 + 5] * corr + pe * bfhi(u.z);
      acc[c * 8 + 6] = acc[c * 8 + 6] * corr + pe * bflo(u.w);
      acc[c * 8 + 7] = acc[c * 8 + 7] * corr + pe * bfhi(u.w);
    }
  }
  const float inv = 1.f / ls;
  uint4* op = (uint4*)(MIX + (size_t)row * 1024 + 256 + h * 64);
#pragma unroll
  for (int c = 0; c < 8; ++c) {
    uint4 u;
    u.x = pack2(acc[c * 8 + 0] * inv, acc[c * 8 + 1] * inv);
    u.y = pack2(acc[c * 8 + 2] * inv, acc[c * 8 + 3] * inv);
    u.z = pack2(acc[c * 8 + 4] * inv, acc[c * 8 + 5] * inv);
    u.w = pack2(acc[c * 8 + 6] * inv, acc[c * 8 + 7] * inv);
    op[c] = u;
  }
}

__device__ void na_flash(const Params& p, int l, int item, char* smem) {
  bf16_t* sK = (bf16_t*)smem;
  bf16_t* sV = sK + 64 * 72;
  float* sBias = (float*)(smem + 18432);
  const int tid = otid(), lane = tid & 63, w = tid >> 6;
  const int li = lane & 31, hh = lane >> 5;
  const bf16_t* P = (const bf16_t*)(p.ws + OFF_P);
  bf16_t* MIX = (bf16_t*)(p.ws + OFF_HM);
  int b, h, qrow, qr = 0, qc = 0, rs0 = 0, ntiles, krow0 = 0;
  bool lat;
  if (item < 512) {
    lat = true;
    b = item >> 6; h = item & 3;
    const int r0 = ((item >> 2) & 15) * 2;
    qr = r0 + (w >> 1); qc = (w & 1) * 32 + li;
    qrow = b * 2048 + qr * 64 + qc;
    krow0 = min(max(r0 - 4, 0), 24);
    const int klast = min(max(r0 + 1 - 4, 0), 24) + 7;
    ntiles = 4 + (klast - krow0 + 1);
    rs0 = min(max(qr - 4, 0), 24);
  } else {
    lat = false;
    const int i = item - 512;
    b = i >> 3; h = i & 3;
    qrow = M_LAT + b * 256 + ((i >> 2) & 1) * 128 + w * 32 + li;
    ntiles = 4;
  }
  const int cs0 = min(max(qc - 8, 0), 48);
  const bf16_t* Vg = (const bf16_t*)(p.ws + OFF_NVT) + (size_t)(b * 4 + h) * 64 * 2304;
  bf16x8 qf0, qf1, qf2, qf3;
  {
    const bf16_t* qp = P + (size_t)qrow * INWP + C_NQ + h * 64 + hh * 8;
    qf0 = *(const bf16x8*)(qp); qf1 = *(const bf16x8*)(qp + 16); qf2 = *(const bf16x8*)(qp + 32); qf3 = *(const bf16x8*)(qp + 48);
  }
  __syncthreads();
  for (int i = tid; i < 465; i += 256)
    sBias[i] = p.rel_bias[(size_t)l * 4 * 465 + h * 465 + i] * 1.4426950408889634f;
  const int kk0 = tid >> 3, kc8 = tid & 7, kk1 = kk0 + 32;
  uint4 rk0, rk1, rv0, rv1;
  {
    const size_t kr = (size_t)(M_LAT + b * 256);
    rk0 = *(const uint4*)(P + (kr + kk0) * INWP + C_NK + h * 64 + kc8 * 8);
    rk1 = *(const uint4*)(P + (kr + kk1) * INWP + C_NK + h * 64 + kc8 * 8);
    rv0 = *(const uint4*)(Vg + (size_t)kk0 * 2304 + kc8 * 8);
    rv1 = *(const uint4*)(Vg + (size_t)kk1 * 2304 + kc8 * 8);
  }
  f32x16 o0, o1;
#pragma unroll
  for (int r = 0; r < 16; ++r) { o0[r] = 0.f; o1[r] = 0.f; }
  float m = -1e30f, lp = 0.f;
  const float sc = 0.125f * 1.4426950408889634f;
  for (int t = 0; t < ntiles; ++t) {
    __syncthreads();
    *(uint4*)(sK + kk0 * 72 + kc8 * 8) = rk0;
    *(uint4*)(sK + kk1 * 72 + kc8 * 8) = rk1;
    *(uint2*)(sV + kk0 * 68 + kc8 * 8) = make_uint2(rv0.x, rv0.y);
    *(uint2*)(sV + kk0 * 68 + kc8 * 8 + 4) = make_uint2(rv0.z, rv0.w);
    *(uint2*)(sV + kk1 * 68 + kc8 * 8) = make_uint2(rv1.x, rv1.y);
    *(uint2*)(sV + kk1 * 68 + kc8 * 8 + 4) = make_uint2(rv1.z, rv1.w);
    __syncthreads();
    if (t + 1 < ntiles) {
      const int tn = t + 1;
      size_t kr;
      int vk;
      if (tn < 4) { kr = (size_t)(M_LAT + b * 256 + tn * 64); vk = tn * 64; }
      else { kr = (size_t)(b * 2048 + (krow0 + tn - 4) * 64); vk = 256 + (krow0 + tn - 4) * 64; }
      rk0 = *(const uint4*)(P + (kr + kk0) * INWP + C_NK + h * 64 + kc8 * 8);
      rk1 = *(const uint4*)(P + (kr + kk1) * INWP + C_NK + h * 64 + kc8 * 8);
      rv0 = *(const uint4*)(Vg + (size_t)kk0 * 2304 + vk + kc8 * 8);
      rv1 = *(const uint4*)(Vg + (size_t)kk1 * 2304 + vk + kc8 * 8);
    }
    const int kr_abs = krow0 + t - 4;
    const bool local = t >= 4;
    if (local && (kr_abs < rs0 || kr_abs >= rs0 + 8)) continue;
    f32x16 s0, s1;
#pragma unroll
    for (int r = 0; r < 16; ++r) { s0[r] = 0.f; s1[r] = 0.f; }
    {
      const bf16_t* ka = sK + li * 72 + hh * 8;
      const bf16_t* kb = ka + 32 * 72;
      s0 = __builtin_amdgcn_mfma_f32_32x32x16_bf16(*(const bf16x8*)(ka), qf0, s0, 0, 0, 0);
      s1 = __builtin_amdgcn_mfma_f32_32x32x16_bf16(*(const bf16x8*)(kb), qf0, s1, 0, 0, 0);
      s0 = __builtin_amdgcn_mfma_f32_32x32x16_bf16(*(const bf16x8*)(ka + 16), qf1, s0, 0, 0, 0);
      s1 = __builtin_amdgcn_mfma_f32_32x32x16_bf16(*(const bf16x8*)(kb + 16), qf1, s1, 0, 0, 0);
      s0 = __builtin_amdgcn_mfma_f32_32x32x16_bf16(*(const bf16x8*)(ka + 32), qf2, s0, 0, 0, 0);
      s1 = __builtin_amdgcn_mfma_f32_32x32x16_bf16(*(const bf16x8*)(kb + 32), qf2, s1, 0, 0, 0);
      s0 = __builtin_amdgcn_mfma_f32_32x32x16_bf16(*(const bf16x8*)(ka + 48), qf3, s0, 0, 0, 0);
      s1 = __builtin_amdgcn_mfma_f32_32x32x16_bf16(*(const bf16x8*)(kb + 48), qf3, s1, 0, 0, 0);
    }
    if (local) {
      const float* bp = sBias + (kr_abs - qr + 7) * 31 - qc + 15;
#pragma unroll
      for (int r = 0; r < 16; ++r) {
        const int kc0 = rowmap(r, hh), kc1 = 32 + kc0;
        const bool v0 = (kc0 >= cs0) && (kc0 < cs0 + 16);
        const bool v1 = (kc1 >= cs0) && (kc1 < cs0 + 16);
        const float b0 = v0 ? bp[kc0] : 0.f;
        const float b1 = v1 ? bp[kc1] : 0.f;
        s0[r] = v0 ? (s0[r] * sc + b0) : -1e30f;
        s1[r] = v1 ? (s1[r] * sc + b1) : -1e30f;
      }
    } else {
#pragma unroll
      for (int r = 0; r < 16; ++r) { s0[r] *= sc; s1[r] *= sc; }
    }
    float mx = s0[0];
#pragma unroll
    for (int r = 1; r < 16; ++r) mx = fmaxf(mx, s0[r]);
#pragma unroll
    for (int r = 0; r < 16; ++r) mx = fmaxf(mx, s1[r]);
    mx = fmaxf(mx, __shfl_xor(mx, 32));
    const float mn = fmaxf(m, mx);
    const float corr = __builtin_amdgcn_exp2f(m - mn);
    m = mn;
    lp *= corr;
#pragma unroll
    for (int r = 0; r < 16; ++r) { o0[r] *= corr; o1[r] *= corr; }
#pragma unroll
    for (int r = 0; r < 16; ++r) {
      s0[r] = __builtin_amdgcn_exp2f(s0[r] - mn);
      s1[r] = __builtin_amdgcn_exp2f(s1[r] - mn);
      lp += s0[r] + s1[r];
    }
#pragma unroll
    for (int u = 0; u < 2; ++u) {
#pragma unroll
      for (int s = 0; s < 2; ++s) {
        bf16x8 pb = u == 0 ? pack8(s0, s) : pack8(s1, s);
        const bf16_t* va = sV + li * 68 + 32 * u + 16 * s + 4 * hh;
        o0 = __builtin_amdgcn_mfma_f32_32x32x16_bf16(ld_perm(va), pb, o0, 0, 0, 0);
        o1 = __builtin_amdgcn_mfma_f32_32x32x16_bf16(ld_perm(va + 32 * 68), pb, o1, 0, 0, 0);
      }
    }
  }
  lp += __shfl_xor(lp, 32);
  const float inv = 1.f / lp;
  bf16_t* op = MIX + (size_t)qrow * 1024 + 256 + h * 64 + 4 * hh;
#pragma unroll
  for (int g = 0; g < 4; ++g) {
    uint2 u0, u1;
    u0.x = pack2(o0[4 * g + 0] * inv, o0[4 * g + 1] * inv);
    u0.y = pack2(o0[4 * g + 2] * inv, o0[4 * g + 3] * inv);
    u1.x = pack2(o1[4 * g + 0] * inv, o1[4 * g + 1] * inv);
    u1.y = pack2(o1[4 * g + 2] * inv, o1[4 * g + 3] * inv);
    *(uint2*)(op + 8 * g) = u0;
    *(uint2*)(op + 32 + 8 * g) = u1;
  }
}

DEVI int dn_rowof(int s, int b, int d) {
  if (s < 256) {
    int c = d ? (255 - s) : s;
    return M_LAT + b * 256 + c;
  }
  int t = s - 256;
  t = d ? (2047 - t) : t;
  return b * 2048 + t;
}

__device__ void dn_naive(const Params& p, int l, int it, char* smem) {
  float* ks = (float*)smem;
  float* qs = ks + 32 * 128;
  float* vs = qs + 32 * 128;
  float* gs = vs + 32 * 64;
  float* bs = gs + 32;
  const int half = it & 1, d = (it >> 1) & 1, h = (it >> 2) & 3, b = it >> 4;
  const int tid = otid(), w = tid >> 6, lane = tid & 63, c = lane & 15, kg = lane >> 4;
  const int col = half * 64 + w * 16 + c;
  const bf16_t* DQ = (const bf16_t*)(p.ws + OFF_DNQKV);
  const float* AB = (const float*)(p.ws + OFF_AB);
  bf16_t* MIX = (bf16_t*)(p.ws + OFF_HM);
  bf16_t* OB = (bf16_t*)(p.ws + OFF_OB);
  float S[32];
#pragma unroll
  for (int i = 0; i < 32; ++i) S[i] = 0.f;
  const float Aneg = -__expf(p.a_log[l * 8 + d * 4 + h]);
  const float dtb = p.dt_bias[l * 8 + d * 4 + h];
  for (int s0 = 0; s0 < 2304; s0 += 32) {
    __syncthreads();
    for (int i = tid; i < 32 * 128; i += 256) {
      int tk = i >> 7, ch = i & 127;
      int row = dn_rowof(s0 + tk, b, d);
      qs[i] = bf2f(DQ[(size_t)row * 1536 + h * 128 + ch]);
      ks[i] = bf2f(DQ[(size_t)row * 1536 + 512 + h * 128 + ch]);
    }
    for (int i = tid; i < 32 * 64; i += 256) {
      int tk = i >> 6, ch = i & 63;
      int row = dn_rowof(s0 + tk, b, d);
      vs[i] = bf2f(DQ[(size_t)row * 1536 + 1024 + h * 128 + half * 64 + ch]);
    }
    if (tid < 32) {
      int row = dn_rowof(s0 + tid, b, d);
      float a = AB[(size_t)row * 16 + d * 4 + h];
      float bb = AB[(size_t)row * 16 + 8 + d * 4 + h];
      float xx = a + dtb;
      const float ee = __expf(xx);
    float sp = ee < 0.25f ? ee * (1.f - ee * (0.5f - ee * (0.33333333f - ee * (0.25f - 0.2f * ee))))
                          : (xx > 20.f ? xx : __logf(1.f + ee));
      gs[tid] = __expf(Aneg * sp);
      bs[tid] = 1.f / (1.f + __expf(-bb));
    }
    __syncthreads();
    for (int tk = 0; tk < 32; ++tk) {
      const float eg = gs[tk], beta = bs[tk];
      const float vv = vs[tk * 64 + w * 16 + c];
      const float4* k4 = (const float4*)(ks + tk * 128 + kg * 32);
      const float4* q4 = (const float4*)(qs + tk * 128 + kg * 32);
      float part = 0.f;
#pragma unroll
      for (int i = 0; i < 8; ++i) {
        float4 kk = k4[i];
        S[4 * i + 0] *= eg; S[4 * i + 1] *= eg; S[4 * i + 2] *= eg; S[4 * i + 3] *= eg;
        part += kk.x * S[4 * i + 0] + kk.y * S[4 * i + 1] + kk.z * S[4 * i + 2] + kk.w * S[4 * i + 3];
      }
      part += __shfl_xor(part, 16);
      part += __shfl_xor(part, 32);
      const float delta = beta * (vv - part);
      float po = 0.f;
#pragma unroll
      for (int i = 0; i < 8; ++i) {
        float4 kk = k4[i];
        float4 qq = q4[i];
        S[4 * i + 0] += kk.x * delta; S[4 * i + 1] += kk.y * delta; S[4 * i + 2] += kk.z * delta; S[4 * i + 3] += kk.w * delta;
        po += qq.x * S[4 * i + 0] + qq.y * S[4 * i + 1] + qq.z * S[4 * i + 2] + qq.w * S[4 * i + 3];
      }
      po += __shfl_xor(po, 16);
      po += __shfl_xor(po, 32);
      if (kg == 0) {
        int row = dn_rowof(s0 + tk, b, d);
        float o = po * 0.08838834764831845f;
        if (d == 0)
          MIX[(size_t)row * 1024 + 512 + h * 128 + col] = f2bf(o);
        else
          OB[(size_t)row * 512 + h * 128 + col] = f2bf(o);
      }
    }
  }
}

__device__ void phaseD(const Params& p, int l, char* smem) {
  const int nb = gridDim.x, bid = blockIdx.x;
  if (bid < 64) {
    dn_scan(p, l, bid, smem);
    return;
  }
  if (bid >= 256 && bid < 320) return;
  const int nb2 = nb - 128;
  const int wid = bid < 256 ? bid - 64 : bid - 128;
  const int n_early = l < 3 ? N_CONV_EARLY : 0;
  for (int it = wid; it < 1152 + N_CONV_LATE + n_early; it += nb2) {
    if (it < 576) {
      int item = it;
      if (it < 512) item = ((it & 7) * 64) + (it >> 3);
      else if (l == 3) continue;
      mla_flash(p, item, smem);
    } else if (it < 1152) {
      if (l == 3 && it - 576 >= 512) continue;
      na_flash(p, l, it - 576, smem);
    } else if (it < 1152 + N_CONV_LATE) {
      conv_item_late(p, l, it - 1152, (float*)smem);
    } else {
      conv_item_early(p, l + 1, it - 1152 - N_CONV_LATE, (float*)smem);
    }
  }
}

__device__ void outgate_item(const Params& p, int l, int item) {
  const int w = otid() >> 6, lane = otid() & 63;
  const int row = item * 4 + w;
  const bf16_t* P = (const bf16_t*)(p.ws + OFF_P);
  bf16_t* MIX = (bf16_t*)(p.ws + OFF_HM);
  const int h = lane >> 4, cb = (lane & 15) * 8;
  uint4 uo = *(const uint4*)(MIX + (size_t)row * 1024 + 512 + h * 128 + cb);
  uint4 ub = *(const uint4*)(P + (size_t)row * INWP + C_DN + h * 128 + cb);
  uint4 uz = *(const uint4*)(P + (size_t)row * INWP + C_DZ + h * 128 + cb);
  float o[8], z[8];
  o[0] = bflo(uo.x) + bflo(ub.x); o[1] = bfhi(uo.x) + bfhi(ub.x); o[2] = bflo(uo.y) + bflo(ub.y); o[3] = bfhi(uo.y) + bfhi(ub.y);
  o[4] = bflo(uo.z) + bflo(ub.z); o[5] = bfhi(uo.z) + bfhi(ub.z); o[6] = bflo(uo.w) + bflo(ub.w); o[7] = bfhi(uo.w) + bfhi(ub.w);
  z[0] = bflo(uz.x); z[1] = bfhi(uz.x); z[2] = bflo(uz.y); z[3] = bfhi(uz.y);
  z[4] = bflo(uz.z); z[5] = bfhi(uz.z); z[6] = bflo(uz.w); z[7] = bfhi(uz.w);
  float ss = 0.f;
#pragma unroll
  for (int e = 0; e < 8; ++e) ss += o[e] * o[e];
  ss += __shfl_xor(ss, 1);
  ss += __shfl_xor(ss, 2);
  ss += __shfl_xor(ss, 4);
  ss += __shfl_xor(ss, 8);
  const float r = rsqrtf(ss * (1.f / 128.f) + 1e-6f);
  const float* go = p.g_out + l * 128 + cb;
  float y[8];
#pragma unroll
  for (int e = 0; e < 8; ++e) y[e] = o[e] * r * go[e] * silu_f(z[e]);
  uint4 u;
  u.x = pack2(y[0], y[1]); u.y = pack2(y[2], y[3]); u.z = pack2(y[4], y[5]); u.w = pack2(y[6], y[7]);
  *(uint4*)(MIX + (size_t)row * 1024 + 512 + h * 128 + cb) = u;
}

__device__ void final_item(const Params& p, int item) {
  const int w = otid() >> 6, lane = otid() & 63;
  const int row = item * 4 + w;
  const float4* xr = (const float4*)((const float*)(p.ws + OFF_X) + (size_t)row * 1024);
  float4 v[4];
  float ss = 0.f;
#pragma unroll
  for (int i = 0; i < 4; ++i) {
    v[i] = xr[lane + 64 * i];
    ss += v[i].x * v[i].x + v[i].y * v[i].y + v[i].z * v[i].z + v[i].w * v[i].w;
  }
  ss = wave_sum(ss);
  const float r = rsqrtf(ss * (1.f / 1024.f) + 1e-6f);
  const float4* g4 = (const float4*)p.g_final;
  float4* o4 = (float4*)(p.out + (size_t)row * 1024);
#pragma unroll
  for (int i = 0; i < 4; ++i) {
    float4 gg = g4[lane + 64 * i];
    float4 y;
    y.x = v[i].x * r * gg.x; y.y = v[i].y * r * gg.y; y.z = v[i].z * r * gg.z; y.w = v[i].w * r * gg.w;
    o4[lane + 64 * i] = y;
  }
}

constexpr int N_PHASES = 1 + 9 * 4 + 1;

__global__ void __launch_bounds__(256, 2) mega(Params p) {
  __shared__ __attribute__((aligned(16))) char smem[SMEM_BYTES];
  cg::grid_group grid = cg::this_grid();
  const int nb = gridDim.x, bid = blockIdx.x;
  __shared__ uint4 xb_words;
  if (threadIdx.x == 0) xb_words = make_uint4(0u, 0u, 0u, 0u);
  __syncthreads();
  XcdBarrier xb = xcd_barrier_post((unsigned*)(p.ws + OFF_BAR), (volatile LAS unsigned*)&xb_words);
#ifdef PROBE_S
  bool again = false;
#endif
  for (int ph = p.ph_lo; ph < p.ph_hi; ++ph) {
    if (ph == 0) {
      phase0(p, smem);
    } else if (ph == N_PHASES - 1) {
      for (int it = bid; it < M_LAT / 4; it += nb) final_item(p, it);
    } else {
      const int l = (ph - 1) / 9, s = (ph - 1) % 9;
      if (s == 0) {
        phaseA(p, l, smem);
      } else if (s == 1) {
        for (int it = bid; it < 144 * 13; it += nb) {
          int mt, nt;
          tile_map(it, 13, mt, nt);
          gemm_wide<EPI_P>(p, l, (const bf16_t*)(p.ws + OFF_HM), 1024, (const bf16_t*)(p.ws + OFF_WIN), 1024,
                           mt * 128, nt * 256, 0, smem);
        }
      } else if (s == 2) {
        phaseC(p, l, smem);
      } else if (s == 3) {
        phaseD(p, l, smem);
      } else if (s == 4) {
        for (int it = bid; it < (l == 3 ? M_LAT : M_ALL) / 4; it += nb) outgate_item(p, l, it);
      } else if (s == 5) {
        const int mpx = l == 3 ? 16 : 18;
        for (int it = bid; it < 8 * mpx * 8; it += nb) {
          int mt, nt;
          tile_map(it, 8, mt, nt, mpx);
          gemm_tile<EPI_RES>(p, l, (const bf16_t*)(p.ws + OFF_HM), 1024, (const bf16_t*)(p.ws + OFF_WOUT), 1024,
                             mt * 128, nt * 128, 2, smem);
        }
      } else if (s == 6) {
        for (int it = bid; it < (l == 3 ? M_LAT : M_ALL) / 4; it += nb)
          norm_rows(p, false, (bf16_t*)(p.ws + OFF_HM), p.g_ffn + l * 1024,
                    (const float*)(p.ws + OFF_MOD) + (size_t)l * 9 * 6144, 3, 4, it);
      } else if (s == 7) {
        const int mpx = l == 3 ? 16 : 18;
        for (int it = bid; it < 8 * mpx * 22; it += nb) {
          int mt, nt;
          tile_map(it, 22, mt, nt, mpx);
          gemm_wide<EPI_GU>(p, l, (const bf16_t*)(p.ws + OFF_HM), 1024, (const bf16_t*)(p.ws + OFF_WGU), 1024,
                            mt * 128, nt * 256, 0, smem);
        }
      } else {
        const int mpx = l == 3 ? 16 : 18;
        for (int it = bid; it < 8 * mpx * 8; it += nb) {
          int mt, nt;
          tile_map(it, 8, mt, nt, mpx);
          gemm_tile<EPI_RES>(p, l, (const bf16_t*)(p.ws + OFF_P), FFN, (const bf16_t*)(p.ws + OFF_WDN), FFN,
                             mt * 128, nt * 128, 5, smem);
        }
      }
    }
#ifdef PROBE_S
    {
      const bool hit = (PROBE_S == 9) ? (ph == 0) : (ph != 0 && ph != N_PHASES - 1 && ((ph - 1) % 9) == PROBE_S);
      if (hit && !again) {
        again = true;
        if (p.use_cg) grid.sync(); else xcd_barrier(xb);
        --ph;
        continue;
      }
      again = false;
    }
#endif
    if (ph + 1 < p.ph_hi) {
      if (p.use_cg) grid.sync();
      else xcd_barrier(xb);
    }
  }
}

extern "C" void kernel_launch(void* const* d_in, const int* in_sizes, int n_in, void* d_out, int out_size, void* d_ws,
                              size_t ws_size, hipStream_t stream) {
  static int grid_blocks = 0;
  if (!grid_blocks) {
    int dev = 0, cus = 0, per_cu = 0;
    hipGetDevice(&dev);
    hipDeviceGetAttribute(&cus, hipDeviceAttributeMultiprocessorCount, dev);
    hipOccupancyMaxActiveBlocksPerMultiprocessor(&per_cu, mega, 256, 0);
    if (per_cu < 1) per_cu = 1;
    if (per_cu > 2) per_cu = 2;
    grid_blocks = cus * per_cu;
  }
  Params p{};
  const float** pp = (const float**)&p;
  for (int i = 0; i < 23; ++i) pp[i] = (const float*)d_in[i];
  p.out = (float*)d_out;
  p.ws = (char*)d_ws;
  p.ph_lo = 0;
  p.ph_hi = N_PHASES;
  p.use_cg = 0;
  p.pad0 = 0;
  hipMemsetAsync((char*)d_ws + OFF_BAR, 0, XCD_BAR_WORDS * sizeof(unsigned), stream);
  void* args[] = {&p};
  hipError_t e = hipLaunchCooperativeKernel((void*)mega, dim3(grid_blocks), dim3(256), args, 0, stream);
  if (e != hipSuccess) {
    fprintf(stderr, "cooperative launch failed: %s (grid %d)\n", hipGetErrorString(e), grid_blocks);
    (void)hipGetLastError();
    for (int ph = 0; ph < N_PHASES; ++ph) {
      p.ph_lo = ph;
      p.ph_hi = ph + 1;
      hipLaunchKernelGGL(mega, dim3(grid_blocks), dim3(256), 0, stream, p);
    }
  }
}
```

```cpp
#include <hip/hip_runtime.h>
#include <hip/hip_bf16.h>
#include <hip/hip_cooperative_groups.h>
#include <cstdio>
namespace cg = cooperative_groups;

#define DEVI __device__ __forceinline__
typedef unsigned short bf16_t;
typedef short bf16x8 __attribute__((ext_vector_type(8)));
typedef float f32x16 __attribute__((ext_vector_type(16)));

constexpr int M_LAT = 16384, M_CTX = 2048, M_ALL = 18432;
constexpr int DM = 1024, INW = 3248, INWP = 3328, FFN = 2816;
constexpr int C_MQ = 0, C_MKV = 256, C_MPE = 384, C_NQ = 416, C_NK = 672, C_NV = 928, C_DN = 1184;
constexpr int C_DZ = C_DN + 1536, C_DA = C_DN + 2048;

constexpr size_t OFF_WIN = 0;
constexpr size_t OFF_WOUT = OFF_WIN + (size_t)INWP * 1024 * 2;
constexpr size_t OFF_WGU = OFF_WOUT + (size_t)1024 * 1024 * 2;
constexpr size_t OFF_WDN = OFF_WGU + (size_t)2 * FFN * 1024 * 2;
constexpr size_t OFF_WQUP = OFF_WDN + (size_t)1024 * FFN * 2;
constexpr size_t OFF_WKVUP = OFF_WQUP + (size_t)384 * 256 * 2;
constexpr size_t OFF_MOD = OFF_WKVUP + (size_t)512 * 128 * 2;
constexpr size_t OFF_ROPE = OFF_MOD + (size_t)4 * 9 * 6144 * 4;
constexpr size_t OFF_X = OFF_ROPE + (size_t)2048 * 16 * 2 * 4;
constexpr size_t OFF_HM = OFF_X + (size_t)M_ALL * 1024 * 4;
constexpr size_t OFF_P = OFF_HM + (size_t)M_ALL * 1024 * 2;
constexpr size_t OFF_QH = OFF_P + (size_t)M_ALL * INWP * 2;
constexpr size_t OFF_KH = OFF_QH + (size_t)M_ALL * 384 * 2;
constexpr size_t OFF_VH = OFF_KH + (size_t)M_ALL * 384 * 2;
constexpr size_t OFF_DNQKV = OFF_VH + (size_t)M_ALL * 256 * 2;
constexpr size_t OFF_OB = OFF_DNQKV + (size_t)M_ALL * 1536 * 2;
constexpr size_t OFF_AB = OFF_OB + (size_t)M_ALL * 512 * 2;
constexpr size_t OFF_GC = OFF_AB + (size_t)M_ALL * 16 * 4;
constexpr size_t OFF_BETA = OFF_GC + (size_t)M_ALL * 8 * 4;
constexpr size_t OFF_NVT = OFF_BETA + (size_t)M_ALL * 8 * 4;
constexpr size_t WS_TOTAL = OFF_NVT + (size_t)M_ALL * 256 * 2;
constexpr int SMEM_BYTES = 74240;
constexpr size_t OFF_BAR = (WS_TOTAL + 255) & ~(size_t)255;

struct Params {
  const float *x, *c, *ctx, *c_ctx, *w_ada, *b_ada, *g_mix, *w_in, *g_q, *g_kv, *w_qup, *w_kvup, *rel_bias,
      *conv_w, *a_log, *dt_bias, *g_out, *w_out, *g_ffn, *w_gate, *w_up, *w_down, *g_final;
  float* out;
  char* ws;
  int ph_lo, ph_hi;
  int use_cg, pad0;
};

DEVI bf16_t f2bf(float f) {
  __bf16 r = (__bf16)f;
  return __builtin_bit_cast(unsigned short, r);
}
DEVI int otid() {
  int t = threadIdx.x;
  asm volatile("" : "+v"(t));
  return t;
}
DEVI float bf2f(bf16_t h) { return __uint_as_float(((unsigned)h) << 16); }
DEVI float bflo(unsigned u) { return __uint_as_float(u << 16); }
DEVI float bfhi(unsigned u) { return __uint_as_float(u & 0xffff0000u); }
typedef __bf16 bf16v2_t __attribute__((ext_vector_type(2)));
typedef float f32v2_t __attribute__((ext_vector_type(2)));
DEVI unsigned pack2(float a, float b) {
  f32v2_t v = {a, b};
  bf16v2_t r = __builtin_convertvector(v, bf16v2_t);
  return __builtin_bit_cast(unsigned, r);
}
DEVI float silu_f(float x) { return x / (1.f + __expf(-x)); }
DEVI float wave_sum(float v) {
#pragma unroll
  for (int o = 32; o >= 1; o >>= 1) v += __shfl_xor(v, o);
  return v;
}

#define XB_TMO 128
#define XB_XCNT(j) (256 + 64 * (j))
#define XB_XSUB(j) (1280 + 64 * (j))
#define XB_XGEN(j) (2304 + 64 * (j))
#define XB_TOP 3328
#define XB_TOPGEN 3392
#define XCD_BAR_WORDS 3456
#define XB_SPIN_CAP (1u << 22)
#define LAS __attribute__((address_space(3)))
DEVI unsigned xb_ld(unsigned* p) { return __hip_atomic_load(p, __ATOMIC_RELAXED, __HIP_MEMORY_SCOPE_AGENT); }
DEVI unsigned xb_add(unsigned* p, unsigned v) { return __hip_atomic_fetch_add(p, v, __ATOMIC_RELAXED, __HIP_MEMORY_SCOPE_AGENT); }
DEVI unsigned xb_xcc_id() { return (unsigned)__builtin_amdgcn_s_getreg((3 << 11) | 20) & 0xFu; }
#define XB_SPIN(cond, bar)                                                     \
  do {                                                                         \
    unsigned _sp = 0;                                                          \
    while (cond) {                                                             \
      __builtin_amdgcn_s_sleep(1);                                             \
      if ((++_sp & 255u) == 0u) {                                              \
        if (xb_ld(&(bar)[XB_TMO])) break;                                      \
        if (_sp > XB_SPIN_CAP) { atomicAdd(&(bar)[XB_TMO], 1u); break; }       \
      }                                                                        \
    }                                                                          \
  } while (0)
struct XcdBarrier {
  unsigned* bar;
  unsigned x;
  volatile LAS unsigned* st;
};
DEVI XcdBarrier xcd_barrier_post(unsigned* bar, volatile LAS unsigned* st) {
  XcdBarrier b;
  b.bar = bar;
  b.x = xb_xcc_id();
  b.st = st;
  if (threadIdx.x == 0) (void)xb_add(&bar[XB_XCNT(b.x)], 1u);
  return b;
}
DEVI void xcd_barrier_complete(unsigned* bar, unsigned x, unsigned& nloc, unsigned& nx) {
  const unsigned G = gridDim.x * gridDim.y * gridDim.z;
  unsigned sum, cnt, mine, sp = 0u;
  for (;;) {
    sum = 0u; cnt = 0u; mine = 0u;
#pragma unroll
    for (unsigned j = 0; j < 16; ++j) {
      const unsigned c = xb_ld(&bar[XB_XCNT(j)]);
      sum += c;
      cnt += (c > 0u) ? 1u : 0u;
      mine = (j == x) ? c : mine;
    }
    if (sum == G) break;
    __builtin_amdgcn_s_sleep(1);
    if ((++sp & 255u) == 0u) {
      if (xb_ld(&bar[XB_TMO])) break;
      if (sp > XB_SPIN_CAP) { atomicAdd(&bar[XB_TMO], 1u); break; }
    }
  }
  nloc = mine > 0u ? mine : 1u;
  nx = cnt > 0u ? cnt : 1u;
}
DEVI void xcd_barrier(const XcdBarrier& b) {
  asm volatile("s_waitcnt vmcnt(0)" ::: "memory");
  __syncthreads();
  if (threadIdx.x == 0) {
    unsigned* bar = b.bar;
    __builtin_amdgcn_s_waitcnt(0);
    unsigned nloc = b.st[0], nx = b.st[1];
    if (nloc == 0u) {
      xcd_barrier_complete(bar, b.x, nloc, nx);
      b.st[0] = nloc;
      b.st[1] = nx;
    }
    const unsigned old = xb_add(&bar[XB_XSUB(b.x)], 1u);
    const unsigned gen = old / nloc;
    if (old + 1u == (gen + 1u) * nloc) {
      __builtin_amdgcn_fence(__ATOMIC_RELEASE, "agent");
      asm volatile("s_waitcnt vmcnt(0)" ::: "memory");
      const unsigned og = xb_add(&bar[XB_TOP], 1u);
      const unsigned tg = og / nx;
      if (og + 1u == (tg + 1u) * nx) xb_add(&bar[XB_TOPGEN], 1u);
      else XB_SPIN(xb_ld(&bar[XB_TOPGEN]) == tg, bar);
      __builtin_amdgcn_fence(__ATOMIC_ACQUIRE, "agent");
      xb_add(&bar[XB_XGEN(b.x)], 1u);
      asm volatile("s_waitcnt vmcnt(0)" ::: "memory");
    } else {
      XB_SPIN(xb_ld(&bar[XB_XGEN(b.x)]) == gen, bar);
      __builtin_amdgcn_fence(__ATOMIC_ACQUIRE, "agent");
      asm volatile("s_waitcnt vmcnt(0)" ::: "memory");
    }
  }
  __syncthreads();
}

constexpr int N_CONV_EARLY = 16 * 52 + 24 + 16;
__device__ void conv_item_early(const Params& p, int l, int it, float* tl);

__device__ void phase0(const Params& p, char* smem) {
  const int tid = otid(), nb = gridDim.x, bid = blockIdx.x;
  {
    float* rc = (float*)(p.ws + OFF_ROPE);
    float* rs = rc + 2048 * 16;
    for (int i = bid * 256 + tid; i < 2048 * 16; i += nb * 256) {
      int t = i >> 4, a = (i >> 3) & 1, j = i & 7;
      float pos = a ? (float)(t & 63) : (float)(t >> 6);
      float inv = __builtin_amdgcn_exp2f(-(float)j * (13.287712379549449f / 8.f));
      float ang = pos * inv;
      rc[i] = cosf(ang);
      rs[i] = sinf(ang);
    }
  }
  for (int it = bid; it < N_CONV_EARLY; it += nb) conv_item_early(p, 0, it, (float*)smem);
  __syncthreads();
  float* sc = (float*)smem;
  float* red = sc + 1024 * 12;
  float* MOD = (float*)(p.ws + OFF_MOD);
  bool loaded = false;
  for (int it = bid; it < 4 * 96; it += nb) {
    if (!loaded) {
      for (int i = tid; i < 9 * 1024; i += 256) {
        float v = i < 8192 ? p.c[i] : p.c_ctx[i - 8192];
        sc[(i & 1023) * 12 + (i >> 10)] = silu_f(v);
      }
      __syncthreads();
      loaded = true;
    }
    const int l = it / 96, n0 = (it % 96) * 64;
    const int cc = tid & 63, kg = tid >> 6;
    const float* w = p.w_ada + (size_t)l * 1024 * 6144 + n0 + cc;
    float acc[9];
#pragma unroll
    for (int b = 0; b < 9; ++b) acc[b] = 0.f;
    for (int k0 = kg * 256; k0 < kg * 256 + 256; k0 += 16) {
      float wvv[16];
#pragma unroll
      for (int j = 0; j < 16; ++j) wvv[j] = w[(size_t)(k0 + j) * 6144];
#pragma unroll
      for (int j = 0; j < 16; ++j) {
      const int k = k0 + j;
      const float wv = wvv[j];
      const float4 s0 = *(const float4*)(sc + k * 12);
      const float4 s1 = *(const float4*)(sc + k * 12 + 4);
      const float s2 = sc[k * 12 + 8];
      acc[0] += s0.x * wv; acc[1] += s0.y * wv; acc[2] += s0.z * wv; acc[3] += s0.w * wv;
      acc[4] += s1.x * wv; acc[5] += s1.y * wv; acc[6] += s1.z * wv; acc[7] += s1.w * wv;
      acc[8] += s2 * wv;
      }
    }
#pragma unroll
    for (int b = 0; b < 9; ++b) red[(kg * 9 + b) * 64 + cc] = acc[b];
    __syncthreads();
    for (int i = tid; i < 9 * 64; i += 256) {
      int b = i >> 6, c2 = i & 63;
      float s = red[(0 * 9 + b) * 64 + c2] + red[(1 * 9 + b) * 64 + c2] + red[(2 * 9 + b) * 64 + c2] +
                red[(3 * 9 + b) * 64 + c2];
      MOD[(size_t)(l * 9 + b) * 6144 + n0 + c2] = s + p.b_ada[l * 6144 + n0 + c2];
    }
    __syncthreads();
  }
}

__device__ void convT_tile(const float* __restrict__ src, int K, int N, bf16_t* __restrict__ dst, int mode,
                           const float* __restrict__ gs, int kt, int nt, float* tl) {
  const int tid = otid();
  const int k0 = kt * 64, n0 = nt * 64;
  __syncthreads();
#pragma unroll 4
  for (int i = 0; i < 16; ++i) {
    int kk = i * 4 + (tid >> 6), nn = tid & 63;
    float v = 0.f;
    if (n0 + nn < N) v = src[(size_t)(k0 + kk) * N + n0 + nn];
    if (gs) v *= gs[k0 + kk];
    tl[kk * 65 + nn] = v;
  }
  __syncthreads();
#pragma unroll 2
  for (int i = 0; i < 8; ++i) {
    int nn = i * 8 + (tid >> 5), kk = (tid & 31) * 2;
    unsigned pk = pack2(tl[kk * 65 + nn], tl[(kk + 1) * 65 + nn]);
    int n = n0 + nn;
    int drow = mode == 0 ? n : ((n >> 5) * 64 + (n & 31) + (mode == 2 ? 32 : 0));
    *(unsigned*)(dst + (size_t)drow * K + k0 + kk) = pk;
  }
}

__device__ void norm_rows(const Params& p, bool from_input, bf16_t* __restrict__ H, const float* __restrict__ g,
                          const float* __restrict__ modl, int shift_i, int scale_i, int item) {
  const int w = otid() >> 6, lane = otid() & 63;
  const int row = item * 4 + w;
  const float* xsrc = from_input ? (row < M_LAT ? p.x + (size_t)row * 1024 : p.ctx + (size_t)(row - M_LAT) * 1024)
                                 : (const float*)(p.ws + OFF_X) + (size_t)row * 1024;
  const float4* xr = (const float4*)xsrc;
  float4 v[4];
  float ss = 0.f;
#pragma unroll
  for (int i = 0; i < 4; ++i) {
    v[i] = xr[lane + 64 * i];
    ss += v[i].x * v[i].x + v[i].y * v[i].y + v[i].z * v[i].z + v[i].w * v[i].w;
  }
  ss = wave_sum(ss);
  const float r = rsqrtf(ss * (1.f / 1024.f) + 1e-6f);
  const int b = row < M_LAT ? (row >> 11) : 8;
  const float4* sh = (const float4*)(modl + b * 6144 + shift_i * 1024);
  const float4* sl = (const float4*)(modl + b * 6144 + scale_i * 1024);
  const float4* g4 = (const float4*)g;
#pragma unroll
  for (int i = 0; i < 4; ++i) {
    int c4 = lane + 64 * i;
    float4 gg = g4[c4], s4 = sh[c4], l4 = sl[c4];
    float y0 = v[i].x * r * gg.x * (1.f + l4.x) + s4.x;
    float y1 = v[i].y * r * gg.y * (1.f + l4.y) + s4.y;
    float y2 = v[i].z * r * gg.z * (1.f + l4.z) + s4.z;
    float y3 = v[i].w * r * gg.w * (1.f + l4.w) + s4.w;
    uint2 pk;
    pk.x = pack2(y0, y1);
    pk.y = pack2(y2, y3);
    *(uint2*)(H + (size_t)row * 1024 + c4 * 4) = pk;
  }
}

__device__ void conv_item_late(const Params& p, int l, int i, float* tl) {
  bf16_t* Wout = (bf16_t*)(p.ws + OFF_WOUT);
  bf16_t* Wgu = (bf16_t*)(p.ws + OFF_WGU);
  bf16_t* Wdn = (bf16_t*)(p.ws + OFF_WDN);
  const float* src;
  bf16_t* dst;
  int K, N, mode = 0, ntn;
  if (i < 256) {
    src = p.w_out + (size_t)l * 1024 * 1024; K = 1024; N = 1024; dst = Wout; ntn = 16;
  } else if (i < 960) {
    i -= 256; src = p.w_gate + (size_t)l * 1024 * FFN; K = 1024; N = FFN; dst = Wgu; ntn = 44; mode = 1;
  } else if (i < 1664) {
    i -= 960; src = p.w_up + (size_t)l * 1024 * FFN; K = 1024; N = FFN; dst = Wgu; ntn = 44; mode = 2;
  } else {
    i -= 1664; src = p.w_down + (size_t)l * FFN * 1024; K = FFN; N = 1024; dst = Wdn; ntn = 16;
  }
  convT_tile(src, K, N, dst, mode, nullptr, i / ntn, i % ntn, tl);
}
constexpr int N_CONV_LATE = 256 + 3 * 704;
__device__ void conv_item_early(const Params& p, int l, int it, float* tl) {
  const float* src;
  const float* gs = nullptr;
  bf16_t* dst;
  int K, N, ntn, i;
  if (it < 832) {
    i = it; src = p.w_in + (size_t)l * 1024 * INW; K = 1024; N = INW; dst = (bf16_t*)(p.ws + OFF_WIN); ntn = 52;
  } else if (it < 856) {
    i = it - 832; src = p.w_qup + (size_t)l * 256 * 384; K = 256; N = 384; dst = (bf16_t*)(p.ws + OFF_WQUP); ntn = 6;
    gs = p.g_q + l * 256;
  } else {
    i = it - 856; src = p.w_kvup + (size_t)l * 128 * 512; K = 128; N = 512; dst = (bf16_t*)(p.ws + OFF_WKVUP); ntn = 8;
    gs = p.g_kv + l * 128;
  }
  convT_tile(src, K, N, dst, 0, gs, i / ntn, i % ntn, tl);
}

__device__ void phaseA(const Params& p, int l, char* smem) {
  const int nb = gridDim.x, bid = blockIdx.x;
  for (int it = bid; it < M_ALL / 4; it += nb)
    norm_rows(p, l == 0, (bf16_t*)(p.ws + OFF_HM), p.g_mix + l * 1024,
              (const float*)(p.ws + OFF_MOD) + (size_t)l * 9 * 6144, 0, 1, it);
}

DEVI void tile_map(int it, int NT, int& mt, int& nt, int MPX = 18) {
  const int xcd = it & 7, idx = it >> 3;
  const int per_group = 8 * NT;
  const int g = idx / per_group, r = idx - g * per_group;
  const int gs = min(8, MPX - 8 * g);
  mt = xcd * MPX + g * 8 + r % gs;
  nt = r / gs;
}

enum { EPI_P = 0, EPI_QUP = 1, EPI_KVUP = 2, EPI_RES = 3, EPI_GU = 4 };

template <int EPI>
__device__ void gemm_tile(const Params& p, int l, const bf16_t* __restrict__ A, int lda,
                          const bf16_t* __restrict__ BT, int K, int m0, int n0, int gate_i, char* smem) {
  constexpr int STAGE = 2 * 128 * 72;
  bf16_t* sbase = (bf16_t*)smem;
  float* rsv = (float*)(smem + 2 * STAGE * 2);
  const int tid = otid(), lane = tid & 63, w = tid >> 6, wm = w >> 1, wn = w & 1;
  const int lr = tid >> 3, lc = (tid & 7) * 8;
  __syncthreads();
  if (EPI == EPI_QUP || EPI == EPI_KVUP) {
    const int row = tid >> 1, hf = tid & 1;
    const int n8 = K / 16;
    const uint4* ap = (const uint4*)(A + (size_t)(m0 + row) * lda + hf * (K / 2));
    float ss = 0.f;
    for (int i = 0; i < n8; ++i) {
      uint4 u = ap[i];
      float a0 = bflo(u.x), a1 = bfhi(u.x), a2 = bflo(u.y), a3 = bfhi(u.y), a4 = bflo(u.z), a5 = bfhi(u.z),
            a6 = bflo(u.w), a7 = bfhi(u.w);
      ss += a0 * a0 + a1 * a1 + a2 * a2 + a3 * a3 + a4 * a4 + a5 * a5 + a6 * a6 + a7 * a7;
    }
    ss += __shfl_xor(ss, 1);
    if (hf == 0) rsv[row] = rsqrtf(ss / (float)K + 1e-6f);
  }
  const bf16_t* Ap = A + (size_t)(m0 + lr) * lda + lc;
  const bf16_t* Bp = BT + (size_t)(n0 + lr) * K + lc;
  uint4 ra0, ra1, ra2, ra3, rb0, rb1, rb2, rb3;
#define G_LOAD()                                  \
  ra0 = *(const uint4*)(Ap);                      \
  ra1 = *(const uint4*)(Ap + (size_t)32 * lda);   \
  ra2 = *(const uint4*)(Ap + (size_t)64 * lda);   \
  ra3 = *(const uint4*)(Ap + (size_t)96 * lda);   \
  rb0 = *(const uint4*)(Bp);                      \
  rb1 = *(const uint4*)(Bp + (size_t)32 * K);     \
  rb2 = *(const uint4*)(Bp + (size_t)64 * K);     \
  rb3 = *(const uint4*)(Bp + (size_t)96 * K);
#define S_WRITE(ST)                                                   \
  {                                                                   \
    bf16_t* wa = sbase + (ST) * STAGE + lr * 72 + lc;                 \
    bf16_t* wb = wa + 128 * 72;                                       \
    *(uint4*)(wa) = ra0;                                              \
    *(uint4*)(wa + 32 * 72) = ra1;                                    \
    *(uint4*)(wa + 64 * 72) = ra2;                                    \
    *(uint4*)(wa + 96 * 72) = ra3;                                    \
    *(uint4*)(wb) = rb0;                                              \
    *(uint4*)(wb + 32 * 72) = rb1;                                    \
    *(uint4*)(wb + 64 * 72) = rb2;                                    \
    *(uint4*)(wb + 96 * 72) = rb3;                                    \
  }
  const int nk = K / 64;
  G_LOAD()
  S_WRITE(0)
  if (nk > 1) {
    Ap += 64;
    Bp += 64;
    G_LOAD()
  }
  f32x16 acc[2][2];
#pragma unroll
  for (int i = 0; i < 2; ++i)
#pragma unroll
    for (int j = 0; j < 2; ++j)
#pragma unroll
      for (int r = 0; r < 16; ++r) acc[i][j][r] = 0.f;
  __syncthreads();
  for (int kt = 0; kt < nk; ++kt) {
    const int cur = kt & 1;
    const bf16_t* pa = sbase + cur * STAGE + (wm * 64 + (lane & 31)) * 72 + (lane >> 5) * 8;
    const bf16_t* pb = sbase + cur * STAGE + 128 * 72 + (wn * 64 + (lane & 31)) * 72 + (lane >> 5) * 8;
    bf16x8 fa00 = *(const bf16x8*)(pa), fa01 = *(const bf16x8*)(pa + 32 * 72);
    bf16x8 fb00 = *(const bf16x8*)(pb), fb01 = *(const bf16x8*)(pb + 32 * 72);
    bf16x8 fa10 = *(const bf16x8*)(pa + 16), fa11 = *(const bf16x8*)(pa + 32 * 72 + 16);
    bf16x8 fb10 = *(const bf16x8*)(pb + 16), fb11 = *(const bf16x8*)(pb + 32 * 72 + 16);
    bf16x8 fa20 = *(const bf16x8*)(pa + 32), fa21 = *(const bf16x8*)(pa + 32 * 72 + 32);
    bf16x8 fb20 = *(const bf16x8*)(pb + 32), fb21 = *(const bf16x8*)(pb + 32 * 72 + 32);
    bf16x8 fa30 = *(const bf16x8*)(pa + 48), fa31 = *(const bf16x8*)(pa + 32 * 72 + 48);
    bf16x8 fb30 = *(const bf16x8*)(pb + 48), fb31 = *(const bf16x8*)(pb + 32 * 72 + 48);
    __builtin_amdgcn_sched_barrier(0);
    __builtin_amdgcn_s_setprio(1);
#define MM4(A0, A1, B0, B1)                                                           \
  acc[0][0] = __builtin_amdgcn_mfma_f32_32x32x16_bf16(A0, B0, acc[0][0], 0, 0, 0);    \
  acc[0][1] = __builtin_amdgcn_mfma_f32_32x32x16_bf16(A0, B1, acc[0][1], 0, 0, 0);    \
  acc[1][0] = __builtin_amdgcn_mfma_f32_32x32x16_bf16(A1, B0, acc[1][0], 0, 0, 0);    \
  acc[1][1] = __builtin_amdgcn_mfma_f32_32x32x16_bf16(A1, B1, acc[1][1], 0, 0, 0);
    MM4(fa00, fa01, fb00, fb01)
    MM4(fa10, fa11, fb10, fb11)
    MM4(fa20, fa21, fb20, fb21)
    MM4(fa30, fa31, fb30, fb31)
#undef MM4
    __builtin_amdgcn_s_setprio(0);
    __builtin_amdgcn_sched_barrier(0);
    if (kt + 1 < nk) {
      S_WRITE(cur ^ 1)
      if (kt + 2 < nk) {
        Ap += 64;
        Bp += 64;
        G_LOAD()
      }
    }
    __syncthreads();
  }
#undef G_LOAD
#undef S_WRITE
  const int ci = lane & 31;
  const int rbase = m0 + wm * 64 + 4 * (lane >> 5);
  const int cbase = n0 + wn * 64;
  if (EPI == EPI_P) {
    bf16_t* P = (bf16_t*)(p.ws + OFF_P);
    float* AB = (float*)(p.ws + OFF_AB);
    bf16_t* sO = (bf16_t*)smem;
#pragma unroll
    for (int mt = 0; mt < 2; ++mt)
#pragma unroll
      for (int nt = 0; nt < 2; ++nt)
#pragma unroll
        for (int r = 0; r < 16; ++r) {
          const int rl = wm * 64 + 4 * (lane >> 5) + mt * 32 + (r & 3) + 8 * (r >> 2);
          const int cl = wn * 64 + nt * 32 + ci;
          const float v = acc[mt][nt][r];
          sO[rl * 136 + cl] = f2bf(v);
          const int col = n0 + cl;
          if (col >= C_DA && col < C_DA + 16) AB[(size_t)(m0 + rl) * 16 + col - C_DA] = v;
        }
    __syncthreads();
#pragma unroll
    for (int e = 0; e < 8; ++e) {
      const int c = tid + 256 * e, rl = c >> 4, ch = c & 15;
      *(uint4*)(P + (size_t)(m0 + rl) * INWP + n0 + ch * 8) = *(const uint4*)(sO + rl * 136 + ch * 8);
    }
    bf16_t* NVT = (bf16_t*)(p.ws + OFF_NVT);
#pragma unroll
    for (int mt = 0; mt < 2; ++mt)
#pragma unroll
      for (int nt = 0; nt < 2; ++nt) {
        const int base = cbase + nt * 32;
        if (base >= C_NV && base < C_NV + 256) {
          const int hv = (base - C_NV) >> 6, dv = ((base - C_NV) & 63) + ci;
#pragma unroll
          for (int g = 0; g < 4; ++g) {
            const int row0 = rbase + mt * 32 + 8 * g;
            int bb, key0;
            if (row0 < M_LAT) { bb = row0 >> 11; key0 = 256 + (row0 & 2047); }
            else { bb = (row0 - M_LAT) >> 8; key0 = (row0 - M_LAT) & 255; }
            uint2 u;
            u.x = pack2(acc[mt][nt][4 * g + 0], acc[mt][nt][4 * g + 1]);
            u.y = pack2(acc[mt][nt][4 * g + 2], acc[mt][nt][4 * g + 3]);
            *(uint2*)(NVT + ((size_t)(bb * 4 + hv) * 64 + dv) * 2304 + key0) = u;
          }
        }
      }
  } else if (EPI == EPI_QUP) {
    bf16_t* QH = (bf16_t*)(p.ws + OFF_QH);
    const float* rc = (const float*)(p.ws + OFF_ROPE);
    const float* rsn = rc + 2048 * 16;
#pragma unroll
    for (int mt = 0; mt < 2; ++mt)
#pragma unroll
      for (int nt = 0; nt < 2; ++nt) {
        const int base = cbase + nt * 32;
        const bool rope = ((base % 96) == 64) && (m0 < M_LAT);
#pragma unroll
        for (int r = 0; r < 16; ++r) {
          int row = rbase + mt * 32 + (r & 3) + 8 * (r >> 2);
          float v = acc[mt][nt][r] * rsv[row - m0];
          float o = __shfl_xor(v, 8);
          if (rope) {
            int t = row & 2047;
            int a = ci >> 4, hf = (ci >> 3) & 1, j = ci & 7;
            float c = rc[t * 16 + a * 8 + j], s = rsn[t * 16 + a * 8 + j];
            v = hf ? (o * s + v * c) : (v * c - o * s);
          }
          QH[(size_t)row * 384 + base + ci] = f2bf(v);
        }
      }
  } else if (EPI == EPI_KVUP) {
    bf16_t* KA = (bf16_t*)(p.ws + OFF_KH);
    bf16_t* VT = (bf16_t*)(p.ws + OFF_VH);
#pragma unroll
    for (int mt = 0; mt < 2; ++mt)
#pragma unroll
      for (int nt = 0; nt < 2; ++nt) {
        const int base = cbase + nt * 32;
        const int h = base >> 7, cc = (base & 127) + ci;
#pragma unroll
        for (int g = 0; g < 4; ++g) {
          const int row0 = rbase + mt * 32 + 8 * g;
          int bb, key0;
          if (row0 < M_LAT) { bb = row0 >> 11; key0 = 256 + (row0 & 2047); }
          else { bb = (row0 - M_LAT) >> 8; key0 = (row0 - M_LAT) & 255; }
          float v0 = acc[mt][nt][4 * g + 0] * rsv[row0 - m0 + 0];
          float v1 = acc[mt][nt][4 * g + 1] * rsv[row0 - m0 + 1];
          float v2 = acc[mt][nt][4 * g + 2] * rsv[row0 - m0 + 2];
          float v3 = acc[mt][nt][4 * g + 3] * rsv[row0 - m0 + 3];
          if (cc < 64) {
            bf16_t* kp = KA + ((size_t)(bb * 4 + h) * 2304 + key0) * 96 + cc;
            kp[0] = f2bf(v0); kp[96] = f2bf(v1); kp[192] = f2bf(v2); kp[288] = f2bf(v3);
          } else {
            uint2 u;
            u.x = pack2(v0, v1);
            u.y = pack2(v2, v3);
            *(uint2*)(VT + ((size_t)(bb * 4 + h) * 64 + (cc - 64)) * 2304 + key0) = u;
          }
        }
      }
  } else if (EPI == EPI_RES) {
    float* X = (float*)(p.ws + OFF_X);
    const float* Xsrc = (l == 0 && gate_i == 2) ? (m0 < M_LAT ? p.x : p.ctx - (size_t)M_LAT * 1024) : X;
    const float* modl = (const float*)(p.ws + OFF_MOD) + (size_t)l * 9 * 6144 + gate_i * 1024;
#pragma unroll
    for (int mt = 0; mt < 2; ++mt)
#pragma unroll
      for (int nt = 0; nt < 2; ++nt)
#pragma unroll
        for (int r = 0; r < 16; ++r) {
          int row = rbase + mt * 32 + (r & 3) + 8 * (r >> 2);
          int col = cbase + nt * 32 + ci;
          int b = row < M_LAT ? (row >> 11) : 8;
          float g = modl[b * 6144 + col];
          size_t idx = (size_t)row * 1024 + col;
          X[idx] = Xsrc[idx] + g * acc[mt][nt][r];
        }
  } else if (EPI == EPI_GU) {
    bf16_t* ACT = (bf16_t*)(p.ws + OFF_P);
    bf16_t* sO = (bf16_t*)smem;
#pragma unroll
    for (int mt = 0; mt < 2; ++mt)
#pragma unroll
      for (int r = 0; r < 16; ++r) {
        const int rl = wm * 64 + 4 * (lane >> 5) + mt * 32 + (r & 3) + 8 * (r >> 2);
        float gt = acc[mt][0][r], up = acc[mt][1][r];
        float a = silu_f(gt) * up;
        sO[rl * 72 + wn * 32 + ci] = f2bf(a);
      }
    __syncthreads();
#pragma unroll
    for (int e = 0; e < 4; ++e) {
      const int c = tid + 256 * e, rl = c >> 3, ch = c & 7;
      *(uint4*)(ACT + (size_t)(m0 + rl) * FFN + (n0 >> 1) + ch * 8) = *(const uint4*)(sO + rl * 72 + ch * 8);
    }
  }
}

template <int EPI>
__device__ void gemm_wide(const Params& p, int l, const bf16_t* __restrict__ A, int lda,
                          const bf16_t* __restrict__ BT, int K, int m0, int n0, int gate_i, char* smem) {
  bf16_t* sA = (bf16_t*)smem;
  bf16_t* sB = sA + 128 * 72;
  const int tid = otid(), lane = tid & 63, w = tid >> 6, wm = w >> 1, wn = w & 1;
  const int lr = tid >> 3, lc = (tid & 7) * 8;
  const bf16_t* Ap = A + (size_t)(m0 + lr) * lda + lc;
  const bf16_t* Bp = BT + (size_t)(n0 + lr) * K + lc;
  uint4 ra0, ra1, ra2, ra3, rb0, rb1, rb2, rb3, rb4, rb5, rb6, rb7;
#define LOAD_AB()                                   \
  ra0 = *(const uint4*)(Ap);                        \
  ra1 = *(const uint4*)(Ap + (size_t)32 * lda);     \
  ra2 = *(const uint4*)(Ap + (size_t)64 * lda);     \
  ra3 = *(const uint4*)(Ap + (size_t)96 * lda);     \
  rb0 = *(const uint4*)(Bp);                        \
  rb1 = *(const uint4*)(Bp + (size_t)32 * K);       \
  rb2 = *(const uint4*)(Bp + (size_t)64 * K);       \
  rb3 = *(const uint4*)(Bp + (size_t)96 * K);       \
  rb4 = *(const uint4*)(Bp + (size_t)128 * K);      \
  rb5 = *(const uint4*)(Bp + (size_t)160 * K);      \
  rb6 = *(const uint4*)(Bp + (size_t)192 * K);      \
  rb7 = *(const uint4*)(Bp + (size_t)224 * K);
  __syncthreads();
  LOAD_AB()
  f32x16 acc[2][4];
#pragma unroll
  for (int i = 0; i < 2; ++i)
#pragma unroll
    for (int j = 0; j < 4; ++j)
#pragma unroll
      for (int r = 0; r < 16; ++r) acc[i][j][r] = 0.f;
  const int nk = K / 64;
  const bf16_t* pa = sA + (wm * 64 + (lane & 31)) * 72 + (lane >> 5) * 8;
  const bf16_t* pb = sB + (wn * 128 + (lane & 31)) * 72 + (lane >> 5) * 8;
#define MM8(A0, A1, B0, B1, B2, B3)                                                   \
  acc[0][0] = __builtin_amdgcn_mfma_f32_32x32x16_bf16(A0, B0, acc[0][0], 0, 0, 0);    \
  acc[1][0] = __builtin_amdgcn_mfma_f32_32x32x16_bf16(A1, B0, acc[1][0], 0, 0, 0);    \
  acc[0][1] = __builtin_amdgcn_mfma_f32_32x32x16_bf16(A0, B1, acc[0][1], 0, 0, 0);    \
  acc[1][1] = __builtin_amdgcn_mfma_f32_32x32x16_bf16(A1, B1, acc[1][1], 0, 0, 0);    \
  acc[0][2] = __builtin_amdgcn_mfma_f32_32x32x16_bf16(A0, B2, acc[0][2], 0, 0, 0);    \
  acc[1][2] = __builtin_amdgcn_mfma_f32_32x32x16_bf16(A1, B2, acc[1][2], 0, 0, 0);    \
  acc[0][3] = __builtin_amdgcn_mfma_f32_32x32x16_bf16(A0, B3, acc[0][3], 0, 0, 0);    \
  acc[1][3] = __builtin_amdgcn_mfma_f32_32x32x16_bf16(A1, B3, acc[1][3], 0, 0, 0);
#define HALF_STEP(KO)                                                                                   \
  {                                                                                                     \
    bf16x8 fa00 = *(const bf16x8*)(pa + (KO)), fa01 = *(const bf16x8*)(pa + 32 * 72 + (KO));            \
    bf16x8 fb00 = *(const bf16x8*)(pb + (KO)), fb01 = *(const bf16x8*)(pb + 32 * 72 + (KO));            \
    bf16x8 fb02 = *(const bf16x8*)(pb + 64 * 72 + (KO)), fb03 = *(const bf16x8*)(pb + 96 * 72 + (KO));  \
    bf16x8 fa10 = *(const bf16x8*)(pa + (KO) + 16), fa11 = *(const bf16x8*)(pa + 32 * 72 + (KO) + 16);  \
    bf16x8 fb10 = *(const bf16x8*)(pb + (KO) + 16), fb11 = *(const bf16x8*)(pb + 32 * 72 + (KO) + 16);  \
    bf16x8 fb12 = *(const bf16x8*)(pb + 64 * 72 + (KO) + 16), fb13 = *(const bf16x8*)(pb + 96 * 72 + (KO) + 16); \
    __builtin_amdgcn_sched_barrier(0);                                                                  \
    __builtin_amdgcn_s_setprio(1);                                                                      \
    MM8(fa00, fa01, fb00, fb01, fb02, fb03)                                                             \
    MM8(fa10, fa11, fb10, fb11, fb12, fb13)                                                             \
    __builtin_amdgcn_s_setprio(0);                                                                      \
    __builtin_amdgcn_sched_barrier(0);                                                                  \
  }
  for (int kt = 0; kt < nk; ++kt) {
    __syncthreads();
    *(uint4*)(sA + (lr + 0) * 72 + lc) = ra0;
    *(uint4*)(sA + (lr + 32) * 72 + lc) = ra1;
    *(uint4*)(sA + (lr + 64) * 72 + lc) = ra2;
    *(uint4*)(sA + (lr + 96) * 72 + lc) = ra3;
    *(uint4*)(sB + (lr + 0) * 72 + lc) = rb0;
    *(uint4*)(sB + (lr + 32) * 72 + lc) = rb1;
    *(uint4*)(sB + (lr + 64) * 72 + lc) = rb2;
    *(uint4*)(sB + (lr + 96) * 72 + lc) = rb3;
    *(uint4*)(sB + (lr + 128) * 72 + lc) = rb4;
    *(uint4*)(sB + (lr + 160) * 72 + lc) = rb5;
    *(uint4*)(sB + (lr + 192) * 72 + lc) = rb6;
    *(uint4*)(sB + (lr + 224) * 72 + lc) = rb7;
    __syncthreads();
    if (kt + 1 < nk) {
      Ap += 64;
      Bp += 64;
      LOAD_AB()
    }
    __builtin_amdgcn_sched_barrier(0);
    HALF_STEP(0)
    HALF_STEP(32)
  }
#undef HALF_STEP
#undef MM8
#undef LOAD_AB
  const int ci = lane & 31;
  const int rbase = m0 + wm * 64 + 4 * (lane >> 5);
  const int cbase = n0 + wn * 128;
  if (EPI == EPI_P) {
    bf16_t* P = (bf16_t*)(p.ws + OFF_P);
    float* AB = (float*)(p.ws + OFF_AB);
    bf16_t* NVT = (bf16_t*)(p.ws + OFF_NVT);
#pragma unroll
    for (int mt = 0; mt < 2; ++mt)
#pragma unroll
      for (int nt = 0; nt < 4; ++nt) {
        const int base = cbase + nt * 32;
#pragma unroll
        for (int r = 0; r < 16; ++r) {
          int row = rbase + mt * 32 + (r & 3) + 8 * (r >> 2);
          int col = base + ci;
          float v = acc[mt][nt][r];
          P[(size_t)row * INWP + col] = f2bf(v);
          if (col >= C_DA && col < C_DA + 16) AB[(size_t)row * 16 + col - C_DA] = v;
        }
        if (base >= C_NV && base < C_NV + 256) {
          const int hv = (base - C_NV) >> 6, dv = ((base - C_NV) & 63) + ci;
#pragma unroll
          for (int g = 0; g < 4; ++g) {
            const int row0 = rbase + mt * 32 + 8 * g;
            int bb, key0;
            if (row0 < M_LAT) { bb = row0 >> 11; key0 = 256 + (row0 & 2047); }
            else { bb = (row0 - M_LAT) >> 8; key0 = (row0 - M_LAT) & 255; }
            uint2 u;
            u.x = pack2(acc[mt][nt][4 * g + 0], acc[mt][nt][4 * g + 1]);
            u.y = pack2(acc[mt][nt][4 * g + 2], acc[mt][nt][4 * g + 3]);
            *(uint2*)(NVT + ((size_t)(bb * 4 + hv) * 64 + dv) * 2304 + key0) = u;
          }
        }
      }
  } else if (EPI == EPI_GU) {
    bf16_t* ACT = (bf16_t*)(p.ws + OFF_P);
#pragma unroll
    for (int mt = 0; mt < 2; ++mt)
#pragma unroll
      for (int pr = 0; pr < 2; ++pr)
#pragma unroll
        for (int r = 0; r < 16; ++r) {
          int row = rbase + mt * 32 + (r & 3) + 8 * (r >> 2);
          float gt = acc[mt][2 * pr][r], up = acc[mt][2 * pr + 1][r];
          float a = silu_f(gt) * up;
          ACT[(size_t)row * FFN + ((cbase >> 6) + pr) * 32 + ci] = f2bf(a);
        }
  }
}

__device__ void kpe_item(const Params& p, int it) {
  const int tid = otid();
  const bf16_t* P = (const bf16_t*)(p.ws + OFF_P);
  bf16_t* KH = (bf16_t*)(p.ws + OFF_KH);
  const float* rc = (const float*)(p.ws + OFF_ROPE);
  const float* rsn = rc + 2048 * 16;
  const int row = it * 8 + (tid >> 5), i = tid & 31;
  float v = bf2f(P[(size_t)row * INWP + C_MPE + i]);
  float o = __shfl_xor(v, 8);
  if (row < M_LAT) {
    int t = row & 2047;
    int a = i >> 4, hf = (i >> 3) & 1, j = i & 7;
    float c = rc[t * 16 + a * 8 + j], s = rsn[t * 16 + a * 8 + j];
    v = hf ? (o * s + v * c) : (v * c - o * s);
  }
  bf16_t bv = f2bf(v);
  int bb, key;
  if (row < M_LAT) { bb = row >> 11; key = 256 + (row & 2047); }
  else { bb = (row - M_LAT) >> 8; key = (row - M_LAT) & 255; }
#pragma unroll
  for (int h = 0; h < 4; ++h) KH[((size_t)(bb * 4 + h) * 2304 + key) * 96 + 64 + i] = bv;
}

__device__ void dn_prep(const Params& p, int l, int it, char* smem) {
  float* buf = (float*)smem;
  float* nrm = buf + 8 * 1536;
  const int tid = otid();
  const bf16_t* P = (const bf16_t*)(p.ws + OFF_P);
  bf16_t* DQ = (bf16_t*)(p.ws + OFF_DNQKV);
  const int r0 = it * 8;
  int seq_lo, seq_hi;
  if (r0 < M_LAT) {
    seq_lo = (r0 >> 11) << 11;
    seq_hi = seq_lo + 2048;
  } else {
    int rr = r0 - M_LAT;
    seq_lo = M_LAT + ((rr >> 8) << 8);
    seq_hi = seq_lo + 256;
  }
  const float* cw = p.conv_w + (size_t)l * 5 * 1536;
  __syncthreads();
  for (int c6 = 0; c6 < 6; ++c6) {
    const int ch = c6 * 256 + tid;
    float w0 = cw[ch], w1 = cw[1536 + ch], w2 = cw[2 * 1536 + ch], w3 = cw[3 * 1536 + ch], w4 = cw[4 * 1536 + ch];
    float xw[12];
#pragma unroll
    for (int j = 0; j < 12; ++j) {
      int r = r0 - 2 + j;
      xw[j] = (r >= seq_lo && r < seq_hi) ? bf2f(P[(size_t)r * INWP + C_DN + ch]) : 0.f;
    }
#pragma unroll
    for (int j = 0; j < 8; ++j) {
      float y = w0 * xw[j] + w1 * xw[j + 1] + w2 * xw[j + 2] + w3 * xw[j + 3] + w4 * xw[j + 4];
      buf[j * 1536 + ch] = silu_f(y);
    }
  }
  __syncthreads();
  {
    int vec = tid >> 2, part = tid & 3;
    int rr = vec >> 3, hv = vec & 7;
    const float* v = buf + rr * 1536 + hv * 128 + part * 32;
    float ss = 0.f;
#pragma unroll
    for (int i = 0; i < 32; ++i) ss += v[i] * v[i];
    ss += __shfl_xor(ss, 1);
    ss += __shfl_xor(ss, 2);
    if (part == 0) nrm[vec] = rsqrtf(ss + 1e-6f);
  }
  __syncthreads();
  for (int i = tid; i < 8 * 1536; i += 256) {
    int rr = i / 1536, ch = i - rr * 1536;
    float v = buf[i];
    if (ch < 1024) v *= nrm[rr * 8 + (ch >> 7)];
    DQ[(size_t)(r0 + rr) * 1536 + ch] = f2bf(v);
  }
}


DEVI int rowmap(int r, int hh) { return (r & 3) + 8 * (r >> 2) + 4 * hh; }

DEVI void unpack8(const uint4& u, float* f) {
  f[0] = bflo(u.x); f[1] = bfhi(u.x); f[2] = bflo(u.y); f[3] = bfhi(u.y);
  f[4] = bflo(u.z); f[5] = bfhi(u.z); f[6] = bflo(u.w); f[7] = bfhi(u.w);
}
__device__ void dn_chunk_prep(const Params& p, int l, int item, char* smem) {
  float* sW = (float*)smem;
  bf16_t* sKb = (bf16_t*)(smem + 7680);
  float* sL0 = (float*)(smem + 25088);
  float* sL1 = sL0 + 64 * 68;
  float* sg = (float*)(smem + 59904);
  float* sbt = sg + 128;
  const int tid = otid(), lane = tid & 63, w = tid >> 6, li = lane & 31, hh = lane >> 5;
  const int chunk = item >> 2, h = item & 3;
  int row0, seq_lo, seq_hi;
  if (chunk < 256) {
    int b = chunk >> 5;
    row0 = b * 2048 + (chunk & 31) * 64; seq_lo = b * 2048; seq_hi = seq_lo + 2048;
  } else {
    int cc = chunk - 256, b = cc >> 2;
    row0 = M_LAT + b * 256 + (cc & 3) * 64; seq_lo = M_LAT + b * 256; seq_hi = seq_lo + 256;
  }
  const bf16_t* P = (const bf16_t*)(p.ws + OFF_P);
  bf16_t* DQ = (bf16_t*)(p.ws + OFF_DNQKV);
  const float* AB = (const float*)(p.ws + OFF_AB);
  const float* cw = p.conv_w + (size_t)l * 5 * 1536;
  __syncthreads();
  for (int i = tid; i < 5 * 384; i += 256) {
    const int tap = i / 384, cc = i - tap * 384, type = cc >> 7, c = cc & 127;
    const int off = type == 0 ? 512 : (type == 1 ? 0 : 1024);
    sW[i] = cw[tap * 1536 + off + h * 128 + c];
  }
  if (w < 2) {
    const int d = w;
    const int row = d ? (row0 + 63 - lane) : (row0 + lane);
    const float Aneg = -__expf(p.a_log[l * 8 + d * 4 + h]);
    const float dtb = p.dt_bias[l * 8 + d * 4 + h];
    float a = AB[(size_t)row * 16 + d * 4 + h];
    float bb = AB[(size_t)row * 16 + 8 + d * 4 + h];
    float xx = a + dtb;
    const float ee = __expf(xx);
    float sp = ee < 0.25f ? ee * (1.f - ee * (0.5f - ee * (0.33333333f - ee * (0.25f - 0.2f * ee))))
                          : (xx > 20.f ? xx : __logf(1.f + ee));
    float g = Aneg * sp;
#pragma unroll
    for (int o = 1; o < 64; o <<= 1) {
      float y = __shfl_up(g, o);
      if (lane >= o) g += y;
    }
    float be = 1.f / (1.f + __expf(-bb));
    sg[d * 64 + lane] = g;
    sbt[d * 64 + lane] = be;
    ((float*)(p.ws + OFF_GC))[(size_t)row * 8 + d * 4 + h] = g;
    ((float*)(p.ws + OFF_BETA))[(size_t)row * 8 + d * 4 + h] = be;
  }
  __syncthreads();
  const int cg = tid & 15, rsub = tid >> 4;
#pragma unroll 1
  for (int type = 0; type < 3; ++type) {
    const int off = type == 0 ? 512 : (type == 1 ? 0 : 1024);
    uint4 xv[4][5];
#pragma unroll
    for (int e = 0; e < 4; ++e) {
      const int row = rsub + 16 * e;
      const bf16_t* base = P + (size_t)(row0 + row) * INWP + C_DN + off + h * 128 + cg * 8;
#pragma unroll
      for (int dd = 0; dd < 5; ++dd) {
        const int r = row0 + row + dd - 2;
        xv[e][dd] = (r >= seq_lo && r < seq_hi) ? *(const uint4*)(base + (dd - 2) * INWP) : make_uint4(0u, 0u, 0u, 0u);
      }
    }
#pragma unroll
    for (int e = 0; e < 4; ++e) {
      const int row = rsub + 16 * e;
      float y[8];
#pragma unroll
      for (int j = 0; j < 8; ++j) y[j] = 0.f;
#pragma unroll
      for (int dd = 0; dd < 5; ++dd) {
        float xf[8];
        unpack8(xv[e][dd], xf);
        const float4 wa = *(const float4*)(sW + dd * 384 + type * 128 + cg * 8);
        const float4 wb = *(const float4*)(sW + dd * 384 + type * 128 + cg * 8 + 4);
        y[0] += wa.x * xf[0]; y[1] += wa.y * xf[1]; y[2] += wa.z * xf[2]; y[3] += wa.w * xf[3];
        y[4] += wb.x * xf[4]; y[5] += wb.y * xf[5]; y[6] += wb.z * xf[6]; y[7] += wb.w * xf[7];
      }
      float ss = 0.f;
#pragma unroll
      for (int j = 0; j < 8; ++j) {
        y[j] = silu_f(y[j]);
        ss += y[j] * y[j];
      }
      if (type < 2) {
        ss += __shfl_xor(ss, 1);
        ss += __shfl_xor(ss, 2);
        ss += __shfl_xor(ss, 4);
        ss += __shfl_xor(ss, 8);
        const float rn = rsqrtf(ss + 1e-6f);
#pragma unroll
        for (int j = 0; j < 8; ++j) y[j] *= rn;
      }
      uint4 u;
      u.x = pack2(y[0], y[1]); u.y = pack2(y[2], y[3]); u.z = pack2(y[4], y[5]); u.w = pack2(y[6], y[7]);
      *(uint4*)(DQ + (size_t)(row0 + row) * 1536 + off + h * 128 + cg * 8) = u;
      if (type == 0) *(uint4*)(sKb + row * 136 + cg * 8) = u;
    }
  }
  __syncthreads();
  {
    const int mi = w >> 1, ni = w & 1;
    f32x16 g;
#pragma unroll
    for (int r = 0; r < 16; ++r) g[r] = 0.f;
#pragma unroll
    for (int ks = 0; ks < 8; ++ks) {
      bf16x8 a = *(const bf16x8*)(sKb + (mi * 32 + li) * 136 + ks * 16 + hh * 8);
      bf16x8 b = *(const bf16x8*)(sKb + (ni * 32 + li) * 136 + ks * 16 + hh * 8);
      g = __builtin_amdgcn_mfma_f32_32x32x16_bf16(a, b, g, 0, 0, 0);
    }
#pragma unroll
    for (int r = 0; r < 16; ++r) {
      const int i = mi * 32 + rowmap(r, hh), m = ni * 32 + li;
      const float G = g[r];
      sL0[i * 68 + m] = (i > m) ? sbt[i] * G * __expf(sg[i] - sg[m]) : 0.f;
      const int i1 = 63 - i, m1 = 63 - m;
      sL1[i1 * 68 + m1] = (i1 > m1) ? sbt[64 + i1] * G * __expf(sg[64 + i1] - sg[64 + m1]) : 0.f;
    }
  }
  __syncthreads();
  if (w < 2) {
    const float* L = w == 0 ? sL0 : sL1;
    float t[64];
#pragma unroll
    for (int i = 0; i < 64; ++i) {
      float a0 = (i == lane) ? 1.f : 0.f, a1 = 0.f, a2 = 0.f, a3 = 0.f;
#pragma unroll
      for (int m = 0; m < i; ++m) {
        const float pr = L[i * 68 + m] * t[m];
        if ((m & 3) == 0) a0 -= pr;
        else if ((m & 3) == 1) a1 -= pr;
        else if ((m & 3) == 2) a2 -= pr;
        else a3 -= pr;
      }
      t[i] = (a0 + a1) + (a2 + a3);
    }
    bf16_t* Tg = (bf16_t*)(p.ws + OFF_OB) + (size_t)((chunk * 4 + h) * 2 + w) * 4096;
#pragma unroll
    for (int i = 0; i < 64; ++i) Tg[i * 64 + lane] = f2bf(t[i]);
  }
}

DEVI bf16x8 ld_perm(const bf16_t* p) {
  union { bf16x8 v; uint2 d[2]; } u;
  u.d[0] = *(const uint2*)(p);
  u.d[1] = *(const uint2*)(p + 8);
  return u.v;
}
DEVI bf16x8 pack8(const f32x16& x, int s) {
  union { bf16x8 v; unsigned w[4]; } u;
  u.w[0] = pack2(x[8 * s + 0], x[8 * s + 1]);
  u.w[1] = pack2(x[8 * s + 2], x[8 * s + 3]);
  u.w[2] = pack2(x[8 * s + 4], x[8 * s + 5]);
  u.w[3] = pack2(x[8 * s + 6], x[8 * s + 7]);
  return u.v;
}

__device__ void dn_scan(const Params& p, int l, int item, char* smem) {
  bf16_t* sK = (bf16_t*)smem;
  bf16_t* sQ = (bf16_t*)(smem + 17408);
  bf16_t* sKT = (bf16_t*)(smem + 34816);
  bf16_t* sT = (bf16_t*)(smem + 52224);
  bf16_t* sA = (bf16_t*)(smem + 60928);
  bf16_t* sV = (bf16_t*)(smem + 52224);
  float* sg = (float*)(smem + 69632);
  float* sbt = sg + 64;
  float* seg = sbt + 64;
  float* sdt = seg + 64;
  const int d = item & 1, h = (item >> 1) & 3, b = item >> 3;
  const bf16_t* DQ = (const bf16_t*)(p.ws + OFF_DNQKV);
  const bf16_t* TB = (const bf16_t*)(p.ws + OFF_OB);
  const float* GC = (const float*)(p.ws + OFF_GC);
  const float* BE = (const float*)(p.ws + OFF_BETA);
  bf16_t* MIX = (bf16_t*)(p.ws + OFF_HM);
  bf16_t* Pw = (bf16_t*)(p.ws + OFF_P);
  const float qscale = 0.08838834764831845f;
  const int rsign = d ? -1 : 1;
  f32x16 S0, S1, S2, S3;
#pragma unroll
  for (int r = 0; r < 16; ++r) { S0[r] = 0.f; S1[r] = 0.f; S2[r] = 0.f; S3[r] = 0.f; }
  __builtin_amdgcn_s_setprio(3);
  uint4 qA0, qB0, kA0, kB0, vA0, vB0, qA1, qB1, kA1, kB1, vA1, vB1, tq0, tq1;
  float pgc = 0.f, pbe = 0.f;
#define SCAN_ROW0(N, CHUNK, ROW0)                                    \
  {                                                                  \
    if ((N) < 4) {                                                   \
      int cn = d ? (3 - (N)) : (N);                                  \
      CHUNK = 256 + b * 4 + cn;                                      \
      ROW0 = M_LAT + b * 256 + cn * 64;                              \
    } else {                                                         \
      int ln = (N)-4;                                                \
      ln = d ? (31 - ln) : ln;                                       \
      CHUNK = b * 32 + ln;                                           \
      ROW0 = b * 2048 + ln * 64;                                     \
    }                                                                \
  }
#define SCAN_LOADS(N)                                                                         \
  {                                                                                           \
    const int tid_ = otid();                                                                  \
    int chunk_, row0_;                                                                        \
    SCAN_ROW0(N, chunk_, row0_)                                                               \
    const int rstart_ = d ? (row0_ + 63) : row0_;                                             \
    {                                                                                         \
      const int u = tid_, c8 = u & 15, tp = u >> 4;                                           \
      const bf16_t* ga = DQ + (size_t)(rstart_ + rsign * 2 * tp) * 1536 + h * 128 + c8 * 8;   \
      const bf16_t* gb = ga + rsign * 1536;                                                   \
      qA0 = *(const uint4*)(ga); kA0 = *(const uint4*)(ga + 512); vA0 = *(const uint4*)(ga + 1024); \
      qB0 = *(const uint4*)(gb); kB0 = *(const uint4*)(gb + 512); vB0 = *(const uint4*)(gb + 1024); \
    }                                                                                         \
    {                                                                                         \
      const int u = tid_ + 256, c8 = u & 15, tp = u >> 4;                                     \
      const bf16_t* ga = DQ + (size_t)(rstart_ + rsign * 2 * tp) * 1536 + h * 128 + c8 * 8;   \
      const bf16_t* gb = ga + rsign * 1536;                                                   \
      qA1 = *(const uint4*)(ga); kA1 = *(const uint4*)(ga + 512); vA1 = *(const uint4*)(ga + 1024); \
      qB1 = *(const uint4*)(gb); kB1 = *(const uint4*)(gb + 512); vB1 = *(const uint4*)(gb + 1024); \
    }                                                                                         \
    {                                                                                         \
      const bf16_t* Tg = TB + (size_t)((chunk_ * 4 + h) * 2 + d) * 4096;                      \
      tq0 = *(const uint4*)(Tg + (tid_ >> 3) * 64 + (tid_ & 7) * 8);                          \
      tq1 = *(const uint4*)(Tg + ((tid_ >> 3) + 32) * 64 + (tid_ & 7) * 8);                   \
    }                                                                                         \
    if (tid_ < 64) {                                                                          \
      const int row = rstart_ + rsign * tid_;                                                 \
      pgc = GC[(size_t)row * 8 + d * 4 + h];                                                  \
      pbe = BE[(size_t)row * 8 + d * 4 + h];                                                  \
    }                                                                                         \
  }
  SCAN_LOADS(0)
  for (int n = 0; n < 36; ++n) {
    const int tid = otid(), lane = tid & 63, w = tid >> 6, li = lane & 31, hh = lane >> 5;
    int chunk, row0;
    SCAN_ROW0(n, chunk, row0)
    (void)chunk;
    const int rstart = d ? (row0 + 63) : row0;
    __syncthreads();
#define STAGE_UNIT(U, QA, QB, KA, KB, VA, VB)                                                   \
  {                                                                                             \
    const int c8 = (U)&15, tp = (U) >> 4;                                                       \
    *(uint4*)(sQ + (2 * tp) * 136 + c8 * 8) = QA;                                               \
    *(uint4*)(sQ + (2 * tp + 1) * 136 + c8 * 8) = QB;                                           \
    *(uint4*)(sK + (2 * tp) * 136 + c8 * 8) = KA;                                               \
    *(uint4*)(sK + (2 * tp + 1) * 136 + c8 * 8) = KB;                                           \
    *(uint4*)(sV + (2 * tp) * 136 + c8 * 8) = VA;                                               \
    *(uint4*)(sV + (2 * tp + 1) * 136 + c8 * 8) = VB;                                           \
    unsigned* kt = (unsigned*)(sKT + (c8 * 8) * 68 + 2 * tp);                                   \
    kt[0 * 34] = (KA.x & 0xffffu) | (KB.x << 16);                                               \
    kt[1 * 34] = (KA.x >> 16) | (KB.x & 0xffff0000u);                                           \
    kt[2 * 34] = (KA.y & 0xffffu) | (KB.y << 16);                                               \
    kt[3 * 34] = (KA.y >> 16) | (KB.y & 0xffff0000u);                                           \
    kt[4 * 34] = (KA.z & 0xffffu) | (KB.z << 16);                                               \
    kt[5 * 34] = (KA.z >> 16) | (KB.z & 0xffff0000u);                                           \
    kt[6 * 34] = (KA.w & 0xffffu) | (KB.w << 16);                                               \
    kt[7 * 34] = (KA.w >> 16) | (KB.w & 0xffff0000u);                                           \
  }
    STAGE_UNIT(tid, qA0, qB0, kA0, kB0, vA0, vB0)
    STAGE_UNIT(tid + 256, qA1, qB1, kA1, kB1, vA1, vB1)
#undef STAGE_UNIT
    if (tid < 64) {
      float g63 = __shfl(pgc, 63);
      sg[lane] = pgc;
      sbt[lane] = pbe;
      seg[lane] = __expf(pgc);
      sdt[lane] = __expf(g63 - pgc);
    }
    __syncthreads();
    f32x16 v0, v1;
#pragma unroll
    for (int r = 0; r < 16; ++r) {
      const int t0 = rowmap(r, hh);
      v0[r] = bf2f(sV[t0 * 136 + w * 32 + li]);
      v1[r] = bf2f(sV[(32 + t0) * 136 + w * 32 + li]);
    }
    __syncthreads();
    {
      const int i0 = tid >> 3, c8 = tid & 7;
      *(uint2*)(sT + i0 * 68 + c8 * 8) = make_uint2(tq0.x, tq0.y);
      *(uint2*)(sT + i0 * 68 + c8 * 8 + 4) = make_uint2(tq0.z, tq0.w);
      *(uint2*)(sT + (i0 + 32) * 68 + c8 * 8) = make_uint2(tq1.x, tq1.y);
      *(uint2*)(sT + (i0 + 32) * 68 + c8 * 8 + 4) = make_uint2(tq1.z, tq1.w);
    }
    {
      const int mi = w >> 1, ni = w & 1;
      f32x16 a;
#pragma unroll
      for (int r = 0; r < 16; ++r) a[r] = 0.f;
      if (!(mi == 0 && ni == 1)) {
#pragma unroll
        for (int ks = 0; ks < 8; ++ks) {
          bf16x8 qa = *(const bf16x8*)(sQ + (mi * 32 + li) * 136 + ks * 16 + hh * 8);
          bf16x8 kb = *(const bf16x8*)(sK + (ni * 32 + li) * 136 + ks * 16 + hh * 8);
          a = __builtin_amdgcn_mfma_f32_32x32x16_bf16(qa, kb, a, 0, 0, 0);
        }
      }
#pragma unroll
      for (int r = 0; r < 16; ++r) {
        const int i = mi * 32 + rowmap(r, hh), j = ni * 32 + li;
        float val = (i >= j) ? a[r] * qscale * __expf(sg[i] - sg[j]) : 0.f;
        sA[i * 68 + j] = f2bf(val);
      }
    }
    __syncthreads();
    f32x16 ks0, ks1;
#pragma unroll
    for (int r = 0; r < 16; ++r) { ks0[r] = 0.f; ks1[r] = 0.f; }
    {
      const bf16_t* ka = sK + li * 136 + 4 * hh;
#define K_STEP(OFFS, SX, SS)                                                                           \
  {                                                                                                    \
    bf16x8 sb = pack8(SX, SS);                                                                         \
    ks0 = __builtin_amdgcn_mfma_f32_32x32x16_bf16(ld_perm(ka + (OFFS)), sb, ks0, 0, 0, 0);             \
    ks1 = __builtin_amdgcn_mfma_f32_32x32x16_bf16(ld_perm(ka + 32 * 136 + (OFFS)), sb, ks1, 0, 0, 0);  \
  }
      K_STEP(0, S0, 0) K_STEP(16, S0, 1) K_STEP(32, S1, 0) K_STEP(48, S1, 1)
      K_STEP(64, S2, 0) K_STEP(80, S2, 1) K_STEP(96, S3, 0) K_STEP(112, S3, 1)
#undef K_STEP
    }
#pragma unroll
    for (int r = 0; r < 16; ++r) {
      const int t0 = rowmap(r, hh), t1 = 32 + t0;
      v0[r] = sbt[t0] * (v0[r] - seg[t0] * ks0[r]);
      v1[r] = sbt[t1] * (v1[r] - seg[t1] * ks1[r]);
    }
    bf16x8 rb00 = pack8(v0, 0), rb01 = pack8(v0, 1), rb10 = pack8(v1, 0), rb11 = pack8(v1, 1);
    f32x16 n0, n1;
#pragma unroll
    for (int r = 0; r < 16; ++r) { n0[r] = 0.f; n1[r] = 0.f; }
    {
      const bf16_t* ta = sT + li * 68 + 4 * hh;
      n0 = __builtin_amdgcn_mfma_f32_32x32x16_bf16(ld_perm(ta + 0), rb00, n0, 0, 0, 0);
      n0 = __builtin_amdgcn_mfma_f32_32x32x16_bf16(ld_perm(ta + 16), rb01, n0, 0, 0, 0);
      const bf16_t* tb = ta + 32 * 68;
      n1 = __builtin_amdgcn_mfma_f32_32x32x16_bf16(ld_perm(tb + 0), rb00, n1, 0, 0, 0);
      n1 = __builtin_amdgcn_mfma_f32_32x32x16_bf16(ld_perm(tb + 16), rb01, n1, 0, 0, 0);
      n1 = __builtin_amdgcn_mfma_f32_32x32x16_bf16(ld_perm(tb + 32), rb10, n1, 0, 0, 0);
      n1 = __builtin_amdgcn_mfma_f32_32x32x16_bf16(ld_perm(tb + 48), rb11, n1, 0, 0, 0);
    }
    f32x16 o0, o1;
#pragma unroll
    for (int r = 0; r < 16; ++r) { o0[r] = 0.f; o1[r] = 0.f; }
    {
      const bf16_t* qa = sQ + li * 136 + 4 * hh;
#define Q_STEP(OFFS, SX, SS)                                                                           \
  {                                                                                                    \
    bf16x8 sb = pack8(SX, SS);                                                                         \
    o0 = __builtin_amdgcn_mfma_f32_32x32x16_bf16(ld_perm(qa + (OFFS)), sb, o0, 0, 0, 0);               \
    o1 = __builtin_amdgcn_mfma_f32_32x32x16_bf16(ld_perm(qa + 32 * 136 + (OFFS)), sb, o1, 0, 0, 0);    \
  }
      Q_STEP(0, S0, 0) Q_STEP(16, S0, 1) Q_STEP(32, S1, 0) Q_STEP(48, S1, 1)
      Q_STEP(64, S2, 0) Q_STEP(80, S2, 1) Q_STEP(96, S3, 0) Q_STEP(112, S3, 1)
#undef Q_STEP
    }
#pragma unroll
    for (int r = 0; r < 16; ++r) {
      const int t0 = rowmap(r, hh), t1 = 32 + t0;
      o0[r] *= seg[t0] * qscale;
      o1[r] *= seg[t1] * qscale;
    }
    {
      bf16x8 nb00 = pack8(n0, 0), nb01 = pack8(n0, 1), nb10 = pack8(n1, 0), nb11 = pack8(n1, 1);
      const bf16_t* aa = sA + li * 68 + 4 * hh;
      o0 = __builtin_amdgcn_mfma_f32_32x32x16_bf16(ld_perm(aa + 0), nb00, o0, 0, 0, 0);
      o0 = __builtin_amdgcn_mfma_f32_32x32x16_bf16(ld_perm(aa + 16), nb01, o0, 0, 0, 0);
      const bf16_t* ab = aa + 32 * 68;
      o1 = __builtin_amdgcn_mfma_f32_32x32x16_bf16(ld_perm(ab + 0), nb00, o1, 0, 0, 0);
      o1 = __builtin_amdgcn_mfma_f32_32x32x16_bf16(ld_perm(ab + 16), nb01, o1, 0, 0, 0);
      o1 = __builtin_amdgcn_mfma_f32_32x32x16_bf16(ld_perm(ab + 32), nb10, o1, 0, 0, 0);
      o1 = __builtin_amdgcn_mfma_f32_32x32x16_bf16(ld_perm(ab + 48), nb11, o1, 0, 0, 0);
    }
    __syncthreads();
#pragma unroll
    for (int r = 0; r < 16; ++r) {
      const int t0 = rowmap(r, hh);
      sQ[t0 * 136 + w * 32 + li] = f2bf(o0[r]);
      sQ[(32 + t0) * 136 + w * 32 + li] = f2bf(o1[r]);
    }
#pragma unroll
    for (int r = 0; r < 16; ++r) {
      const int t0 = rowmap(r, hh), t1 = 32 + t0;
      n0[r] *= sdt[t0];
      n1[r] *= sdt[t1];
    }
    {
      bf16x8 nb00 = pack8(n0, 0), nb01 = pack8(n0, 1), nb10 = pack8(n1, 0), nb11 = pack8(n1, 1);
      const float eg63 = seg[63];
#pragma unroll
      for (int r = 0; r < 16; ++r) { S0[r] *= eg63; S1[r] *= eg63; S2[r] *= eg63; S3[r] *= eg63; }
      SCAN_LOADS(min(n + 1, 35))
      const bf16_t* kt = sKT + li * 68 + 4 * hh;
#define S_UPD(SX, DKT)                                                                                   \
  SX = __builtin_amdgcn_mfma_f32_32x32x16_bf16(ld_perm(kt + (DKT) * 32 * 68 + 0), nb00, SX, 0, 0, 0);    \
  SX = __builtin_amdgcn_mfma_f32_32x32x16_bf16(ld_perm(kt + (DKT) * 32 * 68 + 16), nb01, SX, 0, 0, 0);   \
  SX = __builtin_amdgcn_mfma_f32_32x32x16_bf16(ld_perm(kt + (DKT) * 32 * 68 + 32), nb10, SX, 0, 0, 0);   \
  SX = __builtin_amdgcn_mfma_f32_32x32x16_bf16(ld_perm(kt + (DKT) * 32 * 68 + 48), nb11, SX, 0, 0, 0);
      S_UPD(S0, 0) S_UPD(S1, 1) S_UPD(S2, 2) S_UPD(S3, 3)
#undef S_UPD
    }
    __syncthreads();
    {
      bf16_t* obase = d ? (Pw + C_DN + h * 128) : (MIX + 512 + h * 128);
      const int ostride = d ? INWP : 1024;
#pragma unroll
      for (int e = 0; e < 4; ++e) {
        const int idx = tid + 256 * e, tok = idx >> 4, c8 = idx & 15;
        const int row = rstart + rsign * tok;
        *(uint4*)(obase + (size_t)row * ostride + c8 * 8) = *(const uint4*)(sQ + tok * 136 + c8 * 8);
      }
    }
  }
#undef SCAN_LOADS
#undef SCAN_ROW0
  __builtin_amdgcn_s_setprio(0);
}

__device__ void phaseC(const Params& p, int l, char* smem) {
  const int nb = gridDim.x, bid = blockIdx.x;
  const bf16_t* P = (const bf16_t*)(p.ws + OFF_P);
  constexpr int T0 = 1152, T1 = T0 + 144 * 3, T2 = T1 + 144 * 4, T3 = T2 + M_ALL / 8;
  for (int it = bid; it < T3; it += nb) {
    if (it < T0) {
      dn_chunk_prep(p, l, it, smem);
    } else if (it < T1) {
      int i = it - T0;
      if (l == 3 && i >= 128 * 3) continue;
      gemm_tile<EPI_QUP>(p, l, P + C_MQ, INWP, (const bf16_t*)(p.ws + OFF_WQUP), 256, (i / 3) * 128, (i % 3) * 128, 0,
                         smem);
    } else if (it < T2) {
      int i = it - T1;
      gemm_tile<EPI_KVUP>(p, l, P + C_MKV, INWP, (const bf16_t*)(p.ws + OFF_WKVUP), 128, (i / 4) * 128, (i % 4) * 128,
                          0, smem);
    } else {
      kpe_item(p, it - T2);
    }
  }
}

__device__ void mla_flash(const Params& p, int item, char* smem) {
  bf16_t* sK = (bf16_t*)smem;
  bf16_t* sV = sK + 64 * 104;
  const int tid = otid(), lane = tid & 63, w = tid >> 6;
  const int li = lane & 31, hh = lane >> 5;
  int b, h, q0row, nkeys;
  if (item < 512) {
    b = item >> 6; h = (item >> 4) & 3; q0row = b * 2048 + (item & 15) * 128; nkeys = 2304;
  } else {
    int i = item - 512;
    b = i >> 3; h = (i >> 1) & 3; q0row = M_LAT + b * 256 + (i & 1) * 128; nkeys = 256;
  }
  const bf16_t* Kg = (const bf16_t*)(p.ws + OFF_KH) + (size_t)(b * 4 + h) * 2304 * 96;
  const bf16_t* Vg = (const bf16_t*)(p.ws + OFF_VH) + (size_t)(b * 4 + h) * 64 * 2304;
  const bf16_t* QH = (const bf16_t*)(p.ws + OFF_QH);
  bf16_t* MIX = (bf16_t*)(p.ws + OFF_HM);
  const int qrow = q0row + w * 32 + li;
  bf16x8 qf0, qf1, qf2, qf3, qf4, qf5;
  {
    const bf16_t* qp = QH + (size_t)qrow * 384 + h * 96 + hh * 8;
    qf0 = *(const bf16x8*)(qp); qf1 = *(const bf16x8*)(qp + 16); qf2 = *(const bf16x8*)(qp + 32);
    qf3 = *(const bf16x8*)(qp + 48); qf4 = *(const bf16x8*)(qp + 64); qf5 = *(const bf16x8*)(qp + 80);
  }
  const int k_i0 = tid, k_i1 = tid + 256, k_i2 = tid + 512;
  const int kk0 = k_i0 / 12, kc0 = k_i0 % 12, kk1 = k_i1 / 12, kc1 = k_i1 % 12, kk2 = k_i2 / 12, kc2 = k_i2 % 12;
  const int vd0 = tid >> 3, vc0 = tid & 7, vd1 = vd0 + 32;
  uint4 rk0, rk1, rk2, rv0, rv1;
  rk0 = *(const uint4*)(Kg + (size_t)kk0 * 96 + kc0 * 8);
  rk1 = *(const uint4*)(Kg + (size_t)kk1 * 96 + kc1 * 8);
  rk2 = *(const uint4*)(Kg + (size_t)kk2 * 96 + kc2 * 8);
  rv0 = *(const uint4*)(Vg + (size_t)vd0 * 2304 + vc0 * 8);
  rv1 = *(const uint4*)(Vg + (size_t)vd1 * 2304 + vc0 * 8);
  f32x16 o0, o1;
#pragma unroll
  for (int r = 0; r < 16; ++r) { o0[r] = 0.f; o1[r] = 0.f; }
  float m = -1e30f, lp = 0.f;
  const float sc = 0.10206207261596577f * 1.4426950408889634f;
  const int nt = nkeys >> 6;
  for (int t = 0; t < nt; ++t) {
    __syncthreads();
    *(uint4*)(sK + kk0 * 104 + kc0 * 8) = rk0;
    *(uint4*)(sK + kk1 * 104 + kc1 * 8) = rk1;
    *(uint4*)(sK + kk2 * 104 + kc2 * 8) = rk2;
    *(uint2*)(sV + vd0 * 68 + vc0 * 8) = make_uint2(rv0.x, rv0.y);
    *(uint2*)(sV + vd0 * 68 + vc0 * 8 + 4) = make_uint2(rv0.z, rv0.w);
    *(uint2*)(sV + vd1 * 68 + vc0 * 8) = make_uint2(rv1.x, rv1.y);
    *(uint2*)(sV + vd1 * 68 + vc0 * 8 + 4) = make_uint2(rv1.z, rv1.w);
    __syncthreads();
    if (t + 1 < nt) {
      const int k0 = (t + 1) * 64;
      rk0 = *(const uint4*)(Kg + (size_t)(k0 + kk0) * 96 + kc0 * 8);
      rk1 = *(const uint4*)(Kg + (size_t)(k0 + kk1) * 96 + kc1 * 8);
      rk2 = *(const uint4*)(Kg + (size_t)(k0 + kk2) * 96 + kc2 * 8);
      rv0 = *(const uint4*)(Vg + (size_t)vd0 * 2304 + k0 + vc0 * 8);
      rv1 = *(const uint4*)(Vg + (size_t)vd1 * 2304 + k0 + vc0 * 8);
    }
    f32x16 s0, s1;
#pragma unroll
    for (int r = 0; r < 16; ++r) { s0[r] = 0.f; s1[r] = 0.f; }
    {
      const bf16_t* ka = sK + li * 104 + hh * 8;
      const bf16_t* kb = ka + 32 * 104;
      s0 = __builtin_amdgcn_mfma_f32_32x32x16_bf16(*(const bf16x8*)(ka), qf0, s0, 0, 0, 0);
      s1 = __builtin_amdgcn_mfma_f32_32x32x16_bf16(*(const bf16x8*)(kb), qf0, s1, 0, 0, 0);
      s0 = __builtin_amdgcn_mfma_f32_32x32x16_bf16(*(const bf16x8*)(ka + 16), qf1, s0, 0, 0, 0);
      s1 = __builtin_amdgcn_mfma_f32_32x32x16_bf16(*(const bf16x8*)(kb + 16), qf1, s1, 0, 0, 0);
      s0 = __builtin_amdgcn_mfma_f32_32x32x16_bf16(*(const bf16x8*)(ka + 32), qf2, s0, 0, 0, 0);
      s1 = __builtin_amdgcn_mfma_f32_32x32x16_bf16(*(const bf16x8*)(kb + 32), qf2, s1, 0, 0, 0);
      s0 = __builtin_amdgcn_mfma_f32_32x32x16_bf16(*(const bf16x8*)(ka + 48), qf3, s0, 0, 0, 0);
      s1 = __builtin_amdgcn_mfma_f32_32x32x16_bf16(*(const bf16x8*)(kb + 48), qf3, s1, 0, 0, 0);
      s0 = __builtin_amdgcn_mfma_f32_32x32x16_bf16(*(const bf16x8*)(ka + 64), qf4, s0, 0, 0, 0);
      s1 = __builtin_amdgcn_mfma_f32_32x32x16_bf16(*(const bf16x8*)(kb + 64), qf4, s1, 0, 0, 0);
      s0 = __builtin_amdgcn_mfma_f32_32x32x16_bf16(*(const bf16x8*)(ka + 80), qf5, s0, 0, 0, 0);
      s1 = __builtin_amdgcn_mfma_f32_32x32x16_bf16(*(const bf16x8*)(kb + 80), qf5, s1, 0, 0, 0);
    }
    float mx = s0[0];
#pragma unroll
    for (int r = 1; r < 16; ++r) mx = fmaxf(mx, s0[r]);
#pragma unroll
    for (int r = 0; r < 16; ++r) mx = fmaxf(mx, s1[r]);
    mx = fmaxf(mx, __shfl_xor(mx, 32));
    const float mn = fmaxf(m, mx * sc);
    const float corr = __builtin_amdgcn_exp2f(m - mn);
    m = mn;
    lp *= corr;
#pragma unroll
    for (int r = 0; r < 16; ++r) { o0[r] *= corr; o1[r] *= corr; }
#pragma unroll
    for (int r = 0; r < 16; ++r) {
      s0[r] = __builtin_amdgcn_exp2f(s0[r] * sc - mn);
      s1[r] = __builtin_amdgcn_exp2f(s1[r] * sc - mn);
      lp += s0[r] + s1[r];
    }
#pragma unroll
    for (int u = 0; u < 2; ++u) {
#pragma unroll
      for (int s = 0; s < 2; ++s) {
        union { bf16x8 v; unsigned w[4]; } pb;
        if (u == 0) {
          pb.w[0] = pack2(s0[8 * s + 0], s0[8 * s + 1]); pb.w[1] = pack2(s0[8 * s + 2], s0[8 * s + 3]);
          pb.w[2] = pack2(s0[8 * s + 4], s0[8 * s + 5]); pb.w[3] = pack2(s0[8 * s + 6], s0[8 * s + 7]);
        } else {
          pb.w[0] = pack2(s1[8 * s + 0], s1[8 * s + 1]); pb.w[1] = pack2(s1[8 * s + 2], s1[8 * s + 3]);
          pb.w[2] = pack2(s1[8 * s + 4], s1[8 * s + 5]); pb.w[3] = pack2(s1[8 * s + 6], s1[8 * s + 7]);
        }
        const bf16_t* va = sV + li * 68 + 32 * u + 16 * s + 4 * hh;
        union { bf16x8 v; uint2 d[2]; } a0, a1;
        a0.d[0] = *(const uint2*)(va);
        a0.d[1] = *(const uint2*)(va + 8);
        a1.d[0] = *(const uint2*)(va + 32 * 68);
        a1.d[1] = *(const uint2*)(va + 32 * 68 + 8);
        o0 = __builtin_amdgcn_mfma_f32_32x32x16_bf16(a0.v, pb.v, o0, 0, 0, 0);
        o1 = __builtin_amdgcn_mfma_f32_32x32x16_bf16(a1.v, pb.v, o1, 0, 0, 0);
      }
    }
  }
  lp += __shfl_xor(lp, 32);
  const float inv = 1.f / lp;
  bf16_t* op = MIX + (size_t)qrow * 1024 + h * 64 + 4 * hh;
#pragma unroll
  for (int g = 0; g < 4; ++g) {
    uint2 u0, u1;
    u0.x = pack2(o0[4 * g + 0] * inv, o0[4 * g + 1] * inv);
    u0.y = pack2(o0[4 * g + 2] * inv, o0[4 * g + 3] * inv);
    u1.x = pack2(o1[4 * g + 0] * inv, o1[4 * g + 1] * inv);
    u1.y = pack2(o1[4 * g + 2] * inv, o1[4 * g + 3] * inv);
    *(uint2*)(op + 8 * g) = u0;
    *(uint2*)(op + 32 + 8 * g) = u1;
  }
}

__device__ void na_naive(const Params& p, int l, int ti) {
  const int h = otid() >> 6, lane = otid() & 63;
  const bf16_t* P = (const bf16_t*)(p.ws + OFF_P);
  bf16_t* MIX = (bf16_t*)(p.ws + OFF_HM);
  const bool lat = ti < 256;
  const int b = lat ? (ti >> 5) : ((ti - 256) >> 2);
  const int r = ti & 31;
  const int row = lat ? (ti * 64 + lane) : (M_LAT + (ti - 256) * 64 + lane);
  uint4 qk[8];
  float acc[64];
  {
    const uint4* qp = (const uint4*)(P + (size_t)row * INWP + C_NQ + h * 64);
#pragma unroll
    for (int c = 0; c < 8; ++c) qk[c] = qp[c];
  }
#pragma unroll
  for (int i = 0; i < 64; ++i) acc[i] = 0.f;
  float m = -INFINITY, ls = 0.f;
  const int qc = lane;
  const int rs0 = min(max(r - 4, 0), 24);
  const int cs0 = min(max(qc - 8, 0), 48);
  const float* rb = p.rel_bias + (size_t)l * 4 * 15 * 31 + h * 15 * 31;
  const int nloc = lat ? 128 : 0;
  for (int j = 0; j < nloc + 256; ++j) {
    int krow;
    float bias = 0.f;
    if (j < nloc) {
      int kr = rs0 + (j >> 4), kc = cs0 + (j & 15);
      krow = b * 2048 + kr * 64 + kc;
      bias = rb[(kr - r + 7) * 31 + (kc - qc + 15)];
    } else {
      krow = M_LAT + b * 256 + (j - nloc);
    }
    const uint4* kp = (const uint4*)(P + (size_t)krow * INWP + C_NK + h * 64);
    float s = 0.f;
#pragma unroll
    for (int c = 0; c < 8; ++c) {
      uint4 u = kp[c];
      uint4 q = qk[c];
      s += bflo(q.x) * bflo(u.x) + bfhi(q.x) * bfhi(u.x) + bflo(q.y) * bflo(u.y) + bfhi(q.y) * bfhi(u.y) +
           bflo(q.z) * bflo(u.z) + bfhi(q.z) * bfhi(u.z) + bflo(q.w) * bflo(u.w) + bfhi(q.w) * bfhi(u.w);
    }
    s = s * 0.125f + bias;
    float mn = fmaxf(m, s);
    float corr = __expf(m - mn), pe = __expf(s - mn);
    ls = ls * corr + pe;
    m = mn;
    const uint4* vp = (const uint4*)(P + (size_t)krow * INWP + C_NV + h * 64);
#pragma unroll
    for (int c = 0; c < 8; ++c) {
      uint4 u = vp[c];
      acc[c * 8 + 0] = acc[c * 8 + 0] * corr + pe * bflo(u.x);
      acc[c * 8 + 1] = acc[c * 8 + 1] * corr + pe * bfhi(u.x);
      acc[c * 8 + 2] = acc[c * 8 + 2] * corr + pe * bflo(u.y);
      acc[c * 8 + 3] = acc[c * 8 + 3] * corr + pe * bfhi(u.y);
      acc[c * 8 + 4] = acc[c * 8 + 4] * corr + pe * bflo(u.z);
      acc[c * 8 + 5] = acc[c * 8 + 5] * corr + pe * bfhi(u.z);
      acc[c * 8 + 6] = acc[c * 8 + 6] * corr + pe * bflo(u.w);
      acc[c * 8 + 7] = acc[c * 8 + 7] * corr + pe * bfhi(u.w);
    }
  }
  const float inv = 1.f / ls;
  uint4* op = (uint4*)(MIX + (size_t)row * 1024 + 256 + h * 64);
#pragma unroll
  for (int c = 0; c < 8; ++c) {
    uint4 u;
    u.x = pack2(acc[c * 8 + 0] * inv, acc[c * 8 + 1] * inv);
    u.y = pack2(acc[c * 8 + 2] * inv, acc[c * 8 + 3] * inv);
    u.z = pack2(acc[c * 8 + 4] * inv, acc[c * 8 + 5] * inv);
    u.w = pack2(acc[c * 8 + 6] * inv, acc[c * 8 + 7] * inv);
    op[c] = u;
  }
}

__device__ void na_flash(const Params& p, int l, int item, char* smem) {
  bf16_t* sK = (bf16_t*)smem;
  bf16_t* sV = sK + 64 * 72;
  float* sBias = (float*)(smem + 18432);
  const int tid = otid(), lane = tid & 63, w = tid >> 6;
  const int li = lane & 31, hh = lane >> 5;
  const bf16_t* P = (const bf16_t*)(p.ws + OFF_P);
  bf16_t* MIX = (bf16_t*)(p.ws + OFF_HM);
  int b, h, qrow, qr = 0, qc = 0, rs0 = 0, ntiles, krow0 = 0;
  bool lat;
  if (item < 512) {
    lat = true;
    b = item >> 6; h = item & 3;
    const int r0 = ((item >> 2) & 15) * 2;
    qr = r0 + (w >> 1); qc = (w & 1) * 32 + li;
    qrow = b * 2048 + qr * 64 + qc;
    krow0 = min(max(r0 - 4, 0), 24);
    const int klast = min(max(r0 + 1 - 4, 0), 24) + 7;
    ntiles = 4 + (klast - krow0 + 1);
    rs0 = min(max(qr - 4, 0), 24);
  } else {
    lat = false;
    const int i = item - 512;
    b = i >> 3; h = i & 3;
    qrow = M_LAT + b * 256 + ((i >> 2) & 1) * 128 + w * 32 + li;
    ntiles = 4;
  }
  const int cs0 = min(max(qc - 8, 0), 48);
  const bf16_t* Vg = (const bf16_t*)(p.ws + OFF_NVT) + (size_t)(b * 4 + h) * 64 * 2304;
  bf16x8 qf0, qf1, qf2, qf3;
  {
    const bf16_t* qp = P + (size_t)qrow * INWP + C_NQ + h * 64 + hh * 8;
    qf0 = *(const bf16x8*)(qp); qf1 = *(const bf16x8*)(qp + 16); qf2 = *(const bf16x8*)(qp + 32); qf3 = *(const bf16x8*)(qp + 48);
  }
  __syncthreads();
  for (int i = tid; i < 465; i += 256)
    sBias[i] = p.rel_bias[(size_t)l * 4 * 465 + h * 465 + i] * 1.4426950408889634f;
  const int kk0 = tid >> 3, kc8 = tid & 7, kk1 = kk0 + 32;
  uint4 rk0, rk1, rv0, rv1;
  {
    const size_t kr = (size_t)(M_LAT + b * 256);
    rk0 = *(const uint4*)(P + (kr + kk0) * INWP + C_NK + h * 64 + kc8 * 8);
    rk1 = *(const uint4*)(P + (kr + kk1) * INWP + C_NK + h * 64 + kc8 * 8);
    rv0 = *(const uint4*)(Vg + (size_t)kk0 * 2304 + kc8 * 8);
    rv1 = *(const uint4*)(Vg + (size_t)kk1 * 2304 + kc8 * 8);
  }
  f32x16 o0, o1;
#pragma unroll
  for (int r = 0; r < 16; ++r) { o0[r] = 0.f; o1[r] = 0.f; }
  float m = -1e30f, lp = 0.f;
  const float sc = 0.125f * 1.4426950408889634f;
  for (int t = 0; t < ntiles; ++t) {
    __syncthreads();
    *(uint4*)(sK + kk0 * 72 + kc8 * 8) = rk0;
    *(uint4*)(sK + kk1 * 72 + kc8 * 8) = rk1;
    *(uint2*)(sV + kk0 * 68 + kc8 * 8) = make_uint2(rv0.x, rv0.y);
    *(uint2*)(sV + kk0 * 68 + kc8 * 8 + 4) = make_uint2(rv0.z, rv0.w);
    *(uint2*)(sV + kk1 * 68 + kc8 * 8) = make_uint2(rv1.x, rv1.y);
    *(uint2*)(sV + kk1 * 68 + kc8 * 8 + 4) = make_uint2(rv1.z, rv1.w);
    __syncthreads();
    if (t + 1 < ntiles) {
      const int tn = t + 1;
      size_t kr;
      int vk;
      if (tn < 4) { kr = (size_t)(M_LAT + b * 256 + tn * 64); vk = tn * 64; }
      else { kr = (size_t)(b * 2048 + (krow0 + tn - 4) * 64); vk = 256 + (krow0 + tn - 4) * 64; }
      rk0 = *(const uint4*)(P + (kr + kk0) * INWP + C_NK + h * 64 + kc8 * 8);
      rk1 = *(const uint4*)(P + (kr + kk1) * INWP + C_NK + h * 64 + kc8 * 8);
      rv0 = *(const uint4*)(Vg + (size_t)kk0 * 2304 + vk + kc8 * 8);
      rv1 = *(const uint4*)(Vg + (size_t)kk1 * 2304 + vk + kc8 * 8);
    }
    const int kr_abs = krow0 + t - 4;
    const bool local = t >= 4;
    if (local && (kr_abs < rs0 || kr_abs >= rs0 + 8)) continue;
    f32x16 s0, s1;
#pragma unroll
    for (int r = 0; r < 16; ++r) { s0[r] = 0.f; s1[r] = 0.f; }
    {
      const bf16_t* ka = sK + li * 72 + hh * 8;
      const bf16_t* kb = ka + 32 * 72;
      s0 = __builtin_amdgcn_mfma_f32_32x32x16_bf16(*(const bf16x8*)(ka), qf0, s0, 0, 0, 0);
      s1 = __builtin_amdgcn_mfma_f32_32x32x16_bf16(*(const bf16x8*)(kb), qf0, s1, 0, 0, 0);
      s0 = __builtin_amdgcn_mfma_f32_32x32x16_bf16(*(const bf16x8*)(ka + 16), qf1, s0, 0, 0, 0);
      s1 = __builtin_amdgcn_mfma_f32_32x32x16_bf16(*(const bf16x8*)(kb + 16), qf1, s1, 0, 0, 0);
      s0 = __builtin_amdgcn_mfma_f32_32x32x16_bf16(*(const bf16x8*)(ka + 32), qf2, s0, 0, 0, 0);
      s1 = __builtin_amdgcn_mfma_f32_32x32x16_bf16(*(const bf16x8*)(kb + 32), qf2, s1, 0, 0, 0);
      s0 = __builtin_amdgcn_mfma_f32_32x32x16_bf16(*(const bf16x8*)(ka + 48), qf3, s0, 0, 0, 0);
      s1 = __builtin_amdgcn_mfma_f32_32x32x16_bf16(*(const bf16x8*)(kb + 48), qf3, s1, 0, 0, 0);
    }
    if (local) {
      const float* bp = sBias + (kr_abs - qr + 7) * 31 - qc + 15;
#pragma unroll
      for (int r = 0; r < 16; ++r) {
        const int kc0 = rowmap(r, hh), kc1 = 32 + kc0;
        const bool v0 = (kc0 >= cs0) && (kc0 < cs0 + 16);
        const bool v1 = (kc1 >= cs0) && (kc1 < cs0 + 16);
        const float b0 = v0 ? bp[kc0] : 0.f;
        const float b1 = v1 ? bp[kc1] : 0.f;
        s0[r] = v0 ? (s0[r] * sc + b0) : -1e30f;
        s1[r] = v1 ? (s1[r] * sc + b1) : -1e30f;
      }
    } else {
#pragma unroll
      for (int r = 0; r < 16; ++r) { s0[r] *= sc; s1[r] *= sc; }
    }
    float mx = s0[0];
#pragma unroll
    for (int r = 1; r < 16; ++r) mx = fmaxf(mx, s0[r]);
#pragma unroll
    for (int r = 0; r < 16; ++r) mx = fmaxf(mx, s1[r]);
    mx = fmaxf(mx, __shfl_xor(mx, 32));
    const float mn = fmaxf(m, mx);
    const float corr = __builtin_amdgcn_exp2f(m - mn);
    m = mn;
    lp *= corr;
#pragma unroll
    for (int r = 0; r < 16; ++r) { o0[r] *= corr; o1[r] *= corr; }
#pragma unroll
    for (int r = 0; r < 16; ++r) {
      s0[r] = __builtin_amdgcn_exp2f(s0[r] - mn);
      s1[r] = __builtin_amdgcn_exp2f(s1[r] - mn);
      lp += s0[r] + s1[r];
    }
#pragma unroll
    for (int u = 0; u < 2; ++u) {
#pragma unroll
      for (int s = 0; s < 2; ++s) {
        bf16x8 pb = u == 0 ? pack8(s0, s) : pack8(s1, s);
        const bf16_t* va = sV + li * 68 + 32 * u + 16 * s + 4 * hh;
        o0 = __builtin_amdgcn_mfma_f32_32x32x16_bf16(ld_perm(va), pb, o0, 0, 0, 0);
        o1 = __builtin_amdgcn_mfma_f32_32x32x16_bf16(ld_perm(va + 32 * 68), pb, o1, 0, 0, 0);
      }
    }
  }
  lp += __shfl_xor(lp, 32);
  const float inv = 1.f / lp;
  bf16_t* op = MIX + (size_t)qrow * 1024 + 256 + h * 64 + 4 * hh;
#pragma unroll
  for (int g = 0; g < 4; ++g) {
    uint2 u0, u1;
    u0.x = pack2(o0[4 * g + 0] * inv, o0[4 * g + 1] * inv);
    u0.y = pack2(o0[4 * g + 2] * inv, o0[4 * g + 3] * inv);
    u1.x = pack2(o1[4 * g + 0] * inv, o1[4 * g + 1] * inv);
    u1.y = pack2(o1[4 * g + 2] * inv, o1[4 * g + 3] * inv);
    *(uint2*)(op + 8 * g) = u0;
    *(uint2*)(op + 32 + 8 * g) = u1;
  }
}

DEVI int dn_rowof(int s, int b, int d) {
  if (s < 256) {
    int c = d ? (255 - s) : s;
    return M_LAT + b * 256 + c;
  }
  int t = s - 256;
  t = d ? (2047 - t) : t;
  return b * 2048 + t;
}

__device__ void dn_naive(const Params& p, int l, int it, char* smem) {
  float* ks = (float*)smem;
  float* qs = ks + 32 * 128;
  float* vs = qs + 32 * 128;
  float* gs = vs + 32 * 64;
  float* bs = gs + 32;
  const int half = it & 1, d = (it >> 1) & 1, h = (it >> 2) & 3, b = it >> 4;
  const int tid = otid(), w = tid >> 6, lane = tid & 63, c = lane & 15, kg = lane >> 4;
  const int col = half * 64 + w * 16 + c;
  const bf16_t* DQ = (const bf16_t*)(p.ws + OFF_DNQKV);
  const float* AB = (const float*)(p.ws + OFF_AB);
  bf16_t* MIX = (bf16_t*)(p.ws + OFF_HM);
  bf16_t* OB = (bf16_t*)(p.ws + OFF_OB);
  float S[32];
#pragma unroll
  for (int i = 0; i < 32; ++i) S[i] = 0.f;
  const float Aneg = -__expf(p.a_log[l * 8 + d * 4 + h]);
  const float dtb = p.dt_bias[l * 8 + d * 4 + h];
  for (int s0 = 0; s0 < 2304; s0 += 32) {
    __syncthreads();
    for (int i = tid; i < 32 * 128; i += 256) {
      int tk = i >> 7, ch = i & 127;
      int row = dn_rowof(s0 + tk, b, d);
      qs[i] = bf2f(DQ[(size_t)row * 1536 + h * 128 + ch]);
      ks[i] = bf2f(DQ[(size_t)row * 1536 + 512 + h * 128 + ch]);
    }
    for (int i = tid; i < 32 * 64; i += 256) {
      int tk = i >> 6, ch = i & 63;
      int row = dn_rowof(s0 + tk, b, d);
      vs[i] = bf2f(DQ[(size_t)row * 1536 + 1024 + h * 128 + half * 64 + ch]);
    }
    if (tid < 32) {
      int row = dn_rowof(s0 + tid, b, d);
      float a = AB[(size_t)row * 16 + d * 4 + h];
      float bb = AB[(size_t)row * 16 + 8 + d * 4 + h];
      float xx = a + dtb;
      const float ee = __expf(xx);
    float sp = ee < 0.25f ? ee * (1.f - ee * (0.5f - ee * (0.33333333f - ee * (0.25f - 0.2f * ee))))
                          : (xx > 20.f ? xx : __logf(1.f + ee));
      gs[tid] = __expf(Aneg * sp);
      bs[tid] = 1.f / (1.f + __expf(-bb));
    }
    __syncthreads();
    for (int tk = 0; tk < 32; ++tk) {
      const float eg = gs[tk], beta = bs[tk];
      const float vv = vs[tk * 64 + w * 16 + c];
      const float4* k4 = (const float4*)(ks + tk * 128 + kg * 32);
      const float4* q4 = (const float4*)(qs + tk * 128 + kg * 32);
      float part = 0.f;
#pragma unroll
      for (int i = 0; i < 8; ++i) {
        float4 kk = k4[i];
        S[4 * i + 0] *= eg; S[4 * i + 1] *= eg; S[4 * i + 2] *= eg; S[4 * i + 3] *= eg;
        part += kk.x * S[4 * i + 0] + kk.y * S[4 * i + 1] + kk.z * S[4 * i + 2] + kk.w * S[4 * i + 3];
      }
      part += __shfl_xor(part, 16);
      part += __shfl_xor(part, 32);
      const float delta = beta * (vv - part);
      float po = 0.f;
#pragma unroll
      for (int i = 0; i < 8; ++i) {
        float4 kk = k4[i];
        float4 qq = q4[i];
        S[4 * i + 0] += kk.x * delta; S[4 * i + 1] += kk.y * delta; S[4 * i + 2] += kk.z * delta; S[4 * i + 3] += kk.w * delta;
        po += qq.x * S[4 * i + 0] + qq.y * S[4 * i + 1] + qq.z * S[4 * i + 2] + qq.w * S[4 * i + 3];
      }
      po += __shfl_xor(po, 16);
      po += __shfl_xor(po, 32);
      if (kg == 0) {
        int row = dn_rowof(s0 + tk, b, d);
        float o = po * 0.08838834764831845f;
        if (d == 0)
          MIX[(size_t)row * 1024 + 512 + h * 128 + col] = f2bf(o);
        else
          OB[(size_t)row * 512 + h * 128 + col] = f2bf(o);
      }
    }
  }
}

__device__ void phaseD(const Params& p, int l, char* smem) {
  const int nb = gridDim.x, bid = blockIdx.x;
  if (bid < 64) {
    dn_scan(p, l, bid, smem);
    return;
  }
  if (bid >= 256 && bid < 320) return;
  const int nb2 = nb - 128;
  const int wid = bid < 256 ? bid - 64 : bid - 128;
  const int n_early = l < 3 ? N_CONV_EARLY : 0;
  for (int it = wid; it < 1152 + N_CONV_LATE + n_early; it += nb2) {
    if (it < 576) {
      int item = it;
      if (it < 512) item = ((it & 7) * 64) + (it >> 3);
      else if (l == 3) continue;
      mla_flash(p, item, smem);
    } else if (it < 1152) {
      if (l == 3 && it - 576 >= 512) continue;
      na_flash(p, l, it - 576, smem);
    } else if (it < 1152 + N_CONV_LATE) {
      conv_item_late(p, l, it - 1152, (float*)smem);
    } else {
      conv_item_early(p, l + 1, it - 1152 - N_CONV_LATE, (float*)smem);
    }
  }
}

__device__ void outgate_item(const Params& p, int l, int item) {
  const int w = otid() >> 6, lane = otid() & 63;
  const int row = item * 4 + w;
  const bf16_t* P = (const bf16_t*)(p.ws + OFF_P);
  bf16_t* MIX = (bf16_t*)(p.ws + OFF_HM);
  const int h = lane >> 4, cb = (lane & 15) * 8;
  uint4 uo = *(const uint4*)(MIX + (size_t)row * 1024 + 512 + h * 128 + cb);
  uint4 ub = *(const uint4*)(P + (size_t)row * INWP + C_DN + h * 128 + cb);
  uint4 uz = *(const uint4*)(P + (size_t)row * INWP + C_DZ + h * 128 + cb);
  float o[8], z[8];
  o[0] = bflo(uo.x) + bflo(ub.x); o[1] = bfhi(uo.x) + bfhi(ub.x); o[2] = bflo(uo.y) + bflo(ub.y); o[3] = bfhi(uo.y) + bfhi(ub.y);
  o[4] = bflo(uo.z) + bflo(ub.z); o[5] = bfhi(uo.z) + bfhi(ub.z); o[6] = bflo(uo.w) + bflo(ub.w); o[7] = bfhi(uo.w) + bfhi(ub.w);
  z[0] = bflo(uz.x); z[1] = bfhi(uz.x); z[2] = bflo(uz.y); z[3] = bfhi(uz.y);
  z[4] = bflo(uz.z); z[5] = bfhi(uz.z); z[6] = bflo(uz.w); z[7] = bfhi(uz.w);
  float ss = 0.f;
#pragma unroll
  for (int e = 0; e < 8; ++e) ss += o[e] * o[e];
  ss += __shfl_xor(ss, 1);
  ss += __shfl_xor(ss, 2);
  ss += __shfl_xor(ss, 4);
  ss += __shfl_xor(ss, 8);
  const float r = rsqrtf(ss * (1.f / 128.f) + 1e-6f);
  const float* go = p.g_out + l * 128 + cb;
  float y[8];
#pragma unroll
  for (int e = 0; e < 8; ++e) y[e] = o[e] * r * go[e] * silu_f(z[e]);
  uint4 u;
  u.x = pack2(y[0], y[1]); u.y = pack2(y[2], y[3]); u.z = pack2(y[4], y[5]); u.w = pack2(y[6], y[7]);
  *(uint4*)(MIX + (size_t)row * 1024 + 512 + h * 128 + cb) = u;
}

__device__ void final_item(const Params& p, int item) {
  const int w = otid() >> 6, lane = otid() & 63;
  const int row = item * 4 + w;
  const float4* xr = (const float4*)((const float*)(p.ws + OFF_X) + (size_t)row * 1024);
  float4 v[4];
  float ss = 0.f;
#pragma unroll
  for (int i = 0; i < 4; ++i) {
    v[i] = xr[lane + 64 * i];
    ss += v[i].x * v[i].x + v[i].y * v[i].y + v[i].z * v[i].z + v[i].w * v[i].w;
  }
  ss = wave_sum(ss);
  const float r = rsqrtf(ss * (1.f / 1024.f) + 1e-6f);
  const float4* g4 = (const float4*)p.g_final;
  float4* o4 = (float4*)(p.out + (size_t)row * 1024);
#pragma unroll
  for (int i = 0; i < 4; ++i) {
    float4 gg = g4[lane + 64 * i];
    float4 y;
    y.x = v[i].x * r * gg.x; y.y = v[i].y * r * gg.y; y.z = v[i].z * r * gg.z; y.w = v[i].w * r * gg.w;
    o4[lane + 64 * i] = y;
  }
}

constexpr int N_PHASES = 1 + 9 * 4 + 1;

__global__ void __launch_bounds__(256, 2) mega(Params p) {
  __shared__ __attribute__((aligned(16))) char smem[SMEM_BYTES];
  cg::grid_group grid = cg::this_grid();
  const int nb = gridDim.x, bid = blockIdx.x;
  __shared__ uint4 xb_words;
  if (threadIdx.x == 0) xb_words = make_uint4(0u, 0u, 0u, 0u);
  __syncthreads();
  XcdBarrier xb = xcd_barrier_post((unsigned*)(p.ws + OFF_BAR), (volatile LAS unsigned*)&xb_words);
#ifdef PROBE_S
  bool again = false;
#endif
  for (int ph = p.ph_lo; ph < p.ph_hi; ++ph) {
    if (ph == 0) {
      phase0(p, smem);
    } else if (ph == N_PHASES - 1) {
      for (int it = bid; it < M_LAT / 4; it += nb) final_item(p, it);
    } else {
      const int l = (ph - 1) / 9, s = (ph - 1) % 9;
      if (s == 0) {
        phaseA(p, l, smem);
      } else if (s == 1) {
        for (int it = bid; it < 144 * 13; it += nb) {
          int mt, nt;
          tile_map(it, 13, mt, nt);
          gemm_wide<EPI_P>(p, l, (const bf16_t*)(p.ws + OFF_HM), 1024, (const bf16_t*)(p.ws + OFF_WIN), 1024,
                           mt * 128, nt * 256, 0, smem);
        }
      } else if (s == 2) {
        phaseC(p, l, smem);
      } else if (s == 3) {
        phaseD(p, l, smem);
      } else if (s == 4) {
        for (int it = bid; it < (l == 3 ? M_LAT : M_ALL) / 4; it += nb) outgate_item(p, l, it);
      } else if (s == 5) {
        const int mpx = l == 3 ? 16 : 18;
        for (int it = bid; it < 8 * mpx * 8; it += nb) {
          int mt, nt;
          tile_map(it, 8, mt, nt, mpx);
          gemm_tile<EPI_RES>(p, l, (const bf16_t*)(p.ws + OFF_HM), 1024, (const bf16_t*)(p.ws + OFF_WOUT), 1024,
                             mt * 128, nt * 128, 2, smem);
        }
      } else if (s == 6) {
        for (int it = bid; it < (l == 3 ? M_LAT : M_ALL) / 4; it += nb)
          norm_rows(p, false, (bf16_t*)(p.ws + OFF_HM), p.g_ffn + l * 1024,
                    (const float*)(p.ws + OFF_MOD) + (size_t)l * 9 * 6144, 3, 4, it);
      } else if (s == 7) {
        const int mpx = l == 3 ? 16 : 18;
        for (int it = bid; it < 8 * mpx * 22; it += nb) {
          int mt, nt;
          tile_map(it, 22, mt, nt, mpx);
          gemm_wide<EPI_GU>(p, l, (const bf16_t*)(p.ws + OFF_HM), 1024, (const bf16_t*)(p.ws + OFF_WGU), 1024,
                            mt * 128, nt * 256, 0, smem);
        }
      } else {
        const int mpx = l == 3 ? 16 : 18;
        for (int it = bid; it < 8 * mpx * 8; it += nb) {
          int mt, nt;
          tile_map(it, 8, mt, nt, mpx);
          gemm_tile<EPI_RES>(p, l, (const bf16_t*)(p.ws + OFF_P), FFN, (const bf16_t*)(p.ws + OFF_WDN), FFN,
                             mt * 128, nt * 128, 5, smem);
        }
      }
    }
#ifdef PROBE_S
    {
      const bool hit = (PROBE_S == 9) ? (ph == 0) : (ph != 0 && ph != N_PHASES - 1 && ((ph - 1) % 9) == PROBE_S);
      if (hit && !again) {
        again = true;
        if (p.use_cg) grid.sync(); else xcd_barrier(xb);
        --ph;
        continue;
      }
      again = false;
    }
#endif
    if (ph + 1 < p.ph_hi) {
      if (p.use_cg) grid.sync();
      else xcd_barrier(xb);
    }
  }
}

extern "C" void kernel_launch(void* const* d_in, const int* in_sizes, int n_in, void* d_out, int out_size, void* d_ws,
                              size_t ws_size, hipStream_t stream) {
  static int grid_blocks = 0;
  if (!grid_blocks) {
    int dev = 0, cus = 0, per_cu = 0;
    hipGetDevice(&dev);
    hipDeviceGetAttribute(&cus, hipDeviceAttributeMultiprocessorCount, dev);
    hipOccupancyMaxActiveBlocksPerMultiprocessor(&per_cu, mega, 256, 0);
    if (per_cu < 1) per_cu = 1;
    if (per_cu > 2) per_cu = 2;
    grid_blocks = cus * per_cu;
  }
  Params p{};
  const float** pp = (const float**)&p;
  for (int i = 0; i < 23; ++i) pp[i] = (const float*)d_in[i];
  p.out = (float*)d_out;
  p.ws = (char*)d_ws;
  p.ph_lo = 0;
  p.ph_hi = N_PHASES;
  p.use_cg = 0;
  p.pad0 = 0;
  hipMemsetAsync((char*)d_ws + OFF_BAR, 0, XCD_BAR_WORDS * sizeof(unsigned), stream);
  void* args[] = {&p};
  hipError_t e = hipLaunchCooperativeKernel((void*)mega, dim3(grid_blocks), dim3(256), args, 0, stream);
  if (e != hipSuccess) {
    fprintf(stderr, "cooperative launch failed: %s (grid %d)\n", hipGetErrorString(e), grid_blocks);
    (void)hipGetLastError();
    for (int ph = 0; ph < N_PHASES; ++ph) {
      p.ph_lo = ph;
      p.ph_hi = ph + 1;
      hipLaunchKernelGGL(mega, dim3(grid_blocks), dim3(256), 0, stream, p);
    }
  }
}
```

```cpp
#include <hip/hip_runtime.h>
#include <hip/hip_bf16.h>
#include <hip/hip_cooperative_groups.h>
#include <cstdio>
namespace cg = cooperative_groups;

#define DEVI __device__ __forceinline__
typedef unsigned short bf16_t;
typedef short bf16x8 __attribute__((ext_vector_type(8)));
typedef float f32x16 __attribute__((ext_vector_type(16)));

constexpr int M_LAT = 16384, M_CTX = 2048, M_ALL = 18432;
constexpr int DM = 1024, INW = 3248, INWP = 3328, FFN = 2816;
constexpr int C_MQ = 0, C_MKV = 256, C_MPE = 384, C_NQ = 416, C_NK = 672, C_NV = 928, C_DN = 1184;
constexpr int C_DZ = C_DN + 1536, C_DA = C_DN + 2048;

constexpr size_t OFF_WIN = 0;
constexpr size_t OFF_WOUT = OFF_WIN + (size_t)INWP * 1024 * 2;
constexpr size_t OFF_WGU = OFF_WOUT + (size_t)1024 * 1024 * 2;
constexpr size_t OFF_WDN = OFF_WGU + (size_t)2 * FFN * 1024 * 2;
constexpr size_t OFF_WQUP = OFF_WDN + (size_t)1024 * FFN * 2;
constexpr size_t OFF_WKVUP = OFF_WQUP + (size_t)384 * 256 * 2;
constexpr size_t OFF_MOD = OFF_WKVUP + (size_t)512 * 128 * 2;
constexpr size_t OFF_ROPE = OFF_MOD + (size_t)4 * 9 * 6144 * 4;
constexpr size_t OFF_X = OFF_ROPE + (size_t)2048 * 16 * 2 * 4;
constexpr size_t OFF_HM = OFF_X + (size_t)M_ALL * 1024 * 4;
constexpr size_t OFF_P = OFF_HM + (size_t)M_ALL * 1024 * 2;
constexpr size_t OFF_QH = OFF_P + (size_t)M_ALL * INWP * 2;
constexpr size_t OFF_KH = OFF_QH + (size_t)M_ALL * 384 * 2;
constexpr size_t OFF_VH = OFF_KH + (size_t)M_ALL * 384 * 2;
constexpr size_t OFF_DNQKV = OFF_VH + (size_t)M_ALL * 256 * 2;
constexpr size_t OFF_OB = OFF_DNQKV + (size_t)M_ALL * 1536 * 2;
constexpr size_t OFF_AB = OFF_OB + (size_t)M_ALL * 512 * 2;
constexpr size_t OFF_GC = OFF_AB + (size_t)M_ALL * 16 * 4;
constexpr size_t OFF_BETA = OFF_GC + (size_t)M_ALL * 8 * 4;
constexpr size_t OFF_NVT = OFF_BETA + (size_t)M_ALL * 8 * 4;
constexpr size_t WS_TOTAL = OFF_NVT + (size_t)M_ALL * 256 * 2;
constexpr int SMEM_BYTES = 74240;
constexpr size_t OFF_BAR = (WS_TOTAL + 255) & ~(size_t)255;

struct Params {
  const float *x, *c, *ctx, *c_ctx, *w_ada, *b_ada, *g_mix, *w_in, *g_q, *g_kv, *w_qup, *w_kvup, *rel_bias,
      *conv_w, *a_log, *dt_bias, *g_out, *w_out, *g_ffn, *w_gate, *w_up, *w_down, *g_final;
  float* out;
  char* ws;
  int ph_lo, ph_hi;
  int use_cg, pad0;
};

DEVI bf16_t f2bf(float f) {
  __bf16 r = (__bf16)f;
  return __builtin_bit_cast(unsigned short, r);
}
DEVI int otid() {
  int t = threadIdx.x;
  asm volatile("" : "+v"(t));
  return t;
}
DEVI float bf2f(bf16_t h) { return __uint_as_float(((unsigned)h) << 16); }
DEVI float bflo(unsigned u) { return __uint_as_float(u << 16); }
DEVI float bfhi(unsigned u) { return __uint_as_float(u & 0xffff0000u); }
typedef __bf16 bf16v2_t __attribute__((ext_vector_type(2)));
typedef float f32v2_t __attribute__((ext_vector_type(2)));
DEVI unsigned pack2(float a, float b) {
  f32v2_t v = {a, b};
  bf16v2_t r = __builtin_convertvector(v, bf16v2_t);
  return __builtin_bit_cast(unsigned, r);
}
DEVI float silu_f(float x) { return x / (1.f + __expf(-x)); }
DEVI float wave_sum(float v) {
#pragma unroll
  for (int o = 32; o >= 1; o >>= 1) v += __shfl_xor(v, o);
  return v;
}

#define XB_TMO 128
#define XB_XCNT(j) (256 + 64 * (j))
#define XB_XSUB(j) (1280 + 64 * (j))
#define XB_XGEN(j) (2304 + 64 * (j))
#define XB_TOP 3328
#define XB_TOPGEN 3392
#define XCD_BAR_WORDS 3456
#define XB_SPIN_CAP (1u << 22)
#define LAS __attribute__((address_space(3)))
DEVI unsigned xb_ld(unsigned* p) { return __hip_atomic_load(p, __ATOMIC_RELAXED, __HIP_MEMORY_SCOPE_AGENT); }
DEVI unsigned xb_add(unsigned* p, unsigned v) { return __hip_atomic_fetch_add(p, v, __ATOMIC_RELAXED, __HIP_MEMORY_SCOPE_AGENT); }
DEVI unsigned xb_xcc_id() { return (unsigned)__builtin_amdgcn_s_getreg((3 << 11) | 20) & 0xFu; }
#define XB_SPIN(cond, bar)                                                     \
  do {                                                                         \
    unsigned _sp = 0;                                                          \
    while (cond) {                                                             \
      __builtin_amdgcn_s_sleep(1);                                             \
      if ((++_sp & 255u) == 0u) {                                              \
        if (xb_ld(&(bar)[XB_TMO])) break;                                      \
        if (_sp > XB_SPIN_CAP) { atomicAdd(&(bar)[XB_TMO], 1u); break; }       \
      }                                                                        \
    }                                                                          \
  } while (0)
struct XcdBarrier {
  unsigned* bar;
  unsigned x;
  volatile LAS unsigned* st;
};
DEVI XcdBarrier xcd_barrier_post(unsigned* bar, volatile LAS unsigned* st) {
  XcdBarrier b;
  b.bar = bar;
  b.x = xb_xcc_id();
  b.st = st;
  if (threadIdx.x == 0) (void)xb_add(&bar[XB_XCNT(b.x)], 1u);
  return b;
}
DEVI void xcd_barrier_complete(unsigned* bar, unsigned x, unsigned& nloc, unsigned& nx) {
  const unsigned G = gridDim.x * gridDim.y * gridDim.z;
  unsigned sum, cnt, mine, sp = 0u;
  for (;;) {
    sum = 0u; cnt = 0u; mine = 0u;
#pragma unroll
    for (unsigned j = 0; j < 16; ++j) {
      const unsigned c = xb_ld(&bar[XB_XCNT(j)]);
      sum += c;
      cnt += (c > 0u) ? 1u : 0u;
      mine = (j == x) ? c : mine;
    }
    if (sum == G) break;
    __builtin_amdgcn_s_sleep(1);
    if ((++sp & 255u) == 0u) {
      if (xb_ld(&bar[XB_TMO])) break;
      if (sp > XB_SPIN_CAP) { atomicAdd(&bar[XB_TMO], 1u); break; }
    }
  }
  nloc = mine > 0u ? mine : 1u;
  nx = cnt > 0u ? cnt : 1u;
}
DEVI void xcd_barrier(const XcdBarrier& b) {
  asm volatile("s_waitcnt vmcnt(0)" ::: "memory");
  __syncthreads();
  if (threadIdx.x == 0) {
    unsigned* bar = b.bar;
    __builtin_amdgcn_s_waitcnt(0);
    unsigned nloc = b.st[0], nx = b.st[1];
    if (nloc == 0u) {
      xcd_barrier_complete(bar, b.x, nloc, nx);
      b.st[0] = nloc;
      b.st[1] = nx;
    }
    const unsigned old = xb_add(&bar[XB_XSUB(b.x)], 1u);
    const unsigned gen = old / nloc;
    if (old + 1u == (gen + 1u) * nloc) {
      __builtin_amdgcn_fence(__ATOMIC_RELEASE, "agent");
      asm volatile("s_waitcnt vmcnt(0)" ::: "memory");
      const unsigned og = xb_add(&bar[XB_TOP], 1u);
      const unsigned tg = og / nx;
      if (og + 1u == (tg + 1u) * nx) xb_add(&bar[XB_TOPGEN], 1u);
      else XB_SPIN(xb_ld(&bar[XB_TOPGEN]) == tg, bar);
      __builtin_amdgcn_fence(__ATOMIC_ACQUIRE, "agent");
      xb_add(&bar[XB_XGEN(b.x)], 1u);
      asm volatile("s_waitcnt vmcnt(0)" ::: "memory");
    } else {
      XB_SPIN(xb_ld(&bar[XB_XGEN(b.x)]) == gen, bar);
      __builtin_amdgcn_fence(__ATOMIC_ACQUIRE, "agent");
      asm volatile("s_waitcnt vmcnt(0)" ::: "memory");
    }
  }
  __syncthreads();
}

constexpr int N_CONV_EARLY = 16 * 52 + 24 + 16;
__device__ void conv_item_early(const Params& p, int l, int it, float* tl);

__device__ void phase0(const Params& p, char* smem) {
  const int tid = otid(), nb = gridDim.x, bid = blockIdx.x;
  {
    float* rc = (float*)(p.ws + OFF_ROPE);
    float* rs = rc + 2048 * 16;
    for (int i = bid * 256 + tid; i < 2048 * 16; i += nb * 256) {
      int t = i >> 4, a = (i >> 3) & 1, j = i & 7;
      float pos = a ? (float)(t & 63) : (float)(t >> 6);
      float inv = __builtin_amdgcn_exp2f(-(float)j * (13.287712379549449f / 8.f));
      float ang = pos * inv;
      rc[i] = cosf(ang);
      rs[i] = sinf(ang);
    }
  }
  for (int it = bid; it < N_CONV_EARLY; it += nb) conv_item_early(p, 0, it, (float*)smem);
  __syncthreads();
  float* sc = (float*)smem;
  float* red = sc + 1024 * 12;
  float* MOD = (float*)(p.ws + OFF_MOD);
  bool loaded = false;
  for (int it = bid; it < 4 * 96; it += nb) {
    if (!loaded) {
      for (int i = tid; i < 9 * 1024; i += 256) {
        float v = i < 8192 ? p.c[i] : p.c_ctx[i - 8192];
        sc[(i & 1023) * 12 + (i >> 10)] = silu_f(v);
      }
      __syncthreads();
      loaded = true;
    }
    const int l = it / 96, n0 = (it % 96) * 64;
    const int cc = tid & 63, kg = tid >> 6;
    const float* w = p.w_ada + (size_t)l * 1024 * 6144 + n0 + cc;
    float acc[9];
#pragma unroll
    for (int b = 0; b < 9; ++b) acc[b] = 0.f;
    for (int k0 = kg * 256; k0 < kg * 256 + 256; k0 += 16) {
      float wvv[16];
#pragma unroll
      for (int j = 0; j < 16; ++j) wvv[j] = w[(size_t)(k0 + j) * 6144];
#pragma unroll
      for (int j = 0; j < 16; ++j) {
      const int k = k0 + j;
      const float wv = wvv[j];
      const float4 s0 = *(const float4*)(sc + k * 12);
      const float4 s1 = *(const float4*)(sc + k * 12 + 4);
      const float s2 = sc[k * 12 + 8];
      acc[0] += s0.x * wv; acc[1] += s0.y * wv; acc[2] += s0.z * wv; acc[3] += s0.w * wv;
      acc[4] += s1.x * wv; acc[5] += s1.y * wv; acc[6] += s1.z * wv; acc[7] += s1.w * wv;
      acc[8] += s2 * wv;
      }
    }
#pragma unroll
    for (int b = 0; b < 9; ++b) red[(kg * 9 + b) * 64 + cc] = acc[b];
    __syncthreads();
    for (int i = tid; i < 9 * 64; i += 256) {
      int b = i >> 6, c2 = i & 63;
      float s = red[(0 * 9 + b) * 64 + c2] + red[(1 * 9 + b) * 64 + c2] + red[(2 * 9 + b) * 64 + c2] +
                red[(3 * 9 + b) * 64 + c2];
      MOD[(size_t)(l * 9 + b) * 6144 + n0 + c2] = s + p.b_ada[l * 6144 + n0 + c2];
    }
    __syncthreads();
  }
}

__device__ void convT_tile(const float* __restrict__ src, int K, int N, bf16_t* __restrict__ dst, int mode,
                           const float* __restrict__ gs, int kt, int nt, float* tl) {
  const int tid = otid();
  const int k0 = kt * 64, n0 = nt * 64;
  __syncthreads();
#pragma unroll 4
  for (int i = 0; i < 16; ++i) {
    int kk = i * 4 + (tid >> 6), nn = tid & 63;
    float v = 0.f;
    if (n0 + nn < N) v = src[(size_t)(k0 + kk) * N + n0 + nn];
    if (gs) v *= gs[k0 + kk];
    tl[kk * 65 + nn] = v;
  }
  __syncthreads();
#pragma unroll 2
  for (int i = 0; i < 8; ++i) {
    int nn = i * 8 + (tid >> 5), kk = (tid & 31) * 2;
    unsigned pk = pack2(tl[kk * 65 + nn], tl[(kk + 1) * 65 + nn]);
    int n = n0 + nn;
    int drow = mode == 0 ? n : ((n >> 5) * 64 + (n & 31) + (mode == 2 ? 32 : 0));
    *(unsigned*)(dst + (size_t)drow * K + k0 + kk) = pk;
  }
}

__device__ void norm_rows(const Params& p, bool from_input, bf16_t* __restrict__ H, const float* __restrict__ g,
                          const float* __restrict__ modl, int shift_i, int scale_i, int item) {
  const int w = otid() >> 6, lane = otid() & 63;
  const int row = item * 4 + w;
  const float* xsrc = from_input ? (row < M_LAT ? p.x + (size_t)row * 1024 : p.ctx + (size_t)(row - M_LAT) * 1024)
                                 : (const float*)(p.ws + OFF_X) + (size_t)row * 1024;
  const float4* xr = (const float4*)xsrc;
  float4 v[4];
  float ss = 0.f;
#pragma unroll
  for (int i = 0; i < 4; ++i) {
    v[i] = xr[lane + 64 * i];
    ss += v[i].x * v[i].x + v[i].y * v[i].y + v[i].z * v[i].z + v[i].w * v[i].w;
  }
  ss = wave_sum(ss);
  const float r = rsqrtf(ss * (1.f / 1024.f) + 1e-6f);
  const int b = row < M_LAT ? (row >> 11) : 8;
  const float4* sh = (const float4*)(modl + b * 6144 + shift_i * 1024);
  const float4* sl = (const float4*)(modl + b * 6144 + scale_i * 1024);
  const float4* g4 = (const float4*)g;
#pragma unroll
  for (int i = 0; i < 4; ++i) {
    int c4 = lane + 64 * i;
    float4 gg = g4[c4], s4 = sh[c4], l4 = sl[c4];
    float y0 = v[i].x * r * gg.x * (1.f + l4.x) + s4.x;
    float y1 = v[i].y * r * gg.y * (1.f + l4.y) + s4.y;
    float y2 = v[i].z * r * gg.z * (1.f + l4.z) + s4.z;
    float y3 = v[i].w * r * gg.w * (1.f + l4.w) + s4.w;
    uint2 pk;
    pk.x = pack2(y0, y1);
    pk.y = pack2(y2, y3);
    *(uint2*)(H + (size_t)row * 1024 + c4 * 4) = pk;
  }
}

__device__ void conv_item_late(const Params& p, int l, int i, float* tl) {
  bf16_t* Wout = (bf16_t*)(p.ws + OFF_WOUT);
  bf16_t* Wgu = (bf16_t*)(p.ws + OFF_WGU);
  bf16_t* Wdn = (bf16_t*)(p.ws + OFF_WDN);
  const float* src;
  bf16_t* dst;
  int K, N, mode = 0, ntn;
  if (i < 256) {
    src = p.w_out + (size_t)l * 1024 * 1024; K = 1024; N = 1024; dst = Wout; ntn = 16;
  } else if (i < 960) {
    i -= 256; src = p.w_gate + (size_t)l * 1024 * FFN; K = 1024; N = FFN; dst = Wgu; ntn = 44; mode = 1;
  } else if (i < 1664) {
    i -= 960; src = p.w_up + (size_t)l * 1024 * FFN; K = 1024; N = FFN; dst = Wgu; ntn = 44; mode = 2;
  } else {
    i -= 1664; src = p.w_down + (size_t)l * FFN * 1024; K = FFN; N = 1024; dst = Wdn; ntn = 16;
  }
  convT_tile(src, K, N, dst, mode, nullptr, i / ntn, i % ntn, tl);
}
constexpr int N_CONV_LATE = 256 + 3 * 704;
__device__ void conv_item_early(const Params& p, int l, int it, float* tl) {
  const float* src;
  const float* gs = nullptr;
  bf16_t* dst;
  int K, N, ntn, i;
  if (it < 832) {
    i = it; src = p.w_in + (size_t)l * 1024 * INW; K = 1024; N = INW; dst = (bf16_t*)(p.ws + OFF_WIN); ntn = 52;
  } else if (it < 856) {
    i = it - 832; src = p.w_qup + (size_t)l * 256 * 384; K = 256; N = 384; dst = (bf16_t*)(p.ws + OFF_WQUP); ntn = 6;
    gs = p.g_q + l * 256;
  } else {
    i = it - 856; src = p.w_kvup + (size_t)l * 128 * 512; K = 128; N = 512; dst = (bf16_t*)(p.ws + OFF_WKVUP); ntn = 8;
    gs = p.g_kv + l * 128;
  }
  convT_tile(src, K, N, dst, 0, gs, i / ntn, i % ntn, tl);
}

__device__ void phaseA(const Params& p, int l, char* smem) {
  const int nb = gridDim.x, bid = blockIdx.x;
  for (int it = bid; it < M_ALL / 4; it += nb)
    norm_rows(p, l == 0, (bf16_t*)(p.ws + OFF_HM), p.g_mix + l * 1024,
              (const float*)(p.ws + OFF_MOD) + (size_t)l * 9 * 6144, 0, 1, it);
}

DEVI void tile_map(int it, int NT, int& mt, int& nt, int MPX = 18) {
  const int xcd = it & 7, idx = it >> 3;
  const int per_group = 8 * NT;
  const int g = idx / per_group, r = idx - g * per_group;
  const int gs = min(8, MPX - 8 * g);
  mt = xcd * MPX + g * 8 + r % gs;
  nt = r / gs;
}

enum { EPI_P = 0, EPI_QUP = 1, EPI_KVUP = 2, EPI_RES = 3, EPI_GU = 4 };

template <int EPI>
__device__ void gemm_tile(const Params& p, int l, const bf16_t* __restrict__ A, int lda,
                          const bf16_t* __restrict__ BT, int K, int m0, int n0, int gate_i, char* smem) {
  constexpr int STAGE = 2 * 128 * 72;
  bf16_t* sbase = (bf16_t*)smem;
  float* rsv = (float*)(smem + 2 * STAGE * 2);
  const int tid = otid(), lane = tid & 63, w = tid >> 6, wm = w >> 1, wn = w & 1;
  const int lr = tid >> 3, lc = (tid & 7) * 8;
  __syncthreads();
  if (EPI == EPI_QUP || EPI == EPI_KVUP) {
    const int row = tid >> 1, hf = tid & 1;
    const int n8 = K / 16;
    const uint4* ap = (const uint4*)(A + (size_t)(m0 + row) * lda + hf * (K / 2));
    float ss = 0.f;
    for (int i = 0; i < n8; ++i) {
      uint4 u = ap[i];
      float a0 = bflo(u.x), a1 = bfhi(u.x), a2 = bflo(u.y), a3 = bfhi(u.y), a4 = bflo(u.z), a5 = bfhi(u.z),
            a6 = bflo(u.w), a7 = bfhi(u.w);
      ss += a0 * a0 + a1 * a1 + a2 * a2 + a3 * a3 + a4 * a4 + a5 * a5 + a6 * a6 + a7 * a7;
    }
    ss += __shfl_xor(ss, 1);
    if (hf == 0) rsv[row] = rsqrtf(ss / (float)K + 1e-6f);
  }
  const bf16_t* Ap = A + (size_t)(m0 + lr) * lda + lc;
  const bf16_t* Bp = BT + (size_t)(n0 + lr) * K + lc;
  uint4 ra0, ra1, ra2, ra3, rb0, rb1, rb2, rb3;
#define G_LOAD()                                  \
  ra0 = *(const uint4*)(Ap);                      \
  ra1 = *(const uint4*)(Ap + (size_t)32 * lda);   \
  ra2 = *(const uint4*)(Ap + (size_t)64 * lda);   \
  ra3 = *(const uint4*)(Ap + (size_t)96 * lda);   \
  rb0 = *(const uint4*)(Bp);                      \
  rb1 = *(const uint4*)(Bp + (size_t)32 * K);     \
  rb2 = *(const uint4*)(Bp + (size_t)64 * K);     \
  rb3 = *(const uint4*)(Bp + (size_t)96 * K);
#define S_WRITE(ST)                                                   \
  {                                                                   \
    bf16_t* wa = sbase + (ST) * STAGE + lr * 72 + lc;                 \
    bf16_t* wb = wa + 128 * 72;                                       \
    *(uint4*)(wa) = ra0;                                              \
    *(uint4*)(wa + 32 * 72) = ra1;                                    \
    *(uint4*)(wa + 64 * 72) = ra2;                                    \
    *(uint4*)(wa + 96 * 72) = ra3;                                    \
    *(uint4*)(wb) = rb0;                                              \
    *(uint4*)(wb + 32 * 72) = rb1;                                    \
    *(uint4*)(wb + 64 * 72) = rb2;                                    \
    *(uint4*)(wb + 96 * 72) = rb3;                                    \
  }
  const int nk = K / 64;
  G_LOAD()
  S_WRITE(0)
  if (nk > 1) {
    Ap += 64;
    Bp += 64;
    G_LOAD()
  }
  f32x16 acc[2][2];
#pragma unroll
  for (int i = 0; i < 2; ++i)
#pragma unroll
    for (int j = 0; j < 2; ++j)
#pragma unroll
      for (int r = 0; r < 16; ++r) acc[i][j][r] = 0.f;
  __syncthreads();
  const int foff = (lane & 31) * 72 + (lane >> 5) * 8;
  const bf16_t* fa_base = sbase + wm * 64 * 72 + foff;
  const bf16_t* fb_base = sbase + 128 * 72 + wn * 64 * 72 + foff;
  bf16x8 xa0, xa1, xb0, xb1, ya0, ya1, yb0, yb1;
#define FLOAD(X, ST, KS)                                                   \
  {                                                                        \
    const bf16_t* pa_ = fa_base + (ST) * STAGE + (KS) * 16;                \
    const bf16_t* pb_ = fb_base + (ST) * STAGE + (KS) * 16;                \
    X##a0 = *(const bf16x8*)(pa_);                                         \
    X##a1 = *(const bf16x8*)(pa_ + 32 * 72);                               \
    X##b0 = *(const bf16x8*)(pb_);                                         \
    X##b1 = *(const bf16x8*)(pb_ + 32 * 72);                               \
  }
#define MM4(X)                                                                            \
  acc[0][0] = __builtin_amdgcn_mfma_f32_32x32x16_bf16(X##a0, X##b0, acc[0][0], 0, 0, 0);  \
  acc[0][1] = __builtin_amdgcn_mfma_f32_32x32x16_bf16(X##a0, X##b1, acc[0][1], 0, 0, 0);  \
  acc[1][0] = __builtin_amdgcn_mfma_f32_32x32x16_bf16(X##a1, X##b0, acc[1][0], 0, 0, 0);  \
  acc[1][1] = __builtin_amdgcn_mfma_f32_32x32x16_bf16(X##a1, X##b1, acc[1][1], 0, 0, 0);
  FLOAD(x, 0, 0)
  for (int kt = 0; kt < nk; ++kt) {
    const int cur = kt & 1;
    FLOAD(y, cur, 1)
    __builtin_amdgcn_sched_barrier(0);
    MM4(x)
    __builtin_amdgcn_sched_barrier(0);
    FLOAD(x, cur, 2)
    __builtin_amdgcn_sched_barrier(0);
    MM4(y)
    __builtin_amdgcn_sched_barrier(0);
    FLOAD(y, cur, 3)
    __builtin_amdgcn_sched_barrier(0);
    MM4(x)
    __builtin_amdgcn_sched_barrier(0);
    if (kt + 1 < nk) {
      S_WRITE(cur ^ 1)
      if (kt + 2 < nk) {
        Ap += 64;
        Bp += 64;
        G_LOAD()
      }
    }
    __syncthreads();
    if (kt + 1 < nk) FLOAD(x, cur ^ 1, 0)
    __builtin_amdgcn_sched_barrier(0);
    MM4(y)
    __builtin_amdgcn_sched_barrier(0);
  }
  __syncthreads();
#undef FLOAD
#undef MM4
#undef G_LOAD
#undef S_WRITE
  const int ci = lane & 31;
  const int rbase = m0 + wm * 64 + 4 * (lane >> 5);
  const int cbase = n0 + wn * 64;
  if (EPI == EPI_P) {
    bf16_t* P = (bf16_t*)(p.ws + OFF_P);
    float* AB = (float*)(p.ws + OFF_AB);
    bf16_t* sO = (bf16_t*)smem;
#pragma unroll
    for (int mt = 0; mt < 2; ++mt)
#pragma unroll
      for (int nt = 0; nt < 2; ++nt)
#pragma unroll
        for (int r = 0; r < 16; ++r) {
          const int rl = wm * 64 + 4 * (lane >> 5) + mt * 32 + (r & 3) + 8 * (r >> 2);
          const int cl = wn * 64 + nt * 32 + ci;
          const float v = acc[mt][nt][r];
          sO[rl * 136 + cl] = f2bf(v);
          const int col = n0 + cl;
          if (col >= C_DA && col < C_DA + 16) AB[(size_t)(m0 + rl) * 16 + col - C_DA] = v;
        }
    __syncthreads();
#pragma unroll
    for (int e = 0; e < 8; ++e) {
      const int c = tid + 256 * e, rl = c >> 4, ch = c & 15;
      *(uint4*)(P + (size_t)(m0 + rl) * INWP + n0 + ch * 8) = *(const uint4*)(sO + rl * 136 + ch * 8);
    }
    bf16_t* NVT = (bf16_t*)(p.ws + OFF_NVT);
#pragma unroll
    for (int mt = 0; mt < 2; ++mt)
#pragma unroll
      for (int nt = 0; nt < 2; ++nt) {
        const int base = cbase + nt * 32;
        if (base >= C_NV && base < C_NV + 256) {
          const int hv = (base - C_NV) >> 6, dv = ((base - C_NV) & 63) + ci;
#pragma unroll
          for (int g = 0; g < 4; ++g) {
            const int row0 = rbase + mt * 32 + 8 * g;
            int bb, key0;
            if (row0 < M_LAT) { bb = row0 >> 11; key0 = 256 + (row0 & 2047); }
            else { bb = (row0 - M_LAT) >> 8; key0 = (row0 - M_LAT) & 255; }
            uint2 u;
            u.x = pack2(acc[mt][nt][4 * g + 0], acc[mt][nt][4 * g + 1]);
            u.y = pack2(acc[mt][nt][4 * g + 2], acc[mt][nt][4 * g + 3]);
            *(uint2*)(NVT + ((size_t)(bb * 4 + hv) * 64 + dv) * 2304 + key0) = u;
          }
        }
      }
  } else if (EPI == EPI_QUP) {
    bf16_t* QH = (bf16_t*)(p.ws + OFF_QH);
    const float* rc = (const float*)(p.ws + OFF_ROPE);
    const float* rsn = rc + 2048 * 16;
#pragma unroll
    for (int mt = 0; mt < 2; ++mt)
#pragma unroll
      for (int nt = 0; nt < 2; ++nt) {
        const int base = cbase + nt * 32;
        const bool rope = ((base % 96) == 64) && (m0 < M_LAT);
#pragma unroll
        for (int r = 0; r < 16; ++r) {
          int row = rbase + mt * 32 + (r & 3) + 8 * (r >> 2);
          float v = acc[mt][nt][r] * rsv[row - m0];
          float o = __shfl_xor(v, 8);
          if (rope) {
            int t = row & 2047;
            int a = ci >> 4, hf = (ci >> 3) & 1, j = ci & 7;
            float c = rc[t * 16 + a * 8 + j], s = rsn[t * 16 + a * 8 + j];
            v = hf ? (o * s + v * c) : (v * c - o * s);
          }
          QH[(size_t)row * 384 + base + ci] = f2bf(v);
        }
      }
  } else if (EPI == EPI_KVUP) {
    bf16_t* KA = (bf16_t*)(p.ws + OFF_KH);
    bf16_t* VT = (bf16_t*)(p.ws + OFF_VH);
#pragma unroll
    for (int mt = 0; mt < 2; ++mt)
#pragma unroll
      for (int nt = 0; nt < 2; ++nt) {
        const int base = cbase + nt * 32;
        const int h = base >> 7, cc = (base & 127) + ci;
#pragma unroll
        for (int g = 0; g < 4; ++g) {
          const int row0 = rbase + mt * 32 + 8 * g;
          int bb, key0;
          if (row0 < M_LAT) { bb = row0 >> 11; key0 = 256 + (row0 & 2047); }
          else { bb = (row0 - M_LAT) >> 8; key0 = (row0 - M_LAT) & 255; }
          float v0 = acc[mt][nt][4 * g + 0] * rsv[row0 - m0 + 0];
          float v1 = acc[mt][nt][4 * g + 1] * rsv[row0 - m0 + 1];
          float v2 = acc[mt][nt][4 * g + 2] * rsv[row0 - m0 + 2];
          float v3 = acc[mt][nt][4 * g + 3] * rsv[row0 - m0 + 3];
          if (cc < 64) {
            bf16_t* kp = KA + ((size_t)(bb * 4 + h) * 2304 + key0) * 96 + cc;
            kp[0] = f2bf(v0); kp[96] = f2bf(v1); kp[192] = f2bf(v2); kp[288] = f2bf(v3);
          } else {
            uint2 u;
            u.x = pack2(v0, v1);
            u.y = pack2(v2, v3);
            *(uint2*)(VT + ((size_t)(bb * 4 + h) * 64 + (cc - 64)) * 2304 + key0) = u;
          }
        }
      }
  } else if (EPI == EPI_RES) {
    float* X = (float*)(p.ws + OFF_X);
    const float* Xsrc = (l == 0 && gate_i == 2) ? (m0 < M_LAT ? p.x : p.ctx - (size_t)M_LAT * 1024) : X;
    const float* modl = (const float*)(p.ws + OFF_MOD) + (size_t)l * 9 * 6144 + gate_i * 1024;
#pragma unroll
    for (int mt = 0; mt < 2; ++mt)
#pragma unroll
      for (int nt = 0; nt < 2; ++nt)
#pragma unroll
        for (int r = 0; r < 16; ++r) {
          int row = rbase + mt * 32 + (r & 3) + 8 * (r >> 2);
          int col = cbase + nt * 32 + ci;
          int b = row < M_LAT ? (row >> 11) : 8;
          float g = modl[b * 6144 + col];
          size_t idx = (size_t)row * 1024 + col;
          X[idx] = Xsrc[idx] + g * acc[mt][nt][r];
        }
  } else if (EPI == EPI_GU) {
    bf16_t* ACT = (bf16_t*)(p.ws + OFF_P);
    bf16_t* sO = (bf16_t*)smem;
#pragma unroll
    for (int mt = 0; mt < 2; ++mt)
#pragma unroll
      for (int r = 0; r < 16; ++r) {
        const int rl = wm * 64 + 4 * (lane >> 5) + mt * 32 + (r & 3) + 8 * (r >> 2);
        float gt = acc[mt][0][r], up = acc[mt][1][r];
        float a = silu_f(gt) * up;
        sO[rl * 72 + wn * 32 + ci] = f2bf(a);
      }
    __syncthreads();
#pragma unroll
    for (int e = 0; e < 4; ++e) {
      const int c = tid + 256 * e, rl = c >> 3, ch = c & 7;
      *(uint4*)(ACT + (size_t)(m0 + rl) * FFN + (n0 >> 1) + ch * 8) = *(const uint4*)(sO + rl * 72 + ch * 8);
    }
  }
}

template <int EPI>
__device__ void gemm_wide(const Params& p, int l, const bf16_t* __restrict__ A, int lda,
                          const bf16_t* __restrict__ BT, int K, int m0, int n0, int gate_i, char* smem) {
  bf16_t* sA = (bf16_t*)smem;
  bf16_t* sB = sA + 128 * 72;
  const int tid = otid(), lane = tid & 63, w = tid >> 6, wm = w >> 1, wn = w & 1;
  const int lr = tid >> 3, lc = (tid & 7) * 8;
  const bf16_t* Ap = A + (size_t)(m0 + lr) * lda + lc;
  const bf16_t* Bp = BT + (size_t)(n0 + lr) * K + lc;
  uint4 ra0, ra1, ra2, ra3, rb0, rb1, rb2, rb3, rb4, rb5, rb6, rb7;
#define LOAD_AB()                                   \
  ra0 = *(const uint4*)(Ap);                        \
  ra1 = *(const uint4*)(Ap + (size_t)32 * lda);     \
  ra2 = *(const uint4*)(Ap + (size_t)64 * lda);     \
  ra3 = *(const uint4*)(Ap + (size_t)96 * lda);     \
  rb0 = *(const uint4*)(Bp);                        \
  rb1 = *(const uint4*)(Bp + (size_t)32 * K);       \
  rb2 = *(const uint4*)(Bp + (size_t)64 * K);       \
  rb3 = *(const uint4*)(Bp + (size_t)96 * K);       \
  rb4 = *(const uint4*)(Bp + (size_t)128 * K);      \
  rb5 = *(const uint4*)(Bp + (size_t)160 * K);      \
  rb6 = *(const uint4*)(Bp + (size_t)192 * K);      \
  rb7 = *(const uint4*)(Bp + (size_t)224 * K);
  __syncthreads();
  LOAD_AB()
  f32x16 acc[2][4];
#pragma unroll
  for (int i = 0; i < 2; ++i)
#pragma unroll
    for (int j = 0; j < 4; ++j)
#pragma unroll
      for (int r = 0; r < 16; ++r) acc[i][j][r] = 0.f;
  const int nk = K / 64;
  const bf16_t* pa = sA + (wm * 64 + (lane & 31)) * 72 + (lane >> 5) * 8;
  const bf16_t* pb = sB + (wn * 128 + (lane & 31)) * 72 + (lane >> 5) * 8;
#define MM8(A0, A1, B0, B1, B2, B3)                                                   \
  acc[0][0] = __builtin_amdgcn_mfma_f32_32x32x16_bf16(A0, B0, acc[0][0], 0, 0, 0);    \
  acc[1][0] = __builtin_amdgcn_mfma_f32_32x32x16_bf16(A1, B0, acc[1][0], 0, 0, 0);    \
  acc[0][1] = __builtin_amdgcn_mfma_f32_32x32x16_bf16(A0, B1, acc[0][1], 0, 0, 0);    \
  acc[1][1] = __builtin_amdgcn_mfma_f32_32x32x16_bf16(A1, B1, acc[1][1], 0, 0, 0);    \
  acc[0][2] = __builtin_amdgcn_mfma_f32_32x32x16_bf16(A0, B2, acc[0][2], 0, 0, 0);    \
  acc[1][2] = __builtin_amdgcn_mfma_f32_32x32x16_bf16(A1, B2, acc[1][2], 0, 0, 0);    \
  acc[0][3] = __builtin_amdgcn_mfma_f32_32x32x16_bf16(A0, B3, acc[0][3], 0, 0, 0);    \
  acc[1][3] = __builtin_amdgcn_mfma_f32_32x32x16_bf16(A1, B3, acc[1][3], 0, 0, 0);
#define HALF_STEP(KO)                                                                                   \
  {                                                                                                     \
    bf16x8 fa00 = *(const bf16x8*)(pa + (KO)), fa01 = *(const bf16x8*)(pa + 32 * 72 + (KO));            \
    bf16x8 fb00 = *(const bf16x8*)(pb + (KO)), fb01 = *(const bf16x8*)(pb + 32 * 72 + (KO));            \
    bf16x8 fb02 = *(const bf16x8*)(pb + 64 * 72 + (KO)), fb03 = *(const bf16x8*)(pb + 96 * 72 + (KO));  \
    bf16x8 fa10 = *(const bf16x8*)(pa + (KO) + 16), fa11 = *(const bf16x8*)(pa + 32 * 72 + (KO) + 16);  \
    bf16x8 fb10 = *(const bf16x8*)(pb + (KO) + 16), fb11 = *(const bf16x8*)(pb + 32 * 72 + (KO) + 16);  \
    bf16x8 fb12 = *(const bf16x8*)(pb + 64 * 72 + (KO) + 16), fb13 = *(const bf16x8*)(pb + 96 * 72 + (KO) + 16); \
    __builtin_amdgcn_sched_barrier(0);                                                                  \
    __builtin_amdgcn_s_setprio(1);                                                                      \
    MM8(fa00, fa01, fb00, fb01, fb02, fb03)                                                             \
    MM8(fa10, fa11, fb10, fb11, fb12, fb13)                                                             \
    __builtin_amdgcn_s_setprio(0);                                                                      \
    __builtin_amdgcn_sched_barrier(0);                                                                  \
  }
  for (int kt = 0; kt < nk; ++kt) {
    __syncthreads();
    *(uint4*)(sA + (lr + 0) * 72 + lc) = ra0;
    *(uint4*)(sA + (lr + 32) * 72 + lc) = ra1;
    *(uint4*)(sA + (lr + 64) * 72 + lc) = ra2;
    *(uint4*)(sA + (lr + 96) * 72 + lc) = ra3;
    *(uint4*)(sB + (lr + 0) * 72 + lc) = rb0;
    *(uint4*)(sB + (lr + 32) * 72 + lc) = rb1;
    *(uint4*)(sB + (lr + 64) * 72 + lc) = rb2;
    *(uint4*)(sB + (lr + 96) * 72 + lc) = rb3;
    *(uint4*)(sB + (lr + 128) * 72 + lc) = rb4;
    *(uint4*)(sB + (lr + 160) * 72 + lc) = rb5;
    *(uint4*)(sB + (lr + 192) * 72 + lc) = rb6;
    *(uint4*)(sB + (lr + 224) * 72 + lc) = rb7;
    __syncthreads();
    if (kt + 1 < nk) {
      Ap += 64;
      Bp += 64;
      LOAD_AB()
    }
    __builtin_amdgcn_sched_barrier(0);
    HALF_STEP(0)
    HALF_STEP(32)
  }
#undef HALF_STEP
#undef MM8
#undef LOAD_AB
  const int ci = lane & 31;
  const int rbase = m0 + wm * 64 + 4 * (lane >> 5);
  const int cbase = n0 + wn * 128;
  if (EPI == EPI_P) {
    bf16_t* P = (bf16_t*)(p.ws + OFF_P);
    float* AB = (float*)(p.ws + OFF_AB);
    bf16_t* NVT = (bf16_t*)(p.ws + OFF_NVT);
#pragma unroll
    for (int mt = 0; mt < 2; ++mt)
#pragma unroll
      for (int nt = 0; nt < 4; ++nt) {
        const int base = cbase + nt * 32;
#pragma unroll
        for (int r = 0; r < 16; ++r) {
          int row = rbase + mt * 32 + (r & 3) + 8 * (r >> 2);
          int col = base + ci;
          float v = acc[mt][nt][r];
          P[(size_t)row * INWP + col] = f2bf(v);
          if (col >= C_DA && col < C_DA + 16) AB[(size_t)row * 16 + col - C_DA] = v;
        }
        if (base >= C_NV && base < C_NV + 256) {
          const int hv = (base - C_NV) >> 6, dv = ((base - C_NV) & 63) + ci;
#pragma unroll
          for (int g = 0; g < 4; ++g) {
            const int row0 = rbase + mt * 32 + 8 * g;
            int bb, key0;
            if (row0 < M_LAT) { bb = row0 >> 11; key0 = 256 + (row0 & 2047); }
            else { bb = (row0 - M_LAT) >> 8; key0 = (row0 - M_LAT) & 255; }
            uint2 u;
            u.x = pack2(acc[mt][nt][4 * g + 0], acc[mt][nt][4 * g + 1]);
            u.y = pack2(acc[mt][nt][4 * g + 2], acc[mt][nt][4 * g + 3]);
            *(uint2*)(NVT + ((size_t)(bb * 4 + hv) * 64 + dv) * 2304 + key0) = u;
          }
        }
      }
  } else if (EPI == EPI_GU) {
    bf16_t* ACT = (bf16_t*)(p.ws + OFF_P);
#pragma unroll
    for (int mt = 0; mt < 2; ++mt)
#pragma unroll
      for (int pr = 0; pr < 2; ++pr)
#pragma unroll
        for (int r = 0; r < 16; ++r) {
          int row = rbase + mt * 32 + (r & 3) + 8 * (r >> 2);
          float gt = acc[mt][2 * pr][r], up = acc[mt][2 * pr + 1][r];
          float a = silu_f(gt) * up;
          ACT[(size_t)row * FFN + ((cbase >> 6) + pr) * 32 + ci] = f2bf(a);
        }
  }
}

typedef float f32x4 __attribute__((ext_vector_type(4)));
template <int EPI>
__device__ void gemm_wide16(const Params& p, int l, const bf16_t* __restrict__ A, int lda,
                            const bf16_t* __restrict__ BT, int K, int m0, int n0, char* smem) {
  constexpr int RS = 80;
  bf16_t* sA = (bf16_t*)smem;
  bf16_t* sB = sA + 128 * RS;
  const int tid = otid(), lane = tid & 63, w = tid >> 6, wm = w >> 1, wn = w & 1;
  const int lr = tid >> 3, lc = (tid & 7) * 8;
  const int l15 = lane & 15, lq = lane >> 4;
  const bf16_t* Ap = A + (size_t)(m0 + lr) * lda + lc;
  const bf16_t* Bp = BT + (size_t)(n0 + lr) * K + lc;
  uint4 ra0, ra1, ra2, ra3, rb0, rb1, rb2, rb3, rb4, rb5, rb6, rb7;
#define LOAD_AB()                                   \
  ra0 = *(const uint4*)(Ap);                        \
  ra1 = *(const uint4*)(Ap + (size_t)32 * lda);     \
  ra2 = *(const uint4*)(Ap + (size_t)64 * lda);     \
  ra3 = *(const uint4*)(Ap + (size_t)96 * lda);     \
  rb0 = *(const uint4*)(Bp);                        \
  rb1 = *(const uint4*)(Bp + (size_t)32 * K);       \
  rb2 = *(const uint4*)(Bp + (size_t)64 * K);       \
  rb3 = *(const uint4*)(Bp + (size_t)96 * K);       \
  rb4 = *(const uint4*)(Bp + (size_t)128 * K);      \
  rb5 = *(const uint4*)(Bp + (size_t)160 * K);      \
  rb6 = *(const uint4*)(Bp + (size_t)192 * K);      \
  rb7 = *(const uint4*)(Bp + (size_t)224 * K);
  __syncthreads();
  LOAD_AB()
  f32x4 acc[4][8];
#pragma unroll
  for (int i = 0; i < 4; ++i)
#pragma unroll
    for (int j = 0; j < 8; ++j)
#pragma unroll
      for (int r = 0; r < 4; ++r) acc[i][j][r] = 0.f;
  const int nk = K / 64;
  const bf16_t* pa = sA + (wm * 64 + l15) * RS + lq * 8;
  const bf16_t* pb = sB + (wn * 128 + l15) * RS + lq * 8;
  for (int kt = 0; kt < nk; ++kt) {
    __syncthreads();
    *(uint4*)(sA + (lr + 0) * RS + lc) = ra0;
    *(uint4*)(sA + (lr + 32) * RS + lc) = ra1;
    *(uint4*)(sA + (lr + 64) * RS + lc) = ra2;
    *(uint4*)(sA + (lr + 96) * RS + lc) = ra3;
    *(uint4*)(sB + (lr + 0) * RS + lc) = rb0;
    *(uint4*)(sB + (lr + 32) * RS + lc) = rb1;
    *(uint4*)(sB + (lr + 64) * RS + lc) = rb2;
    *(uint4*)(sB + (lr + 96) * RS + lc) = rb3;
    *(uint4*)(sB + (lr + 128) * RS + lc) = rb4;
    *(uint4*)(sB + (lr + 160) * RS + lc) = rb5;
    *(uint4*)(sB + (lr + 192) * RS + lc) = rb6;
    *(uint4*)(sB + (lr + 224) * RS + lc) = rb7;
    __syncthreads();
    if (kt + 1 < nk) {
      Ap += 64;
      Bp += 64;
      LOAD_AB()
    }
    __builtin_amdgcn_sched_barrier(0);
#pragma unroll
    for (int ks = 0; ks < 2; ++ks) {
      bf16x8 fa[4];
#pragma unroll
      for (int i = 0; i < 4; ++i) fa[i] = *(const bf16x8*)(pa + i * 16 * RS + ks * 32);
#pragma unroll
      for (int jh = 0; jh < 2; ++jh) {
        bf16x8 fb[4];
#pragma unroll
        for (int j = 0; j < 4; ++j) fb[j] = *(const bf16x8*)(pb + (jh * 4 + j) * 16 * RS + ks * 32);
        __builtin_amdgcn_s_setprio(1);
#pragma unroll
        for (int j = 0; j < 4; ++j)
#pragma unroll
          for (int i = 0; i < 4; ++i)
            acc[i][jh * 4 + j] = __builtin_amdgcn_mfma_f32_16x16x32_bf16(fa[i], fb[j], acc[i][jh * 4 + j], 0, 0, 0);
        __builtin_amdgcn_s_setprio(0);
      }
    }
  }
#undef LOAD_AB
  const int rbase = m0 + wm * 64 + lq * 4;
  const int cbase = n0 + wn * 128;
  if (EPI == EPI_P) {
    bf16_t* P = (bf16_t*)(p.ws + OFF_P);
    float* AB = (float*)(p.ws + OFF_AB);
    bf16_t* NVT = (bf16_t*)(p.ws + OFF_NVT);
#pragma unroll
    for (int nt = 0; nt < 8; ++nt) {
      const int base = cbase + nt * 16;
#pragma unroll
      for (int mt = 0; mt < 4; ++mt) {
        const int row0 = rbase + mt * 16;
#pragma unroll
        for (int r = 0; r < 4; ++r) P[(size_t)(row0 + r) * INWP + base + l15] = f2bf(acc[mt][nt][r]);
        if (base == C_DA) {
#pragma unroll
          for (int r = 0; r < 4; ++r) AB[(size_t)(row0 + r) * 16 + l15] = acc[mt][nt][r];
        }
        if (base >= C_NV && base < C_NV + 256) {
          const int hv = (base - C_NV) >> 6, dv = ((base - C_NV) & 63) + l15;
          int bb, key0;
          if (row0 < M_LAT) { bb = row0 >> 11; key0 = 256 + (row0 & 2047); }
          else { bb = (row0 - M_LAT) >> 8; key0 = (row0 - M_LAT) & 255; }
          uint2 u;
          u.x = pack2(acc[mt][nt][0], acc[mt][nt][1]);
          u.y = pack2(acc[mt][nt][2], acc[mt][nt][3]);
          *(uint2*)(NVT + ((size_t)(bb * 4 + hv) * 64 + dv) * 2304 + key0) = u;
        }
      }
    }
  } else if (EPI == EPI_GU) {
    bf16_t* ACT = (bf16_t*)(p.ws + OFF_P);
#pragma unroll
    for (int pr = 0; pr < 2; ++pr)
#pragma unroll
      for (int hf = 0; hf < 2; ++hf)
#pragma unroll
        for (int mt = 0; mt < 4; ++mt)
#pragma unroll
          for (int r = 0; r < 4; ++r) {
            const int row = rbase + mt * 16 + r;
            const float gt = acc[mt][pr * 4 + hf][r], up = acc[mt][pr * 4 + 2 + hf][r];
            ACT[(size_t)row * FFN + ((cbase >> 6) + pr) * 32 + hf * 16 + l15] = f2bf(silu_f(gt) * up);
          }
  }
}

__device__ void kpe_item(const Params& p, int it) {
  const int tid = otid();
  const bf16_t* P = (const bf16_t*)(p.ws + OFF_P);
  bf16_t* KH = (bf16_t*)(p.ws + OFF_KH);
  const float* rc = (const float*)(p.ws + OFF_ROPE);
  const float* rsn = rc + 2048 * 16;
  const int row = it * 8 + (tid >> 5), i = tid & 31;
  float v = bf2f(P[(size_t)row * INWP + C_MPE + i]);
  float o = __shfl_xor(v, 8);
  if (row < M_LAT) {
    int t = row & 2047;
    int a = i >> 4, hf = (i >> 3) & 1, j = i & 7;
    float c = rc[t * 16 + a * 8 + j], s = rsn[t * 16 + a * 8 + j];
    v = hf ? (o * s + v * c) : (v * c - o * s);
  }
  bf16_t bv = f2bf(v);
  int bb, key;
  if (row < M_LAT) { bb = row >> 11; key = 256 + (row & 2047); }
  else { bb = (row - M_LAT) >> 8; key = (row - M_LAT) & 255; }
#pragma unroll
  for (int h = 0; h < 4; ++h) KH[((size_t)(bb * 4 + h) * 2304 + key) * 96 + 64 + i] = bv;
}

__device__ void dn_prep(const Params& p, int l, int it, char* smem) {
  float* buf = (float*)smem;
  float* nrm = buf + 8 * 1536;
  const int tid = otid();
  const bf16_t* P = (const bf16_t*)(p.ws + OFF_P);
  bf16_t* DQ = (bf16_t*)(p.ws + OFF_DNQKV);
  const int r0 = it * 8;
  int seq_lo, seq_hi;
  if (r0 < M_LAT) {
    seq_lo = (r0 >> 11) << 11;
    seq_hi = seq_lo + 2048;
  } else {
    int rr = r0 - M_LAT;
    seq_lo = M_LAT + ((rr >> 8) << 8);
    seq_hi = seq_lo + 256;
  }
  const float* cw = p.conv_w + (size_t)l * 5 * 1536;
  __syncthreads();
  for (int c6 = 0; c6 < 6; ++c6) {
    const int ch = c6 * 256 + tid;
    float w0 = cw[ch], w1 = cw[1536 + ch], w2 = cw[2 * 1536 + ch], w3 = cw[3 * 1536 + ch], w4 = cw[4 * 1536 + ch];
    float xw[12];
#pragma unroll
    for (int j = 0; j < 12; ++j) {
      int r = r0 - 2 + j;
      xw[j] = (r >= seq_lo && r < seq_hi) ? bf2f(P[(size_t)r * INWP + C_DN + ch]) : 0.f;
    }
#pragma unroll
    for (int j = 0; j < 8; ++j) {
      float y = w0 * xw[j] + w1 * xw[j + 1] + w2 * xw[j + 2] + w3 * xw[j + 3] + w4 * xw[j + 4];
      buf[j * 1536 + ch] = silu_f(y);
    }
  }
  __syncthreads();
  {
    int vec = tid >> 2, part = tid & 3;
    int rr = vec >> 3, hv = vec & 7;
    const float* v = buf + rr * 1536 + hv * 128 + part * 32;
    float ss = 0.f;
#pragma unroll
    for (int i = 0; i < 32; ++i) ss += v[i] * v[i];
    ss += __shfl_xor(ss, 1);
    ss += __shfl_xor(ss, 2);
    if (part == 0) nrm[vec] = rsqrtf(ss + 1e-6f);
  }
  __syncthreads();
  for (int i = tid; i < 8 * 1536; i += 256) {
    int rr = i / 1536, ch = i - rr * 1536;
    float v = buf[i];
    if (ch < 1024) v *= nrm[rr * 8 + (ch >> 7)];
    DQ[(size_t)(r0 + rr) * 1536 + ch] = f2bf(v);
  }
}


DEVI int rowmap(int r, int hh) { return (r & 3) + 8 * (r >> 2) + 4 * hh; }

DEVI void unpack8(const uint4& u, float* f) {
  f[0] = bflo(u.x); f[1] = bfhi(u.x); f[2] = bflo(u.y); f[3] = bfhi(u.y);
  f[4] = bflo(u.z); f[5] = bfhi(u.z); f[6] = bflo(u.w); f[7] = bfhi(u.w);
}
__device__ void dn_chunk_prep(const Params& p, int l, int item, char* smem) {
  float* sW = (float*)smem;
  bf16_t* sKb = (bf16_t*)(smem + 7680);
  float* sL0 = (float*)(smem + 25088);
  float* sL1 = sL0 + 64 * 68;
  float* sg = (float*)(smem + 59904);
  float* sbt = sg + 128;
  const int tid = otid(), lane = tid & 63, w = tid >> 6, li = lane & 31, hh = lane >> 5;
  const int chunk = item >> 2, h = item & 3;
  int row0, seq_lo, seq_hi;
  if (chunk < 256) {
    int b = chunk >> 5;
    row0 = b * 2048 + (chunk & 31) * 64; seq_lo = b * 2048; seq_hi = seq_lo + 2048;
  } else {
    int cc = chunk - 256, b = cc >> 2;
    row0 = M_LAT + b * 256 + (cc & 3) * 64; seq_lo = M_LAT + b * 256; seq_hi = seq_lo + 256;
  }
  const bf16_t* P = (const bf16_t*)(p.ws + OFF_P);
  bf16_t* DQ = (bf16_t*)(p.ws + OFF_DNQKV);
  const float* AB = (const float*)(p.ws + OFF_AB);
  const float* cw = p.conv_w + (size_t)l * 5 * 1536;
  __syncthreads();
  for (int i = tid; i < 5 * 384; i += 256) {
    const int tap = i / 384, cc = i - tap * 384, type = cc >> 7, c = cc & 127;
    const int off = type == 0 ? 512 : (type == 1 ? 0 : 1024);
    sW[i] = cw[tap * 1536 + off + h * 128 + c];
  }
  if (w < 2) {
    const int d = w;
    const int row = d ? (row0 + 63 - lane) : (row0 + lane);
    const float Aneg = -__expf(p.a_log[l * 8 + d * 4 + h]);
    const float dtb = p.dt_bias[l * 8 + d * 4 + h];
    float a = AB[(size_t)row * 16 + d * 4 + h];
    float bb = AB[(size_t)row * 16 + 8 + d * 4 + h];
    float xx = a + dtb;
    const float ee = __expf(xx);
    float sp = ee < 0.25f ? ee * (1.f - ee * (0.5f - ee * (0.33333333f - ee * (0.25f - 0.2f * ee))))
                          : (xx > 20.f ? xx : __logf(1.f + ee));
    float g = Aneg * sp;
#pragma unroll
    for (int o = 1; o < 64; o <<= 1) {
      float y = __shfl_up(g, o);
      if (lane >= o) g += y;
    }
    float be = 1.f / (1.f + __expf(-bb));
    sg[d * 64 + lane] = g;
    sbt[d * 64 + lane] = be;
    ((float*)(p.ws + OFF_GC))[(size_t)row * 8 + d * 4 + h] = g;
    ((float*)(p.ws + OFF_BETA))[(size_t)row * 8 + d * 4 + h] = be;
  }
  __syncthreads();
  const int cg = tid & 15, rsub = tid >> 4;
#pragma unroll 1
  for (int type = 0; type < 3; ++type) {
    const int off = type == 0 ? 512 : (type == 1 ? 0 : 1024);
    uint4 xv[4][5];
#pragma unroll
    for (int e = 0; e < 4; ++e) {
      const int row = rsub + 16 * e;
      const bf16_t* base = P + (size_t)(row0 + row) * INWP + C_DN + off + h * 128 + cg * 8;
#pragma unroll
      for (int dd = 0; dd < 5; ++dd) {
        const int r = row0 + row + dd - 2;
        xv[e][dd] = (r >= seq_lo && r < seq_hi) ? *(const uint4*)(base + (dd - 2) * INWP) : make_uint4(0u, 0u, 0u, 0u);
      }
    }
#pragma unroll
    for (int e = 0; e < 4; ++e) {
      const int row = rsub + 16 * e;
      float y[8];
#pragma unroll
      for (int j = 0; j < 8; ++j) y[j] = 0.f;
#pragma unroll
      for (int dd = 0; dd < 5; ++dd) {
        float xf[8];
        unpack8(xv[e][dd], xf);
        const float4 wa = *(const float4*)(sW + dd * 384 + type * 128 + cg * 8);
        const float4 wb = *(const float4*)(sW + dd * 384 + type * 128 + cg * 8 + 4);
        y[0] += wa.x * xf[0]; y[1] += wa.y * xf[1]; y[2] += wa.z * xf[2]; y[3] += wa.w * xf[3];
        y[4] += wb.x * xf[4]; y[5] += wb.y * xf[5]; y[6] += wb.z * xf[6]; y[7] += wb.w * xf[7];
      }
      float ss = 0.f;
#pragma unroll
      for (int j = 0; j < 8; ++j) {
        y[j] = silu_f(y[j]);
        ss += y[j] * y[j];
      }
      if (type < 2) {
        ss += __shfl_xor(ss, 1);
        ss += __shfl_xor(ss, 2);
        ss += __shfl_xor(ss, 4);
        ss += __shfl_xor(ss, 8);
        const float rn = rsqrtf(ss + 1e-6f);
#pragma unroll
        for (int j = 0; j < 8; ++j) y[j] *= rn;
      }
      uint4 u;
      u.x = pack2(y[0], y[1]); u.y = pack2(y[2], y[3]); u.z = pack2(y[4], y[5]); u.w = pack2(y[6], y[7]);
      *(uint4*)(DQ + (size_t)(row0 + row) * 1536 + off + h * 128 + cg * 8) = u;
      if (type == 0) *(uint4*)(sKb + row * 136 + cg * 8) = u;
    }
  }
  __syncthreads();
  {
    const int mi = w >> 1, ni = w & 1;
    f32x16 g;
#pragma unroll
    for (int r = 0; r < 16; ++r) g[r] = 0.f;
#pragma unroll
    for (int ks = 0; ks < 8; ++ks) {
      bf16x8 a = *(const bf16x8*)(sKb + (mi * 32 + li) * 136 + ks * 16 + hh * 8);
      bf16x8 b = *(const bf16x8*)(sKb + (ni * 32 + li) * 136 + ks * 16 + hh * 8);
      g = __builtin_amdgcn_mfma_f32_32x32x16_bf16(a, b, g, 0, 0, 0);
    }
#pragma unroll
    for (int r = 0; r < 16; ++r) {
      const int i = mi * 32 + rowmap(r, hh), m = ni * 32 + li;
      const float G = g[r];
      sL0[i * 68 + m] = (i > m) ? sbt[i] * G * __expf(sg[i] - sg[m]) : 0.f;
      const int i1 = 63 - i, m1 = 63 - m;
      sL1[i1 * 68 + m1] = (i1 > m1) ? sbt[64 + i1] * G * __expf(sg[64 + i1] - sg[64 + m1]) : 0.f;
    }
  }
  __syncthreads();
  if (w < 2) {
    const float* L = w == 0 ? sL0 : sL1;
    float t[64];
#pragma unroll
    for (int i = 0; i < 64; ++i) {
      float a0 = (i == lane) ? 1.f : 0.f, a1 = 0.f, a2 = 0.f, a3 = 0.f;
#pragma unroll
      for (int m = 0; m < i; ++m) {
        const float pr = L[i * 68 + m] * t[m];
        if ((m & 3) == 0) a0 -= pr;
        else if ((m & 3) == 1) a1 -= pr;
        else if ((m & 3) == 2) a2 -= pr;
        else a3 -= pr;
      }
      t[i] = (a0 + a1) + (a2 + a3);
    }
    bf16_t* Tg = (bf16_t*)(p.ws + OFF_OB) + (size_t)((chunk * 4 + h) * 2 + w) * 4096;
#pragma unroll
    for (int i = 0; i < 64; ++i) Tg[i * 64 + lane] = f2bf(t[i]);
  }
}

DEVI bf16x8 ld_perm(const bf16_t* p) {
  union { bf16x8 v; uint2 d[2]; } u;
  u.d[0] = *(const uint2*)(p);
  u.d[1] = *(const uint2*)(p + 8);
  return u.v;
}
DEVI bf16x8 pack8(const f32x16& x, int s) {
  union { bf16x8 v; unsigned w[4]; } u;
  u.w[0] = pack2(x[8 * s + 0], x[8 * s + 1]);
  u.w[1] = pack2(x[8 * s + 2], x[8 * s + 3]);
  u.w[2] = pack2(x[8 * s + 4], x[8 * s + 5]);
  u.w[3] = pack2(x[8 * s + 6], x[8 * s + 7]);
  return u.v;
}

__device__ void dn_scan(const Params& p, int l, int item, char* smem) {
  bf16_t* sK = (bf16_t*)smem;
  bf16_t* sQ = (bf16_t*)(smem + 17408);
  bf16_t* sKT = (bf16_t*)(smem + 34816);
  bf16_t* sT = (bf16_t*)(smem + 52224);
  bf16_t* sA = (bf16_t*)(smem + 60928);
  bf16_t* sV = (bf16_t*)(smem + 52224);
  float* sg = (float*)(smem + 69632);
  float* sbt = sg + 64;
  float* seg = sbt + 64;
  float* sdt = seg + 64;
  const int d = item & 1, h = (item >> 1) & 3, b = item >> 3;
  const bf16_t* DQ = (const bf16_t*)(p.ws + OFF_DNQKV);
  const bf16_t* TB = (const bf16_t*)(p.ws + OFF_OB);
  const float* GC = (const float*)(p.ws + OFF_GC);
  const float* BE = (const float*)(p.ws + OFF_BETA);
  bf16_t* MIX = (bf16_t*)(p.ws + OFF_HM);
  bf16_t* Pw = (bf16_t*)(p.ws + OFF_P);
  const float qscale = 0.08838834764831845f;
  const int rsign = d ? -1 : 1;
  f32x16 S0, S1, S2, S3;
#pragma unroll
  for (int r = 0; r < 16; ++r) { S0[r] = 0.f; S1[r] = 0.f; S2[r] = 0.f; S3[r] = 0.f; }
  __builtin_amdgcn_s_setprio(3);
  uint4 qA0, qB0, kA0, kB0, vA0, vB0, qA1, qB1, kA1, kB1, vA1, vB1, tq0, tq1;
  float pgc = 0.f, pbe = 0.f;
#define SCAN_ROW0(N, CHUNK, ROW0)                                    \
  {                                                                  \
    if ((N) < 4) {                                                   \
      int cn = d ? (3 - (N)) : (N);                                  \
      CHUNK = 256 + b * 4 + cn;                                      \
      ROW0 = M_LAT + b * 256 + cn * 64;                              \
    } else {                                                         \
      int ln = (N)-4;                                                \
      ln = d ? (31 - ln) : ln;                                       \
      CHUNK = b * 32 + ln;                                           \
      ROW0 = b * 2048 + ln * 64;                                     \
    }                                                                \
  }
#define SCAN_LOADS(N)                                                                         \
  {                                                                                           \
    const int tid_ = otid();                                                                  \
    int chunk_, row0_;                                                                        \
    SCAN_ROW0(N, chunk_, row0_)                                                               \
    const int rstart_ = d ? (row0_ + 63) : row0_;                                             \
    {                                                                                         \
      const int u = tid_, c8 = u & 15, tp = u >> 4;                                           \
      const bf16_t* ga = DQ + (size_t)(rstart_ + rsign * 2 * tp) * 1536 + h * 128 + c8 * 8;   \
      const bf16_t* gb = ga + rsign * 1536;                                                   \
      qA0 = *(const uint4*)(ga); kA0 = *(const uint4*)(ga + 512); vA0 = *(const uint4*)(ga + 1024); \
      qB0 = *(const uint4*)(gb); kB0 = *(const uint4*)(gb + 512); vB0 = *(const uint4*)(gb + 1024); \
    }                                                                                         \
    {                                                                                         \
      const int u = tid_ + 256, c8 = u & 15, tp = u >> 4;                                     \
      const bf16_t* ga = DQ + (size_t)(rstart_ + rsign * 2 * tp) * 1536 + h * 128 + c8 * 8;   \
      const bf16_t* gb = ga + rsign * 1536;                                                   \
      qA1 = *(const uint4*)(ga); kA1 = *(const uint4*)(ga + 512); vA1 = *(const uint4*)(ga + 1024); \
      qB1 = *(const uint4*)(gb); kB1 = *(const uint4*)(gb + 512); vB1 = *(const uint4*)(gb + 1024); \
    }                                                                                         \
    {                                                                                         \
      const bf16_t* Tg = TB + (size_t)((chunk_ * 4 + h) * 2 + d) * 4096;                      \
      tq0 = *(const uint4*)(Tg + (tid_ >> 3) * 64 + (tid_ & 7) * 8);                          \
      tq1 = *(const uint4*)(Tg + ((tid_ >> 3) + 32) * 64 + (tid_ & 7) * 8);                   \
    }                                                                                         \
    if (tid_ < 64) {                                                                          \
      const int row = rstart_ + rsign * tid_;                                                 \
      pgc = GC[(size_t)row * 8 + d * 4 + h];                                                  \
      pbe = BE[(size_t)row * 8 + d * 4 + h];                                                  \
    }                                                                                         \
  }
  SCAN_LOADS(0)
  for (int n = 0; n < 36; ++n) {
    const int tid = otid(), lane = tid & 63, w = tid >> 6, li = lane & 31, hh = lane >> 5;
    int chunk, row0;
    SCAN_ROW0(n, chunk, row0)
    (void)chunk;
    const int rstart = d ? (row0 + 63) : row0;
    __syncthreads();
#define STAGE_UNIT(U, QA, QB, KA, KB, VA, VB)                                                   \
  {                                                                                             \
    const int c8 = (U)&15, tp = (U) >> 4;                                                       \
    *(uint4*)(sQ + (2 * tp) * 136 + c8 * 8) = QA;                                               \
    *(uint4*)(sQ + (2 * tp + 1) * 136 + c8 * 8) = QB;                                           \
    *(uint4*)(sK + (2 * tp) * 136 + c8 * 8) = KA;                                               \
    *(uint4*)(sK + (2 * tp + 1) * 136 + c8 * 8) = KB;                                           \
    *(uint4*)(sV + (2 * tp) * 136 + c8 * 8) = VA;                                               \
    *(uint4*)(sV + (2 * tp + 1) * 136 + c8 * 8) = VB;                                           \
    unsigned* kt = (unsigned*)(sKT + (c8 * 8) * 68 + 2 * tp);                                   \
    kt[0 * 34] = (KA.x & 0xffffu) | (KB.x << 16);                                               \
    kt[1 * 34] = (KA.x >> 16) | (KB.x & 0xffff0000u);                                           \
    kt[2 * 34] = (KA.y & 0xffffu) | (KB.y << 16);                                               \
    kt[3 * 34] = (KA.y >> 16) | (KB.y & 0xffff0000u);                                           \
    kt[4 * 34] = (KA.z & 0xffffu) | (KB.z << 16);                                               \
    kt[5 * 34] = (KA.z >> 16) | (KB.z & 0xffff0000u);                                           \
    kt[6 * 34] = (KA.w & 0xffffu) | (KB.w << 16);                                               \
    kt[7 * 34] = (KA.w >> 16) | (KB.w & 0xffff0000u);                                           \
  }
    STAGE_UNIT(tid, qA0, qB0, kA0, kB0, vA0, vB0)
    STAGE_UNIT(tid + 256, qA1, qB1, kA1, kB1, vA1, vB1)
#undef STAGE_UNIT
    if (tid < 64) {
      float g63 = __shfl(pgc, 63);
      sg[lane] = pgc;
      sbt[lane] = pbe;
      seg[lane] = __expf(pgc);
      sdt[lane] = __expf(g63 - pgc);
    }
    __syncthreads();
    f32x16 v0, v1;
#pragma unroll
    for (int r = 0; r < 16; ++r) {
      const int t0 = rowmap(r, hh);
      v0[r] = bf2f(sV[t0 * 136 + w * 32 + li]);
      v1[r] = bf2f(sV[(32 + t0) * 136 + w * 32 + li]);
    }
    __syncthreads();
    {
      const int i0 = tid >> 3, c8 = tid & 7;
      *(uint2*)(sT + i0 * 68 + c8 * 8) = make_uint2(tq0.x, tq0.y);
      *(uint2*)(sT + i0 * 68 + c8 * 8 + 4) = make_uint2(tq0.z, tq0.w);
      *(uint2*)(sT + (i0 + 32) * 68 + c8 * 8) = make_uint2(tq1.x, tq1.y);
      *(uint2*)(sT + (i0 + 32) * 68 + c8 * 8 + 4) = make_uint2(tq1.z, tq1.w);
    }
    {
      const int mi = w >> 1, ni = w & 1;
      f32x16 a;
#pragma unroll
      for (int r = 0; r < 16; ++r) a[r] = 0.f;
      if (!(mi == 0 && ni == 1)) {
#pragma unroll
        for (int ks = 0; ks < 8; ++ks) {
          bf16x8 qa = *(const bf16x8*)(sQ + (mi * 32 + li) * 136 + ks * 16 + hh * 8);
          bf16x8 kb = *(const bf16x8*)(sK + (ni * 32 + li) * 136 + ks * 16 + hh * 8);
          a = __builtin_amdgcn_mfma_f32_32x32x16_bf16(qa, kb, a, 0, 0, 0);
        }
      }
#pragma unroll
      for (int r = 0; r < 16; ++r) {
        const int i = mi * 32 + rowmap(r, hh), j = ni * 32 + li;
        float val = (i >= j) ? a[r] * qscale * __expf(sg[i] - sg[j]) : 0.f;
        sA[i * 68 + j] = f2bf(val);
      }
    }
    __syncthreads();
    f32x16 ks0, ks1;
#pragma unroll
    for (int r = 0; r < 16; ++r) { ks0[r] = 0.f; ks1[r] = 0.f; }
    {
      const bf16_t* ka = sK + li * 136 + 4 * hh;
#define K_STEP(OFFS, SX, SS)                                                                           \
  {                                                                                                    \
    bf16x8 sb = pack8(SX, SS);                                                                         \
    ks0 = __builtin_amdgcn_mfma_f32_32x32x16_bf16(ld_perm(ka + (OFFS)), sb, ks0, 0, 0, 0);             \
    ks1 = __builtin_amdgcn_mfma_f32_32x32x16_bf16(ld_perm(ka + 32 * 136 + (OFFS)), sb, ks1, 0, 0, 0);  \
  }
      K_STEP(0, S0, 0) K_STEP(16, S0, 1) K_STEP(32, S1, 0) K_STEP(48, S1, 1)
      K_STEP(64, S2, 0) K_STEP(80, S2, 1) K_STEP(96, S3, 0) K_STEP(112, S3, 1)
#undef K_STEP
    }
#pragma unroll
    for (int r = 0; r < 16; ++r) {
      const int t0 = rowmap(r, hh), t1 = 32 + t0;
      v0[r] = sbt[t0] * (v0[r] - seg[t0] * ks0[r]);
      v1[r] = sbt[t1] * (v1[r] - seg[t1] * ks1[r]);
    }
    bf16x8 rb00 = pack8(v0, 0), rb01 = pack8(v0, 1), rb10 = pack8(v1, 0), rb11 = pack8(v1, 1);
    f32x16 n0, n1;
#pragma unroll
    for (int r = 0; r < 16; ++r) { n0[r] = 0.f; n1[r] = 0.f; }
    {
      const bf16_t* ta = sT + li * 68 + 4 * hh;
      n0 = __builtin_amdgcn_mfma_f32_32x32x16_bf16(ld_perm(ta + 0), rb00, n0, 0, 0, 0);
      n0 = __builtin_amdgcn_mfma_f32_32x32x16_bf16(ld_perm(ta + 16), rb01, n0, 0, 0, 0);
      const bf16_t* tb = ta + 32 * 68;
      n1 = __builtin_amdgcn_mfma_f32_32x32x16_bf16(ld_perm(tb + 0), rb00, n1, 0, 0, 0);
      n1 = __builtin_amdgcn_mfma_f32_32x32x16_bf16(ld_perm(tb + 16), rb01, n1, 0, 0, 0);
      n1 = __builtin_amdgcn_mfma_f32_32x32x16_bf16(ld_perm(tb + 32), rb10, n1, 0, 0, 0);
      n1 = __builtin_amdgcn_mfma_f32_32x32x16_bf16(ld_perm(tb + 48), rb11, n1, 0, 0, 0);
    }
    f32x16 o0, o1;
#pragma unroll
    for (int r = 0; r < 16; ++r) { o0[r] = 0.f; o1[r] = 0.f; }
    {
      const bf16_t* qa = sQ + li * 136 + 4 * hh;
#define Q_STEP(OFFS, SX, SS)                                                                           \
  {                                                                                                    \
    bf16x8 sb = pack8(SX, SS);                                                                         \
    o0 = __builtin_amdgcn_mfma_f32_32x32x16_bf16(ld_perm(qa + (OFFS)), sb, o0, 0, 0, 0);               \
    o1 = __builtin_amdgcn_mfma_f32_32x32x16_bf16(ld_perm(qa + 32 * 136 + (OFFS)), sb, o1, 0, 0, 0);    \
  }
      Q_STEP(0, S0, 0) Q_STEP(16, S0, 1) Q_STEP(32, S1, 0) Q_STEP(48, S1, 1)
      Q_STEP(64, S2, 0) Q_STEP(80, S2, 1) Q_STEP(96, S3, 0) Q_STEP(112, S3, 1)
#undef Q_STEP
    }
#pragma unroll
    for (int r = 0; r < 16; ++r) {
      const int t0 = rowmap(r, hh), t1 = 32 + t0;
      o0[r] *= seg[t0] * qscale;
      o1[r] *= seg[t1] * qscale;
    }
    {
      bf16x8 nb00 = pack8(n0, 0), nb01 = pack8(n0, 1), nb10 = pack8(n1, 0), nb11 = pack8(n1, 1);
      const bf16_t* aa = sA + li * 68 + 4 * hh;
      o0 = __builtin_amdgcn_mfma_f32_32x32x16_bf16(ld_perm(aa + 0), nb00, o0, 0, 0, 0);
      o0 = __builtin_amdgcn_mfma_f32_32x32x16_bf16(ld_perm(aa + 16), nb01, o0, 0, 0, 0);
      const bf16_t* ab = aa + 32 * 68;
      o1 = __builtin_amdgcn_mfma_f32_32x32x16_bf16(ld_perm(ab + 0), nb00, o1, 0, 0, 0);
      o1 = __builtin_amdgcn_mfma_f32_32x32x16_bf16(ld_perm(ab + 16), nb01, o1, 0, 0, 0);
      o1 = __builtin_amdgcn_mfma_f32_32x32x16_bf16(ld_perm(ab + 32), nb10, o1, 0, 0, 0);
      o1 = __builtin_amdgcn_mfma_f32_32x32x16_bf16(ld_perm(ab + 48), nb11, o1, 0, 0, 0);
    }
    __syncthreads();
#pragma unroll
    for (int r = 0; r < 16; ++r) {
      const int t0 = rowmap(r, hh);
      sQ[t0 * 136 + w * 32 + li] = f2bf(o0[r]);
      sQ[(32 + t0) * 136 + w * 32 + li] = f2bf(o1[r]);
    }
#pragma unroll
    for (int r = 0; r < 16; ++r) {
      const int t0 = rowmap(r, hh), t1 = 32 + t0;
      n0[r] *= sdt[t0];
      n1[r] *= sdt[t1];
    }
    {
      bf16x8 nb00 = pack8(n0, 0), nb01 = pack8(n0, 1), nb10 = pack8(n1, 0), nb11 = pack8(n1, 1);
      const float eg63 = seg[63];
#pragma unroll
      for (int r = 0; r < 16; ++r) { S0[r] *= eg63; S1[r] *= eg63; S2[r] *= eg63; S3[r] *= eg63; }
      SCAN_LOADS(min(n + 1, 35))
      const bf16_t* kt = sKT + li * 68 + 4 * hh;
#define S_UPD(SX, DKT)                                                                                   \
  SX = __builtin_amdgcn_mfma_f32_32x32x16_bf16(ld_perm(kt + (DKT) * 32 * 68 + 0), nb00, SX, 0, 0, 0);    \
  SX = __builtin_amdgcn_mfma_f32_32x32x16_bf16(ld_perm(kt + (DKT) * 32 * 68 + 16), nb01, SX, 0, 0, 0);   \
  SX = __builtin_amdgcn_mfma_f32_32x32x16_bf16(ld_perm(kt + (DKT) * 32 * 68 + 32), nb10, SX, 0, 0, 0);   \
  SX = __builtin_amdgcn_mfma_f32_32x32x16_bf16(ld_perm(kt + (DKT) * 32 * 68 + 48), nb11, SX, 0, 0, 0);
      S_UPD(S0, 0) S_UPD(S1, 1) S_UPD(S2, 2) S_UPD(S3, 3)
#undef S_UPD
    }
    __syncthreads();
    {
      bf16_t* obase = d ? (Pw + C_DN + h * 128) : (MIX + 512 + h * 128);
      const int ostride = d ? INWP : 1024;
#pragma unroll
      for (int e = 0; e < 4; ++e) {
        const int idx = tid + 256 * e, tok = idx >> 4, c8 = idx & 15;
        const int row = rstart + rsign * tok;
        *(uint4*)(obase + (size_t)row * ostride + c8 * 8) = *(const uint4*)(sQ + tok * 136 + c8 * 8);
      }
    }
  }
#undef SCAN_LOADS
#undef SCAN_ROW0
  __builtin_amdgcn_s_setprio(0);
}

__device__ void phaseC(const Params& p, int l, char* smem) {
  const int nb = gridDim.x, bid = blockIdx.x;
  const bf16_t* P = (const bf16_t*)(p.ws + OFF_P);
  constexpr int T0 = 1152, T1 = T0 + 144 * 3, T2 = T1 + 144 * 4, T3 = T2 + M_ALL / 8;
  for (int it = bid; it < T3; it += nb) {
    if (it < T0) {
      dn_chunk_prep(p, l, it, smem);
    } else if (it < T1) {
      int i = it - T0;
      if (l == 3 && i >= 128 * 3) continue;
      gemm_tile<EPI_QUP>(p, l, P + C_MQ, INWP, (const bf16_t*)(p.ws + OFF_WQUP), 256, (i / 3) * 128, (i % 3) * 128, 0,
                         smem);
    } else if (it < T2) {
      int i = it - T1;
      gemm_tile<EPI_KVUP>(p, l, P + C_MKV, INWP, (const bf16_t*)(p.ws + OFF_WKVUP), 128, (i / 4) * 128, (i % 4) * 128,
                          0, smem);
    } else {
      kpe_item(p, it - T2);
    }
  }
}

__device__ void mla_flash(const Params& p, int item, char* smem) {
  bf16_t* sK = (bf16_t*)smem;
  bf16_t* sV = sK + 64 * 104;
  const int tid = otid(), lane = tid & 63, w = tid >> 6;
  const int li = lane & 31, hh = lane >> 5;
  int b, h, q0row, nkeys;
  if (item < 512) {
    b = item >> 6; h = (item >> 4) & 3; q0row = b * 2048 + (item & 15) * 128; nkeys = 2304;
  } else {
    int i = item - 512;
    b = i >> 3; h = (i >> 1) & 3; q0row = M_LAT + b * 256 + (i & 1) * 128; nkeys = 256;
  }
  const bf16_t* Kg = (const bf16_t*)(p.ws + OFF_KH) + (size_t)(b * 4 + h) * 2304 * 96;
  const bf16_t* Vg = (const bf16_t*)(p.ws + OFF_VH) + (size_t)(b * 4 + h) * 64 * 2304;
  const bf16_t* QH = (const bf16_t*)(p.ws + OFF_QH);
  bf16_t* MIX = (bf16_t*)(p.ws + OFF_HM);
  const int qrow = q0row + w * 32 + li;
  bf16x8 qf0, qf1, qf2, qf3, qf4, qf5;
  {
    const bf16_t* qp = QH + (size_t)qrow * 384 + h * 96 + hh * 8;
    qf0 = *(const bf16x8*)(qp); qf1 = *(const bf16x8*)(qp + 16); qf2 = *(const bf16x8*)(qp + 32);
    qf3 = *(const bf16x8*)(qp + 48); qf4 = *(const bf16x8*)(qp + 64); qf5 = *(const bf16x8*)(qp + 80);
  }
  const int k_i0 = tid, k_i1 = tid + 256, k_i2 = tid + 512;
  const int kk0 = k_i0 / 12, kc0 = k_i0 % 12, kk1 = k_i1 / 12, kc1 = k_i1 % 12, kk2 = k_i2 / 12, kc2 = k_i2 % 12;
  const int vd0 = tid >> 3, vc0 = tid & 7, vd1 = vd0 + 32;
  uint4 rk0, rk1, rk2, rv0, rv1;
  rk0 = *(const uint4*)(Kg + (size_t)kk0 * 96 + kc0 * 8);
  rk1 = *(const uint4*)(Kg + (size_t)kk1 * 96 + kc1 * 8);
  rk2 = *(const uint4*)(Kg + (size_t)kk2 * 96 + kc2 * 8);
  rv0 = *(const uint4*)(Vg + (size_t)vd0 * 2304 + vc0 * 8);
  rv1 = *(const uint4*)(Vg + (size_t)vd1 * 2304 + vc0 * 8);
  f32x16 o0, o1;
#pragma unroll
  for (int r = 0; r < 16; ++r) { o0[r] = 0.f; o1[r] = 0.f; }
  float m = -1e30f, lp = 0.f;
  const float sc = 0.10206207261596577f * 1.4426950408889634f;
  const int nt = nkeys >> 6;
  for (int t = 0; t < nt; ++t) {
    __syncthreads();
    *(uint4*)(sK + kk0 * 104 + kc0 * 8) = rk0;
    *(uint4*)(sK + kk1 * 104 + kc1 * 8) = rk1;
    *(uint4*)(sK + kk2 * 104 + kc2 * 8) = rk2;
    *(uint2*)(sV + vd0 * 68 + vc0 * 8) = make_uint2(rv0.x, rv0.y);
    *(uint2*)(sV + vd0 * 68 + vc0 * 8 + 4) = make_uint2(rv0.z, rv0.w);
    *(uint2*)(sV + vd1 * 68 + vc0 * 8) = make_uint2(rv1.x, rv1.y);
    *(uint2*)(sV + vd1 * 68 + vc0 * 8 + 4) = make_uint2(rv1.z, rv1.w);
    __syncthreads();
    if (t + 1 < nt) {
      const int k0 = (t + 1) * 64;
      rk0 = *(const uint4*)(Kg + (size_t)(k0 + kk0) * 96 + kc0 * 8);
      rk1 = *(const uint4*)(Kg + (size_t)(k0 + kk1) * 96 + kc1 * 8);
      rk2 = *(const uint4*)(Kg + (size_t)(k0 + kk2) * 96 + kc2 * 8);
      rv0 = *(const uint4*)(Vg + (size_t)vd0 * 2304 + k0 + vc0 * 8);
      rv1 = *(const uint4*)(Vg + (size_t)vd1 * 2304 + k0 + vc0 * 8);
    }
    f32x16 s0, s1;
#pragma unroll
    for (int r = 0; r < 16; ++r) { s0[r] = 0.f; s1[r] = 0.f; }
    {
      const bf16_t* ka = sK + li * 104 + hh * 8;
      const bf16_t* kb = ka + 32 * 104;
      s0 = __builtin_amdgcn_mfma_f32_32x32x16_bf16(*(const bf16x8*)(ka), qf0, s0, 0, 0, 0);
      s1 = __builtin_amdgcn_mfma_f32_32x32x16_bf16(*(const bf16x8*)(kb), qf0, s1, 0, 0, 0);
      s0 = __builtin_amdgcn_mfma_f32_32x32x16_bf16(*(const bf16x8*)(ka + 16), qf1, s0, 0, 0, 0);
      s1 = __builtin_amdgcn_mfma_f32_32x32x16_bf16(*(const bf16x8*)(kb + 16), qf1, s1, 0, 0, 0);
      s0 = __builtin_amdgcn_mfma_f32_32x32x16_bf16(*(const bf16x8*)(ka + 32), qf2, s0, 0, 0, 0);
      s1 = __builtin_amdgcn_mfma_f32_32x32x16_bf16(*(const bf16x8*)(kb + 32), qf2, s1, 0, 0, 0);
      s0 = __builtin_amdgcn_mfma_f32_32x32x16_bf16(*(const bf16x8*)(ka + 48), qf3, s0, 0, 0, 0);
      s1 = __builtin_amdgcn_mfma_f32_32x32x16_bf16(*(const bf16x8*)(kb + 48), qf3, s1, 0, 0, 0);
      s0 = __builtin_amdgcn_mfma_f32_32x32x16_bf16(*(const bf16x8*)(ka + 64), qf4, s0, 0, 0, 0);
      s1 = __builtin_amdgcn_mfma_f32_32x32x16_bf16(*(const bf16x8*)(kb + 64), qf4, s1, 0, 0, 0);
      s0 = __builtin_amdgcn_mfma_f32_32x32x16_bf16(*(const bf16x8*)(ka + 80), qf5, s0, 0, 0, 0);
      s1 = __builtin_amdgcn_mfma_f32_32x32x16_bf16(*(const bf16x8*)(kb + 80), qf5, s1, 0, 0, 0);
    }
    float mx = s0[0];
#pragma unroll
    for (int r = 1; r < 16; ++r) mx = fmaxf(mx, s0[r]);
#pragma unroll
    for (int r = 0; r < 16; ++r) mx = fmaxf(mx, s1[r]);
    mx = fmaxf(mx, __shfl_xor(mx, 32));
    const float mn = fmaxf(m, mx * sc);
    const float corr = __builtin_amdgcn_exp2f(m - mn);
    m = mn;
    lp *= corr;
#pragma unroll
    for (int r = 0; r < 16; ++r) { o0[r] *= corr; o1[r] *= corr; }
#pragma unroll
    for (int r = 0; r < 16; ++r) {
      s0[r] = __builtin_amdgcn_exp2f(s0[r] * sc - mn);
      s1[r] = __builtin_amdgcn_exp2f(s1[r] * sc - mn);
      lp += s0[r] + s1[r];
    }
#pragma unroll
    for (int u = 0; u < 2; ++u) {
#pragma unroll
      for (int s = 0; s < 2; ++s) {
        union { bf16x8 v; unsigned w[4]; } pb;
        if (u == 0) {
          pb.w[0] = pack2(s0[8 * s + 0], s0[8 * s + 1]); pb.w[1] = pack2(s0[8 * s + 2], s0[8 * s + 3]);
          pb.w[2] = pack2(s0[8 * s + 4], s0[8 * s + 5]); pb.w[3] = pack2(s0[8 * s + 6], s0[8 * s + 7]);
        } else {
          pb.w[0] = pack2(s1[8 * s + 0], s1[8 * s + 1]); pb.w[1] = pack2(s1[8 * s + 2], s1[8 * s + 3]);
          pb.w[2] = pack2(s1[8 * s + 4], s1[8 * s + 5]); pb.w[3] = pack2(s1[8 * s + 6], s1[8 * s + 7]);
        }
        const bf16_t* va = sV + li * 68 + 32 * u + 16 * s + 4 * hh;
        union { bf16x8 v; uint2 d[2]; } a0, a1;
        a0.d[0] = *(const uint2*)(va);
        a0.d[1] = *(const uint2*)(va + 8);
        a1.d[0] = *(const uint2*)(va + 32 * 68);
        a1.d[1] = *(const uint2*)(va + 32 * 68 + 8);
        o0 = __builtin_amdgcn_mfma_f32_32x32x16_bf16(a0.v, pb.v, o0, 0, 0, 0);
        o1 = __builtin_amdgcn_mfma_f32_32x32x16_bf16(a1.v, pb.v, o1, 0, 0, 0);
      }
    }
  }
  lp += __shfl_xor(lp, 32);
  const float inv = 1.f / lp;
  bf16_t* op = MIX + (size_t)qrow * 1024 + h * 64 + 4 * hh;
#pragma unroll
  for (int g = 0; g < 4; ++g) {
    uint2 u0, u1;
    u0.x = pack2(o0[4 * g + 0] * inv, o0[4 * g + 1] * inv);
    u0.y = pack2(o0[4 * g + 2] * inv, o0[4 * g + 3] * inv);
    u1.x = pack2(o1[4 * g + 0] * inv, o1[4 * g + 1] * inv);
    u1.y = pack2(o1[4 * g + 2] * inv, o1[4 * g + 3] * inv);
    *(uint2*)(op + 8 * g) = u0;
    *(uint2*)(op + 32 + 8 * g) = u1;
  }
}

__device__ void na_naive(const Params& p, int l, int ti) {
  const int h = otid() >> 6, lane = otid() & 63;
  const bf16_t* P = (const bf16_t*)(p.ws + OFF_P);
  bf16_t* MIX = (bf16_t*)(p.ws + OFF_HM);
  const bool lat = ti < 256;
  const int b = lat ? (ti >> 5) : ((ti - 256) >> 2);
  const int r = ti & 31;
  const int row = lat ? (ti * 64 + lane) : (M_LAT + (ti - 256) * 64 + lane);
  uint4 qk[8];
  float acc[64];
  {
    const uint4* qp = (const uint4*)(P + (size_t)row * INWP + C_NQ + h * 64);
#pragma unroll
    for (int c = 0; c < 8; ++c) qk[c] = qp[c];
  }
#pragma unroll
  for (int i = 0; i < 64; ++i) acc[i] = 0.f;
  float m = -INFINITY, ls = 0.f;
  const int qc = lane;
  const int rs0 = min(max(r - 4, 0), 24);
  const int cs0 = min(max(qc - 8, 0), 48);
  const float* rb = p.rel_bias + (size_t)l * 4 * 15 * 31 + h * 15 * 31;
  const int nloc = lat ? 128 : 0;
  for (int j = 0; j < nloc + 256; ++j) {
    int krow;
    float bias = 0.f;
    if (j < nloc) {
      int kr = rs0 + (j >> 4), kc = cs0 + (j & 15);
      krow = b * 2048 + kr * 64 + kc;
      bias = rb[(kr - r + 7) * 31 + (kc - qc + 15)];
    } else {
      krow = M_LAT + b * 256 + (j - nloc);
    }
    const uint4* kp = (const uint4*)(P + (size_t)krow * INWP + C_NK + h * 64);
    float s = 0.f;
#pragma unroll
    for (int c = 0; c < 8; ++c) {
      uint4 u = kp[c];
      uint4 q = qk[c];
      s += bflo(q.x) * bflo(u.x) + bfhi(q.x) * bfhi(u.x) + bflo(q.y) * bflo(u.y) + bfhi(q.y) * bfhi(u.y) +
           bflo(q.z) * bflo(u.z) + bfhi(q.z) * bfhi(u.z) + bflo(q.w) * bflo(u.w) + bfhi(q.w) * bfhi(u.w);
    }
    s = s * 0.125f + bias;
    float mn = fmaxf(m, s);
    float corr = __expf(m - mn), pe = __expf(s - mn);
    ls = ls * corr + pe;
    m = mn;
    const uint4* vp = (const uint4*)(P + (size_t)krow * INWP + C_NV + h * 64);
#pragma unroll
    for (int c = 0; c < 8; ++c) {
      uint4 u = vp[c];
      acc[c * 8 + 0] = acc[c * 8 + 0] * corr + pe * bflo(u.x);
      acc[c * 8 + 1] = acc[c * 8 + 1] * corr + pe * bfhi(u.x);
      acc[c * 8 + 2] = acc[c * 8 + 2] * corr + pe * bflo(u.y);
      acc[c * 8 + 3] = acc[c * 8 + 3] * corr + pe * bfhi(u.y);
      acc[c * 8 + 4] = acc[c * 8 + 4] * corr + pe * bflo(u.z);
      acc[c * 8 + 5] = acc[c * 8 + 5] * corr + pe * bfhi(u.z);
      acc[c * 8 + 6] = acc[c * 8 + 6] * corr + pe * bflo(u.w);
      acc[c * 8 + 7] = acc[c * 8 + 7] * corr + pe * bfhi(u.w);
    }
  }
  const float inv = 1.f / ls;
  uint4* op = (uint4*)(MIX + (size_t)row * 1024 + 256 + h * 64);
#pragma unroll
  for (int c = 0; c < 8; ++c) {
    uint4 u;
    u.x = pack2(acc[c * 8 + 0] * inv, acc[c * 8 + 1] * inv);
    u.y = pack2(acc[c * 8 + 2] * inv, acc[c * 8 + 3] * inv);
    u.z = pack2(acc[c * 8 + 4] * inv, acc[c * 8 + 5] * inv);
    u.w = pack2(acc[c * 8 + 6] * inv, acc[c * 8 + 7] * inv);
    op[c] = u;
  }
}

__device__ void na_flash(const Params& p, int l, int item, char* smem) {
  bf16_t* sK = (bf16_t*)smem;
  bf16_t* sV = sK + 64 * 72;
  float* sBias = (float*)(smem + 18432);
  const int tid = otid(), lane = tid & 63, w = tid >> 6;
  const int li = lane & 31, hh = lane >> 5;
  const bf16_t* P = (const bf16_t*)(p.ws + OFF_P);
  bf16_t* MIX = (bf16_t*)(p.ws + OFF_HM);
  int b, h, qrow, qr = 0, qc = 0, rs0 = 0, ntiles, krow0 = 0;
  bool lat;
  if (item < 512) {
    lat = true;
    b = item >> 6; h = item & 3;
    const int r0 = ((item >> 2) & 15) * 2;
    qr = r0 + (w >> 1); qc = (w & 1) * 32 + li;
    qrow = b * 2048 + qr * 64 + qc;
    krow0 = min(max(r0 - 4, 0), 24);
    const int klast = min(max(r0 + 1 - 4, 0), 24) + 7;
    ntiles = 4 + (klast - krow0 + 1);
    rs0 = min(max(qr - 4, 0), 24);
  } else {
    lat = false;
    const int i = item - 512;
    b = i >> 3; h = i & 3;
    qrow = M_LAT + b * 256 + ((i >> 2) & 1) * 128 + w * 32 + li;
    ntiles = 4;
  }
  const int cs0 = min(max(qc - 8, 0), 48);
  const bf16_t* Vg = (const bf16_t*)(p.ws + OFF_NVT) + (size_t)(b * 4 + h) * 64 * 2304;
  bf16x8 qf0, qf1, qf2, qf3;
  {
    const bf16_t* qp = P + (size_t)qrow * INWP + C_NQ + h * 64 + hh * 8;
    qf0 = *(const bf16x8*)(qp); qf1 = *(const bf16x8*)(qp + 16); qf2 = *(const bf16x8*)(qp + 32); qf3 = *(const bf16x8*)(qp + 48);
  }
  __syncthreads();
  for (int i = tid; i < 465; i += 256)
    sBias[i] = p.rel_bias[(size_t)l * 4 * 465 + h * 465 + i] * 1.4426950408889634f;
  const int kk0 = tid >> 3, kc8 = tid & 7, kk1 = kk0 + 32;
  uint4 rk0, rk1, rv0, rv1;
  {
    const size_t kr = (size_t)(M_LAT + b * 256);
    rk0 = *(const uint4*)(P + (kr + kk0) * INWP + C_NK + h * 64 + kc8 * 8);
    rk1 = *(const uint4*)(P + (kr + kk1) * INWP + C_NK + h * 64 + kc8 * 8);
    rv0 = *(const uint4*)(Vg + (size_t)kk0 * 2304 + kc8 * 8);
    rv1 = *(const uint4*)(Vg + (size_t)kk1 * 2304 + kc8 * 8);
  }
  f32x16 o0, o1;
#pragma unroll
  for (int r = 0; r < 16; ++r) { o0[r] = 0.f; o1[r] = 0.f; }
  float m = -1e30f, lp = 0.f;
  const float sc = 0.125f * 1.4426950408889634f;
  for (int t = 0; t < ntiles; ++t) {
    __syncthreads();
    *(uint4*)(sK + kk0 * 72 + kc8 * 8) = rk0;
    *(uint4*)(sK + kk1 * 72 + kc8 * 8) = rk1;
    *(uint2*)(sV + kk0 * 68 + kc8 * 8) = make_uint2(rv0.x, rv0.y);
    *(uint2*)(sV + kk0 * 68 + kc8 * 8 + 4) = make_uint2(rv0.z, rv0.w);
    *(uint2*)(sV + kk1 * 68 + kc8 * 8) = make_uint2(rv1.x, rv1.y);
    *(uint2*)(sV + kk1 * 68 + kc8 * 8 + 4) = make_uint2(rv1.z, rv1.w);
    __syncthreads();
    if (t + 1 < ntiles) {
      const int tn = t + 1;
      size_t kr;
      int vk;
      if (tn < 4) { kr = (size_t)(M_LAT + b * 256 + tn * 64); vk = tn * 64; }
      else { kr = (size_t)(b * 2048 + (krow0 + tn - 4) * 64); vk = 256 + (krow0 + tn - 4) * 64; }
      rk0 = *(const uint4*)(P + (kr + kk0) * INWP + C_NK + h * 64 + kc8 * 8);
      rk1 = *(const uint4*)(P + (kr + kk1) * INWP + C_NK + h * 64 + kc8 * 8);
      rv0 = *(const uint4*)(Vg + (size_t)kk0 * 2304 + vk + kc8 * 8);
      rv1 = *(const uint4*)(Vg + (size_t)kk1 * 2304 + vk + kc8 * 8);
    }
    const int kr_abs = krow0 + t - 4;
    const bool local = t >= 4;
    if (local && (kr_abs < rs0 || kr_abs >= rs0 + 8)) continue;
    f32x16 s0, s1;
#pragma unroll
    for (int r = 0; r < 16; ++r) { s0[r] = 0.f; s1[r] = 0.f; }
    {
      const bf16_t* ka = sK + li * 72 + hh * 8;
      const bf16_t* kb = ka + 32 * 72;
      s0 = __builtin_amdgcn_mfma_f32_32x32x16_bf16(*(const bf16x8*)(ka), qf0, s0, 0, 0, 0);
      s1 = __builtin_amdgcn_mfma_f32_32x32x16_bf16(*(const bf16x8*)(kb), qf0, s1, 0, 0, 0);
      s0 = __builtin_amdgcn_mfma_f32_32x32x16_bf16(*(const bf16x8*)(ka + 16), qf1, s0, 0, 0, 0);
      s1 = __builtin_amdgcn_mfma_f32_32x32x16_bf16(*(const bf16x8*)(kb + 16), qf1, s1, 0, 0, 0);
      s0 = __builtin_amdgcn_mfma_f32_32x32x16_bf16(*(const bf16x8*)(ka + 32), qf2, s0, 0, 0, 0);
      s1 = __builtin_amdgcn_mfma_f32_32x32x16_bf16(*(const bf16x8*)(kb + 32), qf2, s1, 0, 0, 0);
      s0 = __builtin_amdgcn_mfma_f32_32x32x16_bf16(*(const bf16x8*)(ka + 48), qf3, s0, 0, 0, 0);
      s1 = __builtin_amdgcn_mfma_f32_32x32x16_bf16(*(const bf16x8*)(kb + 48), qf3, s1, 0, 0, 0);
    }
    if (local) {
      const float* bp = sBias + (kr_abs - qr + 7) * 31 - qc + 15;
#pragma unroll
      for (int r = 0; r < 16; ++r) {
        const int kc0 = rowmap(r, hh), kc1 = 32 + kc0;
        const bool v0 = (kc0 >= cs0) && (kc0 < cs0 + 16);
        const bool v1 = (kc1 >= cs0) && (kc1 < cs0 + 16);
        const float b0 = v0 ? bp[kc0] : 0.f;
        const float b1 = v1 ? bp[kc1] : 0.f;
        s0[r] = v0 ? (s0[r] * sc + b0) : -1e30f;
        s1[r] = v1 ? (s1[r] * sc + b1) : -1e30f;
      }
    } else {
#pragma unroll
      for (int r = 0; r < 16; ++r) { s0[r] *= sc; s1[r] *= sc; }
    }
    float mx = s0[0];
#pragma unroll
    for (int r = 1; r < 16; ++r) mx = fmaxf(mx, s0[r]);
#pragma unroll
    for (int r = 0; r < 16; ++r) mx = fmaxf(mx, s1[r]);
    mx = fmaxf(mx, __shfl_xor(mx, 32));
    const float mn = fmaxf(m, mx);
    const float corr = __builtin_amdgcn_exp2f(m - mn);
    m = mn;
    lp *= corr;
#pragma unroll
    for (int r = 0; r < 16; ++r) { o0[r] *= corr; o1[r] *= corr; }
#pragma unroll
    for (int r = 0; r < 16; ++r) {
      s0[r] = __builtin_amdgcn_exp2f(s0[r] - mn);
      s1[r] = __builtin_amdgcn_exp2f(s1[r] - mn);
      lp += s0[r] + s1[r];
    }
#pragma unroll
    for (int u = 0; u < 2; ++u) {
#pragma unroll
      for (int s = 0; s < 2; ++s) {
        bf16x8 pb = u == 0 ? pack8(s0, s) : pack8(s1, s);
        const bf16_t* va = sV + li * 68 + 32 * u + 16 * s + 4 * hh;
        o0 = __builtin_amdgcn_mfma_f32_32x32x16_bf16(ld_perm(va), pb, o0, 0, 0, 0);
        o1 = __builtin_amdgcn_mfma_f32_32x32x16_bf16(ld_perm(va + 32 * 68), pb, o1, 0, 0, 0);
      }
    }
  }
  lp += __shfl_xor(lp, 32);
  const float inv = 1.f / lp;
  bf16_t* op = MIX + (size_t)qrow * 1024 + 256 + h * 64 + 4 * hh;
#pragma unroll
  for (int g = 0; g < 4; ++g) {
    uint2 u0, u1;
    u0.x = pack2(o0[4 * g + 0] * inv, o0[4 * g + 1] * inv);
    u0.y = pack2(o0[4 * g + 2] * inv, o0[4 * g + 3] * inv);
    u1.x = pack2(o1[4 * g + 0] * inv, o1[4 * g + 1] * inv);
    u1.y = pack2(o1[4 * g + 2] * inv, o1[4 * g + 3] * inv);
    *(uint2*)(op + 8 * g) = u0;
    *(uint2*)(op + 32 + 8 * g) = u1;
  }
}

DEVI int dn_rowof(int s, int b, int d) {
  if (s < 256) {
    int c = d ? (255 - s) : s;
    return M_LAT + b * 256 + c;
  }
  int t = s - 256;
  t = d ? (2047 - t) : t;
  return b * 2048 + t;
}

__device__ void dn_naive(const Params& p, int l, int it, char* smem) {
  float* ks = (float*)smem;
  float* qs = ks + 32 * 128;
  float* vs = qs + 32 * 128;
  float* gs = vs + 32 * 64;
  float* bs = gs + 32;
  const int half = it & 1, d = (it >> 1) & 1, h = (it >> 2) & 3, b = it >> 4;
  const int tid = otid(), w = tid >> 6, lane = tid & 63, c = lane & 15, kg = lane >> 4;
  const int col = half * 64 + w * 16 + c;
  const bf16_t* DQ = (const bf16_t*)(p.ws + OFF_DNQKV);
  const float* AB = (const float*)(p.ws + OFF_AB);
  bf16_t* MIX = (bf16_t*)(p.ws + OFF_HM);
  bf16_t* OB = (bf16_t*)(p.ws + OFF_OB);
  float S[32];
#pragma unroll
  for (int i = 0; i < 32; ++i) S[i] = 0.f;
  const float Aneg = -__expf(p.a_log[l * 8 + d * 4 + h]);
  const float dtb = p.dt_bias[l * 8 + d * 4 + h];
  for (int s0 = 0; s0 < 2304; s0 += 32) {
    __syncthreads();
    for (int i = tid; i < 32 * 128; i += 256) {
      int tk = i >> 7, ch = i & 127;
      int row = dn_rowof(s0 + tk, b, d);
      qs[i] = bf2f(DQ[(size_t)row * 1536 + h * 128 + ch]);
      ks[i] = bf2f(DQ[(size_t)row * 1536 + 512 + h * 128 + ch]);
    }
    for (int i = tid; i < 32 * 64; i += 256) {
      int tk = i >> 6, ch = i & 63;
      int row = dn_rowof(s0 + tk, b, d);
      vs[i] = bf2f(DQ[(size_t)row * 1536 + 1024 + h * 128 + half * 64 + ch]);
    }
    if (tid < 32) {
      int row = dn_rowof(s0 + tid, b, d);
      float a = AB[(size_t)row * 16 + d * 4 + h];
      float bb = AB[(size_t)row * 16 + 8 + d * 4 + h];
      float xx = a + dtb;
      const float ee = __expf(xx);
    float sp = ee < 0.25f ? ee * (1.f - ee * (0.5f - ee * (0.33333333f - ee * (0.25f - 0.2f * ee))))
                          : (xx > 20.f ? xx : __logf(1.f + ee));
      gs[tid] = __expf(Aneg * sp);
      bs[tid] = 1.f / (1.f + __expf(-bb));
    }
    __syncthreads();
    for (int tk = 0; tk < 32; ++tk) {
      const float eg = gs[tk], beta = bs[tk];
      const float vv = vs[tk * 64 + w * 16 + c];
      const float4* k4 = (const float4*)(ks + tk * 128 + kg * 32);
      const float4* q4 = (const float4*)(qs + tk * 128 + kg * 32);
      float part = 0.f;
#pragma unroll
      for (int i = 0; i < 8; ++i) {
        float4 kk = k4[i];
        S[4 * i + 0] *= eg; S[4 * i + 1] *= eg; S[4 * i + 2] *= eg; S[4 * i + 3] *= eg;
        part += kk.x * S[4 * i + 0] + kk.y * S[4 * i + 1] + kk.z * S[4 * i + 2] + kk.w * S[4 * i + 3];
      }
      part += __shfl_xor(part, 16);
      part += __shfl_xor(part, 32);
      const float delta = beta * (vv - part);
      float po = 0.f;
#pragma unroll
      for (int i = 0; i < 8; ++i) {
        float4 kk = k4[i];
        float4 qq = q4[i];
        S[4 * i + 0] += kk.x * delta; S[4 * i + 1] += kk.y * delta; S[4 * i + 2] += kk.z * delta; S[4 * i + 3] += kk.w * delta;
        po += qq.x * S[4 * i + 0] + qq.y * S[4 * i + 1] + qq.z * S[4 * i + 2] + qq.w * S[4 * i + 3];
      }
      po += __shfl_xor(po, 16);
      po += __shfl_xor(po, 32);
      if (kg == 0) {
        int row = dn_rowof(s0 + tk, b, d);
        float o = po * 0.08838834764831845f;
        if (d == 0)
          MIX[(size_t)row * 1024 + 512 + h * 128 + col] = f2bf(o);
        else
          OB[(size_t)row * 512 + h * 128 + col] = f2bf(o);
      }
    }
  }
}

__device__ void phaseD(const Params& p, int l, char* smem) {
  const int nb = gridDim.x, bid = blockIdx.x;
  if (bid < 64) {
    dn_scan(p, l, bid, smem);
    return;
  }
  if (bid >= 256 && bid < 320) return;
  const int nb2 = nb - 128;
  const int wid = bid < 256 ? bid - 64 : bid - 128;
  const int n_early = l < 3 ? N_CONV_EARLY : 0;
  for (int it = wid; it < 1152 + N_CONV_LATE + n_early; it += nb2) {
    if (it < 576) {
      int item = it;
      if (it < 512) item = ((it & 7) * 64) + (it >> 3);
      else if (l == 3) continue;
      mla_flash(p, item, smem);
    } else if (it < 1152) {
      if (l == 3 && it - 576 >= 512) continue;
      na_flash(p, l, it - 576, smem);
    } else if (it < 1152 + N_CONV_LATE) {
      conv_item_late(p, l, it - 1152, (float*)smem);
    } else {
      conv_item_early(p, l + 1, it - 1152 - N_CONV_LATE, (float*)smem);
    }
  }
}

__device__ void outgate_item(const Params& p, int l, int item) {
  const int w = otid() >> 6, lane = otid() & 63;
  const int row = item * 4 + w;
  const bf16_t* P = (const bf16_t*)(p.ws + OFF_P);
  bf16_t* MIX = (bf16_t*)(p.ws + OFF_HM);
  const int h = lane >> 4, cb = (lane & 15) * 8;
  uint4 uo = *(const uint4*)(MIX + (size_t)row * 1024 + 512 + h * 128 + cb);
  uint4 ub = *(const uint4*)(P + (size_t)row * INWP + C_DN + h * 128 + cb);
  uint4 uz = *(const uint4*)(P + (size_t)row * INWP + C_DZ + h * 128 + cb);
  float o[8], z[8];
  o[0] = bflo(uo.x) + bflo(ub.x); o[1] = bfhi(uo.x) + bfhi(ub.x); o[2] = bflo(uo.y) + bflo(ub.y); o[3] = bfhi(uo.y) + bfhi(ub.y);
  o[4] = bflo(uo.z) + bflo(ub.z); o[5] = bfhi(uo.z) + bfhi(ub.z); o[6] = bflo(uo.w) + bflo(ub.w); o[7] = bfhi(uo.w) + bfhi(ub.w);
  z[0] = bflo(uz.x); z[1] = bfhi(uz.x); z[2] = bflo(uz.y); z[3] = bfhi(uz.y);
  z[4] = bflo(uz.z); z[5] = bfhi(uz.z); z[6] = bflo(uz.w); z[7] = bfhi(uz.w);
  float ss = 0.f;
#pragma unroll
  for (int e = 0; e < 8; ++e) ss += o[e] * o[e];
  ss += __shfl_xor(ss, 1);
  ss += __shfl_xor(ss, 2);
  ss += __shfl_xor(ss, 4);
  ss += __shfl_xor(ss, 8);
  const float r = rsqrtf(ss * (1.f / 128.f) + 1e-6f);
  const float* go = p.g_out + l * 128 + cb;
  float y[8];
#pragma unroll
  for (int e = 0; e < 8; ++e) y[e] = o[e] * r * go[e] * silu_f(z[e]);
  uint4 u;
  u.x = pack2(y[0], y[1]); u.y = pack2(y[2], y[3]); u.z = pack2(y[4], y[5]); u.w = pack2(y[6], y[7]);
  *(uint4*)(MIX + (size_t)row * 1024 + 512 + h * 128 + cb) = u;
}

__device__ void final_item(const Params& p, int item) {
  const int w = otid() >> 6, lane = otid() & 63;
  const int row = item * 4 + w;
  const float4* xr = (const float4*)((const float*)(p.ws + OFF_X) + (size_t)row * 1024);
  float4 v[4];
  float ss = 0.f;
#pragma unroll
  for (int i = 0; i < 4; ++i) {
    v[i] = xr[lane + 64 * i];
    ss += v[i].x * v[i].x + v[i].y * v[i].y + v[i].z * v[i].z + v[i].w * v[i].w;
  }
  ss = wave_sum(ss);
  const float r = rsqrtf(ss * (1.f / 1024.f) + 1e-6f);
  const float4* g4 = (const float4*)p.g_final;
  float4* o4 = (float4*)(p.out + (size_t)row * 1024);
#pragma unroll
  for (int i = 0; i < 4; ++i) {
    float4 gg = g4[lane + 64 * i];
    float4 y;
    y.x = v[i].x * r * gg.x; y.y = v[i].y * r * gg.y; y.z = v[i].z * r * gg.z; y.w = v[i].w * r * gg.w;
    o4[lane + 64 * i] = y;
  }
}

constexpr int N_PHASES = 1 + 9 * 4 + 1;

__global__ void __launch_bounds__(256, 2) mega(Params p) {
  __shared__ __attribute__((aligned(16))) char smem[SMEM_BYTES];
  cg::grid_group grid = cg::this_grid();
  const int nb = gridDim.x, bid = blockIdx.x;
  __shared__ uint4 xb_words;
  if (threadIdx.x == 0) xb_words = make_uint4(0u, 0u, 0u, 0u);
  __syncthreads();
  XcdBarrier xb = xcd_barrier_post((unsigned*)(p.ws + OFF_BAR), (volatile LAS unsigned*)&xb_words);
#ifdef PROBE_S
  bool again = false;
#endif
  for (int ph = p.ph_lo; ph < p.ph_hi; ++ph) {
    if (ph == 0) {
      phase0(p, smem);
    } else if (ph == N_PHASES - 1) {
      for (int it = bid; it < M_LAT / 4; it += nb) final_item(p, it);
    } else {
      const int l = (ph - 1) / 9, s = (ph - 1) % 9;
      if (s == 0) {
        phaseA(p, l, smem);
      } else if (s == 1) {
        for (int it = bid; it < 144 * 13; it += nb) {
          int mt, nt;
          tile_map(it, 13, mt, nt);
          gemm_wide16<EPI_P>(p, l, (const bf16_t*)(p.ws + OFF_HM), 1024, (const bf16_t*)(p.ws + OFF_WIN), 1024,
                             mt * 128, nt * 256, smem);
        }
      } else if (s == 2) {
        phaseC(p, l, smem);
      } else if (s == 3) {
        phaseD(p, l, smem);
      } else if (s == 4) {
        for (int it = bid; it < (l == 3 ? M_LAT : M_ALL) / 4; it += nb) outgate_item(p, l, it);
      } else if (s == 5) {
        const int mpx = l == 3 ? 16 : 18;
        for (int it = bid; it < 8 * mpx * 8; it += nb) {
          int mt, nt;
          tile_map(it, 8, mt, nt, mpx);
          gemm_tile<EPI_RES>(p, l, (const bf16_t*)(p.ws + OFF_HM), 1024, (const bf16_t*)(p.ws + OFF_WOUT), 1024,
                             mt * 128, nt * 128, 2, smem);
        }
      } else if (s == 6) {
        for (int it = bid; it < (l == 3 ? M_LAT : M_ALL) / 4; it += nb)
          norm_rows(p, false, (bf16_t*)(p.ws + OFF_HM), p.g_ffn + l * 1024,
                    (const float*)(p.ws + OFF_MOD) + (size_t)l * 9 * 6144, 3, 4, it);
      } else if (s == 7) {
        const int mpx = l == 3 ? 16 : 18;
        for (int it = bid; it < 8 * mpx * 22; it += nb) {
          int mt, nt;
          tile_map(it, 22, mt, nt, mpx);
          gemm_wide16<EPI_GU>(p, l, (const bf16_t*)(p.ws + OFF_HM), 1024, (const bf16_t*)(p.ws + OFF_WGU), 1024,
                              mt * 128, nt * 256, smem);
        }
      } else {
        const int mpx = l == 3 ? 16 : 18;
        for (int it = bid; it < 8 * mpx * 8; it += nb) {
          int mt, nt;
          tile_map(it, 8, mt, nt, mpx);
          gemm_tile<EPI_RES>(p, l, (const bf16_t*)(p.ws + OFF_P), FFN, (const bf16_t*)(p.ws + OFF_WDN), FFN,
                             mt * 128, nt * 128, 5, smem);
        }
      }
    }
#ifdef PROBE_S
    {
      const bool hit = (PROBE_S == 9) ? (ph == 0) : (ph != 0 && ph != N_PHASES - 1 && ((ph - 1) % 9) == PROBE_S);
      if (hit && !again) {
        again = true;
        if (p.use_cg) grid.sync(); else xcd_barrier(xb);
        --ph;
        continue;
      }
      again = false;
    }
#endif
    if (ph + 1 < p.ph_hi) {
      if (p.use_cg) grid.sync();
      else xcd_barrier(xb);
    }
  }
}

extern "C" void kernel_launch(void* const* d_in, const int* in_sizes, int n_in, void* d_out, int out_size, void* d_ws,
                              size_t ws_size, hipStream_t stream) {
  static int grid_blocks = 0;
  if (!grid_blocks) {
    int dev = 0, cus = 0, per_cu = 0;
    hipGetDevice(&dev);
    hipDeviceGetAttribute(&cus, hipDeviceAttributeMultiprocessorCount, dev);
    hipOccupancyMaxActiveBlocksPerMultiprocessor(&per_cu, mega, 256, 0);
    if (per_cu < 1) per_cu = 1;
    if (per_cu > 2) per_cu = 2;
    grid_blocks = cus * per_cu;
  }
  Params p{};
  const float** pp = (const float**)&p;
  for (int i = 0; i < 23; ++i) pp[i] = (const float*)d_in[i];
  p.out = (float*)d_out;
  p.ws = (char*)d_ws;
  p.ph_lo = 0;
  p.ph_hi = N_PHASES;
  p.use_cg = 0;
  p.pad0 = 0;
  hipMemsetAsync((char*)d_ws + OFF_BAR, 0, XCD_BAR_WORDS * sizeof(unsigned), stream);
  void* args[] = {&p};
  hipError_t e = hipLaunchCooperativeKernel((void*)mega, dim3(grid_blocks), dim3(256), args, 0, stream);
  if (e != hipSuccess) {
    fprintf(stderr, "cooperative launch failed: %s (grid %d)\n", hipGetErrorString(e), grid_blocks);
    (void)hipGetLastError();
    for (int ph = 0; ph < N_PHASES; ++ph) {
      p.ph_lo = ph;
      p.ph_hi = ph + 1;
      hipLaunchKernelGGL(mega, dim3(grid_blocks), dim3(256), 0, stream, p);
    }
  }
}
```

```cpp
#include <hip/hip_runtime.h>
#include <hip/hip_bf16.h>
#include <hip/hip_cooperative_groups.h>
#include <cstdio>
namespace cg = cooperative_groups;

#define DEVI __device__ __forceinline__
typedef unsigned short bf16_t;
typedef short bf16x8 __attribute__((ext_vector_type(8)));
typedef float f32x16 __attribute__((ext_vector_type(16)));

constexpr int M_LAT = 16384, M_CTX = 2048, M_ALL = 18432;
constexpr int DM = 1024, INW = 3248, INWP = 3328, FFN = 2816;
constexpr int C_MQ = 0, C_MKV = 256, C_MPE = 384, C_NQ = 416, C_NK = 672, C_NV = 928, C_DN = 1184;
constexpr int C_DZ = C_DN + 1536, C_DA = C_DN + 2048;

constexpr size_t OFF_WIN = 0;
constexpr size_t OFF_WOUT = OFF_WIN + (size_t)INWP * 1024 * 2;
constexpr size_t OFF_WGU = OFF_WOUT + (size_t)1024 * 1024 * 2;
constexpr size_t OFF_WDN = OFF_WGU + (size_t)2 * FFN * 1024 * 2;
constexpr size_t OFF_WQUP = OFF_WDN + (size_t)1024 * FFN * 2;
constexpr size_t OFF_WKVUP = OFF_WQUP + (size_t)384 * 256 * 2;
constexpr size_t OFF_MOD = OFF_WKVUP + (size_t)512 * 128 * 2;
constexpr size_t OFF_ROPE = OFF_MOD + (size_t)4 * 9 * 6144 * 4;
constexpr size_t OFF_X = OFF_ROPE + (size_t)2048 * 16 * 2 * 4;
constexpr size_t OFF_HM = OFF_X + (size_t)M_ALL * 1024 * 4;
constexpr size_t OFF_P = OFF_HM + (size_t)M_ALL * 1024 * 2;
constexpr size_t OFF_QH = OFF_P + (size_t)M_ALL * INWP * 2;
constexpr size_t OFF_KH = OFF_QH + (size_t)M_ALL * 384 * 2;
constexpr size_t OFF_VH = OFF_KH + (size_t)M_ALL * 384 * 2;
constexpr size_t OFF_DNQKV = OFF_VH + (size_t)M_ALL * 256 * 2;
constexpr size_t OFF_OB = OFF_DNQKV + (size_t)M_ALL * 1536 * 2;
constexpr size_t OFF_AB = OFF_OB + (size_t)M_ALL * 512 * 2;
constexpr size_t OFF_GC = OFF_AB + (size_t)M_ALL * 16 * 4;
constexpr size_t OFF_BETA = OFF_GC + (size_t)M_ALL * 8 * 4;
constexpr size_t OFF_NVT = OFF_BETA + (size_t)M_ALL * 8 * 4;
constexpr size_t WS_TOTAL = OFF_NVT + (size_t)M_ALL * 256 * 2;
constexpr int SMEM_BYTES = 74240;
constexpr size_t OFF_BAR = (WS_TOTAL + 255) & ~(size_t)255;

struct Params {
  const float *x, *c, *ctx, *c_ctx, *w_ada, *b_ada, *g_mix, *w_in, *g_q, *g_kv, *w_qup, *w_kvup, *rel_bias,
      *conv_w, *a_log, *dt_bias, *g_out, *w_out, *g_ffn, *w_gate, *w_up, *w_down, *g_final;
  float* out;
  char* ws;
  int ph_lo, ph_hi;
  int use_cg, pad0;
};

DEVI bf16_t f2bf(float f) {
  __bf16 r = (__bf16)f;
  return __builtin_bit_cast(unsigned short, r);
}
DEVI int otid() {
  int t = threadIdx.x;
  asm volatile("" : "+v"(t));
  return t;
}
DEVI float bf2f(bf16_t h) { return __uint_as_float(((unsigned)h) << 16); }
DEVI float bflo(unsigned u) { return __uint_as_float(u << 16); }
DEVI float bfhi(unsigned u) { return __uint_as_float(u & 0xffff0000u); }
typedef __bf16 bf16v2_t __attribute__((ext_vector_type(2)));
typedef float f32v2_t __attribute__((ext_vector_type(2)));
DEVI unsigned pack2(float a, float b) {
  f32v2_t v = {a, b};
  bf16v2_t r = __builtin_convertvector(v, bf16v2_t);
  return __builtin_bit_cast(unsigned, r);
}
DEVI float silu_f(float x) { return x / (1.f + __expf(-x)); }
DEVI float wave_sum(float v) {
#pragma unroll
  for (int o = 32; o >= 1; o >>= 1) v += __shfl_xor(v, o);
  return v;
}

#define XB_TMO 128
#define XB_XCNT(j) (256 + 64 * (j))
#define XB_XSUB(j) (1280 + 64 * (j))
#define XB_XGEN(j) (2304 + 64 * (j))
#define XB_TOP 3328
#define XB_TOPGEN 3392
#define XCD_BAR_WORDS 3456
#define XB_SPIN_CAP (1u << 22)
#define LAS __attribute__((address_space(3)))
DEVI unsigned xb_ld(unsigned* p) { return __hip_atomic_load(p, __ATOMIC_RELAXED, __HIP_MEMORY_SCOPE_AGENT); }
DEVI unsigned xb_add(unsigned* p, unsigned v) { return __hip_atomic_fetch_add(p, v, __ATOMIC_RELAXED, __HIP_MEMORY_SCOPE_AGENT); }
DEVI unsigned xb_xcc_id() { return (unsigned)__builtin_amdgcn_s_getreg((3 << 11) | 20) & 0xFu; }
#define XB_SPIN(cond, bar)                                                     \
  do {                                                                         \
    unsigned _sp = 0;                                                          \
    while (cond) {                                                             \
      __builtin_amdgcn_s_sleep(6);                                             \
      if ((++_sp & 255u) == 0u) {                                              \
        if (xb_ld(&(bar)[XB_TMO])) break;                                      \
        if (_sp > XB_SPIN_CAP) { atomicAdd(&(bar)[XB_TMO], 1u); break; }       \
      }                                                                        \
    }                                                                          \
  } while (0)
struct XcdBarrier {
  unsigned* bar;
  unsigned x;
  volatile LAS unsigned* st;
};
DEVI XcdBarrier xcd_barrier_post(unsigned* bar, volatile LAS unsigned* st) {
  XcdBarrier b;
  b.bar = bar;
  b.x = xb_xcc_id();
  b.st = st;
  if (threadIdx.x == 0) (void)xb_add(&bar[XB_XCNT(b.x)], 1u);
  return b;
}
DEVI void xcd_barrier_complete(unsigned* bar, unsigned x, unsigned& nloc, unsigned& nx) {
  const unsigned G = gridDim.x * gridDim.y * gridDim.z;
  unsigned sum, cnt, mine, sp = 0u;
  for (;;) {
    sum = 0u; cnt = 0u; mine = 0u;
#pragma unroll
    for (unsigned j = 0; j < 16; ++j) {
      const unsigned c = xb_ld(&bar[XB_XCNT(j)]);
      sum += c;
      cnt += (c > 0u) ? 1u : 0u;
      mine = (j == x) ? c : mine;
    }
    if (sum == G) break;
    __builtin_amdgcn_s_sleep(1);
    if ((++sp & 255u) == 0u) {
      if (xb_ld(&bar[XB_TMO])) break;
      if (sp > XB_SPIN_CAP) { atomicAdd(&bar[XB_TMO], 1u); break; }
    }
  }
  nloc = mine > 0u ? mine : 1u;
  nx = cnt > 0u ? cnt : 1u;
}
DEVI void xcd_barrier(const XcdBarrier& b) {
  asm volatile("s_waitcnt vmcnt(0)" ::: "memory");
  __syncthreads();
  if (threadIdx.x == 0) {
    unsigned* bar = b.bar;
    __builtin_amdgcn_s_waitcnt(0);
    unsigned nloc = b.st[0], nx = b.st[1];
    if (nloc == 0u) {
      xcd_barrier_complete(bar, b.x, nloc, nx);
      b.st[0] = nloc;
      b.st[1] = nx;
    }
    const unsigned old = xb_add(&bar[XB_XSUB(b.x)], 1u);
    const unsigned gen = old / nloc;
    if (old + 1u == (gen + 1u) * nloc) {
      __builtin_amdgcn_fence(__ATOMIC_RELEASE, "agent");
      asm volatile("s_waitcnt vmcnt(0)" ::: "memory");
      const unsigned og = xb_add(&bar[XB_TOP], 1u);
      const unsigned tg = og / nx;
      if (og + 1u == (tg + 1u) * nx) xb_add(&bar[XB_TOPGEN], 1u);
      else XB_SPIN(xb_ld(&bar[XB_TOPGEN]) == tg, bar);
      __builtin_amdgcn_fence(__ATOMIC_ACQUIRE, "agent");
      xb_add(&bar[XB_XGEN(b.x)], 1u);
      asm volatile("s_waitcnt vmcnt(0)" ::: "memory");
    } else {
      XB_SPIN(xb_ld(&bar[XB_XGEN(b.x)]) == gen, bar);
      __builtin_amdgcn_fence(__ATOMIC_ACQUIRE, "agent");
      asm volatile("s_waitcnt vmcnt(0)" ::: "memory");
    }
  }
  __syncthreads();
}

constexpr int N_CONV_EARLY = 16 * 52 + 24 + 16;
__device__ void conv_item_early(const Params& p, int l, int it, float* tl);

__device__ void phase0(const Params& p, char* smem) {
  const int tid = otid(), nb = gridDim.x, bid = blockIdx.x;
  {
    float* rc = (float*)(p.ws + OFF_ROPE);
    float* rs = rc + 2048 * 16;
    for (int i = bid * 256 + tid; i < 2048 * 16; i += nb * 256) {
      int t = i >> 4, a = (i >> 3) & 1, j = i & 7;
      float pos = a ? (float)(t & 63) : (float)(t >> 6);
      float inv = __builtin_amdgcn_exp2f(-(float)j * (13.287712379549449f / 8.f));
      float ang = pos * inv;
      rc[i] = cosf(ang);
      rs[i] = sinf(ang);
    }
  }
  for (int it = bid; it < N_CONV_EARLY; it += nb) conv_item_early(p, 0, it, (float*)smem);
  __syncthreads();
  float* sc = (float*)smem;
  float* red = sc + 1024 * 12;
  float* MOD = (float*)(p.ws + OFF_MOD);
  bool loaded = false;
  for (int it = bid; it < 4 * 96; it += nb) {
    if (!loaded) {
      for (int i = tid; i < 9 * 1024; i += 256) {
        float v = i < 8192 ? p.c[i] : p.c_ctx[i - 8192];
        sc[(i & 1023) * 12 + (i >> 10)] = silu_f(v);
      }
      __syncthreads();
      loaded = true;
    }
    const int l = it / 96, n0 = (it % 96) * 64;
    const int cc = tid & 63, kg = tid >> 6;
    const float* w = p.w_ada + (size_t)l * 1024 * 6144 + n0 + cc;
    float acc[9];
#pragma unroll
    for (int b = 0; b < 9; ++b) acc[b] = 0.f;
    for (int k0 = kg * 256; k0 < kg * 256 + 256; k0 += 16) {
      float wvv[16];
#pragma unroll
      for (int j = 0; j < 16; ++j) wvv[j] = w[(size_t)(k0 + j) * 6144];
#pragma unroll
      for (int j = 0; j < 16; ++j) {
      const int k = k0 + j;
      const float wv = wvv[j];
      const float4 s0 = *(const float4*)(sc + k * 12);
      const float4 s1 = *(const float4*)(sc + k * 12 + 4);
      const float s2 = sc[k * 12 + 8];
      acc[0] += s0.x * wv; acc[1] += s0.y * wv; acc[2] += s0.z * wv; acc[3] += s0.w * wv;
      acc[4] += s1.x * wv; acc[5] += s1.y * wv; acc[6] += s1.z * wv; acc[7] += s1.w * wv;
      acc[8] += s2 * wv;
      }
    }
#pragma unroll
    for (int b = 0; b < 9; ++b) red[(kg * 9 + b) * 64 + cc] = acc[b];
    __syncthreads();
    for (int i = tid; i < 9 * 64; i += 256) {
      int b = i >> 6, c2 = i & 63;
      float s = red[(0 * 9 + b) * 64 + c2] + red[(1 * 9 + b) * 64 + c2] + red[(2 * 9 + b) * 64 + c2] +
                red[(3 * 9 + b) * 64 + c2];
      MOD[(size_t)(l * 9 + b) * 6144 + n0 + c2] = s + p.b_ada[l * 6144 + n0 + c2];
    }
    __syncthreads();
  }
}

__device__ void convT_tile(const float* __restrict__ src, int K, int N, bf16_t* __restrict__ dst, int mode,
                           const float* __restrict__ gs, int kt, int nt, float* tl) {
  const int tid = otid();
  const int k0 = kt * 64, n0 = nt * 64;
  __syncthreads();
#pragma unroll 4
  for (int i = 0; i < 16; ++i) {
    int kk = i * 4 + (tid >> 6), nn = tid & 63;
    float v = 0.f;
    if (n0 + nn < N) v = src[(size_t)(k0 + kk) * N + n0 + nn];
    if (gs) v *= gs[k0 + kk];
    tl[kk * 65 + nn] = v;
  }
  __syncthreads();
#pragma unroll 2
  for (int i = 0; i < 8; ++i) {
    int nn = i * 8 + (tid >> 5), kk = (tid & 31) * 2;
    unsigned pk = pack2(tl[kk * 65 + nn], tl[(kk + 1) * 65 + nn]);
    int n = n0 + nn;
    int drow = mode == 0 ? n : ((n >> 5) * 64 + (n & 31) + (mode == 2 ? 32 : 0));
    *(unsigned*)(dst + (size_t)drow * K + k0 + kk) = pk;
  }
}

__device__ void norm_rows(const Params& p, bool from_input, bf16_t* __restrict__ H, const float* __restrict__ g,
                          const float* __restrict__ modl, int shift_i, int scale_i, int item) {
  const int w = otid() >> 6, lane = otid() & 63;
  const int row = item * 4 + w;
  const float* xsrc = from_input ? (row < M_LAT ? p.x + (size_t)row * 1024 : p.ctx + (size_t)(row - M_LAT) * 1024)
                                 : (const float*)(p.ws + OFF_X) + (size_t)row * 1024;
  const float4* xr = (const float4*)xsrc;
  float4 v[4];
  float ss = 0.f;
#pragma unroll
  for (int i = 0; i < 4; ++i) {
    v[i] = xr[lane + 64 * i];
    ss += v[i].x * v[i].x + v[i].y * v[i].y + v[i].z * v[i].z + v[i].w * v[i].w;
  }
  ss = wave_sum(ss);
  const float r = rsqrtf(ss * (1.f / 1024.f) + 1e-6f);
  const int b = row < M_LAT ? (row >> 11) : 8;
  const float4* sh = (const float4*)(modl + b * 6144 + shift_i * 1024);
  const float4* sl = (const float4*)(modl + b * 6144 + scale_i * 1024);
  const float4* g4 = (const float4*)g;
#pragma unroll
  for (int i = 0; i < 4; ++i) {
    int c4 = lane + 64 * i;
    float4 gg = g4[c4], s4 = sh[c4], l4 = sl[c4];
    float y0 = v[i].x * r * gg.x * (1.f + l4.x) + s4.x;
    float y1 = v[i].y * r * gg.y * (1.f + l4.y) + s4.y;
    float y2 = v[i].z * r * gg.z * (1.f + l4.z) + s4.z;
    float y3 = v[i].w * r * gg.w * (1.f + l4.w) + s4.w;
    uint2 pk;
    pk.x = pack2(y0, y1);
    pk.y = pack2(y2, y3);
    *(uint2*)(H + (size_t)row * 1024 + c4 * 4) = pk;
  }
}

__device__ void conv_item_late(const Params& p, int l, int i, float* tl) {
  bf16_t* Wout = (bf16_t*)(p.ws + OFF_WOUT);
  bf16_t* Wgu = (bf16_t*)(p.ws + OFF_WGU);
  bf16_t* Wdn = (bf16_t*)(p.ws + OFF_WDN);
  const float* src;
  bf16_t* dst;
  int K, N, mode = 0, ntn;
  if (i < 256) {
    src = p.w_out + (size_t)l * 1024 * 1024; K = 1024; N = 1024; dst = Wout; ntn = 16;
  } else if (i < 960) {
    i -= 256; src = p.w_gate + (size_t)l * 1024 * FFN; K = 1024; N = FFN; dst = Wgu; ntn = 44; mode = 1;
  } else if (i < 1664) {
    i -= 960; src = p.w_up + (size_t)l * 1024 * FFN; K = 1024; N = FFN; dst = Wgu; ntn = 44; mode = 2;
  } else {
    i -= 1664; src = p.w_down + (size_t)l * FFN * 1024; K = FFN; N = 1024; dst = Wdn; ntn = 16;
  }
  convT_tile(src, K, N, dst, mode, nullptr, i / ntn, i % ntn, tl);
}
constexpr int N_CONV_LATE = 256 + 3 * 704;
__device__ void conv_item_early(const Params& p, int l, int it, float* tl) {
  const float* src;
  const float* gs = nullptr;
  bf16_t* dst;
  int K, N, ntn, i;
  if (it < 832) {
    i = it; src = p.w_in + (size_t)l * 1024 * INW; K = 1024; N = INW; dst = (bf16_t*)(p.ws + OFF_WIN); ntn = 52;
  } else if (it < 856) {
    i = it - 832; src = p.w_qup + (size_t)l * 256 * 384; K = 256; N = 384; dst = (bf16_t*)(p.ws + OFF_WQUP); ntn = 6;
    gs = p.g_q + l * 256;
  } else {
    i = it - 856; src = p.w_kvup + (size_t)l * 128 * 512; K = 128; N = 512; dst = (bf16_t*)(p.ws + OFF_WKVUP); ntn = 8;
    gs = p.g_kv + l * 128;
  }
  convT_tile(src, K, N, dst, 0, gs, i / ntn, i % ntn, tl);
}

__device__ void phaseA(const Params& p, int l, char* smem) {
  const int nb = gridDim.x, bid = blockIdx.x;
  for (int it = bid; it < M_ALL / 4; it += nb)
    norm_rows(p, l == 0, (bf16_t*)(p.ws + OFF_HM), p.g_mix + l * 1024,
              (const float*)(p.ws + OFF_MOD) + (size_t)l * 9 * 6144, 0, 1, it);
}

DEVI void tile_map(int it, int NT, int& mt, int& nt, int MPX = 18) {
  const int xcd = it & 7, idx = it >> 3;
  const int per_group = 8 * NT;
  const int g = idx / per_group, r = idx - g * per_group;
  const int gs = min(8, MPX - 8 * g);
  mt = xcd * MPX + g * 8 + r % gs;
  nt = r / gs;
}

enum { EPI_P = 0, EPI_QUP = 1, EPI_KVUP = 2, EPI_RES = 3, EPI_GU = 4 };

template <int EPI>
__device__ void gemm_tile(const Params& p, int l, const bf16_t* __restrict__ A, int lda,
                          const bf16_t* __restrict__ BT, int K, int m0, int n0, int gate_i, char* smem) {
  constexpr int STAGE = 2 * 128 * 72;
  bf16_t* sbase = (bf16_t*)smem;
  float* rsv = (float*)(smem + 2 * STAGE * 2);
  const int tid = otid(), lane = tid & 63, w = tid >> 6, wm = w >> 1, wn = w & 1;
  const int lr = tid >> 3, lc = (tid & 7) * 8;
  __syncthreads();
  if (EPI == EPI_QUP || EPI == EPI_KVUP) {
    const int row = tid >> 1, hf = tid & 1;
    const int n8 = K / 16;
    const uint4* ap = (const uint4*)(A + (size_t)(m0 + row) * lda + hf * (K / 2));
    float ss = 0.f;
    for (int i = 0; i < n8; ++i) {
      uint4 u = ap[i];
      float a0 = bflo(u.x), a1 = bfhi(u.x), a2 = bflo(u.y), a3 = bfhi(u.y), a4 = bflo(u.z), a5 = bfhi(u.z),
            a6 = bflo(u.w), a7 = bfhi(u.w);
      ss += a0 * a0 + a1 * a1 + a2 * a2 + a3 * a3 + a4 * a4 + a5 * a5 + a6 * a6 + a7 * a7;
    }
    ss += __shfl_xor(ss, 1);
    if (hf == 0) rsv[row] = rsqrtf(ss / (float)K + 1e-6f);
  }
  const bf16_t* Ap = A + (size_t)(m0 + lr) * lda + lc;
  const bf16_t* Bp = BT + (size_t)(n0 + lr) * K + lc;
  uint4 ra0, ra1, ra2, ra3, rb0, rb1, rb2, rb3;
#define G_LOAD()                                  \
  ra0 = *(const uint4*)(Ap);                      \
  ra1 = *(const uint4*)(Ap + (size_t)32 * lda);   \
  ra2 = *(const uint4*)(Ap + (size_t)64 * lda);   \
  ra3 = *(const uint4*)(Ap + (size_t)96 * lda);   \
  rb0 = *(const uint4*)(Bp);                      \
  rb1 = *(const uint4*)(Bp + (size_t)32 * K);     \
  rb2 = *(const uint4*)(Bp + (size_t)64 * K);     \
  rb3 = *(const uint4*)(Bp + (size_t)96 * K);
#define S_WRITE(ST)                                                   \
  {                                                                   \
    bf16_t* wa = sbase + (ST) * STAGE + lr * 72 + lc;                 \
    bf16_t* wb = wa + 128 * 72;                                       \
    *(uint4*)(wa) = ra0;                                              \
    *(uint4*)(wa + 32 * 72) = ra1;                                    \
    *(uint4*)(wa + 64 * 72) = ra2;                                    \
    *(uint4*)(wa + 96 * 72) = ra3;                                    \
    *(uint4*)(wb) = rb0;                                              \
    *(uint4*)(wb + 32 * 72) = rb1;                                    \
    *(uint4*)(wb + 64 * 72) = rb2;                                    \
    *(uint4*)(wb + 96 * 72) = rb3;                                    \
  }
  const int nk = K / 64;
  G_LOAD()
  S_WRITE(0)
  if (nk > 1) {
    Ap += 64;
    Bp += 64;
    G_LOAD()
  }
  f32x16 acc[2][2];
#pragma unroll
  for (int i = 0; i < 2; ++i)
#pragma unroll
    for (int j = 0; j < 2; ++j)
#pragma unroll
      for (int r = 0; r < 16; ++r) acc[i][j][r] = 0.f;
  __syncthreads();
  const int foff = (lane & 31) * 72 + (lane >> 5) * 8;
  const bf16_t* fa_base = sbase + wm * 64 * 72 + foff;
  const bf16_t* fb_base = sbase + 128 * 72 + wn * 64 * 72 + foff;
  bf16x8 xa0, xa1, xb0, xb1, ya0, ya1, yb0, yb1;
#define FLOAD(X, ST, KS)                                                   \
  {                                                                        \
    const bf16_t* pa_ = fa_base + (ST) * STAGE + (KS) * 16;                \
    const bf16_t* pb_ = fb_base + (ST) * STAGE + (KS) * 16;                \
    X##a0 = *(const bf16x8*)(pa_);                                         \
    X##a1 = *(const bf16x8*)(pa_ + 32 * 72);                               \
    X##b0 = *(const bf16x8*)(pb_);                                         \
    X##b1 = *(const bf16x8*)(pb_ + 32 * 72);                               \
  }
#define MM4(X)                                                                            \
  acc[0][0] = __builtin_amdgcn_mfma_f32_32x32x16_bf16(X##a0, X##b0, acc[0][0], 0, 0, 0);  \
  acc[0][1] = __builtin_amdgcn_mfma_f32_32x32x16_bf16(X##a0, X##b1, acc[0][1], 0, 0, 0);  \
  acc[1][0] = __builtin_amdgcn_mfma_f32_32x32x16_bf16(X##a1, X##b0, acc[1][0], 0, 0, 0);  \
  acc[1][1] = __builtin_amdgcn_mfma_f32_32x32x16_bf16(X##a1, X##b1, acc[1][1], 0, 0, 0);
  FLOAD(x, 0, 0)
  for (int kt = 0; kt < nk; ++kt) {
    const int cur = kt & 1;
    FLOAD(y, cur, 1)
    __builtin_amdgcn_sched_barrier(0);
    MM4(x)
    __builtin_amdgcn_sched_barrier(0);
    FLOAD(x, cur, 2)
    __builtin_amdgcn_sched_barrier(0);
    MM4(y)
    __builtin_amdgcn_sched_barrier(0);
    FLOAD(y, cur, 3)
    __builtin_amdgcn_sched_barrier(0);
    MM4(x)
    __builtin_amdgcn_sched_barrier(0);
    if (kt + 1 < nk) {
      S_WRITE(cur ^ 1)
      if (kt + 2 < nk) {
        Ap += 64;
        Bp += 64;
        G_LOAD()
      }
    }
    __syncthreads();
    if (kt + 1 < nk) FLOAD(x, cur ^ 1, 0)
    __builtin_amdgcn_sched_barrier(0);
    MM4(y)
    __builtin_amdgcn_sched_barrier(0);
  }
  __syncthreads();
#undef FLOAD
#undef MM4
#undef G_LOAD
#undef S_WRITE
  const int ci = lane & 31;
  const int rbase = m0 + wm * 64 + 4 * (lane >> 5);
  const int cbase = n0 + wn * 64;
  if (EPI == EPI_P) {
    bf16_t* P = (bf16_t*)(p.ws + OFF_P);
    float* AB = (float*)(p.ws + OFF_AB);
    bf16_t* sO = (bf16_t*)smem;
#pragma unroll
    for (int mt = 0; mt < 2; ++mt)
#pragma unroll
      for (int nt = 0; nt < 2; ++nt)
#pragma unroll
        for (int r = 0; r < 16; ++r) {
          const int rl = wm * 64 + 4 * (lane >> 5) + mt * 32 + (r & 3) + 8 * (r >> 2);
          const int cl = wn * 64 + nt * 32 + ci;
          const float v = acc[mt][nt][r];
          sO[rl * 136 + cl] = f2bf(v);
          const int col = n0 + cl;
          if (col >= C_DA && col < C_DA + 16) AB[(size_t)(m0 + rl) * 16 + col - C_DA] = v;
        }
    __syncthreads();
#pragma unroll
    for (int e = 0; e < 8; ++e) {
      const int c = tid + 256 * e, rl = c >> 4, ch = c & 15;
      *(uint4*)(P + (size_t)(m0 + rl) * INWP + n0 + ch * 8) = *(const uint4*)(sO + rl * 136 + ch * 8);
    }
    bf16_t* NVT = (bf16_t*)(p.ws + OFF_NVT);
#pragma unroll
    for (int mt = 0; mt < 2; ++mt)
#pragma unroll
      for (int nt = 0; nt < 2; ++nt) {
        const int base = cbase + nt * 32;
        if (base >= C_NV && base < C_NV + 256) {
          const int hv = (base - C_NV) >> 6, dv = ((base - C_NV) & 63) + ci;
#pragma unroll
          for (int g = 0; g < 4; ++g) {
            const int row0 = rbase + mt * 32 + 8 * g;
            int bb, key0;
            if (row0 < M_LAT) { bb = row0 >> 11; key0 = 256 + (row0 & 2047); }
            else { bb = (row0 - M_LAT) >> 8; key0 = (row0 - M_LAT) & 255; }
            uint2 u;
            u.x = pack2(acc[mt][nt][4 * g + 0], acc[mt][nt][4 * g + 1]);
            u.y = pack2(acc[mt][nt][4 * g + 2], acc[mt][nt][4 * g + 3]);
            *(uint2*)(NVT + ((size_t)(bb * 4 + hv) * 64 + dv) * 2304 + key0) = u;
          }
        }
      }
  } else if (EPI == EPI_QUP) {
    bf16_t* QH = (bf16_t*)(p.ws + OFF_QH);
    const float* rc = (const float*)(p.ws + OFF_ROPE);
    const float* rsn = rc + 2048 * 16;
#pragma unroll
    for (int mt = 0; mt < 2; ++mt)
#pragma unroll
      for (int nt = 0; nt < 2; ++nt) {
        const int base = cbase + nt * 32;
        const bool rope = ((base % 96) == 64) && (m0 < M_LAT);
#pragma unroll
        for (int r = 0; r < 16; ++r) {
          int row = rbase + mt * 32 + (r & 3) + 8 * (r >> 2);
          float v = acc[mt][nt][r] * rsv[row - m0];
          float o = __shfl_xor(v, 8);
          if (rope) {
            int t = row & 2047;
            int a = ci >> 4, hf = (ci >> 3) & 1, j = ci & 7;
            float c = rc[t * 16 + a * 8 + j], s = rsn[t * 16 + a * 8 + j];
            v = hf ? (o * s + v * c) : (v * c - o * s);
          }
          QH[(size_t)row * 384 + base + ci] = f2bf(v);
        }
      }
  } else if (EPI == EPI_KVUP) {
    bf16_t* KA = (bf16_t*)(p.ws + OFF_KH);
    bf16_t* VT = (bf16_t*)(p.ws + OFF_VH);
#pragma unroll
    for (int mt = 0; mt < 2; ++mt)
#pragma unroll
      for (int nt = 0; nt < 2; ++nt) {
        const int base = cbase + nt * 32;
        const int h = base >> 7, cc = (base & 127) + ci;
#pragma unroll
        for (int g = 0; g < 4; ++g) {
          const int row0 = rbase + mt * 32 + 8 * g;
          int bb, key0;
          if (row0 < M_LAT) { bb = row0 >> 11; key0 = 256 + (row0 & 2047); }
          else { bb = (row0 - M_LAT) >> 8; key0 = (row0 - M_LAT) & 255; }
          float v0 = acc[mt][nt][4 * g + 0] * rsv[row0 - m0 + 0];
          float v1 = acc[mt][nt][4 * g + 1] * rsv[row0 - m0 + 1];
          float v2 = acc[mt][nt][4 * g + 2] * rsv[row0 - m0 + 2];
          float v3 = acc[mt][nt][4 * g + 3] * rsv[row0 - m0 + 3];
          if (cc < 64) {
            bf16_t* kp = KA + ((size_t)(bb * 4 + h) * 2304 + key0) * 96 + cc;
            kp[0] = f2bf(v0); kp[96] = f2bf(v1); kp[192] = f2bf(v2); kp[288] = f2bf(v3);
          } else {
            uint2 u;
            u.x = pack2(v0, v1);
            u.y = pack2(v2, v3);
            *(uint2*)(VT + ((size_t)(bb * 4 + h) * 64 + (cc - 64)) * 2304 + key0) = u;
          }
        }
      }
  } else if (EPI == EPI_RES) {
    float* X = (float*)(p.ws + OFF_X);
    const float* Xsrc = (l == 0 && gate_i == 2) ? (m0 < M_LAT ? p.x : p.ctx - (size_t)M_LAT * 1024) : X;
    const float* modl = (const float*)(p.ws + OFF_MOD) + (size_t)l * 9 * 6144 + gate_i * 1024;
#pragma unroll
    for (int mt = 0; mt < 2; ++mt)
#pragma unroll
      for (int nt = 0; nt < 2; ++nt)
#pragma unroll
        for (int r = 0; r < 16; ++r) {
          int row = rbase + mt * 32 + (r & 3) + 8 * (r >> 2);
          int col = cbase + nt * 32 + ci;
          int b = row < M_LAT ? (row >> 11) : 8;
          float g = modl[b * 6144 + col];
          size_t idx = (size_t)row * 1024 + col;
          X[idx] = Xsrc[idx] + g * acc[mt][nt][r];
        }
  } else if (EPI == EPI_GU) {
    bf16_t* ACT = (bf16_t*)(p.ws + OFF_P);
    bf16_t* sO = (bf16_t*)smem;
#pragma unroll
    for (int mt = 0; mt < 2; ++mt)
#pragma unroll
      for (int r = 0; r < 16; ++r) {
        const int rl = wm * 64 + 4 * (lane >> 5) + mt * 32 + (r & 3) + 8 * (r >> 2);
        float gt = acc[mt][0][r], up = acc[mt][1][r];
        float a = silu_f(gt) * up;
        sO[rl * 72 + wn * 32 + ci] = f2bf(a);
      }
    __syncthreads();
#pragma unroll
    for (int e = 0; e < 4; ++e) {
      const int c = tid + 256 * e, rl = c >> 3, ch = c & 7;
      *(uint4*)(ACT + (size_t)(m0 + rl) * FFN + (n0 >> 1) + ch * 8) = *(const uint4*)(sO + rl * 72 + ch * 8);
    }
  }
}

template <int EPI>
__device__ void gemm_wide(const Params& p, int l, const bf16_t* __restrict__ A, int lda,
                          const bf16_t* __restrict__ BT, int K, int m0, int n0, int gate_i, char* smem) {
  bf16_t* sA = (bf16_t*)smem;
  bf16_t* sB = sA + 128 * 72;
  const int tid = otid(), lane = tid & 63, w = tid >> 6, wm = w >> 1, wn = w & 1;
  const int lr = tid >> 3, lc = (tid & 7) * 8;
  const bf16_t* Ap = A + (size_t)(m0 + lr) * lda + lc;
  const bf16_t* Bp = BT + (size_t)(n0 + lr) * K + lc;
  uint4 ra0, ra1, ra2, ra3, rb0, rb1, rb2, rb3, rb4, rb5, rb6, rb7;
#define LOAD_AB()                                   \
  ra0 = *(const uint4*)(Ap);                        \
  ra1 = *(const uint4*)(Ap + (size_t)32 * lda);     \
  ra2 = *(const uint4*)(Ap + (size_t)64 * lda);     \
  ra3 = *(const uint4*)(Ap + (size_t)96 * lda);     \
  rb0 = *(const uint4*)(Bp);                        \
  rb1 = *(const uint4*)(Bp + (size_t)32 * K);       \
  rb2 = *(const uint4*)(Bp + (size_t)64 * K);       \
  rb3 = *(const uint4*)(Bp + (size_t)96 * K);       \
  rb4 = *(const uint4*)(Bp + (size_t)128 * K);      \
  rb5 = *(const uint4*)(Bp + (size_t)160 * K);      \
  rb6 = *(const uint4*)(Bp + (size_t)192 * K);      \
  rb7 = *(const uint4*)(Bp + (size_t)224 * K);
  __syncthreads();
  LOAD_AB()
  f32x16 acc[2][4];
#pragma unroll
  for (int i = 0; i < 2; ++i)
#pragma unroll
    for (int j = 0; j < 4; ++j)
#pragma unroll
      for (int r = 0; r < 16; ++r) acc[i][j][r] = 0.f;
  const int nk = K / 64;
  const bf16_t* pa = sA + (wm * 64 + (lane & 31)) * 72 + (lane >> 5) * 8;
  const bf16_t* pb = sB + (wn * 128 + (lane & 31)) * 72 + (lane >> 5) * 8;
#define MM8(A0, A1, B0, B1, B2, B3)                                                   \
  acc[0][0] = __builtin_amdgcn_mfma_f32_32x32x16_bf16(A0, B0, acc[0][0], 0, 0, 0);    \
  acc[1][0] = __builtin_amdgcn_mfma_f32_32x32x16_bf16(A1, B0, acc[1][0], 0, 0, 0);    \
  acc[0][1] = __builtin_amdgcn_mfma_f32_32x32x16_bf16(A0, B1, acc[0][1], 0, 0, 0);    \
  acc[1][1] = __builtin_amdgcn_mfma_f32_32x32x16_bf16(A1, B1, acc[1][1], 0, 0, 0);    \
  acc[0][2] = __builtin_amdgcn_mfma_f32_32x32x16_bf16(A0, B2, acc[0][2], 0, 0, 0);    \
  acc[1][2] = __builtin_amdgcn_mfma_f32_32x32x16_bf16(A1, B2, acc[1][2], 0, 0, 0);    \
  acc[0][3] = __builtin_amdgcn_mfma_f32_32x32x16_bf16(A0, B3, acc[0][3], 0, 0, 0);    \
  acc[1][3] = __builtin_amdgcn_mfma_f32_32x32x16_bf16(A1, B3, acc[1][3], 0, 0, 0);
#define HALF_STEP(KO)                                                                                   \
  {                                                                                                     \
    bf16x8 fa00 = *(const bf16x8*)(pa + (KO)), fa01 = *(const bf16x8*)(pa + 32 * 72 + (KO));            \
    bf16x8 fb00 = *(const bf16x8*)(pb + (KO)), fb01 = *(const bf16x8*)(pb + 32 * 72 + (KO));            \
    bf16x8 fb02 = *(const bf16x8*)(pb + 64 * 72 + (KO)), fb03 = *(const bf16x8*)(pb + 96 * 72 + (KO));  \
    bf16x8 fa10 = *(const bf16x8*)(pa + (KO) + 16), fa11 = *(const bf16x8*)(pa + 32 * 72 + (KO) + 16);  \
    bf16x8 fb10 = *(const bf16x8*)(pb + (KO) + 16), fb11 = *(const bf16x8*)(pb + 32 * 72 + (KO) + 16);  \
    bf16x8 fb12 = *(const bf16x8*)(pb + 64 * 72 + (KO) + 16), fb13 = *(const bf16x8*)(pb + 96 * 72 + (KO) + 16); \
    __builtin_amdgcn_sched_barrier(0);                                                                  \
    __builtin_amdgcn_s_setprio(1);                                                                      \
    MM8(fa00, fa01, fb00, fb01, fb02, fb03)                                                             \
    MM8(fa10, fa11, fb10, fb11, fb12, fb13)                                                             \
    __builtin_amdgcn_s_setprio(0);                                                                      \
    __builtin_amdgcn_sched_barrier(0);                                                                  \
  }
  for (int kt = 0; kt < nk; ++kt) {
    __syncthreads();
    *(uint4*)(sA + (lr + 0) * 72 + lc) = ra0;
    *(uint4*)(sA + (lr + 32) * 72 + lc) = ra1;
    *(uint4*)(sA + (lr + 64) * 72 + lc) = ra2;
    *(uint4*)(sA + (lr + 96) * 72 + lc) = ra3;
    *(uint4*)(sB + (lr + 0) * 72 + lc) = rb0;
    *(uint4*)(sB + (lr + 32) * 72 + lc) = rb1;
    *(uint4*)(sB + (lr + 64) * 72 + lc) = rb2;
    *(uint4*)(sB + (lr + 96) * 72 + lc) = rb3;
    *(uint4*)(sB + (lr + 128) * 72 + lc) = rb4;
    *(uint4*)(sB + (lr + 160) * 72 + lc) = rb5;
    *(uint4*)(sB + (lr + 192) * 72 + lc) = rb6;
    *(uint4*)(sB + (lr + 224) * 72 + lc) = rb7;
    __syncthreads();
    if (kt + 1 < nk) {
      Ap += 64;
      Bp += 64;
      LOAD_AB()
    }
    __builtin_amdgcn_sched_barrier(0);
    HALF_STEP(0)
    HALF_STEP(32)
  }
#undef HALF_STEP
#undef MM8
#undef LOAD_AB
  const int ci = lane & 31;
  const int rbase = m0 + wm * 64 + 4 * (lane >> 5);
  const int cbase = n0 + wn * 128;
  if (EPI == EPI_P) {
    bf16_t* P = (bf16_t*)(p.ws + OFF_P);
    float* AB = (float*)(p.ws + OFF_AB);
    bf16_t* NVT = (bf16_t*)(p.ws + OFF_NVT);
#pragma unroll
    for (int mt = 0; mt < 2; ++mt)
#pragma unroll
      for (int nt = 0; nt < 4; ++nt) {
        const int base = cbase + nt * 32;
#pragma unroll
        for (int r = 0; r < 16; ++r) {
          int row = rbase + mt * 32 + (r & 3) + 8 * (r >> 2);
          int col = base + ci;
          float v = acc[mt][nt][r];
          P[(size_t)row * INWP + col] = f2bf(v);
          if (col >= C_DA && col < C_DA + 16) AB[(size_t)row * 16 + col - C_DA] = v;
        }
        if (base >= C_NV && base < C_NV + 256) {
          const int hv = (base - C_NV) >> 6, dv = ((base - C_NV) & 63) + ci;
#pragma unroll
          for (int g = 0; g < 4; ++g) {
            const int row0 = rbase + mt * 32 + 8 * g;
            int bb, key0;
            if (row0 < M_LAT) { bb = row0 >> 11; key0 = 256 + (row0 & 2047); }
            else { bb = (row0 - M_LAT) >> 8; key0 = (row0 - M_LAT) & 255; }
            uint2 u;
            u.x = pack2(acc[mt][nt][4 * g + 0], acc[mt][nt][4 * g + 1]);
            u.y = pack2(acc[mt][nt][4 * g + 2], acc[mt][nt][4 * g + 3]);
            *(uint2*)(NVT + ((size_t)(bb * 4 + hv) * 64 + dv) * 2304 + key0) = u;
          }
        }
      }
  } else if (EPI == EPI_GU) {
    bf16_t* ACT = (bf16_t*)(p.ws + OFF_P);
#pragma unroll
    for (int mt = 0; mt < 2; ++mt)
#pragma unroll
      for (int pr = 0; pr < 2; ++pr)
#pragma unroll
        for (int r = 0; r < 16; ++r) {
          int row = rbase + mt * 32 + (r & 3) + 8 * (r >> 2);
          float gt = acc[mt][2 * pr][r], up = acc[mt][2 * pr + 1][r];
          float a = silu_f(gt) * up;
          ACT[(size_t)row * FFN + ((cbase >> 6) + pr) * 32 + ci] = f2bf(a);
        }
  }
}

typedef float f32x4 __attribute__((ext_vector_type(4)));
template <int EPI>
__device__ void gemm_wide16(const Params& p, int l, const bf16_t* __restrict__ A, int lda,
                            const bf16_t* __restrict__ BT, int K, int m0, int n0, char* smem) {
  constexpr int RS = 80;
  bf16_t* sA = (bf16_t*)smem;
  bf16_t* sB = sA + 128 * RS;
  const int tid = otid(), lane = tid & 63, w = tid >> 6, wm = w >> 1, wn = w & 1;
  const int lr = tid >> 3, lc = (tid & 7) * 8;
  const int l15 = lane & 15, lq = lane >> 4;
  const bf16_t* Ap = A + (size_t)(m0 + lr) * lda + lc;
  const bf16_t* Bp = BT + (size_t)(n0 + lr) * K + lc;
  uint4 ra0, ra1, ra2, ra3, rb0, rb1, rb2, rb3, rb4, rb5, rb6, rb7;
#define LOAD_AB()                                   \
  ra0 = *(const uint4*)(Ap);                        \
  ra1 = *(const uint4*)(Ap + (size_t)32 * lda);     \
  ra2 = *(const uint4*)(Ap + (size_t)64 * lda);     \
  ra3 = *(const uint4*)(Ap + (size_t)96 * lda);     \
  rb0 = *(const uint4*)(Bp);                        \
  rb1 = *(const uint4*)(Bp + (size_t)32 * K);       \
  rb2 = *(const uint4*)(Bp + (size_t)64 * K);       \
  rb3 = *(const uint4*)(Bp + (size_t)96 * K);       \
  rb4 = *(const uint4*)(Bp + (size_t)128 * K);      \
  rb5 = *(const uint4*)(Bp + (size_t)160 * K);      \
  rb6 = *(const uint4*)(Bp + (size_t)192 * K);      \
  rb7 = *(const uint4*)(Bp + (size_t)224 * K);
  __syncthreads();
  LOAD_AB()
  f32x4 acc[4][8];
#pragma unroll
  for (int i = 0; i < 4; ++i)
#pragma unroll
    for (int j = 0; j < 8; ++j)
#pragma unroll
      for (int r = 0; r < 4; ++r) acc[i][j][r] = 0.f;
  const int nk = K / 64;
  const bf16_t* pa = sA + (wm * 64 + l15) * RS + lq * 8;
  const bf16_t* pb = sB + (wn * 128 + l15) * RS + lq * 8;
  for (int kt = 0; kt < nk; ++kt) {
    __syncthreads();
    *(uint4*)(sA + (lr + 0) * RS + lc) = ra0;
    *(uint4*)(sA + (lr + 32) * RS + lc) = ra1;
    *(uint4*)(sA + (lr + 64) * RS + lc) = ra2;
    *(uint4*)(sA + (lr + 96) * RS + lc) = ra3;
    *(uint4*)(sB + (lr + 0) * RS + lc) = rb0;
    *(uint4*)(sB + (lr + 32) * RS + lc) = rb1;
    *(uint4*)(sB + (lr + 64) * RS + lc) = rb2;
    *(uint4*)(sB + (lr + 96) * RS + lc) = rb3;
    *(uint4*)(sB + (lr + 128) * RS + lc) = rb4;
    *(uint4*)(sB + (lr + 160) * RS + lc) = rb5;
    *(uint4*)(sB + (lr + 192) * RS + lc) = rb6;
    *(uint4*)(sB + (lr + 224) * RS + lc) = rb7;
    __syncthreads();
    if (kt + 1 < nk) {
      Ap += 64;
      Bp += 64;
      LOAD_AB()
    }
    __builtin_amdgcn_sched_barrier(0);
#pragma unroll
    for (int ks = 0; ks < 2; ++ks) {
      bf16x8 fa[4];
#pragma unroll
      for (int i = 0; i < 4; ++i) fa[i] = *(const bf16x8*)(pa + i * 16 * RS + ks * 32);
#pragma unroll
      for (int jh = 0; jh < 2; ++jh) {
        bf16x8 fb[4];
#pragma unroll
        for (int j = 0; j < 4; ++j) fb[j] = *(const bf16x8*)(pb + (jh * 4 + j) * 16 * RS + ks * 32);
        __builtin_amdgcn_s_setprio(1);
#pragma unroll
        for (int j = 0; j < 4; ++j)
#pragma unroll
          for (int i = 0; i < 4; ++i)
            acc[i][jh * 4 + j] = __builtin_amdgcn_mfma_f32_16x16x32_bf16(fa[i], fb[j], acc[i][jh * 4 + j], 0, 0, 0);
        __builtin_amdgcn_s_setprio(0);
      }
    }
  }
#undef LOAD_AB
  const int rbase = m0 + wm * 64 + lq * 4;
  const int cbase = n0 + wn * 128;
  if (EPI == EPI_P) {
    bf16_t* P = (bf16_t*)(p.ws + OFF_P);
    float* AB = (float*)(p.ws + OFF_AB);
    bf16_t* NVT = (bf16_t*)(p.ws + OFF_NVT);
#pragma unroll
    for (int nt = 0; nt < 8; ++nt) {
      const int base = cbase + nt * 16;
#pragma unroll
      for (int mt = 0; mt < 4; ++mt) {
        const int row0 = rbase + mt * 16;
#pragma unroll
        for (int r = 0; r < 4; ++r) P[(size_t)(row0 + r) * INWP + base + l15] = f2bf(acc[mt][nt][r]);
        if (base == C_DA) {
#pragma unroll
          for (int r = 0; r < 4; ++r) AB[(size_t)(row0 + r) * 16 + l15] = acc[mt][nt][r];
        }
        if (base >= C_NV && base < C_NV + 256) {
          const int hv = (base - C_NV) >> 6, dv = ((base - C_NV) & 63) + l15;
          int bb, key0;
          if (row0 < M_LAT) { bb = row0 >> 11; key0 = 256 + (row0 & 2047); }
          else { bb = (row0 - M_LAT) >> 8; key0 = (row0 - M_LAT) & 255; }
          uint2 u;
          u.x = pack2(acc[mt][nt][0], acc[mt][nt][1]);
          u.y = pack2(acc[mt][nt][2], acc[mt][nt][3]);
          *(uint2*)(NVT + ((size_t)(bb * 4 + hv) * 64 + dv) * 2304 + key0) = u;
        }
      }
    }
  } else if (EPI == EPI_GU) {
    bf16_t* ACT = (bf16_t*)(p.ws + OFF_P);
#pragma unroll
    for (int pr = 0; pr < 2; ++pr)
#pragma unroll
      for (int hf = 0; hf < 2; ++hf)
#pragma unroll
        for (int mt = 0; mt < 4; ++mt)
#pragma unroll
          for (int r = 0; r < 4; ++r) {
            const int row = rbase + mt * 16 + r;
            const float gt = acc[mt][pr * 4 + hf][r], up = acc[mt][pr * 4 + 2 + hf][r];
            ACT[(size_t)row * FFN + ((cbase >> 6) + pr) * 32 + hf * 16 + l15] = f2bf(silu_f(gt) * up);
          }
  }
}

__device__ void kpe_item(const Params& p, int it) {
  const int tid = otid();
  const bf16_t* P = (const bf16_t*)(p.ws + OFF_P);
  bf16_t* KH = (bf16_t*)(p.ws + OFF_KH);
  const float* rc = (const float*)(p.ws + OFF_ROPE);
  const float* rsn = rc + 2048 * 16;
  const int row = it * 8 + (tid >> 5), i = tid & 31;
  float v = bf2f(P[(size_t)row * INWP + C_MPE + i]);
  float o = __shfl_xor(v, 8);
  if (row < M_LAT) {
    int t = row & 2047;
    int a = i >> 4, hf = (i >> 3) & 1, j = i & 7;
    float c = rc[t * 16 + a * 8 + j], s = rsn[t * 16 + a * 8 + j];
    v = hf ? (o * s + v * c) : (v * c - o * s);
  }
  bf16_t bv = f2bf(v);
  int bb, key;
  if (row < M_LAT) { bb = row >> 11; key = 256 + (row & 2047); }
  else { bb = (row - M_LAT) >> 8; key = (row - M_LAT) & 255; }
#pragma unroll
  for (int h = 0; h < 4; ++h) KH[((size_t)(bb * 4 + h) * 2304 + key) * 96 + 64 + i] = bv;
}

__device__ void dn_prep(const Params& p, int l, int it, char* smem) {
  float* buf = (float*)smem;
  float* nrm = buf + 8 * 1536;
  const int tid = otid();
  const bf16_t* P = (const bf16_t*)(p.ws + OFF_P);
  bf16_t* DQ = (bf16_t*)(p.ws + OFF_DNQKV);
  const int r0 = it * 8;
  int seq_lo, seq_hi;
  if (r0 < M_LAT) {
    seq_lo = (r0 >> 11) << 11;
    seq_hi = seq_lo + 2048;
  } else {
    int rr = r0 - M_LAT;
    seq_lo = M_LAT + ((rr >> 8) << 8);
    seq_hi = seq_lo + 256;
  }
  const float* cw = p.conv_w + (size_t)l * 5 * 1536;
  __syncthreads();
  for (int c6 = 0; c6 < 6; ++c6) {
    const int ch = c6 * 256 + tid;
    float w0 = cw[ch], w1 = cw[1536 + ch], w2 = cw[2 * 1536 + ch], w3 = cw[3 * 1536 + ch], w4 = cw[4 * 1536 + ch];
    float xw[12];
#pragma unroll
    for (int j = 0; j < 12; ++j) {
      int r = r0 - 2 + j;
      xw[j] = (r >= seq_lo && r < seq_hi) ? bf2f(P[(size_t)r * INWP + C_DN + ch]) : 0.f;
    }
#pragma unroll
    for (int j = 0; j < 8; ++j) {
      float y = w0 * xw[j] + w1 * xw[j + 1] + w2 * xw[j + 2] + w3 * xw[j + 3] + w4 * xw[j + 4];
      buf[j * 1536 + ch] = silu_f(y);
    }
  }
  __syncthreads();
  {
    int vec = tid >> 2, part = tid & 3;
    int rr = vec >> 3, hv = vec & 7;
    const float* v = buf + rr * 1536 + hv * 128 + part * 32;
    float ss = 0.f;
#pragma unroll
    for (int i = 0; i < 32; ++i) ss += v[i] * v[i];
    ss += __shfl_xor(ss, 1);
    ss += __shfl_xor(ss, 2);
    if (part == 0) nrm[vec] = rsqrtf(ss + 1e-6f);
  }
  __syncthreads();
  for (int i = tid; i < 8 * 1536; i += 256) {
    int rr = i / 1536, ch = i - rr * 1536;
    float v = buf[i];
    if (ch < 1024) v *= nrm[rr * 8 + (ch >> 7)];
    DQ[(size_t)(r0 + rr) * 1536 + ch] = f2bf(v);
  }
}


DEVI int rowmap(int r, int hh) { return (r & 3) + 8 * (r >> 2) + 4 * hh; }

DEVI void unpack8(const uint4& u, float* f) {
  f[0] = bflo(u.x); f[1] = bfhi(u.x); f[2] = bflo(u.y); f[3] = bfhi(u.y);
  f[4] = bflo(u.z); f[5] = bfhi(u.z); f[6] = bflo(u.w); f[7] = bfhi(u.w);
}
__device__ void dn_chunk_prep(const Params& p, int l, int item, char* smem) {
  float* sW = (float*)smem;
  bf16_t* sKb = (bf16_t*)(smem + 7680);
  float* sL0 = (float*)(smem + 25088);
  float* sL1 = sL0 + 64 * 68;
  float* sg = (float*)(smem + 59904);
  float* sbt = sg + 128;
  const int tid = otid(), lane = tid & 63, w = tid >> 6, li = lane & 31, hh = lane >> 5;
  const int chunk = item >> 2, h = item & 3;
  int row0, seq_lo, seq_hi;
  if (chunk < 256) {
    int b = chunk >> 5;
    row0 = b * 2048 + (chunk & 31) * 64; seq_lo = b * 2048; seq_hi = seq_lo + 2048;
  } else {
    int cc = chunk - 256, b = cc >> 2;
    row0 = M_LAT + b * 256 + (cc & 3) * 64; seq_lo = M_LAT + b * 256; seq_hi = seq_lo + 256;
  }
  const bf16_t* P = (const bf16_t*)(p.ws + OFF_P);
  bf16_t* DQ = (bf16_t*)(p.ws + OFF_DNQKV);
  const float* AB = (const float*)(p.ws + OFF_AB);
  const float* cw = p.conv_w + (size_t)l * 5 * 1536;
  __syncthreads();
  for (int i = tid; i < 5 * 384; i += 256) {
    const int tap = i / 384, cc = i - tap * 384, type = cc >> 7, c = cc & 127;
    const int off = type == 0 ? 512 : (type == 1 ? 0 : 1024);
    sW[i] = cw[tap * 1536 + off + h * 128 + c];
  }
  if (w < 2) {
    const int d = w;
    const int row = d ? (row0 + 63 - lane) : (row0 + lane);
    const float Aneg = -__expf(p.a_log[l * 8 + d * 4 + h]);
    const float dtb = p.dt_bias[l * 8 + d * 4 + h];
    float a = AB[(size_t)row * 16 + d * 4 + h];
    float bb = AB[(size_t)row * 16 + 8 + d * 4 + h];
    float xx = a + dtb;
    const float ee = __expf(xx);
    float sp = ee < 0.25f ? ee * (1.f - ee * (0.5f - ee * (0.33333333f - ee * (0.25f - 0.2f * ee))))
                          : (xx > 20.f ? xx : __logf(1.f + ee));
    float g = Aneg * sp;
#pragma unroll
    for (int o = 1; o < 64; o <<= 1) {
      float y = __shfl_up(g, o);
      if (lane >= o) g += y;
    }
    float be = 1.f / (1.f + __expf(-bb));
    sg[d * 64 + lane] = g;
    sbt[d * 64 + lane] = be;
    ((float*)(p.ws + OFF_GC))[(size_t)row * 8 + d * 4 + h] = g;
    ((float*)(p.ws + OFF_BETA))[(size_t)row * 8 + d * 4 + h] = be;
  }
  __syncthreads();
  const int cg = tid & 15, rsub = tid >> 4;
#pragma unroll 1
  for (int type = 0; type < 3; ++type) {
    const int off = type == 0 ? 512 : (type == 1 ? 0 : 1024);
    uint4 xv[4][5];
#pragma unroll
    for (int e = 0; e < 4; ++e) {
      const int row = rsub + 16 * e;
      const bf16_t* base = P + (size_t)(row0 + row) * INWP + C_DN + off + h * 128 + cg * 8;
#pragma unroll
      for (int dd = 0; dd < 5; ++dd) {
        const int r = row0 + row + dd - 2;
        xv[e][dd] = (r >= seq_lo && r < seq_hi) ? *(const uint4*)(base + (dd - 2) * INWP) : make_uint4(0u, 0u, 0u, 0u);
      }
    }
#pragma unroll
    for (int e = 0; e < 4; ++e) {
      const int row = rsub + 16 * e;
      float y[8];
#pragma unroll
      for (int j = 0; j < 8; ++j) y[j] = 0.f;
#pragma unroll
      for (int dd = 0; dd < 5; ++dd) {
        float xf[8];
        unpack8(xv[e][dd], xf);
        const float4 wa = *(const float4*)(sW + dd * 384 + type * 128 + cg * 8);
        const float4 wb = *(const float4*)(sW + dd * 384 + type * 128 + cg * 8 + 4);
        y[0] += wa.x * xf[0]; y[1] += wa.y * xf[1]; y[2] += wa.z * xf[2]; y[3] += wa.w * xf[3];
        y[4] += wb.x * xf[4]; y[5] += wb.y * xf[5]; y[6] += wb.z * xf[6]; y[7] += wb.w * xf[7];
      }
      float ss = 0.f;
#pragma unroll
      for (int j = 0; j < 8; ++j) {
        y[j] = silu_f(y[j]);
        ss += y[j] * y[j];
      }
      if (type < 2) {
        ss += __shfl_xor(ss, 1);
        ss += __shfl_xor(ss, 2);
        ss += __shfl_xor(ss, 4);
        ss += __shfl_xor(ss, 8);
        const float rn = rsqrtf(ss + 1e-6f);
#pragma unroll
        for (int j = 0; j < 8; ++j) y[j] *= rn;
      }
      uint4 u;
      u.x = pack2(y[0], y[1]); u.y = pack2(y[2], y[3]); u.z = pack2(y[4], y[5]); u.w = pack2(y[6], y[7]);
      *(uint4*)(DQ + (size_t)(row0 + row) * 1536 + off + h * 128 + cg * 8) = u;
      if (type == 0) *(uint4*)(sKb + row * 136 + cg * 8) = u;
    }
  }
  __syncthreads();
  {
    const int mi = w >> 1, ni = w & 1;
    f32x16 g;
#pragma unroll
    for (int r = 0; r < 16; ++r) g[r] = 0.f;
#pragma unroll
    for (int ks = 0; ks < 8; ++ks) {
      bf16x8 a = *(const bf16x8*)(sKb + (mi * 32 + li) * 136 + ks * 16 + hh * 8);
      bf16x8 b = *(const bf16x8*)(sKb + (ni * 32 + li) * 136 + ks * 16 + hh * 8);
      g = __builtin_amdgcn_mfma_f32_32x32x16_bf16(a, b, g, 0, 0, 0);
    }
#pragma unroll
    for (int r = 0; r < 16; ++r) {
      const int i = mi * 32 + rowmap(r, hh), m = ni * 32 + li;
      const float G = g[r];
      sL0[i * 68 + m] = (i > m) ? sbt[i] * G * __expf(sg[i] - sg[m]) : 0.f;
      const int i1 = 63 - i, m1 = 63 - m;
      sL1[i1 * 68 + m1] = (i1 > m1) ? sbt[64 + i1] * G * __expf(sg[64 + i1] - sg[64 + m1]) : 0.f;
    }
  }
  __syncthreads();
  if (w < 2) {
    const float* L = w == 0 ? sL0 : sL1;
    float t[64];
#pragma unroll
    for (int i = 0; i < 64; ++i) {
      float a0 = (i == lane) ? 1.f : 0.f, a1 = 0.f, a2 = 0.f, a3 = 0.f;
#pragma unroll
      for (int m = 0; m < i; ++m) {
        const float pr = L[i * 68 + m] * t[m];
        if ((m & 3) == 0) a0 -= pr;
        else if ((m & 3) == 1) a1 -= pr;
        else if ((m & 3) == 2) a2 -= pr;
        else a3 -= pr;
      }
      t[i] = (a0 + a1) + (a2 + a3);
    }
    bf16_t* Tg = (bf16_t*)(p.ws + OFF_OB) + (size_t)((chunk * 4 + h) * 2 + w) * 4096;
#pragma unroll
    for (int i = 0; i < 64; ++i) Tg[i * 64 + lane] = f2bf(t[i]);
  }
}

DEVI bf16x8 ld_perm(const bf16_t* p) {
  union { bf16x8 v; uint2 d[2]; } u;
  u.d[0] = *(const uint2*)(p);
  u.d[1] = *(const uint2*)(p + 8);
  return u.v;
}
DEVI bf16x8 pack8(const f32x16& x, int s) {
  union { bf16x8 v; unsigned w[4]; } u;
  u.w[0] = pack2(x[8 * s + 0], x[8 * s + 1]);
  u.w[1] = pack2(x[8 * s + 2], x[8 * s + 3]);
  u.w[2] = pack2(x[8 * s + 4], x[8 * s + 5]);
  u.w[3] = pack2(x[8 * s + 6], x[8 * s + 7]);
  return u.v;
}

__device__ void dn_scan(const Params& p, int l, int item, char* smem) {
  bf16_t* sK = (bf16_t*)smem;
  bf16_t* sQ = (bf16_t*)(smem + 17408);
  bf16_t* sKT = (bf16_t*)(smem + 34816);
  bf16_t* sT = (bf16_t*)(smem + 52224);
  bf16_t* sA = (bf16_t*)(smem + 60928);
  bf16_t* sV = (bf16_t*)(smem + 52224);
  float* sg = (float*)(smem + 69632);
  float* sbt = sg + 64;
  float* seg = sbt + 64;
  float* sdt = seg + 64;
  const int d = item & 1, h = (item >> 1) & 3, b = item >> 3;
  const bf16_t* DQ = (const bf16_t*)(p.ws + OFF_DNQKV);
  const bf16_t* TB = (const bf16_t*)(p.ws + OFF_OB);
  const float* GC = (const float*)(p.ws + OFF_GC);
  const float* BE = (const float*)(p.ws + OFF_BETA);
  bf16_t* MIX = (bf16_t*)(p.ws + OFF_HM);
  bf16_t* Pw = (bf16_t*)(p.ws + OFF_P);
  const float qscale = 0.08838834764831845f;
  const int rsign = d ? -1 : 1;
  f32x16 S0, S1, S2, S3;
#pragma unroll
  for (int r = 0; r < 16; ++r) { S0[r] = 0.f; S1[r] = 0.f; S2[r] = 0.f; S3[r] = 0.f; }
  __builtin_amdgcn_s_setprio(3);
  uint4 qA0, qB0, kA0, kB0, vA0, vB0, qA1, qB1, kA1, kB1, vA1, vB1, tq0, tq1;
  float pgc = 0.f, pbe = 0.f;
#define SCAN_ROW0(N, CHUNK, ROW0)                                    \
  {                                                                  \
    if ((N) < 4) {                                                   \
      int cn = d ? (3 - (N)) : (N);                                  \
      CHUNK = 256 + b * 4 + cn;                                      \
      ROW0 = M_LAT + b * 256 + cn * 64;                              \
    } else {                                                         \
      int ln = (N)-4;                                                \
      ln = d ? (31 - ln) : ln;                                       \
      CHUNK = b * 32 + ln;                                           \
      ROW0 = b * 2048 + ln * 64;                                     \
    }                                                                \
  }
#define SCAN_LOADS(N)                                                                         \
  {                                                                                           \
    const int tid_ = otid();                                                                  \
    int chunk_, row0_;                                                                        \
    SCAN_ROW0(N, chunk_, row0_)                                                               \
    const int rstart_ = d ? (row0_ + 63) : row0_;                                             \
    {                                                                                         \
      const int u = tid_, c8 = u & 15, tp = u >> 4;                                           \
      const bf16_t* ga = DQ + (size_t)(rstart_ + rsign * 2 * tp) * 1536 + h * 128 + c8 * 8;   \
      const bf16_t* gb = ga + rsign * 1536;                                                   \
      qA0 = *(const uint4*)(ga); kA0 = *(const uint4*)(ga + 512); vA0 = *(const uint4*)(ga + 1024); \
      qB0 = *(const uint4*)(gb); kB0 = *(const uint4*)(gb + 512); vB0 = *(const uint4*)(gb + 1024); \
    }                                                                                         \
    {                                                                                         \
      const int u = tid_ + 256, c8 = u & 15, tp = u >> 4;                                     \
      const bf16_t* ga = DQ + (size_t)(rstart_ + rsign * 2 * tp) * 1536 + h * 128 + c8 * 8;   \
      const bf16_t* gb = ga + rsign * 1536;                                                   \
      qA1 = *(const uint4*)(ga); kA1 = *(const uint4*)(ga + 512); vA1 = *(const uint4*)(ga + 1024); \
      qB1 = *(const uint4*)(gb); kB1 = *(const uint4*)(gb + 512); vB1 = *(const uint4*)(gb + 1024); \
    }                                                                                         \
    {                                                                                         \
      const bf16_t* Tg = TB + (size_t)((chunk_ * 4 + h) * 2 + d) * 4096;                      \
      tq0 = *(const uint4*)(Tg + (tid_ >> 3) * 64 + (tid_ & 7) * 8);                          \
      tq1 = *(const uint4*)(Tg + ((tid_ >> 3) + 32) * 64 + (tid_ & 7) * 8);                   \
    }                                                                                         \
    if (tid_ < 64) {                                                                          \
      const int row = rstart_ + rsign * tid_;                                                 \
      pgc = GC[(size_t)row * 8 + d * 4 + h];                                                  \
      pbe = BE[(size_t)row * 8 + d * 4 + h];                                                  \
    }                                                                                         \
  }
  SCAN_LOADS(0)
  for (int n = 0; n < 36; ++n) {
    const int tid = otid(), lane = tid & 63, w = tid >> 6, li = lane & 31, hh = lane >> 5;
    int chunk, row0;
    SCAN_ROW0(n, chunk, row0)
    (void)chunk;
    const int rstart = d ? (row0 + 63) : row0;
    __syncthreads();
#define STAGE_UNIT(U, QA, QB, KA, KB, VA, VB)                                                   \
  {                                                                                             \
    const int c8 = (U)&15, tp = (U) >> 4;                                                       \
    *(uint4*)(sQ + (2 * tp) * 136 + c8 * 8) = QA;                                               \
    *(uint4*)(sQ + (2 * tp + 1) * 136 + c8 * 8) = QB;                                           \
    *(uint4*)(sK + (2 * tp) * 136 + c8 * 8) = KA;                                               \
    *(uint4*)(sK + (2 * tp + 1) * 136 + c8 * 8) = KB;                                           \
    *(uint4*)(sV + (2 * tp) * 136 + c8 * 8) = VA;                                               \
    *(uint4*)(sV + (2 * tp + 1) * 136 + c8 * 8) = VB;                                           \
    unsigned* kt = (unsigned*)(sKT + (c8 * 8) * 68 + 2 * tp);                                   \
    kt[0 * 34] = (KA.x & 0xffffu) | (KB.x << 16);                                               \
    kt[1 * 34] = (KA.x >> 16) | (KB.x & 0xffff0000u);                                           \
    kt[2 * 34] = (KA.y & 0xffffu) | (KB.y << 16);                                               \
    kt[3 * 34] = (KA.y >> 16) | (KB.y & 0xffff0000u);                                           \
    kt[4 * 34] = (KA.z & 0xffffu) | (KB.z << 16);                                               \
    kt[5 * 34] = (KA.z >> 16) | (KB.z & 0xffff0000u);                                           \
    kt[6 * 34] = (KA.w & 0xffffu) | (KB.w << 16);                                               \
    kt[7 * 34] = (KA.w >> 16) | (KB.w & 0xffff0000u);                                           \
  }
    STAGE_UNIT(tid, qA0, qB0, kA0, kB0, vA0, vB0)
    STAGE_UNIT(tid + 256, qA1, qB1, kA1, kB1, vA1, vB1)
#undef STAGE_UNIT
    if (tid < 64) {
      float g63 = __shfl(pgc, 63);
      sg[lane] = pgc;
      sbt[lane] = pbe;
      seg[lane] = __expf(pgc);
      sdt[lane] = __expf(g63 - pgc);
    }
    __syncthreads();
    f32x16 v0, v1;
#pragma unroll
    for (int r = 0; r < 16; ++r) {
      const int t0 = rowmap(r, hh);
      v0[r] = bf2f(sV[t0 * 136 + w * 32 + li]);
      v1[r] = bf2f(sV[(32 + t0) * 136 + w * 32 + li]);
    }
    __syncthreads();
    {
      const int i0 = tid >> 3, c8 = tid & 7;
      *(uint2*)(sT + i0 * 68 + c8 * 8) = make_uint2(tq0.x, tq0.y);
      *(uint2*)(sT + i0 * 68 + c8 * 8 + 4) = make_uint2(tq0.z, tq0.w);
      *(uint2*)(sT + (i0 + 32) * 68 + c8 * 8) = make_uint2(tq1.x, tq1.y);
      *(uint2*)(sT + (i0 + 32) * 68 + c8 * 8 + 4) = make_uint2(tq1.z, tq1.w);
    }
    {
      const int mi = w >> 1, ni = w & 1;
      f32x16 a;
#pragma unroll
      for (int r = 0; r < 16; ++r) a[r] = 0.f;
      if (!(mi == 0 && ni == 1)) {
#pragma unroll
        for (int ks = 0; ks < 8; ++ks) {
          bf16x8 qa = *(const bf16x8*)(sQ + (mi * 32 + li) * 136 + ks * 16 + hh * 8);
          bf16x8 kb = *(const bf16x8*)(sK + (ni * 32 + li) * 136 + ks * 16 + hh * 8);
          a = __builtin_amdgcn_mfma_f32_32x32x16_bf16(qa, kb, a, 0, 0, 0);
        }
      }
#pragma unroll
      for (int r = 0; r < 16; ++r) {
        const int i = mi * 32 + rowmap(r, hh), j = ni * 32 + li;
        float val = (i >= j) ? a[r] * qscale * __expf(sg[i] - sg[j]) : 0.f;
        sA[i * 68 + j] = f2bf(val);
      }
    }
    __syncthreads();
    f32x16 ks0, ks1;
#pragma unroll
    for (int r = 0; r < 16; ++r) { ks0[r] = 0.f; ks1[r] = 0.f; }
    {
      const bf16_t* ka = sK + li * 136 + 4 * hh;
#define K_STEP(OFFS, SX, SS)                                                                           \
  {                                                                                                    \
    bf16x8 sb = pack8(SX, SS);                                                                         \
    ks0 = __builtin_amdgcn_mfma_f32_32x32x16_bf16(ld_perm(ka + (OFFS)), sb, ks0, 0, 0, 0);             \
    ks1 = __builtin_amdgcn_mfma_f32_32x32x16_bf16(ld_perm(ka + 32 * 136 + (OFFS)), sb, ks1, 0, 0, 0);  \
  }
      K_STEP(0, S0, 0) K_STEP(16, S0, 1) K_STEP(32, S1, 0) K_STEP(48, S1, 1)
      K_STEP(64, S2, 0) K_STEP(80, S2, 1) K_STEP(96, S3, 0) K_STEP(112, S3, 1)
#undef K_STEP
    }
#pragma unroll
    for (int r = 0; r < 16; ++r) {
      const int t0 = rowmap(r, hh), t1 = 32 + t0;
      v0[r] = sbt[t0] * (v0[r] - seg[t0] * ks0[r]);
      v1[r] = sbt[t1] * (v1[r] - seg[t1] * ks1[r]);
    }
    bf16x8 rb00 = pack8(v0, 0), rb01 = pack8(v0, 1), rb10 = pack8(v1, 0), rb11 = pack8(v1, 1);
    f32x16 n0, n1;
#pragma unroll
    for (int r = 0; r < 16; ++r) { n0[r] = 0.f; n1[r] = 0.f; }
    {
      const bf16_t* ta = sT + li * 68 + 4 * hh;
      n0 = __builtin_amdgcn_mfma_f32_32x32x16_bf16(ld_perm(ta + 0), rb00, n0, 0, 0, 0);
      n0 = __builtin_amdgcn_mfma_f32_32x32x16_bf16(ld_perm(ta + 16), rb01, n0, 0, 0, 0);
      const bf16_t* tb = ta + 32 * 68;
      n1 = __builtin_amdgcn_mfma_f32_32x32x16_bf16(ld_perm(tb + 0), rb00, n1, 0, 0, 0);
      n1 = __builtin_amdgcn_mfma_f32_32x32x16_bf16(ld_perm(tb + 16), rb01, n1, 0, 0, 0);
      n1 = __builtin_amdgcn_mfma_f32_32x32x16_bf16(ld_perm(tb + 32), rb10, n1, 0, 0, 0);
      n1 = __builtin_amdgcn_mfma_f32_32x32x16_bf16(ld_perm(tb + 48), rb11, n1, 0, 0, 0);
    }
    f32x16 o0, o1;
#pragma unroll
    for (int r = 0; r < 16; ++r) { o0[r] = 0.f; o1[r] = 0.f; }
    {
      const bf16_t* qa = sQ + li * 136 + 4 * hh;
#define Q_STEP(OFFS, SX, SS)                                                                           \
  {                                                                                                    \
    bf16x8 sb = pack8(SX, SS);                                                                         \
    o0 = __builtin_amdgcn_mfma_f32_32x32x16_bf16(ld_perm(qa + (OFFS)), sb, o0, 0, 0, 0);               \
    o1 = __builtin_amdgcn_mfma_f32_32x32x16_bf16(ld_perm(qa + 32 * 136 + (OFFS)), sb, o1, 0, 0, 0);    \
  }
      Q_STEP(0, S0, 0) Q_STEP(16, S0, 1) Q_STEP(32, S1, 0) Q_STEP(48, S1, 1)
      Q_STEP(64, S2, 0) Q_STEP(80, S2, 1) Q_STEP(96, S3, 0) Q_STEP(112, S3, 1)
#undef Q_STEP
    }
#pragma unroll
    for (int r = 0; r < 16; ++r) {
      const int t0 = rowmap(r, hh), t1 = 32 + t0;
      o0[r] *= seg[t0] * qscale;
      o1[r] *= seg[t1] * qscale;
    }
    {
      bf16x8 nb00 = pack8(n0, 0), nb01 = pack8(n0, 1), nb10 = pack8(n1, 0), nb11 = pack8(n1, 1);
      const bf16_t* aa = sA + li * 68 + 4 * hh;
      o0 = __builtin_amdgcn_mfma_f32_32x32x16_bf16(ld_perm(aa + 0), nb00, o0, 0, 0, 0);
      o0 = __builtin_amdgcn_mfma_f32_32x32x16_bf16(ld_perm(aa + 16), nb01, o0, 0, 0, 0);
      const bf16_t* ab = aa + 32 * 68;
      o1 = __builtin_amdgcn_mfma_f32_32x32x16_bf16(ld_perm(ab + 0), nb00, o1, 0, 0, 0);
      o1 = __builtin_amdgcn_mfma_f32_32x32x16_bf16(ld_perm(ab + 16), nb01, o1, 0, 0, 0);
      o1 = __builtin_amdgcn_mfma_f32_32x32x16_bf16(ld_perm(ab + 32), nb10, o1, 0, 0, 0);
      o1 = __builtin_amdgcn_mfma_f32_32x32x16_bf16(ld_perm(ab + 48), nb11, o1, 0, 0, 0);
    }
    __syncthreads();
#pragma unroll
    for (int r = 0; r < 16; ++r) {
      const int t0 = rowmap(r, hh);
      sQ[t0 * 136 + w * 32 + li] = f2bf(o0[r]);
      sQ[(32 + t0) * 136 + w * 32 + li] = f2bf(o1[r]);
    }
#pragma unroll
    for (int r = 0; r < 16; ++r) {
      const int t0 = rowmap(r, hh), t1 = 32 + t0;
      n0[r] *= sdt[t0];
      n1[r] *= sdt[t1];
    }
    {
      bf16x8 nb00 = pack8(n0, 0), nb01 = pack8(n0, 1), nb10 = pack8(n1, 0), nb11 = pack8(n1, 1);
      const float eg63 = seg[63];
#pragma unroll
      for (int r = 0; r < 16; ++r) { S0[r] *= eg63; S1[r] *= eg63; S2[r] *= eg63; S3[r] *= eg63; }
      SCAN_LOADS(min(n + 1, 35))
      const bf16_t* kt = sKT + li * 68 + 4 * hh;
#define S_UPD(SX, DKT)                                                                                   \
  SX = __builtin_amdgcn_mfma_f32_32x32x16_bf16(ld_perm(kt + (DKT) * 32 * 68 + 0), nb00, SX, 0, 0, 0);    \
  SX = __builtin_amdgcn_mfma_f32_32x32x16_bf16(ld_perm(kt + (DKT) * 32 * 68 + 16), nb01, SX, 0, 0, 0);   \
  SX = __builtin_amdgcn_mfma_f32_32x32x16_bf16(ld_perm(kt + (DKT) * 32 * 68 + 32), nb10, SX, 0, 0, 0);   \
  SX = __builtin_amdgcn_mfma_f32_32x32x16_bf16(ld_perm(kt + (DKT) * 32 * 68 + 48), nb11, SX, 0, 0, 0);
      S_UPD(S0, 0) S_UPD(S1, 1) S_UPD(S2, 2) S_UPD(S3, 3)
#undef S_UPD
    }
    __syncthreads();
    {
      bf16_t* obase = d ? (Pw + C_DN + h * 128) : (MIX + 512 + h * 128);
      const int ostride = d ? INWP : 1024;
#pragma unroll
      for (int e = 0; e < 4; ++e) {
        const int idx = tid + 256 * e, tok = idx >> 4, c8 = idx & 15;
        const int row = rstart + rsign * tok;
        *(uint4*)(obase + (size_t)row * ostride + c8 * 8) = *(const uint4*)(sQ + tok * 136 + c8 * 8);
      }
    }
  }
#undef SCAN_LOADS
#undef SCAN_ROW0
  __builtin_amdgcn_s_setprio(0);
}

__device__ void phaseC(const Params& p, int l, char* smem) {
  const int nb = gridDim.x, bid = blockIdx.x;
  const bf16_t* P = (const bf16_t*)(p.ws + OFF_P);
  constexpr int T0 = 1152, T1 = T0 + 144 * 3, T2 = T1 + 144 * 4, T3 = T2 + M_ALL / 8;
  for (int it = bid; it < T3; it += nb) {
    if (it < T0) {
      dn_chunk_prep(p, l, it, smem);
    } else if (it < T1) {
      int i = it - T0;
      if (l == 3 && i >= 128 * 3) continue;
      gemm_tile<EPI_QUP>(p, l, P + C_MQ, INWP, (const bf16_t*)(p.ws + OFF_WQUP), 256, (i / 3) * 128, (i % 3) * 128, 0,
                         smem);
    } else if (it < T2) {
      int i = it - T1;
      gemm_tile<EPI_KVUP>(p, l, P + C_MKV, INWP, (const bf16_t*)(p.ws + OFF_WKVUP), 128, (i / 4) * 128, (i % 4) * 128,
                          0, smem);
    } else {
      kpe_item(p, it - T2);
    }
  }
}

__device__ void mla_flash(const Params& p, int item, char* smem) {
  bf16_t* sK = (bf16_t*)smem;
  bf16_t* sV = sK + 64 * 104;
  const int tid = otid(), lane = tid & 63, w = tid >> 6;
  const int li = lane & 31, hh = lane >> 5;
  int b, h, q0row, nkeys;
  if (item < 512) {
    b = item >> 6; h = (item >> 4) & 3; q0row = b * 2048 + (item & 15) * 128; nkeys = 2304;
  } else {
    int i = item - 512;
    b = i >> 3; h = (i >> 1) & 3; q0row = M_LAT + b * 256 + (i & 1) * 128; nkeys = 256;
  }
  const bf16_t* Kg = (const bf16_t*)(p.ws + OFF_KH) + (size_t)(b * 4 + h) * 2304 * 96;
  const bf16_t* Vg = (const bf16_t*)(p.ws + OFF_VH) + (size_t)(b * 4 + h) * 64 * 2304;
  const bf16_t* QH = (const bf16_t*)(p.ws + OFF_QH);
  bf16_t* MIX = (bf16_t*)(p.ws + OFF_HM);
  const int qrow = q0row + w * 32 + li;
  bf16x8 qf0, qf1, qf2, qf3, qf4, qf5;
  {
    const bf16_t* qp = QH + (size_t)qrow * 384 + h * 96 + hh * 8;
    qf0 = *(const bf16x8*)(qp); qf1 = *(const bf16x8*)(qp + 16); qf2 = *(const bf16x8*)(qp + 32);
    qf3 = *(const bf16x8*)(qp + 48); qf4 = *(const bf16x8*)(qp + 64); qf5 = *(const bf16x8*)(qp + 80);
  }
  const int k_i0 = tid, k_i1 = tid + 256, k_i2 = tid + 512;
  const int kk0 = k_i0 / 12, kc0 = k_i0 % 12, kk1 = k_i1 / 12, kc1 = k_i1 % 12, kk2 = k_i2 / 12, kc2 = k_i2 % 12;
  const int vd0 = tid >> 3, vc0 = tid & 7, vd1 = vd0 + 32;
  uint4 rk0, rk1, rk2, rv0, rv1;
  rk0 = *(const uint4*)(Kg + (size_t)kk0 * 96 + kc0 * 8);
  rk1 = *(const uint4*)(Kg + (size_t)kk1 * 96 + kc1 * 8);
  rk2 = *(const uint4*)(Kg + (size_t)kk2 * 96 + kc2 * 8);
  rv0 = *(const uint4*)(Vg + (size_t)vd0 * 2304 + vc0 * 8);
  rv1 = *(const uint4*)(Vg + (size_t)vd1 * 2304 + vc0 * 8);
  f32x16 o0, o1;
#pragma unroll
  for (int r = 0; r < 16; ++r) { o0[r] = 0.f; o1[r] = 0.f; }
  float m = -1e30f, lp = 0.f;
  const float sc = 0.10206207261596577f * 1.4426950408889634f;
  const int nt = nkeys >> 6;
  for (int t = 0; t < nt; ++t) {
    __syncthreads();
    *(uint4*)(sK + kk0 * 104 + kc0 * 8) = rk0;
    *(uint4*)(sK + kk1 * 104 + kc1 * 8) = rk1;
    *(uint4*)(sK + kk2 * 104 + kc2 * 8) = rk2;
    *(uint2*)(sV + vd0 * 68 + vc0 * 8) = make_uint2(rv0.x, rv0.y);
    *(uint2*)(sV + vd0 * 68 + vc0 * 8 + 4) = make_uint2(rv0.z, rv0.w);
    *(uint2*)(sV + vd1 * 68 + vc0 * 8) = make_uint2(rv1.x, rv1.y);
    *(uint2*)(sV + vd1 * 68 + vc0 * 8 + 4) = make_uint2(rv1.z, rv1.w);
    __syncthreads();
    if (t + 1 < nt) {
      const int k0 = (t + 1) * 64;
      rk0 = *(const uint4*)(Kg + (size_t)(k0 + kk0) * 96 + kc0 * 8);
      rk1 = *(const uint4*)(Kg + (size_t)(k0 + kk1) * 96 + kc1 * 8);
      rk2 = *(const uint4*)(Kg + (size_t)(k0 + kk2) * 96 + kc2 * 8);
      rv0 = *(const uint4*)(Vg + (size_t)vd0 * 2304 + k0 + vc0 * 8);
      rv1 = *(const uint4*)(Vg + (size_t)vd1 * 2304 + k0 + vc0 * 8);
    }
    f32x16 s0, s1;
#pragma unroll
    for (int r = 0; r < 16; ++r) { s0[r] = 0.f; s1[r] = 0.f; }
    {
      const bf16_t* ka = sK + li * 104 + hh * 8;
      const bf16_t* kb = ka + 32 * 104;
      s0 = __builtin_amdgcn_mfma_f32_32x32x16_bf16(*(const bf16x8*)(ka), qf0, s0, 0, 0, 0);
      s1 = __builtin_amdgcn_mfma_f32_32x32x16_bf16(*(const bf16x8*)(kb), qf0, s1, 0, 0, 0);
      s0 = __builtin_amdgcn_mfma_f32_32x32x16_bf16(*(const bf16x8*)(ka + 16), qf1, s0, 0, 0, 0);
      s1 = __builtin_amdgcn_mfma_f32_32x32x16_bf16(*(const bf16x8*)(kb + 16), qf1, s1, 0, 0, 0);
      s0 = __builtin_amdgcn_mfma_f32_32x32x16_bf16(*(const bf16x8*)(ka + 32), qf2, s0, 0, 0, 0);
      s1 = __builtin_amdgcn_mfma_f32_32x32x16_bf16(*(const bf16x8*)(kb + 32), qf2, s1, 0, 0, 0);
      s0 = __builtin_amdgcn_mfma_f32_32x32x16_bf16(*(const bf16x8*)(ka + 48), qf3, s0, 0, 0, 0);
      s1 = __builtin_amdgcn_mfma_f32_32x32x16_bf16(*(const bf16x8*)(kb + 48), qf3, s1, 0, 0, 0);
      s0 = __builtin_amdgcn_mfma_f32_32x32x16_bf16(*(const bf16x8*)(ka + 64), qf4, s0, 0, 0, 0);
      s1 = __builtin_amdgcn_mfma_f32_32x32x16_bf16(*(const bf16x8*)(kb + 64), qf4, s1, 0, 0, 0);
      s0 = __builtin_amdgcn_mfma_f32_32x32x16_bf16(*(const bf16x8*)(ka + 80), qf5, s0, 0, 0, 0);
      s1 = __builtin_amdgcn_mfma_f32_32x32x16_bf16(*(const bf16x8*)(kb + 80), qf5, s1, 0, 0, 0);
    }
    float mx = s0[0];
#pragma unroll
    for (int r = 1; r < 16; ++r) mx = fmaxf(mx, s0[r]);
#pragma unroll
    for (int r = 0; r < 16; ++r) mx = fmaxf(mx, s1[r]);
    mx = fmaxf(mx, __shfl_xor(mx, 32));
    const float mn = fmaxf(m, mx * sc);
    const float corr = __builtin_amdgcn_exp2f(m - mn);
    m = mn;
    lp *= corr;
#pragma unroll
    for (int r = 0; r < 16; ++r) { o0[r] *= corr; o1[r] *= corr; }
#pragma unroll
    for (int r = 0; r < 16; ++r) {
      s0[r] = __builtin_amdgcn_exp2f(s0[r] * sc - mn);
      s1[r] = __builtin_amdgcn_exp2f(s1[r] * sc - mn);
      lp += s0[r] + s1[r];
    }
#pragma unroll
    for (int u = 0; u < 2; ++u) {
#pragma unroll
      for (int s = 0; s < 2; ++s) {
        union { bf16x8 v; unsigned w[4]; } pb;
        if (u == 0) {
          pb.w[0] = pack2(s0[8 * s + 0], s0[8 * s + 1]); pb.w[1] = pack2(s0[8 * s + 2], s0[8 * s + 3]);
          pb.w[2] = pack2(s0[8 * s + 4], s0[8 * s + 5]); pb.w[3] = pack2(s0[8 * s + 6], s0[8 * s + 7]);
        } else {
          pb.w[0] = pack2(s1[8 * s + 0], s1[8 * s + 1]); pb.w[1] = pack2(s1[8 * s + 2], s1[8 * s + 3]);
          pb.w[2] = pack2(s1[8 * s + 4], s1[8 * s + 5]); pb.w[3] = pack2(s1[8 * s + 6], s1[8 * s + 7]);
        }
        const bf16_t* va = sV + li * 68 + 32 * u + 16 * s + 4 * hh;
        union { bf16x8 v; uint2 d[2]; } a0, a1;
        a0.d[0] = *(const uint2*)(va);
        a0.d[1] = *(const uint2*)(va + 8);
        a1.d[0] = *(const uint2*)(va + 32 * 68);
        a1.d[1] = *(const uint2*)(va + 32 * 68 + 8);
        o0 = __builtin_amdgcn_mfma_f32_32x32x16_bf16(a0.v, pb.v, o0, 0, 0, 0);
        o1 = __builtin_amdgcn_mfma_f32_32x32x16_bf16(a1.v, pb.v, o1, 0, 0, 0);
      }
    }
  }
  lp += __shfl_xor(lp, 32);
  const float inv = 1.f / lp;
  bf16_t* op = MIX + (size_t)qrow * 1024 + h * 64 + 4 * hh;
#pragma unroll
  for (int g = 0; g < 4; ++g) {
    uint2 u0, u1;
    u0.x = pack2(o0[4 * g + 0] * inv, o0[4 * g + 1] * inv);
    u0.y = pack2(o0[4 * g + 2] * inv, o0[4 * g + 3] * inv);
    u1.x = pack2(o1[4 * g + 0] * inv, o1[4 * g + 1] * inv);
    u1.y = pack2(o1[4 * g + 2] * inv, o1[4 * g + 3] * inv);
    *(uint2*)(op + 8 * g) = u0;
    *(uint2*)(op + 32 + 8 * g) = u1;
  }
}

__device__ void na_naive(const Params& p, int l, int ti) {
  const int h = otid() >> 6, lane = otid() & 63;
  const bf16_t* P = (const bf16_t*)(p.ws + OFF_P);
  bf16_t* MIX = (bf16_t*)(p.ws + OFF_HM);
  const bool lat = ti < 256;
  const int b = lat ? (ti >> 5) : ((ti - 256) >> 2);
  const int r = ti & 31;
  const int row = lat ? (ti * 64 + lane) : (M_LAT + (ti - 256) * 64 + lane);
  uint4 qk[8];
  float acc[64];
  {
    const uint4* qp = (const uint4*)(P + (size_t)row * INWP + C_NQ + h * 64);
#pragma unroll
    for (int c = 0; c < 8; ++c) qk[c] = qp[c];
  }
#pragma unroll
  for (int i = 0; i < 64; ++i) acc[i] = 0.f;
  float m = -INFINITY, ls = 0.f;
  const int qc = lane;
  const int rs0 = min(max(r - 4, 0), 24);
  const int cs0 = min(max(qc - 8, 0), 48);
  const float* rb = p.rel_bias + (size_t)l * 4 * 15 * 31 + h * 15 * 31;
  const int nloc = lat ? 128 : 0;
  for (int j = 0; j < nloc + 256; ++j) {
    int krow;
    float bias = 0.f;
    if (j < nloc) {
      int kr = rs0 + (j >> 4), kc = cs0 + (j & 15);
      krow = b * 2048 + kr * 64 + kc;
      bias = rb[(kr - r + 7) * 31 + (kc - qc + 15)];
    } else {
      krow = M_LAT + b * 256 + (j - nloc);
    }
    const uint4* kp = (const uint4*)(P + (size_t)krow * INWP + C_NK + h * 64);
    float s = 0.f;
#pragma unroll
    for (int c = 0; c < 8; ++c) {
      uint4 u = kp[c];
      uint4 q = qk[c];
      s += bflo(q.x) * bflo(u.x) + bfhi(q.x) * bfhi(u.x) + bflo(q.y) * bflo(u.y) + bfhi(q.y) * bfhi(u.y) +
           bflo(q.z) * bflo(u.z) + bfhi(q.z) * bfhi(u.z) + bflo(q.w) * bflo(u.w) + bfhi(q.w) * bfhi(u.w);
    }
    s = s * 0.125f + bias;
    float mn = fmaxf(m, s);
    float corr = __expf(m - mn), pe = __expf(s - mn);
    ls = ls * corr + pe;
    m = mn;
    const uint4* vp = (const uint4*)(P + (size_t)krow * INWP + C_NV + h * 64);
#pragma unroll
    for (int c = 0; c < 8; ++c) {
      uint4 u = vp[c];
      acc[c * 8 + 0] = acc[c * 8 + 0] * corr + pe * bflo(u.x);
      acc[c * 8 + 1] = acc[c * 8 + 1] * corr + pe * bfhi(u.x);
      acc[c * 8 + 2] = acc[c * 8 + 2] * corr + pe * bflo(u.y);
      acc[c * 8 + 3] = acc[c * 8 + 3] * corr + pe * bfhi(u.y);
      acc[c * 8 + 4] = acc[c * 8 + 4] * corr + pe * bflo(u.z);
      acc[c * 8 + 5] = acc[c * 8 + 5] * corr + pe * bfhi(u.z);
      acc[c * 8 + 6] = acc[c * 8 + 6] * corr + pe * bflo(u.w);
      acc[c * 8 + 7] = acc[c * 8 + 7] * corr + pe * bfhi(u.w);
    }
  }
  const float inv = 1.f / ls;
  uint4* op = (uint4*)(MIX + (size_t)row * 1024 + 256 + h * 64);
#pragma unroll
  for (int c = 0; c < 8; ++c) {
    uint4 u;
    u.x = pack2(acc[c * 8 + 0] * inv, acc[c * 8 + 1] * inv);
    u.y = pack2(acc[c * 8 + 2] * inv, acc[c * 8 + 3] * inv);
    u.z = pack2(acc[c * 8 + 4] * inv, acc[c * 8 + 5] * inv);
    u.w = pack2(acc[c * 8 + 6] * inv, acc[c * 8 + 7] * inv);
    op[c] = u;
  }
}

__device__ void na_flash(const Params& p, int l, int item, char* smem) {
  bf16_t* sK = (bf16_t*)smem;
  bf16_t* sV = sK + 64 * 72;
  float* sBias = (float*)(smem + 18432);
  const int tid = otid(), lane = tid & 63, w = tid >> 6;
  const int li = lane & 31, hh = lane >> 5;
  const bf16_t* P = (const bf16_t*)(p.ws + OFF_P);
  bf16_t* MIX = (bf16_t*)(p.ws + OFF_HM);
  int b, h, qrow, qr = 0, qc = 0, rs0 = 0, ntiles, krow0 = 0;
  bool lat;
  if (item < 512) {
    lat = true;
    b = item >> 6; h = item & 3;
    const int r0 = ((item >> 2) & 15) * 2;
    qr = r0 + (w >> 1); qc = (w & 1) * 32 + li;
    qrow = b * 2048 + qr * 64 + qc;
    krow0 = min(max(r0 - 4, 0), 24);
    const int klast = min(max(r0 + 1 - 4, 0), 24) + 7;
    ntiles = 4 + (klast - krow0 + 1);
    rs0 = min(max(qr - 4, 0), 24);
  } else {
    lat = false;
    const int i = item - 512;
    b = i >> 3; h = i & 3;
    qrow = M_LAT + b * 256 + ((i >> 2) & 1) * 128 + w * 32 + li;
    ntiles = 4;
  }
  const int cs0 = min(max(qc - 8, 0), 48);
  const bf16_t* Vg = (const bf16_t*)(p.ws + OFF_NVT) + (size_t)(b * 4 + h) * 64 * 2304;
  bf16x8 qf0, qf1, qf2, qf3;
  {
    const bf16_t* qp = P + (size_t)qrow * INWP + C_NQ + h * 64 + hh * 8;
    qf0 = *(const bf16x8*)(qp); qf1 = *(const bf16x8*)(qp + 16); qf2 = *(const bf16x8*)(qp + 32); qf3 = *(const bf16x8*)(qp + 48);
  }
  __syncthreads();
  for (int i = tid; i < 465; i += 256)
    sBias[i] = p.rel_bias[(size_t)l * 4 * 465 + h * 465 + i] * 1.4426950408889634f;
  const int kk0 = tid >> 3, kc8 = tid & 7, kk1 = kk0 + 32;
  uint4 rk0, rk1, rv0, rv1;
  {
    const size_t kr = (size_t)(M_LAT + b * 256);
    rk0 = *(const uint4*)(P + (kr + kk0) * INWP + C_NK + h * 64 + kc8 * 8);
    rk1 = *(const uint4*)(P + (kr + kk1) * INWP + C_NK + h * 64 + kc8 * 8);
    rv0 = *(const uint4*)(Vg + (size_t)kk0 * 2304 + kc8 * 8);
    rv1 = *(const uint4*)(Vg + (size_t)kk1 * 2304 + kc8 * 8);
  }
  f32x16 o0, o1;
#pragma unroll
  for (int r = 0; r < 16; ++r) { o0[r] = 0.f; o1[r] = 0.f; }
  float m = -1e30f, lp = 0.f;
  const float sc = 0.125f * 1.4426950408889634f;
  for (int t = 0; t < ntiles; ++t) {
    __syncthreads();
    *(uint4*)(sK + kk0 * 72 + kc8 * 8) = rk0;
    *(uint4*)(sK + kk1 * 72 + kc8 * 8) = rk1;
    *(uint2*)(sV + kk0 * 68 + kc8 * 8) = make_uint2(rv0.x, rv0.y);
    *(uint2*)(sV + kk0 * 68 + kc8 * 8 + 4) = make_uint2(rv0.z, rv0.w);
    *(uint2*)(sV + kk1 * 68 + kc8 * 8) = make_uint2(rv1.x, rv1.y);
    *(uint2*)(sV + kk1 * 68 + kc8 * 8 + 4) = make_uint2(rv1.z, rv1.w);
    __syncthreads();
    if (t + 1 < ntiles) {
      const int tn = t + 1;
      size_t kr;
      int vk;
      if (tn < 4) { kr = (size_t)(M_LAT + b * 256 + tn * 64); vk = tn * 64; }
      else { kr = (size_t)(b * 2048 + (krow0 + tn - 4) * 64); vk = 256 + (krow0 + tn - 4) * 64; }
      rk0 = *(const uint4*)(P + (kr + kk0) * INWP + C_NK + h * 64 + kc8 * 8);
      rk1 = *(const uint4*)(P + (kr + kk1) * INWP + C_NK + h * 64 + kc8 * 8);
      rv0 = *(const uint4*)(Vg + (size_t)kk0 * 2304 + vk + kc8 * 8);
      rv1 = *(const uint4*)(Vg + (size_t)kk1 * 2304 + vk + kc8 * 8);
    }
    const int kr_abs = krow0 + t - 4;
    const bool local = t >= 4;
    if (local && (kr_abs < rs0 || kr_abs >= rs0 + 8)) continue;
    f32x16 s0, s1;
#pragma unroll
    for (int r = 0; r < 16; ++r) { s0[r] = 0.f; s1[r] = 0.f; }
    {
      const bf16_t* ka = sK + li * 72 + hh * 8;
      const bf16_t* kb = ka + 32 * 72;
      s0 = __builtin_amdgcn_mfma_f32_32x32x16_bf16(*(const bf16x8*)(ka), qf0, s0, 0, 0, 0);
      s1 = __builtin_amdgcn_mfma_f32_32x32x16_bf16(*(const bf16x8*)(kb), qf0, s1, 0, 0, 0);
      s0 = __builtin_amdgcn_mfma_f32_32x32x16_bf16(*(const bf16x8*)(ka + 16), qf1, s0, 0, 0, 0);
      s1 = __builtin_amdgcn_mfma_f32_32x32x16_bf16(*(const bf16x8*)(kb + 16), qf1, s1, 0, 0, 0);
      s0 = __builtin_amdgcn_mfma_f32_32x32x16_bf16(*(const bf16x8*)(ka + 32), qf2, s0, 0, 0, 0);
      s1 = __builtin_amdgcn_mfma_f32_32x32x16_bf16(*(const bf16x8*)(kb + 32), qf2, s1, 0, 0, 0);
      s0 = __builtin_amdgcn_mfma_f32_32x32x16_bf16(*(const bf16x8*)(ka + 48), qf3, s0, 0, 0, 0);
      s1 = __builtin_amdgcn_mfma_f32_32x32x16_bf16(*(const bf16x8*)(kb + 48), qf3, s1, 0, 0, 0);
    }
    if (local) {
      const float* bp = sBias + (kr_abs - qr + 7) * 31 - qc + 15;
#pragma unroll
      for (int r = 0; r < 16; ++r) {
        const int kc0 = rowmap(r, hh), kc1 = 32 + kc0;
        const bool v0 = (kc0 >= cs0) && (kc0 < cs0 + 16);
        const bool v1 = (kc1 >= cs0) && (kc1 < cs0 + 16);
        const float b0 = v0 ? bp[kc0] : 0.f;
        const float b1 = v1 ? bp[kc1] : 0.f;
        s0[r] = v0 ? (s0[r] * sc + b0) : -1e30f;
        s1[r] = v1 ? (s1[r] * sc + b1) : -1e30f;
      }
    } else {
#pragma unroll
      for (int r = 0; r < 16; ++r) { s0[r] *= sc; s1[r] *= sc; }
    }
    float mx = s0[0];
#pragma unroll
    for (int r = 1; r < 16; ++r) mx = fmaxf(mx, s0[r]);
#pragma unroll
    for (int r = 0; r < 16; ++r) mx = fmaxf(mx, s1[r]);
    mx = fmaxf(mx, __shfl_xor(mx, 32));
    const float mn = fmaxf(m, mx);
    const float corr = __builtin_amdgcn_exp2f(m - mn);
    m = mn;
    lp *= corr;
#pragma unroll
    for (int r = 0; r < 16; ++r) { o0[r] *= corr; o1[r] *= corr; }
#pragma unroll
    for (int r = 0; r < 16; ++r) {
      s0[r] = __builtin_amdgcn_exp2f(s0[r] - mn);
      s1[r] = __builtin_amdgcn_exp2f(s1[r] - mn);
      lp += s0[r] + s1[r];
    }
#pragma unroll
    for (int u = 0; u < 2; ++u) {
#pragma unroll
      for (int s = 0; s < 2; ++s) {
        bf16x8 pb = u == 0 ? pack8(s0, s) : pack8(s1, s);
        const bf16_t* va = sV + li * 68 + 32 * u + 16 * s + 4 * hh;
        o0 = __builtin_amdgcn_mfma_f32_32x32x16_bf16(ld_perm(va), pb, o0, 0, 0, 0);
        o1 = __builtin_amdgcn_mfma_f32_32x32x16_bf16(ld_perm(va + 32 * 68), pb, o1, 0, 0, 0);
      }
    }
  }
  lp += __shfl_xor(lp, 32);
  const float inv = 1.f / lp;
  bf16_t* op = MIX + (size_t)qrow * 1024 + 256 + h * 64 + 4 * hh;
#pragma unroll
  for (int g = 0; g < 4; ++g) {
    uint2 u0, u1;
    u0.x = pack2(o0[4 * g + 0] * inv, o0[4 * g + 1] * inv);
    u0.y = pack2(o0[4 * g + 2] * inv, o0[4 * g + 3] * inv);
    u1.x = pack2(o1[4 * g + 0] * inv, o1[4 * g + 1] * inv);
    u1.y = pack2(o1[4 * g + 2] * inv, o1[4 * g + 3] * inv);
    *(uint2*)(op + 8 * g) = u0;
    *(uint2*)(op + 32 + 8 * g) = u1;
  }
}

DEVI int dn_rowof(int s, int b, int d) {
  if (s < 256) {
    int c = d ? (255 - s) : s;
    return M_LAT + b * 256 + c;
  }
  int t = s - 256;
  t = d ? (2047 - t) : t;
  return b * 2048 + t;
}

__device__ void dn_naive(const Params& p, int l, int it, char* smem) {
  float* ks = (float*)smem;
  float* qs = ks + 32 * 128;
  float* vs = qs + 32 * 128;
  float* gs = vs + 32 * 64;
  float* bs = gs + 32;
  const int half = it & 1, d = (it >> 1) & 1, h = (it >> 2) & 3, b = it >> 4;
  const int tid = otid(), w = tid >> 6, lane = tid & 63, c = lane & 15, kg = lane >> 4;
  const int col = half * 64 + w * 16 + c;
  const bf16_t* DQ = (const bf16_t*)(p.ws + OFF_DNQKV);
  const float* AB = (const float*)(p.ws + OFF_AB);
  bf16_t* MIX = (bf16_t*)(p.ws + OFF_HM);
  bf16_t* OB = (bf16_t*)(p.ws + OFF_OB);
  float S[32];
#pragma unroll
  for (int i = 0; i < 32; ++i) S[i] = 0.f;
  const float Aneg = -__expf(p.a_log[l * 8 + d * 4 + h]);
  const float dtb = p.dt_bias[l * 8 + d * 4 + h];
  for (int s0 = 0; s0 < 2304; s0 += 32) {
    __syncthreads();
    for (int i = tid; i < 32 * 128; i += 256) {
      int tk = i >> 7, ch = i & 127;
      int row = dn_rowof(s0 + tk, b, d);
      qs[i] = bf2f(DQ[(size_t)row * 1536 + h * 128 + ch]);
      ks[i] = bf2f(DQ[(size_t)row * 1536 + 512 + h * 128 + ch]);
    }
    for (int i = tid; i < 32 * 64; i += 256) {
      int tk = i >> 6, ch = i & 63;
      int row = dn_rowof(s0 + tk, b, d);
      vs[i] = bf2f(DQ[(size_t)row * 1536 + 1024 + h * 128 + half * 64 + ch]);
    }
    if (tid < 32) {
      int row = dn_rowof(s0 + tid, b, d);
      float a = AB[(size_t)row * 16 + d * 4 + h];
      float bb = AB[(size_t)row * 16 + 8 + d * 4 + h];
      float xx = a + dtb;
      const float ee = __expf(xx);
    float sp = ee < 0.25f ? ee * (1.f - ee * (0.5f - ee * (0.33333333f - ee * (0.25f - 0.2f * ee))))
                          : (xx > 20.f ? xx : __logf(1.f + ee));
      gs[tid] = __expf(Aneg * sp);
      bs[tid] = 1.f / (1.f + __expf(-bb));
    }
    __syncthreads();
    for (int tk = 0; tk < 32; ++tk) {
      const float eg = gs[tk], beta = bs[tk];
      const float vv = vs[tk * 64 + w * 16 + c];
      const float4* k4 = (const float4*)(ks + tk * 128 + kg * 32);
      const float4* q4 = (const float4*)(qs + tk * 128 + kg * 32);
      float part = 0.f;
#pragma unroll
      for (int i = 0; i < 8; ++i) {
        float4 kk = k4[i];
        S[4 * i + 0] *= eg; S[4 * i + 1] *= eg; S[4 * i + 2] *= eg; S[4 * i + 3] *= eg;
        part += kk.x * S[4 * i + 0] + kk.y * S[4 * i + 1] + kk.z * S[4 * i + 2] + kk.w * S[4 * i + 3];
      }
      part += __shfl_xor(part, 16);
      part += __shfl_xor(part, 32);
      const float delta = beta * (vv - part);
      float po = 0.f;
#pragma unroll
      for (int i = 0; i < 8; ++i) {
        float4 kk = k4[i];
        float4 qq = q4[i];
        S[4 * i + 0] += kk.x * delta; S[4 * i + 1] += kk.y * delta; S[4 * i + 2] += kk.z * delta; S[4 * i + 3] += kk.w * delta;
        po += qq.x * S[4 * i + 0] + qq.y * S[4 * i + 1] + qq.z * S[4 * i + 2] + qq.w * S[4 * i + 3];
      }
      po += __shfl_xor(po, 16);
      po += __shfl_xor(po, 32);
      if (kg == 0) {
        int row = dn_rowof(s0 + tk, b, d);
        float o = po * 0.08838834764831845f;
        if (d == 0)
          MIX[(size_t)row * 1024 + 512 + h * 128 + col] = f2bf(o);
        else
          OB[(size_t)row * 512 + h * 128 + col] = f2bf(o);
      }
    }
  }
}

__device__ void phaseD(const Params& p, int l, char* smem) {
  const int nb = gridDim.x, bid = blockIdx.x;
  if (bid < 64) {
    dn_scan(p, l, bid, smem);
    return;
  }
  if (bid >= 256 && bid < 320) return;
  const int nb2 = nb - 128;
  const int wid = bid < 256 ? bid - 64 : bid - 128;
  const int n_early = l < 3 ? N_CONV_EARLY : 0;
  for (int it = wid; it < 1152 + N_CONV_LATE + n_early; it += nb2) {
    if (it < 576) {
      int item = it;
      if (it < 512) item = ((it & 7) * 64) + (it >> 3);
      else if (l == 3) continue;
      mla_flash(p, item, smem);
    } else if (it < 1152) {
      if (l == 3 && it - 576 >= 512) continue;
      na_flash(p, l, it - 576, smem);
    } else if (it < 1152 + N_CONV_LATE) {
      conv_item_late(p, l, it - 1152, (float*)smem);
    } else {
      conv_item_early(p, l + 1, it - 1152 - N_CONV_LATE, (float*)smem);
    }
  }
}

__device__ void outgate_item(const Params& p, int l, int item) {
  const int w = otid() >> 6, lane = otid() & 63;
  const int row = item * 4 + w;
  const bf16_t* P = (const bf16_t*)(p.ws + OFF_P);
  bf16_t* MIX = (bf16_t*)(p.ws + OFF_HM);
  const int h = lane >> 4, cb = (lane & 15) * 8;
  uint4 uo = *(const uint4*)(MIX + (size_t)row * 1024 + 512 + h * 128 + cb);
  uint4 ub = *(const uint4*)(P + (size_t)row * INWP + C_DN + h * 128 + cb);
  uint4 uz = *(const uint4*)(P + (size_t)row * INWP + C_DZ + h * 128 + cb);
  float o[8], z[8];
  o[0] = bflo(uo.x) + bflo(ub.x); o[1] = bfhi(uo.x) + bfhi(ub.x); o[2] = bflo(uo.y) + bflo(ub.y); o[3] = bfhi(uo.y) + bfhi(ub.y);
  o[4] = bflo(uo.z) + bflo(ub.z); o[5] = bfhi(uo.z) + bfhi(ub.z); o[6] = bflo(uo.w) + bflo(ub.w); o[7] = bfhi(uo.w) + bfhi(ub.w);
  z[0] = bflo(uz.x); z[1] = bfhi(uz.x); z[2] = bflo(uz.y); z[3] = bfhi(uz.y);
  z[4] = bflo(uz.z); z[5] = bfhi(uz.z); z[6] = bflo(uz.w); z[7] = bfhi(uz.w);
  float ss = 0.f;
#pragma unroll
  for (int e = 0; e < 8; ++e) ss += o[e] * o[e];
  ss += __shfl_xor(ss, 1);
  ss += __shfl_xor(ss, 2);
  ss += __shfl_xor(ss, 4);
  ss += __shfl_xor(ss, 8);
  const float r = rsqrtf(ss * (1.f / 128.f) + 1e-6f);
  const float* go = p.g_out + l * 128 + cb;
  float y[8];
#pragma unroll
  for (int e = 0; e < 8; ++e) y[e] = o[e] * r * go[e] * silu_f(z[e]);
  uint4 u;
  u.x = pack2(y[0], y[1]); u.y = pack2(y[2], y[3]); u.z = pack2(y[4], y[5]); u.w = pack2(y[6], y[7]);
  *(uint4*)(MIX + (size_t)row * 1024 + 512 + h * 128 + cb) = u;
}

__device__ void final_item(const Params& p, int item) {
  const int w = otid() >> 6, lane = otid() & 63;
  const int row = item * 4 + w;
  const float4* xr = (const float4*)((const float*)(p.ws + OFF_X) + (size_t)row * 1024);
  float4 v[4];
  float ss = 0.f;
#pragma unroll
  for (int i = 0; i < 4; ++i) {
    v[i] = xr[lane + 64 * i];
    ss += v[i].x * v[i].x + v[i].y * v[i].y + v[i].z * v[i].z + v[i].w * v[i].w;
  }
  ss = wave_sum(ss);
  const float r = rsqrtf(ss * (1.f / 1024.f) + 1e-6f);
  const float4* g4 = (const float4*)p.g_final;
  float4* o4 = (float4*)(p.out + (size_t)row * 1024);
#pragma unroll
  for (int i = 0; i < 4; ++i) {
    float4 gg = g4[lane + 64 * i];
    float4 y;
    y.x = v[i].x * r * gg.x; y.y = v[i].y * r * gg.y; y.z = v[i].z * r * gg.z; y.w = v[i].w * r * gg.w;
    o4[lane + 64 * i] = y;
  }
}

constexpr int N_PHASES = 1 + 9 * 4 + 1;

__global__ void __launch_bounds__(256, 2) mega(Params p) {
  __shared__ __attribute__((aligned(16))) char smem[SMEM_BYTES];
  cg::grid_group grid = cg::this_grid();
  const int nb = gridDim.x, bid = blockIdx.x;
  __shared__ uint4 xb_words;
  if (threadIdx.x == 0) xb_words = make_uint4(0u, 0u, 0u, 0u);
  __syncthreads();
  XcdBarrier xb = xcd_barrier_post((unsigned*)(p.ws + OFF_BAR), (volatile LAS unsigned*)&xb_words);
#ifdef PROBE_S
  bool again = false;
#endif
  for (int ph = p.ph_lo; ph < p.ph_hi; ++ph) {
    if (ph == 0) {
      phase0(p, smem);
    } else if (ph == N_PHASES - 1) {
      for (int it = bid; it < M_LAT / 4; it += nb) final_item(p, it);
    } else {
      const int l = (ph - 1) / 9, s = (ph - 1) % 9;
      if (s == 0) {
        phaseA(p, l, smem);
      } else if (s == 1) {
        for (int it = bid; it < 144 * 13; it += nb) {
          int mt, nt;
          tile_map(it, 13, mt, nt);
          gemm_wide16<EPI_P>(p, l, (const bf16_t*)(p.ws + OFF_HM), 1024, (const bf16_t*)(p.ws + OFF_WIN), 1024,
                             mt * 128, nt * 256, smem);
        }
      } else if (s == 2) {
        phaseC(p, l, smem);
      } else if (s == 3) {
        phaseD(p, l, smem);
      } else if (s == 4) {
        for (int it = bid; it < (l == 3 ? M_LAT : M_ALL) / 4; it += nb) outgate_item(p, l, it);
      } else if (s == 5) {
        const int mpx = l == 3 ? 16 : 18;
        for (int it = bid; it < 8 * mpx * 8; it += nb) {
          int mt, nt;
          tile_map(it, 8, mt, nt, mpx);
          gemm_tile<EPI_RES>(p, l, (const bf16_t*)(p.ws + OFF_HM), 1024, (const bf16_t*)(p.ws + OFF_WOUT), 1024,
                             mt * 128, nt * 128, 2, smem);
        }
      } else if (s == 6) {
        for (int it = bid; it < (l == 3 ? M_LAT : M_ALL) / 4; it += nb)
          norm_rows(p, false, (bf16_t*)(p.ws + OFF_HM), p.g_ffn + l * 1024,
                    (const float*)(p.ws + OFF_MOD) + (size_t)l * 9 * 6144, 3, 4, it);
      } else if (s == 7) {
        const int mpx = l == 3 ? 16 : 18;
        for (int it = bid; it < 8 * mpx * 22; it += nb) {
          int mt, nt;
          tile_map(it, 22, mt, nt, mpx);
          gemm_wide16<EPI_GU>(p, l, (const bf16_t*)(p.ws + OFF_HM), 1024, (const bf16_t*)(p.ws + OFF_WGU), 1024,
                              mt * 128, nt * 256, smem);
        }
      } else {
        const int mpx = l == 3 ? 16 : 18;
        for (int it = bid; it < 8 * mpx * 8; it += nb) {
          int mt, nt;
          tile_map(it, 8, mt, nt, mpx);
          gemm_tile<EPI_RES>(p, l, (const bf16_t*)(p.ws + OFF_P), FFN, (const bf16_t*)(p.ws + OFF_WDN), FFN,
                             mt * 128, nt * 128, 5, smem);
        }
      }
    }
#ifdef PROBE_S
    {
      const bool hit = (PROBE_S == 9) ? (ph == 0) : (ph != 0 && ph != N_PHASES - 1 && ((ph - 1) % 9) == PROBE_S);
      if (hit && !again) {
        again = true;
        if (p.use_cg) grid.sync(); else xcd_barrier(xb);
        --ph;
        continue;
      }
      again = false;
    }
#endif
    if (ph + 1 < p.ph_hi) {
      if (p.use_cg) grid.sync();
      else xcd_barrier(xb);
    }
  }
}

extern "C" void kernel_launch(void* const* d_in, const int* in_sizes, int n_in, void* d_out, int out_size, void* d_ws,
                              size_t ws_size, hipStream_t stream) {
  static int grid_blocks = 0;
  if (!grid_blocks) {
    int dev = 0, cus = 0, per_cu = 0;
    hipGetDevice(&dev);
    hipDeviceGetAttribute(&cus, hipDeviceAttributeMultiprocessorCount, dev);
    hipOccupancyMaxActiveBlocksPerMultiprocessor(&per_cu, mega, 256, 0);
    if (per_cu < 1) per_cu = 1;
    if (per_cu > 2) per_cu = 2;
    grid_blocks = cus * per_cu;
  }
  Params p{};
  const float** pp = (const float**)&p;
  for (int i = 0; i < 23; ++i) pp[i] = (const float*)d_in[i];
  p.out = (float*)d_out;
  p.ws = (char*)d_ws;
  p.ph_lo = 0;
  p.ph_hi = N_PHASES;
  p.use_cg = 0;
  p.pad0 = 0;
  hipMemsetAsync((char*)d_ws + OFF_BAR, 0, XCD_BAR_WORDS * sizeof(unsigned), stream);
  void* args[] = {&p};
  hipError_t e = hipLaunchCooperativeKernel((void*)mega, dim3(grid_blocks), dim3(256), args, 0, stream);
  if (e != hipSuccess) {
    fprintf(stderr, "cooperative launch failed: %s (grid %d)\n", hipGetErrorString(e), grid_blocks);
    (void)hipGetLastError();
    for (int ph = 0; ph < N_PHASES; ++ph) {
      p.ph_lo = ph;
      p.ph_hi = ph + 1;
      hipLaunchKernelGGL(mega, dim3(grid_blocks), dim3(256), 0, stream, p);
    }
  }
}
```

```cpp
#include <hip/hip_runtime.h>
#include <hip/hip_bf16.h>
#include <hip/hip_cooperative_groups.h>
#include <cstdio>
namespace cg = cooperative_groups;

#define DEVI __device__ __forceinline__
typedef unsigned short bf16_t;
typedef short bf16x8 __attribute__((ext_vector_type(8)));
typedef float f32x16 __attribute__((ext_vector_type(16)));

constexpr int M_LAT = 16384, M_CTX = 2048, M_ALL = 18432;
constexpr int DM = 1024, INW = 3248, INWP = 3328, FFN = 2816;
constexpr int C_MQ = 0, C_MKV = 256, C_MPE = 384, C_NQ = 416, C_NK = 672, C_NV = 928, C_DN = 1184;
constexpr int C_DZ = C_DN + 1536, C_DA = C_DN + 2048;

constexpr size_t OFF_WIN = 0;
constexpr size_t OFF_WOUT = OFF_WIN + (size_t)INWP * 1024 * 2;
constexpr size_t OFF_WGU = OFF_WOUT + (size_t)1024 * 1024 * 2;
constexpr size_t OFF_WDN = OFF_WGU + (size_t)2 * FFN * 1024 * 2;
constexpr size_t OFF_WQUP = OFF_WDN + (size_t)1024 * FFN * 2;
constexpr size_t OFF_WKVUP = OFF_WQUP + (size_t)384 * 256 * 2;
constexpr size_t OFF_MOD = OFF_WKVUP + (size_t)512 * 128 * 2;
constexpr size_t OFF_ROPE = OFF_MOD + (size_t)4 * 9 * 6144 * 4;
constexpr size_t OFF_X = OFF_ROPE + (size_t)2048 * 16 * 2 * 4;
constexpr size_t OFF_HM = OFF_X + (size_t)M_ALL * 1024 * 4;
constexpr size_t OFF_P = OFF_HM + (size_t)M_ALL * 1024 * 2;
constexpr size_t OFF_QH = OFF_P + (size_t)M_ALL * INWP * 2;
constexpr size_t OFF_KH = OFF_QH + (size_t)M_ALL * 384 * 2;
constexpr size_t OFF_VH = OFF_KH + (size_t)M_ALL * 384 * 2;
constexpr size_t OFF_DNQKV = OFF_VH + (size_t)M_ALL * 256 * 2;
constexpr size_t OFF_OB = OFF_DNQKV + (size_t)M_ALL * 1536 * 2;
constexpr size_t OFF_AB = OFF_OB + (size_t)M_ALL * 512 * 2;
constexpr size_t OFF_GC = OFF_AB + (size_t)M_ALL * 16 * 4;
constexpr size_t OFF_BETA = OFF_GC + (size_t)M_ALL * 8 * 4;
constexpr size_t OFF_NVT = OFF_BETA + (size_t)M_ALL * 8 * 4;
constexpr size_t WS_TOTAL = OFF_NVT + (size_t)M_ALL * 256 * 2;
constexpr int SMEM_BYTES = 74240;
constexpr size_t OFF_BAR = (WS_TOTAL + 255) & ~(size_t)255;

struct Params {
  const float *x, *c, *ctx, *c_ctx, *w_ada, *b_ada, *g_mix, *w_in, *g_q, *g_kv, *w_qup, *w_kvup, *rel_bias,
      *conv_w, *a_log, *dt_bias, *g_out, *w_out, *g_ffn, *w_gate, *w_up, *w_down, *g_final;
  float* out;
  char* ws;
  int ph_lo, ph_hi;
  int use_cg, pad0;
};

DEVI bf16_t f2bf(float f) {
  __bf16 r = (__bf16)f;
  return __builtin_bit_cast(unsigned short, r);
}
DEVI int otid() {
  int t = threadIdx.x;
  asm volatile("" : "+v"(t));
  return t;
}
DEVI float bf2f(bf16_t h) { return __uint_as_float(((unsigned)h) << 16); }
DEVI float bflo(unsigned u) { return __uint_as_float(u << 16); }
DEVI float bfhi(unsigned u) { return __uint_as_float(u & 0xffff0000u); }
typedef __bf16 bf16v2_t __attribute__((ext_vector_type(2)));
typedef float f32v2_t __attribute__((ext_vector_type(2)));
DEVI unsigned pack2(float a, float b) {
  f32v2_t v = {a, b};
  bf16v2_t r = __builtin_convertvector(v, bf16v2_t);
  return __builtin_bit_cast(unsigned, r);
}
DEVI float silu_f(float x) { return x / (1.f + __expf(-x)); }
DEVI float wave_sum(float v) {
#pragma unroll
  for (int o = 32; o >= 1; o >>= 1) v += __shfl_xor(v, o);
  return v;
}

#define XB_TMO 128
#define XB_XCNT(j) (256 + 64 * (j))
#define XB_XSUB(j) (1280 + 64 * (j))
#define XB_XGEN(j) (2304 + 64 * (j))
#define XB_TOP 3328
#define XB_TOPGEN 3392
#define XCD_BAR_WORDS 3456
#define XB_SPIN_CAP (1u << 22)
#define LAS __attribute__((address_space(3)))
DEVI unsigned xb_ld(unsigned* p) { return __hip_atomic_load(p, __ATOMIC_RELAXED, __HIP_MEMORY_SCOPE_AGENT); }
DEVI unsigned xb_add(unsigned* p, unsigned v) { return __hip_atomic_fetch_add(p, v, __ATOMIC_RELAXED, __HIP_MEMORY_SCOPE_AGENT); }
DEVI unsigned xb_xcc_id() { return (unsigned)__builtin_amdgcn_s_getreg((3 << 11) | 20) & 0xFu; }
#define XB_SPIN(cond, bar)                                                     \
  do {                                                                         \
    unsigned _sp = 0;                                                          \
    while (cond) {                                                             \
      __builtin_amdgcn_s_sleep(6);                                             \
      if ((++_sp & 255u) == 0u) {                                              \
        if (xb_ld(&(bar)[XB_TMO])) break;                                      \
        if (_sp > XB_SPIN_CAP) { atomicAdd(&(bar)[XB_TMO], 1u); break; }       \
      }                                                                        \
    }                                                                          \
  } while (0)
struct XcdBarrier {
  unsigned* bar;
  unsigned x;
  volatile LAS unsigned* st;
};
DEVI XcdBarrier xcd_barrier_post(unsigned* bar, volatile LAS unsigned* st) {
  XcdBarrier b;
  b.bar = bar;
  b.x = xb_xcc_id();
  b.st = st;
  if (threadIdx.x == 0) (void)xb_add(&bar[XB_XCNT(b.x)], 1u);
  return b;
}
DEVI void xcd_barrier_complete(unsigned* bar, unsigned x, unsigned& nloc, unsigned& nx) {
  const unsigned G = gridDim.x * gridDim.y * gridDim.z;
  unsigned sum, cnt, mine, sp = 0u;
  for (;;) {
    sum = 0u; cnt = 0u; mine = 0u;
#pragma unroll
    for (unsigned j = 0; j < 16; ++j) {
      const unsigned c = xb_ld(&bar[XB_XCNT(j)]);
      sum += c;
      cnt += (c > 0u) ? 1u : 0u;
      mine = (j == x) ? c : mine;
    }
    if (sum == G) break;
    __builtin_amdgcn_s_sleep(1);
    if ((++sp & 255u) == 0u) {
      if (xb_ld(&bar[XB_TMO])) break;
      if (sp > XB_SPIN_CAP) { atomicAdd(&bar[XB_TMO], 1u); break; }
    }
  }
  nloc = mine > 0u ? mine : 1u;
  nx = cnt > 0u ? cnt : 1u;
}
DEVI void xcd_barrier(const XcdBarrier& b) {
  asm volatile("s_waitcnt vmcnt(0)" ::: "memory");
  __syncthreads();
  if (threadIdx.x == 0) {
    unsigned* bar = b.bar;
    __builtin_amdgcn_s_waitcnt(0);
    unsigned nloc = b.st[0], nx = b.st[1];
    if (nloc == 0u) {
      xcd_barrier_complete(bar, b.x, nloc, nx);
      b.st[0] = nloc;
      b.st[1] = nx;
    }
    const unsigned old = xb_add(&bar[XB_XSUB(b.x)], 1u);
    const unsigned gen = old / nloc;
    if (old + 1u == (gen + 1u) * nloc) {
      __builtin_amdgcn_fence(__ATOMIC_RELEASE, "agent");
      asm volatile("s_waitcnt vmcnt(0)" ::: "memory");
      const unsigned og = xb_add(&bar[XB_TOP], 1u);
      const unsigned tg = og / nx;
      if (og + 1u == (tg + 1u) * nx) xb_add(&bar[XB_TOPGEN], 1u);
      else XB_SPIN(xb_ld(&bar[XB_TOPGEN]) == tg, bar);
      __builtin_amdgcn_fence(__ATOMIC_ACQUIRE, "agent");
      xb_add(&bar[XB_XGEN(b.x)], 1u);
      asm volatile("s_waitcnt vmcnt(0)" ::: "memory");
    } else {
      XB_SPIN(xb_ld(&bar[XB_XGEN(b.x)]) == gen, bar);
      __builtin_amdgcn_fence(__ATOMIC_ACQUIRE, "agent");
      asm volatile("s_waitcnt vmcnt(0)" ::: "memory");
    }
  }
  __syncthreads();
}

constexpr int N_CONV_EARLY = 16 * 52 + 24 + 16;
__device__ void conv_item_early(const Params& p, int l, int it, float* tl);

__device__ void phase0(const Params& p, char* smem) {
  const int tid = otid(), nb = gridDim.x, bid = blockIdx.x;
  {
    float* rc = (float*)(p.ws + OFF_ROPE);
    float* rs = rc + 2048 * 16;
    for (int i = bid * 256 + tid; i < 2048 * 16; i += nb * 256) {
      int t = i >> 4, a = (i >> 3) & 1, j = i & 7;
      float pos = a ? (float)(t & 63) : (float)(t >> 6);
      float inv = __builtin_amdgcn_exp2f(-(float)j * (13.287712379549449f / 8.f));
      float ang = pos * inv;
      rc[i] = cosf(ang);
      rs[i] = sinf(ang);
    }
  }
  for (int it = bid; it < N_CONV_EARLY; it += nb) conv_item_early(p, 0, it, (float*)smem);
  __syncthreads();
  float* sc = (float*)smem;
  float* red = sc + 1024 * 12;
  float* MOD = (float*)(p.ws + OFF_MOD);
  bool loaded = false;
  for (int it = bid; it < 4 * 96; it += nb) {
    if (!loaded) {
      for (int i = tid; i < 9 * 1024; i += 256) {
        float v = i < 8192 ? p.c[i] : p.c_ctx[i - 8192];
        sc[(i & 1023) * 12 + (i >> 10)] = silu_f(v);
      }
      __syncthreads();
      loaded = true;
    }
    const int l = it / 96, n0 = (it % 96) * 64;
    const int cc = tid & 63, kg = tid >> 6;
    const float* w = p.w_ada + (size_t)l * 1024 * 6144 + n0 + cc;
    float acc[9];
#pragma unroll
    for (int b = 0; b < 9; ++b) acc[b] = 0.f;
    for (int k0 = kg * 256; k0 < kg * 256 + 256; k0 += 32) {
      float wvv[32];
#pragma unroll
      for (int j = 0; j < 32; ++j) wvv[j] = w[(size_t)(k0 + j) * 6144];
#pragma unroll
      for (int j = 0; j < 32; ++j) {
      const int k = k0 + j;
      const float wv = wvv[j];
      const float4 s0 = *(const float4*)(sc + k * 12);
      const float4 s1 = *(const float4*)(sc + k * 12 + 4);
      const float s2 = sc[k * 12 + 8];
      acc[0] += s0.x * wv; acc[1] += s0.y * wv; acc[2] += s0.z * wv; acc[3] += s0.w * wv;
      acc[4] += s1.x * wv; acc[5] += s1.y * wv; acc[6] += s1.z * wv; acc[7] += s1.w * wv;
      acc[8] += s2 * wv;
      }
    }
#pragma unroll
    for (int b = 0; b < 9; ++b) red[(kg * 9 + b) * 64 + cc] = acc[b];
    __syncthreads();
    for (int i = tid; i < 9 * 64; i += 256) {
      int b = i >> 6, c2 = i & 63;
      float s = red[(0 * 9 + b) * 64 + c2] + red[(1 * 9 + b) * 64 + c2] + red[(2 * 9 + b) * 64 + c2] +
                red[(3 * 9 + b) * 64 + c2];
      MOD[(size_t)(l * 9 + b) * 6144 + n0 + c2] = s + p.b_ada[l * 6144 + n0 + c2];
    }
    __syncthreads();
  }
}

__device__ void convT_tile(const float* __restrict__ src, int K, int N, bf16_t* __restrict__ dst, int mode,
                           const float* __restrict__ gs, int kt, int nt, float* tl) {
  const int tid = otid();
  const int k0 = kt * 64, n0 = nt * 64;
  __syncthreads();
#pragma unroll 4
  for (int i = 0; i < 16; ++i) {
    int kk = i * 4 + (tid >> 6), nn = tid & 63;
    float v = 0.f;
    if (n0 + nn < N) v = src[(size_t)(k0 + kk) * N + n0 + nn];
    if (gs) v *= gs[k0 + kk];
    tl[kk * 65 + nn] = v;
  }
  __syncthreads();
#pragma unroll 2
  for (int i = 0; i < 8; ++i) {
    int nn = i * 8 + (tid >> 5), kk = (tid & 31) * 2;
    unsigned pk = pack2(tl[kk * 65 + nn], tl[(kk + 1) * 65 + nn]);
    int n = n0 + nn;
    int drow = mode == 0 ? n : ((n >> 5) * 64 + (n & 31) + (mode == 2 ? 32 : 0));
    *(unsigned*)(dst + (size_t)drow * K + k0 + kk) = pk;
  }
}

__device__ void norm_rows(const Params& p, bool from_input, bf16_t* __restrict__ H, const float* __restrict__ g,
                          const float* __restrict__ modl, int shift_i, int scale_i, int item) {
  const int w = otid() >> 6, lane = otid() & 63;
  const int row = item * 4 + w;
  const float* xsrc = from_input ? (row < M_LAT ? p.x + (size_t)row * 1024 : p.ctx + (size_t)(row - M_LAT) * 1024)
                                 : (const float*)(p.ws + OFF_X) + (size_t)row * 1024;
  const float4* xr = (const float4*)xsrc;
  float4 v[4];
  float ss = 0.f;
#pragma unroll
  for (int i = 0; i < 4; ++i) {
    v[i] = xr[lane + 64 * i];
    ss += v[i].x * v[i].x + v[i].y * v[i].y + v[i].z * v[i].z + v[i].w * v[i].w;
  }
  ss = wave_sum(ss);
  const float r = rsqrtf(ss * (1.f / 1024.f) + 1e-6f);
  const int b = row < M_LAT ? (row >> 11) : 8;
  const float4* sh = (const float4*)(modl + b * 6144 + shift_i * 1024);
  const float4* sl = (const float4*)(modl + b * 6144 + scale_i * 1024);
  const float4* g4 = (const float4*)g;
#pragma unroll
  for (int i = 0; i < 4; ++i) {
    int c4 = lane + 64 * i;
    float4 gg = g4[c4], s4 = sh[c4], l4 = sl[c4];
    float y0 = v[i].x * r * gg.x * (1.f + l4.x) + s4.x;
    float y1 = v[i].y * r * gg.y * (1.f + l4.y) + s4.y;
    float y2 = v[i].z * r * gg.z * (1.f + l4.z) + s4.z;
    float y3 = v[i].w * r * gg.w * (1.f + l4.w) + s4.w;
    uint2 pk;
    pk.x = pack2(y0, y1);
    pk.y = pack2(y2, y3);
    *(uint2*)(H + (size_t)row * 1024 + c4 * 4) = pk;
  }
}

__device__ void conv_item_late(const Params& p, int l, int i, float* tl) {
  bf16_t* Wout = (bf16_t*)(p.ws + OFF_WOUT);
  bf16_t* Wgu = (bf16_t*)(p.ws + OFF_WGU);
  bf16_t* Wdn = (bf16_t*)(p.ws + OFF_WDN);
  const float* src;
  bf16_t* dst;
  int K, N, mode = 0, ntn;
  if (i < 256) {
    src = p.w_out + (size_t)l * 1024 * 1024; K = 1024; N = 1024; dst = Wout; ntn = 16;
  } else if (i < 960) {
    i -= 256; src = p.w_gate + (size_t)l * 1024 * FFN; K = 1024; N = FFN; dst = Wgu; ntn = 44; mode = 1;
  } else if (i < 1664) {
    i -= 960; src = p.w_up + (size_t)l * 1024 * FFN; K = 1024; N = FFN; dst = Wgu; ntn = 44; mode = 2;
  } else {
    i -= 1664; src = p.w_down + (size_t)l * FFN * 1024; K = FFN; N = 1024; dst = Wdn; ntn = 16;
  }
  convT_tile(src, K, N, dst, mode, nullptr, i / ntn, i % ntn, tl);
}
constexpr int N_CONV_LATE = 256 + 3 * 704;
__device__ void conv_item_early(const Params& p, int l, int it, float* tl) {
  const float* src;
  const float* gs = nullptr;
  bf16_t* dst;
  int K, N, ntn, i;
  if (it < 832) {
    i = it; src = p.w_in + (size_t)l * 1024 * INW; K = 1024; N = INW; dst = (bf16_t*)(p.ws + OFF_WIN); ntn = 52;
  } else if (it < 856) {
    i = it - 832; src = p.w_qup + (size_t)l * 256 * 384; K = 256; N = 384; dst = (bf16_t*)(p.ws + OFF_WQUP); ntn = 6;
    gs = p.g_q + l * 256;
  } else {
    i = it - 856; src = p.w_kvup + (size_t)l * 128 * 512; K = 128; N = 512; dst = (bf16_t*)(p.ws + OFF_WKVUP); ntn = 8;
    gs = p.g_kv + l * 128;
  }
  convT_tile(src, K, N, dst, 0, gs, i / ntn, i % ntn, tl);
}

__device__ void phaseA(const Params& p, int l, char* smem) {
  const int nb = gridDim.x, bid = blockIdx.x;
  for (int it = bid; it < M_ALL / 4; it += nb)
    norm_rows(p, l == 0, (bf16_t*)(p.ws + OFF_HM), p.g_mix + l * 1024,
              (const float*)(p.ws + OFF_MOD) + (size_t)l * 9 * 6144, 0, 1, it);
}

DEVI void tile_map(int it, int NT, int& mt, int& nt, int MPX = 18) {
  const int xcd = it & 7, idx = it >> 3;
  const int per_group = 8 * NT;
  const int g = idx / per_group, r = idx - g * per_group;
  const int gs = min(8, MPX - 8 * g);
  mt = xcd * MPX + g * 8 + r % gs;
  nt = r / gs;
}

enum { EPI_P = 0, EPI_QUP = 1, EPI_KVUP = 2, EPI_RES = 3, EPI_GU = 4 };

template <int EPI>
__device__ void gemm_tile(const Params& p, int l, const bf16_t* __restrict__ A, int lda,
                          const bf16_t* __restrict__ BT, int K, int m0, int n0, int gate_i, char* smem) {
  constexpr int STAGE = 2 * 128 * 72;
  bf16_t* sbase = (bf16_t*)smem;
  float* rsv = (float*)(smem + 2 * STAGE * 2);
  const int tid = otid(), lane = tid & 63, w = tid >> 6, wm = w >> 1, wn = w & 1;
  const int lr = tid >> 3, lc = (tid & 7) * 8;
  __syncthreads();
  if (EPI == EPI_QUP || EPI == EPI_KVUP) {
    const int row = tid >> 1, hf = tid & 1;
    const int n8 = K / 16;
    const uint4* ap = (const uint4*)(A + (size_t)(m0 + row) * lda + hf * (K / 2));
    float ss = 0.f;
    for (int i = 0; i < n8; ++i) {
      uint4 u = ap[i];
      float a0 = bflo(u.x), a1 = bfhi(u.x), a2 = bflo(u.y), a3 = bfhi(u.y), a4 = bflo(u.z), a5 = bfhi(u.z),
            a6 = bflo(u.w), a7 = bfhi(u.w);
      ss += a0 * a0 + a1 * a1 + a2 * a2 + a3 * a3 + a4 * a4 + a5 * a5 + a6 * a6 + a7 * a7;
    }
    ss += __shfl_xor(ss, 1);
    if (hf == 0) rsv[row] = rsqrtf(ss / (float)K + 1e-6f);
  }
  const bf16_t* Ap = A + (size_t)(m0 + lr) * lda + lc;
  const bf16_t* Bp = BT + (size_t)(n0 + lr) * K + lc;
  uint4 ra0, ra1, ra2, ra3, rb0, rb1, rb2, rb3;
#define G_LOAD()                                  \
  ra0 = *(const uint4*)(Ap);                      \
  ra1 = *(const uint4*)(Ap + (size_t)32 * lda);   \
  ra2 = *(const uint4*)(Ap + (size_t)64 * lda);   \
  ra3 = *(const uint4*)(Ap + (size_t)96 * lda);   \
  rb0 = *(const uint4*)(Bp);                      \
  rb1 = *(const uint4*)(Bp + (size_t)32 * K);     \
  rb2 = *(const uint4*)(Bp + (size_t)64 * K);     \
  rb3 = *(const uint4*)(Bp + (size_t)96 * K);
#define S_WRITE(ST)                                                   \
  {                                                                   \
    bf16_t* wa = sbase + (ST) * STAGE + lr * 72 + lc;                 \
    bf16_t* wb = wa + 128 * 72;                                       \
    *(uint4*)(wa) = ra0;                                              \
    *(uint4*)(wa + 32 * 72) = ra1;                                    \
    *(uint4*)(wa + 64 * 72) = ra2;                                    \
    *(uint4*)(wa + 96 * 72) = ra3;                                    \
    *(uint4*)(wb) = rb0;                                              \
    *(uint4*)(wb + 32 * 72) = rb1;                                    \
    *(uint4*)(wb + 64 * 72) = rb2;                                    \
    *(uint4*)(wb + 96 * 72) = rb3;                                    \
  }
  const int nk = K / 64;
  G_LOAD()
  S_WRITE(0)
  if (nk > 1) {
    Ap += 64;
    Bp += 64;
    G_LOAD()
  }
  f32x16 acc[2][2];
#pragma unroll
  for (int i = 0; i < 2; ++i)
#pragma unroll
    for (int j = 0; j < 2; ++j)
#pragma unroll
      for (int r = 0; r < 16; ++r) acc[i][j][r] = 0.f;
  __syncthreads();
  const int foff = (lane & 31) * 72 + (lane >> 5) * 8;
  const bf16_t* fa_base = sbase + wm * 64 * 72 + foff;
  const bf16_t* fb_base = sbase + 128 * 72 + wn * 64 * 72 + foff;
  bf16x8 xa0, xa1, xb0, xb1, ya0, ya1, yb0, yb1;
#define FLOAD(X, ST, KS)                                                   \
  {                                                                        \
    const bf16_t* pa_ = fa_base + (ST) * STAGE + (KS) * 16;                \
    const bf16_t* pb_ = fb_base + (ST) * STAGE + (KS) * 16;                \
    X##a0 = *(const bf16x8*)(pa_);                                         \
    X##a1 = *(const bf16x8*)(pa_ + 32 * 72);                               \
    X##b0 = *(const bf16x8*)(pb_);                                         \
    X##b1 = *(const bf16x8*)(pb_ + 32 * 72);                               \
  }
#define MM4(X)                                                                            \
  acc[0][0] = __builtin_amdgcn_mfma_f32_32x32x16_bf16(X##a0, X##b0, acc[0][0], 0, 0, 0);  \
  acc[0][1] = __builtin_amdgcn_mfma_f32_32x32x16_bf16(X##a0, X##b1, acc[0][1], 0, 0, 0);  \
  acc[1][0] = __builtin_amdgcn_mfma_f32_32x32x16_bf16(X##a1, X##b0, acc[1][0], 0, 0, 0);  \
  acc[1][1] = __builtin_amdgcn_mfma_f32_32x32x16_bf16(X##a1, X##b1, acc[1][1], 0, 0, 0);
  FLOAD(x, 0, 0)
  for (int kt = 0; kt < nk; ++kt) {
    const int cur = kt & 1;
    FLOAD(y, cur, 1)
    __builtin_amdgcn_sched_barrier(0);
    MM4(x)
    __builtin_amdgcn_sched_barrier(0);
    FLOAD(x, cur, 2)
    __builtin_amdgcn_sched_barrier(0);
    MM4(y)
    __builtin_amdgcn_sched_barrier(0);
    FLOAD(y, cur, 3)
    __builtin_amdgcn_sched_barrier(0);
    MM4(x)
    __builtin_amdgcn_sched_barrier(0);
    if (kt + 1 < nk) {
      S_WRITE(cur ^ 1)
      if (kt + 2 < nk) {
        Ap += 64;
        Bp += 64;
        G_LOAD()
      }
    }
    __syncthreads();
    if (kt + 1 < nk) FLOAD(x, cur ^ 1, 0)
    __builtin_amdgcn_sched_barrier(0);
    MM4(y)
    __builtin_amdgcn_sched_barrier(0);
  }
  __syncthreads();
#undef FLOAD
#undef MM4
#undef G_LOAD
#undef S_WRITE
  const int ci = lane & 31;
  const int rbase = m0 + wm * 64 + 4 * (lane >> 5);
  const int cbase = n0 + wn * 64;
  if (EPI == EPI_P) {
    bf16_t* P = (bf16_t*)(p.ws + OFF_P);
    float* AB = (float*)(p.ws + OFF_AB);
    bf16_t* sO = (bf16_t*)smem;
#pragma unroll
    for (int mt = 0; mt < 2; ++mt)
#pragma unroll
      for (int nt = 0; nt < 2; ++nt)
#pragma unroll
        for (int r = 0; r < 16; ++r) {
          const int rl = wm * 64 + 4 * (lane >> 5) + mt * 32 + (r & 3) + 8 * (r >> 2);
          const int cl = wn * 64 + nt * 32 + ci;
          const float v = acc[mt][nt][r];
          sO[rl * 136 + cl] = f2bf(v);
          const int col = n0 + cl;
          if (col >= C_DA && col < C_DA + 16) AB[(size_t)(m0 + rl) * 16 + col - C_DA] = v;
        }
    __syncthreads();
#pragma unroll
    for (int e = 0; e < 8; ++e) {
      const int c = tid + 256 * e, rl = c >> 4, ch = c & 15;
      *(uint4*)(P + (size_t)(m0 + rl) * INWP + n0 + ch * 8) = *(const uint4*)(sO + rl * 136 + ch * 8);
    }
    bf16_t* NVT = (bf16_t*)(p.ws + OFF_NVT);
#pragma unroll
    for (int mt = 0; mt < 2; ++mt)
#pragma unroll
      for (int nt = 0; nt < 2; ++nt) {
        const int base = cbase + nt * 32;
        if (base >= C_NV && base < C_NV + 256) {
          const int hv = (base - C_NV) >> 6, dv = ((base - C_NV) & 63) + ci;
#pragma unroll
          for (int g = 0; g < 4; ++g) {
            const int row0 = rbase + mt * 32 + 8 * g;
            int bb, key0;
            if (row0 < M_LAT) { bb = row0 >> 11; key0 = 256 + (row0 & 2047); }
            else { bb = (row0 - M_LAT) >> 8; key0 = (row0 - M_LAT) & 255; }
            uint2 u;
            u.x = pack2(acc[mt][nt][4 * g + 0], acc[mt][nt][4 * g + 1]);
            u.y = pack2(acc[mt][nt][4 * g + 2], acc[mt][nt][4 * g + 3]);
            *(uint2*)(NVT + ((size_t)(bb * 4 + hv) * 64 + dv) * 2304 + key0) = u;
          }
        }
      }
  } else if (EPI == EPI_QUP) {
    bf16_t* QH = (bf16_t*)(p.ws + OFF_QH);
    const float* rc = (const float*)(p.ws + OFF_ROPE);
    const float* rsn = rc + 2048 * 16;
#pragma unroll
    for (int mt = 0; mt < 2; ++mt)
#pragma unroll
      for (int nt = 0; nt < 2; ++nt) {
        const int base = cbase + nt * 32;
        const bool rope = ((base % 96) == 64) && (m0 < M_LAT);
#pragma unroll
        for (int r = 0; r < 16; ++r) {
          int row = rbase + mt * 32 + (r & 3) + 8 * (r >> 2);
          float v = acc[mt][nt][r] * rsv[row - m0];
          float o = __shfl_xor(v, 8);
          if (rope) {
            int t = row & 2047;
            int a = ci >> 4, hf = (ci >> 3) & 1, j = ci & 7;
            float c = rc[t * 16 + a * 8 + j], s = rsn[t * 16 + a * 8 + j];
            v = hf ? (o * s + v * c) : (v * c - o * s);
          }
          QH[(size_t)row * 384 + base + ci] = f2bf(v);
        }
      }
  } else if (EPI == EPI_KVUP) {
    bf16_t* KA = (bf16_t*)(p.ws + OFF_KH);
    bf16_t* VT = (bf16_t*)(p.ws + OFF_VH);
#pragma unroll
    for (int mt = 0; mt < 2; ++mt)
#pragma unroll
      for (int nt = 0; nt < 2; ++nt) {
        const int base = cbase + nt * 32;
        const int h = base >> 7, cc = (base & 127) + ci;
#pragma unroll
        for (int g = 0; g < 4; ++g) {
          const int row0 = rbase + mt * 32 + 8 * g;
          int bb, key0;
          if (row0 < M_LAT) { bb = row0 >> 11; key0 = 256 + (row0 & 2047); }
          else { bb = (row0 - M_LAT) >> 8; key0 = (row0 - M_LAT) & 255; }
          float v0 = acc[mt][nt][4 * g + 0] * rsv[row0 - m0 + 0];
          float v1 = acc[mt][nt][4 * g + 1] * rsv[row0 - m0 + 1];
          float v2 = acc[mt][nt][4 * g + 2] * rsv[row0 - m0 + 2];
          float v3 = acc[mt][nt][4 * g + 3] * rsv[row0 - m0 + 3];
          if (cc < 64) {
            bf16_t* kp = KA + ((size_t)(bb * 4 + h) * 2304 + key0) * 96 + cc;
            kp[0] = f2bf(v0); kp[96] = f2bf(v1); kp[192] = f2bf(v2); kp[288] = f2bf(v3);
          } else {
            uint2 u;
            u.x = pack2(v0, v1);
            u.y = pack2(v2, v3);
            *(uint2*)(VT + ((size_t)(bb * 4 + h) * 64 + (cc - 64)) * 2304 + key0) = u;
          }
        }
      }
  } else if (EPI == EPI_RES) {
    float* X = (float*)(p.ws + OFF_X);
    const float* Xsrc = (l == 0 && gate_i == 2) ? (m0 < M_LAT ? p.x : p.ctx - (size_t)M_LAT * 1024) : X;
    const float* modl = (const float*)(p.ws + OFF_MOD) + (size_t)l * 9 * 6144 + gate_i * 1024;
#pragma unroll
    for (int mt = 0; mt < 2; ++mt)
#pragma unroll
      for (int nt = 0; nt < 2; ++nt)
#pragma unroll
        for (int r = 0; r < 16; ++r) {
          int row = rbase + mt * 32 + (r & 3) + 8 * (r >> 2);
          int col = cbase + nt * 32 + ci;
          int b = row < M_LAT ? (row >> 11) : 8;
          float g = modl[b * 6144 + col];
          size_t idx = (size_t)row * 1024 + col;
          X[idx] = Xsrc[idx] + g * acc[mt][nt][r];
        }
  } else if (EPI == EPI_GU) {
    bf16_t* ACT = (bf16_t*)(p.ws + OFF_P);
    bf16_t* sO = (bf16_t*)smem;
#pragma unroll
    for (int mt = 0; mt < 2; ++mt)
#pragma unroll
      for (int r = 0; r < 16; ++r) {
        const int rl = wm * 64 + 4 * (lane >> 5) + mt * 32 + (r & 3) + 8 * (r >> 2);
        float gt = acc[mt][0][r], up = acc[mt][1][r];
        float a = silu_f(gt) * up;
        sO[rl * 72 + wn * 32 + ci] = f2bf(a);
      }
    __syncthreads();
#pragma unroll
    for (int e = 0; e < 4; ++e) {
      const int c = tid + 256 * e, rl = c >> 3, ch = c & 7;
      *(uint4*)(ACT + (size_t)(m0 + rl) * FFN + (n0 >> 1) + ch * 8) = *(const uint4*)(sO + rl * 72 + ch * 8);
    }
  }
}

template <int EPI>
__device__ void gemm_wide(const Params& p, int l, const bf16_t* __restrict__ A, int lda,
                          const bf16_t* __restrict__ BT, int K, int m0, int n0, int gate_i, char* smem) {
  bf16_t* sA = (bf16_t*)smem;
  bf16_t* sB = sA + 128 * 72;
  const int tid = otid(), lane = tid & 63, w = tid >> 6, wm = w >> 1, wn = w & 1;
  const int lr = tid >> 3, lc = (tid & 7) * 8;
  const bf16_t* Ap = A + (size_t)(m0 + lr) * lda + lc;
  const bf16_t* Bp = BT + (size_t)(n0 + lr) * K + lc;
  uint4 ra0, ra1, ra2, ra3, rb0, rb1, rb2, rb3, rb4, rb5, rb6, rb7;
#define LOAD_AB()                                   \
  ra0 = *(const uint4*)(Ap);                        \
  ra1 = *(const uint4*)(Ap + (size_t)32 * lda);     \
  ra2 = *(const uint4*)(Ap + (size_t)64 * lda);     \
  ra3 = *(const uint4*)(Ap + (size_t)96 * lda);     \
  rb0 = *(const uint4*)(Bp);                        \
  rb1 = *(const uint4*)(Bp + (size_t)32 * K);       \
  rb2 = *(const uint4*)(Bp + (size_t)64 * K);       \
  rb3 = *(const uint4*)(Bp + (size_t)96 * K);       \
  rb4 = *(const uint4*)(Bp + (size_t)128 * K);      \
  rb5 = *(const uint4*)(Bp + (size_t)160 * K);      \
  rb6 = *(const uint4*)(Bp + (size_t)192 * K);      \
  rb7 = *(const uint4*)(Bp + (size_t)224 * K);
  __syncthreads();
  LOAD_AB()
  f32x16 acc[2][4];
#pragma unroll
  for (int i = 0; i < 2; ++i)
#pragma unroll
    for (int j = 0; j < 4; ++j)
#pragma unroll
      for (int r = 0; r < 16; ++r) acc[i][j][r] = 0.f;
  const int nk = K / 64;
  const bf16_t* pa = sA + (wm * 64 + (lane & 31)) * 72 + (lane >> 5) * 8;
  const bf16_t* pb = sB + (wn * 128 + (lane & 31)) * 72 + (lane >> 5) * 8;
#define MM8(A0, A1, B0, B1, B2, B3)                                                   \
  acc[0][0] = __builtin_amdgcn_mfma_f32_32x32x16_bf16(A0, B0, acc[0][0], 0, 0, 0);    \
  acc[1][0] = __builtin_amdgcn_mfma_f32_32x32x16_bf16(A1, B0, acc[1][0], 0, 0, 0);    \
  acc[0][1] = __builtin_amdgcn_mfma_f32_32x32x16_bf16(A0, B1, acc[0][1], 0, 0, 0);    \
  acc[1][1] = __builtin_amdgcn_mfma_f32_32x32x16_bf16(A1, B1, acc[1][1], 0, 0, 0);    \
  acc[0][2] = __builtin_amdgcn_mfma_f32_32x32x16_bf16(A0, B2, acc[0][2], 0, 0, 0);    \
  acc[1][2] = __builtin_amdgcn_mfma_f32_32x32x16_bf16(A1, B2, acc[1][2], 0, 0, 0);    \
  acc[0][3] = __builtin_amdgcn_mfma_f32_32x32x16_bf16(A0, B3, acc[0][3], 0, 0, 0);    \
  acc[1][3] = __builtin_amdgcn_mfma_f32_32x32x16_bf16(A1, B3, acc[1][3], 0, 0, 0);
#define HALF_STEP(KO)                                                                                   \
  {                                                                                                     \
    bf16x8 fa00 = *(const bf16x8*)(pa + (KO)), fa01 = *(const bf16x8*)(pa + 32 * 72 + (KO));            \
    bf16x8 fb00 = *(const bf16x8*)(pb + (KO)), fb01 = *(const bf16x8*)(pb + 32 * 72 + (KO));            \
    bf16x8 fb02 = *(const bf16x8*)(pb + 64 * 72 + (KO)), fb03 = *(const bf16x8*)(pb + 96 * 72 + (KO));  \
    bf16x8 fa10 = *(const bf16x8*)(pa + (KO) + 16), fa11 = *(const bf16x8*)(pa + 32 * 72 + (KO) + 16);  \
    bf16x8 fb10 = *(const bf16x8*)(pb + (KO) + 16), fb11 = *(const bf16x8*)(pb + 32 * 72 + (KO) + 16);  \
    bf16x8 fb12 = *(const bf16x8*)(pb + 64 * 72 + (KO) + 16), fb13 = *(const bf16x8*)(pb + 96 * 72 + (KO) + 16); \
    __builtin_amdgcn_sched_barrier(0);                                                                  \
    __builtin_amdgcn_s_setprio(1);                                                                      \
    MM8(fa00, fa01, fb00, fb01, fb02, fb03)                                                             \
    MM8(fa10, fa11, fb10, fb11, fb12, fb13)                                                             \
    __builtin_amdgcn_s_setprio(0);                                                                      \
    __builtin_amdgcn_sched_barrier(0);                                                                  \
  }
  for (int kt = 0; kt < nk; ++kt) {
    __syncthreads();
    *(uint4*)(sA + (lr + 0) * 72 + lc) = ra0;
    *(uint4*)(sA + (lr + 32) * 72 + lc) = ra1;
    *(uint4*)(sA + (lr + 64) * 72 + lc) = ra2;
    *(uint4*)(sA + (lr + 96) * 72 + lc) = ra3;
    *(uint4*)(sB + (lr + 0) * 72 + lc) = rb0;
    *(uint4*)(sB + (lr + 32) * 72 + lc) = rb1;
    *(uint4*)(sB + (lr + 64) * 72 + lc) = rb2;
    *(uint4*)(sB + (lr + 96) * 72 + lc) = rb3;
    *(uint4*)(sB + (lr + 128) * 72 + lc) = rb4;
    *(uint4*)(sB + (lr + 160) * 72 + lc) = rb5;
    *(uint4*)(sB + (lr + 192) * 72 + lc) = rb6;
    *(uint4*)(sB + (lr + 224) * 72 + lc) = rb7;
    __syncthreads();
    if (kt + 1 < nk) {
      Ap += 64;
      Bp += 64;
      LOAD_AB()
    }
    __builtin_amdgcn_sched_barrier(0);
    HALF_STEP(0)
    HALF_STEP(32)
  }
#undef HALF_STEP
#undef MM8
#undef LOAD_AB
  const int ci = lane & 31;
  const int rbase = m0 + wm * 64 + 4 * (lane >> 5);
  const int cbase = n0 + wn * 128;
  if (EPI == EPI_P) {
    bf16_t* P = (bf16_t*)(p.ws + OFF_P);
    float* AB = (float*)(p.ws + OFF_AB);
    bf16_t* NVT = (bf16_t*)(p.ws + OFF_NVT);
#pragma unroll
    for (int mt = 0; mt < 2; ++mt)
#pragma unroll
      for (int nt = 0; nt < 4; ++nt) {
        const int base = cbase + nt * 32;
#pragma unroll
        for (int r = 0; r < 16; ++r) {
          int row = rbase + mt * 32 + (r & 3) + 8 * (r >> 2);
          int col = base + ci;
          float v = acc[mt][nt][r];
          P[(size_t)row * INWP + col] = f2bf(v);
          if (col >= C_DA && col < C_DA + 16) AB[(size_t)row * 16 + col - C_DA] = v;
        }
        if (base >= C_NV && base < C_NV + 256) {
          const int hv = (base - C_NV) >> 6, dv = ((base - C_NV) & 63) + ci;
#pragma unroll
          for (int g = 0; g < 4; ++g) {
            const int row0 = rbase + mt * 32 + 8 * g;
            int bb, key0;
            if (row0 < M_LAT) { bb = row0 >> 11; key0 = 256 + (row0 & 2047); }
            else { bb = (row0 - M_LAT) >> 8; key0 = (row0 - M_LAT) & 255; }
            uint2 u;
            u.x = pack2(acc[mt][nt][4 * g + 0], acc[mt][nt][4 * g + 1]);
            u.y = pack2(acc[mt][nt][4 * g + 2], acc[mt][nt][4 * g + 3]);
            *(uint2*)(NVT + ((size_t)(bb * 4 + hv) * 64 + dv) * 2304 + key0) = u;
          }
        }
      }
  } else if (EPI == EPI_GU) {
    bf16_t* ACT = (bf16_t*)(p.ws + OFF_P);
#pragma unroll
    for (int mt = 0; mt < 2; ++mt)
#pragma unroll
      for (int pr = 0; pr < 2; ++pr)
#pragma unroll
        for (int r = 0; r < 16; ++r) {
          int row = rbase + mt * 32 + (r & 3) + 8 * (r >> 2);
          float gt = acc[mt][2 * pr][r], up = acc[mt][2 * pr + 1][r];
          float a = silu_f(gt) * up;
          ACT[(size_t)row * FFN + ((cbase >> 6) + pr) * 32 + ci] = f2bf(a);
        }
  }
}

typedef float f32x4 __attribute__((ext_vector_type(4)));
template <int EPI>
__device__ void gemm_wide16(const Params& p, int l, const bf16_t* __restrict__ A, int lda,
                            const bf16_t* __restrict__ BT, int K, int m0, int n0, char* smem) {
  constexpr int RS = 80;
  bf16_t* sA = (bf16_t*)smem;
  bf16_t* sB = sA + 128 * RS;
  const int tid = otid(), lane = tid & 63, w = tid >> 6, wm = w >> 1, wn = w & 1;
  const int lr = tid >> 3, lc = (tid & 7) * 8;
  const int l15 = lane & 15, lq = lane >> 4;
  const bf16_t* Ap = A + (size_t)(m0 + lr) * lda + lc;
  const bf16_t* Bp = BT + (size_t)(n0 + lr) * K + lc;
  uint4 ra0, ra1, ra2, ra3, rb0, rb1, rb2, rb3, rb4, rb5, rb6, rb7;
#define LOAD_AB()                                   \
  ra0 = *(const uint4*)(Ap);                        \
  ra1 = *(const uint4*)(Ap + (size_t)32 * lda);     \
  ra2 = *(const uint4*)(Ap + (size_t)64 * lda);     \
  ra3 = *(const uint4*)(Ap + (size_t)96 * lda);     \
  rb0 = *(const uint4*)(Bp);                        \
  rb1 = *(const uint4*)(Bp + (size_t)32 * K);       \
  rb2 = *(const uint4*)(Bp + (size_t)64 * K);       \
  rb3 = *(const uint4*)(Bp + (size_t)96 * K);       \
  rb4 = *(const uint4*)(Bp + (size_t)128 * K);      \
  rb5 = *(const uint4*)(Bp + (size_t)160 * K);      \
  rb6 = *(const uint4*)(Bp + (size_t)192 * K);      \
  rb7 = *(const uint4*)(Bp + (size_t)224 * K);
  __syncthreads();
  LOAD_AB()
  f32x4 acc[4][8];
#pragma unroll
  for (int i = 0; i < 4; ++i)
#pragma unroll
    for (int j = 0; j < 8; ++j)
#pragma unroll
      for (int r = 0; r < 4; ++r) acc[i][j][r] = 0.f;
  const int nk = K / 64;
  const bf16_t* pa = sA + (wm * 64 + l15) * RS + lq * 8;
  const bf16_t* pb = sB + (wn * 128 + l15) * RS + lq * 8;
  for (int kt = 0; kt < nk; ++kt) {
    __syncthreads();
    *(uint4*)(sA + (lr + 0) * RS + lc) = ra0;
    *(uint4*)(sA + (lr + 32) * RS + lc) = ra1;
    *(uint4*)(sA + (lr + 64) * RS + lc) = ra2;
    *(uint4*)(sA + (lr + 96) * RS + lc) = ra3;
    *(uint4*)(sB + (lr + 0) * RS + lc) = rb0;
    *(uint4*)(sB + (lr + 32) * RS + lc) = rb1;
    *(uint4*)(sB + (lr + 64) * RS + lc) = rb2;
    *(uint4*)(sB + (lr + 96) * RS + lc) = rb3;
    *(uint4*)(sB + (lr + 128) * RS + lc) = rb4;
    *(uint4*)(sB + (lr + 160) * RS + lc) = rb5;
    *(uint4*)(sB + (lr + 192) * RS + lc) = rb6;
    *(uint4*)(sB + (lr + 224) * RS + lc) = rb7;
    __syncthreads();
    if (kt + 1 < nk) {
      Ap += 64;
      Bp += 64;
      LOAD_AB()
    }
    __builtin_amdgcn_sched_barrier(0);
#pragma unroll
    for (int ks = 0; ks < 2; ++ks) {
      bf16x8 fa[4];
#pragma unroll
      for (int i = 0; i < 4; ++i) fa[i] = *(const bf16x8*)(pa + i * 16 * RS + ks * 32);
#pragma unroll
      for (int jh = 0; jh < 2; ++jh) {
        bf16x8 fb[4];
#pragma unroll
        for (int j = 0; j < 4; ++j) fb[j] = *(const bf16x8*)(pb + (jh * 4 + j) * 16 * RS + ks * 32);
        __builtin_amdgcn_s_setprio(1);
#pragma unroll
        for (int j = 0; j < 4; ++j)
#pragma unroll
          for (int i = 0; i < 4; ++i)
            acc[i][jh * 4 + j] = __builtin_amdgcn_mfma_f32_16x16x32_bf16(fa[i], fb[j], acc[i][jh * 4 + j], 0, 0, 0);
        __builtin_amdgcn_s_setprio(0);
      }
    }
  }
#undef LOAD_AB
  const int rbase = m0 + wm * 64 + lq * 4;
  const int cbase = n0 + wn * 128;
  if (EPI == EPI_P) {
    bf16_t* P = (bf16_t*)(p.ws + OFF_P);
    float* AB = (float*)(p.ws + OFF_AB);
    bf16_t* NVT = (bf16_t*)(p.ws + OFF_NVT);
#pragma unroll
    for (int nt = 0; nt < 8; ++nt) {
      const int base = cbase + nt * 16;
#pragma unroll
      for (int mt = 0; mt < 4; ++mt) {
        const int row0 = rbase + mt * 16;
#pragma unroll
        for (int r = 0; r < 4; ++r) P[(size_t)(row0 + r) * INWP + base + l15] = f2bf(acc[mt][nt][r]);
        if (base == C_DA) {
#pragma unroll
          for (int r = 0; r < 4; ++r) AB[(size_t)(row0 + r) * 16 + l15] = acc[mt][nt][r];
        }
        if (base >= C_NV && base < C_NV + 256) {
          const int hv = (base - C_NV) >> 6, dv = ((base - C_NV) & 63) + l15;
          int bb, key0;
          if (row0 < M_LAT) { bb = row0 >> 11; key0 = 256 + (row0 & 2047); }
          else { bb = (row0 - M_LAT) >> 8; key0 = (row0 - M_LAT) & 255; }
          uint2 u;
          u.x = pack2(acc[mt][nt][0], acc[mt][nt][1]);
          u.y = pack2(acc[mt][nt][2], acc[mt][nt][3]);
          *(uint2*)(NVT + ((size_t)(bb * 4 + hv) * 64 + dv) * 2304 + key0) = u;
        }
      }
    }
  } else if (EPI == EPI_GU) {
    bf16_t* ACT = (bf16_t*)(p.ws + OFF_P);
#pragma unroll
    for (int pr = 0; pr < 2; ++pr)
#pragma unroll
      for (int hf = 0; hf < 2; ++hf)
#pragma unroll
        for (int mt = 0; mt < 4; ++mt)
#pragma unroll
          for (int r = 0; r < 4; ++r) {
            const int row = rbase + mt * 16 + r;
            const float gt = acc[mt][pr * 4 + hf][r], up = acc[mt][pr * 4 + 2 + hf][r];
            ACT[(size_t)row * FFN + ((cbase >> 6) + pr) * 32 + hf * 16 + l15] = f2bf(silu_f(gt) * up);
          }
  }
}

__device__ void kpe_item(const Params& p, int it) {
  const int tid = otid();
  const bf16_t* P = (const bf16_t*)(p.ws + OFF_P);
  bf16_t* KH = (bf16_t*)(p.ws + OFF_KH);
  const float* rc = (const float*)(p.ws + OFF_ROPE);
  const float* rsn = rc + 2048 * 16;
  const int row = it * 8 + (tid >> 5), i = tid & 31;
  float v = bf2f(P[(size_t)row * INWP + C_MPE + i]);
  float o = __shfl_xor(v, 8);
  if (row < M_LAT) {
    int t = row & 2047;
    int a = i >> 4, hf = (i >> 3) & 1, j = i & 7;
    float c = rc[t * 16 + a * 8 + j], s = rsn[t * 16 + a * 8 + j];
    v = hf ? (o * s + v * c) : (v * c - o * s);
  }
  bf16_t bv = f2bf(v);
  int bb, key;
  if (row < M_LAT) { bb = row >> 11; key = 256 + (row & 2047); }
  else { bb = (row - M_LAT) >> 8; key = (row - M_LAT) & 255; }
#pragma unroll
  for (int h = 0; h < 4; ++h) KH[((size_t)(bb * 4 + h) * 2304 + key) * 96 + 64 + i] = bv;
}

__device__ void dn_prep(const Params& p, int l, int it, char* smem) {
  float* buf = (float*)smem;
  float* nrm = buf + 8 * 1536;
  const int tid = otid();
  const bf16_t* P = (const bf16_t*)(p.ws + OFF_P);
  bf16_t* DQ = (bf16_t*)(p.ws + OFF_DNQKV);
  const int r0 = it * 8;
  int seq_lo, seq_hi;
  if (r0 < M_LAT) {
    seq_lo = (r0 >> 11) << 11;
    seq_hi = seq_lo + 2048;
  } else {
    int rr = r0 - M_LAT;
    seq_lo = M_LAT + ((rr >> 8) << 8);
    seq_hi = seq_lo + 256;
  }
  const float* cw = p.conv_w + (size_t)l * 5 * 1536;
  __syncthreads();
  for (int c6 = 0; c6 < 6; ++c6) {
    const int ch = c6 * 256 + tid;
    float w0 = cw[ch], w1 = cw[1536 + ch], w2 = cw[2 * 1536 + ch], w3 = cw[3 * 1536 + ch], w4 = cw[4 * 1536 + ch];
    float xw[12];
#pragma unroll
    for (int j = 0; j < 12; ++j) {
      int r = r0 - 2 + j;
      xw[j] = (r >= seq_lo && r < seq_hi) ? bf2f(P[(size_t)r * INWP + C_DN + ch]) : 0.f;
    }
#pragma unroll
    for (int j = 0; j < 8; ++j) {
      float y = w0 * xw[j] + w1 * xw[j + 1] + w2 * xw[j + 2] + w3 * xw[j + 3] + w4 * xw[j + 4];
      buf[j * 1536 + ch] = silu_f(y);
    }
  }
  __syncthreads();
  {
    int vec = tid >> 2, part = tid & 3;
    int rr = vec >> 3, hv = vec & 7;
    const float* v = buf + rr * 1536 + hv * 128 + part * 32;
    float ss = 0.f;
#pragma unroll
    for (int i = 0; i < 32; ++i) ss += v[i] * v[i];
    ss += __shfl_xor(ss, 1);
    ss += __shfl_xor(ss, 2);
    if (part == 0) nrm[vec] = rsqrtf(ss + 1e-6f);
  }
  __syncthreads();
  for (int i = tid; i < 8 * 1536; i += 256) {
    int rr = i / 1536, ch = i - rr * 1536;
    float v = buf[i];
    if (ch < 1024) v *= nrm[rr * 8 + (ch >> 7)];
    DQ[(size_t)(r0 + rr) * 1536 + ch] = f2bf(v);
  }
}


DEVI int rowmap(int r, int hh) { return (r & 3) + 8 * (r >> 2) + 4 * hh; }

DEVI void unpack8(const uint4& u, float* f) {
  f[0] = bflo(u.x); f[1] = bfhi(u.x); f[2] = bflo(u.y); f[3] = bfhi(u.y);
  f[4] = bflo(u.z); f[5] = bfhi(u.z); f[6] = bflo(u.w); f[7] = bfhi(u.w);
}
__device__ void dn_chunk_prep(const Params& p, int l, int item, char* smem) {
  float* sW = (float*)smem;
  bf16_t* sKb = (bf16_t*)(smem + 7680);
  float* sL0 = (float*)(smem + 25088);
  float* sL1 = sL0 + 64 * 68;
  float* sg = (float*)(smem + 59904);
  float* sbt = sg + 128;
  const int tid = otid(), lane = tid & 63, w = tid >> 6, li = lane & 31, hh = lane >> 5;
  const int chunk = item >> 2, h = item & 3;
  int row0, seq_lo, seq_hi;
  if (chunk < 256) {
    int b = chunk >> 5;
    row0 = b * 2048 + (chunk & 31) * 64; seq_lo = b * 2048; seq_hi = seq_lo + 2048;
  } else {
    int cc = chunk - 256, b = cc >> 2;
    row0 = M_LAT + b * 256 + (cc & 3) * 64; seq_lo = M_LAT + b * 256; seq_hi = seq_lo + 256;
  }
  const bf16_t* P = (const bf16_t*)(p.ws + OFF_P);
  bf16_t* DQ = (bf16_t*)(p.ws + OFF_DNQKV);
  const float* AB = (const float*)(p.ws + OFF_AB);
  const float* cw = p.conv_w + (size_t)l * 5 * 1536;
  __syncthreads();
  for (int i = tid; i < 5 * 384; i += 256) {
    const int tap = i / 384, cc = i - tap * 384, type = cc >> 7, c = cc & 127;
    const int off = type == 0 ? 512 : (type == 1 ? 0 : 1024);
    sW[i] = cw[tap * 1536 + off + h * 128 + c];
  }
  if (w < 2) {
    const int d = w;
    const int row = d ? (row0 + 63 - lane) : (row0 + lane);
    const float Aneg = -__expf(p.a_log[l * 8 + d * 4 + h]);
    const float dtb = p.dt_bias[l * 8 + d * 4 + h];
    float a = AB[(size_t)row * 16 + d * 4 + h];
    float bb = AB[(size_t)row * 16 + 8 + d * 4 + h];
    float xx = a + dtb;
    const float ee = __expf(xx);
    float sp = ee < 0.25f ? ee * (1.f - ee * (0.5f - ee * (0.33333333f - ee * (0.25f - 0.2f * ee))))
                          : (xx > 20.f ? xx : __logf(1.f + ee));
    float g = Aneg * sp;
#pragma unroll
    for (int o = 1; o < 64; o <<= 1) {
      float y = __shfl_up(g, o);
      if (lane >= o) g += y;
    }
    float be = 1.f / (1.f + __expf(-bb));
    sg[d * 64 + lane] = g;
    sbt[d * 64 + lane] = be;
    ((float*)(p.ws + OFF_GC))[(size_t)row * 8 + d * 4 + h] = g;
    ((float*)(p.ws + OFF_BETA))[(size_t)row * 8 + d * 4 + h] = be;
  }
  __syncthreads();
  const int cg = tid & 15, rsub = tid >> 4;
#pragma unroll 1
  for (int type = 0; type < 3; ++type) {
    const int off = type == 0 ? 512 : (type == 1 ? 0 : 1024);
    uint4 xv[4][5];
#pragma unroll
    for (int e = 0; e < 4; ++e) {
      const int row = rsub + 16 * e;
      const bf16_t* base = P + (size_t)(row0 + row) * INWP + C_DN + off + h * 128 + cg * 8;
#pragma unroll
      for (int dd = 0; dd < 5; ++dd) {
        const int r = row0 + row + dd - 2;
        xv[e][dd] = (r >= seq_lo && r < seq_hi) ? *(const uint4*)(base + (dd - 2) * INWP) : make_uint4(0u, 0u, 0u, 0u);
      }
    }
#pragma unroll
    for (int e = 0; e < 4; ++e) {
      const int row = rsub + 16 * e;
      float y[8];
#pragma unroll
      for (int j = 0; j < 8; ++j) y[j] = 0.f;
#pragma unroll
      for (int dd = 0; dd < 5; ++dd) {
        float xf[8];
        unpack8(xv[e][dd], xf);
        const float4 wa = *(const float4*)(sW + dd * 384 + type * 128 + cg * 8);
        const float4 wb = *(const float4*)(sW + dd * 384 + type * 128 + cg * 8 + 4);
        y[0] += wa.x * xf[0]; y[1] += wa.y * xf[1]; y[2] += wa.z * xf[2]; y[3] += wa.w * xf[3];
        y[4] += wb.x * xf[4]; y[5] += wb.y * xf[5]; y[6] += wb.z * xf[6]; y[7] += wb.w * xf[7];
      }
      float ss = 0.f;
#pragma unroll
      for (int j = 0; j < 8; ++j) {
        y[j] = silu_f(y[j]);
        ss += y[j] * y[j];
      }
      if (type < 2) {
        ss += __shfl_xor(ss, 1);
        ss += __shfl_xor(ss, 2);
        ss += __shfl_xor(ss, 4);
        ss += __shfl_xor(ss, 8);
        const float rn = rsqrtf(ss + 1e-6f);
#pragma unroll
        for (int j = 0; j < 8; ++j) y[j] *= rn;
      }
      uint4 u;
      u.x = pack2(y[0], y[1]); u.y = pack2(y[2], y[3]); u.z = pack2(y[4], y[5]); u.w = pack2(y[6], y[7]);
      *(uint4*)(DQ + (size_t)(row0 + row) * 1536 + off + h * 128 + cg * 8) = u;
      if (type == 0) *(uint4*)(sKb + row * 136 + cg * 8) = u;
    }
  }
  __syncthreads();
  {
    const int mi = w >> 1, ni = w & 1;
    f32x16 g;
#pragma unroll
    for (int r = 0; r < 16; ++r) g[r] = 0.f;
#pragma unroll
    for (int ks = 0; ks < 8; ++ks) {
      bf16x8 a = *(const bf16x8*)(sKb + (mi * 32 + li) * 136 + ks * 16 + hh * 8);
      bf16x8 b = *(const bf16x8*)(sKb + (ni * 32 + li) * 136 + ks * 16 + hh * 8);
      g = __builtin_amdgcn_mfma_f32_32x32x16_bf16(a, b, g, 0, 0, 0);
    }
#pragma unroll
    for (int r = 0; r < 16; ++r) {
      const int i = mi * 32 + rowmap(r, hh), m = ni * 32 + li;
      const float G = g[r];
      sL0[i * 68 + m] = (i > m) ? sbt[i] * G * __expf(sg[i] - sg[m]) : 0.f;
      const int i1 = 63 - i, m1 = 63 - m;
      sL1[i1 * 68 + m1] = (i1 > m1) ? sbt[64 + i1] * G * __expf(sg[64 + i1] - sg[64 + m1]) : 0.f;
    }
  }
  __syncthreads();
  if (w < 2) {
    const float* L = w == 0 ? sL0 : sL1;
    float t[64];
#pragma unroll
    for (int i = 0; i < 64; ++i) {
      float a0 = (i == lane) ? 1.f : 0.f, a1 = 0.f, a2 = 0.f, a3 = 0.f;
#pragma unroll
      for (int m = 0; m < i; ++m) {
        const float pr = L[i * 68 + m] * t[m];
        if ((m & 3) == 0) a0 -= pr;
        else if ((m & 3) == 1) a1 -= pr;
        else if ((m & 3) == 2) a2 -= pr;
        else a3 -= pr;
      }
      t[i] = (a0 + a1) + (a2 + a3);
    }
    bf16_t* Tg = (bf16_t*)(p.ws + OFF_OB) + (size_t)((chunk * 4 + h) * 2 + w) * 4096;
#pragma unroll
    for (int i = 0; i < 64; ++i) Tg[i * 64 + lane] = f2bf(t[i]);
  }
}

DEVI bf16x8 ld_perm(const bf16_t* p) {
  union { bf16x8 v; uint2 d[2]; } u;
  u.d[0] = *(const uint2*)(p);
  u.d[1] = *(const uint2*)(p + 8);
  return u.v;
}
DEVI bf16x8 pack8(const f32x16& x, int s) {
  union { bf16x8 v; unsigned w[4]; } u;
  u.w[0] = pack2(x[8 * s + 0], x[8 * s + 1]);
  u.w[1] = pack2(x[8 * s + 2], x[8 * s + 3]);
  u.w[2] = pack2(x[8 * s + 4], x[8 * s + 5]);
  u.w[3] = pack2(x[8 * s + 6], x[8 * s + 7]);
  return u.v;
}

__device__ void dn_scan(const Params& p, int l, int item, char* smem) {
  bf16_t* sK = (bf16_t*)smem;
  bf16_t* sQ = (bf16_t*)(smem + 17408);
  bf16_t* sKT = (bf16_t*)(smem + 34816);
  bf16_t* sT = (bf16_t*)(smem + 52224);
  bf16_t* sA = (bf16_t*)(smem + 60928);
  bf16_t* sV = (bf16_t*)(smem + 52224);
  float* sg = (float*)(smem + 69632);
  float* sbt = sg + 64;
  float* seg = sbt + 64;
  float* sdt = seg + 64;
  const int d = item & 1, h = (item >> 1) & 3, b = item >> 3;
  const bf16_t* DQ = (const bf16_t*)(p.ws + OFF_DNQKV);
  const bf16_t* TB = (const bf16_t*)(p.ws + OFF_OB);
  const float* GC = (const float*)(p.ws + OFF_GC);
  const float* BE = (const float*)(p.ws + OFF_BETA);
  bf16_t* MIX = (bf16_t*)(p.ws + OFF_HM);
  bf16_t* Pw = (bf16_t*)(p.ws + OFF_P);
  const float qscale = 0.08838834764831845f;
  const int rsign = d ? -1 : 1;
  f32x16 S0, S1, S2, S3;
#pragma unroll
  for (int r = 0; r < 16; ++r) { S0[r] = 0.f; S1[r] = 0.f; S2[r] = 0.f; S3[r] = 0.f; }
  __builtin_amdgcn_s_setprio(3);
  uint4 qA0, qB0, kA0, kB0, vA0, vB0, qA1, qB1, kA1, kB1, vA1, vB1, tq0, tq1;
  float pgc = 0.f, pbe = 0.f;
#define SCAN_ROW0(N, CHUNK, ROW0)                                    \
  {                                                                  \
    if ((N) < 4) {                                                   \
      int cn = d ? (3 - (N)) : (N);                                  \
      CHUNK = 256 + b * 4 + cn;                                      \
      ROW0 = M_LAT + b * 256 + cn * 64;                              \
    } else {                                                         \
      int ln = (N)-4;                                                \
      ln = d ? (31 - ln) : ln;                                       \
      CHUNK = b * 32 + ln;                                           \
      ROW0 = b * 2048 + ln * 64;                                     \
    }                                                                \
  }
#define SCAN_LOADS(N)                                                                         \
  {                                                                                           \
    const int tid_ = otid();                                                                  \
    int chunk_, row0_;                                                                        \
    SCAN_ROW0(N, chunk_, row0_)                                                               \
    const int rstart_ = d ? (row0_ + 63) : row0_;                                             \
    {                                                                                         \
      const int u = tid_, c8 = u & 15, tp = u >> 4;                                           \
      const bf16_t* ga = DQ + (size_t)(rstart_ + rsign * 2 * tp) * 1536 + h * 128 + c8 * 8;   \
      const bf16_t* gb = ga + rsign * 1536;                                                   \
      qA0 = *(const uint4*)(ga); kA0 = *(const uint4*)(ga + 512); vA0 = *(const uint4*)(ga + 1024); \
      qB0 = *(const uint4*)(gb); kB0 = *(const uint4*)(gb + 512); vB0 = *(const uint4*)(gb + 1024); \
    }                                                                                         \
    {                                                                                         \
      const int u = tid_ + 256, c8 = u & 15, tp = u >> 4;                                     \
      const bf16_t* ga = DQ + (size_t)(rstart_ + rsign * 2 * tp) * 1536 + h * 128 + c8 * 8;   \
      const bf16_t* gb = ga + rsign * 1536;                                                   \
      qA1 = *(const uint4*)(ga); kA1 = *(const uint4*)(ga + 512); vA1 = *(const uint4*)(ga + 1024); \
      qB1 = *(const uint4*)(gb); kB1 = *(const uint4*)(gb + 512); vB1 = *(const uint4*)(gb + 1024); \
    }                                                                                         \
    {                                                                                         \
      const bf16_t* Tg = TB + (size_t)((chunk_ * 4 + h) * 2 + d) * 4096;                      \
      tq0 = *(const uint4*)(Tg + (tid_ >> 3) * 64 + (tid_ & 7) * 8);                          \
      tq1 = *(const uint4*)(Tg + ((tid_ >> 3) + 32) * 64 + (tid_ & 7) * 8);                   \
    }                                                                                         \
    if (tid_ < 64) {                                                                          \
      const int row = rstart_ + rsign * tid_;                                                 \
      pgc = GC[(size_t)row * 8 + d * 4 + h];                                                  \
      pbe = BE[(size_t)row * 8 + d * 4 + h];                                                  \
    }                                                                                         \
  }
  SCAN_LOADS(0)
  for (int n = 0; n < 36; ++n) {
    const int tid = otid(), lane = tid & 63, w = tid >> 6, li = lane & 31, hh = lane >> 5;
    int chunk, row0;
    SCAN_ROW0(n, chunk, row0)
    (void)chunk;
    const int rstart = d ? (row0 + 63) : row0;
    __syncthreads();
#define STAGE_UNIT(U, QA, QB, KA, KB, VA, VB)                                                   \
  {                                                                                             \
    const int c8 = (U)&15, tp = (U) >> 4;                                                       \
    *(uint4*)(sQ + (2 * tp) * 136 + c8 * 8) = QA;                                               \
    *(uint4*)(sQ + (2 * tp + 1) * 136 + c8 * 8) = QB;                                           \
    *(uint4*)(sK + (2 * tp) * 136 + c8 * 8) = KA;                                               \
    *(uint4*)(sK + (2 * tp + 1) * 136 + c8 * 8) = KB;                                           \
    *(uint4*)(sV + (2 * tp) * 136 + c8 * 8) = VA;                                               \
    *(uint4*)(sV + (2 * tp + 1) * 136 + c8 * 8) = VB;                                           \
    unsigned* kt = (unsigned*)(sKT + (c8 * 8) * 68 + 2 * tp);                                   \
    kt[0 * 34] = (KA.x & 0xffffu) | (KB.x << 16);                                               \
    kt[1 * 34] = (KA.x >> 16) | (KB.x & 0xffff0000u);                                           \
    kt[2 * 34] = (KA.y & 0xffffu) | (KB.y << 16);                                               \
    kt[3 * 34] = (KA.y >> 16) | (KB.y & 0xffff0000u);                                           \
    kt[4 * 34] = (KA.z & 0xffffu) | (KB.z << 16);                                               \
    kt[5 * 34] = (KA.z >> 16) | (KB.z & 0xffff0000u);                                           \
    kt[6 * 34] = (KA.w & 0xffffu) | (KB.w << 16);                                               \
    kt[7 * 34] = (KA.w >> 16) | (KB.w & 0xffff0000u);                                           \
  }
    STAGE_UNIT(tid, qA0, qB0, kA0, kB0, vA0, vB0)
    STAGE_UNIT(tid + 256, qA1, qB1, kA1, kB1, vA1, vB1)
#undef STAGE_UNIT
    if (tid < 64) {
      float g63 = __shfl(pgc, 63);
      sg[lane] = pgc;
      sbt[lane] = pbe;
      seg[lane] = __expf(pgc);
      sdt[lane] = __expf(g63 - pgc);
    }
    __syncthreads();
    f32x16 v0, v1;
#pragma unroll
    for (int r = 0; r < 16; ++r) {
      const int t0 = rowmap(r, hh);
      v0[r] = bf2f(sV[t0 * 136 + w * 32 + li]);
      v1[r] = bf2f(sV[(32 + t0) * 136 + w * 32 + li]);
    }
    __syncthreads();
    {
      const int i0 = tid >> 3, c8 = tid & 7;
      *(uint2*)(sT + i0 * 68 + c8 * 8) = make_uint2(tq0.x, tq0.y);
      *(uint2*)(sT + i0 * 68 + c8 * 8 + 4) = make_uint2(tq0.z, tq0.w);
      *(uint2*)(sT + (i0 + 32) * 68 + c8 * 8) = make_uint2(tq1.x, tq1.y);
      *(uint2*)(sT + (i0 + 32) * 68 + c8 * 8 + 4) = make_uint2(tq1.z, tq1.w);
    }
    {
      const int mi = w >> 1, ni = w & 1;
      f32x16 a;
#pragma unroll
      for (int r = 0; r < 16; ++r) a[r] = 0.f;
      if (!(mi == 0 && ni == 1)) {
#pragma unroll
        for (int ks = 0; ks < 8; ++ks) {
          bf16x8 qa = *(const bf16x8*)(sQ + (mi * 32 + li) * 136 + ks * 16 + hh * 8);
          bf16x8 kb = *(const bf16x8*)(sK + (ni * 32 + li) * 136 + ks * 16 + hh * 8);
          a = __builtin_amdgcn_mfma_f32_32x32x16_bf16(qa, kb, a, 0, 0, 0);
        }
      }
#pragma unroll
      for (int r = 0; r < 16; ++r) {
        const int i = mi * 32 + rowmap(r, hh), j = ni * 32 + li;
        float val = (i >= j) ? a[r] * qscale * __expf(sg[i] - sg[j]) : 0.f;
        sA[i * 68 + j] = f2bf(val);
      }
    }
    __syncthreads();
    f32x16 ks0, ks1;
#pragma unroll
    for (int r = 0; r < 16; ++r) { ks0[r] = 0.f; ks1[r] = 0.f; }
    {
      const bf16_t* ka = sK + li * 136 + 4 * hh;
#define K_STEP(OFFS, SX, SS)                                                                           \
  {                                                                                                    \
    bf16x8 sb = pack8(SX, SS);                                                                         \
    ks0 = __builtin_amdgcn_mfma_f32_32x32x16_bf16(ld_perm(ka + (OFFS)), sb, ks0, 0, 0, 0);             \
    ks1 = __builtin_amdgcn_mfma_f32_32x32x16_bf16(ld_perm(ka + 32 * 136 + (OFFS)), sb, ks1, 0, 0, 0);  \
  }
      K_STEP(0, S0, 0) K_STEP(16, S0, 1) K_STEP(32, S1, 0) K_STEP(48, S1, 1)
      K_STEP(64, S2, 0) K_STEP(80, S2, 1) K_STEP(96, S3, 0) K_STEP(112, S3, 1)
#undef K_STEP
    }
#pragma unroll
    for (int r = 0; r < 16; ++r) {
      const int t0 = rowmap(r, hh), t1 = 32 + t0;
      v0[r] = sbt[t0] * (v0[r] - seg[t0] * ks0[r]);
      v1[r] = sbt[t1] * (v1[r] - seg[t1] * ks1[r]);
    }
    bf16x8 rb00 = pack8(v0, 0), rb01 = pack8(v0, 1), rb10 = pack8(v1, 0), rb11 = pack8(v1, 1);
    f32x16 n0, n1;
#pragma unroll
    for (int r = 0; r < 16; ++r) { n0[r] = 0.f; n1[r] = 0.f; }
    {
      const bf16_t* ta = sT + li * 68 + 4 * hh;
      n0 = __builtin_amdgcn_mfma_f32_32x32x16_bf16(ld_perm(ta + 0), rb00, n0, 0, 0, 0);
      n0 = __builtin_amdgcn_mfma_f32_32x32x16_bf16(ld_perm(ta + 16), rb01, n0, 0, 0, 0);
      const bf16_t* tb = ta + 32 * 68;
      n1 = __builtin_amdgcn_mfma_f32_32x32x16_bf16(ld_perm(tb + 0), rb00, n1, 0, 0, 0);
      n1 = __builtin_amdgcn_mfma_f32_32x32x16_bf16(ld_perm(tb + 16), rb01, n1, 0, 0, 0);
      n1 = __builtin_amdgcn_mfma_f32_32x32x16_bf16(ld_perm(tb + 32), rb10, n1, 0, 0, 0);
      n1 = __builtin_amdgcn_mfma_f32_32x32x16_bf16(ld_perm(tb + 48), rb11, n1, 0, 0, 0);
    }
    f32x16 o0, o1;
#pragma unroll
    for (int r = 0; r < 16; ++r) { o0[r] = 0.f; o1[r] = 0.f; }
    {
      const bf16_t* qa = sQ + li * 136 + 4 * hh;
#define Q_STEP(OFFS, SX, SS)                                                                           \
  {                                                                                                    \
    bf16x8 sb = pack8(SX, SS);                                                                         \
    o0 = __builtin_amdgcn_mfma_f32_32x32x16_bf16(ld_perm(qa + (OFFS)), sb, o0, 0, 0, 0);               \
    o1 = __builtin_amdgcn_mfma_f32_32x32x16_bf16(ld_perm(qa + 32 * 136 + (OFFS)), sb, o1, 0, 0, 0);    \
  }
      Q_STEP(0, S0, 0) Q_STEP(16, S0, 1) Q_STEP(32, S1, 0) Q_STEP(48, S1, 1)
      Q_STEP(64, S2, 0) Q_STEP(80, S2, 1) Q_STEP(96, S3, 0) Q_STEP(112, S3, 1)
#undef Q_STEP
    }
#pragma unroll
    for (int r = 0; r < 16; ++r) {
      const int t0 = rowmap(r, hh), t1 = 32 + t0;
      o0[r] *= seg[t0] * qscale;
      o1[r] *= seg[t1] * qscale;
    }
    {
      bf16x8 nb00 = pack8(n0, 0), nb01 = pack8(n0, 1), nb10 = pack8(n1, 0), nb11 = pack8(n1, 1);
      const bf16_t* aa = sA + li * 68 + 4 * hh;
      o0 = __builtin_amdgcn_mfma_f32_32x32x16_bf16(ld_perm(aa + 0), nb00, o0, 0, 0, 0);
      o0 = __builtin_amdgcn_mfma_f32_32x32x16_bf16(ld_perm(aa + 16), nb01, o0, 0, 0, 0);
      const bf16_t* ab = aa + 32 * 68;
      o1 = __builtin_amdgcn_mfma_f32_32x32x16_bf16(ld_perm(ab + 0), nb00, o1, 0, 0, 0);
      o1 = __builtin_amdgcn_mfma_f32_32x32x16_bf16(ld_perm(ab + 16), nb01, o1, 0, 0, 0);
      o1 = __builtin_amdgcn_mfma_f32_32x32x16_bf16(ld_perm(ab + 32), nb10, o1, 0, 0, 0);
      o1 = __builtin_amdgcn_mfma_f32_32x32x16_bf16(ld_perm(ab + 48), nb11, o1, 0, 0, 0);
    }
    __syncthreads();
#pragma unroll
    for (int r = 0; r < 16; ++r) {
      const int t0 = rowmap(r, hh);
      sQ[t0 * 136 + w * 32 + li] = f2bf(o0[r]);
      sQ[(32 + t0) * 136 + w * 32 + li] = f2bf(o1[r]);
    }
#pragma unroll
    for (int r = 0; r < 16; ++r) {
      const int t0 = rowmap(r, hh), t1 = 32 + t0;
      n0[r] *= sdt[t0];
      n1[r] *= sdt[t1];
    }
    {
      bf16x8 nb00 = pack8(n0, 0), nb01 = pack8(n0, 1), nb10 = pack8(n1, 0), nb11 = pack8(n1, 1);
      const float eg63 = seg[63];
#pragma unroll
      for (int r = 0; r < 16; ++r) { S0[r] *= eg63; S1[r] *= eg63; S2[r] *= eg63; S3[r] *= eg63; }
      SCAN_LOADS(min(n + 1, 35))
      const bf16_t* kt = sKT + li * 68 + 4 * hh;
#define S_UPD(SX, DKT)                                                                                   \
  SX = __builtin_amdgcn_mfma_f32_32x32x16_bf16(ld_perm(kt + (DKT) * 32 * 68 + 0), nb00, SX, 0, 0, 0);    \
  SX = __builtin_amdgcn_mfma_f32_32x32x16_bf16(ld_perm(kt + (DKT) * 32 * 68 + 16), nb01, SX, 0, 0, 0);   \
  SX = __builtin_amdgcn_mfma_f32_32x32x16_bf16(ld_perm(kt + (DKT) * 32 * 68 + 32), nb10, SX, 0, 0, 0);   \
  SX = __builtin_amdgcn_mfma_f32_32x32x16_bf16(ld_perm(kt + (DKT) * 32 * 68 + 48), nb11, SX, 0, 0, 0);
      S_UPD(S0, 0) S_UPD(S1, 1) S_UPD(S2, 2) S_UPD(S3, 3)
#undef S_UPD
    }
    __syncthreads();
    {
      bf16_t* obase = d ? (Pw + C_DN + h * 128) : (MIX + 512 + h * 128);
      const int ostride = d ? INWP : 1024;
#pragma unroll
      for (int e = 0; e < 4; ++e) {
        const int idx = tid + 256 * e, tok = idx >> 4, c8 = idx & 15;
        const int row = rstart + rsign * tok;
        *(uint4*)(obase + (size_t)row * ostride + c8 * 8) = *(const uint4*)(sQ + tok * 136 + c8 * 8);
      }
    }
  }
#undef SCAN_LOADS
#undef SCAN_ROW0
  __builtin_amdgcn_s_setprio(0);
}

__device__ void phaseC(const Params& p, int l, char* smem) {
  const int nb = gridDim.x, bid = blockIdx.x;
  const bf16_t* P = (const bf16_t*)(p.ws + OFF_P);
  constexpr int T0 = 1152, T1 = T0 + 144 * 3, T2 = T1 + 144 * 4, T3 = T2 + M_ALL / 8;
  for (int it = bid; it < T3; it += nb) {
    if (it < T0) {
      dn_chunk_prep(p, l, it, smem);
    } else if (it < T1) {
      int i = it - T0;
      if (l == 3 && i >= 128 * 3) continue;
      gemm_tile<EPI_QUP>(p, l, P + C_MQ, INWP, (const bf16_t*)(p.ws + OFF_WQUP), 256, (i / 3) * 128, (i % 3) * 128, 0,
                         smem);
    } else if (it < T2) {
      int i = it - T1;
      gemm_tile<EPI_KVUP>(p, l, P + C_MKV, INWP, (const bf16_t*)(p.ws + OFF_WKVUP), 128, (i / 4) * 128, (i % 4) * 128,
                          0, smem);
    } else {
      kpe_item(p, it - T2);
    }
  }
}

__device__ void mla_flash(const Params& p, int item, char* smem) {
  bf16_t* sK = (bf16_t*)smem;
  bf16_t* sV = sK + 64 * 104;
  const int tid = otid(), lane = tid & 63, w = tid >> 6;
  const int li = lane & 31, hh = lane >> 5;
  int b, h, q0row, nkeys;
  if (item < 512) {
    b = item >> 6; h = (item >> 4) & 3; q0row = b * 2048 + (item & 15) * 128; nkeys = 2304;
  } else {
    int i = item - 512;
    b = i >> 3; h = (i >> 1) & 3; q0row = M_LAT + b * 256 + (i & 1) * 128; nkeys = 256;
  }
  const bf16_t* Kg = (const bf16_t*)(p.ws + OFF_KH) + (size_t)(b * 4 + h) * 2304 * 96;
  const bf16_t* Vg = (const bf16_t*)(p.ws + OFF_VH) + (size_t)(b * 4 + h) * 64 * 2304;
  const bf16_t* QH = (const bf16_t*)(p.ws + OFF_QH);
  bf16_t* MIX = (bf16_t*)(p.ws + OFF_HM);
  const int qrow = q0row + w * 32 + li;
  bf16x8 qf0, qf1, qf2, qf3, qf4, qf5;
  {
    const bf16_t* qp = QH + (size_t)qrow * 384 + h * 96 + hh * 8;
    qf0 = *(const bf16x8*)(qp); qf1 = *(const bf16x8*)(qp + 16); qf2 = *(const bf16x8*)(qp + 32);
    qf3 = *(const bf16x8*)(qp + 48); qf4 = *(const bf16x8*)(qp + 64); qf5 = *(const bf16x8*)(qp + 80);
  }
  const int k_i0 = tid, k_i1 = tid + 256, k_i2 = tid + 512;
  const int kk0 = k_i0 / 12, kc0 = k_i0 % 12, kk1 = k_i1 / 12, kc1 = k_i1 % 12, kk2 = k_i2 / 12, kc2 = k_i2 % 12;
  const int vd0 = tid >> 3, vc0 = tid & 7, vd1 = vd0 + 32;
  uint4 rk0, rk1, rk2, rv0, rv1;
  rk0 = *(const uint4*)(Kg + (size_t)kk0 * 96 + kc0 * 8);
  rk1 = *(const uint4*)(Kg + (size_t)kk1 * 96 + kc1 * 8);
  rk2 = *(const uint4*)(Kg + (size_t)kk2 * 96 + kc2 * 8);
  rv0 = *(const uint4*)(Vg + (size_t)vd0 * 2304 + vc0 * 8);
  rv1 = *(const uint4*)(Vg + (size_t)vd1 * 2304 + vc0 * 8);
  f32x16 o0, o1;
#pragma unroll
  for (int r = 0; r < 16; ++r) { o0[r] = 0.f; o1[r] = 0.f; }
  float m = -1e30f, lp = 0.f;
  const float sc = 0.10206207261596577f * 1.4426950408889634f;
  const int nt = nkeys >> 6;
  for (int t = 0; t < nt; ++t) {
    __syncthreads();
    *(uint4*)(sK + kk0 * 104 + kc0 * 8) = rk0;
    *(uint4*)(sK + kk1 * 104 + kc1 * 8) = rk1;
    *(uint4*)(sK + kk2 * 104 + kc2 * 8) = rk2;
    *(uint2*)(sV + vd0 * 68 + vc0 * 8) = make_uint2(rv0.x, rv0.y);
    *(uint2*)(sV + vd0 * 68 + vc0 * 8 + 4) = make_uint2(rv0.z, rv0.w);
    *(uint2*)(sV + vd1 * 68 + vc0 * 8) = make_uint2(rv1.x, rv1.y);
    *(uint2*)(sV + vd1 * 68 + vc0 * 8 + 4) = make_uint2(rv1.z, rv1.w);
    __syncthreads();
    if (t + 1 < nt) {
      const int k0 = (t + 1) * 64;
      rk0 = *(const uint4*)(Kg + (size_t)(k0 + kk0) * 96 + kc0 * 8);
      rk1 = *(const uint4*)(Kg + (size_t)(k0 + kk1) * 96 + kc1 * 8);
      rk2 = *(const uint4*)(Kg + (size_t)(k0 + kk2) * 96 + kc2 * 8);
      rv0 = *(const uint4*)(Vg + (size_t)vd0 * 2304 + k0 + vc0 * 8);
      rv1 = *(const uint4*)(Vg + (size_t)vd1 * 2304 + k0 + vc0 * 8);
    }
    f32x16 s0, s1;
#pragma unroll
    for (int r = 0; r < 16; ++r) { s0[r] = 0.f; s1[r] = 0.f; }
    {
      const bf16_t* ka = sK + li * 104 + hh * 8;
      const bf16_t* kb = ka + 32 * 104;
      s0 = __builtin_amdgcn_mfma_f32_32x32x16_bf16(*(const bf16x8*)(ka), qf0, s0, 0, 0, 0);
      s1 = __builtin_amdgcn_mfma_f32_32x32x16_bf16(*(const bf16x8*)(kb), qf0, s1, 0, 0, 0);
      s0 = __builtin_amdgcn_mfma_f32_32x32x16_bf16(*(const bf16x8*)(ka + 16), qf1, s0, 0, 0, 0);
      s1 = __builtin_amdgcn_mfma_f32_32x32x16_bf16(*(const bf16x8*)(kb + 16), qf1, s1, 0, 0, 0);
      s0 = __builtin_amdgcn_mfma_f32_32x32x16_bf16(*(const bf16x8*)(ka + 32), qf2, s0, 0, 0, 0);
      s1 = __builtin_amdgcn_mfma_f32_32x32x16_bf16(*(const bf16x8*)(kb + 32), qf2, s1, 0, 0, 0);
      s0 = __builtin_amdgcn_mfma_f32_32x32x16_bf16(*(const bf16x8*)(ka + 48), qf3, s0, 0, 0, 0);
      s1 = __builtin_amdgcn_mfma_f32_32x32x16_bf16(*(const bf16x8*)(kb + 48), qf3, s1, 0, 0, 0);
      s0 = __builtin_amdgcn_mfma_f32_32x32x16_bf16(*(const bf16x8*)(ka + 64), qf4, s0, 0, 0, 0);
      s1 = __builtin_amdgcn_mfma_f32_32x32x16_bf16(*(const bf16x8*)(kb + 64), qf4, s1, 0, 0, 0);
      s0 = __builtin_amdgcn_mfma_f32_32x32x16_bf16(*(const bf16x8*)(ka + 80), qf5, s0, 0, 0, 0);
      s1 = __builtin_amdgcn_mfma_f32_32x32x16_bf16(*(const bf16x8*)(kb + 80), qf5, s1, 0, 0, 0);
    }
    float mx = s0[0];
#pragma unroll
    for (int r = 1; r < 16; ++r) mx = fmaxf(mx, s0[r]);
#pragma unroll
    for (int r = 0; r < 16; ++r) mx = fmaxf(mx, s1[r]);
    mx = fmaxf(mx, __shfl_xor(mx, 32));
    const float mn = fmaxf(m, mx * sc);
    const float corr = __builtin_amdgcn_exp2f(m - mn);
    m = mn;
    lp *= corr;
#pragma unroll
    for (int r = 0; r < 16; ++r) { o0[r] *= corr; o1[r] *= corr; }
#pragma unroll
    for (int r = 0; r < 16; ++r) {
      s0[r] = __builtin_amdgcn_exp2f(s0[r] * sc - mn);
      s1[r] = __builtin_amdgcn_exp2f(s1[r] * sc - mn);
      lp += s0[r] + s1[r];
    }
#pragma unroll
    for (int u = 0; u < 2; ++u) {
#pragma unroll
      for (int s = 0; s < 2; ++s) {
        union { bf16x8 v; unsigned w[4]; } pb;
        if (u == 0) {
          pb.w[0] = pack2(s0[8 * s + 0], s0[8 * s + 1]); pb.w[1] = pack2(s0[8 * s + 2], s0[8 * s + 3]);
          pb.w[2] = pack2(s0[8 * s + 4], s0[8 * s + 5]); pb.w[3] = pack2(s0[8 * s + 6], s0[8 * s + 7]);
        } else {
          pb.w[0] = pack2(s1[8 * s + 0], s1[8 * s + 1]); pb.w[1] = pack2(s1[8 * s + 2], s1[8 * s + 3]);
          pb.w[2] = pack2(s1[8 * s + 4], s1[8 * s + 5]); pb.w[3] = pack2(s1[8 * s + 6], s1[8 * s + 7]);
        }
        const bf16_t* va = sV + li * 68 + 32 * u + 16 * s + 4 * hh;
        union { bf16x8 v; uint2 d[2]; } a0, a1;
        a0.d[0] = *(const uint2*)(va);
        a0.d[1] = *(const uint2*)(va + 8);
        a1.d[0] = *(const uint2*)(va + 32 * 68);
        a1.d[1] = *(const uint2*)(va + 32 * 68 + 8);
        o0 = __builtin_amdgcn_mfma_f32_32x32x16_bf16(a0.v, pb.v, o0, 0, 0, 0);
        o1 = __builtin_amdgcn_mfma_f32_32x32x16_bf16(a1.v, pb.v, o1, 0, 0, 0);
      }
    }
  }
  lp += __shfl_xor(lp, 32);
  const float inv = 1.f / lp;
  bf16_t* op = MIX + (size_t)qrow * 1024 + h * 64 + 4 * hh;
#pragma unroll
  for (int g = 0; g < 4; ++g) {
    uint2 u0, u1;
    u0.x = pack2(o0[4 * g + 0] * inv, o0[4 * g + 1] * inv);
    u0.y = pack2(o0[4 * g + 2] * inv, o0[4 * g + 3] * inv);
    u1.x = pack2(o1[4 * g + 0] * inv, o1[4 * g + 1] * inv);
    u1.y = pack2(o1[4 * g + 2] * inv, o1[4 * g + 3] * inv);
    *(uint2*)(op + 8 * g) = u0;
    *(uint2*)(op + 32 + 8 * g) = u1;
  }
}

__device__ void na_naive(const Params& p, int l, int ti) {
  const int h = otid() >> 6, lane = otid() & 63;
  const bf16_t* P = (const bf16_t*)(p.ws + OFF_P);
  bf16_t* MIX = (bf16_t*)(p.ws + OFF_HM);
  const bool lat = ti < 256;
  const int b = lat ? (ti >> 5) : ((ti - 256) >> 2);
  const int r = ti & 31;
  const int row = lat ? (ti * 64 + lane) : (M_LAT + (ti - 256) * 64 + lane);
  uint4 qk[8];
  float acc[64];
  {
    const uint4* qp = (const uint4*)(P + (size_t)row * INWP + C_NQ + h * 64);
#pragma unroll
    for (int c = 0; c < 8; ++c) qk[c] = qp[c];
  }
#pragma unroll
  for (int i = 0; i < 64; ++i) acc[i] = 0.f;
  float m = -INFINITY, ls = 0.f;
  const int qc = lane;
  const int rs0 = min(max(r - 4, 0), 24);
  const int cs0 = min(max(qc - 8, 0), 48);
  const float* rb = p.rel_bias + (size_t)l * 4 * 15 * 31 + h * 15 * 31;
  const int nloc = lat ? 128 : 0;
  for (int j = 0; j < nloc + 256; ++j) {
    int krow;
    float bias = 0.f;
    if (j < nloc) {
      int kr = rs0 + (j >> 4), kc = cs0 + (j & 15);
      krow = b * 2048 + kr * 64 + kc;
      bias = rb[(kr - r + 7) * 31 + (kc - qc + 15)];
    } else {
      krow = M_LAT + b * 256 + (j - nloc);
    }
    const uint4* kp = (const uint4*)(P + (size_t)krow * INWP + C_NK + h * 64);
    float s = 0.f;
#pragma unroll
    for (int c = 0; c < 8; ++c) {
      uint4 u = kp[c];
      uint4 q = qk[c];
      s += bflo(q.x) * bflo(u.x) + bfhi(q.x) * bfhi(u.x) + bflo(q.y) * bflo(u.y) + bfhi(q.y) * bfhi(u.y) +
           bflo(q.z) * bflo(u.z) + bfhi(q.z) * bfhi(u.z) + bflo(q.w) * bflo(u.w) + bfhi(q.w) * bfhi(u.w);
    }
    s = s * 0.125f + bias;
    float mn = fmaxf(m, s);
    float corr = __expf(m - mn), pe = __expf(s - mn);
    ls = ls * corr + pe;
    m = mn;
    const uint4* vp = (const uint4*)(P + (size_t)krow * INWP + C_NV + h * 64);
#pragma unroll
    for (int c = 0; c < 8; ++c) {
      uint4 u = vp[c];
      acc[c * 8 + 0] = acc[c * 8 + 0] * corr + pe * bflo(u.x);
      acc[c * 8 + 1] = acc[c * 8 + 1] * corr + pe * bfhi(u.x);
      acc[c * 8 + 2] = acc[c * 8 + 2] * corr + pe * bflo(u.y);
      acc[c * 8 + 3] = acc[c * 8 + 3] * corr + pe * bfhi(u.y);
      acc[c * 8 + 4] = acc[c * 8 + 4] * corr + pe * bflo(u.z);
      acc[c * 8 + 5] = acc[c * 8 + 5] * corr + pe * bfhi(u.z);
      acc[c * 8 + 6] = acc[c * 8 + 6] * corr + pe * bflo(u.w);
      acc[c * 8 + 7] = acc[c * 8 + 7] * corr + pe * bfhi(u.w);
    }
  }
  const float inv = 1.f / ls;
  uint4* op = (uint4*)(MIX + (size_t)row * 1024 + 256 + h * 64);
#pragma unroll
  for (int c = 0; c < 8; ++c) {
    uint4 u;
    u.x = pack2(acc[c * 8 + 0] * inv, acc[c * 8 + 1] * inv);
    u.y = pack2(acc[c * 8 + 2] * inv, acc[c * 8 + 3] * inv);
    u.z = pack2(acc[c * 8 + 4] * inv, acc[c * 8 + 5] * inv);
    u.w = pack2(acc[c * 8 + 6] * inv, acc[c * 8 + 7] * inv);
    op[c] = u;
  }
}

__device__ void na_flash(const Params& p, int l, int item, char* smem) {
  bf16_t* sK = (bf16_t*)smem;
  bf16_t* sV = sK + 64 * 72;
  float* sBias = (float*)(smem + 18432);
  const int tid = otid(), lane = tid & 63, w = tid >> 6;
  const int li = lane & 31, hh = lane >> 5;
  const bf16_t* P = (const bf16_t*)(p.ws + OFF_P);
  bf16_t* MIX = (bf16_t*)(p.ws + OFF_HM);
  int b, h, qrow, qr = 0, qc = 0, rs0 = 0, ntiles, krow0 = 0;
  bool lat;
  if (item < 512) {
    lat = true;
    b = item >> 6; h = item & 3;
    const int r0 = ((item >> 2) & 15) * 2;
    qr = r0 + (w >> 1); qc = (w & 1) * 32 + li;
    qrow = b * 2048 + qr * 64 + qc;
    krow0 = min(max(r0 - 4, 0), 24);
    const int klast = min(max(r0 + 1 - 4, 0), 24) + 7;
    ntiles = 4 + (klast - krow0 + 1);
    rs0 = min(max(qr - 4, 0), 24);
  } else {
    lat = false;
    const int i = item - 512;
    b = i >> 3; h = i & 3;
    qrow = M_LAT + b * 256 + ((i >> 2) & 1) * 128 + w * 32 + li;
    ntiles = 4;
  }
  const int cs0 = min(max(qc - 8, 0), 48);
  const bf16_t* Vg = (const bf16_t*)(p.ws + OFF_NVT) + (size_t)(b * 4 + h) * 64 * 2304;
  bf16x8 qf0, qf1, qf2, qf3;
  {
    const bf16_t* qp = P + (size_t)qrow * INWP + C_NQ + h * 64 + hh * 8;
    qf0 = *(const bf16x8*)(qp); qf1 = *(const bf16x8*)(qp + 16); qf2 = *(const bf16x8*)(qp + 32); qf3 = *(const bf16x8*)(qp + 48);
  }
  __syncthreads();
  for (int i = tid; i < 465; i += 256)
    sBias[i] = p.rel_bias[(size_t)l * 4 * 465 + h * 465 + i] * 1.4426950408889634f;
  const int kk0 = tid >> 3, kc8 = tid & 7, kk1 = kk0 + 32;
  uint4 rk0, rk1, rv0, rv1;
  {
    const size_t kr = (size_t)(M_LAT + b * 256);
    rk0 = *(const uint4*)(P + (kr + kk0) * INWP + C_NK + h * 64 + kc8 * 8);
    rk1 = *(const uint4*)(P + (kr + kk1) * INWP + C_NK + h * 64 + kc8 * 8);
    rv0 = *(const uint4*)(Vg + (size_t)kk0 * 2304 + kc8 * 8);
    rv1 = *(const uint4*)(Vg + (size_t)kk1 * 2304 + kc8 * 8);
  }
  f32x16 o0, o1;
#pragma unroll
  for (int r = 0; r < 16; ++r) { o0[r] = 0.f; o1[r] = 0.f; }
  float m = -1e30f, lp = 0.f;
  const float sc = 0.125f * 1.4426950408889634f;
  for (int t = 0; t < ntiles; ++t) {
    __syncthreads();
    *(uint4*)(sK + kk0 * 72 + kc8 * 8) = rk0;
    *(uint4*)(sK + kk1 * 72 + kc8 * 8) = rk1;
    *(uint2*)(sV + kk0 * 68 + kc8 * 8) = make_uint2(rv0.x, rv0.y);
    *(uint2*)(sV + kk0 * 68 + kc8 * 8 + 4) = make_uint2(rv0.z, rv0.w);
    *(uint2*)(sV + kk1 * 68 + kc8 * 8) = make_uint2(rv1.x, rv1.y);
    *(uint2*)(sV + kk1 * 68 + kc8 * 8 + 4) = make_uint2(rv1.z, rv1.w);
    __syncthreads();
    if (t + 1 < ntiles) {
      const int tn = t + 1;
      size_t kr;
      int vk;
      if (tn < 4) { kr = (size_t)(M_LAT + b * 256 + tn * 64); vk = tn * 64; }
      else { kr = (size_t)(b * 2048 + (krow0 + tn - 4) * 64); vk = 256 + (krow0 + tn - 4) * 64; }
      rk0 = *(const uint4*)(P + (kr + kk0) * INWP + C_NK + h * 64 + kc8 * 8);
      rk1 = *(const uint4*)(P + (kr + kk1) * INWP + C_NK + h * 64 + kc8 * 8);
      rv0 = *(const uint4*)(Vg + (size_t)kk0 * 2304 + vk + kc8 * 8);
      rv1 = *(const uint4*)(Vg + (size_t)kk1 * 2304 + vk + kc8 * 8);
    }
    const int kr_abs = krow0 + t - 4;
    const bool local = t >= 4;
    if (local && (kr_abs < rs0 || kr_abs >= rs0 + 8)) continue;
    f32x16 s0, s1;
#pragma unroll
    for (int r = 0; r < 16; ++r) { s0[r] = 0.f; s1[r] = 0.f; }
    {
      const bf16_t* ka = sK + li * 72 + hh * 8;
      const bf16_t* kb = ka + 32 * 72;
      s0 = __builtin_amdgcn_mfma_f32_32x32x16_bf16(*(const bf16x8*)(ka), qf0, s0, 0, 0, 0);
      s1 = __builtin_amdgcn_mfma_f32_32x32x16_bf16(*(const bf16x8*)(kb), qf0, s1, 0, 0, 0);
      s0 = __builtin_amdgcn_mfma_f32_32x32x16_bf16(*(const bf16x8*)(ka + 16), qf1, s0, 0, 0, 0);
      s1 = __builtin_amdgcn_mfma_f32_32x32x16_bf16(*(const bf16x8*)(kb + 16), qf1, s1, 0, 0, 0);
      s0 = __builtin_amdgcn_mfma_f32_32x32x16_bf16(*(const bf16x8*)(ka + 32), qf2, s0, 0, 0, 0);
      s1 = __builtin_amdgcn_mfma_f32_32x32x16_bf16(*(const bf16x8*)(kb + 32), qf2, s1, 0, 0, 0);
      s0 = __builtin_amdgcn_mfma_f32_32x32x16_bf16(*(const bf16x8*)(ka + 48), qf3, s0, 0, 0, 0);
      s1 = __builtin_amdgcn_mfma_f32_32x32x16_bf16(*(const bf16x8*)(kb + 48), qf3, s1, 0, 0, 0);
    }
    if (local) {
      const float* bp = sBias + (kr_abs - qr + 7) * 31 - qc + 15;
#pragma unroll
      for (int r = 0; r < 16; ++r) {
        const int kc0 = rowmap(r, hh), kc1 = 32 + kc0;
        const bool v0 = (kc0 >= cs0) && (kc0 < cs0 + 16);
        const bool v1 = (kc1 >= cs0) && (kc1 < cs0 + 16);
        const float b0 = v0 ? bp[kc0] : 0.f;
        const float b1 = v1 ? bp[kc1] : 0.f;
        s0[r] = v0 ? (s0[r] * sc + b0) : -1e30f;
        s1[r] = v1 ? (s1[r] * sc + b1) : -1e30f;
      }
    } else {
#pragma unroll
      for (int r = 0; r < 16; ++r) { s0[r] *= sc; s1[r] *= sc; }
    }
    float mx = s0[0];
#pragma unroll
    for (int r = 1; r < 16; ++r) mx = fmaxf(mx, s0[r]);
#pragma unroll
    for (int r = 0; r < 16; ++r) mx = fmaxf(mx, s1[r]);
    mx = fmaxf(mx, __shfl_xor(mx, 32));
    const float mn = fmaxf(m, mx);
    const float corr = __builtin_amdgcn_exp2f(m - mn);
    m = mn;
    lp *= corr;
#pragma unroll
    for (int r = 0; r < 16; ++r) { o0[r] *= corr; o1[r] *= corr; }
#pragma unroll
    for (int r = 0; r < 16; ++r) {
      s0[r] = __builtin_amdgcn_exp2f(s0[r] - mn);
      s1[r] = __builtin_amdgcn_exp2f(s1[r] - mn);
      lp += s0[r] + s1[r];
    }
#pragma unroll
    for (int u = 0; u < 2; ++u) {
#pragma unroll
      for (int s = 0; s < 2; ++s) {
        bf16x8 pb = u == 0 ? pack8(s0, s) : pack8(s1, s);
        const bf16_t* va = sV + li * 68 + 32 * u + 16 * s + 4 * hh;
        o0 = __builtin_amdgcn_mfma_f32_32x32x16_bf16(ld_perm(va), pb, o0, 0, 0, 0);
        o1 = __builtin_amdgcn_mfma_f32_32x32x16_bf16(ld_perm(va + 32 * 68), pb, o1, 0, 0, 0);
      }
    }
  }
  lp += __shfl_xor(lp, 32);
  const float inv = 1.f / lp;
  bf16_t* op = MIX + (size_t)qrow * 1024 + 256 + h * 64 + 4 * hh;
#pragma unroll
  for (int g = 0; g < 4; ++g) {
    uint2 u0, u1;
    u0.x = pack2(o0[4 * g + 0] * inv, o0[4 * g + 1] * inv);
    u0.y = pack2(o0[4 * g + 2] * inv, o0[4 * g + 3] * inv);
    u1.x = pack2(o1[4 * g + 0] * inv, o1[4 * g + 1] * inv);
    u1.y = pack2(o1[4 * g + 2] * inv, o1[4 * g + 3] * inv);
    *(uint2*)(op + 8 * g) = u0;
    *(uint2*)(op + 32 + 8 * g) = u1;
  }
}

DEVI int dn_rowof(int s, int b, int d) {
  if (s < 256) {
    int c = d ? (255 - s) : s;
    return M_LAT + b * 256 + c;
  }
  int t = s - 256;
  t = d ? (2047 - t) : t;
  return b * 2048 + t;
}

__device__ void dn_naive(const Params& p, int l, int it, char* smem) {
  float* ks = (float*)smem;
  float* qs = ks + 32 * 128;
  float* vs = qs + 32 * 128;
  float* gs = vs + 32 * 64;
  float* bs = gs + 32;
  const int half = it & 1, d = (it >> 1) & 1, h = (it >> 2) & 3, b = it >> 4;
  const int tid = otid(), w = tid >> 6, lane = tid & 63, c = lane & 15, kg = lane >> 4;
  const int col = half * 64 + w * 16 + c;
  const bf16_t* DQ = (const bf16_t*)(p.ws + OFF_DNQKV);
  const float* AB = (const float*)(p.ws + OFF_AB);
  bf16_t* MIX = (bf16_t*)(p.ws + OFF_HM);
  bf16_t* OB = (bf16_t*)(p.ws + OFF_OB);
  float S[32];
#pragma unroll
  for (int i = 0; i < 32; ++i) S[i] = 0.f;
  const float Aneg = -__expf(p.a_log[l * 8 + d * 4 + h]);
  const float dtb = p.dt_bias[l * 8 + d * 4 + h];
  for (int s0 = 0; s0 < 2304; s0 += 32) {
    __syncthreads();
    for (int i = tid; i < 32 * 128; i += 256) {
      int tk = i >> 7, ch = i & 127;
      int row = dn_rowof(s0 + tk, b, d);
      qs[i] = bf2f(DQ[(size_t)row * 1536 + h * 128 + ch]);
      ks[i] = bf2f(DQ[(size_t)row * 1536 + 512 + h * 128 + ch]);
    }
    for (int i = tid; i < 32 * 64; i += 256) {
      int tk = i >> 6, ch = i & 63;
      int row = dn_rowof(s0 + tk, b, d);
      vs[i] = bf2f(DQ[(size_t)row * 1536 + 1024 + h * 128 + half * 64 + ch]);
    }
    if (tid < 32) {
      int row = dn_rowof(s0 + tid, b, d);
      float a = AB[(size_t)row * 16 + d * 4 + h];
      float bb = AB[(size_t)row * 16 + 8 + d * 4 + h];
      float xx = a + dtb;
      const float ee = __expf(xx);
    float sp = ee < 0.25f ? ee * (1.f - ee * (0.5f - ee * (0.33333333f - ee * (0.25f - 0.2f * ee))))
                          : (xx > 20.f ? xx : __logf(1.f + ee));
      gs[tid] = __expf(Aneg * sp);
      bs[tid] = 1.f / (1.f + __expf(-bb));
    }
    __syncthreads();
    for (int tk = 0; tk < 32; ++tk) {
      const float eg = gs[tk], beta = bs[tk];
      const float vv = vs[tk * 64 + w * 16 + c];
      const float4* k4 = (const float4*)(ks + tk * 128 + kg * 32);
      const float4* q4 = (const float4*)(qs + tk * 128 + kg * 32);
      float part = 0.f;
#pragma unroll
      for (int i = 0; i < 8; ++i) {
        float4 kk = k4[i];
        S[4 * i + 0] *= eg; S[4 * i + 1] *= eg; S[4 * i + 2] *= eg; S[4 * i + 3] *= eg;
        part += kk.x * S[4 * i + 0] + kk.y * S[4 * i + 1] + kk.z * S[4 * i + 2] + kk.w * S[4 * i + 3];
      }
      part += __shfl_xor(part, 16);
      part += __shfl_xor(part, 32);
      const float delta = beta * (vv - part);
      float po = 0.f;
#pragma unroll
      for (int i = 0; i < 8; ++i) {
        float4 kk = k4[i];
        float4 qq = q4[i];
        S[4 * i + 0] += kk.x * delta; S[4 * i + 1] += kk.y * delta; S[4 * i + 2] += kk.z * delta; S[4 * i + 3] += kk.w * delta;
        po += qq.x * S[4 * i + 0] + qq.y * S[4 * i + 1] + qq.z * S[4 * i + 2] + qq.w * S[4 * i + 3];
      }
      po += __shfl_xor(po, 16);
      po += __shfl_xor(po, 32);
      if (kg == 0) {
        int row = dn_rowof(s0 + tk, b, d);
        float o = po * 0.08838834764831845f;
        if (d == 0)
          MIX[(size_t)row * 1024 + 512 + h * 128 + col] = f2bf(o);
        else
          OB[(size_t)row * 512 + h * 128 + col] = f2bf(o);
      }
    }
  }
}

__device__ void phaseD(const Params& p, int l, char* smem) {
  const int nb = gridDim.x, bid = blockIdx.x;
  if (bid < 64) {
    dn_scan(p, l, bid, smem);
    return;
  }
  if (bid >= 256 && bid < 320) return;
  const int nb2 = nb - 128;
  const int wid = bid < 256 ? bid - 64 : bid - 128;
  const int n_early = l < 3 ? N_CONV_EARLY : 0;
  for (int it = wid; it < 1152 + N_CONV_LATE + n_early; it += nb2) {
    if (it < 576) {
      int item = it;
      if (it < 512) item = ((it & 7) * 64) + (it >> 3);
      else if (l == 3) continue;
      mla_flash(p, item, smem);
    } else if (it < 1152) {
      if (l == 3 && it - 576 >= 512) continue;
      na_flash(p, l, it - 576, smem);
    } else if (it < 1152 + N_CONV_LATE) {
      conv_item_late(p, l, it - 1152, (float*)smem);
    } else {
      conv_item_early(p, l + 1, it - 1152 - N_CONV_LATE, (float*)smem);
    }
  }
}

__device__ void outgate_item(const Params& p, int l, int item) {
  const int w = otid() >> 6, lane = otid() & 63;
  const int row = item * 4 + w;
  const bf16_t* P = (const bf16_t*)(p.ws + OFF_P);
  bf16_t* MIX = (bf16_t*)(p.ws + OFF_HM);
  const int h = lane >> 4, cb = (lane & 15) * 8;
  uint4 uo = *(const uint4*)(MIX + (size_t)row * 1024 + 512 + h * 128 + cb);
  uint4 ub = *(const uint4*)(P + (size_t)row * INWP + C_DN + h * 128 + cb);
  uint4 uz = *(const uint4*)(P + (size_t)row * INWP + C_DZ + h * 128 + cb);
  float o[8], z[8];
  o[0] = bflo(uo.x) + bflo(ub.x); o[1] = bfhi(uo.x) + bfhi(ub.x); o[2] = bflo(uo.y) + bflo(ub.y); o[3] = bfhi(uo.y) + bfhi(ub.y);
  o[4] = bflo(uo.z) + bflo(ub.z); o[5] = bfhi(uo.z) + bfhi(ub.z); o[6] = bflo(uo.w) + bflo(ub.w); o[7] = bfhi(uo.w) + bfhi(ub.w);
  z[0] = bflo(uz.x); z[1] = bfhi(uz.x); z[2] = bflo(uz.y); z[3] = bfhi(uz.y);
  z[4] = bflo(uz.z); z[5] = bfhi(uz.z); z[6] = bflo(uz.w); z[7] = bfhi(uz.w);
  float ss = 0.f;
#pragma unroll
  for (int e = 0; e < 8; ++e) ss += o[e] * o[e];
  ss += __shfl_xor(ss, 1);
  ss += __shfl_xor(ss, 2);
  ss += __shfl_xor(ss, 4);
  ss += __shfl_xor(ss, 8);
  const float r = rsqrtf(ss * (1.f / 128.f) + 1e-6f);
  const float* go = p.g_out + l * 128 + cb;
  float y[8];
#pragma unroll
  for (int e = 0; e < 8; ++e) y[e] = o[e] * r * go[e] * silu_f(z[e]);
  uint4 u;
  u.x = pack2(y[0], y[1]); u.y = pack2(y[2], y[3]); u.z = pack2(y[4], y[5]); u.w = pack2(y[6], y[7]);
  *(uint4*)(MIX + (size_t)row * 1024 + 512 + h * 128 + cb) = u;
}

__device__ void final_item(const Params& p, int item) {
  const int w = otid() >> 6, lane = otid() & 63;
  const int row = item * 4 + w;
  const float4* xr = (const float4*)((const float*)(p.ws + OFF_X) + (size_t)row * 1024);
  float4 v[4];
  float ss = 0.f;
#pragma unroll
  for (int i = 0; i < 4; ++i) {
    v[i] = xr[lane + 64 * i];
    ss += v[i].x * v[i].x + v[i].y * v[i].y + v[i].z * v[i].z + v[i].w * v[i].w;
  }
  ss = wave_sum(ss);
  const float r = rsqrtf(ss * (1.f / 1024.f) + 1e-6f);
  const float4* g4 = (const float4*)p.g_final;
  float4* o4 = (float4*)(p.out + (size_t)row * 1024);
#pragma unroll
  for (int i = 0; i < 4; ++i) {
    float4 gg = g4[lane + 64 * i];
    float4 y;
    y.x = v[i].x * r * gg.x; y.y = v[i].y * r * gg.y; y.z = v[i].z * r * gg.z; y.w = v[i].w * r * gg.w;
    o4[lane + 64 * i] = y;
  }
}

constexpr int N_PHASES = 1 + 9 * 4 + 1;

__global__ void __launch_bounds__(256, 2) mega(Params p) {
  __shared__ __attribute__((aligned(16))) char smem[SMEM_BYTES];
  cg::grid_group grid = cg::this_grid();
  const int nb = gridDim.x, bid = blockIdx.x;
  __shared__ uint4 xb_words;
  if (threadIdx.x == 0) xb_words = make_uint4(0u, 0u, 0u, 0u);
  __syncthreads();
  XcdBarrier xb = xcd_barrier_post((unsigned*)(p.ws + OFF_BAR), (volatile LAS unsigned*)&xb_words);
#ifdef PROBE_S
  bool again = false;
#endif
  for (int ph = p.ph_lo; ph < p.ph_hi; ++ph) {
    if (ph == 0) {
      phase0(p, smem);
    } else if (ph == N_PHASES - 1) {
      for (int it = bid; it < M_LAT / 4; it += nb) final_item(p, it);
    } else {
      const int l = (ph - 1) / 9, s = (ph - 1) % 9;
      if (s == 0) {
        phaseA(p, l, smem);
      } else if (s == 1) {
        for (int it = bid; it < 144 * 13; it += nb) {
          int mt, nt;
          tile_map(it, 13, mt, nt);
          gemm_wide16<EPI_P>(p, l, (const bf16_t*)(p.ws + OFF_HM), 1024, (const bf16_t*)(p.ws + OFF_WIN), 1024,
                             mt * 128, nt * 256, smem);
        }
      } else if (s == 2) {
        phaseC(p, l, smem);
      } else if (s == 3) {
        phaseD(p, l, smem);
      } else if (s == 4) {
        for (int it = bid; it < (l == 3 ? M_LAT : M_ALL) / 4; it += nb) outgate_item(p, l, it);
      } else if (s == 5) {
        const int mpx = l == 3 ? 16 : 18;
        for (int it = bid; it < 8 * mpx * 8; it += nb) {
          int mt, nt;
          tile_map(it, 8, mt, nt, mpx);
          gemm_tile<EPI_RES>(p, l, (const bf16_t*)(p.ws + OFF_HM), 1024, (const bf16_t*)(p.ws + OFF_WOUT), 1024,
                             mt * 128, nt * 128, 2, smem);
        }
      } else if (s == 6) {
        for (int it = bid; it < (l == 3 ? M_LAT : M_ALL) / 4; it += nb)
          norm_rows(p, false, (bf16_t*)(p.ws + OFF_HM), p.g_ffn + l * 1024,
                    (const float*)(p.ws + OFF_MOD) + (size_t)l * 9 * 6144, 3, 4, it);
      } else if (s == 7) {
        const int mpx = l == 3 ? 16 : 18;
        for (int it = bid; it < 8 * mpx * 22; it += nb) {
          int mt, nt;
          tile_map(it, 22, mt, nt, mpx);
          gemm_wide16<EPI_GU>(p, l, (const bf16_t*)(p.ws + OFF_HM), 1024, (const bf16_t*)(p.ws + OFF_WGU), 1024,
                              mt * 128, nt * 256, smem);
        }
      } else {
        const int mpx = l == 3 ? 16 : 18;
        for (int it = bid; it < 8 * mpx * 8; it += nb) {
          int mt, nt;
          tile_map(it, 8, mt, nt, mpx);
          gemm_tile<EPI_RES>(p, l, (const bf16_t*)(p.ws + OFF_P), FFN, (const bf16_t*)(p.ws + OFF_WDN), FFN,
                             mt * 128, nt * 128, 5, smem);
        }
      }
    }
#ifdef PROBE_S
    {
      const bool hit = (PROBE_S == 9) ? (ph == 0) : (ph != 0 && ph != N_PHASES - 1 && ((ph - 1) % 9) == PROBE_S);
      if (hit && !again) {
        again = true;
        if (p.use_cg) grid.sync(); else xcd_barrier(xb);
        --ph;
        continue;
      }
      again = false;
    }
#endif
    if (ph + 1 < p.ph_hi) {
      if (p.use_cg) grid.sync();
      else xcd_barrier(xb);
    }
  }
}

extern "C" void kernel_launch(void* const* d_in, const int* in_sizes, int n_in, void* d_out, int out_size, void* d_ws,
                              size_t ws_size, hipStream_t stream) {
  static int grid_blocks = 0;
  if (!grid_blocks) {
    int dev = 0, cus = 0, per_cu = 0;
    hipGetDevice(&dev);
    hipDeviceGetAttribute(&cus, hipDeviceAttributeMultiprocessorCount, dev);
    hipOccupancyMaxActiveBlocksPerMultiprocessor(&per_cu, mega, 256, 0);
    if (per_cu < 1) per_cu = 1;
    if (per_cu > 2) per_cu = 2;
    grid_blocks = cus * per_cu;
  }
  Params p{};
  const float** pp = (const float**)&p;
  for (int i = 0; i < 23; ++i) pp[i] = (const float*)d_in[i];
  p.out = (float*)d_out;
  p.ws = (char*)d_ws;
  p.ph_lo = 0;
  p.ph_hi = N_PHASES;
  p.use_cg = 0;
  p.pad0 = 0;
  hipMemsetAsync((char*)d_ws + OFF_BAR, 0, XCD_BAR_WORDS * sizeof(unsigned), stream);
  void* args[] = {&p};
  hipError_t e = hipLaunchCooperativeKernel((void*)mega, dim3(grid_blocks), dim3(256), args, 0, stream);
  if (e != hipSuccess) {
    fprintf(stderr, "cooperative launch failed: %s (grid %d)\n", hipGetErrorString(e), grid_blocks);
    (void)hipGetLastError();
    for (int ph = 0; ph < N_PHASES; ++ph) {
      p.ph_lo = ph;
      p.ph_hi = ph + 1;
      hipLaunchKernelGGL(mega, dim3(grid_blocks), dim3(256), 0, stream, p);
    }
  }
}
```
